# Optimizing an MI355X kernel written in HIP

```python
import jax, jax.numpy as jnp
from jax import lax
import numpy as np

D_MODEL = 2048
BATCH = 4
SEQ = 4096
DEPTH = 1

GRID_W = 64
CTX_LEN = 256
D_INNER = D_MODEL
W_A = D_INNER // 2
W_B = D_INNER - W_A
HG_HEADS = 8
HG_DK = W_A // HG_HEADS
HG_DV = W_A // HG_HEADS
ML_HEADS = 4
ML_DH = W_B // ML_HEADS
CHUNK = 64
CONV_K = 3
N_IN = 5 * W_A + 5 * W_B + 4 * ML_HEADS
ALPHA = (2 * DEPTH) ** 0.25
BETA = (8 * DEPTH) ** -0.25
LN_EPS = 1e-5
NORM_EPS = 1e-6

kernel_name = "hymba_hgrn2_mlstm_bidir_dit_block"


def layer_norm(a, g, b):
    af = a.astype(jnp.float32)
    mu = jnp.mean(af, axis=-1, keepdims=True)
    var = jnp.mean(jnp.square(af - mu), axis=-1, keepdims=True)
    out = (af - mu) * lax.rsqrt(var + LN_EPS) * g.astype(jnp.float32) + b.astype(jnp.float32)
    return out.astype(a.dtype)


def modulate(a, shift, scale):
    af = a.astype(jnp.float32)
    mu = jnp.mean(af, axis=-1, keepdims=True)
    var = jnp.mean(jnp.square(af - mu), axis=-1, keepdims=True)
    n = (af - mu) * lax.rsqrt(var + LN_EPS)
    return (n * (1.0 + scale.astype(jnp.float32)) + shift.astype(jnp.float32)).astype(a.dtype)


def rms_norm(a):
    return a * lax.rsqrt(jnp.mean(jnp.square(a), axis=-1, keepdims=True) + NORM_EPS)


def head_layer_norm(a):
    mu = jnp.mean(a, axis=-1, keepdims=True)
    var = jnp.mean(jnp.square(a - mu), axis=-1, keepdims=True)
    return (a - mu) * lax.rsqrt(var + NORM_EPS)


def heads(a, n_heads):
    return a.reshape(a.shape[:2] + (n_heads, a.shape[-1] // n_heads))


def flip(a):
    return jnp.flip(a, axis=1)


def to_chunks(a):
    bsz, t = a.shape[:2]
    a = a.reshape((bsz, t // CHUNK, CHUNK) + a.shape[2:])
    return jnp.swapaxes(jnp.moveaxis(a, 1, 0), 2, 3)


def from_chunks(o):
    o = jnp.moveaxis(jnp.swapaxes(o, 2, 3), 0, 1)
    return o.reshape((o.shape[0], o.shape[1] * o.shape[2]) + o.shape[3:])


def hgrn2_scan(q, k, v, logf, s0):
    mask = jnp.tril(jnp.ones((CHUNK, CHUNK), dtype=bool))[:, :, None]

    def step(s, inp):
        qc, kc, vc, gc = inp
        b = jnp.cumsum(gc, axis=2)
        o_inter = jnp.einsum('bhtk,bhkv->bhtv', qc * jnp.exp(b), s)
        diff = b[:, :, :, None, :] - b[:, :, None, :, :]
        decay = jnp.exp(jnp.where(mask, diff, -jnp.inf))
        scores = jnp.einsum('bhtk,bhsk,bhtsk->bhts', qc, kc, decay)
        o = o_inter + jnp.einsum('bhts,bhsv->bhtv', scores, vc)
        b_last = b[:, :, -1]
        k_dec = kc * jnp.exp(b_last[:, :, None, :] - b)
        s_new = jnp.exp(b_last)[..., None] * s + jnp.einsum('bhsk,bhsv->bhkv', k_dec, vc)
        return s_new, o

    s_fin, o = lax.scan(step, s0, (to_chunks(q), to_chunks(k), to_chunks(v), to_chunks(logf)))
    return from_chunks(o), s_fin


def mlstm_scan(q, k, v, log_i, log_f, state):
    mask = jnp.tril(jnp.ones((CHUNK, CHUNK), dtype=bool))

    def step(carry, inp):
        c_mat, n_vec, m = carry
        qc, kc, vc, ic, fc = inp
        b = jnp.cumsum(fc, axis=-1)
        log_w = jnp.where(mask, b[..., :, None] - b[..., None, :] + ic[..., None, :], -jnp.inf)
        m_inter = b + m[..., None]
        m_t = jnp.maximum(m_inter, jnp.max(log_w, axis=-1))
        w_inter = jnp.exp(m_inter - m_t)
        w_qk = jnp.exp(log_w - m_t[..., None]) * jnp.einsum('bhtk,bhsk->bhts', qc, kc)
        num = (w_inter[..., None] * jnp.einsum('bhvk,bhtk->bhtv', c_mat, qc)
               + jnp.einsum('bhts,bhsv->bhtv', w_qk, vc))
        den = w_inter * jnp.einsum('bhk,bhtk->bht', n_vec, qc) + jnp.sum(w_qk, axis=-1)
        h = num / jnp.maximum(jnp.abs(den), jnp.exp(-m_t))[..., None]
        m_new = m_t[..., -1]
        w_s = jnp.exp(b[..., -1:] - b + ic - m_new[..., None])
        decay = jnp.exp(b[..., -1] + m - m_new)
        c_new = decay[..., None, None] * c_mat + jnp.einsum('bhsv,bhsk->bhvk', w_s[..., None] * vc, kc)
        n_new = decay[..., None] * n_vec + jnp.einsum('bhs,bhsk->bhk', w_s, kc)
        return (c_new, n_new, m_new), h

    st, h = lax.scan(step, state, (to_chunks(q), to_chunks(k), to_chunks(v), to_chunks(log_i), to_chunks(log_f)))
    return from_chunks(h), st


def short_conv(a, w, b, grid):
    ch = a.shape[-1]
    w = w.astype(jnp.float32)
    if grid:
        rows = a.shape[1] // GRID_W
        img = a.reshape(a.shape[0], rows, GRID_W, ch)
        out = lax.conv_general_dilated(img, w[:, :, None, :], (1, 1), 'SAME',
                                       dimension_numbers=('NHWC', 'HWIO', 'NHWC'), feature_group_count=ch)
        out = out.reshape(a.shape)
    else:
        out = lax.conv_general_dilated(a, w[1][:, None, :], (1,), 'SAME',
                                       dimension_numbers=('NWC', 'WIO', 'NWC'), feature_group_count=ch)
    return jax.nn.silu(out + b.astype(jnp.float32))


def hgrn2_gates(z, lb):
    f = lb + (1.0 - lb) * jax.nn.sigmoid(z)
    return jnp.log(f), 1.0 - f


def zero_states(bsz):
    hg = jnp.zeros((bsz, HG_HEADS, HG_DK, HG_DV), jnp.float32)
    ml = (jnp.zeros((bsz, ML_HEADS, ML_DH, ML_DH), jnp.float32),
          jnp.zeros((bsz, ML_HEADS, ML_DH), jnp.float32),
          jnp.zeros((bsz, ML_HEADS), jnp.float32))
    return (hg, hg, ml, ml)


def mix(u, grid, states, lb, conv_w_l, conv_b_l, gate_b_l, hg_norm_l, ml_norm_l):
    u = u.astype(jnp.float32)
    bsz, t = u.shape[:2]
    splits = [W_A, 2 * W_A, 3 * W_A, 4 * W_A, 5 * W_A,
              5 * W_A + 2 * W_B, 5 * W_A + 3 * W_B, 5 * W_A + 4 * W_B, 5 * W_A + 5 * W_B]
    a_q, a_ff, a_fb, a_i, a_z, b_qk, b_v, b_o, b_z, b_g = jnp.split(u, splits, axis=-1)
    hg_f0, hg_b0, ml_f0, ml_b0 = states

    q_a = heads(jax.nn.silu(a_q), HG_HEADS)
    v_a = heads(a_i, HG_HEADS)
    logf_f, k_f = hgrn2_gates(a_ff, lb[0])
    logf_b, k_b = hgrn2_gates(a_fb, lb[1])
    o_f, hg_f = hgrn2_scan(q_a, heads(k_f, HG_HEADS), v_a, heads(logf_f, HG_HEADS), hg_f0)
    o_b, hg_b = hgrn2_scan(flip(q_a), flip(heads(k_b, HG_HEADS)), flip(v_a), flip(heads(logf_b, HG_HEADS)), hg_b0)
    o_a = rms_norm(o_f + flip(o_b)) * hg_norm_l.astype(jnp.float32).reshape(HG_HEADS, HG_DV)
    y_a = o_a.reshape(bsz, t, W_A) * jax.nn.silu(a_z)

    qk = short_conv(b_qk, conv_w_l, conv_b_l, grid)
    q_m, k_m = jnp.split(qk, 2, axis=-1)
    q_m = heads(q_m, ML_HEADS)
    k_m = heads(k_m, ML_HEADS) * (ML_DH ** -0.5)
    v_m = heads(b_v, ML_HEADS)
    g = b_g.reshape(bsz, t, 4, ML_HEADS) + gate_b_l.astype(jnp.float32)
    log_i_f, log_i_b = g[:, :, 0], g[:, :, 1]
    log_f_f, log_f_b = jax.nn.log_sigmoid(g[:, :, 2]), jax.nn.log_sigmoid(g[:, :, 3])
    h_f, ml_f = mlstm_scan(q_m, k_m, v_m, log_i_f, log_f_f, ml_f0)
    h_b, ml_b = mlstm_scan(flip(q_m), flip(k_m), flip(v_m), flip(log_i_b), flip(log_f_b), ml_b0)
    h = head_layer_norm(h_f + flip(h_b)) * ml_norm_l.astype(jnp.float32).reshape(ML_HEADS, ML_DH)
    y_b = h.reshape(bsz, t, W_B) * jax.nn.sigmoid(b_o) * jax.nn.silu(b_z)

    return jnp.concatenate([y_a, y_b], axis=-1), (hg_f, hg_b, ml_f, ml_b)


def setup_inputs(seed: int = 0) -> dict:
    key = jax.random.key(seed)
    ks = jax.random.split(key, 20)
    f32 = jnp.float32
    x = jax.random.normal(ks[0], (BATCH, SEQ, D_MODEL), f32)
    c = jax.random.normal(ks[1], (BATCH, D_MODEL), f32)
    ctx = jax.random.normal(ks[2], (BATCH, CTX_LEN, D_MODEL), f32)
    c_ctx = jax.random.normal(ks[3], (D_MODEL,), f32)
    w_mod = jax.random.normal(ks[4], (DEPTH, D_MODEL, 3 * D_MODEL), f32) * (0.5 * D_MODEL ** -0.5)
    b_mod = jax.random.normal(ks[5], (DEPTH, 3 * D_MODEL), f32) * 0.02
    w_in = jax.random.normal(ks[6], (DEPTH, D_MODEL, N_IN), f32) * (D_MODEL ** -0.5)
    conv_w = jax.random.normal(ks[7], (DEPTH, CONV_K, CONV_K, 2 * W_B), f32) * (1.0 / CONV_K)
    conv_b = jax.random.normal(ks[8], (DEPTH, 2 * W_B), f32) * 0.02
    hg_lb = jax.random.normal(ks[9], (2, DEPTH + 1, W_A), f32) * 0.1
    ig_b = jax.random.normal(ks[10], (DEPTH, 2, ML_HEADS), f32) * 0.1
    fg_b = jnp.linspace(3.0, 6.0, ML_HEADS, dtype=f32)[None, None, :] + 0.1 * jax.random.normal(ks[11], (DEPTH, 2, ML_HEADS), f32)
    ml_gate_b = jnp.concatenate([ig_b, fg_b], axis=1)
    hg_norm_w = 1.0 + 0.02 * jax.random.normal(ks[12], (DEPTH, W_A), f32)
    ml_norm_w = 1.0 + 0.02 * jax.random.normal(ks[13], (DEPTH, W_B), f32)
    w_out = jax.random.normal(ks[14], (DEPTH, D_INNER, D_MODEL), f32) * (BETA * D_INNER ** -0.5)
    ln_g = 1.0 + 0.02 * jax.random.normal(ks[15], (DEPTH, D_MODEL), f32)
    ln_b = 0.02 * jax.random.normal(ks[16], (DEPTH, D_MODEL), f32)
    return {"x": x, "c": c, "ctx": ctx, "c_ctx": c_ctx, "w_mod": w_mod, "b_mod": b_mod, "w_in": w_in,
            "conv_w": conv_w, "conv_b": conv_b, "hg_lb": hg_lb, "ml_gate_b": ml_gate_b,
            "hg_norm_w": hg_norm_w, "ml_norm_w": ml_norm_w, "w_out": w_out, "ln_g": ln_g, "ln_b": ln_b}


def reference(x, c, ctx, c_ctx, w_mod, b_mod, w_in, conv_w, conv_b, hg_lb, ml_gate_b,
              hg_norm_w, ml_norm_w, w_out, ln_g, ln_b):
    lower = jnp.cumsum(jax.nn.softmax(hg_lb.astype(jnp.float32), axis=1), axis=1)
    states0 = zero_states(ctx.shape[0])
    for layer in range(DEPTH):
        mod_x = jax.nn.silu(c) @ w_mod[layer] + b_mod[layer]
        mod_c = jax.nn.silu(c_ctx) @ w_mod[layer] + b_mod[layer]
        shift_x, scale_x, gate_x = jnp.split(mod_x[:, None, :], 3, axis=-1)
        shift_c, scale_c, gate_c = jnp.split(mod_c, 3, axis=-1)
        lp = (lower[:, layer], conv_w[layer], conv_b[layer], ml_gate_b[layer], hg_norm_w[layer], ml_norm_w[layer])
        u_ctx = modulate(ctx, shift_c, scale_c) @ w_in[layer]
        y_ctx, ctx_states = mix(u_ctx, False, states0, *lp)
        u_x = modulate(x, shift_x, scale_x) @ w_in[layer]
        y_x, _ = mix(u_x, True, ctx_states, *lp)
        x = layer_norm(ALPHA * x + gate_x * (y_x.astype(x.dtype) @ w_out[layer]), ln_g[layer], ln_b[layer])
        if layer < DEPTH - 1:
            ctx = layer_norm(ALPHA * ctx + gate_c * (y_ctx.astype(ctx.dtype) @ w_out[layer]), ln_g[layer], ln_b[layer])
    return x
```

```cpp
#include <hip/hip_runtime.h>
#include <cstdio>
#include <cstdint>
namespace pg8 {
#define PG8_LAS __attribute__((address_space(3)))
typedef unsigned short bf16_t;
typedef short bf16x8 __attribute__((ext_vector_type(8)));
typedef float f32x4 __attribute__((ext_vector_type(4)));
typedef unsigned u32x4 __attribute__((ext_vector_type(4)));
constexpr int BM = 256, BK = 64, HALF = 128, HTB = HALF * BK * 2  , STAGE_BYTES = 8 * HTB, NXCD = 8, WGM = 8;

__host__ __device__ __forceinline__ int lds_byte(int r, int c) { const int st = (r >> 4) * 2 + (c >> 5), rr = r & 15, cc = c & 31, ob = rr * 64 + cc * 2; return st * 1024 + (ob ^ (((ob >> 9) & 1) << 5)); }
__host__ __device__ __forceinline__ void stage_rc(int b, int& R, int& C) { const int st = b / 1024, sb = b % 1024, swz = sb ^ (((sb >> 9) & 1) << 5); R = (st >> 1) * 16 + swz / 64; C = (st & 1) * 32 + (swz % 64) / 2; }
__host__ __device__ __forceinline__ int perm32(int rho) { const int n = rho >> 4, i = rho & 15; return 8 * (i >> 2) + 4 * n + (i & 3); }

struct Unit { int pm, pn; };
struct Gemm { const bf16_t* A; const bf16_t* Bt; int M, N, K; };

struct StaticOrder {
    int nM, nN, nwg, G, c;
    __host__ __device__ void init(int M, int N, int G_, int c_) { nM = M / BM; nN = N / BM; nwg = nM * nN; G = G_; c = c_; }
    __host__ __device__ bool next(int i, Unit& u) const {
        const long L = (long)i * G + c; if (L >= nwg) return false;
        int wgid = (int)L; { const int q = nwg / NXCD, r = nwg % NXCD, xcd = wgid % NXCD, off = wgid / NXCD; wgid = (xcd < r ? xcd * (q + 1) : r * (q + 1) + (xcd - r) * q) + off; }
        const int nig = WGM * nN, gid = wgid / nig, fm = gid * WGM, gsz = (nM - fm) < WGM ? (nM - fm) : WGM;
        u.pm = fm + ((wgid % nig) % gsz); u.pn = (wgid % nig) / gsz; return true;
    }
    __device__ __forceinline__ void a_ready(const Unit&) const {}
    __device__ __forceinline__ void done(const Unit&) const {}
};

__device__ __forceinline__ unsigned cvt_pk_bf16(float lo, float hi) { unsigned r; asm volatile("v_cvt_pk_bf16_f32 %0, %1, %2" : "=v"(r) : "v"(lo), "v"(hi)); return r; }
typedef float f32x2 __attribute__((ext_vector_type(2)));
__device__ __forceinline__ f32x2 gelu_pk(f32x2 v) {
    const f32x2 av = __builtin_elementwise_abs(v), d = av * 0.2316418882f + 1.0f;
    f32x2 t; t.x = __builtin_amdgcn_rcpf(d.x); t.y = __builtin_amdgcn_rcpf(d.y);
    f32x2 q = t * 0.5307027145f + (-0.7265760135f); q = q * t + 0.7107068705f; q = q * t + (-0.142248368f); q = q * t + 0.127414796f; q = q * t;
    const f32x2 s = (v * v) * (-0.72134752044f);
    f32x2 e; e.x = __builtin_amdgcn_exp2f(s.x); e.y = __builtin_amdgcn_exp2f(s.y);
    const f32x2 m = v * (q * e), r = v - m;
    f32x2 o; o.x = v.x < 0.f ? m.x : r.x; o.y = v.y < 0.f ? m.y : r.y; return o;
}

template <int ACT  > struct EpiBf16 {
    static constexpr bool PERM = true, AFTER_DRAIN = false; static_assert(ACT == 0 || ACT == 1, "EpiBf16: ACT is 0 (none) or 1 (gelu_pk)");
    bf16_t* O; int ldc; const float* bias; int split_cols; size_t split_stride; float scale0;
    __device__ __forceinline__ void operator()(const f32x4 (&acc)[2][2][4][2], const Unit& u, int wr, int wc, int fr, int fq) const {
        const int row0 = u.pm * BM + wr * 64 + fr; int colt = u.pn * BM; bf16_t* base = O;
        float sc = 1.f; if (split_cols) { const int t = colt / split_cols; base += (size_t)t * split_stride; colt -= t * split_cols; if (t == 0) sc = scale0; }
        const int col0 = colt + wc * 32 + 8 * fq, bcol0 = u.pn * BM + wc * 32 + 8 * fq;
        f32x4 bv[2][2];
#pragma unroll
        for (int bj = 0; bj < 2; ++bj)
#pragma unroll
            for (int n = 0; n < 2; ++n) bv[bj][n] = bias ? *(const f32x4*)(bias + bcol0 + bj * HALF + 4 * n) : (f32x4){0.f, 0.f, 0.f, 0.f};
#pragma unroll
        for (int ai = 0; ai < 2; ++ai)
#pragma unroll
            for (int m = 0; m < 4; ++m) { bf16_t* rowp = base + (size_t)(row0 + ai * HALF + m * 16) * ldc + col0;
#pragma unroll
                for (int bj = 0; bj < 2; ++bj) { f32x4 v0 = acc[ai][bj][m][0] + bv[bj][0], v1 = acc[ai][bj][m][1] + bv[bj][1];
                    if (ACT == 1) { f32x2 a = gelu_pk((f32x2){v0[0], v0[1]}), b = gelu_pk((f32x2){v0[2], v0[3]}), c = gelu_pk((f32x2){v1[0], v1[1]}), d = gelu_pk((f32x2){v1[2], v1[3]});
                        v0 = (f32x4){a.x, a.y, b.x, b.y}; v1 = (f32x4){c.x, c.y, d.x, d.y}; }
                    v0 = v0 * sc; v1 = v1 * sc; u32x4 w; w.x = cvt_pk_bf16(v0[0], v0[1]); w.y = cvt_pk_bf16(v0[2], v0[3]); w.z = cvt_pk_bf16(v1[0], v1[1]); w.w = cvt_pk_bf16(v1[2], v1[3]);
                    *(u32x4*)(rowp + bj * HALF) = w; } }
    }
};
template <class Epi, class Sched, bool ALIGN_EPI = false, bool SP2 = false>
__device__ __forceinline__ void gemm_phase(PG8_LAS unsigned char* lds, const Gemm g, const Sched& S, const Epi& E) {
    const int tid = threadIdx.x, wid = __builtin_amdgcn_readfirstlane(tid >> 6), lane = tid & 63, wr = wid >> 2, wc = wid & 3, fr = lane & 15, fq = lane >> 4;
    const int K = g.K, nt = K / BK;
    unsigned voffA[2], voffB[2];
#pragma unroll
    for (int i = 0; i < 2; ++i) { int R, C; stage_rc(tid * 16 + i * 8192, R, C); const int Rb = Epi::PERM ? ((R & ~31) + perm32(R & 31)) : R;
        voffA[i] = (unsigned)(R * K + C) * 2u; voffB[i] = (unsigned)(Rb * K + C) * 2u; }
    const size_t kstep = (size_t)(BK * 2);
    const size_t hstep = (size_t)HALF * K * 2;
    const size_t tstep = 2 * hstep;
    const unsigned ldsw = (unsigned)wid * 1024u;
    const int aoff = lds_byte(wr * 64 + fr, fq * 8), boff = lds_byte(wc * 32 + fr, fq * 8);
#define PG8_SA(b, h) (((b) * 2 + (h)) * HTB)
#define PG8_SB(b, h) ((4 + (b) * 2 + (h)) * HTB)
#define PG8_STAGE(bufoff, gbase, voff) do { _Pragma("unroll") for (int _i = 0; _i < 2; ++_i) \
        __builtin_amdgcn_global_load_lds((const unsigned*)((const char*)(gbase) + (voff)[_i]), (PG8_LAS unsigned*)(lds + (bufoff) + ldsw + _i * 8192), 16, 0, 0); } while (0)
#define PG8_LDA(dst, b, h) do { _Pragma("unroll") for (int m = 0; m < 4; ++m) _Pragma("unroll") for (int k = 0; k < 2; ++k) dst[m][k] = *(const PG8_LAS bf16x8*)(lds + PG8_SA(b, h) + aoff + m * 2048 + k * 1024); } while (0)
#define PG8_LDB(dst, b, h) do { _Pragma("unroll") for (int n = 0; n < 2; ++n) _Pragma("unroll") for (int k = 0; k < 2; ++k) dst[n][k] = *(const PG8_LAS bf16x8*)(lds + PG8_SB(b, h) + boff + n * 2048 + k * 1024); } while (0)
#define PG8_MMA(ai, bj, At, Bt) do { __builtin_amdgcn_s_setprio(1); _Pragma("unroll") for (int m = 0; m < 4; ++m) _Pragma("unroll") for (int n = 0; n < 2; ++n) _Pragma("unroll") for (int k = 0; k < 2; ++k) \
        acc[ai][bj][m][n] = __builtin_amdgcn_mfma_f32_16x16x32_bf16(Bt[n][k], At[m][k], acc[ai][bj][m][n], 0, 0, 0); __builtin_amdgcn_s_setprio(0); } while (0)
#define PG8_WAIT_V(n) asm volatile("s_waitcnt vmcnt(" #n ")" ::: "memory")
#define PG8_WAIT_L(n) asm volatile("s_waitcnt lgkmcnt(" #n ")" ::: "memory")
#define PG8_BAR __builtin_amdgcn_s_barrier()
#define PG8_SCHED __builtin_amdgcn_sched_barrier(0)
    Unit cur, nxt; int ui = 0;
    if (!S.next(0, cur)) return;
    f32x4 acc[2][2][4][2];
#pragma unroll
    for (int a = 0; a < 2; ++a)
#pragma unroll
        for (int b = 0; b < 2; ++b)
#pragma unroll
            for (int m = 0; m < 4; ++m)
#pragma unroll
                for (int n = 0; n < 2; ++n) acc[a][b][m][n] = (f32x4){0.f, 0.f, 0.f, 0.f};
    bf16x8 At[4][2], B0[2][2], B1[2][2];
    const char* cA = (const char*)g.A + (size_t)cur.pm * tstep; const char* cB = (const char*)g.Bt + (size_t)cur.pn * tstep;
    S.a_ready(cur);
    if constexpr (SP2) {
        PG8_STAGE(PG8_SB(0, 0), cB, voffB); PG8_STAGE(PG8_SB(0, 1), cB + hstep, voffB); PG8_STAGE(PG8_SA(0, 0), cA, voffA); PG8_STAGE(PG8_SA(0, 1), cA + hstep, voffA);
        if (wr == 1) PG8_BAR;
        PG8_WAIT_V(2); PG8_BAR;
        PG8_STAGE(PG8_SB(1, 0), cB + kstep, voffB); PG8_STAGE(PG8_SA(1, 0), cA + kstep, voffA); PG8_STAGE(PG8_SB(1, 1), cB + hstep + kstep, voffB);
        PG8_WAIT_V(6); PG8_BAR;
    } else {
        PG8_STAGE(PG8_SB(0, 0), cB, voffB); PG8_STAGE(PG8_SA(0, 0), cA, voffA); PG8_STAGE(PG8_SB(0, 1), cB + hstep, voffB); PG8_STAGE(PG8_SA(0, 1), cA + hstep, voffA);
        if (wr == 1) PG8_BAR;
        PG8_WAIT_V(4); PG8_BAR;
        PG8_STAGE(PG8_SB(1, 0), cB + kstep, voffB); PG8_STAGE(PG8_SA(1, 0), cA + kstep, voffA); PG8_STAGE(PG8_SB(1, 1), cB + hstep + kstep, voffB);
        PG8_WAIT_V(6); PG8_BAR;
    }
    for (;;) {
        const bool has_next = S.next(ui + 1, nxt);
        const char* nA = has_next ? (const char*)g.A + (size_t)nxt.pm * tstep : cA; const char* nB = has_next ? (const char*)g.Bt + (size_t)nxt.pn * tstep : cB;
        for (int t = 0; t < nt; t += 2) {
            const bool last = (t == nt - 2);
            const char* a1 = cA + (size_t)(t + 1) * kstep;
            const char* a2 = last ? nA : cA + (size_t)(t + 2) * kstep; const char* b2 = last ? nB : cB + (size_t)(t + 2) * kstep;
            const char* a3 = a2 + kstep; const char* b3 = b2 + kstep;
            if (last && has_next) S.a_ready(nxt);
            if constexpr (SP2) {
            PG8_LDB(B0, 0, 0); PG8_LDB(B1, 0, 1); PG8_SCHED; PG8_LDA(At, 0, 0); PG8_STAGE(PG8_SA(1, 1), a1 + hstep, voffA);
            PG8_WAIT_V(8); PG8_WAIT_L(0); PG8_BAR; PG8_MMA(0, 0, At, B0); PG8_MMA(0, 1, At, B1); PG8_BAR; PG8_SCHED;
            PG8_LDA(At, 0, 1); PG8_STAGE(PG8_SB(0, 0), b2, voffB); PG8_STAGE(PG8_SB(0, 1), b2 + hstep, voffB); PG8_STAGE(PG8_SA(0, 0), a2, voffA);
            PG8_WAIT_V(8); PG8_WAIT_L(0); PG8_BAR; PG8_MMA(1, 0, At, B0); PG8_MMA(1, 1, At, B1); PG8_BAR; PG8_SCHED;
            PG8_LDB(B0, 1, 0); PG8_LDB(B1, 1, 1); PG8_SCHED; PG8_LDA(At, 1, 0); PG8_STAGE(PG8_SA(0, 1), a2 + hstep, voffA);
            PG8_WAIT_V(8); PG8_WAIT_L(0); PG8_BAR; PG8_MMA(0, 0, At, B0); PG8_MMA(0, 1, At, B1); PG8_BAR; PG8_SCHED;
            PG8_LDA(At, 1, 1); PG8_STAGE(PG8_SB(1, 0), b3, voffB); PG8_STAGE(PG8_SB(1, 1), b3 + hstep, voffB); PG8_STAGE(PG8_SA(1, 0), a3, voffA);
            PG8_WAIT_V(8); PG8_WAIT_L(0); PG8_BAR; PG8_MMA(1, 0, At, B0); PG8_MMA(1, 1, At, B1); PG8_BAR; PG8_SCHED;
            } else {
            PG8_LDB(B0, 0, 0); PG8_SCHED; PG8_LDA(At, 0, 0); PG8_STAGE(PG8_SA(1, 1), a1 + hstep, voffA);
            PG8_WAIT_L(8); PG8_BAR; PG8_WAIT_L(0); PG8_MMA(0, 0, At, B0); PG8_BAR; PG8_SCHED;
            PG8_LDB(B1, 0, 1); PG8_STAGE(PG8_SB(0, 0), b2, voffB);
            PG8_BAR; PG8_WAIT_L(0); PG8_MMA(0, 1, At, B1); PG8_BAR;
            PG8_LDA(At, 0, 1); PG8_STAGE(PG8_SA(0, 0), a2, voffA);
            PG8_BAR; PG8_WAIT_L(0); PG8_MMA(1, 0, At, B0); PG8_BAR; PG8_SCHED;
            PG8_STAGE(PG8_SB(0, 1), b2 + hstep, voffB);
            PG8_WAIT_V(6); PG8_BAR; PG8_MMA(1, 1, At, B1); PG8_BAR;
            PG8_LDB(B0, 1, 0); PG8_SCHED; PG8_LDA(At, 1, 0); PG8_STAGE(PG8_SA(0, 1), a2 + hstep, voffA);
            PG8_WAIT_L(8); PG8_BAR; PG8_WAIT_L(0); PG8_MMA(0, 0, At, B0); PG8_BAR; PG8_SCHED;
            PG8_LDB(B1, 1, 1); PG8_STAGE(PG8_SB(1, 0), b3, voffB);
            PG8_BAR; PG8_WAIT_L(0); PG8_MMA(0, 1, At, B1); PG8_BAR;
            PG8_LDA(At, 1, 1); PG8_STAGE(PG8_SA(1, 0), a3, voffA);
            PG8_BAR; PG8_WAIT_L(0); PG8_MMA(1, 0, At, B0); PG8_BAR; PG8_SCHED;
            PG8_STAGE(PG8_SB(1, 1), b3 + hstep, voffB);
            PG8_WAIT_V(6); PG8_BAR; PG8_MMA(1, 1, At, B1); PG8_BAR;
            }
        }
        if constexpr (ALIGN_EPI) { if (wr == 0) PG8_BAR; }
        if constexpr (!Epi::AFTER_DRAIN) { E(acc, cur, wr, wc, fr, fq); S.done(cur); }
        if (!has_next) break;
#pragma unroll
        for (int a = 0; a < 2; ++a)
#pragma unroll
            for (int b = 0; b < 2; ++b)
#pragma unroll
                for (int m = 0; m < 4; ++m)
#pragma unroll
                    for (int n = 0; n < 2; ++n) acc[a][b][m][n] = (f32x4){0.f, 0.f, 0.f, 0.f};
        cur = nxt; cA = nA; cB = nB; ++ui;
        if constexpr (ALIGN_EPI) { if (wr == 1) PG8_BAR; }
    }
    PG8_WAIT_V(0);
    if constexpr (!ALIGN_EPI) { if (wr == 0) PG8_BAR; }
    PG8_BAR;
    if constexpr (Epi::AFTER_DRAIN) { E.fused(acc, cur, wr, wc, fr, fq, lds, wid, lane); S.done(cur); }
#undef PG8_SA
#undef PG8_SB
#undef PG8_STAGE
#undef PG8_LDA
#undef PG8_LDB
#undef PG8_MMA
#undef PG8_WAIT_V
#undef PG8_WAIT_L
#undef PG8_BAR
#undef PG8_SCHED
}
}

#ifndef PG8_SP2
#define PG8_SP2 true
#endif
#ifndef PG8_ALIGN
#define PG8_ALIGN true
#endif
#define GAS __attribute__((address_space(1)))
#define LAS __attribute__((address_space(3)))
typedef unsigned short bf16;
typedef unsigned v4u __attribute__((ext_vector_type(4)));
typedef float f32x4 __attribute__((ext_vector_type(4)));
typedef short bf16x8 __attribute__((ext_vector_type(8)));
typedef GAS unsigned gu32;
typedef GAS unsigned long long gu64;
#define RLX_AGENT __ATOMIC_RELAXED, __HIP_MEMORY_SCOPE_AGENT
#define LDS_WAIT() asm volatile("s_waitcnt lgkmcnt(0)" ::: "memory")
#define VM_WAIT() asm volatile("s_waitcnt vmcnt(0)" ::: "memory")
__device__ __forceinline__ unsigned long long rt() { return __builtin_amdgcn_s_memrealtime(); }
__device__ __forceinline__ unsigned f2bf(float f) { unsigned u = __builtin_bit_cast(unsigned, f); return (u + 0x7fffu + ((u >> 16) & 1u)) >> 16; }
__device__ __forceinline__ unsigned pk2(float lo, float hi) { return f2bf(lo) | (f2bf(hi) << 16); }

#define XB_TMO      128
#define XB_XCNT(j)  (256  + 64 * (j))
#define XB_XSUB(j)  (1280 + 64 * (j))
#define XB_XGEN(j)  (2304 + 64 * (j))
#define XB_TOP      3328
#define XB_TOPGEN   3392
#define XCD_BAR_WORDS 3456
#define XB_SPIN_CAP (1u << 18)

__device__ __forceinline__ unsigned xb_ld(unsigned* p)              { return __hip_atomic_load(p, __ATOMIC_RELAXED, __HIP_MEMORY_SCOPE_AGENT); }
__device__ __forceinline__ unsigned xb_add(unsigned* p, unsigned v) { return __hip_atomic_fetch_add(p, v, __ATOMIC_RELAXED, __HIP_MEMORY_SCOPE_AGENT); }
__device__ __forceinline__ unsigned xb_xcc_id() { return (unsigned)__builtin_amdgcn_s_getreg((3 << 11) | 20) & 0xFu; }
#define XB_SPIN(cond, bar) do { unsigned _sp = 0; while (cond) { __builtin_amdgcn_s_sleep(1); \
    if ((++_sp & 255u) == 0u) { if (xb_ld(&(bar)[XB_TMO])) break; if (_sp > XB_SPIN_CAP) { atomicAdd(&(bar)[XB_TMO], 1u); break; } } } } while (0)

struct XcdBarrier {
    unsigned* bar; unsigned x;
    volatile LAS unsigned* st;
};

__device__ __forceinline__ XcdBarrier xcd_barrier_post(unsigned* bar, volatile LAS unsigned* st) {
    XcdBarrier b; b.bar = bar; b.x = xb_xcc_id(); b.st = st;
    if (threadIdx.x == 0) (void)xb_add(&bar[XB_XCNT(b.x)], 1u);
    return b;
}
__device__ __forceinline__ void xcd_barrier_complete(unsigned* bar, unsigned x, unsigned& nloc, unsigned& nx) {
    const unsigned G = gridDim.x * gridDim.y * gridDim.z;
    unsigned sum, cnt, mine, sp = 0u;
    for (;;) {
        sum = 0u; cnt = 0u; mine = 0u;
#pragma unroll
        for (unsigned j = 0; j < 16; ++j) { const unsigned c = xb_ld(&bar[XB_XCNT(j)]); sum += c; cnt += (c > 0u) ? 1u : 0u; mine = (j == x) ? c : mine; }
        if (sum == G) break;
        __builtin_amdgcn_s_sleep(1);
        if ((++sp & 255u) == 0u) { if (xb_ld(&bar[XB_TMO])) break; if (sp > XB_SPIN_CAP) { atomicAdd(&bar[XB_TMO], 1u); break; } }
    }
    nloc = mine > 0u ? mine : 1u; nx = cnt > 0u ? cnt : 1u;
}

__device__ __forceinline__ void xcd_barrier(const XcdBarrier& b) {
    asm volatile("s_waitcnt vmcnt(0)" ::: "memory");
    __syncthreads();
    if (threadIdx.x == 0) {
        unsigned* bar = b.bar;
        __builtin_amdgcn_s_waitcnt(0);
        unsigned nloc = b.st[0], nx = b.st[1];
        if (nloc == 0u) { xcd_barrier_complete(bar, b.x, nloc, nx); b.st[0] = nloc; b.st[1] = nx; }
        const unsigned old = xb_add(&bar[XB_XSUB(b.x)], 1u);
        const unsigned gen = old / nloc;
        if (old + 1u == (gen + 1u) * nloc) {
            __builtin_amdgcn_fence(__ATOMIC_RELEASE, "agent");
            asm volatile("s_waitcnt vmcnt(0)" ::: "memory");
            const unsigned og = xb_add(&bar[XB_TOP], 1u);
            const unsigned tg = og / nx;
            if (og + 1u == (tg + 1u) * nx) xb_add(&bar[XB_TOPGEN], 1u);
            else XB_SPIN(xb_ld(&bar[XB_TOPGEN]) == tg, bar);
            __builtin_amdgcn_fence(__ATOMIC_ACQUIRE, "agent");
            xb_add(&bar[XB_XGEN(b.x)], 1u);
            asm volatile("s_waitcnt vmcnt(0)" ::: "memory");
        } else {
            XB_SPIN(xb_ld(&bar[XB_XGEN(b.x)]) == gen, bar);
            __builtin_amdgcn_fence(__ATOMIC_ACQUIRE, "agent");
            asm volatile("s_waitcnt vmcnt(0)" ::: "memory");
        }
    }
    __syncthreads();
}
constexpr int NWAVES = 8, NT = NWAVES * 64;
constexpr int BATCH = 4, SEQ = 4096, DM = 2048, CTXL = 256;
constexpr int MX = BATCH * SEQ, MC = BATCH * CTXL, MALL = MX + MC;
constexpr int WA = 1024, WB = 1024, NIN = 10256, NU = 10496;
constexpr int C_AQ = 0, C_AFF = 1024, C_AFB = 2048, C_AI = 3072, C_AZ = 4096, C_BQK = 5120, C_BV = 7168, C_BO = 8192, C_BZ = 9216, C_BG = 10240;
constexpr int HGH = 8, HGD = 128, MLH = 4, MLD = 256;
constexpr float ALPHA = 1.189207115002721f;
constexpr float LN_EPS = 1e-5f, NORM_EPS = 1e-6f;
constexpr int NMOD = 3 * DM, KSPLIT = 16;

#ifndef MK_N_LAUNCHES
#define MK_N_LAUNCHES 8
#endif
constexpr int N_PHASES = 8;

constexpr size_t MiB = 1u << 20;
constexpr size_t WS_CTL = 0, CTL_ZERO_BYTES = 1 * MiB;
constexpr size_t WS_MODP = 1 * MiB;
constexpr size_t WS_GATE = 3 * MiB;
constexpr size_t WS_WINT = 4 * MiB;
constexpr size_t WS_WOUTT = 45 * MiB;
constexpr size_t WS_XN = 53 * MiB;
constexpr size_t WS_U = 121 * MiB;
constexpr size_t WS_END = 470 * MiB;
static_assert(WS_WINT + (size_t)NU * DM * 2 <= WS_WOUTT && WS_WOUTT + (size_t)DM * DM * 2 <= WS_XN && WS_XN + (size_t)MALL * DM * 2 <= WS_U && WS_U + (size_t)MALL * NU * 2 <= WS_END, "d_ws map");
constexpr int CW_TMO = 0, CW_BAR = 4096;

constexpr int RING_OFF = 0, RING_BYTES = 131072;
constexpr int LDSCTL_OFF = RING_BYTES, MISC_OFF = LDSCTL_OFF + 320;
constexpr int LDS_BYTES = 147456;

struct Frame {
    LAS unsigned char* lds;
    volatile LAS unsigned* MISC;
    gu32* ctl;
    int tid, lane, wave, vcu, G;
    const float *x, *c, *ctx, *c_ctx, *w_mod, *b_mod, *w_in, *conv_w, *conv_b, *hg_lb, *ml_gate_b, *hg_norm_w, *ml_norm_w, *w_out, *ln_g, *ln_b;
    float* out;
    float *modp, *gate;
    bf16 *WinT, *WoutT, *XN, *U;
    bf16 *OAF, *OAB, *HBF, *HBB;
};

__device__ __forceinline__ float bf2f(unsigned short u) { return __builtin_bit_cast(float, (unsigned)u << 16); }
__device__ __forceinline__ float lo2f(unsigned u) { return __builtin_bit_cast(float, u << 16); }
__device__ __forceinline__ float hi2f(unsigned u) { return __builtin_bit_cast(float, u & 0xffff0000u); }
__device__ __forceinline__ float siluf(float v) { return v / (1.f + __expf(-v)); }
__device__ __forceinline__ float sigmf(float v) { return 1.f / (1.f + __expf(-v)); }
__device__ __forceinline__ float wave_sum(float v) {
#pragma unroll
    for (int o = 1; o < 64; o <<= 1) v += __shfl_xor(v, o);
    return v;
}

__device__ __forceinline__ void transpose_item(const float* W, int ldw, int nvalid, int K, bf16* WT, LAS float* scr, int kb, int nb, int lane) {
    const int k0 = 64 * kb, n0 = 32 * nb; const int n_l = n0 + (lane & 31);
#pragma unroll 8
    for (int i = 0; i < 32; ++i) { const int kk = 2 * i + (lane >> 5); scr[kk * 33 + (lane & 31)] = n_l < nvalid ? W[(size_t)(k0 + kk) * ldw + n_l] : 0.f; }
    LDS_WAIT(); asm volatile("" ::: "memory");
    const int c = lane & 7;
#pragma unroll
    for (int j = 0; j < 4; ++j) { const int n = (lane >> 3) + 8 * j; const LAS float* s = scr + (8 * c) * 33 + n;
        v4u o; o.x = pk2(s[0 * 33], s[1 * 33]); o.y = pk2(s[2 * 33], s[3 * 33]); o.z = pk2(s[4 * 33], s[5 * 33]); o.w = pk2(s[6 * 33], s[7 * 33]);
        *(GAS v4u*)(WT + (size_t)(n0 + n) * K + k0 + 8 * c) = o; }
    LDS_WAIT(); asm volatile("" ::: "memory");
}
__device__ __forceinline__ void p0_prep(Frame& F) {
    LAS float* scr = (LAS float*)(F.lds + RING_OFF + F.wave * 16384);
    const int gw = F.vcu * NWAVES + F.wave, NGW = F.G * NWAVES;
    constexpr int NB_IN = NU / 32, I_IN = (DM / 64) * NB_IN, NB_OUT = DM / 32, I_OUT = (DM / 64) * NB_OUT, I_MOD = (NMOD / 64) * KSPLIT;
    for (int it = gw; it < I_IN + I_OUT + I_MOD; it += NGW) {
        int r = it;
        if (r < I_IN) { transpose_item(F.w_in, NIN, NIN, DM, F.WinT, scr, r / NB_IN, r % NB_IN, F.lane); continue; } r -= I_IN;
        if (r < I_OUT) { transpose_item(F.w_out, DM, DM, DM, F.WoutT, scr, r / NB_OUT, r % NB_OUT, F.lane); continue; } r -= I_OUT;
        const int cg = r / KSPLIT, ks = r % KSPLIT, n = cg * 64 + F.lane, k0 = ks * (DM / KSPLIT);
#pragma unroll
        for (int rr = 0; rr < 5; ++rr)
#pragma unroll
            for (int j = 0; j < 2; ++j) { const int k = k0 + F.lane + 64 * j; const float v = rr < 4 ? F.c[rr * DM + k] : F.c_ctx[k]; scr[rr * 128 + F.lane + 64 * j] = siluf(v); }
        LDS_WAIT(); asm volatile("" ::: "memory");
        float a0 = 0.f, a1 = 0.f, a2 = 0.f, a3 = 0.f, a4 = 0.f;
#pragma unroll 8
        for (int k = 0; k < DM / KSPLIT; ++k) { const float w = F.w_mod[(size_t)(k0 + k) * NMOD + n];
            a0 += scr[k] * w; a1 += scr[128 + k] * w; a2 += scr[256 + k] * w; a3 += scr[384 + k] * w; a4 += scr[512 + k] * w; }
        const float bm = ks == 0 ? F.b_mod[n] : 0.f;
        float* o = F.modp + (size_t)ks * 5 * NMOD + n;
        o[0] = a0 + bm; o[NMOD] = a1 + bm; o[2 * NMOD] = a2 + bm; o[3 * NMOD] = a3 + bm; o[4 * NMOD] = a4 + bm;
        LDS_WAIT(); asm volatile("" ::: "memory");
    }
}

__device__ __forceinline__ void ln_mod_row(Frame& F, const float* xrow, bf16* orow, const LAS float* shift, const LAS float* scale) {
    const GAS f32x4* xr = (const GAS f32x4*)xrow + F.lane;
    f32x4 v[8]; float s = 0.f;
#pragma unroll
    for (int j = 0; j < 8; ++j) { v[j] = xr[64 * j]; s += (v[j].x + v[j].y) + (v[j].z + v[j].w); }
    const float mean = wave_sum(s) * (1.f / DM); float s2 = 0.f;
#pragma unroll
    for (int j = 0; j < 8; ++j) { v[j] = v[j] - mean; s2 += (v[j].x * v[j].x + v[j].y * v[j].y) + (v[j].z * v[j].z + v[j].w * v[j].w); }
    const float rstd = 1.f / sqrtf(wave_sum(s2) * (1.f / DM) + LN_EPS);
    GAS unsigned long long* o8 = (GAS unsigned long long*)orow + F.lane;
#pragma unroll
    for (int j = 0; j < 8; ++j) { const int k = 4 * F.lane + 256 * j; const f32x4 sc = *(const LAS f32x4*)(scale + k), sh = *(const LAS f32x4*)(shift + k);
        const f32x4 h = v[j] * rstd * (sc + 1.f) + sh;
        o8[64 * j] = (unsigned long long)pk2(h.x, h.y) | ((unsigned long long)pk2(h.z, h.w) << 32); }
}
__device__ __forceinline__ void p1_lnmod(Frame& F) {
    LAS float* md = (LAS float*)(F.lds + RING_OFF);
    for (int e = F.vcu * NT + F.tid; e < BATCH * DM; e += F.G * NT) { const int b = e / DM, n = e % DM; float s = 0.f;
#pragma unroll
        for (int ks = 0; ks < KSPLIT; ++ks) s += F.modp[((size_t)ks * 5 + b) * NMOD + 2 * DM + n];
        F.gate[e] = s; }
    for (int blk = F.vcu; blk < 256; blk += F.G) {
        const int b = blk >> 6;
        __syncthreads();
        for (int e = F.tid; e < 4 * DM; e += NT) { const int row = e < 2 * DM ? b : 4, col = e & (2 * DM - 1); float s = 0.f;
#pragma unroll
            for (int ks = 0; ks < KSPLIT; ++ks) s += F.modp[((size_t)ks * 5 + row) * NMOD + col];
            md[e] = s; }
        __syncthreads();
#pragma unroll 1
        for (int r = 0; r < 8; ++r) { const int m = blk * 64 + F.wave * 8 + r; ln_mod_row(F, F.x + (size_t)m * DM, F.XN + (size_t)m * DM, md, md + DM); }
        if (F.wave < 4) { const int m = blk * 4 + F.wave; ln_mod_row(F, F.ctx + (size_t)m * DM, F.XN + (size_t)(MX + m) * DM, md + 2 * DM, md + 3 * DM); }
    }
}

__device__ __forceinline__ void p3_conv(Frame& F) {
    bf16* QKM = F.XN;
    for (int it = F.vcu * NT + F.tid; it < MALL * 256; it += F.G * NT) {
        const int row = it >> 8, cg = it & 255, ch = cg * 8;
        float acc[8];
#pragma unroll
        for (int j = 0; j < 8; ++j) acc[j] = F.conv_b[ch + j];
        if (row < MX) {
            const int b = row >> 12, t = row & 4095, r = t >> 6, cc = t & 63;
#pragma unroll
            for (int dr = 0; dr < 3; ++dr)
#pragma unroll
                for (int dc = 0; dc < 3; ++dc) { const int rr = r + dr - 1, c2 = cc + dc - 1;
                    if (rr >= 0 && rr < 64 && c2 >= 0 && c2 < 64) {
                        const v4u u = *(const GAS v4u*)(F.U + (size_t)(b * SEQ + rr * 64 + c2) * NU + C_BQK + ch);
                        const float* w = F.conv_w + (dr * 3 + dc) * 2048 + ch;
                        acc[0] += lo2f(u.x) * w[0]; acc[1] += hi2f(u.x) * w[1]; acc[2] += lo2f(u.y) * w[2]; acc[3] += hi2f(u.y) * w[3];
                        acc[4] += lo2f(u.z) * w[4]; acc[5] += hi2f(u.z) * w[5]; acc[6] += lo2f(u.w) * w[6]; acc[7] += hi2f(u.w) * w[7]; } }
        } else {
            const int rc = row - MX, t = rc & 255;
#pragma unroll
            for (int d = 0; d < 3; ++d) { const int tt = t + d - 1;
                if (tt >= 0 && tt < CTXL) {
                    const v4u u = *(const GAS v4u*)(F.U + (size_t)(row + d - 1) * NU + C_BQK + ch);
                    const float* w = F.conv_w + (3 + d) * 2048 + ch;
                    acc[0] += lo2f(u.x) * w[0]; acc[1] += hi2f(u.x) * w[1]; acc[2] += lo2f(u.y) * w[2]; acc[3] += hi2f(u.y) * w[3];
                    acc[4] += lo2f(u.z) * w[4]; acc[5] += hi2f(u.z) * w[5]; acc[6] += lo2f(u.w) * w[6]; acc[7] += hi2f(u.w) * w[7]; } }
        }
        const float sc = ch >= 1024 ? 0.0625f : 1.f;
#pragma unroll
        for (int j = 0; j < 8; ++j) acc[j] = siluf(acc[j]) * sc;
        v4u o; o.x = pk2(acc[0], acc[1]); o.y = pk2(acc[2], acc[3]); o.z = pk2(acc[4], acc[5]); o.w = pk2(acc[6], acc[7]);
        *(GAS v4u*)(QKM + (size_t)row * DM + ch) = o;
    }
}

__device__ __forceinline__ int scan_row(int b, int dirn, int nb, int i) {
    if (nb < 16) { const int p = nb * 16 + i; const int t = dirn ? (CTXL - 1 - p) : p; return MX + b * CTXL + t; }
    const int p = (nb - 16) * 16 + i; const int t = dirn ? (SEQ - 1 - p) : p; return b * SEQ + t;
}
__device__ __forceinline__ void p4_hgrn2_task(Frame& F, int task) {
    const int vs = task & 3, dirn = (task >> 2) & 1, h = (task >> 3) & 7, b = task >> 6;
    LAS float* Fg = (LAS float*)(F.lds);
    LAS float* Kg = Fg + 2048, *Qg = Kg + 2048;
    LAS float* Vg = Qg + 2048;
    LAS float* LB = Vg + 512;
    LAS float* P = LB + 128;
    const int v = F.tid & 31, kg = F.tid >> 5, k0 = kg * 8;
    const int zcol = (dirn ? C_AFB : C_AFF) + h * HGD;
    __syncthreads();
    if (F.tid < 128) { const int col = h * HGD + F.tid; LB[F.tid] = sigmf(F.hg_lb[(dirn * 2 + 0) * WA + col] - F.hg_lb[(dirn * 2 + 1) * WA + col]); }
    __syncthreads();
    float S[8];
#pragma unroll
    for (int j = 0; j < 8; ++j) S[j] = 0.f;
    bf16* O = dirn ? F.OAB : F.OAF;
#pragma unroll 1
    for (int nb = 0; nb < 16 + 256; ++nb) {
        const bool lat = nb >= 16;
#pragma unroll
        for (int j = 0; j < 4; ++j) { const int e = F.tid + NT * j, i = e >> 7, k = e & 127; const int row = scan_row(b, dirn, nb, i);
            const float z = bf2f(F.U[(size_t)row * NU + zcol + k]); const float lb = LB[k]; const float f = lb + (1.f - lb) * sigmf(z);
            Fg[e] = f; Kg[e] = 1.f - f; Qg[e] = lat ? siluf(bf2f(F.U[(size_t)row * NU + C_AQ + h * HGD + k])) : 0.f; }
        { const int i = F.tid >> 5; const int row = scan_row(b, dirn, nb, i); Vg[F.tid] = bf2f(F.U[(size_t)row * NU + C_AI + h * HGD + vs * 32 + v]); }
        __syncthreads();
#pragma unroll 2
        for (int i = 0; i < 16; ++i) { const float vv = Vg[i * 32 + v]; float a = 0.f;
#pragma unroll
            for (int j = 0; j < 8; ++j) { S[j] = Fg[i * 128 + k0 + j] * S[j] + Kg[i * 128 + k0 + j] * vv; a += S[j] * Qg[i * 128 + k0 + j]; }
            P[(kg * 16 + i) * 32 + v] = a; }
        __syncthreads();
        if (lat) { const int i = F.tid >> 5; float o = 0.f;
#pragma unroll
            for (int g = 0; g < 16; ++g) o += P[(g * 16 + i) * 32 + v];
            const int row = scan_row(b, dirn, nb, i);
            O[(size_t)row * WA + h * HGD + vs * 32 + v] = (bf16)f2bf(o); }
    }
}
__device__ __forceinline__ void p4_mlstm_task(Frame& F, int task) {
    const int vs = task & 7, dirn = (task >> 3) & 1, h = (task >> 4) & 3, b = task >> 6;
    const bf16* QKM = F.XN;
    LAS float* Kb = (LAS float*)(F.lds);
    LAS float* Qb = Kb + 4096;
    LAS float* Vb = Qb + 4096;
    LAS float* LI = Vb + 512, *LF = LI + 16, *EM = LF + 16;
    LAS float* PD = EM + 16;
    LAS float* P = PD + 256;
    const int v = F.tid & 31, kg = F.tid >> 5, k0 = kg * 16;
    float C[16], nn[16]; float m = 0.f;
#pragma unroll
    for (int j = 0; j < 16; ++j) { C[j] = 0.f; nn[j] = 0.f; }
    bf16* O = dirn ? F.HBB : F.HBF;
    const float gbi = F.ml_gate_b[dirn * 4 + h], gbf = F.ml_gate_b[(2 + dirn) * 4 + h];
#pragma unroll 1
    for (int nb = 0; nb < 16 + 256; ++nb) {
        const bool lat = nb >= 16;
        __syncthreads();
#pragma unroll
        for (int j = 0; j < 8; ++j) { const int e = F.tid + NT * j, i = e >> 8, k = e & 255; const int row = scan_row(b, dirn, nb, i);
            Kb[e] = bf2f(QKM[(size_t)row * DM + 1024 + h * MLD + k]); Qb[e] = lat ? bf2f(QKM[(size_t)row * DM + h * MLD + k]) : 0.f; }
        { const int i = F.tid >> 5; const int row = scan_row(b, dirn, nb, i); Vb[F.tid] = bf2f(F.U[(size_t)row * NU + C_BV + h * MLD + vs * 32 + v]); }
        if (F.tid < 16) { const int row = scan_row(b, dirn, nb, F.tid);
            const float gi = bf2f(F.U[(size_t)row * NU + C_BG + dirn * 4 + h]) + gbi, gf = bf2f(F.U[(size_t)row * NU + C_BG + (2 + dirn) * 4 + h]) + gbf;
            LI[F.tid] = gi; LF[F.tid] = gf > 0.f ? -log1pf(__expf(-gf)) : gf - log1pf(__expf(gf)); }
        __syncthreads();
#pragma unroll 2
        for (int i = 0; i < 16; ++i) {
            const float lf = LF[i], li = LI[i]; const float mn = fmaxf(lf + m, li); const float fd = __expf(lf + m - mn), iw = __expf(li - mn); m = mn;
            if (F.tid == 0) EM[i] = __expf(-m);
            const float vv = iw * Vb[i * 32 + v]; float a = 0.f, d = 0.f;
#pragma unroll
            for (int j = 0; j < 16; ++j) { const float kk = Kb[i * 256 + k0 + j], qq = Qb[i * 256 + k0 + j];
                C[j] = fd * C[j] + vv * kk; nn[j] = fd * nn[j] + iw * kk; a += C[j] * qq; d += nn[j] * qq; }
            P[(kg * 16 + i) * 32 + v] = a; if (v == 0) PD[kg * 16 + i] = d; }
        __syncthreads();
        if (lat) { const int i = F.tid >> 5; float num = 0.f, den = 0.f;
#pragma unroll
            for (int g = 0; g < 16; ++g) { num += P[(g * 16 + i) * 32 + v]; den += PD[g * 16 + i]; }
            const int row = scan_row(b, dirn, nb, i);
            O[(size_t)row * WB + h * MLD + vs * 32 + v] = (bf16)f2bf(num / fmaxf(fabsf(den), EM[i])); }
    }
}
__device__ __forceinline__ void p4_scan_naive(Frame& F) {
    for (int task = F.vcu; task < 512; task += F.G) { if (task < 256) p4_hgrn2_task(F, task); else p4_mlstm_task(F, task - 256); }
}

__device__ __forceinline__ void p5_combine(Frame& F) {
    bf16* Y = F.XN;
    const int gw = F.vcu * NWAVES + F.wave, NGW = F.G * NWAVES;
    for (int row = gw; row < MX; row += NGW) {
        const int ch = F.lane * 16;
        {
            float o[16];
            const v4u a0 = *(const GAS v4u*)(F.OAF + (size_t)row * WA + ch), a1 = *(const GAS v4u*)(F.OAF + (size_t)row * WA + ch + 8);
            const v4u b0 = *(const GAS v4u*)(F.OAB + (size_t)row * WA + ch), b1 = *(const GAS v4u*)(F.OAB + (size_t)row * WA + ch + 8);
            const unsigned ua[8] = {a0.x, a0.y, a0.z, a0.w, a1.x, a1.y, a1.z, a1.w}, ub[8] = {b0.x, b0.y, b0.z, b0.w, b1.x, b1.y, b1.z, b1.w};
            float ss = 0.f;
#pragma unroll
            for (int j = 0; j < 8; ++j) { o[2 * j] = lo2f(ua[j]) + lo2f(ub[j]); o[2 * j + 1] = hi2f(ua[j]) + hi2f(ub[j]); ss += o[2 * j] * o[2 * j] + o[2 * j + 1] * o[2 * j + 1]; }
            ss += __shfl_xor(ss, 1); ss += __shfl_xor(ss, 2); ss += __shfl_xor(ss, 4);
            const float r = 1.f / sqrtf(ss * (1.f / HGD) + NORM_EPS);
            const v4u z0 = *(const GAS v4u*)(F.U + (size_t)row * NU + C_AZ + ch), z1 = *(const GAS v4u*)(F.U + (size_t)row * NU + C_AZ + ch + 8);
            const unsigned uz[8] = {z0.x, z0.y, z0.z, z0.w, z1.x, z1.y, z1.z, z1.w};
            unsigned w[8];
#pragma unroll
            for (int j = 0; j < 8; ++j) { const float y0 = o[2 * j] * r * F.hg_norm_w[ch + 2 * j] * siluf(lo2f(uz[j])), y1 = o[2 * j + 1] * r * F.hg_norm_w[ch + 2 * j + 1] * siluf(hi2f(uz[j])); w[j] = pk2(y0, y1); }
            *(GAS v4u*)(Y + (size_t)row * DM + ch) = (v4u){w[0], w[1], w[2], w[3]}; *(GAS v4u*)(Y + (size_t)row * DM + ch + 8) = (v4u){w[4], w[5], w[6], w[7]};
        }
        {
            float o[16];
            const v4u a0 = *(const GAS v4u*)(F.HBF + (size_t)row * WB + ch), a1 = *(const GAS v4u*)(F.HBF + (size_t)row * WB + ch + 8);
            const v4u b0 = *(const GAS v4u*)(F.HBB + (size_t)row * WB + ch), b1 = *(const GAS v4u*)(F.HBB + (size_t)row * WB + ch + 8);
            const unsigned ua[8] = {a0.x, a0.y, a0.z, a0.w, a1.x, a1.y, a1.z, a1.w}, ub[8] = {b0.x, b0.y, b0.z, b0.w, b1.x, b1.y, b1.z, b1.w};
            float s = 0.f;
#pragma unroll
            for (int j = 0; j < 8; ++j) { o[2 * j] = lo2f(ua[j]) + lo2f(ub[j]); o[2 * j + 1] = hi2f(ua[j]) + hi2f(ub[j]); s += o[2 * j] + o[2 * j + 1]; }
            s += __shfl_xor(s, 1); s += __shfl_xor(s, 2); s += __shfl_xor(s, 4); s += __shfl_xor(s, 8);
            const float mu = s * (1.f / MLD); float q = 0.f;
#pragma unroll
            for (int j = 0; j < 16; ++j) { o[j] -= mu; q += o[j] * o[j]; }
            q += __shfl_xor(q, 1); q += __shfl_xor(q, 2); q += __shfl_xor(q, 4); q += __shfl_xor(q, 8);
            const float r = 1.f / sqrtf(q * (1.f / MLD) + NORM_EPS);
            const v4u g0 = *(const GAS v4u*)(F.U + (size_t)row * NU + C_BO + ch), g1 = *(const GAS v4u*)(F.U + (size_t)row * NU + C_BO + ch + 8);
            const v4u z0 = *(const GAS v4u*)(F.U + (size_t)row * NU + C_BZ + ch), z1 = *(const GAS v4u*)(F.U + (size_t)row * NU + C_BZ + ch + 8);
            const unsigned ug[8] = {g0.x, g0.y, g0.z, g0.w, g1.x, g1.y, g1.z, g1.w}, uz[8] = {z0.x, z0.y, z0.z, z0.w, z1.x, z1.y, z1.z, z1.w};
            unsigned w[8];
#pragma unroll
            for (int j = 0; j < 8; ++j) { const float y0 = o[2 * j] * r * F.ml_norm_w[ch + 2 * j] * sigmf(lo2f(ug[j])) * siluf(lo2f(uz[j])), y1 = o[2 * j + 1] * r * F.ml_norm_w[ch + 2 * j + 1] * sigmf(hi2f(ug[j])) * siluf(hi2f(uz[j])); w[j] = pk2(y0, y1); }
            *(GAS v4u*)(Y + (size_t)row * DM + WA + ch) = (v4u){w[0], w[1], w[2], w[3]}; *(GAS v4u*)(Y + (size_t)row * DM + WA + ch + 8) = (v4u){w[4], w[5], w[6], w[7]};
        }
    }
}

struct EpiResid {
    static constexpr bool PERM = false, AFTER_DRAIN = false;
    const float* x; const float* gate; float* out;
    __device__ __forceinline__ void operator()(const pg8::f32x4 (&acc)[2][2][4][2], const pg8::Unit& u, int wr, int wc, int fr, int fq) const {
        using pg8::BM; using pg8::HALF;
        const int row0 = u.pm * BM + wr * 64 + fr, col0 = u.pn * BM + wc * 32 + 4 * fq; const int b = (u.pm * BM) / SEQ;
        pg8::f32x4 gv[2][2];
#pragma unroll
        for (int bj = 0; bj < 2; ++bj)
#pragma unroll
            for (int n = 0; n < 2; ++n) gv[bj][n] = *(const pg8::f32x4*)(gate + b * DM + col0 + bj * HALF + n * 16);
#pragma unroll
        for (int ai = 0; ai < 2; ++ai)
#pragma unroll
            for (int m = 0; m < 4; ++m) { const size_t off = (size_t)(row0 + ai * HALF + m * 16) * DM + col0;
#pragma unroll
                for (int bj = 0; bj < 2; ++bj)
#pragma unroll
                    for (int n = 0; n < 2; ++n) { const pg8::f32x4 xv = *(const pg8::f32x4*)(x + off + bj * HALF + n * 16);
                        *(pg8::f32x4*)(out + off + bj * HALF + n * 16) = xv * ALPHA + gv[bj][n] * acc[ai][bj][m][n]; } }
    }
};

__device__ __forceinline__ void p7_ln(Frame& F) {
    const int gw = F.vcu * NWAVES + F.wave, NGW = F.G * NWAVES;
    for (int row = gw; row < MX; row += NGW) {
        GAS f32x4* xr = (GAS f32x4*)(F.out + (size_t)row * DM) + F.lane;
        f32x4 v[8]; float s = 0.f;
#pragma unroll
        for (int j = 0; j < 8; ++j) { v[j] = xr[64 * j]; s += (v[j].x + v[j].y) + (v[j].z + v[j].w); }
        const float mean = wave_sum(s) * (1.f / DM); float s2 = 0.f;
#pragma unroll
        for (int j = 0; j < 8; ++j) { v[j] = v[j] - mean; s2 += (v[j].x * v[j].x + v[j].y * v[j].y) + (v[j].z * v[j].z + v[j].w * v[j].w); }
        const float rstd = 1.f / sqrtf(wave_sum(s2) * (1.f / DM) + LN_EPS);
#pragma unroll
        for (int j = 0; j < 8; ++j) { const int k = 4 * F.lane + 256 * j; const f32x4 g = *(const f32x4*)(F.ln_g + k), bb = *(const f32x4*)(F.ln_b + k);
            xr[64 * j] = v[j] * rstd * g + bb; }
    }
}

struct Args { const float* in[16]; float* out; unsigned char* ws; int ph_lo, ph_hi, li, pad; };
__global__ void __launch_bounds__(NWAVES * 64, 2) mk_fwd(Args args) {
    extern __shared__ __attribute__((aligned(16))) unsigned char lds[];
    Frame F;
    F.lds = (LAS unsigned char*)lds;
    F.MISC = (volatile LAS unsigned*)(F.lds + MISC_OFF);
    F.tid = threadIdx.x; F.lane = F.tid & 63; F.wave = __builtin_amdgcn_readfirstlane(F.tid >> 6);
    F.G = gridDim.x; { const int bx = blockIdx.x; F.vcu = (F.G % 8 == 0) ? (bx % 8) * (F.G / 8) + bx / 8 : bx; }
    unsigned char* ws = args.ws;
    F.ctl = (gu32*)(ws + WS_CTL);
    F.x = args.in[0]; F.c = args.in[1]; F.ctx = args.in[2]; F.c_ctx = args.in[3]; F.w_mod = args.in[4]; F.b_mod = args.in[5]; F.w_in = args.in[6];
    F.conv_w = args.in[7]; F.conv_b = args.in[8]; F.hg_lb = args.in[9]; F.ml_gate_b = args.in[10]; F.hg_norm_w = args.in[11]; F.ml_norm_w = args.in[12];
    F.w_out = args.in[13]; F.ln_g = args.in[14]; F.ln_b = args.in[15]; F.out = args.out;
    F.modp = (float*)(ws + WS_MODP); F.gate = (float*)(ws + WS_GATE);
    F.WinT = (bf16*)(ws + WS_WINT); F.WoutT = (bf16*)(ws + WS_WOUTT); F.XN = (bf16*)(ws + WS_XN); F.U = (bf16*)(ws + WS_U);
    F.OAF = (bf16*)args.out; F.OAB = F.OAF + (size_t)MX * WA; F.HBF = F.OAB + (size_t)MX * WA; F.HBB = F.HBF + (size_t)MX * WB;
    for (int u = F.tid; u < (LDS_BYTES - LDSCTL_OFF) / 4; u += NT) ((LAS unsigned*)(F.lds + LDSCTL_OFF))[u] = 0u;
    __syncthreads();
    XcdBarrier bar; bar.bar = (unsigned*)(F.ctl + CW_BAR); bar.x = 0; bar.st = nullptr;
    if (MK_N_LAUNCHES == 1) bar = xcd_barrier_post((unsigned*)(F.ctl + CW_BAR), F.MISC + 8);
    const int lo = args.ph_lo, hi = args.ph_hi;
#ifndef PH_MASK
#define PH_MASK 255
#endif
#define PHON(k) ((PH_MASK >> (k)) & 1)
#define IN(k) (lo <= (k) && (k) < hi)
#define SEAM(k) do { if (IN(k) && IN((k) + 1)) xcd_barrier(bar); } while (0)
    if (PHON(0) && IN(0)) { p0_prep(F); } SEAM(0);
    if (PHON(1) && IN(1)) { p1_lnmod(F); } SEAM(1);
    if (PHON(2) && IN(2)) { pg8::Gemm g{F.XN, F.WinT, MALL, NU, DM}; pg8::StaticOrder S; S.init(MALL, NU, F.G, (int)blockIdx.x);
        pg8::EpiBf16<0> E{F.U, NU, nullptr, 0, 0, 1.f};
        pg8::gemm_phase<pg8::EpiBf16<0>, pg8::StaticOrder, PG8_ALIGN, PG8_SP2>(F.lds + RING_OFF, g, S, E); } SEAM(2);
    if (PHON(3) && IN(3)) { p3_conv(F); } SEAM(3);
    if (PHON(4) && IN(4)) { p4_scan_naive(F); } SEAM(4);
    if (PHON(5) && IN(5)) { p5_combine(F); } SEAM(5);
    if (PHON(6) && IN(6)) { pg8::Gemm g{F.XN, F.WoutT, MX, DM, DM}; pg8::StaticOrder S; S.init(MX, DM, F.G, (int)blockIdx.x);
        EpiResid E{F.x, F.gate, F.out};
        pg8::gemm_phase<EpiResid, pg8::StaticOrder, PG8_ALIGN, PG8_SP2>(F.lds + RING_OFF, g, S, E); } SEAM(6);
    if (PHON(7) && IN(7)) { p7_ln(F); }
#undef IN
#undef SEAM
}

extern "C" void kernel_launch(void* const* d_in, const int* in_sizes, int n_in, void* d_out, int out_size, void* d_ws, size_t ws_size, hipStream_t stream) {
    static int grid = 0;
    if (grid == 0) {
        if (n_in != 16 || out_size != MX * DM || ws_size < WS_END) { fprintf(stderr, "kernel_launch: unexpected shapes (n_in %d out %d ws %zu)\n", n_in, out_size, ws_size); grid = -1; return; }
        int dev = 0, cus = 0, per_cu = 0;
        if (hipGetDevice(&dev) != hipSuccess || hipDeviceGetAttribute(&cus, hipDeviceAttributeMultiprocessorCount, dev) != hipSuccess) { grid = -1; return; }
        if (hipFuncSetAttribute((const void*)mk_fwd, hipFuncAttributeMaxDynamicSharedMemorySize, LDS_BYTES) != hipSuccess) { fprintf(stderr, "kernel_launch: hipFuncSetAttribute failed\n"); grid = -1; return; }
        if (hipOccupancyMaxActiveBlocksPerMultiprocessor(&per_cu, (const void*)mk_fwd, NT, LDS_BYTES) != hipSuccess || per_cu < 1) { fprintf(stderr, "kernel_launch: occupancy query says %d\n", per_cu); per_cu = 1; }
        (void)hipGetLastError();
        grid = cus;
    }
    if (grid < 0) return;
    if (hipMemsetAsync((char*)d_ws + WS_CTL, 0, CTL_ZERO_BYTES, stream) != hipSuccess) { fprintf(stderr, "kernel_launch: memset failed\n"); return; }
    Args a{};
    for (int i = 0; i < 16; ++i) a.in[i] = (const float*)d_in[i];
    a.out = (float*)d_out; a.ws = (unsigned char*)d_ws;
    for (int li = 0; li < MK_N_LAUNCHES; ++li) {
        a.ph_lo = (MK_N_LAUNCHES == 1) ? 0 : li; a.ph_hi = (MK_N_LAUNCHES == 1) ? N_PHASES : li + 1; a.li = li;
        hipLaunchKernelGGL(mk_fwd, dim3(grid), dim3(NT), LDS_BYTES, stream, a);
        const hipError_t le = hipPeekAtLastError();
        if (le != hipSuccess) { fprintf(stderr, "kernel_launch: launch %d failed: %s\n", li, hipGetErrorName(le)); break; }
    }
}
```

```cpp
#define DUP_MASK 0
#include <hip/hip_runtime.h>
#include <cstdio>
#include <cstdint>
namespace pg8 {
#define PG8_LAS __attribute__((address_space(3)))
typedef unsigned short bf16_t;
typedef short bf16x8 __attribute__((ext_vector_type(8)));
typedef float f32x4 __attribute__((ext_vector_type(4)));
typedef unsigned u32x4 __attribute__((ext_vector_type(4)));
constexpr int BM = 256, BK = 64, HALF = 128, HTB = HALF * BK * 2  , STAGE_BYTES = 8 * HTB, NXCD = 8, WGM = 4;

__host__ __device__ __forceinline__ int lds_byte(int r, int c) { const int st = (r >> 4) * 2 + (c >> 5), rr = r & 15, cc = c & 31, ob = rr * 64 + cc * 2; return st * 1024 + (ob ^ (((ob >> 9) & 1) << 5)); }
__host__ __device__ __forceinline__ void stage_rc(int b, int& R, int& C) { const int st = b / 1024, sb = b % 1024, swz = sb ^ (((sb >> 9) & 1) << 5); R = (st >> 1) * 16 + swz / 64; C = (st & 1) * 32 + (swz % 64) / 2; }
__host__ __device__ __forceinline__ int perm32(int rho) { const int n = rho >> 4, i = rho & 15; return 8 * (i >> 2) + 4 * n + (i & 3); }

struct Unit { int pm, pn; };
struct Gemm { const bf16_t* A; const bf16_t* Bt; int M, N, K; };

struct StaticOrder {
    int nM, nN, nwg, G, c;
    __host__ __device__ void init(int M, int N, int G_, int c_) { nM = M / BM; nN = N / BM; nwg = nM * nN; G = G_; c = c_; }
    __host__ __device__ bool next(int i, Unit& u) const {
        const long L = (long)i * G + c; if (L >= nwg) return false;
        int wgid = (int)L; { const int q = nwg / NXCD, r = nwg % NXCD, xcd = wgid % NXCD, off = wgid / NXCD; wgid = (xcd < r ? xcd * (q + 1) : r * (q + 1) + (xcd - r) * q) + off; }
        const int nig = WGM * nN, gid = wgid / nig, fm = gid * WGM, gsz = (nM - fm) < WGM ? (nM - fm) : WGM;
        u.pm = fm + ((wgid % nig) % gsz); u.pn = (wgid % nig) / gsz; return true;
    }
    __device__ __forceinline__ void a_ready(const Unit&) const {}
    __device__ __forceinline__ void done(const Unit&) const {}
};

__device__ __forceinline__ unsigned cvt_pk_bf16(float lo, float hi) { unsigned r; asm volatile("v_cvt_pk_bf16_f32 %0, %1, %2" : "=v"(r) : "v"(lo), "v"(hi)); return r; }
typedef float f32x2 __attribute__((ext_vector_type(2)));
__device__ __forceinline__ f32x2 gelu_pk(f32x2 v) {
    const f32x2 av = __builtin_elementwise_abs(v), d = av * 0.2316418882f + 1.0f;
    f32x2 t; t.x = __builtin_amdgcn_rcpf(d.x); t.y = __builtin_amdgcn_rcpf(d.y);
    f32x2 q = t * 0.5307027145f + (-0.7265760135f); q = q * t + 0.7107068705f; q = q * t + (-0.142248368f); q = q * t + 0.127414796f; q = q * t;
    const f32x2 s = (v * v) * (-0.72134752044f);
    f32x2 e; e.x = __builtin_amdgcn_exp2f(s.x); e.y = __builtin_amdgcn_exp2f(s.y);
    const f32x2 m = v * (q * e), r = v - m;
    f32x2 o; o.x = v.x < 0.f ? m.x : r.x; o.y = v.y < 0.f ? m.y : r.y; return o;
}

template <int ACT  > struct EpiBf16 {
    static constexpr bool PERM = true, AFTER_DRAIN = false; static_assert(ACT == 0 || ACT == 1, "EpiBf16: ACT is 0 (none) or 1 (gelu_pk)");
    bf16_t* O; int ldc; const float* bias; int split_cols; size_t split_stride; float scale0;
    __device__ __forceinline__ void operator()(const f32x4 (&acc)[2][2][4][2], const Unit& u, int wr, int wc, int fr, int fq) const {
        const int row0 = u.pm * BM + wr * 64 + fr; int colt = u.pn * BM; bf16_t* base = O;
        float sc = 1.f; if (split_cols) { const int t = colt / split_cols; base += (size_t)t * split_stride; colt -= t * split_cols; if (t == 0) sc = scale0; }
        const int col0 = colt + wc * 32 + 8 * fq, bcol0 = u.pn * BM + wc * 32 + 8 * fq;
        f32x4 bv[2][2];
#pragma unroll
        for (int bj = 0; bj < 2; ++bj)
#pragma unroll
            for (int n = 0; n < 2; ++n) bv[bj][n] = bias ? *(const f32x4*)(bias + bcol0 + bj * HALF + 4 * n) : (f32x4){0.f, 0.f, 0.f, 0.f};
#pragma unroll
        for (int ai = 0; ai < 2; ++ai)
#pragma unroll
            for (int m = 0; m < 4; ++m) { bf16_t* rowp = base + (size_t)(row0 + ai * HALF + m * 16) * ldc + col0;
#pragma unroll
                for (int bj = 0; bj < 2; ++bj) { f32x4 v0 = acc[ai][bj][m][0] + bv[bj][0], v1 = acc[ai][bj][m][1] + bv[bj][1];
                    if (ACT == 1) { f32x2 a = gelu_pk((f32x2){v0[0], v0[1]}), b = gelu_pk((f32x2){v0[2], v0[3]}), c = gelu_pk((f32x2){v1[0], v1[1]}), d = gelu_pk((f32x2){v1[2], v1[3]});
                        v0 = (f32x4){a.x, a.y, b.x, b.y}; v1 = (f32x4){c.x, c.y, d.x, d.y}; }
                    v0 = v0 * sc; v1 = v1 * sc; u32x4 w; w.x = cvt_pk_bf16(v0[0], v0[1]); w.y = cvt_pk_bf16(v0[2], v0[3]); w.z = cvt_pk_bf16(v1[0], v1[1]); w.w = cvt_pk_bf16(v1[2], v1[3]);
                    *(u32x4*)(rowp + bj * HALF) = w; } }
    }
};
template <class Epi, class Sched, bool ALIGN_EPI = false, bool SP2 = false>
__device__ __forceinline__ void gemm_phase(PG8_LAS unsigned char* lds, const Gemm g, const Sched& S, const Epi& E) {
    const int tid = threadIdx.x, wid = __builtin_amdgcn_readfirstlane(tid >> 6), lane = tid & 63, wr = wid >> 2, wc = wid & 3, fr = lane & 15, fq = lane >> 4;
    const int K = g.K, nt = K / BK;
    unsigned voffA[2], voffB[2];
#pragma unroll
    for (int i = 0; i < 2; ++i) { int R, C; stage_rc(tid * 16 + i * 8192, R, C); const int Rb = Epi::PERM ? ((R & ~31) + perm32(R & 31)) : R;
        voffA[i] = (unsigned)(R * K + C) * 2u; voffB[i] = (unsigned)(Rb * K + C) * 2u; }
    const size_t kstep = (size_t)(BK * 2);
    const size_t hstep = (size_t)HALF * K * 2;
    const size_t tstep = 2 * hstep;
    const unsigned ldsw = (unsigned)wid * 1024u;
    const int aoff = lds_byte(wr * 64 + fr, fq * 8), boff = lds_byte(wc * 32 + fr, fq * 8);
#define PG8_SA(b, h) (((b) * 2 + (h)) * HTB)
#define PG8_SB(b, h) ((4 + (b) * 2 + (h)) * HTB)
#define PG8_STAGE(bufoff, gbase, voff) do { _Pragma("unroll") for (int _i = 0; _i < 2; ++_i) \
        __builtin_amdgcn_global_load_lds((const unsigned*)((const char*)(gbase) + (voff)[_i]), (PG8_LAS unsigned*)(lds + (bufoff) + ldsw + _i * 8192), 16, 0, 0); } while (0)
#define PG8_LDA(dst, b, h) do { _Pragma("unroll") for (int m = 0; m < 4; ++m) _Pragma("unroll") for (int k = 0; k < 2; ++k) dst[m][k] = *(const PG8_LAS bf16x8*)(lds + PG8_SA(b, h) + aoff + m * 2048 + k * 1024); } while (0)
#define PG8_LDB(dst, b, h) do { _Pragma("unroll") for (int n = 0; n < 2; ++n) _Pragma("unroll") for (int k = 0; k < 2; ++k) dst[n][k] = *(const PG8_LAS bf16x8*)(lds + PG8_SB(b, h) + boff + n * 2048 + k * 1024); } while (0)
#define PG8_MMA(ai, bj, At, Bt) do { __builtin_amdgcn_s_setprio(1); _Pragma("unroll") for (int m = 0; m < 4; ++m) _Pragma("unroll") for (int n = 0; n < 2; ++n) _Pragma("unroll") for (int k = 0; k < 2; ++k) \
        acc[ai][bj][m][n] = __builtin_amdgcn_mfma_f32_16x16x32_bf16(Bt[n][k], At[m][k], acc[ai][bj][m][n], 0, 0, 0); __builtin_amdgcn_s_setprio(0); } while (0)
#define PG8_WAIT_V(n) asm volatile("s_waitcnt vmcnt(" #n ")" ::: "memory")
#define PG8_WAIT_L(n) asm volatile("s_waitcnt lgkmcnt(" #n ")" ::: "memory")
#define PG8_BAR __builtin_amdgcn_s_barrier()
#define PG8_SCHED __builtin_amdgcn_sched_barrier(0)
    Unit cur, nxt; int ui = 0;
    if (!S.next(0, cur)) return;
    f32x4 acc[2][2][4][2];
#pragma unroll
    for (int a = 0; a < 2; ++a)
#pragma unroll
        for (int b = 0; b < 2; ++b)
#pragma unroll
            for (int m = 0; m < 4; ++m)
#pragma unroll
                for (int n = 0; n < 2; ++n) acc[a][b][m][n] = (f32x4){0.f, 0.f, 0.f, 0.f};
    bf16x8 At[4][2], B0[2][2], B1[2][2];
    const char* cA = (const char*)g.A + (size_t)cur.pm * tstep; const char* cB = (const char*)g.Bt + (size_t)cur.pn * tstep;
    S.a_ready(cur);
    if constexpr (SP2) {
        PG8_STAGE(PG8_SB(0, 0), cB, voffB); PG8_STAGE(PG8_SB(0, 1), cB + hstep, voffB); PG8_STAGE(PG8_SA(0, 0), cA, voffA); PG8_STAGE(PG8_SA(0, 1), cA + hstep, voffA);
        if (wr == 1) PG8_BAR;
        PG8_WAIT_V(2); PG8_BAR;
        PG8_STAGE(PG8_SB(1, 0), cB + kstep, voffB); PG8_STAGE(PG8_SA(1, 0), cA + kstep, voffA); PG8_STAGE(PG8_SB(1, 1), cB + hstep + kstep, voffB);
        PG8_WAIT_V(6); PG8_BAR;
    } else {
        PG8_STAGE(PG8_SB(0, 0), cB, voffB); PG8_STAGE(PG8_SA(0, 0), cA, voffA); PG8_STAGE(PG8_SB(0, 1), cB + hstep, voffB); PG8_STAGE(PG8_SA(0, 1), cA + hstep, voffA);
        if (wr == 1) PG8_BAR;
        PG8_WAIT_V(4); PG8_BAR;
        PG8_STAGE(PG8_SB(1, 0), cB + kstep, voffB); PG8_STAGE(PG8_SA(1, 0), cA + kstep, voffA); PG8_STAGE(PG8_SB(1, 1), cB + hstep + kstep, voffB);
        PG8_WAIT_V(6); PG8_BAR;
    }
    for (;;) {
        const bool has_next = S.next(ui + 1, nxt);
        const char* nA = has_next ? (const char*)g.A + (size_t)nxt.pm * tstep : cA; const char* nB = has_next ? (const char*)g.Bt + (size_t)nxt.pn * tstep : cB;
        for (int t = 0; t < nt; t += 2) {
            const bool last = (t == nt - 2);
            const char* a1 = cA + (size_t)(t + 1) * kstep;
            const char* a2 = last ? nA : cA + (size_t)(t + 2) * kstep; const char* b2 = last ? nB : cB + (size_t)(t + 2) * kstep;
            const char* a3 = a2 + kstep; const char* b3 = b2 + kstep;
            if (last && has_next) S.a_ready(nxt);
            if constexpr (SP2) {
            PG8_LDB(B0, 0, 0); PG8_LDB(B1, 0, 1); PG8_SCHED; PG8_LDA(At, 0, 0); PG8_STAGE(PG8_SA(1, 1), a1 + hstep, voffA);
            PG8_WAIT_V(8); PG8_WAIT_L(0); PG8_BAR; PG8_MMA(0, 0, At, B0); PG8_MMA(0, 1, At, B1); PG8_BAR; PG8_SCHED;
            PG8_LDA(At, 0, 1); PG8_STAGE(PG8_SB(0, 0), b2, voffB); PG8_STAGE(PG8_SB(0, 1), b2 + hstep, voffB); PG8_STAGE(PG8_SA(0, 0), a2, voffA);
            PG8_WAIT_V(8); PG8_WAIT_L(0); PG8_BAR; PG8_MMA(1, 0, At, B0); PG8_MMA(1, 1, At, B1); PG8_BAR; PG8_SCHED;
            PG8_LDB(B0, 1, 0); PG8_LDB(B1, 1, 1); PG8_SCHED; PG8_LDA(At, 1, 0); PG8_STAGE(PG8_SA(0, 1), a2 + hstep, voffA);
            PG8_WAIT_V(8); PG8_WAIT_L(0); PG8_BAR; PG8_MMA(0, 0, At, B0); PG8_MMA(0, 1, At, B1); PG8_BAR; PG8_SCHED;
            PG8_LDA(At, 1, 1); PG8_STAGE(PG8_SB(1, 0), b3, voffB); PG8_STAGE(PG8_SB(1, 1), b3 + hstep, voffB); PG8_STAGE(PG8_SA(1, 0), a3, voffA);
            PG8_WAIT_V(8); PG8_WAIT_L(0); PG8_BAR; PG8_MMA(1, 0, At, B0); PG8_MMA(1, 1, At, B1); PG8_BAR; PG8_SCHED;
            } else {
            PG8_LDB(B0, 0, 0); PG8_SCHED; PG8_LDA(At, 0, 0); PG8_STAGE(PG8_SA(1, 1), a1 + hstep, voffA);
            PG8_WAIT_L(8); PG8_BAR; PG8_WAIT_L(0); PG8_MMA(0, 0, At, B0); PG8_BAR; PG8_SCHED;
            PG8_LDB(B1, 0, 1); PG8_STAGE(PG8_SB(0, 0), b2, voffB);
            PG8_BAR; PG8_WAIT_L(0); PG8_MMA(0, 1, At, B1); PG8_BAR;
            PG8_LDA(At, 0, 1); PG8_STAGE(PG8_SA(0, 0), a2, voffA);
            PG8_BAR; PG8_WAIT_L(0); PG8_MMA(1, 0, At, B0); PG8_BAR; PG8_SCHED;
            PG8_STAGE(PG8_SB(0, 1), b2 + hstep, voffB);
            PG8_WAIT_V(6); PG8_BAR; PG8_MMA(1, 1, At, B1); PG8_BAR;
            PG8_LDB(B0, 1, 0); PG8_SCHED; PG8_LDA(At, 1, 0); PG8_STAGE(PG8_SA(0, 1), a2 + hstep, voffA);
            PG8_WAIT_L(8); PG8_BAR; PG8_WAIT_L(0); PG8_MMA(0, 0, At, B0); PG8_BAR; PG8_SCHED;
            PG8_LDB(B1, 1, 1); PG8_STAGE(PG8_SB(1, 0), b3, voffB);
            PG8_BAR; PG8_WAIT_L(0); PG8_MMA(0, 1, At, B1); PG8_BAR;
            PG8_LDA(At, 1, 1); PG8_STAGE(PG8_SA(1, 0), a3, voffA);
            PG8_BAR; PG8_WAIT_L(0); PG8_MMA(1, 0, At, B0); PG8_BAR; PG8_SCHED;
            PG8_STAGE(PG8_SB(1, 1), b3 + hstep, voffB);
            PG8_WAIT_V(6); PG8_BAR; PG8_MMA(1, 1, At, B1); PG8_BAR;
            }
        }
        if constexpr (ALIGN_EPI) { if (wr == 0) PG8_BAR; }
        if constexpr (!Epi::AFTER_DRAIN) { E(acc, cur, wr, wc, fr, fq); S.done(cur); }
        else { if (has_next) { E(acc, cur, wr, wc, fr, fq); S.done(cur); } }
        if (!has_next) break;
#pragma unroll
        for (int a = 0; a < 2; ++a)
#pragma unroll
            for (int b = 0; b < 2; ++b)
#pragma unroll
                for (int m = 0; m < 4; ++m)
#pragma unroll
                    for (int n = 0; n < 2; ++n) acc[a][b][m][n] = (f32x4){0.f, 0.f, 0.f, 0.f};
        cur = nxt; cA = nA; cB = nB; ++ui;
        if constexpr (ALIGN_EPI) { if (wr == 1) PG8_BAR; }
    }
    PG8_WAIT_V(0);
    if constexpr (!ALIGN_EPI) { if (wr == 0) PG8_BAR; }
    PG8_BAR;
    if constexpr (Epi::AFTER_DRAIN) { E.fused(acc, cur, wr, wc, fr, fq, lds, wid, lane); S.done(cur); }
#undef PG8_SA
#undef PG8_SB
#undef PG8_STAGE
#undef PG8_LDA
#undef PG8_LDB
#undef PG8_MMA
#undef PG8_WAIT_V
#undef PG8_WAIT_L
#undef PG8_BAR
#undef PG8_SCHED
}
}

#ifndef PG8_SP2
#define PG8_SP2 true
#endif
#ifndef PG8_ALIGN
#define PG8_ALIGN true
#endif
#define GAS __attribute__((address_space(1)))
#define LAS __attribute__((address_space(3)))
typedef unsigned short bf16;
typedef unsigned v4u __attribute__((ext_vector_type(4)));
typedef float f32x4 __attribute__((ext_vector_type(4)));
typedef short bf16x8 __attribute__((ext_vector_type(8)));
typedef GAS unsigned gu32;
typedef GAS unsigned long long gu64;
#define RLX_AGENT __ATOMIC_RELAXED, __HIP_MEMORY_SCOPE_AGENT
#define LDS_WAIT() asm volatile("s_waitcnt lgkmcnt(0)" ::: "memory")
#define VM_WAIT() asm volatile("s_waitcnt vmcnt(0)" ::: "memory")
__device__ __forceinline__ unsigned long long rt() { return __builtin_amdgcn_s_memrealtime(); }
__device__ __forceinline__ unsigned f2bf(float f) { unsigned u = __builtin_bit_cast(unsigned, f); return (u + 0x7fffu + ((u >> 16) & 1u)) >> 16; }
__device__ __forceinline__ unsigned pk2(float lo, float hi) { return f2bf(lo) | (f2bf(hi) << 16); }

#define XB_TMO      128
#define XB_XCNT(j)  (256  + 64 * (j))
#define XB_XSUB(j)  (1280 + 64 * (j))
#define XB_XGEN(j)  (2304 + 64 * (j))
#define XB_TOP      3328
#define XB_TOPGEN   3392
#define XCD_BAR_WORDS 3456
#define XB_SPIN_CAP (1u << 18)

__device__ __forceinline__ unsigned xb_ld(unsigned* p)              { return __hip_atomic_load(p, __ATOMIC_RELAXED, __HIP_MEMORY_SCOPE_AGENT); }
__device__ __forceinline__ unsigned xb_add(unsigned* p, unsigned v) { return __hip_atomic_fetch_add(p, v, __ATOMIC_RELAXED, __HIP_MEMORY_SCOPE_AGENT); }
__device__ __forceinline__ unsigned xb_xcc_id() { return (unsigned)__builtin_amdgcn_s_getreg((3 << 11) | 20) & 0xFu; }
#define XB_SPIN(cond, bar) do { unsigned _sp = 0; while (cond) { __builtin_amdgcn_s_sleep(1); \
    if ((++_sp & 255u) == 0u) { if (xb_ld(&(bar)[XB_TMO])) break; if (_sp > XB_SPIN_CAP) { atomicAdd(&(bar)[XB_TMO], 1u); break; } } } } while (0)

struct XcdBarrier {
    unsigned* bar; unsigned x;
    volatile LAS unsigned* st;
};

__device__ __forceinline__ XcdBarrier xcd_barrier_post(unsigned* bar, volatile LAS unsigned* st) {
    XcdBarrier b; b.bar = bar; b.x = xb_xcc_id(); b.st = st;
    if (threadIdx.x == 0) (void)xb_add(&bar[XB_XCNT(b.x)], 1u);
    return b;
}
__device__ __forceinline__ void xcd_barrier_complete(unsigned* bar, unsigned x, unsigned& nloc, unsigned& nx) {
    const unsigned G = gridDim.x * gridDim.y * gridDim.z;
    unsigned sum, cnt, mine, sp = 0u;
    for (;;) {
        sum = 0u; cnt = 0u; mine = 0u;
#pragma unroll
        for (unsigned j = 0; j < 16; ++j) { const unsigned c = xb_ld(&bar[XB_XCNT(j)]); sum += c; cnt += (c > 0u) ? 1u : 0u; mine = (j == x) ? c : mine; }
        if (sum == G) break;
        __builtin_amdgcn_s_sleep(1);
        if ((++sp & 255u) == 0u) { if (xb_ld(&bar[XB_TMO])) break; if (sp > XB_SPIN_CAP) { atomicAdd(&bar[XB_TMO], 1u); break; } }
    }
    nloc = mine > 0u ? mine : 1u; nx = cnt > 0u ? cnt : 1u;
}

__device__ __forceinline__ void xcd_barrier(const XcdBarrier& b) {
    asm volatile("s_waitcnt vmcnt(0)" ::: "memory");
    __syncthreads();
    if (threadIdx.x == 0) {
        unsigned* bar = b.bar;
        __builtin_amdgcn_s_waitcnt(0);
        unsigned nloc = b.st[0], nx = b.st[1];
        if (nloc == 0u) { xcd_barrier_complete(bar, b.x, nloc, nx); b.st[0] = nloc; b.st[1] = nx; }
        const unsigned old = xb_add(&bar[XB_XSUB(b.x)], 1u);
        const unsigned gen = old / nloc;
        if (old + 1u == (gen + 1u) * nloc) {
            __builtin_amdgcn_fence(__ATOMIC_RELEASE, "agent");
            asm volatile("s_waitcnt vmcnt(0)" ::: "memory");
            const unsigned og = xb_add(&bar[XB_TOP], 1u);
            const unsigned tg = og / nx;
            if (og + 1u == (tg + 1u) * nx) xb_add(&bar[XB_TOPGEN], 1u);
            else XB_SPIN(xb_ld(&bar[XB_TOPGEN]) == tg, bar);
            __builtin_amdgcn_fence(__ATOMIC_ACQUIRE, "agent");
            xb_add(&bar[XB_XGEN(b.x)], 1u);
            asm volatile("s_waitcnt vmcnt(0)" ::: "memory");
        } else {
            XB_SPIN(xb_ld(&bar[XB_XGEN(b.x)]) == gen, bar);
            __builtin_amdgcn_fence(__ATOMIC_ACQUIRE, "agent");
            asm volatile("s_waitcnt vmcnt(0)" ::: "memory");
        }
    }
    __syncthreads();
}
constexpr int NWAVES = 8, NT = NWAVES * 64;
constexpr int BATCH = 4, SEQ = 4096, DM = 2048, CTXL = 256;
constexpr int MX = BATCH * SEQ, MC = BATCH * CTXL, MALL = MX + MC;
constexpr int WA = 1024, WB = 1024, NIN = 10256, NU = 10496;
constexpr int C_AQ = 0, C_AFF = 1024, C_AFB = 2048, C_AI = 3072, C_AZ = 4096, C_BQK = 5120, C_BV = 7168, C_BO = 8192, C_BZ = 9216, C_BG = 10240;
constexpr int HGH = 8, HGD = 128, MLH = 4, MLD = 256;
constexpr float ALPHA = 1.189207115002721f;
constexpr float LN_EPS = 1e-5f, NORM_EPS = 1e-6f;
constexpr int NMOD = 3 * DM;

#ifndef MK_N_LAUNCHES
#define MK_N_LAUNCHES 1
#endif
constexpr int N_PHASES = 8;

constexpr size_t MiB = 1u << 20;
constexpr size_t WS_CTL = 0, CTL_ZERO_BYTES = 1 * MiB;
constexpr size_t WS_MODP = 1 * MiB;
constexpr size_t WS_GATE = 3 * MiB;
constexpr size_t WS_WINT = 4 * MiB;
constexpr size_t WS_WOUTT = 45 * MiB;
constexpr size_t WS_XN = 53 * MiB;
constexpr size_t WS_U = 121 * MiB;
constexpr size_t WS_PE = 470 * MiB, WS_MLS = 473 * MiB, WS_DEC = 478 * MiB;
constexpr size_t WS_MLW = 479 * MiB;
constexpr size_t WS_DQP = 496 * MiB;
constexpr size_t WS_XB = 498 * MiB;
constexpr size_t WS_END = 502 * MiB;
static_assert(WS_WINT + (size_t)NU * DM * 2 <= WS_WOUTT && WS_WOUTT + (size_t)DM * DM * 2 <= WS_XN && WS_XN + (size_t)MALL * DM * 2 <= WS_U && WS_U + (size_t)MALL * NU * 2 <= WS_END, "d_ws map");
constexpr int CW_TMO = 0, CW_BAR = 4096, CW_PANEL = 16384;

constexpr int RING_OFF = 0, RING_BYTES = 131072;
constexpr int LDS_BYTES = 163840;
constexpr int LDSCTL_OFF = LDS_BYTES - 1024, MISC_OFF = LDSCTL_OFF + 320;

struct Frame {
    LAS unsigned char* lds;
    volatile LAS unsigned* MISC;
    gu32* ctl;
    int tid, lane, wave, vcu, G;
    const float *x, *c, *ctx, *c_ctx, *w_mod, *b_mod, *w_in, *conv_w, *conv_b, *hg_lb, *ml_gate_b, *hg_norm_w, *ml_norm_w, *w_out, *ln_g, *ln_b;
    float* out;
    float *modp, *gate;
    bf16 *WinT, *WoutT, *XN, *U;
    bf16 *QTF, *MLW; float *PE, *MLS, *DEC, *DQP;
    bf16 *OAF, *OAB, *HBF, *HBB;
};

typedef float f32x2_t __attribute__((ext_vector_type(2)));
typedef __bf16 bf16x2_t __attribute__((ext_vector_type(2)));
__device__ __forceinline__ unsigned pkbf(float a, float b) { const f32x2_t v = {a, b}; return __builtin_bit_cast(unsigned, __builtin_convertvector(v, bf16x2_t)); }
__device__ __forceinline__ float bf2f(unsigned short u) { return __builtin_bit_cast(float, (unsigned)u << 16); }
__device__ __forceinline__ float lo2f(unsigned u) { return __builtin_bit_cast(float, u << 16); }
__device__ __forceinline__ float hi2f(unsigned u) { return __builtin_bit_cast(float, u & 0xffff0000u); }
__device__ __forceinline__ float siluf(float v) { return v / (1.f + __expf(-v)); }
__device__ __forceinline__ float sigmf(float v) { return 1.f / (1.f + __expf(-v)); }
__device__ __forceinline__ float wave_sum(float v) {
#pragma unroll
    for (int o = 1; o < 64; o <<= 1) v += __shfl_xor(v, o);
    return v;
}

__device__ __forceinline__ void transpose_item(const float* W, int ldw, int nvalid, int K, bf16* WT, LAS float* scr, int kb, int nb, int lane) {
    const int k0 = 64 * kb, n0 = 32 * nb; const int n_l = n0 + (lane & 31);
#pragma unroll 8
    for (int i = 0; i < 32; ++i) { const int kk = 2 * i + (lane >> 5); scr[kk * 33 + (lane & 31)] = n_l < nvalid ? W[(size_t)(k0 + kk) * ldw + n_l] : 0.f; }
    LDS_WAIT(); asm volatile("" ::: "memory");
    const int c = lane & 7;
#pragma unroll
    for (int j = 0; j < 4; ++j) { const int n = (lane >> 3) + 8 * j; const LAS float* s = scr + (8 * c) * 33 + n;
        v4u o; o.x = pk2(s[0 * 33], s[1 * 33]); o.y = pk2(s[2 * 33], s[3 * 33]); o.z = pk2(s[4 * 33], s[5 * 33]); o.w = pk2(s[6 * 33], s[7 * 33]);
        *(GAS v4u*)(WT + (size_t)(n0 + n) * K + k0 + 8 * c) = o; }
    LDS_WAIT(); asm volatile("" ::: "memory");
}
constexpr int KS2 = 2;
__device__ __forceinline__ void p0_prep(Frame& F) {
    LAS float* scr = (LAS float*)(F.lds + RING_OFF + F.wave * 16384);
    LAS float* red = (LAS float*)(F.lds + RING_OFF + 131072);
    for (int it = F.vcu; it < (NMOD / 64) * KS2; it += F.G) {
        const int cg = it >> 1, kh2 = it & 1, n = cg * 64 + F.lane, k0 = kh2 * 1024 + F.wave * 128;
#pragma unroll
        for (int rr = 0; rr < 5; ++rr)
#pragma unroll
            for (int j = 0; j < 2; ++j) { const int k = k0 + F.lane + 64 * j; const float v = rr < 4 ? F.c[rr * DM + k] : F.c_ctx[k]; scr[rr * 128 + F.lane + 64 * j] = siluf(v); }
        LDS_WAIT(); asm volatile("" ::: "memory");
        float a0 = 0.f, a1 = 0.f, a2 = 0.f, a3 = 0.f, a4 = 0.f;
#pragma unroll 16
        for (int k = 0; k < 128; ++k) { const float w = F.w_mod[(size_t)(k0 + k) * NMOD + n];
            a0 += scr[k] * w; a1 += scr[128 + k] * w; a2 += scr[256 + k] * w; a3 += scr[384 + k] * w; a4 += scr[512 + k] * w; }
        LAS float* rp = red + F.wave * 320 + F.lane; rp[0] = a0; rp[64] = a1; rp[128] = a2; rp[192] = a3; rp[256] = a4;
        __syncthreads();
        if (F.tid < 320) { float sacc = 0.f;
#pragma unroll
            for (int ww = 0; ww < 8; ++ww) sacc += red[ww * 320 + F.tid];
            const int rr = F.tid >> 6, nn = cg * 64 + (F.tid & 63);
            F.modp[((size_t)kh2 * 5 + rr) * NMOD + nn] = sacc + (kh2 == 0 ? F.b_mod[nn] : 0.f); }
        __syncthreads();
    }
    const int gw = F.vcu * NWAVES + F.wave, NGW = F.G * NWAVES;
    constexpr int NB_IN = NU / 32, I_IN = (DM / 64) * NB_IN, NB_OUT = DM / 32, I_OUT = (DM / 64) * NB_OUT;
    for (int it = gw; it < I_IN + I_OUT; it += NGW) {
        int r = it;
        if (r < I_IN) { transpose_item(F.w_in, NIN, NIN, DM, F.WinT, scr, r / NB_IN, r % NB_IN, F.lane); continue; } r -= I_IN;
        transpose_item(F.w_out, DM, DM, DM, F.WoutT, scr, r / NB_OUT, r % NB_OUT, F.lane);
    }
}

__device__ __forceinline__ void ln_mod_row2(Frame& F, const float* xa, const float* xb, bf16* oa, bf16* ob, const LAS float* shift, const LAS float* scale) {
    const GAS f32x4* ra = (const GAS f32x4*)xa + F.lane; const GAS f32x4* rb = (const GAS f32x4*)xb + F.lane;
    f32x4 va[8], vb[8]; float sa = 0.f, sb = 0.f;
#pragma unroll
    for (int j = 0; j < 8; ++j) { va[j] = ra[64 * j]; vb[j] = rb[64 * j]; }
#pragma unroll
    for (int j = 0; j < 8; ++j) { sa += (va[j].x + va[j].y) + (va[j].z + va[j].w); sb += (vb[j].x + vb[j].y) + (vb[j].z + vb[j].w); }
    const float ma = wave_sum(sa) * (1.f / DM), mb = wave_sum(sb) * (1.f / DM); float qa = 0.f, qb = 0.f;
#pragma unroll
    for (int j = 0; j < 8; ++j) { va[j] = va[j] - ma; vb[j] = vb[j] - mb; qa += (va[j].x * va[j].x + va[j].y * va[j].y) + (va[j].z * va[j].z + va[j].w * va[j].w); qb += (vb[j].x * vb[j].x + vb[j].y * vb[j].y) + (vb[j].z * vb[j].z + vb[j].w * vb[j].w); }
    const float rsa = 1.f / sqrtf(wave_sum(qa) * (1.f / DM) + LN_EPS), rsb = 1.f / sqrtf(wave_sum(qb) * (1.f / DM) + LN_EPS);
    GAS unsigned long long* o8a = (GAS unsigned long long*)oa + F.lane; GAS unsigned long long* o8b = (GAS unsigned long long*)ob + F.lane;
#pragma unroll
    for (int j = 0; j < 8; ++j) { const int k = 4 * F.lane + 256 * j; const f32x4 sc = *(const LAS f32x4*)(scale + k) + 1.f, sh = *(const LAS f32x4*)(shift + k);
        const f32x4 ha = va[j] * rsa * sc + sh, hb = vb[j] * rsb * sc + sh;
        o8a[64 * j] = (unsigned long long)pk2(ha.x, ha.y) | ((unsigned long long)pk2(ha.z, ha.w) << 32);
        o8b[64 * j] = (unsigned long long)pk2(hb.x, hb.y) | ((unsigned long long)pk2(hb.z, hb.w) << 32); }
}
__device__ __forceinline__ void ln_mod_row(Frame& F, const float* xrow, bf16* orow, const LAS float* shift, const LAS float* scale) {
    const GAS f32x4* xr = (const GAS f32x4*)xrow + F.lane;
    f32x4 v[8]; float s = 0.f;
#pragma unroll
    for (int j = 0; j < 8; ++j) { v[j] = xr[64 * j]; s += (v[j].x + v[j].y) + (v[j].z + v[j].w); }
    const float mean = wave_sum(s) * (1.f / DM); float s2 = 0.f;
#pragma unroll
    for (int j = 0; j < 8; ++j) { v[j] = v[j] - mean; s2 += (v[j].x * v[j].x + v[j].y * v[j].y) + (v[j].z * v[j].z + v[j].w * v[j].w); }
    const float rstd = 1.f / sqrtf(wave_sum(s2) * (1.f / DM) + LN_EPS);
    GAS unsigned long long* o8 = (GAS unsigned long long*)orow + F.lane;
#pragma unroll
    for (int j = 0; j < 8; ++j) { const int k = 4 * F.lane + 256 * j; const f32x4 sc = *(const LAS f32x4*)(scale + k), sh = *(const LAS f32x4*)(shift + k);
        const f32x4 h = v[j] * rstd * (sc + 1.f) + sh;
        o8[64 * j] = (unsigned long long)pk2(h.x, h.y) | ((unsigned long long)pk2(h.z, h.w) << 32); }
}
__device__ __forceinline__ void p1_lnmod(Frame& F) {
    LAS float* md = (LAS float*)(F.lds + RING_OFF);
    for (int e = F.vcu * NT + F.tid; e < BATCH * DM; e += F.G * NT) { const int b = e / DM, n = e % DM;
        F.gate[e] = F.modp[(size_t)b * NMOD + 2 * DM + n] + F.modp[((size_t)5 + b) * NMOD + 2 * DM + n]; }
    for (int blk = F.vcu; blk < 256; blk += F.G) {
        const int b = blk >> 6;
        __syncthreads();
        for (int e = F.tid; e < 4 * DM; e += NT) { const int row = e < 2 * DM ? b : 4, col = e & (2 * DM - 1);
            md[e] = F.modp[(size_t)row * NMOD + col] + F.modp[((size_t)5 + row) * NMOD + col]; }
        __syncthreads();
#pragma unroll 1
        for (int r = 0; r < 8; r += 2) { const int m = blk * 64 + F.wave * 8 + r;
            ln_mod_row2(F, F.x + (size_t)m * DM, F.x + (size_t)(m + 1) * DM, F.XN + (size_t)m * DM, F.XN + (size_t)(m + 1) * DM, md, md + DM); }
        if (F.wave < 4) { const int m = blk * 4 + F.wave; ln_mod_row(F, F.ctx + (size_t)m * DM, F.XN + (size_t)(MX + m) * DM, md + 2 * DM, md + 3 * DM); }
    }
}

__device__ __forceinline__ float rcpf_(float v) { return __builtin_amdgcn_rcpf(v); }
__device__ __forceinline__ float silu_fast(float v) { return v * rcpf_(1.f + __expf(-v)); }
__device__ __forceinline__ void conv_acc8(float (&acc)[8], const v4u u, const f32x4 wa, const f32x4 wb) {
    acc[0] += lo2f(u.x) * wa.x; acc[1] += hi2f(u.x) * wa.y; acc[2] += lo2f(u.y) * wa.z; acc[3] += hi2f(u.y) * wa.w;
    acc[4] += lo2f(u.z) * wb.x; acc[5] += hi2f(u.z) * wb.y; acc[6] += lo2f(u.w) * wb.z; acc[7] += hi2f(u.w) * wb.w;
}
constexpr int NSC = 4;
__device__ __forceinline__ void p3_conv(Frame& F) {
    bf16* QKM = F.XN;
    if (F.G > 2 * NSC && F.vcu < NSC) return;
    const int wk = F.G > 2 * NSC ? F.vcu - NSC : F.vcu, NW = F.G > 2 * NSC ? F.G - NSC : F.G;
    const int gw = wk * NWAVES + F.wave, NGW = NW * NWAVES;
    const int cq = gw & 3, ch = cq * 512 + F.lane * 8;
    f32x4 wa[9], wb[9];
#pragma unroll
    for (int t = 0; t < 9; ++t) { wa[t] = *(const GAS f32x4*)(F.conv_w + t * 2048 + ch); wb[t] = *(const GAS f32x4*)(F.conv_w + t * 2048 + ch + 4); }
    const f32x4 ba = *(const GAS f32x4*)(F.conv_b + ch), bb = *(const GAS f32x4*)(F.conv_b + ch + 4);
    const float sc = ch >= 1024 ? 0.0625f : 1.f;
    constexpr int NLAT = BATCH * 64 * 16, NCTX = BATCH * (CTXL / 4);
    int it0 = gw >> 2, it1 = NLAT + NCTX, its = NGW >> 2;
    if (NW == 252) { const int j = wk - 80; const int lo = wk < 80 ? 8 * wk : 640 + (j < 100 ? 22 * j : 2200 + 21 * (j - 100)); const int len = wk < 80 ? 8 : (j < 100 ? 22 : 21);
        it0 = lo + (F.wave >> 2); it1 = lo + len; its = 2; }
    for (int it = it0; it < it1; it += its) {
        const v4u zero4 = {0u, 0u, 0u, 0u};
        if (it < NLAT) {
            const int b = it >> 10, r = (it >> 4) & 63, c0 = (it & 15) * 4;
            v4u in[3][6];
#pragma unroll
            for (int dr = 0; dr < 3; ++dr)
#pragma unroll
                for (int j = 0; j < 6; ++j) { const int rr = r + dr - 1, cc = c0 + j - 1; const bool ok = rr >= 0 && rr < 64 && cc >= 0 && cc < 64;
                    in[dr][j] = ok ? *(const GAS v4u*)(F.U + (size_t)(b * SEQ + rr * 64 + cc) * NU + C_BQK + ch) : zero4; }
#pragma unroll
            for (int o = 0; o < 4; ++o) {
                float acc[8] = {ba.x, ba.y, ba.z, ba.w, bb.x, bb.y, bb.z, bb.w};
#pragma unroll
                for (int dr = 0; dr < 3; ++dr)
#pragma unroll
                    for (int dc = 0; dc < 3; ++dc) conv_acc8(acc, in[dr][o + dc], wa[dr * 3 + dc], wb[dr * 3 + dc]);
#pragma unroll
                for (int j = 0; j < 8; ++j) acc[j] = silu_fast(acc[j]) * sc;
                v4u ov; ov.x = pk2(acc[0], acc[1]); ov.y = pk2(acc[2], acc[3]); ov.z = pk2(acc[4], acc[5]); ov.w = pk2(acc[6], acc[7]);
                *(GAS v4u*)(QKM + (size_t)(b * SEQ + r * 64 + c0 + o) * DM + ch) = ov;
            }
        } else {
            const int ic = it - NLAT, b = ic >> 6, t0 = (ic & 63) * 4;
            v4u in[6];
#pragma unroll
            for (int j = 0; j < 6; ++j) { const int tt = t0 + j - 1; in[j] = (tt >= 0 && tt < CTXL) ? *(const GAS v4u*)(F.U + (size_t)(MX + b * CTXL + tt) * NU + C_BQK + ch) : zero4; }
#pragma unroll
            for (int o = 0; o < 4; ++o) {
                float acc[8] = {ba.x, ba.y, ba.z, ba.w, bb.x, bb.y, bb.z, bb.w};
#pragma unroll
                for (int dc = 0; dc < 3; ++dc) conv_acc8(acc, in[o + dc], wa[3 + dc], wb[3 + dc]);
#pragma unroll
                for (int j = 0; j < 8; ++j) acc[j] = silu_fast(acc[j]) * sc;
                v4u ov; ov.x = pk2(acc[0], acc[1]); ov.y = pk2(acc[2], acc[3]); ov.z = pk2(acc[4], acc[5]); ov.w = pk2(acc[6], acc[7]);
                *(GAS v4u*)(QKM + (size_t)(MX + b * CTXL + t0 + o) * DM + ch) = ov;
            }
        }
    }
}

__device__ __forceinline__ int scan_row(int b, int dirn, int nb, int i) {
    if (nb < 16) { const int p = nb * 16 + i; const int t = dirn ? (CTXL - 1 - p) : p; return MX + b * CTXL + t; }
    const int p = (nb - 16) * 16 + i; const int t = dirn ? (SEQ - 1 - p) : p; return b * SEQ + t;
}
__device__ __forceinline__ void p4_hgrn2_task(Frame& F, int task) {
    const int vs = task & 3, dirn = (task >> 2) & 1, h = (task >> 3) & 7, b = task >> 6;
    LAS float* Fg = (LAS float*)(F.lds);
    LAS float* Kg = Fg + 2048, *Qg = Kg + 2048;
    LAS float* Vg = Qg + 2048;
    LAS float* LB = Vg + 512;
    LAS float* P = LB + 128;
    const int v = F.tid & 31, kg = F.tid >> 5, k0 = kg * 8;
    const int zcol = (dirn ? C_AFB : C_AFF) + h * HGD;
    __syncthreads();
    if (F.tid < 128) { const int col = h * HGD + F.tid; LB[F.tid] = sigmf(F.hg_lb[(dirn * 2 + 0) * WA + col] - F.hg_lb[(dirn * 2 + 1) * WA + col]); }
    __syncthreads();
    float S[8];
#pragma unroll
    for (int j = 0; j < 8; ++j) S[j] = 0.f;
    bf16* O = dirn ? F.OAB : F.OAF;
#pragma unroll 1
    for (int nb = 0; nb < 16 + 256; ++nb) {
        const bool lat = nb >= 16;
#pragma unroll
        for (int j = 0; j < 4; ++j) { const int e = F.tid + NT * j, i = e >> 7, k = e & 127; const int row = scan_row(b, dirn, nb, i);
            const float z = bf2f(F.U[(size_t)row * NU + zcol + k]); const float lb = LB[k]; const float f = lb + (1.f - lb) * sigmf(z);
            Fg[e] = f; Kg[e] = 1.f - f; Qg[e] = lat ? siluf(bf2f(F.U[(size_t)row * NU + C_AQ + h * HGD + k])) : 0.f; }
        { const int i = F.tid >> 5; const int row = scan_row(b, dirn, nb, i); Vg[F.tid] = bf2f(F.U[(size_t)row * NU + C_AI + h * HGD + vs * 32 + v]); }
        __syncthreads();
#pragma unroll 2
        for (int i = 0; i < 16; ++i) { const float vv = Vg[i * 32 + v]; float a = 0.f;
#pragma unroll
            for (int j = 0; j < 8; ++j) { S[j] = Fg[i * 128 + k0 + j] * S[j] + Kg[i * 128 + k0 + j] * vv; a += S[j] * Qg[i * 128 + k0 + j]; }
            P[(kg * 16 + i) * 32 + v] = a; }
        __syncthreads();
        if (lat) { const int i = F.tid >> 5; float o = 0.f;
#pragma unroll
            for (int g = 0; g < 16; ++g) o += P[(g * 16 + i) * 32 + v];
            const int row = scan_row(b, dirn, nb, i);
            O[(size_t)row * WA + h * HGD + vs * 32 + v] = (bf16)f2bf(o); }
    }
}
__device__ __forceinline__ void p4_mlstm_task(Frame& F, int task) {
    const int vs = task & 7, dirn = (task >> 3) & 1, h = (task >> 4) & 3, b = task >> 6;
    const bf16* QKM = F.XN;
    LAS float* Kb = (LAS float*)(F.lds);
    LAS float* Qb = Kb + 4096;
    LAS float* Vb = Qb + 4096;
    LAS float* LI = Vb + 512, *LF = LI + 16, *EM = LF + 16;
    LAS float* PD = EM + 16;
    LAS float* P = PD + 256;
    const int v = F.tid & 31, kg = F.tid >> 5, k0 = kg * 16;
    float C[16], nn[16]; float m = 0.f;
#pragma unroll
    for (int j = 0; j < 16; ++j) { C[j] = 0.f; nn[j] = 0.f; }
    bf16* O = dirn ? F.HBB : F.HBF;
    const float gbi = F.ml_gate_b[dirn * 4 + h], gbf = F.ml_gate_b[(2 + dirn) * 4 + h];
#pragma unroll 1
    for (int nb = 0; nb < 16 + 256; ++nb) {
        const bool lat = nb >= 16;
        __syncthreads();
#pragma unroll
        for (int j = 0; j < 8; ++j) { const int e = F.tid + NT * j, i = e >> 8, k = e & 255; const int row = scan_row(b, dirn, nb, i);
            Kb[e] = bf2f(QKM[(size_t)row * DM + 1024 + h * MLD + k]); Qb[e] = lat ? bf2f(QKM[(size_t)row * DM + h * MLD + k]) : 0.f; }
        { const int i = F.tid >> 5; const int row = scan_row(b, dirn, nb, i); Vb[F.tid] = bf2f(F.U[(size_t)row * NU + C_BV + h * MLD + vs * 32 + v]); }
        if (F.tid < 16) { const int row = scan_row(b, dirn, nb, F.tid);
            const float gi = bf2f(F.U[(size_t)row * NU + C_BG + dirn * 4 + h]) + gbi, gf = bf2f(F.U[(size_t)row * NU + C_BG + (2 + dirn) * 4 + h]) + gbf;
            LI[F.tid] = gi; LF[F.tid] = gf > 0.f ? -log1pf(__expf(-gf)) : gf - log1pf(__expf(gf)); }
        __syncthreads();
#pragma unroll 2
        for (int i = 0; i < 16; ++i) {
            const float lf = LF[i], li = LI[i]; const float mn = fmaxf(lf + m, li); const float fd = __expf(lf + m - mn), iw = __expf(li - mn); m = mn;
            if (F.tid == 0) EM[i] = __expf(-m);
            const float vv = iw * Vb[i * 32 + v]; float a = 0.f, d = 0.f;
#pragma unroll
            for (int j = 0; j < 16; ++j) { const float kk = Kb[i * 256 + k0 + j], qq = Qb[i * 256 + k0 + j];
                C[j] = fd * C[j] + vv * kk; nn[j] = fd * nn[j] + iw * kk; a += C[j] * qq; d += nn[j] * qq; }
            P[(kg * 16 + i) * 32 + v] = a; if (v == 0) PD[kg * 16 + i] = d; }
        __syncthreads();
        if (lat) { const int i = F.tid >> 5; float num = 0.f, den = 0.f;
#pragma unroll
            for (int g = 0; g < 16; ++g) { num += P[(g * 16 + i) * 32 + v]; den += PD[g * 16 + i]; }
            const int row = scan_row(b, dirn, nb, i);
            O[(size_t)row * WB + h * MLD + vs * 32 + v] = (bf16)f2bf(num / fmaxf(fabsf(den), EM[i])); }
    }
}
__device__ __forceinline__ void p4_scan_naive(Frame& F) {
    for (int task = F.vcu; task < 512; task += F.G) { if (task < 256) p4_hgrn2_task(F, task); else p4_mlstm_task(F, task - 256); }
}

constexpr int NCHUNK = MALL / 64;
__device__ __forceinline__ void gate_fk(float z, float lb, float& f, float& kk) {
    const float e = __expf(-fabsf(z)); const float rb = 1.f / (1.f + e), rs = e * rb;
    const float sg = z >= 0.f ? rb : rs, sn = z >= 0.f ? rs : rb;
    f = lb + (1.f - lb) * sg; kk = (1.f - lb) * sn;
}
template <bool DUMMY>
__device__ __forceinline__ void p3_hg_prep(Frame& F) {
    bf16* dq = F.OAF; bf16* dkf = F.OAB; bf16* dkb = F.HBF;
    LAS unsigned char* L = F.lds;
    constexpr int TQ = 0, TZF = 32768, TZB = 65536, TQF = 98304;
    const int tid = F.tid, dirn = tid >> 8, cl = tid & 255;
    if (F.G > 2 * NSC && F.vcu < NSC) return;
    const int wk = F.G > 2 * NSC ? F.vcu - NSC : F.vcu, NW = F.G > 2 * NSC ? F.G - NSC : F.G;
    v4u pre[3][4];
    auto issue = [&](int it) { const int cid = it >> 2, cb = (it & 3) * 256; const size_t row0 = (size_t)cid * 64;
#pragma unroll
        for (int i = 0; i < 4; ++i) { const int piece = tid + NT * i, row = piece >> 5, c16 = piece & 31; const bf16* ur = F.U + (row0 + row) * NU + cb + c16 * 8;
            pre[0][i] = *(const GAS v4u*)(ur + C_AQ); pre[1][i] = *(const GAS v4u*)(ur + C_AFF); pre[2][i] = *(const GAS v4u*)(ur + C_AFB); } };
    int it = wk;
    if (it < NCHUNK * 4) issue(it);
    for (; it < NCHUNK * 4; it += NW) {
        const int cid = it >> 2, cb = (it & 3) * 256; const size_t row0 = (size_t)cid * 64;
        __syncthreads();
#pragma unroll
        for (int i = 0; i < 4; ++i) { const int piece = tid + NT * i; *(LAS v4u*)(L + TQ + piece * 16) = pre[0][i]; *(LAS v4u*)(L + TZF + piece * 16) = pre[1][i]; *(LAS v4u*)(L + TZB + piece * 16) = pre[2][i]; }
        __syncthreads();
        if (it + NW < NCHUNK * 4) issue(it + NW);
        const int c = cb + cl;
        const float lb = sigmf(F.hg_lb[(dirn * 2) * WA + c] - F.hg_lb[(dirn * 2 + 1) * WA + c]), olb = 1.f - lb;
        LAS unsigned short* zt = (LAS unsigned short*)(L + (dirn ? TZB : TZF)) + cl;
        const LAS unsigned short* qtile = (const LAS unsigned short*)(L + TQ) + cl;
        LAS unsigned short* qf = (LAS unsigned short*)(L + TQF) + cl;
        float P = 1.f; unsigned qb[32];
#pragma unroll
        for (int pp = 0; pp < 64; ++pp) {
            const int p = dirn ? 63 - pp : pp;
            const float z = bf2f(zt[p * 256]), q = bf2f(qtile[p * 256]);
            const float e = __expf(-fabsf(z)); const float rbig = rcpf_(1.f + e), rsm = e * rbig;
            const float sg = z >= 0.f ? rbig : rsm, sn = z >= 0.f ? rsm : rbig;
            const float f = lb + olb * sg, kk = olb * sn; P *= f;
            const float qt = silu_fast(q) * P, kt = kk * rcpf_(P);
            zt[p * 256] = (unsigned short)(pkbf(kt, 0.f) & 0xffffu);
            const unsigned qh = pkbf(qt, 0.f) & 0xffffu;
            if (dirn) { if (pp & 1) qb[pp >> 1] |= qh << 16; else qb[pp >> 1] = qh; } else qf[p * 256] = (unsigned short)qh;
        }
        F.PE[(size_t)(dirn * NCHUNK + cid) * WA + c] = P;
        __syncthreads();
        if (dirn) {
            LAS unsigned short* qw = (LAS unsigned short*)(L + TQ) + cl;
#pragma unroll
            for (int pp = 0; pp < 64; ++pp) qw[(63 - pp) * 256] = (unsigned short)((pp & 1) ? (qb[pp >> 1] >> 16) : (qb[pp >> 1] & 0xffffu));
        }
        __syncthreads();
#pragma unroll
        for (int i = 0; i < 4; ++i) { const int piece = tid + NT * i, row = piece >> 5, c16 = piece & 31; const size_t r = row0 + row; bf16* ur = F.U + r * NU + cb + c16 * 8;
            const v4u vq = *(const LAS v4u*)(L + TQ + piece * 16), vf = *(const LAS v4u*)(L + TZF + piece * 16), vb = *(const LAS v4u*)(L + TZB + piece * 16), vqf = *(const LAS v4u*)(L + TQF + piece * 16);
            *(GAS v4u*)(F.QTF + r * WA + cb + c16 * 8) = vqf;
            if (DUMMY) { if (r < MX) { *(GAS v4u*)(dq + r * WA + cb + c16 * 8) = vq; *(GAS v4u*)(dkf + r * WA + cb + c16 * 8) = vf; *(GAS v4u*)(dkb + r * WA + cb + c16 * 8) = vb; } }
            else { *(GAS v4u*)(ur + C_AQ) = vq; *(GAS v4u*)(ur + C_AFF) = vf; *(GAS v4u*)(ur + C_AFB) = vb; } }
    }
    __syncthreads();
}
template <int CTRL, int RM> __device__ __forceinline__ float dpp_f(float idv, float x) { return __builtin_bit_cast(float, __builtin_amdgcn_update_dpp(__builtin_bit_cast(int, idv), __builtin_bit_cast(int, x), CTRL, RM, 0xf, false)); }
__device__ __forceinline__ float wave_scan_add(float x) {
    x += dpp_f<0x111, 0xf>(0.f, x); x += dpp_f<0x112, 0xf>(0.f, x); x += dpp_f<0x114, 0xf>(0.f, x); x += dpp_f<0x118, 0xf>(0.f, x);
    x += dpp_f<0x142, 0xa>(0.f, x); x += dpp_f<0x143, 0xc>(0.f, x); return x; }
__device__ __forceinline__ float wave_scan_max(float x) { const float ni = -__builtin_inff();
    x = fmaxf(x, dpp_f<0x111, 0xf>(ni, x)); x = fmaxf(x, dpp_f<0x112, 0xf>(ni, x)); x = fmaxf(x, dpp_f<0x114, 0xf>(ni, x)); x = fmaxf(x, dpp_f<0x118, 0xf>(ni, x));
    x = fmaxf(x, dpp_f<0x142, 0xa>(ni, x)); x = fmaxf(x, dpp_f<0x143, 0xc>(ni, x)); return x; }
__device__ __forceinline__ void p3_ml_scalars(Frame& F) {
    const int gw = F.vcu * NWAVES + F.wave;
    if (gw >= 32) return;
    const int dirn = gw & 1, h = (gw >> 1) & 3, b = gw >> 3;
    const float gbi = F.ml_gate_b[dirn * 4 + h], gbf = F.ml_gate_b[(2 + dirn) * 4 + h];
    float m0 = 0.f;
    float* mls = F.MLS + (size_t)(dirn * 4 + h) * MALL * 8;
    auto row_of = [&](int n) -> int { int row0; if (n < 4) { const int cc = dirn ? 3 - n : n; row0 = MX + b * CTXL + cc * 64; } else { const int lc = dirn ? 67 - n : n - 4; row0 = b * SEQ + lc * 64; }
        return row0 + (dirn ? 63 - F.lane : F.lane); };
    unsigned short gi_r[8], gf_r[8];
#pragma unroll
    for (int j = 0; j < 8; ++j) { const int row = row_of(j); gi_r[j] = F.U[(size_t)row * NU + C_BG + dirn * 4 + h]; gf_r[j] = F.U[(size_t)row * NU + C_BG + (2 + dirn) * 4 + h]; }
#pragma unroll 1
    for (int nb = 0; nb < 72; nb += 8) {
#pragma unroll
        for (int j = 0; j < 8; ++j) {
            const int n = nb + j;
            if (n < 68) {
                const int row = row_of(n);
                const float gi = bf2f(gi_r[j]) + gbi, gf = bf2f(gf_r[j]) + gbf;
                if (n + 8 < 68) { const int r2 = row_of(n + 8); gi_r[j] = F.U[(size_t)r2 * NU + C_BG + dirn * 4 + h]; gf_r[j] = F.U[(size_t)r2 * NU + C_BG + (2 + dirn) * 4 + h]; }
                const float lf = gf > 0.f ? -log1pf(__expf(-gf)) : gf - log1pf(__expf(gf));
                const float cs = wave_scan_add(lf);
                const float a = gi - cs; const float cm = wave_scan_max(a);
                const float mx = fmaxf(m0, cm), m63 = __shfl(mx, 63), cs63 = __shfl(cs, 63);
                f32x4 o0; o0.x = a; o0.y = mx; o0.z = __expf(m0 - mx); o0.w = __expf(a - m63);
                f32x4 o1; o1.x = __expf(-(cs + mx)); o1.y = 0.f; o1.z = __expf(m0 - m63); o1.w = 0.f;
                *(f32x4*)(mls + (size_t)row * 8) = o0; *(f32x4*)(mls + (size_t)row * 8 + 4) = o1;
                const int row0 = row - (dirn ? 63 - F.lane : F.lane);
                if (F.lane == 0) F.DEC[(dirn * 4 + h) * NCHUNK + (row0 >> 6)] = __expf(m0 - m63);
                m0 = cs63 + m63;
            }
        }
    }
}

typedef short s16x4 __attribute__((ext_vector_type(4)));
typedef float f32x16 __attribute__((ext_vector_type(16)));
#define MFMA32(a, b, c) __builtin_amdgcn_mfma_f32_32x32x16_bf16((a), (b), (c), 0, 0, 0)
__device__ __forceinline__ bf16x8 pk8(float a0, float a1, float a2, float a3, float a4, float a5, float a6, float a7) {
    const v4u u = {pkbf(a0, a1), pkbf(a2, a3), pkbf(a4, a5), pkbf(a6, a7)}; return __builtin_bit_cast(bf16x8, u); }
__device__ __forceinline__ bf16x8 cat4(s16x4 lo, s16x4 hi) { return __builtin_shufflevector(lo, hi, 0, 1, 2, 3, 4, 5, 6, 7); }
__device__ __forceinline__ s16x4 lds_tr(LAS unsigned char* p) { return __builtin_amdgcn_ds_read_tr16_b64_v4i16((LAS s16x4*)p); }
__device__ __forceinline__ unsigned img_off_a(unsigned row, unsigned ch) { return 2048u * (row >> 3) + 512u * (ch >> 2) + 64u * (row & 7) + 16u * ((ch & 3) ^ ((row >> 2) & 3)); }
__device__ __forceinline__ unsigned img_addr(unsigned row, unsigned ch, unsigned ncb) { return ((row >> 5) * ncb + (ch >> 4)) * 8192u + img_off_a(row & 31, ch & 15); }
__device__ __forceinline__ unsigned v_addr(unsigned row, unsigned ch) { const unsigned r = row & 31; return (row >> 5) * 4096u + 1024u * (r >> 3) + 512u * (ch >> 2) + 64u * (r & 7) + 16u * ((ch & 3) ^ ((r >> 2) & 3)); }

constexpr int SL_QT = 0, SL_KT = 32768, SL_V = 65536, SL_VW = 73728, SL_SF = 81920, SL_XCH = 114688, SL_SC = 131072, SL_W = 144384;
constexpr int SC_PAR = 448, SC_DQW = 896, SC_N0 = 1024, SC_NP = 1280;


__device__ __forceinline__ void p3b_ml_scores(Frame& F) {
    LAS unsigned char* L = F.lds;
    constexpr int BQ = 0, BK = 32768, BX = 65536, BS = 98304;
    LAS float* SCA = (LAS float*)(L + BS);
    const int tid = F.tid, lane = F.lane, w = F.wave, ts = w & 1, tp = (w >> 1) & 1, kh = w >> 2;
    const unsigned hh = lane >> 5, x4 = (lane >> 2) & 3;
    const unsigned LB0 = 2048u * ((lane >> 3) & 3) + 64u * (lane & 7);
    unsigned LBx[2];
#pragma unroll
    for (int e = 0; e < 2; ++e) LBx[e] = LB0 + 16u * ((2u * e + hh) ^ x4) + kh * 8192u;
    v4u pq[4], pk[4]; f32x2_t psc;
    auto issue = [&](int it) { const int lc = it & 63, h = (it >> 6) & 3, b = it >> 8; const size_t row0 = (size_t)b * SEQ + lc * 64;
        int tv = F.tid; asm volatile("" : "+v"(tv));
#pragma unroll
        for (int i = 0; i < 4; ++i) { const int piece = tv + NT * i, row = piece >> 5, ch = piece & 31;
            pq[i] = *(const GAS v4u*)(F.XN + (row0 + row) * DM + h * MLD + ch * 8); pk[i] = *(const GAS v4u*)(F.XN + (row0 + row) * DM + WB + h * MLD + ch * 8); }
        if (tv < 128) psc = *(const GAS f32x2_t*)(F.MLS + ((size_t)((tv >> 6) * 4 + h) * MALL + row0 + (tv & 63)) * 8); };
    int it = F.vcu;
    if (it < 1024) issue(it);
    for (; it < 1024; it += F.G) {
        const int lc = it & 63, h = (it >> 6) & 3, b = it >> 8; const size_t row0 = (size_t)b * SEQ + lc * 64;
        __syncthreads();
        { int tv = F.tid; asm volatile("" : "+v"(tv));
#pragma unroll
          for (int i = 0; i < 4; ++i) { const int piece = tv + NT * i; const unsigned a = img_addr(piece >> 5, piece & 31, 2); *(LAS v4u*)(L + BQ + a) = pq[i]; *(LAS v4u*)(L + BK + a) = pk[i]; }
          if (tv < 128) { SCA[(tv >> 6) * 128 + (tv & 63)] = psc.x; SCA[(tv >> 6) * 128 + 64 + (tv & 63)] = psc.y; } }
        __syncthreads();
        if (it + F.G < 1024) issue(it + F.G);
        f32x16 c;
#pragma unroll
        for (int r = 0; r < 16; ++r) c[r] = 0.f;
#pragma unroll
        for (int s = 0; s < 8; ++s) {
            const bf16x8 a = *(const LAS bf16x8*)(L + BK + ts * 16384 + 512 * (s >> 1) + LBx[s & 1]);
            const bf16x8 bq = *(const LAS bf16x8*)(L + BQ + tp * 16384 + 512 * (s >> 1) + LBx[s & 1]);
            c = MFMA32(a, bq, c);
        }
#pragma unroll
        for (int r = 0; r < 16; ++r) *(LAS float*)(L + BX + (((kh * 4 + ts * 2 + tp) * 16 + r) * 64 + lane) * 4) = c[r];
        __syncthreads();
#pragma unroll
        for (int r = 0; r < 16; ++r) c[r] += *(const LAS float*)(L + BX + ((((1 - kh) * 4 + ts * 2 + tp) * 16 + r) * 64 + lane) * 4);
        const int dirn = kh;
        const bool need = dirn ? (ts >= tp) : (ts <= tp);
        const float mxp = SCA[dirn * 128 + 64 + 32 * tp + (lane & 31)];
        int dl = (lane & 31) - 4 * (int)hh; if (dirn) dl = -dl; asm volatile("" : "+v"(dl));
        const int sg1 = dirn ? -1 : 1; const bool diag = ts == tp;
        float rs = 0.f;
        bf16* wout = F.MLW + ((size_t)((dirn * 4 + h) * 256 + (int)(row0 >> 6)) * 4096) + (32 * tp + (lane & 31)) * 64 + 32 * ts + 4 * hh;
#pragma unroll
        for (int g = 0; g < 4; ++g) {
            const f32x4 av = *(const LAS f32x4*)(SCA + dirn * 128 + 32 * ts + 8 * g + 4 * hh);
            float wv[4];
#pragma unroll
            for (int j = 0; j < 4; ++j) { float v = need ? c[4 * g + j] * __expf(av[j] - mxp) : 0.f;
                if (diag) v = (dl - sg1 * (j + 8 * g) >= 0) ? v : 0.f;
                wv[j] = v; rs += v; }
            *(GAS unsigned long long*)(wout + 8 * g) = (unsigned long long)pkbf(wv[0], wv[1]) | ((unsigned long long)pkbf(wv[2], wv[3]) << 32);
        }
        rs += __shfl_xor(rs, 32);
        if (lane < 32) SCA[256 + (dirn * 2 + ts) * 64 + 32 * tp + lane] = rs;
        __syncthreads();
        if (tid < 128) { const int d = tid >> 6, p = tid & 63; F.MLS[((size_t)(d * 4 + h) * MALL + row0 + p) * 8 + 5] = SCA[256 + (d * 2) * 64 + p] + SCA[256 + (d * 2 + 1) * 64 + p]; }
    }
    __syncthreads();
}

template <bool ML, int SKIP = 0>
__device__ __forceinline__ void scan_task(Frame& F, int task) {
    constexpr int NKT = ML ? 8 : 4, NCB = NKT / 4, NKH = NKT / 2, NOWN = NKT / 4, NPQ = ML ? 4 : 2, DKK = 32 * NKT;
    int vs, dirn, h, b;
    if (ML) { vs = task & 3; dirn = (task >> 2) & 1; h = (task >> 3) & 3; b = task >> 5; } else { vs = task & 1; dirn = (task >> 1) & 1; h = (task >> 2) & 7; b = task >> 5; }
    const int lane = F.lane, w = F.wave, tid = F.tid; const int tp = (w >> 2) & 1, tj = (w >> 1) & 1, kh = w & 1;
    const unsigned hh = lane >> 5, q4 = (lane & 15) >> 2, p4 = lane & 3, blk = (lane >> 4) & 1, x4 = (lane >> 2) & 3;
    LAS unsigned char* L = F.lds;
    LAS float* SC = (LAS float*)(L + SL_SC);
    const unsigned LB0 = 2048u * ((lane >> 3) & 3) + 64u * (lane & 7);
    const unsigned khoff = ML ? kh * 8192u : kh * 1024u;
    unsigned LBx[2], LK[2][2], TRK[2], VK[2], VN[2], WL[2];
#pragma unroll
    for (int e = 0; e < 2; ++e) { LBx[e] = LB0 + 16u * ((2u * e + hh) ^ x4) + khoff; WL[e] = 1024u * ((lane >> 3) & 3) + 64u * (lane & 7) + 16u * ((2u * e + hh) ^ x4);
#pragma unroll
        for (int t = 0; t < 2; ++t) LK[e][t] = LB0 + 16u * ((2u * e + t) ^ x4) + 8u * hh + khoff; }
#pragma unroll
    for (int t = 0; t < 2; ++t) {
        TRK[t] = 2048u * hh + 64u * q4 + 8u * (p4 & 1) + 16u * ((2u * blk + (p4 >> 1)) ^ (2u * hh + t));
        VK[t] = 64u * (4u * hh + q4) + 8u * (p4 & 1) + 16u * ((2u * blk + (p4 >> 1)) ^ (2u * t + hh)) + 512u * tj;
        VN[t] = 1024u * hh + 64u * q4 + 8u * (p4 & 1) + 512u * tj + 16u * ((2u * blk + (p4 >> 1)) ^ (2u * hh + t)); }
    unsigned tkoff[NOWN];
#pragma unroll
    for (int i = 0; i < NOWN; ++i) { const unsigned tk = kh * NKH + tp * NOWN + i; tkoff[i] = (tk >> 2) * 8192u + 512u * (tk & 3); }
    const bf16 *gq, *gk, *gv; int sq, sk; bf16* go;
    if (ML) { gq = F.XN + h * MLD; gk = F.XN + WB + h * MLD; sq = DM; sk = DM; gv = F.U + C_BV + h * MLD + vs * 64; go = (dirn ? F.HBB : F.HBF) + h * MLD + vs * 64; }
    else { if (dirn) { gq = F.U + C_AQ + h * HGD; sq = NU; gk = F.U + C_AFB + h * HGD; } else { gq = F.QTF + h * HGD; sq = WA; gk = F.U + C_AFF + h * HGD; }
        sk = NU; gv = F.U + C_AI + h * HGD + vs * 64; go = (dirn ? F.OAB : F.OAF) + h * HGD + vs * 64; }
    const float* mls = F.MLS + (size_t)(dirn * 4 + h) * MALL * 8;
    const float* pev = F.PE + (size_t)dirn * NCHUNK * WA + h * HGD;
    f32x16 S[NOWN];
#pragma unroll
    for (int i = 0; i < NOWN; ++i)
#pragma unroll
        for (int r = 0; r < 16; ++r) S[i][r] = 0.f;
    v4u pq[NPQ], pk[NPQ], pv, pw; f32x4 ps0, ps1; float pws;
    const bf16* gw_ = F.MLW + (size_t)(dirn * 4 + h) * 256 * 4096;
    auto row0_of = [&](int n) -> int { if (n < 4) { const int cc = dirn ? 3 - n : n; return MX + b * CTXL + cc * 64; } const int lc = dirn ? 67 - n : n - 4; return b * SEQ + lc * 64; };
    int offq[NPQ], offk[NPQ]; unsigned aimg[NPQ];
#pragma unroll
    for (int i = 0; i < NPQ; ++i) { const int piece = tid + NT * i, row = piece >> (ML ? 5 : 4), ch = piece & (ML ? 31 : 15); offq[i] = row * sq + ch * 8; offk[i] = row * sk + ch * 8; aimg[i] = img_addr(row, ch, NCB); }
    const int offv = (tid >> 3) * NU + (tid & 7) * 8, offw = (tid >> 3) * 64 + (tid & 7) * 8; const unsigned va = v_addr(tid >> 3, tid & 7);
    auto issue_loads = [&](int n) {
        const int row0 = row0_of(n);
        const bf16* bq_ = gq + (size_t)row0 * sq; const bf16* bk_ = gk + (size_t)row0 * sk;
#pragma unroll
        for (int i = 0; i < NPQ; ++i) { pq[i] = *(const GAS v4u*)(bq_ + offq[i]); pk[i] = *(const GAS v4u*)(bk_ + offk[i]); }
        pv = *(const GAS v4u*)(gv + (size_t)row0 * NU + offv);
        if (ML) { pws = mls[(size_t)(row0 + (tid >> 3)) * 8 + 3];
            if (n >= 4) pw = *(const GAS v4u*)(gw_ + (size_t)(row0 >> 6) * 4096 + offw);
            if (tid < 64) { ps0 = *(const GAS f32x4*)(mls + (size_t)(row0 + tid) * 8); ps1 = *(const GAS f32x4*)(mls + (size_t)(row0 + tid) * 8 + 4); } }
        else { if (tid < 32) ps0 = *(const GAS f32x4*)(pev + (size_t)(row0 >> 6) * WA + tid * 4); }
    };
    auto store_images = [&](int n) {
#pragma unroll
        for (int i = 0; i < NPQ; ++i) { *(LAS v4u*)(L + SL_QT + aimg[i]) = pq[i]; *(LAS v4u*)(L + SL_KT + aimg[i]) = pk[i]; }
        *(LAS v4u*)(L + SL_V + va) = pv;
        if (!ML && tid < 32) *(LAS f32x4*)(SC + (n & 1) * SC_PAR + tid * 4) = ps0;
        if (ML) { v4u o; o.x = pkbf(lo2f(pv.x) * pws, hi2f(pv.x) * pws); o.y = pkbf(lo2f(pv.y) * pws, hi2f(pv.y) * pws); o.z = pkbf(lo2f(pv.z) * pws, hi2f(pv.z) * pws); o.w = pkbf(lo2f(pv.w) * pws, hi2f(pv.w) * pws);
            *(LAS v4u*)(L + SL_VW + va) = o;
            if (n >= 4) *(LAS v4u*)(L + SL_W + va) = pw;
            if (tid < 64) { LAS float* sp = SC + (n & 1) * SC_PAR + tid; sp[0] = ps0.x; sp[64] = ps0.y; sp[128] = ps0.z; sp[192] = ps0.w; sp[256] = ps1.x; sp[320] = ps1.y; sp[384] = ps1.z; } }
    };
    __syncthreads();
    issue_loads(0);
    for (int e = tid; e < 32768 / 16; e += NT) *(LAS v4u*)(L + SL_SF + e * 16) = (v4u){0u, 0u, 0u, 0u};
    store_images(0);
    __syncthreads();
#pragma unroll 1
    for (int n = 0; n < 68; ++n) {
        const bool lat = n >= 4; const int row0 = row0_of(n); const int cid = row0 >> 6;
        if (n + 1 < 68 && !(SKIP & 16)) issue_loads(n + 1);
        LAS float* SP = SC + (n & 1) * SC_PAR;
        float dec = 1.f; f32x4 pe[NOWN][4];
        if (ML) dec = SP[384];
        else {
#pragma unroll
            for (int i = 0; i < NOWN; ++i)
#pragma unroll
                for (int g = 0; g < 4; ++g) pe[i][g] = *(const LAS f32x4*)(SP + 32 * (kh * NKH + tp * NOWN + i) + 8 * g + 4 * hh);
        }
        f32x16 o;
        if (lat && !(SKIP & 4)) {
            f32x16 acc_o, acc_i;
#pragma unroll
            for (int r = 0; r < 16; ++r) { acc_o[r] = 0.f; acc_i[r] = 0.f; }
            if (ML) {
                if (kh == 0) {
#pragma unroll
                    for (int ts = 0; ts < 2; ++ts) {
                        const bool need = dirn ? (ts >= tp) : (ts <= tp);
                        if (need) {
#pragma unroll
                            for (int e = 0; e < 2; ++e) {
                                const bf16x8 a = *(const LAS bf16x8*)(L + SL_W + tp * 4096 + 512 * ts + WL[e]);
                                const s16x4 lo = lds_tr(L + SL_V + ts * 4096 + 2048 * e + VN[0]), hi = lds_tr(L + SL_V + ts * 4096 + 2048 * e + 256 + VN[1]);
                                acc_o = MFMA32(a, cat4(lo, hi), acc_o);
                            }
                        }
                    }
                }
            } else
#pragma unroll
            for (int ts = 0; ts < 2; ++ts) {
                const bool need = dirn ? (ts >= tp) : (ts <= tp);
                if (need) {
                    f32x16 c;
#pragma unroll
                    for (int r = 0; r < 16; ++r) c[r] = 0.f;
#pragma unroll
                    for (int s = 0; s < NKT; ++s) {
                        const bf16x8 a = *(const LAS bf16x8*)(L + SL_KT + ts * NCB * 8192 + 512 * (s >> 1) + LBx[s & 1]);
                        const bf16x8 bq = *(const LAS bf16x8*)(L + SL_QT + tp * NCB * 8192 + 512 * (s >> 1) + LBx[s & 1]);
                        c = MFMA32(a, bq, c);
                    }
                    int dl = (lane & 31) - 4 * (int)hh; if (dirn) dl = -dl; asm volatile("" : "+v"(dl));
                    const int sg1 = dirn ? -1 : 1; const bool diag = ts == tp;
#pragma unroll
                    for (int r = 0; r < 16; ++r) { const int ro = (r & 3) + 8 * (r >> 2);
                        float wv = c[r];
                        if (diag) wv = (dl - sg1 * ro >= 0) ? wv : 0.f;
                        c[r] = wv; }
#pragma unroll
                    for (int st = 0; st < 2; ++st) {
                        const bf16x8 a = pk8(c[8 * st], c[8 * st + 1], c[8 * st + 2], c[8 * st + 3], c[8 * st + 4], c[8 * st + 5], c[8 * st + 6], c[8 * st + 7]);
                        const s16x4 lo = lds_tr(L + SL_V + ts * 4096 + 1024 * (2 * st) + VK[0]), hi = lds_tr(L + SL_V + ts * 4096 + 1024 * (2 * st + 1) + VK[1]);
                        acc_o = MFMA32(a, cat4(lo, hi), acc_o);
                    }
                }
            }
#pragma unroll
            for (int tkk = 0; tkk < NKH; ++tkk)
#pragma unroll
                for (int st = 0; st < 2; ++st) {
                    const s16x4 lo = *(const LAS s16x4*)(L + SL_QT + tp * NCB * 8192 + 512 * tkk + LK[st][0]), hi = *(const LAS s16x4*)(L + SL_QT + tp * NCB * 8192 + 512 * tkk + LK[st][1]);
                    const bf16x8 sf = *(const LAS bf16x8*)(L + SL_SF + ((((kh * NKH + tkk) * 2 + tj) * 2 + st) * 1024) + lane * 16);
                    acc_i = MFMA32(cat4(lo, hi), sf, acc_i);
                }
            if (ML) {
                f32x4 wi[4];
#pragma unroll
                for (int g = 0; g < 4; ++g) wi[g] = *(const LAS f32x4*)(SP + 128 + 32 * tp + 8 * g + 4 * hh);
#pragma unroll
                for (int r = 0; r < 16; ++r) o[r] = acc_o[r] + wi[r >> 2][r & 3] * acc_i[r];
            } else {
#pragma unroll
                for (int r = 0; r < 16; ++r) o[r] = acc_o[r] + acc_i[r];
            }
            {
#pragma unroll
                for (int r = 0; r < 8; ++r) { const int rr = kh ? r : r + 8; *(LAS float*)(L + SL_XCH + (((tp * 2 + tj) * 16 + rr) * 64 + lane) * 4) = kh ? o[r] : o[r + 8]; }
            }
        }
#pragma unroll
        for (int i = 0; i < NOWN; ++i) {
            f32x16 g = S[i];
            if (ML) {
#pragma unroll
                for (int r = 0; r < 16; ++r) g[r] *= dec;
            }
#pragma unroll
            for (int ks = 0; ks < ((SKIP & 8) ? 0 : 4); ++ks) {
                const s16x4 alo = lds_tr(L + SL_KT + (ks >> 1) * NCB * 8192 + 4096 * (ks & 1) + tkoff[i] + TRK[0]), ahi = lds_tr(L + SL_KT + (ks >> 1) * NCB * 8192 + 4096 * (ks & 1) + 256 + tkoff[i] + TRK[1]);
                const s16x4 blo = lds_tr(L + (ML ? SL_VW : SL_V) + (ks >> 1) * 4096 + 2048 * (ks & 1) + VN[0]), bhi = lds_tr(L + (ML ? SL_VW : SL_V) + (ks >> 1) * 4096 + 2048 * (ks & 1) + 256 + VN[1]);
                g = MFMA32(cat4(alo, ahi), cat4(blo, bhi), g);
            }
            if (!ML) {
#pragma unroll
                for (int r = 0; r < 16; ++r) g[r] *= pe[i][r >> 2][r & 3];
            }
            S[i] = g;
        }
        __syncthreads();
        if (lat && !(SKIP & 2)) {
#pragma unroll
            for (int r8 = 0; r8 < 8; ++r8) { const int r = kh ? r8 + 8 : r8; const float ov = (kh ? o[r8 + 8] : o[r8]) + *(const LAS float*)(L + SL_XCH + (((tp * 2 + tj) * 16 + r) * 64 + lane) * 4);
                const int pr = 32 * tp + (r & 3) + 8 * (r >> 2) + 4 * (int)hh;
                go[(size_t)(row0 + pr) * WA + 32 * tj + (lane & 31)] = (bf16)(pkbf(ov, 0.f) & 0xffffu); }
        }
#pragma unroll
        for (int i = 0; i < NOWN; ++i)
#pragma unroll
            for (int st = 0; st < 2; ++st) {
                const bf16x8 f8 = pk8(S[i][8 * st], S[i][8 * st + 1], S[i][8 * st + 2], S[i][8 * st + 3], S[i][8 * st + 4], S[i][8 * st + 5], S[i][8 * st + 6], S[i][8 * st + 7]);
                *(LAS bf16x8*)(L + SL_SF + ((((kh * NKH + tp * NOWN + i) * 2 + tj) * 2 + st) * 1024) + lane * 16) = f8;
            }
        if (n + 1 < 68 && !(SKIP & 16)) store_images(n + 1);
        __syncthreads();
    }
}
#ifndef HG_MFMA
#define HG_MFMA 1
#endif
#ifndef ML_MFMA
#define ML_MFMA 1
#endif

__device__ __forceinline__ void nchain_task(Frame& F, int j) {
    const int kq = j & 3, id = j >> 2, dirn = id & 1, h = (id >> 1) & 3, b = id >> 3;
    const int tid = F.tid, lane = F.lane, w = F.wave;
    LAS unsigned char* L = F.lds;
    constexpr int NQ = 0, NK = 8192, NS = 16384;
    LAS float* SN = (LAS float*)(L + NS);
    const bf16* gq = F.XN + h * MLD + kq * 64; const bf16* gk = gq + WB;
    const float* mls = F.MLS + (size_t)(dirn * 4 + h) * MALL * 8;
    float* dqp = F.DQP + (size_t)((dirn * 4 + h) * 4 + kq) * MX;
    auto row0_of = [&](int n) -> int { if (n < 4) { const int cc = dirn ? 3 - n : n; return MX + b * CTXL + cc * 64; } const int lc = dirn ? 67 - n : n - 4; return b * SEQ + lc * 64; };
    v4u pq, pk; float pws = 0.f, pdec = 0.f;
    auto issue = [&](int n) { const int row0 = row0_of(n); const size_t off = (size_t)(row0 + (tid >> 3)) * DM + (tid & 7) * 8;
        pq = *(const GAS v4u*)(gq + off); pk = *(const GAS v4u*)(gk + off);
        if (tid < 64) { pws = mls[(size_t)(row0 + tid) * 8 + 3]; pdec = mls[(size_t)(row0 + tid) * 8 + 6]; } };
    auto stash = [&]() { *(LAS v4u*)(L + NQ + tid * 16) = pq; *(LAS v4u*)(L + NK + tid * 16) = pk; if (tid < 64) { SN[tid] = pws; if (tid == 0) SN[640] = pdec; } };
    __syncthreads();
    issue(0);
    if (tid < 64) SN[64 + tid] = 0.f;
    stash();
    __syncthreads();
#pragma unroll 1
    for (int n = 0; n < 68; ++n) {
        const int row0 = row0_of(n);
        if (n + 1 < 68) issue(n + 1);
        if (n >= 4) {
            const int p = tid >> 3, kk = tid & 7; const v4u u = *(const LAS v4u*)(L + NQ + tid * 16);
            const f32x4 na = *(const LAS f32x4*)(SN + 64 + 8 * kk), nb = *(const LAS f32x4*)(SN + 64 + 8 * kk + 4);
            float d = lo2f(u.x) * na.x + hi2f(u.x) * na.y + lo2f(u.y) * na.z + hi2f(u.y) * na.w + lo2f(u.z) * nb.x + hi2f(u.z) * nb.y + lo2f(u.w) * nb.z + hi2f(u.w) * nb.w;
            d += __shfl_xor(d, 1); d += __shfl_xor(d, 2); d += __shfl_xor(d, 4);
            if (kk == 0) dqp[row0 + p] = d;
        }
        { float a = 0.f;
#pragma unroll
          for (int i = 0; i < 8; ++i) { const int s_ = 8 * w + i; a += SN[s_] * bf2f(*(const LAS unsigned short*)(L + NK + s_ * 128 + lane * 2)); }
          SN[128 + w * 64 + lane] = a; }
        __syncthreads();
        if (tid < 64) { float nn = SN[640] * SN[64 + tid];
#pragma unroll
            for (int ww = 0; ww < 8; ++ww) nn += SN[128 + ww * 64 + tid];
            SN[64 + tid] = nn; }
        if (n + 1 < 68) stash();
        __syncthreads();
    }
}

template <int WHICH, int SKIP = 0>
__device__ __forceinline__ void p4_scan(Frame& F) {
    for (int t = F.vcu; t < 256; t += F.G) {
        if (t < 128 ? !(WHICH & 1) : !(WHICH & 2)) continue;
        if (t < 128) { if (ML_MFMA) scan_task<true, SKIP>(F, t); else { p4_mlstm_task(F, 2 * t); p4_mlstm_task(F, 2 * t + 1); } }
        else { if (HG_MFMA) { scan_task<false, SKIP>(F, t - 128); nchain_task(F, t - 128); } else { p4_hgrn2_task(F, 2 * (t - 128)); p4_hgrn2_task(F, 2 * (t - 128) + 1); } }
    }
}
__device__ __forceinline__ void p5_combine(Frame& F) {
    bf16* Y = F.XN;
    const int gw = F.vcu * NWAVES + F.wave, NGW = F.G * NWAVES;
    for (int row = gw; row < MX; row += NGW) {
        const int ch = F.lane * 16;
        {
            float o[16];
            const v4u a0 = *(const GAS v4u*)(F.OAF + (size_t)row * WA + ch), a1 = *(const GAS v4u*)(F.OAF + (size_t)row * WA + ch + 8);
            const v4u b0 = *(const GAS v4u*)(F.OAB + (size_t)row * WA + ch), b1 = *(const GAS v4u*)(F.OAB + (size_t)row * WA + ch + 8);
            const unsigned ua[8] = {a0.x, a0.y, a0.z, a0.w, a1.x, a1.y, a1.z, a1.w}, ub[8] = {b0.x, b0.y, b0.z, b0.w, b1.x, b1.y, b1.z, b1.w};
            float ss = 0.f;
#pragma unroll
            for (int j = 0; j < 8; ++j) { o[2 * j] = lo2f(ua[j]) + lo2f(ub[j]); o[2 * j + 1] = hi2f(ua[j]) + hi2f(ub[j]); ss += o[2 * j] * o[2 * j] + o[2 * j + 1] * o[2 * j + 1]; }
            ss += __shfl_xor(ss, 1); ss += __shfl_xor(ss, 2); ss += __shfl_xor(ss, 4);
            const float r = 1.f / sqrtf(ss * (1.f / HGD) + NORM_EPS);
            const v4u z0 = *(const GAS v4u*)(F.U + (size_t)row * NU + C_AZ + ch), z1 = *(const GAS v4u*)(F.U + (size_t)row * NU + C_AZ + ch + 8);
            const unsigned uz[8] = {z0.x, z0.y, z0.z, z0.w, z1.x, z1.y, z1.z, z1.w};
            unsigned w[8];
#pragma unroll
            for (int j = 0; j < 8; ++j) { const float y0 = o[2 * j] * r * F.hg_norm_w[ch + 2 * j] * siluf(lo2f(uz[j])), y1 = o[2 * j + 1] * r * F.hg_norm_w[ch + 2 * j + 1] * siluf(hi2f(uz[j])); w[j] = pk2(y0, y1); }
            *(GAS v4u*)(Y + (size_t)row * DM + ch) = (v4u){w[0], w[1], w[2], w[3]}; *(GAS v4u*)(Y + (size_t)row * DM + ch + 8) = (v4u){w[4], w[5], w[6], w[7]};
        }
        {
            float o[16];
            const v4u a0 = *(const GAS v4u*)(F.HBF + (size_t)row * WB + ch), a1 = *(const GAS v4u*)(F.HBF + (size_t)row * WB + ch + 8);
            const v4u b0 = *(const GAS v4u*)(F.HBB + (size_t)row * WB + ch), b1 = *(const GAS v4u*)(F.HBB + (size_t)row * WB + ch + 8);
            const unsigned ua[8] = {a0.x, a0.y, a0.z, a0.w, a1.x, a1.y, a1.z, a1.w}, ub[8] = {b0.x, b0.y, b0.z, b0.w, b1.x, b1.y, b1.z, b1.w};
            float s = 0.f; const int hq = F.lane >> 4;
            float invd[2];
#pragma unroll
            for (int d = 0; d < 2; ++d) { const float* mr = F.MLS + ((size_t)(d * 4 + hq) * MALL + row) * 8; const float* dq = F.DQP + (size_t)((d * 4 + hq) * 4) * MX + row;
                const float den = mr[2] * ((dq[0] + dq[MX]) + (dq[2 * MX] + dq[3 * MX])) + mr[5];
                invd[d] = rcpf_(fmaxf(fabsf(den), mr[4])); }
#pragma unroll
            for (int j = 0; j < 8; ++j) { o[2 * j] = lo2f(ua[j]) * invd[0] + lo2f(ub[j]) * invd[1]; o[2 * j + 1] = hi2f(ua[j]) * invd[0] + hi2f(ub[j]) * invd[1]; s += o[2 * j] + o[2 * j + 1]; }
            s += __shfl_xor(s, 1); s += __shfl_xor(s, 2); s += __shfl_xor(s, 4); s += __shfl_xor(s, 8);
            const float mu = s * (1.f / MLD); float q = 0.f;
#pragma unroll
            for (int j = 0; j < 16; ++j) { o[j] -= mu; q += o[j] * o[j]; }
            q += __shfl_xor(q, 1); q += __shfl_xor(q, 2); q += __shfl_xor(q, 4); q += __shfl_xor(q, 8);
            const float r = 1.f / sqrtf(q * (1.f / MLD) + NORM_EPS);
            const v4u g0 = *(const GAS v4u*)(F.U + (size_t)row * NU + C_BO + ch), g1 = *(const GAS v4u*)(F.U + (size_t)row * NU + C_BO + ch + 8);
            const v4u z0 = *(const GAS v4u*)(F.U + (size_t)row * NU + C_BZ + ch), z1 = *(const GAS v4u*)(F.U + (size_t)row * NU + C_BZ + ch + 8);
            const unsigned ug[8] = {g0.x, g0.y, g0.z, g0.w, g1.x, g1.y, g1.z, g1.w}, uz[8] = {z0.x, z0.y, z0.z, z0.w, z1.x, z1.y, z1.z, z1.w};
            unsigned w[8];
#pragma unroll
            for (int j = 0; j < 8; ++j) { const float y0 = o[2 * j] * r * F.ml_norm_w[ch + 2 * j] * sigmf(lo2f(ug[j])) * siluf(lo2f(uz[j])), y1 = o[2 * j + 1] * r * F.ml_norm_w[ch + 2 * j + 1] * sigmf(hi2f(ug[j])) * siluf(hi2f(uz[j])); w[j] = pk2(y0, y1); }
            *(GAS v4u*)(Y + (size_t)row * DM + WA + ch) = (v4u){w[0], w[1], w[2], w[3]}; *(GAS v4u*)(Y + (size_t)row * DM + WA + ch + 8) = (v4u){w[4], w[5], w[6], w[7]};
        }
    }
}

struct EpiResid {
    static constexpr bool PERM = false, AFTER_DRAIN = false;
    const float* x; const float* gate; float* out;
    __device__ __forceinline__ void operator()(const pg8::f32x4 (&acc)[2][2][4][2], const pg8::Unit& u, int wr, int wc, int fr, int fq) const {
        using pg8::BM; using pg8::HALF;
        const int row0 = u.pm * BM + wr * 64 + fr, col0 = u.pn * BM + wc * 32 + 4 * fq; const int b = (u.pm * BM) / SEQ;
        pg8::f32x4 gv[2][2];
#pragma unroll
        for (int bj = 0; bj < 2; ++bj)
#pragma unroll
            for (int n = 0; n < 2; ++n) gv[bj][n] = *(const pg8::f32x4*)(gate + b * DM + col0 + bj * HALF + n * 16);
#pragma unroll
        for (int ai = 0; ai < 2; ++ai)
#pragma unroll
            for (int m = 0; m < 4; ++m) { const size_t off = (size_t)(row0 + ai * HALF + m * 16) * DM + col0;
#pragma unroll
                for (int bj = 0; bj < 2; ++bj)
#pragma unroll
                    for (int n = 0; n < 2; ++n) { const pg8::f32x4 xv = *(const pg8::f32x4*)(x + off + bj * HALF + n * 16);
                        *(pg8::f32x4*)(out + off + bj * HALF + n * 16) = xv * ALPHA + gv[bj][n] * acc[ai][bj][m][n]; } }
    }
};


struct PanelOrder {
    int c;
    __device__ __forceinline__ bool next(int i, pg8::Unit& u) const { if (i >= 2) return false; u.pm = c >> 2; u.pn = (c & 3) + 4 * i; return true; }
    __device__ __forceinline__ void a_ready(const pg8::Unit&) const {}
    __device__ __forceinline__ void done(const pg8::Unit&) const {}
};
struct EpiLnFused {
    static constexpr bool PERM = false, AFTER_DRAIN = true;
    const float* x; const float* gate; float* out; const float* ln_g; const float* ln_b;
    unsigned long long* xbuf;
    unsigned* cnt;
    __device__ __forceinline__ void zstats(pg8::f32x4 (&acc)[2][2][4][2], const pg8::Unit& u, int wr, int wc, int fr, int fq) const {
        using pg8::BM; using pg8::HALF;
        asm volatile("" : "+v"(fr), "+v"(fq));
        const int row0 = u.pm * BM + wr * 64 + fr, col0 = u.pn * BM + wc * 32 + 4 * fq; const int b = (u.pm * BM) / SEQ;
        pg8::f32x4 gv[2][2];
#pragma unroll
        for (int bj = 0; bj < 2; ++bj)
#pragma unroll
            for (int n = 0; n < 2; ++n) gv[bj][n] = *(const pg8::f32x4*)(gate + b * DM + col0 + bj * HALF + n * 16);
#pragma unroll
        for (int ai = 0; ai < 2; ++ai)
#pragma unroll
            for (int m = 0; m < 4; ++m) { const int row = row0 + ai * HALF + m * 16; const size_t off = (size_t)row * DM + col0;
                float s = 0.f;
#pragma unroll
                for (int bj = 0; bj < 2; ++bj)
#pragma unroll
                    for (int n = 0; n < 2; ++n) { const pg8::f32x4 xv = *(const pg8::f32x4*)(x + off + bj * HALF + n * 16);
                        const pg8::f32x4 z = xv * ALPHA + gv[bj][n] * acc[ai][bj][m][n]; acc[ai][bj][m][n] = z; s += (z[0] + z[1]) + (z[2] + z[3]); }
                s += __shfl_xor(s, 16); s += __shfl_xor(s, 32);
                const float mw = s * (1.0f / 64.0f); float q = 0.f;
#pragma unroll
                for (int bj = 0; bj < 2; ++bj)
#pragma unroll
                    for (int n = 0; n < 2; ++n) { const pg8::f32x4 d = acc[ai][bj][m][n] - mw; q += (d[0] * d[0] + d[1] * d[1]) + (d[2] * d[2] + d[3] * d[3]); }
                q += __shfl_xor(q, 16); q += __shfl_xor(q, 32);
                if (fq == 0) __hip_atomic_store(xbuf + (size_t)row * 32 + u.pn * 4 + wc, ((unsigned long long)__float_as_uint(q) << 32) | __float_as_uint(mw), __ATOMIC_RELAXED, __HIP_MEMORY_SCOPE_AGENT);
            }
    }
    __device__ __forceinline__ void publish(const pg8::Unit& u) const {
        asm volatile("s_waitcnt vmcnt(0)" ::: "memory");
        if ((threadIdx.x & 63) == 0) __hip_atomic_fetch_add(cnt + 64 * u.pm, 1u, __ATOMIC_RELAXED, __HIP_MEMORY_SCOPE_AGENT);
    }
    __device__ __forceinline__ void operator()(const pg8::f32x4 (&acc_c)[2][2][4][2], const pg8::Unit& u, int wr, int wc, int fr, int fq) const {
        using pg8::BM; using pg8::HALF;
        pg8::f32x4 (&acc)[2][2][4][2] = const_cast<pg8::f32x4 (&)[2][2][4][2]>(acc_c);
        zstats(acc, u, wr, wc, fr, fq);
        const int row0 = u.pm * BM + wr * 64 + fr, col0 = u.pn * BM + wc * 32 + 4 * fq;
#pragma unroll
        for (int ai = 0; ai < 2; ++ai)
#pragma unroll
            for (int m = 0; m < 4; ++m) { const size_t off = (size_t)(row0 + ai * HALF + m * 16) * DM + col0;
#pragma unroll
                for (int bj = 0; bj < 2; ++bj)
#pragma unroll
                    for (int n = 0; n < 2; ++n) *(pg8::f32x4*)(out + off + bj * HALF + n * 16) = acc[ai][bj][m][n]; }
        publish(u);
    }
    __device__ __forceinline__ void fused(pg8::f32x4 (&acc)[2][2][4][2], const pg8::Unit& u, int wr, int wc, int fr, int fq, PG8_LAS unsigned char* lds, int wid, int lane) const {
        using pg8::BM; using pg8::HALF;
        typedef float f32x2v __attribute__((ext_vector_type(2)));
        PG8_LAS f32x2v* PH = (PG8_LAS f32x2v*)(lds + 131072);
        PG8_LAS f32x2v* S = (PG8_LAS f32x2v*)(lds + 131072 + 4096);
        zstats(acc, u, wr, wc, fr, fq);
        publish(u);
        if (wid == 0) {
            unsigned spins = 0;
            while ((unsigned)__builtin_amdgcn_readfirstlane(__hip_atomic_load(cnt + 64 * u.pm, __ATOMIC_RELAXED, __HIP_MEMORY_SCOPE_AGENT)) < 64u) { __builtin_amdgcn_s_sleep(2); if (++spins > (1u << 22)) break; }
            __builtin_amdgcn_fence(__ATOMIC_ACQUIRE, "agent");
            asm volatile("s_waitcnt vmcnt(0)" ::: "memory");
        }
        asm volatile("s_waitcnt vmcnt(0) lgkmcnt(0)" ::: "memory"); __builtin_amdgcn_s_barrier(); asm volatile("" ::: "memory");
        { const int t = threadIdx.x, row = t >> 1, half = t & 1; const unsigned long long* sl = xbuf + (size_t)(u.pm * BM + row) * 32 + half * 16;
          float ms = 0.f, mq = 0.f, m2s = 0.f;
#pragma unroll
          for (int i = 0; i < 16; ++i) { const unsigned long long w = __hip_atomic_load(sl + i, __ATOMIC_RELAXED, __HIP_MEMORY_SCOPE_AGENT); const float mt = __uint_as_float((unsigned)w); ms += mt; mq += mt * mt; m2s += __uint_as_float((unsigned)(w >> 32)); }
          const float mh = ms * (1.0f / 16.0f);
          PH[row * 2 + half] = (f32x2v){mh, m2s + 64.0f * fmaxf(mq - 16.0f * mh * mh, 0.f)}; }
        asm volatile("s_waitcnt lgkmcnt(0)" ::: "memory"); __builtin_amdgcn_s_barrier(); asm volatile("" ::: "memory");
        if (threadIdx.x < 256) { const int row = threadIdx.x; const f32x2v a = PH[row * 2], bq = PH[row * 2 + 1];
            const float mean = 0.5f * (a.x + bq.x), da = a.x - mean, db = bq.x - mean; const float m2t = (a.y + bq.y) + 1024.0f * (da * da + db * db);
            S[row] = (f32x2v){mean, 1.0f / sqrtf(m2t * (1.0f / 2048.0f) + LN_EPS)}; }
        asm volatile("s_waitcnt lgkmcnt(0)" ::: "memory"); __builtin_amdgcn_s_barrier(); asm volatile("" ::: "memory");
        const int row0 = u.pm * BM + wr * 64 + fr, col0 = u.pn * BM + wc * 32 + 4 * fq;
#pragma unroll
        for (int bj = 0; bj < 2; ++bj)
#pragma unroll
            for (int n = 0; n < 2; ++n) { const int c = col0 + bj * HALF + n * 16;
                const pg8::f32x4 g2 = *(const pg8::f32x4*)(ln_g + c), b2 = *(const pg8::f32x4*)(ln_b + c), g1 = *(const pg8::f32x4*)(ln_g + c - 4 * BM), b1 = *(const pg8::f32x4*)(ln_b + c - 4 * BM);
#pragma unroll
                for (int ai = 0; ai < 2; ++ai)
#pragma unroll
                    for (int m = 0; m < 4; ++m) { const int rl = ai * HALF + wr * 64 + m * 16 + fr; const f32x2v sr = S[rl]; const size_t off = (size_t)(row0 + ai * HALF + m * 16) * DM + c;
                        const pg8::f32x4 z1 = *(const pg8::f32x4*)(out + off - 4 * BM);
                        *(pg8::f32x4*)(out + off) = (acc[ai][bj][m][n] - sr.x) * sr.y * g2 + b2;
                        acc[ai][bj][m][n] = (z1 - sr.x) * sr.y * g1 + b1; }
#pragma unroll
                for (int ai = 0; ai < 2; ++ai)
#pragma unroll
                    for (int m = 0; m < 4; ++m) { const size_t off = (size_t)(row0 + ai * HALF + m * 16) * DM + c; *(pg8::f32x4*)(out + off - 4 * BM) = acc[ai][bj][m][n]; } }
    }
};

__device__ __forceinline__ void p7_ln(Frame& F) {
    const int gw = F.vcu * NWAVES + F.wave, NGW = F.G * NWAVES;
    for (int row = 2 * gw; row < MX; row += 2 * NGW) {
        GAS f32x4* ra = (GAS f32x4*)(F.out + (size_t)row * DM) + F.lane; GAS f32x4* rb = ra + DM / 4;
        f32x4 va[8], vb[8]; float sa = 0.f, sb = 0.f;
#pragma unroll
        for (int j = 0; j < 8; ++j) { va[j] = ra[64 * j]; vb[j] = rb[64 * j]; }
#pragma unroll
        for (int j = 0; j < 8; ++j) { sa += (va[j].x + va[j].y) + (va[j].z + va[j].w); sb += (vb[j].x + vb[j].y) + (vb[j].z + vb[j].w); }
        const float ma = wave_sum(sa) * (1.f / DM), mb = wave_sum(sb) * (1.f / DM); float qa = 0.f, qb = 0.f;
#pragma unroll
        for (int j = 0; j < 8; ++j) { va[j] = va[j] - ma; vb[j] = vb[j] - mb; qa += (va[j].x * va[j].x + va[j].y * va[j].y) + (va[j].z * va[j].z + va[j].w * va[j].w); qb += (vb[j].x * vb[j].x + vb[j].y * vb[j].y) + (vb[j].z * vb[j].z + vb[j].w * vb[j].w); }
        const float rsa = 1.f / sqrtf(wave_sum(qa) * (1.f / DM) + LN_EPS), rsb = 1.f / sqrtf(wave_sum(qb) * (1.f / DM) + LN_EPS);
#pragma unroll
        for (int j = 0; j < 8; ++j) { const int k = 4 * F.lane + 256 * j; const f32x4 g = *(const f32x4*)(F.ln_g + k), bb = *(const f32x4*)(F.ln_b + k);
            ra[64 * j] = va[j] * rsa * g + bb; rb[64 * j] = vb[j] * rsb * g + bb; }
    }
}

struct Args { const float* in[16]; float* out; unsigned char* ws; int ph_lo, ph_hi, li, pad; };
__global__ void __launch_bounds__(NWAVES * 64, 2) mk_fwd(Args args) {
    extern __shared__ __attribute__((aligned(16))) unsigned char lds[];
    Frame F;
    F.lds = (LAS unsigned char*)lds;
    F.MISC = (volatile LAS unsigned*)(F.lds + MISC_OFF);
    F.tid = threadIdx.x; F.lane = F.tid & 63; F.wave = __builtin_amdgcn_readfirstlane(F.tid >> 6);
    F.G = gridDim.x; { const int bx = blockIdx.x; F.vcu = (F.G % 8 == 0) ? (bx % 8) * (F.G / 8) + bx / 8 : bx; }
    unsigned char* ws = args.ws;
    F.ctl = (gu32*)(ws + WS_CTL);
    F.x = args.in[0]; F.c = args.in[1]; F.ctx = args.in[2]; F.c_ctx = args.in[3]; F.w_mod = args.in[4]; F.b_mod = args.in[5]; F.w_in = args.in[6];
    F.conv_w = args.in[7]; F.conv_b = args.in[8]; F.hg_lb = args.in[9]; F.ml_gate_b = args.in[10]; F.hg_norm_w = args.in[11]; F.ml_norm_w = args.in[12];
    F.w_out = args.in[13]; F.ln_g = args.in[14]; F.ln_b = args.in[15]; F.out = args.out;
    F.modp = (float*)(ws + WS_MODP); F.gate = (float*)(ws + WS_GATE);
    F.QTF = (bf16*)(ws + WS_WINT); F.PE = (float*)(ws + WS_PE); F.MLS = (float*)(ws + WS_MLS); F.DEC = (float*)(ws + WS_DEC); F.MLW = (bf16*)(ws + WS_MLW); F.DQP = (float*)(ws + WS_DQP);
    F.WinT = (bf16*)(ws + WS_WINT); F.WoutT = (bf16*)(ws + WS_WOUTT); F.XN = (bf16*)(ws + WS_XN); F.U = (bf16*)(ws + WS_U);
    F.OAF = (bf16*)args.out; F.OAB = F.OAF + (size_t)MX * WA; F.HBF = F.OAB + (size_t)MX * WA; F.HBB = F.HBF + (size_t)MX * WB;
    for (int u = F.tid; u < (LDS_BYTES - LDSCTL_OFF) / 4; u += NT) ((LAS unsigned*)(F.lds + LDSCTL_OFF))[u] = 0u;
    __syncthreads();
    XcdBarrier bar; bar.bar = (unsigned*)(F.ctl + CW_BAR); bar.x = 0; bar.st = nullptr;
    if (MK_N_LAUNCHES == 1) bar = xcd_barrier_post((unsigned*)(F.ctl + CW_BAR), F.MISC + 8);
    const int lo = args.ph_lo, hi = args.ph_hi;
#ifndef PH_MASK
#define PH_MASK 255
#endif
#define PHON(k) ((PH_MASK >> (k)) & 1)
#ifndef DUP_MASK
#define DUP_MASK 0
#endif
#define DUP(k) ((DUP_MASK >> (k)) & 1)
#ifndef FUSE_LN
#define FUSE_LN 0
#endif
#ifndef DUP4S
#define DUP4S 0
#endif
#ifndef DUP4W
#define DUP4W 3
#endif
#ifndef DUP3W
#define DUP3W 7
#endif
#define IN(k) (lo <= (k) && (k) < hi)
#define SEAM(k) do { if (IN(k) && IN((k) + 1)) xcd_barrier(bar); } while (0)
    if (PHON(0) && IN(0)) { p0_prep(F); if (DUP(0)) p0_prep(F); } SEAM(0);
    if (PHON(1) && IN(1)) { p1_lnmod(F); if (DUP(1)) p1_lnmod(F); } SEAM(1);
    if (PHON(2) && IN(2)) { pg8::Gemm g{F.XN, F.WinT, MALL, NU, DM}; pg8::StaticOrder S; S.init(MALL, NU, F.G, (int)blockIdx.x);
        pg8::EpiBf16<0> E{F.U, NU, nullptr, 0, 0, 1.f};
        pg8::gemm_phase<pg8::EpiBf16<0>, pg8::StaticOrder, PG8_ALIGN, PG8_SP2>(F.lds + RING_OFF, g, S, E); } SEAM(2);
    if (PHON(3) && IN(3)) { if (DUP(3)) { if (DUP3W & 1) p3_hg_prep<true>(F); if (DUP3W & 2) p3_conv(F); if (DUP3W & 4) p3_ml_scalars(F); } p3_conv(F); if (HG_MFMA) p3_hg_prep<false>(F); if (ML_MFMA) p3_ml_scalars(F); xcd_barrier(bar); p3b_ml_scores(F); if (DUP(6)) p3b_ml_scores(F); } SEAM(3);
    if (PHON(4) && IN(4)) { if (DUP(4)) p4_scan<DUP4W, DUP4S>(F); p4_scan<3>(F); } SEAM(4);
    if (PHON(5) && IN(5)) { p5_combine(F); if (DUP(5)) p5_combine(F); if (DUP(7)) { xcd_barrier(bar); xcd_barrier(bar); xcd_barrier(bar); xcd_barrier(bar); } } SEAM(5);
    if (PHON(6) && IN(6)) { pg8::Gemm g{F.XN, F.WoutT, MX, DM, DM}; pg8::StaticOrder S; S.init(MX, DM, F.G, (int)blockIdx.x);
        if (F.G == 256 && FUSE_LN) { PanelOrder PO{F.vcu}; EpiLnFused E{F.x, F.gate, F.out, F.ln_g, F.ln_b, (unsigned long long*)(args.ws + WS_XB), (unsigned*)(F.ctl + CW_PANEL)};
            pg8::gemm_phase<EpiLnFused, PanelOrder, PG8_ALIGN, PG8_SP2>(F.lds + RING_OFF, g, PO, E); }
        else { EpiResid E{F.x, F.gate, F.out};
            pg8::gemm_phase<EpiResid, pg8::StaticOrder, PG8_ALIGN, PG8_SP2>(F.lds + RING_OFF, g, S, E); } }
    if (!(F.G == 256 && FUSE_LN)) { SEAM(6); if (PHON(7) && IN(7)) { p7_ln(F); } }
#undef IN
#undef SEAM
}

extern "C" void kernel_launch(void* const* d_in, const int* in_sizes, int n_in, void* d_out, int out_size, void* d_ws, size_t ws_size, hipStream_t stream) {
    static int grid = 0;
    if (grid == 0) {
        if (n_in != 16 || out_size != MX * DM || ws_size < WS_END) { fprintf(stderr, "kernel_launch: unexpected shapes (n_in %d out %d ws %zu)\n", n_in, out_size, ws_size); grid = -1; return; }
        int dev = 0, cus = 0, per_cu = 0;
        if (hipGetDevice(&dev) != hipSuccess || hipDeviceGetAttribute(&cus, hipDeviceAttributeMultiprocessorCount, dev) != hipSuccess) { grid = -1; return; }
        if (hipFuncSetAttribute((const void*)mk_fwd, hipFuncAttributeMaxDynamicSharedMemorySize, LDS_BYTES) != hipSuccess) { fprintf(stderr, "kernel_launch: hipFuncSetAttribute failed\n"); grid = -1; return; }
        if (hipOccupancyMaxActiveBlocksPerMultiprocessor(&per_cu, (const void*)mk_fwd, NT, LDS_BYTES) != hipSuccess || per_cu < 1) { fprintf(stderr, "kernel_launch: occupancy query says %d\n", per_cu); per_cu = 1; }
        (void)hipGetLastError();
        grid = cus;
    }
    if (grid < 0) return;
    if (hipMemsetAsync((char*)d_ws + WS_CTL, 0, CTL_ZERO_BYTES, stream) != hipSuccess) { fprintf(stderr, "kernel_launch: memset failed\n"); return; }
    Args a{};
    for (int i = 0; i < 16; ++i) a.in[i] = (const float*)d_in[i];
    a.out = (float*)d_out; a.ws = (unsigned char*)d_ws;
    for (int li = 0; li < MK_N_LAUNCHES; ++li) {
        a.ph_lo = (MK_N_LAUNCHES == 1) ? 0 : li; a.ph_hi = (MK_N_LAUNCHES == 1) ? N_PHASES : li + 1; a.li = li;
        hipLaunchKernelGGL(mk_fwd, dim3(grid), dim3(NT), LDS_BYTES, stream, a);
        const hipError_t le = hipPeekAtLastError();
        if (le != hipSuccess) { fprintf(stderr, "kernel_launch: launch %d failed: %s\n", li, hipGetErrorName(le)); break; }
    }
}
```

```cpp
#include <hip/hip_runtime.h>
#include <cstdio>
#include <cstdint>
namespace pg8 {
#define PG8_LAS __attribute__((address_space(3)))
typedef unsigned short bf16_t;
typedef short bf16x8 __attribute__((ext_vector_type(8)));
typedef float f32x4 __attribute__((ext_vector_type(4)));
typedef unsigned u32x4 __attribute__((ext_vector_type(4)));
constexpr int BM = 256, BK = 64, HALF = 128, HTB = HALF * BK * 2  , STAGE_BYTES = 8 * HTB, NXCD = 8, WGM = 4;

__host__ __device__ __forceinline__ int lds_byte(int r, int c) { const int st = (r >> 4) * 2 + (c >> 5), rr = r & 15, cc = c & 31, ob = rr * 64 + cc * 2; return st * 1024 + (ob ^ (((ob >> 9) & 1) << 5)); }
__host__ __device__ __forceinline__ void stage_rc(int b, int& R, int& C) { const int st = b / 1024, sb = b % 1024, swz = sb ^ (((sb >> 9) & 1) << 5); R = (st >> 1) * 16 + swz / 64; C = (st & 1) * 32 + (swz % 64) / 2; }
__host__ __device__ __forceinline__ int perm32(int rho) { const int n = rho >> 4, i = rho & 15; return 8 * (i >> 2) + 4 * n + (i & 3); }

struct Unit { int pm, pn; };
struct Gemm { const bf16_t* A; const bf16_t* Bt; int M, N, K; };

struct StaticOrder {
    int nM, nN, nwg, G, c;
    __host__ __device__ void init(int M, int N, int G_, int c_) { nM = M / BM; nN = N / BM; nwg = nM * nN; G = G_; c = c_; }
    __host__ __device__ bool next(int i, Unit& u) const {
        const long L = (long)i * G + c; if (L >= nwg) return false;
        int wgid = (int)L; { const int q = nwg / NXCD, r = nwg % NXCD, xcd = wgid % NXCD, off = wgid / NXCD; wgid = (xcd < r ? xcd * (q + 1) : r * (q + 1) + (xcd - r) * q) + off; }
        const int nig = WGM * nN, gid = wgid / nig, fm = gid * WGM, gsz = (nM - fm) < WGM ? (nM - fm) : WGM;
        u.pm = fm + ((wgid % nig) % gsz); u.pn = (wgid % nig) / gsz; return true;
    }
    __device__ __forceinline__ void a_ready(const Unit&) const {}
    __device__ __forceinline__ void done(const Unit&) const {}
};

__device__ __forceinline__ unsigned cvt_pk_bf16(float lo, float hi) { unsigned r; asm volatile("v_cvt_pk_bf16_f32 %0, %1, %2" : "=v"(r) : "v"(lo), "v"(hi)); return r; }
typedef float f32x2 __attribute__((ext_vector_type(2)));
__device__ __forceinline__ f32x2 gelu_pk(f32x2 v) {
    const f32x2 av = __builtin_elementwise_abs(v), d = av * 0.2316418882f + 1.0f;
    f32x2 t; t.x = __builtin_amdgcn_rcpf(d.x); t.y = __builtin_amdgcn_rcpf(d.y);
    f32x2 q = t * 0.5307027145f + (-0.7265760135f); q = q * t + 0.7107068705f; q = q * t + (-0.142248368f); q = q * t + 0.127414796f; q = q * t;
    const f32x2 s = (v * v) * (-0.72134752044f);
    f32x2 e; e.x = __builtin_amdgcn_exp2f(s.x); e.y = __builtin_amdgcn_exp2f(s.y);
    const f32x2 m = v * (q * e), r = v - m;
    f32x2 o; o.x = v.x < 0.f ? m.x : r.x; o.y = v.y < 0.f ? m.y : r.y; return o;
}

template <int ACT  > struct EpiBf16 {
    static constexpr bool PERM = true, AFTER_DRAIN = false; static_assert(ACT == 0 || ACT == 1, "EpiBf16: ACT is 0 (none) or 1 (gelu_pk)");
    bf16_t* O; int ldc; const float* bias; int split_cols; size_t split_stride; float scale0;
    __device__ __forceinline__ void operator()(const f32x4 (&acc)[2][2][4][2], const Unit& u, int wr, int wc, int fr, int fq) const {
        const int row0 = u.pm * BM + wr * 64 + fr; int colt = u.pn * BM; bf16_t* base = O;
        float sc = 1.f; if (split_cols) { const int t = colt / split_cols; base += (size_t)t * split_stride; colt -= t * split_cols; if (t == 0) sc = scale0; }
        const int col0 = colt + wc * 32 + 8 * fq, bcol0 = u.pn * BM + wc * 32 + 8 * fq;
        f32x4 bv[2][2];
#pragma unroll
        for (int bj = 0; bj < 2; ++bj)
#pragma unroll
            for (int n = 0; n < 2; ++n) bv[bj][n] = bias ? *(const f32x4*)(bias + bcol0 + bj * HALF + 4 * n) : (f32x4){0.f, 0.f, 0.f, 0.f};
#pragma unroll
        for (int ai = 0; ai < 2; ++ai)
#pragma unroll
            for (int m = 0; m < 4; ++m) { bf16_t* rowp = base + (size_t)(row0 + ai * HALF + m * 16) * ldc + col0;
#pragma unroll
                for (int bj = 0; bj < 2; ++bj) { f32x4 v0 = acc[ai][bj][m][0] + bv[bj][0], v1 = acc[ai][bj][m][1] + bv[bj][1];
                    if (ACT == 1) { f32x2 a = gelu_pk((f32x2){v0[0], v0[1]}), b = gelu_pk((f32x2){v0[2], v0[3]}), c = gelu_pk((f32x2){v1[0], v1[1]}), d = gelu_pk((f32x2){v1[2], v1[3]});
                        v0 = (f32x4){a.x, a.y, b.x, b.y}; v1 = (f32x4){c.x, c.y, d.x, d.y}; }
                    v0 = v0 * sc; v1 = v1 * sc; u32x4 w; w.x = cvt_pk_bf16(v0[0], v0[1]); w.y = cvt_pk_bf16(v0[2], v0[3]); w.z = cvt_pk_bf16(v1[0], v1[1]); w.w = cvt_pk_bf16(v1[2], v1[3]);
                    *(u32x4*)(rowp + bj * HALF) = w; } }
    }
};
template <class Epi, class Sched, bool ALIGN_EPI = false, bool SP2 = false>
__device__ __forceinline__ void gemm_phase(PG8_LAS unsigned char* lds, const Gemm g, const Sched& S, const Epi& E) {
    const int tid = threadIdx.x, wid = __builtin_amdgcn_readfirstlane(tid >> 6), lane = tid & 63, wr = wid >> 2, wc = wid & 3, fr = lane & 15, fq = lane >> 4;
    const int K = g.K, nt = K / BK;
    unsigned voffA[2], voffB[2];
#pragma unroll
    for (int i = 0; i < 2; ++i) { int R, C; stage_rc(tid * 16 + i * 8192, R, C); const int Rb = Epi::PERM ? ((R & ~31) + perm32(R & 31)) : R;
        voffA[i] = (unsigned)(R * K + C) * 2u; voffB[i] = (unsigned)(Rb * K + C) * 2u; }
    const size_t kstep = (size_t)(BK * 2);
    const size_t hstep = (size_t)HALF * K * 2;
    const size_t tstep = 2 * hstep;
    const unsigned ldsw = (unsigned)wid * 1024u;
    const int aoff = lds_byte(wr * 64 + fr, fq * 8), boff = lds_byte(wc * 32 + fr, fq * 8);
#define PG8_SA(b, h) (((b) * 2 + (h)) * HTB)
#define PG8_SB(b, h) ((4 + (b) * 2 + (h)) * HTB)
#define PG8_STAGE(bufoff, gbase, voff) do { _Pragma("unroll") for (int _i = 0; _i < 2; ++_i) \
        __builtin_amdgcn_global_load_lds((const unsigned*)((const char*)(gbase) + (voff)[_i]), (PG8_LAS unsigned*)(lds + (bufoff) + ldsw + _i * 8192), 16, 0, 0); } while (0)
#define PG8_LDA(dst, b, h) do { _Pragma("unroll") for (int m = 0; m < 4; ++m) _Pragma("unroll") for (int k = 0; k < 2; ++k) dst[m][k] = *(const PG8_LAS bf16x8*)(lds + PG8_SA(b, h) + aoff + m * 2048 + k * 1024); } while (0)
#define PG8_LDB(dst, b, h) do { _Pragma("unroll") for (int n = 0; n < 2; ++n) _Pragma("unroll") for (int k = 0; k < 2; ++k) dst[n][k] = *(const PG8_LAS bf16x8*)(lds + PG8_SB(b, h) + boff + n * 2048 + k * 1024); } while (0)
#define PG8_MMA(ai, bj, At, Bt) do { __builtin_amdgcn_s_setprio(1); _Pragma("unroll") for (int m = 0; m < 4; ++m) _Pragma("unroll") for (int n = 0; n < 2; ++n) _Pragma("unroll") for (int k = 0; k < 2; ++k) \
        acc[ai][bj][m][n] = __builtin_amdgcn_mfma_f32_16x16x32_bf16(Bt[n][k], At[m][k], acc[ai][bj][m][n], 0, 0, 0); __builtin_amdgcn_s_setprio(0); } while (0)
#define PG8_WAIT_V(n) asm volatile("s_waitcnt vmcnt(" #n ")" ::: "memory")
#define PG8_WAIT_L(n) asm volatile("s_waitcnt lgkmcnt(" #n ")" ::: "memory")
#define PG8_BAR __builtin_amdgcn_s_barrier()
#define PG8_SCHED __builtin_amdgcn_sched_barrier(0)
    Unit cur, nxt; int ui = 0;
    if (!S.next(0, cur)) return;
    f32x4 acc[2][2][4][2];
#pragma unroll
    for (int a = 0; a < 2; ++a)
#pragma unroll
        for (int b = 0; b < 2; ++b)
#pragma unroll
            for (int m = 0; m < 4; ++m)
#pragma unroll
                for (int n = 0; n < 2; ++n) acc[a][b][m][n] = (f32x4){0.f, 0.f, 0.f, 0.f};
    bf16x8 At[4][2], B0[2][2], B1[2][2];
    const char* cA = (const char*)g.A + (size_t)cur.pm * tstep; const char* cB = (const char*)g.Bt + (size_t)cur.pn * tstep;
    S.a_ready(cur);
    if constexpr (SP2) {
        PG8_STAGE(PG8_SB(0, 0), cB, voffB); PG8_STAGE(PG8_SB(0, 1), cB + hstep, voffB); PG8_STAGE(PG8_SA(0, 0), cA, voffA); PG8_STAGE(PG8_SA(0, 1), cA + hstep, voffA);
        if (wr == 1) PG8_BAR;
        PG8_WAIT_V(2); PG8_BAR;
        PG8_STAGE(PG8_SB(1, 0), cB + kstep, voffB); PG8_STAGE(PG8_SA(1, 0), cA + kstep, voffA); PG8_STAGE(PG8_SB(1, 1), cB + hstep + kstep, voffB);
        PG8_WAIT_V(6); PG8_BAR;
    } else {
        PG8_STAGE(PG8_SB(0, 0), cB, voffB); PG8_STAGE(PG8_SA(0, 0), cA, voffA); PG8_STAGE(PG8_SB(0, 1), cB + hstep, voffB); PG8_STAGE(PG8_SA(0, 1), cA + hstep, voffA);
        if (wr == 1) PG8_BAR;
        PG8_WAIT_V(4); PG8_BAR;
        PG8_STAGE(PG8_SB(1, 0), cB + kstep, voffB); PG8_STAGE(PG8_SA(1, 0), cA + kstep, voffA); PG8_STAGE(PG8_SB(1, 1), cB + hstep + kstep, voffB);
        PG8_WAIT_V(6); PG8_BAR;
    }
    for (;;) {
        const bool has_next = S.next(ui + 1, nxt);
        const char* nA = has_next ? (const char*)g.A + (size_t)nxt.pm * tstep : cA; const char* nB = has_next ? (const char*)g.Bt + (size_t)nxt.pn * tstep : cB;
        for (int t = 0; t < nt; t += 2) {
            const bool last = (t == nt - 2);
            const char* a1 = cA + (size_t)(t + 1) * kstep;
            const char* a2 = last ? nA : cA + (size_t)(t + 2) * kstep; const char* b2 = last ? nB : cB + (size_t)(t + 2) * kstep;
            const char* a3 = a2 + kstep; const char* b3 = b2 + kstep;
            if (last && has_next) S.a_ready(nxt);
            if constexpr (SP2) {
            PG8_LDB(B0, 0, 0); PG8_LDB(B1, 0, 1); PG8_SCHED; PG8_LDA(At, 0, 0); PG8_STAGE(PG8_SA(1, 1), a1 + hstep, voffA);
            PG8_WAIT_V(8); PG8_WAIT_L(0); PG8_BAR; PG8_MMA(0, 0, At, B0); PG8_MMA(0, 1, At, B1); PG8_BAR; PG8_SCHED;
            PG8_LDA(At, 0, 1); PG8_STAGE(PG8_SB(0, 0), b2, voffB); PG8_STAGE(PG8_SB(0, 1), b2 + hstep, voffB); PG8_STAGE(PG8_SA(0, 0), a2, voffA);
            PG8_WAIT_V(8); PG8_WAIT_L(0); PG8_BAR; PG8_MMA(1, 0, At, B0); PG8_MMA(1, 1, At, B1); PG8_BAR; PG8_SCHED;
            PG8_LDB(B0, 1, 0); PG8_LDB(B1, 1, 1); PG8_SCHED; PG8_LDA(At, 1, 0); PG8_STAGE(PG8_SA(0, 1), a2 + hstep, voffA);
            PG8_WAIT_V(8); PG8_WAIT_L(0); PG8_BAR; PG8_MMA(0, 0, At, B0); PG8_MMA(0, 1, At, B1); PG8_BAR; PG8_SCHED;
            PG8_LDA(At, 1, 1); PG8_STAGE(PG8_SB(1, 0), b3, voffB); PG8_STAGE(PG8_SB(1, 1), b3 + hstep, voffB); PG8_STAGE(PG8_SA(1, 0), a3, voffA);
            PG8_WAIT_V(8); PG8_WAIT_L(0); PG8_BAR; PG8_MMA(1, 0, At, B0); PG8_MMA(1, 1, At, B1); PG8_BAR; PG8_SCHED;
            } else {
            PG8_LDB(B0, 0, 0); PG8_SCHED; PG8_LDA(At, 0, 0); PG8_STAGE(PG8_SA(1, 1), a1 + hstep, voffA);
            PG8_WAIT_L(8); PG8_BAR; PG8_WAIT_L(0); PG8_MMA(0, 0, At, B0); PG8_BAR; PG8_SCHED;
            PG8_LDB(B1, 0, 1); PG8_STAGE(PG8_SB(0, 0), b2, voffB);
            PG8_BAR; PG8_WAIT_L(0); PG8_MMA(0, 1, At, B1); PG8_BAR;
            PG8_LDA(At, 0, 1); PG8_STAGE(PG8_SA(0, 0), a2, voffA);
            PG8_BAR; PG8_WAIT_L(0); PG8_MMA(1, 0, At, B0); PG8_BAR; PG8_SCHED;
            PG8_STAGE(PG8_SB(0, 1), b2 + hstep, voffB);
            PG8_WAIT_V(6); PG8_BAR; PG8_MMA(1, 1, At, B1); PG8_BAR;
            PG8_LDB(B0, 1, 0); PG8_SCHED; PG8_LDA(At, 1, 0); PG8_STAGE(PG8_SA(0, 1), a2 + hstep, voffA);
            PG8_WAIT_L(8); PG8_BAR; PG8_WAIT_L(0); PG8_MMA(0, 0, At, B0); PG8_BAR; PG8_SCHED;
            PG8_LDB(B1, 1, 1); PG8_STAGE(PG8_SB(1, 0), b3, voffB);
            PG8_BAR; PG8_WAIT_L(0); PG8_MMA(0, 1, At, B1); PG8_BAR;
            PG8_LDA(At, 1, 1); PG8_STAGE(PG8_SA(1, 0), a3, voffA);
            PG8_BAR; PG8_WAIT_L(0); PG8_MMA(1, 0, At, B0); PG8_BAR; PG8_SCHED;
            PG8_STAGE(PG8_SB(1, 1), b3 + hstep, voffB);
            PG8_WAIT_V(6); PG8_BAR; PG8_MMA(1, 1, At, B1); PG8_BAR;
            }
        }
        if constexpr (ALIGN_EPI) { if (wr == 0) PG8_BAR; }
        if constexpr (!Epi::AFTER_DRAIN) { E(acc, cur, wr, wc, fr, fq); S.done(cur); }
        else { if (has_next) { E(acc, cur, wr, wc, fr, fq); S.done(cur); } }
        if (!has_next) break;
#pragma unroll
        for (int a = 0; a < 2; ++a)
#pragma unroll
            for (int b = 0; b < 2; ++b)
#pragma unroll
                for (int m = 0; m < 4; ++m)
#pragma unroll
                    for (int n = 0; n < 2; ++n) acc[a][b][m][n] = (f32x4){0.f, 0.f, 0.f, 0.f};
        cur = nxt; cA = nA; cB = nB; ++ui;
        if constexpr (ALIGN_EPI) { if (wr == 1) PG8_BAR; }
    }
    PG8_WAIT_V(0);
    if constexpr (!ALIGN_EPI) { if (wr == 0) PG8_BAR; }
    PG8_BAR;
    if constexpr (Epi::AFTER_DRAIN) { E.fused(acc, cur, wr, wc, fr, fq, lds, wid, lane); S.done(cur); }
#undef PG8_SA
#undef PG8_SB
#undef PG8_STAGE
#undef PG8_LDA
#undef PG8_LDB
#undef PG8_MMA
#undef PG8_WAIT_V
#undef PG8_WAIT_L
#undef PG8_BAR
#undef PG8_SCHED
}
}

#ifndef PG8_SP2
#define PG8_SP2 true
#endif
#ifndef PG8_ALIGN
#define PG8_ALIGN true
#endif
#define GAS __attribute__((address_space(1)))
#define LAS __attribute__((address_space(3)))
typedef unsigned short bf16;
typedef unsigned v4u __attribute__((ext_vector_type(4)));
typedef float f32x4 __attribute__((ext_vector_type(4)));
typedef short bf16x8 __attribute__((ext_vector_type(8)));
typedef GAS unsigned gu32;
typedef GAS unsigned long long gu64;
#define RLX_AGENT __ATOMIC_RELAXED, __HIP_MEMORY_SCOPE_AGENT
#define LDS_WAIT() asm volatile("s_waitcnt lgkmcnt(0)" ::: "memory")
#define VM_WAIT() asm volatile("s_waitcnt vmcnt(0)" ::: "memory")
__device__ __forceinline__ unsigned long long rt() { return __builtin_amdgcn_s_memrealtime(); }
__device__ __forceinline__ unsigned f2bf(float f) { unsigned u = __builtin_bit_cast(unsigned, f); return (u + 0x7fffu + ((u >> 16) & 1u)) >> 16; }
__device__ __forceinline__ unsigned pk2(float lo, float hi) { return f2bf(lo) | (f2bf(hi) << 16); }

#define XB_TMO      128
#define XB_XCNT(j)  (256  + 64 * (j))
#define XB_XSUB(j)  (1280 + 64 * (j))
#define XB_XGEN(j)  (2304 + 64 * (j))
#define XB_TOP      3328
#define XB_TOPGEN   3392
#define XCD_BAR_WORDS 3456
#define XB_SPIN_CAP (1u << 18)

__device__ __forceinline__ unsigned xb_ld(unsigned* p)              { return __hip_atomic_load(p, __ATOMIC_RELAXED, __HIP_MEMORY_SCOPE_AGENT); }
__device__ __forceinline__ unsigned xb_add(unsigned* p, unsigned v) { return __hip_atomic_fetch_add(p, v, __ATOMIC_RELAXED, __HIP_MEMORY_SCOPE_AGENT); }
__device__ __forceinline__ unsigned xb_xcc_id() { return (unsigned)__builtin_amdgcn_s_getreg((3 << 11) | 20) & 0xFu; }
#define XB_SPIN(cond, bar) do { unsigned _sp = 0; while (cond) { __builtin_amdgcn_s_sleep(1); \
    if ((++_sp & 255u) == 0u) { if (xb_ld(&(bar)[XB_TMO])) break; if (_sp > XB_SPIN_CAP) { atomicAdd(&(bar)[XB_TMO], 1u); break; } } } } while (0)

struct XcdBarrier {
    unsigned* bar; unsigned x;
    volatile LAS unsigned* st;
};

__device__ __forceinline__ XcdBarrier xcd_barrier_post(unsigned* bar, volatile LAS unsigned* st) {
    XcdBarrier b; b.bar = bar; b.x = xb_xcc_id(); b.st = st;
    if (threadIdx.x == 0) (void)xb_add(&bar[XB_XCNT(b.x)], 1u);
    return b;
}
__device__ __forceinline__ void xcd_barrier_complete(unsigned* bar, unsigned x, unsigned& nloc, unsigned& nx) {
    const unsigned G = gridDim.x * gridDim.y * gridDim.z;
    unsigned sum, cnt, mine, sp = 0u;
    for (;;) {
        sum = 0u; cnt = 0u; mine = 0u;
#pragma unroll
        for (unsigned j = 0; j < 16; ++j) { const unsigned c = xb_ld(&bar[XB_XCNT(j)]); sum += c; cnt += (c > 0u) ? 1u : 0u; mine = (j == x) ? c : mine; }
        if (sum == G) break;
        __builtin_amdgcn_s_sleep(1);
        if ((++sp & 255u) == 0u) { if (xb_ld(&bar[XB_TMO])) break; if (sp > XB_SPIN_CAP) { atomicAdd(&bar[XB_TMO], 1u); break; } }
    }
    nloc = mine > 0u ? mine : 1u; nx = cnt > 0u ? cnt : 1u;
}

__device__ __forceinline__ void xcd_barrier(const XcdBarrier& b) {
    asm volatile("s_waitcnt vmcnt(0)" ::: "memory");
    __syncthreads();
    if (threadIdx.x == 0) {
        unsigned* bar = b.bar;
        __builtin_amdgcn_s_waitcnt(0);
        unsigned nloc = b.st[0], nx = b.st[1];
        if (nloc == 0u) { xcd_barrier_complete(bar, b.x, nloc, nx); b.st[0] = nloc; b.st[1] = nx; }
        const unsigned old = xb_add(&bar[XB_XSUB(b.x)], 1u);
        const unsigned gen = old / nloc;
        if (old + 1u == (gen + 1u) * nloc) {
            __builtin_amdgcn_fence(__ATOMIC_RELEASE, "agent");
            asm volatile("s_waitcnt vmcnt(0)" ::: "memory");
            const unsigned og = xb_add(&bar[XB_TOP], 1u);
            const unsigned tg = og / nx;
            if (og + 1u == (tg + 1u) * nx) xb_add(&bar[XB_TOPGEN], 1u);
            else XB_SPIN(xb_ld(&bar[XB_TOPGEN]) == tg, bar);
            __builtin_amdgcn_fence(__ATOMIC_ACQUIRE, "agent");
            xb_add(&bar[XB_XGEN(b.x)], 1u);
            asm volatile("s_waitcnt vmcnt(0)" ::: "memory");
        } else {
            XB_SPIN(xb_ld(&bar[XB_XGEN(b.x)]) == gen, bar);
            __builtin_amdgcn_fence(__ATOMIC_ACQUIRE, "agent");
            asm volatile("s_waitcnt vmcnt(0)" ::: "memory");
        }
    }
    __syncthreads();
}
constexpr int NWAVES = 8, NT = NWAVES * 64;
constexpr int BATCH = 4, SEQ = 4096, DM = 2048, CTXL = 256;
constexpr int MX = BATCH * SEQ, MC = BATCH * CTXL, MALL = MX + MC;
constexpr int WA = 1024, WB = 1024, NIN = 10256, NU = 10496;
constexpr int C_AQ = 0, C_AFF = 1024, C_AFB = 2048, C_AI = 3072, C_AZ = 4096, C_BQK = 5120, C_BV = 7168, C_BO = 8192, C_BZ = 9216, C_BG = 10240;
constexpr int HGH = 8, HGD = 128, MLH = 4, MLD = 256;
constexpr float ALPHA = 1.189207115002721f;
constexpr float LN_EPS = 1e-5f, NORM_EPS = 1e-6f;
constexpr int NMOD = 3 * DM;

#ifndef MK_N_LAUNCHES
#define MK_N_LAUNCHES 1
#endif
constexpr int N_PHASES = 8;

constexpr size_t MiB = 1u << 20;
constexpr size_t WS_CTL = 0, CTL_ZERO_BYTES = 1 * MiB;
constexpr size_t WS_MODP = 1 * MiB;
constexpr size_t WS_GATE = 3 * MiB;
constexpr size_t WS_WINT = 4 * MiB;
constexpr size_t WS_WOUTT = 45 * MiB;
constexpr size_t WS_XN = 53 * MiB;
constexpr size_t WS_U = 121 * MiB;
constexpr size_t WS_PE = 470 * MiB, WS_MLS = 473 * MiB, WS_DEC = 478 * MiB;
constexpr size_t WS_MLW = 479 * MiB;
constexpr size_t WS_DQP = 496 * MiB;
constexpr size_t WS_XB = 498 * MiB;
constexpr size_t WS_END = 502 * MiB;
static_assert(WS_WINT + (size_t)NU * DM * 2 <= WS_WOUTT && WS_WOUTT + (size_t)DM * DM * 2 <= WS_XN && WS_XN + (size_t)MALL * DM * 2 <= WS_U && WS_U + (size_t)MALL * NU * 2 <= WS_END, "d_ws map");
constexpr int CW_TMO = 0, CW_BAR = 4096, CW_PANEL = 16384;

constexpr int RING_OFF = 0, RING_BYTES = 131072;
constexpr int LDS_BYTES = 163840;
constexpr int LDSCTL_OFF = LDS_BYTES - 1024, MISC_OFF = LDSCTL_OFF + 320;

struct Frame {
    LAS unsigned char* lds;
    volatile LAS unsigned* MISC;
    gu32* ctl;
    int tid, lane, wave, vcu, G;
    const float *x, *c, *ctx, *c_ctx, *w_mod, *b_mod, *w_in, *conv_w, *conv_b, *hg_lb, *ml_gate_b, *hg_norm_w, *ml_norm_w, *w_out, *ln_g, *ln_b;
    float* out;
    float *modp, *gate;
    bf16 *WinT, *WoutT, *XN, *U;
    bf16 *QTF, *MLW; float *PE, *MLS, *DEC, *DQP;
    bf16 *OAF, *OAB, *HBF, *HBB;
};

typedef float f32x2_t __attribute__((ext_vector_type(2)));
typedef __bf16 bf16x2_t __attribute__((ext_vector_type(2)));
__device__ __forceinline__ unsigned pkbf(float a, float b) { const f32x2_t v = {a, b}; return __builtin_bit_cast(unsigned, __builtin_convertvector(v, bf16x2_t)); }
__device__ __forceinline__ float bf2f(unsigned short u) { return __builtin_bit_cast(float, (unsigned)u << 16); }
__device__ __forceinline__ float lo2f(unsigned u) { return __builtin_bit_cast(float, u << 16); }
__device__ __forceinline__ float hi2f(unsigned u) { return __builtin_bit_cast(float, u & 0xffff0000u); }
__device__ __forceinline__ float siluf(float v) { return v / (1.f + __expf(-v)); }
__device__ __forceinline__ float sigmf(float v) { return 1.f / (1.f + __expf(-v)); }
__device__ __forceinline__ float wave_sum(float v) {
#pragma unroll
    for (int o = 1; o < 64; o <<= 1) v += __shfl_xor(v, o);
    return v;
}

__device__ __forceinline__ void transpose_item(const float* W, int ldw, int nvalid, int K, bf16* WT, LAS float* scr, int kb, int nb, int lane) {
    const int k0 = 64 * kb, n0 = 32 * nb; const int n_l = n0 + (lane & 31);
#pragma unroll 8
    for (int i = 0; i < 32; ++i) { const int kk = 2 * i + (lane >> 5); scr[kk * 33 + (lane & 31)] = n_l < nvalid ? W[(size_t)(k0 + kk) * ldw + n_l] : 0.f; }
    LDS_WAIT(); asm volatile("" ::: "memory");
    const int c = lane & 7;
#pragma unroll
    for (int j = 0; j < 4; ++j) { const int n = (lane >> 3) + 8 * j; const LAS float* s = scr + (8 * c) * 33 + n;
        v4u o; o.x = pk2(s[0 * 33], s[1 * 33]); o.y = pk2(s[2 * 33], s[3 * 33]); o.z = pk2(s[4 * 33], s[5 * 33]); o.w = pk2(s[6 * 33], s[7 * 33]);
        *(GAS v4u*)(WT + (size_t)(n0 + n) * K + k0 + 8 * c) = o; }
    LDS_WAIT(); asm volatile("" ::: "memory");
}
constexpr int KS2 = 2;
__device__ __forceinline__ void p0_prep(Frame& F) {
    LAS float* scr = (LAS float*)(F.lds + RING_OFF + F.wave * 16384);
    LAS float* red = (LAS float*)(F.lds + RING_OFF + 131072);
    for (int it = F.vcu; it < (NMOD / 64) * KS2; it += F.G) {
        const int cg = it >> 1, kh2 = it & 1, n = cg * 64 + F.lane, k0 = kh2 * 1024 + F.wave * 128;
#pragma unroll
        for (int rr = 0; rr < 5; ++rr)
#pragma unroll
            for (int j = 0; j < 2; ++j) { const int k = k0 + F.lane + 64 * j; const float v = rr < 4 ? F.c[rr * DM + k] : F.c_ctx[k]; scr[rr * 128 + F.lane + 64 * j] = siluf(v); }
        LDS_WAIT(); asm volatile("" ::: "memory");
        float a0 = 0.f, a1 = 0.f, a2 = 0.f, a3 = 0.f, a4 = 0.f;
#pragma unroll 16
        for (int k = 0; k < 128; ++k) { const float w = F.w_mod[(size_t)(k0 + k) * NMOD + n];
            a0 += scr[k] * w; a1 += scr[128 + k] * w; a2 += scr[256 + k] * w; a3 += scr[384 + k] * w; a4 += scr[512 + k] * w; }
        LAS float* rp = red + F.wave * 320 + F.lane; rp[0] = a0; rp[64] = a1; rp[128] = a2; rp[192] = a3; rp[256] = a4;
        __syncthreads();
        if (F.tid < 320) { float sacc = 0.f;
#pragma unroll
            for (int ww = 0; ww < 8; ++ww) sacc += red[ww * 320 + F.tid];
            const int rr = F.tid >> 6, nn = cg * 64 + (F.tid & 63);
            F.modp[((size_t)kh2 * 5 + rr) * NMOD + nn] = sacc + (kh2 == 0 ? F.b_mod[nn] : 0.f); }
        __syncthreads();
    }
    const int gw = F.vcu * NWAVES + F.wave, NGW = F.G * NWAVES;
    constexpr int NB_IN = NU / 32, I_IN = (DM / 64) * NB_IN, NB_OUT = DM / 32, I_OUT = (DM / 64) * NB_OUT;
    for (int it = gw; it < I_IN + I_OUT; it += NGW) {
        int r = it;
        if (r < I_IN) { transpose_item(F.w_in, NIN, NIN, DM, F.WinT, scr, r / NB_IN, r % NB_IN, F.lane); continue; } r -= I_IN;
        transpose_item(F.w_out, DM, DM, DM, F.WoutT, scr, r / NB_OUT, r % NB_OUT, F.lane);
    }
}

__device__ __forceinline__ void ln_mod_row2(Frame& F, const float* xa, const float* xb, bf16* oa, bf16* ob, const LAS float* shift, const LAS float* scale) {
    const GAS f32x4* ra = (const GAS f32x4*)xa + F.lane; const GAS f32x4* rb = (const GAS f32x4*)xb + F.lane;
    f32x4 va[8], vb[8]; float sa = 0.f, sb = 0.f;
#pragma unroll
    for (int j = 0; j < 8; ++j) { va[j] = ra[64 * j]; vb[j] = rb[64 * j]; }
#pragma unroll
    for (int j = 0; j < 8; ++j) { sa += (va[j].x + va[j].y) + (va[j].z + va[j].w); sb += (vb[j].x + vb[j].y) + (vb[j].z + vb[j].w); }
    const float ma = wave_sum(sa) * (1.f / DM), mb = wave_sum(sb) * (1.f / DM); float qa = 0.f, qb = 0.f;
#pragma unroll
    for (int j = 0; j < 8; ++j) { va[j] = va[j] - ma; vb[j] = vb[j] - mb; qa += (va[j].x * va[j].x + va[j].y * va[j].y) + (va[j].z * va[j].z + va[j].w * va[j].w); qb += (vb[j].x * vb[j].x + vb[j].y * vb[j].y) + (vb[j].z * vb[j].z + vb[j].w * vb[j].w); }
    const float rsa = 1.f / sqrtf(wave_sum(qa) * (1.f / DM) + LN_EPS), rsb = 1.f / sqrtf(wave_sum(qb) * (1.f / DM) + LN_EPS);
    GAS unsigned long long* o8a = (GAS unsigned long long*)oa + F.lane; GAS unsigned long long* o8b = (GAS unsigned long long*)ob + F.lane;
#pragma unroll
    for (int j = 0; j < 8; ++j) { const int k = 4 * F.lane + 256 * j; const f32x4 sc = *(const LAS f32x4*)(scale + k) + 1.f, sh = *(const LAS f32x4*)(shift + k);
        const f32x4 ha = va[j] * rsa * sc + sh, hb = vb[j] * rsb * sc + sh;
        o8a[64 * j] = (unsigned long long)pk2(ha.x, ha.y) | ((unsigned long long)pk2(ha.z, ha.w) << 32);
        o8b[64 * j] = (unsigned long long)pk2(hb.x, hb.y) | ((unsigned long long)pk2(hb.z, hb.w) << 32); }
}
__device__ __forceinline__ void ln_mod_row(Frame& F, const float* xrow, bf16* orow, const LAS float* shift, const LAS float* scale) {
    const GAS f32x4* xr = (const GAS f32x4*)xrow + F.lane;
    f32x4 v[8]; float s = 0.f;
#pragma unroll
    for (int j = 0; j < 8; ++j) { v[j] = xr[64 * j]; s += (v[j].x + v[j].y) + (v[j].z + v[j].w); }
    const float mean = wave_sum(s) * (1.f / DM); float s2 = 0.f;
#pragma unroll
    for (int j = 0; j < 8; ++j) { v[j] = v[j] - mean; s2 += (v[j].x * v[j].x + v[j].y * v[j].y) + (v[j].z * v[j].z + v[j].w * v[j].w); }
    const float rstd = 1.f / sqrtf(wave_sum(s2) * (1.f / DM) + LN_EPS);
    GAS unsigned long long* o8 = (GAS unsigned long long*)orow + F.lane;
#pragma unroll
    for (int j = 0; j < 8; ++j) { const int k = 4 * F.lane + 256 * j; const f32x4 sc = *(const LAS f32x4*)(scale + k), sh = *(const LAS f32x4*)(shift + k);
        const f32x4 h = v[j] * rstd * (sc + 1.f) + sh;
        o8[64 * j] = (unsigned long long)pk2(h.x, h.y) | ((unsigned long long)pk2(h.z, h.w) << 32); }
}
__device__ __forceinline__ void p1_lnmod(Frame& F) {
    LAS float* md = (LAS float*)(F.lds + RING_OFF);
    for (int e = F.vcu * NT + F.tid; e < BATCH * DM; e += F.G * NT) { const int b = e / DM, n = e % DM;
        F.gate[e] = F.modp[(size_t)b * NMOD + 2 * DM + n] + F.modp[((size_t)5 + b) * NMOD + 2 * DM + n]; }
    for (int blk = F.vcu; blk < 256; blk += F.G) {
        const int b = blk >> 6;
        __syncthreads();
        for (int e = F.tid; e < 4 * DM; e += NT) { const int row = e < 2 * DM ? b : 4, col = e & (2 * DM - 1);
            md[e] = F.modp[(size_t)row * NMOD + col] + F.modp[((size_t)5 + row) * NMOD + col]; }
        __syncthreads();
#pragma unroll 1
        for (int r = 0; r < 8; r += 2) { const int m = blk * 64 + F.wave * 8 + r;
            ln_mod_row2(F, F.x + (size_t)m * DM, F.x + (size_t)(m + 1) * DM, F.XN + (size_t)m * DM, F.XN + (size_t)(m + 1) * DM, md, md + DM); }
        if (F.wave < 4) { const int m = blk * 4 + F.wave; ln_mod_row(F, F.ctx + (size_t)m * DM, F.XN + (size_t)(MX + m) * DM, md + 2 * DM, md + 3 * DM); }
    }
}

__device__ __forceinline__ float rcpf_(float v) { return __builtin_amdgcn_rcpf(v); }
__device__ __forceinline__ float silu_fast(float v) { return v * rcpf_(1.f + __expf(-v)); }
__device__ __forceinline__ void conv_acc8(float (&acc)[8], const v4u u, const f32x4 wa, const f32x4 wb) {
    acc[0] += lo2f(u.x) * wa.x; acc[1] += hi2f(u.x) * wa.y; acc[2] += lo2f(u.y) * wa.z; acc[3] += hi2f(u.y) * wa.w;
    acc[4] += lo2f(u.z) * wb.x; acc[5] += hi2f(u.z) * wb.y; acc[6] += lo2f(u.w) * wb.z; acc[7] += hi2f(u.w) * wb.w;
}
constexpr int NSC = 4;
__device__ __forceinline__ void p3_conv(Frame& F) {
    bf16* QKM = F.XN;
    if (F.G > 2 * NSC && F.vcu < NSC) return;
    const int wk = F.G > 2 * NSC ? F.vcu - NSC : F.vcu, NW = F.G > 2 * NSC ? F.G - NSC : F.G;
    const int gw = wk * NWAVES + F.wave, NGW = NW * NWAVES;
    const int cq = gw & 3, ch = cq * 512 + F.lane * 8;
    f32x4 wa[9], wb[9];
#pragma unroll
    for (int t = 0; t < 9; ++t) { wa[t] = *(const GAS f32x4*)(F.conv_w + t * 2048 + ch); wb[t] = *(const GAS f32x4*)(F.conv_w + t * 2048 + ch + 4); }
    const f32x4 ba = *(const GAS f32x4*)(F.conv_b + ch), bb = *(const GAS f32x4*)(F.conv_b + ch + 4);
    const float sc = ch >= 1024 ? 0.0625f : 1.f;
    constexpr int NLAT = BATCH * 64 * 16, NCTX = BATCH * (CTXL / 4);
    int it0 = gw >> 2, it1 = NLAT + NCTX, its = NGW >> 2;
    if (NW == 252) { const int j = wk - 80; const int lo = wk < 80 ? 8 * wk : 640 + (j < 100 ? 22 * j : 2200 + 21 * (j - 100)); const int len = wk < 80 ? 8 : (j < 100 ? 22 : 21);
        it0 = lo + (F.wave >> 2); it1 = lo + len; its = 2; }
    for (int it = it0; it < it1; it += its) {
        const v4u zero4 = {0u, 0u, 0u, 0u};
        if (it < NLAT) {
            const int b = it >> 10, r = (it >> 4) & 63, c0 = (it & 15) * 4;
            v4u in[3][6];
#pragma unroll
            for (int dr = 0; dr < 3; ++dr)
#pragma unroll
                for (int j = 0; j < 6; ++j) { const int rr = r + dr - 1, cc = c0 + j - 1; const bool ok = rr >= 0 && rr < 64 && cc >= 0 && cc < 64;
                    in[dr][j] = ok ? *(const GAS v4u*)(F.U + (size_t)(b * SEQ + rr * 64 + cc) * NU + C_BQK + ch) : zero4; }
#pragma unroll
            for (int o = 0; o < 4; ++o) {
                float acc[8] = {ba.x, ba.y, ba.z, ba.w, bb.x, bb.y, bb.z, bb.w};
#pragma unroll
                for (int dr = 0; dr < 3; ++dr)
#pragma unroll
                    for (int dc = 0; dc < 3; ++dc) conv_acc8(acc, in[dr][o + dc], wa[dr * 3 + dc], wb[dr * 3 + dc]);
#pragma unroll
                for (int j = 0; j < 8; ++j) acc[j] = silu_fast(acc[j]) * sc;
                v4u ov; ov.x = pk2(acc[0], acc[1]); ov.y = pk2(acc[2], acc[3]); ov.z = pk2(acc[4], acc[5]); ov.w = pk2(acc[6], acc[7]);
                *(GAS v4u*)(QKM + (size_t)(b * SEQ + r * 64 + c0 + o) * DM + ch) = ov;
            }
        } else {
            const int ic = it - NLAT, b = ic >> 6, t0 = (ic & 63) * 4;
            v4u in[6];
#pragma unroll
            for (int j = 0; j < 6; ++j) { const int tt = t0 + j - 1; in[j] = (tt >= 0 && tt < CTXL) ? *(const GAS v4u*)(F.U + (size_t)(MX + b * CTXL + tt) * NU + C_BQK + ch) : zero4; }
#pragma unroll
            for (int o = 0; o < 4; ++o) {
                float acc[8] = {ba.x, ba.y, ba.z, ba.w, bb.x, bb.y, bb.z, bb.w};
#pragma unroll
                for (int dc = 0; dc < 3; ++dc) conv_acc8(acc, in[o + dc], wa[3 + dc], wb[3 + dc]);
#pragma unroll
                for (int j = 0; j < 8; ++j) acc[j] = silu_fast(acc[j]) * sc;
                v4u ov; ov.x = pk2(acc[0], acc[1]); ov.y = pk2(acc[2], acc[3]); ov.z = pk2(acc[4], acc[5]); ov.w = pk2(acc[6], acc[7]);
                *(GAS v4u*)(QKM + (size_t)(MX + b * CTXL + t0 + o) * DM + ch) = ov;
            }
        }
    }
}

__device__ __forceinline__ int scan_row(int b, int dirn, int nb, int i) {
    if (nb < 16) { const int p = nb * 16 + i; const int t = dirn ? (CTXL - 1 - p) : p; return MX + b * CTXL + t; }
    const int p = (nb - 16) * 16 + i; const int t = dirn ? (SEQ - 1 - p) : p; return b * SEQ + t;
}
__device__ __forceinline__ void p4_hgrn2_task(Frame& F, int task) {
    const int vs = task & 3, dirn = (task >> 2) & 1, h = (task >> 3) & 7, b = task >> 6;
    LAS float* Fg = (LAS float*)(F.lds);
    LAS float* Kg = Fg + 2048, *Qg = Kg + 2048;
    LAS float* Vg = Qg + 2048;
    LAS float* LB = Vg + 512;
    LAS float* P = LB + 128;
    const int v = F.tid & 31, kg = F.tid >> 5, k0 = kg * 8;
    const int zcol = (dirn ? C_AFB : C_AFF) + h * HGD;
    __syncthreads();
    if (F.tid < 128) { const int col = h * HGD + F.tid; LB[F.tid] = sigmf(F.hg_lb[(dirn * 2 + 0) * WA + col] - F.hg_lb[(dirn * 2 + 1) * WA + col]); }
    __syncthreads();
    float S[8];
#pragma unroll
    for (int j = 0; j < 8; ++j) S[j] = 0.f;
    bf16* O = dirn ? F.OAB : F.OAF;
#pragma unroll 1
    for (int nb = 0; nb < 16 + 256; ++nb) {
        const bool lat = nb >= 16;
#pragma unroll
        for (int j = 0; j < 4; ++j) { const int e = F.tid + NT * j, i = e >> 7, k = e & 127; const int row = scan_row(b, dirn, nb, i);
            const float z = bf2f(F.U[(size_t)row * NU + zcol + k]); const float lb = LB[k]; const float f = lb + (1.f - lb) * sigmf(z);
            Fg[e] = f; Kg[e] = 1.f - f; Qg[e] = lat ? siluf(bf2f(F.U[(size_t)row * NU + C_AQ + h * HGD + k])) : 0.f; }
        { const int i = F.tid >> 5; const int row = scan_row(b, dirn, nb, i); Vg[F.tid] = bf2f(F.U[(size_t)row * NU + C_AI + h * HGD + vs * 32 + v]); }
        __syncthreads();
#pragma unroll 2
        for (int i = 0; i < 16; ++i) { const float vv = Vg[i * 32 + v]; float a = 0.f;
#pragma unroll
            for (int j = 0; j < 8; ++j) { S[j] = Fg[i * 128 + k0 + j] * S[j] + Kg[i * 128 + k0 + j] * vv; a += S[j] * Qg[i * 128 + k0 + j]; }
            P[(kg * 16 + i) * 32 + v] = a; }
        __syncthreads();
        if (lat) { const int i = F.tid >> 5; float o = 0.f;
#pragma unroll
            for (int g = 0; g < 16; ++g) o += P[(g * 16 + i) * 32 + v];
            const int row = scan_row(b, dirn, nb, i);
            O[(size_t)row * WA + h * HGD + vs * 32 + v] = (bf16)f2bf(o); }
    }
}
__device__ __forceinline__ void p4_mlstm_task(Frame& F, int task) {
    const int vs = task & 7, dirn = (task >> 3) & 1, h = (task >> 4) & 3, b = task >> 6;
    const bf16* QKM = F.XN;
    LAS float* Kb = (LAS float*)(F.lds);
    LAS float* Qb = Kb + 4096;
    LAS float* Vb = Qb + 4096;
    LAS float* LI = Vb + 512, *LF = LI + 16, *EM = LF + 16;
    LAS float* PD = EM + 16;
    LAS float* P = PD + 256;
    const int v = F.tid & 31, kg = F.tid >> 5, k0 = kg * 16;
    float C[16], nn[16]; float m = 0.f;
#pragma unroll
    for (int j = 0; j < 16; ++j) { C[j] = 0.f; nn[j] = 0.f; }
    bf16* O = dirn ? F.HBB : F.HBF;
    const float gbi = F.ml_gate_b[dirn * 4 + h], gbf = F.ml_gate_b[(2 + dirn) * 4 + h];
#pragma unroll 1
    for (int nb = 0; nb < 16 + 256; ++nb) {
        const bool lat = nb >= 16;
        __syncthreads();
#pragma unroll
        for (int j = 0; j < 8; ++j) { const int e = F.tid + NT * j, i = e >> 8, k = e & 255; const int row = scan_row(b, dirn, nb, i);
            Kb[e] = bf2f(QKM[(size_t)row * DM + 1024 + h * MLD + k]); Qb[e] = lat ? bf2f(QKM[(size_t)row * DM + h * MLD + k]) : 0.f; }
        { const int i = F.tid >> 5; const int row = scan_row(b, dirn, nb, i); Vb[F.tid] = bf2f(F.U[(size_t)row * NU + C_BV + h * MLD + vs * 32 + v]); }
        if (F.tid < 16) { const int row = scan_row(b, dirn, nb, F.tid);
            const float gi = bf2f(F.U[(size_t)row * NU + C_BG + dirn * 4 + h]) + gbi, gf = bf2f(F.U[(size_t)row * NU + C_BG + (2 + dirn) * 4 + h]) + gbf;
            LI[F.tid] = gi; LF[F.tid] = gf > 0.f ? -log1pf(__expf(-gf)) : gf - log1pf(__expf(gf)); }
        __syncthreads();
#pragma unroll 2
        for (int i = 0; i < 16; ++i) {
            const float lf = LF[i], li = LI[i]; const float mn = fmaxf(lf + m, li); const float fd = __expf(lf + m - mn), iw = __expf(li - mn); m = mn;
            if (F.tid == 0) EM[i] = __expf(-m);
            const float vv = iw * Vb[i * 32 + v]; float a = 0.f, d = 0.f;
#pragma unroll
            for (int j = 0; j < 16; ++j) { const float kk = Kb[i * 256 + k0 + j], qq = Qb[i * 256 + k0 + j];
                C[j] = fd * C[j] + vv * kk; nn[j] = fd * nn[j] + iw * kk; a += C[j] * qq; d += nn[j] * qq; }
            P[(kg * 16 + i) * 32 + v] = a; if (v == 0) PD[kg * 16 + i] = d; }
        __syncthreads();
        if (lat) { const int i = F.tid >> 5; float num = 0.f, den = 0.f;
#pragma unroll
            for (int g = 0; g < 16; ++g) { num += P[(g * 16 + i) * 32 + v]; den += PD[g * 16 + i]; }
            const int row = scan_row(b, dirn, nb, i);
            O[(size_t)row * WB + h * MLD + vs * 32 + v] = (bf16)f2bf(num / fmaxf(fabsf(den), EM[i])); }
    }
}
__device__ __forceinline__ void p4_scan_naive(Frame& F) {
    for (int task = F.vcu; task < 512; task += F.G) { if (task < 256) p4_hgrn2_task(F, task); else p4_mlstm_task(F, task - 256); }
}

constexpr int NCHUNK = MALL / 64;
__device__ __forceinline__ void gate_fk(float z, float lb, float& f, float& kk) {
    const float e = __expf(-fabsf(z)); const float rb = 1.f / (1.f + e), rs = e * rb;
    const float sg = z >= 0.f ? rb : rs, sn = z >= 0.f ? rs : rb;
    f = lb + (1.f - lb) * sg; kk = (1.f - lb) * sn;
}
template <bool DUMMY>
__device__ __forceinline__ void p3_hg_prep(Frame& F) {
    bf16* dq = F.OAF; bf16* dkf = F.OAB; bf16* dkb = F.HBF;
    LAS unsigned char* L = F.lds;
    constexpr int TQ = 0, TZF = 32768, TZB = 65536, TQF = 98304;
    const int tid = F.tid, dirn = tid >> 8, cl = tid & 255;
    if (F.G > 2 * NSC && F.vcu < NSC) return;
    const int wk = F.G > 2 * NSC ? F.vcu - NSC : F.vcu, NW = F.G > 2 * NSC ? F.G - NSC : F.G;
    v4u pre[3][4];
    auto issue = [&](int it) { const int cid = it >> 2, cb = (it & 3) * 256; const size_t row0 = (size_t)cid * 64;
#pragma unroll
        for (int i = 0; i < 4; ++i) { const int piece = tid + NT * i, row = piece >> 5, c16 = piece & 31; const bf16* ur = F.U + (row0 + row) * NU + cb + c16 * 8;
            pre[0][i] = *(const GAS v4u*)(ur + C_AQ); pre[1][i] = *(const GAS v4u*)(ur + C_AFF); pre[2][i] = *(const GAS v4u*)(ur + C_AFB); } };
    int it = wk;
    if (it < NCHUNK * 4) issue(it);
    for (; it < NCHUNK * 4; it += NW) {
        const int cid = it >> 2, cb = (it & 3) * 256; const size_t row0 = (size_t)cid * 64;
        __syncthreads();
#pragma unroll
        for (int i = 0; i < 4; ++i) { const int piece = tid + NT * i; *(LAS v4u*)(L + TQ + piece * 16) = pre[0][i]; *(LAS v4u*)(L + TZF + piece * 16) = pre[1][i]; *(LAS v4u*)(L + TZB + piece * 16) = pre[2][i]; }
        __syncthreads();
        if (it + NW < NCHUNK * 4) issue(it + NW);
        const int c = cb + cl;
        const float lb = sigmf(F.hg_lb[(dirn * 2) * WA + c] - F.hg_lb[(dirn * 2 + 1) * WA + c]), olb = 1.f - lb;
        LAS unsigned short* zt = (LAS unsigned short*)(L + (dirn ? TZB : TZF)) + cl;
        const LAS unsigned short* qtile = (const LAS unsigned short*)(L + TQ) + cl;
        LAS unsigned short* qf = (LAS unsigned short*)(L + TQF) + cl;
        float P = 1.f; unsigned qb[32];
#pragma unroll
        for (int pp = 0; pp < 64; ++pp) {
            const int p = dirn ? 63 - pp : pp;
            const float z = bf2f(zt[p * 256]), q = bf2f(qtile[p * 256]);
            const float e = __expf(-fabsf(z)); const float rbig = rcpf_(1.f + e), rsm = e * rbig;
            const float sg = z >= 0.f ? rbig : rsm, sn = z >= 0.f ? rsm : rbig;
            const float f = lb + olb * sg, kk = olb * sn; P *= f;
            const float qt = silu_fast(q) * P, kt = kk * rcpf_(P);
            zt[p * 256] = (unsigned short)(pkbf(kt, 0.f) & 0xffffu);
            const unsigned qh = pkbf(qt, 0.f) & 0xffffu;
            if (dirn) { if (pp & 1) qb[pp >> 1] |= qh << 16; else qb[pp >> 1] = qh; } else qf[p * 256] = (unsigned short)qh;
        }
        F.PE[(size_t)(dirn * NCHUNK + cid) * WA + c] = P;
        __syncthreads();
        if (dirn) {
            LAS unsigned short* qw = (LAS unsigned short*)(L + TQ) + cl;
#pragma unroll
            for (int pp = 0; pp < 64; ++pp) qw[(63 - pp) * 256] = (unsigned short)((pp & 1) ? (qb[pp >> 1] >> 16) : (qb[pp >> 1] & 0xffffu));
        }
        __syncthreads();
#pragma unroll
        for (int i = 0; i < 4; ++i) { const int piece = tid + NT * i, row = piece >> 5, c16 = piece & 31; const size_t r = row0 + row; bf16* ur = F.U + r * NU + cb + c16 * 8;
            const v4u vq = *(const LAS v4u*)(L + TQ + piece * 16), vf = *(const LAS v4u*)(L + TZF + piece * 16), vb = *(const LAS v4u*)(L + TZB + piece * 16), vqf = *(const LAS v4u*)(L + TQF + piece * 16);
            *(GAS v4u*)(F.QTF + r * WA + cb + c16 * 8) = vqf;
            if (DUMMY) { if (r < MX) { *(GAS v4u*)(dq + r * WA + cb + c16 * 8) = vq; *(GAS v4u*)(dkf + r * WA + cb + c16 * 8) = vf; *(GAS v4u*)(dkb + r * WA + cb + c16 * 8) = vb; } }
            else { *(GAS v4u*)(ur + C_AQ) = vq; *(GAS v4u*)(ur + C_AFF) = vf; *(GAS v4u*)(ur + C_AFB) = vb; } }
    }
    __syncthreads();
}
template <int CTRL, int RM> __device__ __forceinline__ float dpp_f(float idv, float x) { return __builtin_bit_cast(float, __builtin_amdgcn_update_dpp(__builtin_bit_cast(int, idv), __builtin_bit_cast(int, x), CTRL, RM, 0xf, false)); }
__device__ __forceinline__ float wave_scan_add(float x) {
    x += dpp_f<0x111, 0xf>(0.f, x); x += dpp_f<0x112, 0xf>(0.f, x); x += dpp_f<0x114, 0xf>(0.f, x); x += dpp_f<0x118, 0xf>(0.f, x);
    x += dpp_f<0x142, 0xa>(0.f, x); x += dpp_f<0x143, 0xc>(0.f, x); return x; }
__device__ __forceinline__ float wave_scan_max(float x) { const float ni = -__builtin_inff();
    x = fmaxf(x, dpp_f<0x111, 0xf>(ni, x)); x = fmaxf(x, dpp_f<0x112, 0xf>(ni, x)); x = fmaxf(x, dpp_f<0x114, 0xf>(ni, x)); x = fmaxf(x, dpp_f<0x118, 0xf>(ni, x));
    x = fmaxf(x, dpp_f<0x142, 0xa>(ni, x)); x = fmaxf(x, dpp_f<0x143, 0xc>(ni, x)); return x; }
__device__ __forceinline__ void p3_ml_scalars(Frame& F) {
    const int gw = F.vcu * NWAVES + F.wave;
    if (gw >= 32) return;
    const int dirn = gw & 1, h = (gw >> 1) & 3, b = gw >> 3;
    const float gbi = F.ml_gate_b[dirn * 4 + h], gbf = F.ml_gate_b[(2 + dirn) * 4 + h];
    float m0 = 0.f;
    float* mls = F.MLS + (size_t)(dirn * 4 + h) * MALL * 8;
    auto row_of = [&](int n) -> int { int row0; if (n < 4) { const int cc = dirn ? 3 - n : n; row0 = MX + b * CTXL + cc * 64; } else { const int lc = dirn ? 67 - n : n - 4; row0 = b * SEQ + lc * 64; }
        return row0 + (dirn ? 63 - F.lane : F.lane); };
    unsigned short gi_r[8], gf_r[8];
#pragma unroll
    for (int j = 0; j < 8; ++j) { const int row = row_of(j); gi_r[j] = F.U[(size_t)row * NU + C_BG + dirn * 4 + h]; gf_r[j] = F.U[(size_t)row * NU + C_BG + (2 + dirn) * 4 + h]; }
#pragma unroll 1
    for (int nb = 0; nb < 72; nb += 8) {
#pragma unroll
        for (int j = 0; j < 8; ++j) {
            const int n = nb + j;
            if (n < 68) {
                const int row = row_of(n);
                const float gi = bf2f(gi_r[j]) + gbi, gf = bf2f(gf_r[j]) + gbf;
                if (n + 8 < 68) { const int r2 = row_of(n + 8); gi_r[j] = F.U[(size_t)r2 * NU + C_BG + dirn * 4 + h]; gf_r[j] = F.U[(size_t)r2 * NU + C_BG + (2 + dirn) * 4 + h]; }
                const float lf = gf > 0.f ? -log1pf(__expf(-gf)) : gf - log1pf(__expf(gf));
                const float cs = wave_scan_add(lf);
                const float a = gi - cs; const float cm = wave_scan_max(a);
                const float mx = fmaxf(m0, cm), m63 = __shfl(mx, 63), cs63 = __shfl(cs, 63);
                f32x4 o0; o0.x = a; o0.y = mx; o0.z = __expf(m0 - mx); o0.w = __expf(a - m63);
                f32x4 o1; o1.x = __expf(-(cs + mx)); o1.y = 0.f; o1.z = __expf(m0 - m63); o1.w = 0.f;
                *(f32x4*)(mls + (size_t)row * 8) = o0; *(f32x4*)(mls + (size_t)row * 8 + 4) = o1;
                const int row0 = row - (dirn ? 63 - F.lane : F.lane);
                if (F.lane == 0) F.DEC[(dirn * 4 + h) * NCHUNK + (row0 >> 6)] = __expf(m0 - m63);
                m0 = cs63 + m63;
            }
        }
    }
}

typedef short s16x4 __attribute__((ext_vector_type(4)));
typedef float f32x16 __attribute__((ext_vector_type(16)));
#define MFMA32(a, b, c) __builtin_amdgcn_mfma_f32_32x32x16_bf16((a), (b), (c), 0, 0, 0)
__device__ __forceinline__ bf16x8 pk8(float a0, float a1, float a2, float a3, float a4, float a5, float a6, float a7) {
    const v4u u = {pkbf(a0, a1), pkbf(a2, a3), pkbf(a4, a5), pkbf(a6, a7)}; return __builtin_bit_cast(bf16x8, u); }
__device__ __forceinline__ bf16x8 cat4(s16x4 lo, s16x4 hi) { return __builtin_shufflevector(lo, hi, 0, 1, 2, 3, 4, 5, 6, 7); }
__device__ __forceinline__ s16x4 lds_tr(LAS unsigned char* p) { return __builtin_amdgcn_ds_read_tr16_b64_v4i16((LAS s16x4*)p); }
__device__ __forceinline__ unsigned img_off_a(unsigned row, unsigned ch) { return 2048u * (row >> 3) + 512u * (ch >> 2) + 64u * (row & 7) + 16u * ((ch & 3) ^ ((row >> 2) & 3)); }
__device__ __forceinline__ unsigned img_addr(unsigned row, unsigned ch, unsigned ncb) { return ((row >> 5) * ncb + (ch >> 4)) * 8192u + img_off_a(row & 31, ch & 15); }
__device__ __forceinline__ unsigned v_addr(unsigned row, unsigned ch) { const unsigned r = row & 31; return (row >> 5) * 4096u + 1024u * (r >> 3) + 512u * (ch >> 2) + 64u * (r & 7) + 16u * ((ch & 3) ^ ((r >> 2) & 3)); }

constexpr int SL_QT = 0, SL_KT = 32768, SL_V = 65536, SL_VW = 73728, SL_SF = 81920, SL_XCH = 114688, SL_SC = 131072, SL_W = 144384;
constexpr int SC_PAR = 448, SC_DQW = 896, SC_N0 = 1024, SC_NP = 1280;


__device__ __forceinline__ void p3b_ml_scores(Frame& F) {
    LAS unsigned char* L = F.lds;
    constexpr int BQ = 0, BK = 32768, BX = 65536, BS = 98304;
    LAS float* SCA = (LAS float*)(L + BS);
    const int tid = F.tid, lane = F.lane, w = F.wave, ts = w & 1, tp = (w >> 1) & 1, kh = w >> 2;
    const unsigned hh = lane >> 5, x4 = (lane >> 2) & 3;
    const unsigned LB0 = 2048u * ((lane >> 3) & 3) + 64u * (lane & 7);
    unsigned LBx[2];
#pragma unroll
    for (int e = 0; e < 2; ++e) LBx[e] = LB0 + 16u * ((2u * e + hh) ^ x4) + kh * 8192u;
    v4u pq[4], pk[4]; f32x2_t psc;
    auto issue = [&](int it) { const int lc = it & 63, h = (it >> 6) & 3, b = it >> 8; const size_t row0 = (size_t)b * SEQ + lc * 64;
        int tv = F.tid; asm volatile("" : "+v"(tv));
#pragma unroll
        for (int i = 0; i < 4; ++i) { const int piece = tv + NT * i, row = piece >> 5, ch = piece & 31;
            pq[i] = *(const GAS v4u*)(F.XN + (row0 + row) * DM + h * MLD + ch * 8); pk[i] = *(const GAS v4u*)(F.XN + (row0 + row) * DM + WB + h * MLD + ch * 8); }
        if (tv < 128) psc = *(const GAS f32x2_t*)(F.MLS + ((size_t)((tv >> 6) * 4 + h) * MALL + row0 + (tv & 63)) * 8); };
    int it = F.vcu;
    if (it < 1024) issue(it);
    for (; it < 1024; it += F.G) {
        const int lc = it & 63, h = (it >> 6) & 3, b = it >> 8; const size_t row0 = (size_t)b * SEQ + lc * 64;
        __syncthreads();
        { int tv = F.tid; asm volatile("" : "+v"(tv));
#pragma unroll
          for (int i = 0; i < 4; ++i) { const int piece = tv + NT * i; const unsigned a = img_addr(piece >> 5, piece & 31, 2); *(LAS v4u*)(L + BQ + a) = pq[i]; *(LAS v4u*)(L + BK + a) = pk[i]; }
          if (tv < 128) { SCA[(tv >> 6) * 128 + (tv & 63)] = psc.x; SCA[(tv >> 6) * 128 + 64 + (tv & 63)] = psc.y; } }
        __syncthreads();
        if (it + F.G < 1024) issue(it + F.G);
        f32x16 c;
#pragma unroll
        for (int r = 0; r < 16; ++r) c[r] = 0.f;
#pragma unroll
        for (int s = 0; s < 8; ++s) {
            const bf16x8 a = *(const LAS bf16x8*)(L + BK + ts * 16384 + 512 * (s >> 1) + LBx[s & 1]);
            const bf16x8 bq = *(const LAS bf16x8*)(L + BQ + tp * 16384 + 512 * (s >> 1) + LBx[s & 1]);
            c = MFMA32(a, bq, c);
        }
#pragma unroll
        for (int r = 0; r < 16; ++r) *(LAS float*)(L + BX + (((kh * 4 + ts * 2 + tp) * 16 + r) * 64 + lane) * 4) = c[r];
        __syncthreads();
#pragma unroll
        for (int r = 0; r < 16; ++r) c[r] += *(const LAS float*)(L + BX + ((((1 - kh) * 4 + ts * 2 + tp) * 16 + r) * 64 + lane) * 4);
        const int dirn = kh;
        const bool need = dirn ? (ts >= tp) : (ts <= tp);
        const float mxp = SCA[dirn * 128 + 64 + 32 * tp + (lane & 31)];
        int dl = (lane & 31) - 4 * (int)hh; if (dirn) dl = -dl; asm volatile("" : "+v"(dl));
        const int sg1 = dirn ? -1 : 1; const bool diag = ts == tp;
        float rs = 0.f;
        bf16* wout = F.MLW + ((size_t)((dirn * 4 + h) * 256 + (int)(row0 >> 6)) * 4096) + (32 * tp + (lane & 31)) * 64 + 32 * ts + 4 * hh;
#pragma unroll
        for (int g = 0; g < 4; ++g) {
            const f32x4 av = *(const LAS f32x4*)(SCA + dirn * 128 + 32 * ts + 8 * g + 4 * hh);
            float wv[4];
#pragma unroll
            for (int j = 0; j < 4; ++j) { float v = need ? c[4 * g + j] * __expf(av[j] - mxp) : 0.f;
                if (diag) v = (dl - sg1 * (j + 8 * g) >= 0) ? v : 0.f;
                wv[j] = v; rs += v; }
            *(GAS unsigned long long*)(wout + 8 * g) = (unsigned long long)pkbf(wv[0], wv[1]) | ((unsigned long long)pkbf(wv[2], wv[3]) << 32);
        }
        rs += __shfl_xor(rs, 32);
        if (lane < 32) SCA[256 + (dirn * 2 + ts) * 64 + 32 * tp + lane] = rs;
        __syncthreads();
        if (tid < 128) { const int d = tid >> 6, p = tid & 63; F.MLS[((size_t)(d * 4 + h) * MALL + row0 + p) * 8 + 5] = SCA[256 + (d * 2) * 64 + p] + SCA[256 + (d * 2 + 1) * 64 + p]; }
    }
    __syncthreads();
}

template <bool ML, int SKIP = 0>
__device__ __forceinline__ void scan_task(Frame& F, int task) {
    constexpr int NKT = ML ? 8 : 4, NCB = NKT / 4, NKH = NKT / 2, NOWN = NKT / 4, NPQ = ML ? 4 : 2, DKK = 32 * NKT;
    int vs, dirn, h, b;
    if (ML) { vs = task & 3; dirn = (task >> 2) & 1; h = (task >> 3) & 3; b = task >> 5; } else { vs = task & 1; dirn = (task >> 1) & 1; h = (task >> 2) & 7; b = task >> 5; }
    const int lane = F.lane, w = F.wave, tid = F.tid; const int tp = (w >> 2) & 1, tj = (w >> 1) & 1, kh = w & 1;
    const unsigned hh = lane >> 5, q4 = (lane & 15) >> 2, p4 = lane & 3, blk = (lane >> 4) & 1, x4 = (lane >> 2) & 3;
    LAS unsigned char* L = F.lds;
    LAS float* SC = (LAS float*)(L + SL_SC);
    const unsigned LB0 = 2048u * ((lane >> 3) & 3) + 64u * (lane & 7);
    const unsigned khoff = ML ? kh * 8192u : kh * 1024u;
    unsigned LBx[2], LK[2][2], TRK[2], VK[2], VN[2], WL[2];
#pragma unroll
    for (int e = 0; e < 2; ++e) { LBx[e] = LB0 + 16u * ((2u * e + hh) ^ x4) + khoff; WL[e] = 1024u * ((lane >> 3) & 3) + 64u * (lane & 7) + 16u * ((2u * e + hh) ^ x4);
#pragma unroll
        for (int t = 0; t < 2; ++t) LK[e][t] = LB0 + 16u * ((2u * e + t) ^ x4) + 8u * hh + khoff; }
#pragma unroll
    for (int t = 0; t < 2; ++t) {
        TRK[t] = 2048u * hh + 64u * q4 + 8u * (p4 & 1) + 16u * ((2u * blk + (p4 >> 1)) ^ (2u * hh + t));
        VK[t] = 64u * (4u * hh + q4) + 8u * (p4 & 1) + 16u * ((2u * blk + (p4 >> 1)) ^ (2u * t + hh)) + 512u * tj;
        VN[t] = 1024u * hh + 64u * q4 + 8u * (p4 & 1) + 512u * tj + 16u * ((2u * blk + (p4 >> 1)) ^ (2u * hh + t)); }
    unsigned tkoff[NOWN];
#pragma unroll
    for (int i = 0; i < NOWN; ++i) { const unsigned tk = kh * NKH + tp * NOWN + i; tkoff[i] = (tk >> 2) * 8192u + 512u * (tk & 3); }
    const bf16 *gq, *gk, *gv; int sq, sk; bf16* go;
    if (ML) { gq = F.XN + h * MLD; gk = F.XN + WB + h * MLD; sq = DM; sk = DM; gv = F.U + C_BV + h * MLD + vs * 64; go = (dirn ? F.HBB : F.HBF) + h * MLD + vs * 64; }
    else { if (dirn) { gq = F.U + C_AQ + h * HGD; sq = NU; gk = F.U + C_AFB + h * HGD; } else { gq = F.QTF + h * HGD; sq = WA; gk = F.U + C_AFF + h * HGD; }
        sk = NU; gv = F.U + C_AI + h * HGD + vs * 64; go = (dirn ? F.OAB : F.OAF) + h * HGD + vs * 64; }
    const float* mls = F.MLS + (size_t)(dirn * 4 + h) * MALL * 8;
    const float* pev = F.PE + (size_t)dirn * NCHUNK * WA + h * HGD;
    f32x16 S[NOWN];
#pragma unroll
    for (int i = 0; i < NOWN; ++i)
#pragma unroll
        for (int r = 0; r < 16; ++r) S[i][r] = 0.f;
    v4u pq[NPQ], pk[NPQ], pv, pw; f32x4 ps0, ps1; float pws;
    const bf16* gw_ = F.MLW + (size_t)(dirn * 4 + h) * 256 * 4096;
    auto row0_of = [&](int n) -> int { if (n < 4) { const int cc = dirn ? 3 - n : n; return MX + b * CTXL + cc * 64; } const int lc = dirn ? 67 - n : n - 4; return b * SEQ + lc * 64; };
    int offq[NPQ], offk[NPQ]; unsigned aimg[NPQ];
#pragma unroll
    for (int i = 0; i < NPQ; ++i) { const int piece = tid + NT * i, row = piece >> (ML ? 5 : 4), ch = piece & (ML ? 31 : 15); offq[i] = row * sq + ch * 8; offk[i] = row * sk + ch * 8; aimg[i] = img_addr(row, ch, NCB); }
    const int offv = (tid >> 3) * NU + (tid & 7) * 8, offw = (tid >> 3) * 64 + (tid & 7) * 8; const unsigned va = v_addr(tid >> 3, tid & 7);
    auto issue_loads = [&](int n) {
        const int row0 = row0_of(n);
        const bf16* bq_ = gq + (size_t)row0 * sq; const bf16* bk_ = gk + (size_t)row0 * sk;
#pragma unroll
        for (int i = 0; i < NPQ; ++i) { pq[i] = *(const GAS v4u*)(bq_ + offq[i]); pk[i] = *(const GAS v4u*)(bk_ + offk[i]); }
        pv = *(const GAS v4u*)(gv + (size_t)row0 * NU + offv);
        if (ML) { pws = mls[(size_t)(row0 + (tid >> 3)) * 8 + 3];
            if (n >= 4) pw = *(const GAS v4u*)(gw_ + (size_t)(row0 >> 6) * 4096 + offw);
            if (tid < 64) { ps0 = *(const GAS f32x4*)(mls + (size_t)(row0 + tid) * 8); ps1 = *(const GAS f32x4*)(mls + (size_t)(row0 + tid) * 8 + 4); } }
        else { if (tid < 32) ps0 = *(const GAS f32x4*)(pev + (size_t)(row0 >> 6) * WA + tid * 4); }
    };
    auto store_images = [&](int n) {
#pragma unroll
        for (int i = 0; i < NPQ; ++i) { *(LAS v4u*)(L + SL_QT + aimg[i]) = pq[i]; *(LAS v4u*)(L + SL_KT + aimg[i]) = pk[i]; }
        *(LAS v4u*)(L + SL_V + va) = pv;
        if (!ML && tid < 32) *(LAS f32x4*)(SC + (n & 1) * SC_PAR + tid * 4) = ps0;
        if (ML) { v4u o; o.x = pkbf(lo2f(pv.x) * pws, hi2f(pv.x) * pws); o.y = pkbf(lo2f(pv.y) * pws, hi2f(pv.y) * pws); o.z = pkbf(lo2f(pv.z) * pws, hi2f(pv.z) * pws); o.w = pkbf(lo2f(pv.w) * pws, hi2f(pv.w) * pws);
            *(LAS v4u*)(L + SL_VW + va) = o;
            if (n >= 4) *(LAS v4u*)(L + SL_W + va) = pw;
            if (tid < 64) { LAS float* sp = SC + (n & 1) * SC_PAR + tid; sp[0] = ps0.x; sp[64] = ps0.y; sp[128] = ps0.z; sp[192] = ps0.w; sp[256] = ps1.x; sp[320] = ps1.y; sp[384] = ps1.z; } }
    };
    __syncthreads();
    issue_loads(0);
    for (int e = tid; e < 32768 / 16; e += NT) *(LAS v4u*)(L + SL_SF + e * 16) = (v4u){0u, 0u, 0u, 0u};
    store_images(0);
    __syncthreads();
#pragma unroll 1
    for (int n = 0; n < 68; ++n) {
        const bool lat = n >= 4; const int row0 = row0_of(n); const int cid = row0 >> 6;
        if (n + 1 < 68 && !(SKIP & 16)) issue_loads(n + 1);
        LAS float* SP = SC + (n & 1) * SC_PAR;
        float dec = 1.f; f32x4 pe[NOWN][4];
        if (ML) dec = SP[384];
        else {
#pragma unroll
            for (int i = 0; i < NOWN; ++i)
#pragma unroll
                for (int g = 0; g < 4; ++g) pe[i][g] = *(const LAS f32x4*)(SP + 32 * (kh * NKH + tp * NOWN + i) + 8 * g + 4 * hh);
        }
        f32x16 o;
        if (lat && !(SKIP & 4)) {
            f32x16 acc_o, acc_i;
#pragma unroll
            for (int r = 0; r < 16; ++r) { acc_o[r] = 0.f; acc_i[r] = 0.f; }
            if (ML) {
                if (kh == 0) {
#pragma unroll
                    for (int ts = 0; ts < 2; ++ts) {
                        const bool need = dirn ? (ts >= tp) : (ts <= tp);
                        if (need) {
#pragma unroll
                            for (int e = 0; e < 2; ++e) {
                                const bf16x8 a = *(const LAS bf16x8*)(L + SL_W + tp * 4096 + 512 * ts + WL[e]);
                                const s16x4 lo = lds_tr(L + SL_V + ts * 4096 + 2048 * e + VN[0]), hi = lds_tr(L + SL_V + ts * 4096 + 2048 * e + 256 + VN[1]);
                                acc_o = MFMA32(a, cat4(lo, hi), acc_o);
                            }
                        }
                    }
                }
            } else
#pragma unroll
            for (int ts = 0; ts < 2; ++ts) {
                const bool need = dirn ? (ts >= tp) : (ts <= tp);
                if (need) {
                    f32x16 c;
#pragma unroll
                    for (int r = 0; r < 16; ++r) c[r] = 0.f;
#pragma unroll
                    for (int s = 0; s < NKT; ++s) {
                        const bf16x8 a = *(const LAS bf16x8*)(L + SL_KT + ts * NCB * 8192 + 512 * (s >> 1) + LBx[s & 1]);
                        const bf16x8 bq = *(const LAS bf16x8*)(L + SL_QT + tp * NCB * 8192 + 512 * (s >> 1) + LBx[s & 1]);
                        c = MFMA32(a, bq, c);
                    }
                    int dl = (lane & 31) - 4 * (int)hh; if (dirn) dl = -dl; asm volatile("" : "+v"(dl));
                    const int sg1 = dirn ? -1 : 1; const bool diag = ts == tp;
#pragma unroll
                    for (int r = 0; r < 16; ++r) { const int ro = (r & 3) + 8 * (r >> 2);
                        float wv = c[r];
                        if (diag) wv = (dl - sg1 * ro >= 0) ? wv : 0.f;
                        c[r] = wv; }
#pragma unroll
                    for (int st = 0; st < 2; ++st) {
                        const bf16x8 a = pk8(c[8 * st], c[8 * st + 1], c[8 * st + 2], c[8 * st + 3], c[8 * st + 4], c[8 * st + 5], c[8 * st + 6], c[8 * st + 7]);
                        const s16x4 lo = lds_tr(L + SL_V + ts * 4096 + 1024 * (2 * st) + VK[0]), hi = lds_tr(L + SL_V + ts * 4096 + 1024 * (2 * st + 1) + VK[1]);
                        acc_o = MFMA32(a, cat4(lo, hi), acc_o);
                    }
                }
            }
#pragma unroll
            for (int tkk = 0; tkk < NKH; ++tkk)
#pragma unroll
                for (int st = 0; st < 2; ++st) {
                    const s16x4 lo = *(const LAS s16x4*)(L + SL_QT + tp * NCB * 8192 + 512 * tkk + LK[st][0]), hi = *(const LAS s16x4*)(L + SL_QT + tp * NCB * 8192 + 512 * tkk + LK[st][1]);
                    const bf16x8 sf = *(const LAS bf16x8*)(L + SL_SF + ((((kh * NKH + tkk) * 2 + tj) * 2 + st) * 1024) + lane * 16);
                    acc_i = MFMA32(cat4(lo, hi), sf, acc_i);
                }
            if (ML) {
                f32x4 wi[4];
#pragma unroll
                for (int g = 0; g < 4; ++g) wi[g] = *(const LAS f32x4*)(SP + 128 + 32 * tp + 8 * g + 4 * hh);
#pragma unroll
                for (int r = 0; r < 16; ++r) o[r] = acc_o[r] + wi[r >> 2][r & 3] * acc_i[r];
            } else {
#pragma unroll
                for (int r = 0; r < 16; ++r) o[r] = acc_o[r] + acc_i[r];
            }
            {
#pragma unroll
                for (int r = 0; r < 8; ++r) { const int rr = kh ? r : r + 8; *(LAS float*)(L + SL_XCH + (((tp * 2 + tj) * 16 + rr) * 64 + lane) * 4) = kh ? o[r] : o[r + 8]; }
            }
        }
#pragma unroll
        for (int i = 0; i < NOWN; ++i) {
            f32x16 g = S[i];
            if (ML) {
#pragma unroll
                for (int r = 0; r < 16; ++r) g[r] *= dec;
            }
#pragma unroll
            for (int ks = 0; ks < ((SKIP & 8) ? 0 : 4); ++ks) {
                const s16x4 alo = lds_tr(L + SL_KT + (ks >> 1) * NCB * 8192 + 4096 * (ks & 1) + tkoff[i] + TRK[0]), ahi = lds_tr(L + SL_KT + (ks >> 1) * NCB * 8192 + 4096 * (ks & 1) + 256 + tkoff[i] + TRK[1]);
                const s16x4 blo = lds_tr(L + (ML ? SL_VW : SL_V) + (ks >> 1) * 4096 + 2048 * (ks & 1) + VN[0]), bhi = lds_tr(L + (ML ? SL_VW : SL_V) + (ks >> 1) * 4096 + 2048 * (ks & 1) + 256 + VN[1]);
                g = MFMA32(cat4(alo, ahi), cat4(blo, bhi), g);
            }
            if (!ML) {
#pragma unroll
                for (int r = 0; r < 16; ++r) g[r] *= pe[i][r >> 2][r & 3];
            }
            S[i] = g;
        }
        __syncthreads();
        if (lat && !(SKIP & 2)) {
#pragma unroll
            for (int r8 = 0; r8 < 8; ++r8) { const int r = kh ? r8 + 8 : r8; const float ov = (kh ? o[r8 + 8] : o[r8]) + *(const LAS float*)(L + SL_XCH + (((tp * 2 + tj) * 16 + r) * 64 + lane) * 4);
                const int pr = 32 * tp + (r & 3) + 8 * (r >> 2) + 4 * (int)hh;
                go[(size_t)(row0 + pr) * WA + 32 * tj + (lane & 31)] = (bf16)(pkbf(ov, 0.f) & 0xffffu); }
        }
#pragma unroll
        for (int i = 0; i < NOWN; ++i)
#pragma unroll
            for (int st = 0; st < 2; ++st) {
                const bf16x8 f8 = pk8(S[i][8 * st], S[i][8 * st + 1], S[i][8 * st + 2], S[i][8 * st + 3], S[i][8 * st + 4], S[i][8 * st + 5], S[i][8 * st + 6], S[i][8 * st + 7]);
                *(LAS bf16x8*)(L + SL_SF + ((((kh * NKH + tp * NOWN + i) * 2 + tj) * 2 + st) * 1024) + lane * 16) = f8;
            }
        if (n + 1 < 68 && !(SKIP & 16)) store_images(n + 1);
        __syncthreads();
    }
}
#ifndef HG_MFMA
#define HG_MFMA 1
#endif
#ifndef ML_MFMA
#define ML_MFMA 1
#endif

__device__ __forceinline__ void nchain_task(Frame& F, int j) {
    const int kq = j & 3, id = j >> 2, dirn = id & 1, h = (id >> 1) & 3, b = id >> 3;
    const int tid = F.tid, lane = F.lane, w = F.wave;
    LAS unsigned char* L = F.lds;
    constexpr int NQ = 0, NK = 8192, NS = 16384;
    LAS float* SN = (LAS float*)(L + NS);
    const bf16* gq = F.XN + h * MLD + kq * 64; const bf16* gk = gq + WB;
    const float* mls = F.MLS + (size_t)(dirn * 4 + h) * MALL * 8;
    float* dqp = F.DQP + (size_t)((dirn * 4 + h) * 4 + kq) * MX;
    auto row0_of = [&](int n) -> int { if (n < 4) { const int cc = dirn ? 3 - n : n; return MX + b * CTXL + cc * 64; } const int lc = dirn ? 67 - n : n - 4; return b * SEQ + lc * 64; };
    v4u pq, pk; float pws = 0.f, pdec = 0.f;
    auto issue = [&](int n) { const int row0 = row0_of(n); const size_t off = (size_t)(row0 + (tid >> 3)) * DM + (tid & 7) * 8;
        pq = *(const GAS v4u*)(gq + off); pk = *(const GAS v4u*)(gk + off);
        if (tid < 64) { pws = mls[(size_t)(row0 + tid) * 8 + 3]; pdec = mls[(size_t)(row0 + tid) * 8 + 6]; } };
    auto stash = [&]() { *(LAS v4u*)(L + NQ + tid * 16) = pq; *(LAS v4u*)(L + NK + tid * 16) = pk; if (tid < 64) { SN[tid] = pws; if (tid == 0) SN[640] = pdec; } };
    __syncthreads();
    issue(0);
    if (tid < 64) SN[64 + tid] = 0.f;
    stash();
    __syncthreads();
#pragma unroll 1
    for (int n = 0; n < 68; ++n) {
        const int row0 = row0_of(n);
        if (n + 1 < 68) issue(n + 1);
        if (n >= 4) {
            const int p = tid >> 3, kk = tid & 7; const v4u u = *(const LAS v4u*)(L + NQ + tid * 16);
            const f32x4 na = *(const LAS f32x4*)(SN + 64 + 8 * kk), nb = *(const LAS f32x4*)(SN + 64 + 8 * kk + 4);
            float d = lo2f(u.x) * na.x + hi2f(u.x) * na.y + lo2f(u.y) * na.z + hi2f(u.y) * na.w + lo2f(u.z) * nb.x + hi2f(u.z) * nb.y + lo2f(u.w) * nb.z + hi2f(u.w) * nb.w;
            d += __shfl_xor(d, 1); d += __shfl_xor(d, 2); d += __shfl_xor(d, 4);
            if (kk == 0) dqp[row0 + p] = d;
        }
        { float a = 0.f;
#pragma unroll
          for (int i = 0; i < 8; ++i) { const int s_ = 8 * w + i; a += SN[s_] * bf2f(*(const LAS unsigned short*)(L + NK + s_ * 128 + lane * 2)); }
          SN[128 + w * 64 + lane] = a; }
        __syncthreads();
        if (tid < 64) { float nn = SN[640] * SN[64 + tid];
#pragma unroll
            for (int ww = 0; ww < 8; ++ww) nn += SN[128 + ww * 64 + tid];
            SN[64 + tid] = nn; }
        if (n + 1 < 68) stash();
        __syncthreads();
    }
}

template <int WHICH, int SKIP = 0>
__device__ __forceinline__ void p4_scan(Frame& F) {
    for (int t = F.vcu; t < 256; t += F.G) {
        if (t < 128 ? !(WHICH & 1) : !(WHICH & 2)) continue;
        if (t < 128) { if (ML_MFMA) scan_task<true, SKIP>(F, t); else { p4_mlstm_task(F, 2 * t); p4_mlstm_task(F, 2 * t + 1); } }
        else { if (HG_MFMA) { scan_task<false, SKIP>(F, t - 128); nchain_task(F, t - 128); } else { p4_hgrn2_task(F, 2 * (t - 128)); p4_hgrn2_task(F, 2 * (t - 128) + 1); } }
    }
}
__device__ __forceinline__ void p5_combine(Frame& F) {
    bf16* Y = F.XN;
    const int gw = F.vcu * NWAVES + F.wave, NGW = F.G * NWAVES;
    for (int row = gw; row < MX; row += NGW) {
        const int ch = F.lane * 16;
        {
            float o[16];
            const v4u a0 = *(const GAS v4u*)(F.OAF + (size_t)row * WA + ch), a1 = *(const GAS v4u*)(F.OAF + (size_t)row * WA + ch + 8);
            const v4u b0 = *(const GAS v4u*)(F.OAB + (size_t)row * WA + ch), b1 = *(const GAS v4u*)(F.OAB + (size_t)row * WA + ch + 8);
            const unsigned ua[8] = {a0.x, a0.y, a0.z, a0.w, a1.x, a1.y, a1.z, a1.w}, ub[8] = {b0.x, b0.y, b0.z, b0.w, b1.x, b1.y, b1.z, b1.w};
            float ss = 0.f;
#pragma unroll
            for (int j = 0; j < 8; ++j) { o[2 * j] = lo2f(ua[j]) + lo2f(ub[j]); o[2 * j + 1] = hi2f(ua[j]) + hi2f(ub[j]); ss += o[2 * j] * o[2 * j] + o[2 * j + 1] * o[2 * j + 1]; }
            ss += __shfl_xor(ss, 1); ss += __shfl_xor(ss, 2); ss += __shfl_xor(ss, 4);
            const float r = 1.f / sqrtf(ss * (1.f / HGD) + NORM_EPS);
            const v4u z0 = *(const GAS v4u*)(F.U + (size_t)row * NU + C_AZ + ch), z1 = *(const GAS v4u*)(F.U + (size_t)row * NU + C_AZ + ch + 8);
            const unsigned uz[8] = {z0.x, z0.y, z0.z, z0.w, z1.x, z1.y, z1.z, z1.w};
            unsigned w[8];
#pragma unroll
            for (int j = 0; j < 8; ++j) { const float y0 = o[2 * j] * r * F.hg_norm_w[ch + 2 * j] * siluf(lo2f(uz[j])), y1 = o[2 * j + 1] * r * F.hg_norm_w[ch + 2 * j + 1] * siluf(hi2f(uz[j])); w[j] = pk2(y0, y1); }
            *(GAS v4u*)(Y + (size_t)row * DM + ch) = (v4u){w[0], w[1], w[2], w[3]}; *(GAS v4u*)(Y + (size_t)row * DM + ch + 8) = (v4u){w[4], w[5], w[6], w[7]};
        }
        {
            float o[16];
            const v4u a0 = *(const GAS v4u*)(F.HBF + (size_t)row * WB + ch), a1 = *(const GAS v4u*)(F.HBF + (size_t)row * WB + ch + 8);
            const v4u b0 = *(const GAS v4u*)(F.HBB + (size_t)row * WB + ch), b1 = *(const GAS v4u*)(F.HBB + (size_t)row * WB + ch + 8);
            const unsigned ua[8] = {a0.x, a0.y, a0.z, a0.w, a1.x, a1.y, a1.z, a1.w}, ub[8] = {b0.x, b0.y, b0.z, b0.w, b1.x, b1.y, b1.z, b1.w};
            float s = 0.f; const int hq = F.lane >> 4;
            float invd[2];
#pragma unroll
            for (int d = 0; d < 2; ++d) { const float* mr = F.MLS + ((size_t)(d * 4 + hq) * MALL + row) * 8; const float* dq = F.DQP + (size_t)((d * 4 + hq) * 4) * MX + row;
                const float den = mr[2] * ((dq[0] + dq[MX]) + (dq[2 * MX] + dq[3 * MX])) + mr[5];
                invd[d] = rcpf_(fmaxf(fabsf(den), mr[4])); }
#pragma unroll
            for (int j = 0; j < 8; ++j) { o[2 * j] = lo2f(ua[j]) * invd[0] + lo2f(ub[j]) * invd[1]; o[2 * j + 1] = hi2f(ua[j]) * invd[0] + hi2f(ub[j]) * invd[1]; s += o[2 * j] + o[2 * j + 1]; }
            s += __shfl_xor(s, 1); s += __shfl_xor(s, 2); s += __shfl_xor(s, 4); s += __shfl_xor(s, 8);
            const float mu = s * (1.f / MLD); float q = 0.f;
#pragma unroll
            for (int j = 0; j < 16; ++j) { o[j] -= mu; q += o[j] * o[j]; }
            q += __shfl_xor(q, 1); q += __shfl_xor(q, 2); q += __shfl_xor(q, 4); q += __shfl_xor(q, 8);
            const float r = 1.f / sqrtf(q * (1.f / MLD) + NORM_EPS);
            const v4u g0 = *(const GAS v4u*)(F.U + (size_t)row * NU + C_BO + ch), g1 = *(const GAS v4u*)(F.U + (size_t)row * NU + C_BO + ch + 8);
            const v4u z0 = *(const GAS v4u*)(F.U + (size_t)row * NU + C_BZ + ch), z1 = *(const GAS v4u*)(F.U + (size_t)row * NU + C_BZ + ch + 8);
            const unsigned ug[8] = {g0.x, g0.y, g0.z, g0.w, g1.x, g1.y, g1.z, g1.w}, uz[8] = {z0.x, z0.y, z0.z, z0.w, z1.x, z1.y, z1.z, z1.w};
            unsigned w[8];
#pragma unroll
            for (int j = 0; j < 8; ++j) { const float y0 = o[2 * j] * r * F.ml_norm_w[ch + 2 * j] * sigmf(lo2f(ug[j])) * siluf(lo2f(uz[j])), y1 = o[2 * j + 1] * r * F.ml_norm_w[ch + 2 * j + 1] * sigmf(hi2f(ug[j])) * siluf(hi2f(uz[j])); w[j] = pk2(y0, y1); }
            *(GAS v4u*)(Y + (size_t)row * DM + WA + ch) = (v4u){w[0], w[1], w[2], w[3]}; *(GAS v4u*)(Y + (size_t)row * DM + WA + ch + 8) = (v4u){w[4], w[5], w[6], w[7]};
        }
    }
}

struct EpiResid {
    static constexpr bool PERM = false, AFTER_DRAIN = false;
    const float* x; const float* gate; float* out;
    __device__ __forceinline__ void operator()(const pg8::f32x4 (&acc)[2][2][4][2], const pg8::Unit& u, int wr, int wc, int fr, int fq) const {
        using pg8::BM; using pg8::HALF;
        const int row0 = u.pm * BM + wr * 64 + fr, col0 = u.pn * BM + wc * 32 + 4 * fq; const int b = (u.pm * BM) / SEQ;
        pg8::f32x4 gv[2][2];
#pragma unroll
        for (int bj = 0; bj < 2; ++bj)
#pragma unroll
            for (int n = 0; n < 2; ++n) gv[bj][n] = *(const pg8::f32x4*)(gate + b * DM + col0 + bj * HALF + n * 16);
#pragma unroll
        for (int ai = 0; ai < 2; ++ai)
#pragma unroll
            for (int m = 0; m < 4; ++m) { const size_t off = (size_t)(row0 + ai * HALF + m * 16) * DM + col0;
#pragma unroll
                for (int bj = 0; bj < 2; ++bj)
#pragma unroll
                    for (int n = 0; n < 2; ++n) { const pg8::f32x4 xv = *(const pg8::f32x4*)(x + off + bj * HALF + n * 16);
                        *(pg8::f32x4*)(out + off + bj * HALF + n * 16) = xv * ALPHA + gv[bj][n] * acc[ai][bj][m][n]; } }
    }
};


struct PanelOrder {
    int c;
    __device__ __forceinline__ bool next(int i, pg8::Unit& u) const { if (i >= 2) return false; u.pm = c >> 2; u.pn = (c & 3) + 4 * i; return true; }
    __device__ __forceinline__ void a_ready(const pg8::Unit&) const {}
    __device__ __forceinline__ void done(const pg8::Unit&) const {}
};
struct EpiLnFused {
    static constexpr bool PERM = false, AFTER_DRAIN = true;
    const float* x; const float* gate; float* out; const float* ln_g; const float* ln_b;
    unsigned long long* xbuf;
    unsigned* cnt;
    __device__ __forceinline__ void zstats(pg8::f32x4 (&acc)[2][2][4][2], const pg8::Unit& u, int wr, int wc, int fr, int fq) const {
        using pg8::BM; using pg8::HALF;
        asm volatile("" : "+v"(fr), "+v"(fq));
        const int row0 = u.pm * BM + wr * 64 + fr, col0 = u.pn * BM + wc * 32 + 4 * fq; const int b = (u.pm * BM) / SEQ;
        pg8::f32x4 gv[2][2];
#pragma unroll
        for (int bj = 0; bj < 2; ++bj)
#pragma unroll
            for (int n = 0; n < 2; ++n) gv[bj][n] = *(const pg8::f32x4*)(gate + b * DM + col0 + bj * HALF + n * 16);
#pragma unroll
        for (int ai = 0; ai < 2; ++ai)
#pragma unroll
            for (int m = 0; m < 4; ++m) { const int row = row0 + ai * HALF + m * 16; const size_t off = (size_t)row * DM + col0;
                float s = 0.f;
#pragma unroll
                for (int bj = 0; bj < 2; ++bj)
#pragma unroll
                    for (int n = 0; n < 2; ++n) { const pg8::f32x4 xv = *(const pg8::f32x4*)(x + off + bj * HALF + n * 16);
                        const pg8::f32x4 z = xv * ALPHA + gv[bj][n] * acc[ai][bj][m][n]; acc[ai][bj][m][n] = z; s += (z[0] + z[1]) + (z[2] + z[3]); }
                s += __shfl_xor(s, 16); s += __shfl_xor(s, 32);
                const float mw = s * (1.0f / 64.0f); float q = 0.f;
#pragma unroll
                for (int bj = 0; bj < 2; ++bj)
#pragma unroll
                    for (int n = 0; n < 2; ++n) { const pg8::f32x4 d = acc[ai][bj][m][n] - mw; q += (d[0] * d[0] + d[1] * d[1]) + (d[2] * d[2] + d[3] * d[3]); }
                q += __shfl_xor(q, 16); q += __shfl_xor(q, 32);
                if (fq == 0) __hip_atomic_store(xbuf + (size_t)row * 32 + u.pn * 4 + wc, ((unsigned long long)__float_as_uint(q) << 32) | __float_as_uint(mw), __ATOMIC_RELAXED, __HIP_MEMORY_SCOPE_AGENT);
            }
    }
    __device__ __forceinline__ void publish(const pg8::Unit& u) const {
        asm volatile("s_waitcnt vmcnt(0)" ::: "memory");
        if ((threadIdx.x & 63) == 0) __hip_atomic_fetch_add(cnt + 64 * u.pm, 1u, __ATOMIC_RELAXED, __HIP_MEMORY_SCOPE_AGENT);
    }
    __device__ __forceinline__ void operator()(const pg8::f32x4 (&acc_c)[2][2][4][2], const pg8::Unit& u, int wr, int wc, int fr, int fq) const {
        using pg8::BM; using pg8::HALF;
        pg8::f32x4 (&acc)[2][2][4][2] = const_cast<pg8::f32x4 (&)[2][2][4][2]>(acc_c);
        zstats(acc, u, wr, wc, fr, fq);
        const int row0 = u.pm * BM + wr * 64 + fr, col0 = u.pn * BM + wc * 32 + 4 * fq;
#pragma unroll
        for (int ai = 0; ai < 2; ++ai)
#pragma unroll
            for (int m = 0; m < 4; ++m) { const size_t off = (size_t)(row0 + ai * HALF + m * 16) * DM + col0;
#pragma unroll
                for (int bj = 0; bj < 2; ++bj)
#pragma unroll
                    for (int n = 0; n < 2; ++n) *(pg8::f32x4*)(out + off + bj * HALF + n * 16) = acc[ai][bj][m][n]; }
        publish(u);
    }
    __device__ __forceinline__ void fused(pg8::f32x4 (&acc)[2][2][4][2], const pg8::Unit& u, int wr, int wc, int fr, int fq, PG8_LAS unsigned char* lds, int wid, int lane) const {
        using pg8::BM; using pg8::HALF;
        typedef float f32x2v __attribute__((ext_vector_type(2)));
        PG8_LAS f32x2v* PH = (PG8_LAS f32x2v*)(lds + 131072);
        PG8_LAS f32x2v* S = (PG8_LAS f32x2v*)(lds + 131072 + 4096);
        zstats(acc, u, wr, wc, fr, fq);
        publish(u);
        if (wid == 0) {
            unsigned spins = 0;
            while ((unsigned)__builtin_amdgcn_readfirstlane(__hip_atomic_load(cnt + 64 * u.pm, __ATOMIC_RELAXED, __HIP_MEMORY_SCOPE_AGENT)) < 64u) { __builtin_amdgcn_s_sleep(2); if (++spins > (1u << 22)) break; }
            __builtin_amdgcn_fence(__ATOMIC_ACQUIRE, "agent");
            asm volatile("s_waitcnt vmcnt(0)" ::: "memory");
        }
        asm volatile("s_waitcnt vmcnt(0) lgkmcnt(0)" ::: "memory"); __builtin_amdgcn_s_barrier(); asm volatile("" ::: "memory");
        { const int t = threadIdx.x, row = t >> 1, half = t & 1; const unsigned long long* sl = xbuf + (size_t)(u.pm * BM + row) * 32 + half * 16;
          float ms = 0.f, mq = 0.f, m2s = 0.f;
#pragma unroll
          for (int i = 0; i < 16; ++i) { const unsigned long long w = __hip_atomic_load(sl + i, __ATOMIC_RELAXED, __HIP_MEMORY_SCOPE_AGENT); const float mt = __uint_as_float((unsigned)w); ms += mt; mq += mt * mt; m2s += __uint_as_float((unsigned)(w >> 32)); }
          const float mh = ms * (1.0f / 16.0f);
          PH[row * 2 + half] = (f32x2v){mh, m2s + 64.0f * fmaxf(mq - 16.0f * mh * mh, 0.f)}; }
        asm volatile("s_waitcnt lgkmcnt(0)" ::: "memory"); __builtin_amdgcn_s_barrier(); asm volatile("" ::: "memory");
        if (threadIdx.x < 256) { const int row = threadIdx.x; const f32x2v a = PH[row * 2], bq = PH[row * 2 + 1];
            const float mean = 0.5f * (a.x + bq.x), da = a.x - mean, db = bq.x - mean; const float m2t = (a.y + bq.y) + 1024.0f * (da * da + db * db);
            S[row] = (f32x2v){mean, 1.0f / sqrtf(m2t * (1.0f / 2048.0f) + LN_EPS)}; }
        asm volatile("s_waitcnt lgkmcnt(0)" ::: "memory"); __builtin_amdgcn_s_barrier(); asm volatile("" ::: "memory");
        const int row0 = u.pm * BM + wr * 64 + fr, col0 = u.pn * BM + wc * 32 + 4 * fq;
#pragma unroll
        for (int bj = 0; bj < 2; ++bj)
#pragma unroll
            for (int n = 0; n < 2; ++n) { const int c = col0 + bj * HALF + n * 16;
                const pg8::f32x4 g2 = *(const pg8::f32x4*)(ln_g + c), b2 = *(const pg8::f32x4*)(ln_b + c), g1 = *(const pg8::f32x4*)(ln_g + c - 4 * BM), b1 = *(const pg8::f32x4*)(ln_b + c - 4 * BM);
#pragma unroll
                for (int ai = 0; ai < 2; ++ai)
#pragma unroll
                    for (int m = 0; m < 4; ++m) { const int rl = ai * HALF + wr * 64 + m * 16 + fr; const f32x2v sr = S[rl]; const size_t off = (size_t)(row0 + ai * HALF + m * 16) * DM + c;
                        const pg8::f32x4 z1 = *(const pg8::f32x4*)(out + off - 4 * BM);
                        *(pg8::f32x4*)(out + off) = (acc[ai][bj][m][n] - sr.x) * sr.y * g2 + b2;
                        acc[ai][bj][m][n] = (z1 - sr.x) * sr.y * g1 + b1; }
#pragma unroll
                for (int ai = 0; ai < 2; ++ai)
#pragma unroll
                    for (int m = 0; m < 4; ++m) { const size_t off = (size_t)(row0 + ai * HALF + m * 16) * DM + c; *(pg8::f32x4*)(out + off - 4 * BM) = acc[ai][bj][m][n]; } }
    }
};

__device__ __forceinline__ void p7_ln(Frame& F) {
    const int gw = F.vcu * NWAVES + F.wave, NGW = F.G * NWAVES;
    for (int row = 2 * gw; row < MX; row += 2 * NGW) {
        GAS f32x4* ra = (GAS f32x4*)(F.out + (size_t)row * DM) + F.lane; GAS f32x4* rb = ra + DM / 4;
        f32x4 va[8], vb[8]; float sa = 0.f, sb = 0.f;
#pragma unroll
        for (int j = 0; j < 8; ++j) { va[j] = ra[64 * j]; vb[j] = rb[64 * j]; }
#pragma unroll
        for (int j = 0; j < 8; ++j) { sa += (va[j].x + va[j].y) + (va[j].z + va[j].w); sb += (vb[j].x + vb[j].y) + (vb[j].z + vb[j].w); }
        const float ma = wave_sum(sa) * (1.f / DM), mb = wave_sum(sb) * (1.f / DM); float qa = 0.f, qb = 0.f;
#pragma unroll
        for (int j = 0; j < 8; ++j) { va[j] = va[j] - ma; vb[j] = vb[j] - mb; qa += (va[j].x * va[j].x + va[j].y * va[j].y) + (va[j].z * va[j].z + va[j].w * va[j].w); qb += (vb[j].x * vb[j].x + vb[j].y * vb[j].y) + (vb[j].z * vb[j].z + vb[j].w * vb[j].w); }
        const float rsa = 1.f / sqrtf(wave_sum(qa) * (1.f / DM) + LN_EPS), rsb = 1.f / sqrtf(wave_sum(qb) * (1.f / DM) + LN_EPS);
#pragma unroll
        for (int j = 0; j < 8; ++j) { const int k = 4 * F.lane + 256 * j; const f32x4 g = *(const f32x4*)(F.ln_g + k), bb = *(const f32x4*)(F.ln_b + k);
            ra[64 * j] = va[j] * rsa * g + bb; rb[64 * j] = vb[j] * rsb * g + bb; }
    }
}

struct Args { const float* in[16]; float* out; unsigned char* ws; int ph_lo, ph_hi, li, pad; };
__global__ void __launch_bounds__(NWAVES * 64, 2) mk_fwd(Args args) {
    extern __shared__ __attribute__((aligned(16))) unsigned char lds[];
    Frame F;
    F.lds = (LAS unsigned char*)lds;
    F.MISC = (volatile LAS unsigned*)(F.lds + MISC_OFF);
    F.tid = threadIdx.x; F.lane = F.tid & 63; F.wave = __builtin_amdgcn_readfirstlane(F.tid >> 6);
    F.G = gridDim.x; { const int bx = blockIdx.x; F.vcu = (F.G % 8 == 0) ? (bx % 8) * (F.G / 8) + bx / 8 : bx; }
    unsigned char* ws = args.ws;
    F.ctl = (gu32*)(ws + WS_CTL);
    F.x = args.in[0]; F.c = args.in[1]; F.ctx = args.in[2]; F.c_ctx = args.in[3]; F.w_mod = args.in[4]; F.b_mod = args.in[5]; F.w_in = args.in[6];
    F.conv_w = args.in[7]; F.conv_b = args.in[8]; F.hg_lb = args.in[9]; F.ml_gate_b = args.in[10]; F.hg_norm_w = args.in[11]; F.ml_norm_w = args.in[12];
    F.w_out = args.in[13]; F.ln_g = args.in[14]; F.ln_b = args.in[15]; F.out = args.out;
    F.modp = (float*)(ws + WS_MODP); F.gate = (float*)(ws + WS_GATE);
    F.QTF = (bf16*)(ws + WS_WINT); F.PE = (float*)(ws + WS_PE); F.MLS = (float*)(ws + WS_MLS); F.DEC = (float*)(ws + WS_DEC); F.MLW = (bf16*)(ws + WS_MLW); F.DQP = (float*)(ws + WS_DQP);
    F.WinT = (bf16*)(ws + WS_WINT); F.WoutT = (bf16*)(ws + WS_WOUTT); F.XN = (bf16*)(ws + WS_XN); F.U = (bf16*)(ws + WS_U);
    F.OAF = (bf16*)args.out; F.OAB = F.OAF + (size_t)MX * WA; F.HBF = F.OAB + (size_t)MX * WA; F.HBB = F.HBF + (size_t)MX * WB;
    for (int u = F.tid; u < (LDS_BYTES - LDSCTL_OFF) / 4; u += NT) ((LAS unsigned*)(F.lds + LDSCTL_OFF))[u] = 0u;
    __syncthreads();
    XcdBarrier bar; bar.bar = (unsigned*)(F.ctl + CW_BAR); bar.x = 0; bar.st = nullptr;
    if (MK_N_LAUNCHES == 1) bar = xcd_barrier_post((unsigned*)(F.ctl + CW_BAR), F.MISC + 8);
    const int lo = args.ph_lo, hi = args.ph_hi;
#ifndef PH_MASK
#define PH_MASK 255
#endif
#define PHON(k) ((PH_MASK >> (k)) & 1)
#ifndef DUP_MASK
#define DUP_MASK 0
#endif
#define DUP(k) ((DUP_MASK >> (k)) & 1)
#ifndef FUSE_LN
#define FUSE_LN 0
#endif
#ifndef DUP4S
#define DUP4S 0
#endif
#ifndef DUP4W
#define DUP4W 3
#endif
#ifndef DUP3W
#define DUP3W 7
#endif
#define IN(k) (lo <= (k) && (k) < hi)
#define SEAM(k) do { if (IN(k) && IN((k) + 1)) xcd_barrier(bar); } while (0)
    if (PHON(0) && IN(0)) { p0_prep(F); if (DUP(0)) p0_prep(F); } SEAM(0);
    if (PHON(1) && IN(1)) { p1_lnmod(F); if (DUP(1)) p1_lnmod(F); } SEAM(1);
    if (PHON(2) && IN(2)) { pg8::Gemm g{F.XN, F.WinT, MALL, NU, DM}; pg8::StaticOrder S; S.init(MALL, NU, F.G, (int)blockIdx.x);
        pg8::EpiBf16<0> E{F.U, NU, nullptr, 0, 0, 1.f};
        pg8::gemm_phase<pg8::EpiBf16<0>, pg8::StaticOrder, PG8_ALIGN, PG8_SP2>(F.lds + RING_OFF, g, S, E); } SEAM(2);
    if (PHON(3) && IN(3)) { if (DUP(3)) { if (DUP3W & 1) p3_hg_prep<true>(F); if (DUP3W & 2) p3_conv(F); if (DUP3W & 4) p3_ml_scalars(F); } p3_conv(F); if (HG_MFMA) p3_hg_prep<false>(F); if (ML_MFMA) p3_ml_scalars(F); xcd_barrier(bar); p3b_ml_scores(F); if (DUP(6)) p3b_ml_scores(F); } SEAM(3);
    if (PHON(4) && IN(4)) { if (DUP(4)) p4_scan<DUP4W, DUP4S>(F); p4_scan<3>(F); } SEAM(4);
    if (PHON(5) && IN(5)) { p5_combine(F); if (DUP(5)) p5_combine(F); if (DUP(7)) { xcd_barrier(bar); xcd_barrier(bar); xcd_barrier(bar); xcd_barrier(bar); } } SEAM(5);
    if (PHON(6) && IN(6)) { pg8::Gemm g{F.XN, F.WoutT, MX, DM, DM}; pg8::StaticOrder S; S.init(MX, DM, F.G, (int)blockIdx.x);
        if (F.G == 256 && FUSE_LN) { PanelOrder PO{F.vcu}; EpiLnFused E{F.x, F.gate, F.out, F.ln_g, F.ln_b, (unsigned long long*)(args.ws + WS_XB), (unsigned*)(F.ctl + CW_PANEL)};
            pg8::gemm_phase<EpiLnFused, PanelOrder, PG8_ALIGN, PG8_SP2>(F.lds + RING_OFF, g, PO, E); }
        else { EpiResid E{F.x, F.gate, F.out};
            pg8::gemm_phase<EpiResid, pg8::StaticOrder, PG8_ALIGN, PG8_SP2>(F.lds + RING_OFF, g, S, E);
            if (DUP(8)) { __syncthreads(); pg8::gemm_phase<EpiResid, pg8::StaticOrder, PG8_ALIGN, PG8_SP2>(F.lds + RING_OFF, g, S, E); } } }
    if (!(F.G == 256 && FUSE_LN)) { SEAM(6); if (PHON(7) && IN(7)) { p7_ln(F); } }
#undef IN
#undef SEAM
}

extern "C" void kernel_launch(void* const* d_in, const int* in_sizes, int n_in, void* d_out, int out_size, void* d_ws, size_t ws_size, hipStream_t stream) {
    static int grid = 0;
    if (grid == 0) {
        if (n_in != 16 || out_size != MX * DM || ws_size < WS_END) { fprintf(stderr, "kernel_launch: unexpected shapes (n_in %d out %d ws %zu)\n", n_in, out_size, ws_size); grid = -1; return; }
        int dev = 0, cus = 0, per_cu = 0;
        if (hipGetDevice(&dev) != hipSuccess || hipDeviceGetAttribute(&cus, hipDeviceAttributeMultiprocessorCount, dev) != hipSuccess) { grid = -1; return; }
        if (hipFuncSetAttribute((const void*)mk_fwd, hipFuncAttributeMaxDynamicSharedMemorySize, LDS_BYTES) != hipSuccess) { fprintf(stderr, "kernel_launch: hipFuncSetAttribute failed\n"); grid = -1; return; }
        if (hipOccupancyMaxActiveBlocksPerMultiprocessor(&per_cu, (const void*)mk_fwd, NT, LDS_BYTES) != hipSuccess || per_cu < 1) { fprintf(stderr, "kernel_launch: occupancy query says %d\n", per_cu); per_cu = 1; }
        (void)hipGetLastError();
        grid = cus;
    }
    if (grid < 0) return;
    if (hipMemsetAsync((char*)d_ws + WS_CTL, 0, CTL_ZERO_BYTES, stream) != hipSuccess) { fprintf(stderr, "kernel_launch: memset failed\n"); return; }
    Args a{};
    for (int i = 0; i < 16; ++i) a.in[i] = (const float*)d_in[i];
    a.out = (float*)d_out; a.ws = (unsigned char*)d_ws;
    for (int li = 0; li < MK_N_LAUNCHES; ++li) {
        a.ph_lo = (MK_N_LAUNCHES == 1) ? 0 : li; a.ph_hi = (MK_N_LAUNCHES == 1) ? N_PHASES : li + 1; a.li = li;
        hipLaunchKernelGGL(mk_fwd, dim3(grid), dim3(NT), LDS_BYTES, stream, a);
        const hipError_t le = hipPeekAtLastError();
        if (le != hipSuccess) { fprintf(stderr, "kernel_launch: launch %d failed: %s\n", li, hipGetErrorName(le)); break; }
    }
}
```

```cpp
#include <hip/hip_runtime.h>
#include <cstdio>
#include <cstdint>
namespace pg8 {
#define PG8_LAS __attribute__((address_space(3)))
typedef unsigned short bf16_t;
typedef short bf16x8 __attribute__((ext_vector_type(8)));
typedef float f32x4 __attribute__((ext_vector_type(4)));
typedef unsigned u32x4 __attribute__((ext_vector_type(4)));
constexpr int BM = 256, BK = 64, HALF = 128, HTB = HALF * BK * 2  , STAGE_BYTES = 8 * HTB, NXCD = 8, WGM = 4;

__host__ __device__ __forceinline__ int lds_byte(int r, int c) { const int st = (r >> 4) * 2 + (c >> 5), rr = r & 15, cc = c & 31, ob = rr * 64 + cc * 2; return st * 1024 + (ob ^ (((ob >> 9) & 1) << 5)); }
__host__ __device__ __forceinline__ void stage_rc(int b, int& R, int& C) { const int st = b / 1024, sb = b % 1024, swz = sb ^ (((sb >> 9) & 1) << 5); R = (st >> 1) * 16 + swz / 64; C = (st & 1) * 32 + (swz % 64) / 2; }
__host__ __device__ __forceinline__ int perm32(int rho) { const int n = rho >> 4, i = rho & 15; return 8 * (i >> 2) + 4 * n + (i & 3); }

struct Unit { int pm, pn; };
struct Gemm { const bf16_t* A; const bf16_t* Bt; int M, N, K; };

struct StaticOrder {
    int nM, nN, nwg, G, c;
    __host__ __device__ void init(int M, int N, int G_, int c_) { nM = M / BM; nN = N / BM; nwg = nM * nN; G = G_; c = c_; }
    __host__ __device__ bool next(int i, Unit& u) const {
        const long L = (long)i * G + c; if (L >= nwg) return false;
        int wgid = (int)L; { const int q = nwg / NXCD, r = nwg % NXCD, xcd = wgid % NXCD, off = wgid / NXCD; wgid = (xcd < r ? xcd * (q + 1) : r * (q + 1) + (xcd - r) * q) + off; }
        const int nig = WGM * nN, gid = wgid / nig, fm = gid * WGM, gsz = (nM - fm) < WGM ? (nM - fm) : WGM;
        u.pm = fm + ((wgid % nig) % gsz); u.pn = (wgid % nig) / gsz; return true;
    }
    __device__ __forceinline__ void a_ready(const Unit&) const {}
    __device__ __forceinline__ void done(const Unit&) const {}
};

__device__ __forceinline__ unsigned cvt_pk_bf16(float lo, float hi) { unsigned r; asm volatile("v_cvt_pk_bf16_f32 %0, %1, %2" : "=v"(r) : "v"(lo), "v"(hi)); return r; }
typedef float f32x2 __attribute__((ext_vector_type(2)));
__device__ __forceinline__ f32x2 gelu_pk(f32x2 v) {
    const f32x2 av = __builtin_elementwise_abs(v), d = av * 0.2316418882f + 1.0f;
    f32x2 t; t.x = __builtin_amdgcn_rcpf(d.x); t.y = __builtin_amdgcn_rcpf(d.y);
    f32x2 q = t * 0.5307027145f + (-0.7265760135f); q = q * t + 0.7107068705f; q = q * t + (-0.142248368f); q = q * t + 0.127414796f; q = q * t;
    const f32x2 s = (v * v) * (-0.72134752044f);
    f32x2 e; e.x = __builtin_amdgcn_exp2f(s.x); e.y = __builtin_amdgcn_exp2f(s.y);
    const f32x2 m = v * (q * e), r = v - m;
    f32x2 o; o.x = v.x < 0.f ? m.x : r.x; o.y = v.y < 0.f ? m.y : r.y; return o;
}

template <int ACT  > struct EpiBf16 {
    static constexpr bool PERM = true, AFTER_DRAIN = false; static_assert(ACT == 0 || ACT == 1, "EpiBf16: ACT is 0 (none) or 1 (gelu_pk)");
    bf16_t* O; int ldc; const float* bias; int split_cols; size_t split_stride; float scale0;
    __device__ __forceinline__ void operator()(const f32x4 (&acc)[2][2][4][2], const Unit& u, int wr, int wc, int fr, int fq) const {
        const int row0 = u.pm * BM + wr * 64 + fr; int colt = u.pn * BM; bf16_t* base = O;
        float sc = 1.f; if (split_cols) { const int t = colt / split_cols; base += (size_t)t * split_stride; colt -= t * split_cols; if (t == 0) sc = scale0; }
        const int col0 = colt + wc * 32 + 8 * fq, bcol0 = u.pn * BM + wc * 32 + 8 * fq;
        f32x4 bv[2][2];
#pragma unroll
        for (int bj = 0; bj < 2; ++bj)
#pragma unroll
            for (int n = 0; n < 2; ++n) bv[bj][n] = bias ? *(const f32x4*)(bias + bcol0 + bj * HALF + 4 * n) : (f32x4){0.f, 0.f, 0.f, 0.f};
#pragma unroll
        for (int ai = 0; ai < 2; ++ai)
#pragma unroll
            for (int m = 0; m < 4; ++m) { bf16_t* rowp = base + (size_t)(row0 + ai * HALF + m * 16) * ldc + col0;
#pragma unroll
                for (int bj = 0; bj < 2; ++bj) { f32x4 v0 = acc[ai][bj][m][0] + bv[bj][0], v1 = acc[ai][bj][m][1] + bv[bj][1];
                    if (ACT == 1) { f32x2 a = gelu_pk((f32x2){v0[0], v0[1]}), b = gelu_pk((f32x2){v0[2], v0[3]}), c = gelu_pk((f32x2){v1[0], v1[1]}), d = gelu_pk((f32x2){v1[2], v1[3]});
                        v0 = (f32x4){a.x, a.y, b.x, b.y}; v1 = (f32x4){c.x, c.y, d.x, d.y}; }
                    v0 = v0 * sc; v1 = v1 * sc; u32x4 w; w.x = cvt_pk_bf16(v0[0], v0[1]); w.y = cvt_pk_bf16(v0[2], v0[3]); w.z = cvt_pk_bf16(v1[0], v1[1]); w.w = cvt_pk_bf16(v1[2], v1[3]);
                    *(u32x4*)(rowp + bj * HALF) = w; } }
    }
};
template <class Epi, class Sched, bool ALIGN_EPI = false, bool SP2 = false>
__device__ __forceinline__ void gemm_phase(PG8_LAS unsigned char* lds, const Gemm g, const Sched& S, const Epi& E) {
    const int tid = threadIdx.x, wid = __builtin_amdgcn_readfirstlane(tid >> 6), lane = tid & 63, wr = wid >> 2, wc = wid & 3, fr = lane & 15, fq = lane >> 4;
    const int K = g.K, nt = K / BK;
    unsigned voffA[2], voffB[2];
#pragma unroll
    for (int i = 0; i < 2; ++i) { int R, C; stage_rc(tid * 16 + i * 8192, R, C); const int Rb = Epi::PERM ? ((R & ~31) + perm32(R & 31)) : R;
        voffA[i] = (unsigned)(R * K + C) * 2u; voffB[i] = (unsigned)(Rb * K + C) * 2u; }
    const size_t kstep = (size_t)(BK * 2);
    const size_t hstep = (size_t)HALF * K * 2;
    const size_t tstep = 2 * hstep;
    const unsigned ldsw = (unsigned)wid * 1024u;
    const int aoff = lds_byte(wr * 64 + fr, fq * 8), boff = lds_byte(wc * 32 + fr, fq * 8);
#define PG8_SA(b, h) (((b) * 2 + (h)) * HTB)
#define PG8_SB(b, h) ((4 + (b) * 2 + (h)) * HTB)
#define PG8_STAGE(bufoff, gbase, voff) do { _Pragma("unroll") for (int _i = 0; _i < 2; ++_i) \
        __builtin_amdgcn_global_load_lds((const unsigned*)((const char*)(gbase) + (voff)[_i]), (PG8_LAS unsigned*)(lds + (bufoff) + ldsw + _i * 8192), 16, 0, 0); } while (0)
#define PG8_LDA(dst, b, h) do { _Pragma("unroll") for (int m = 0; m < 4; ++m) _Pragma("unroll") for (int k = 0; k < 2; ++k) dst[m][k] = *(const PG8_LAS bf16x8*)(lds + PG8_SA(b, h) + aoff + m * 2048 + k * 1024); } while (0)
#define PG8_LDB(dst, b, h) do { _Pragma("unroll") for (int n = 0; n < 2; ++n) _Pragma("unroll") for (int k = 0; k < 2; ++k) dst[n][k] = *(const PG8_LAS bf16x8*)(lds + PG8_SB(b, h) + boff + n * 2048 + k * 1024); } while (0)
#define PG8_MMA(ai, bj, At, Bt) do { __builtin_amdgcn_s_setprio(1); _Pragma("unroll") for (int m = 0; m < 4; ++m) _Pragma("unroll") for (int n = 0; n < 2; ++n) _Pragma("unroll") for (int k = 0; k < 2; ++k) \
        acc[ai][bj][m][n] = __builtin_amdgcn_mfma_f32_16x16x32_bf16(Bt[n][k], At[m][k], acc[ai][bj][m][n], 0, 0, 0); __builtin_amdgcn_s_setprio(0); } while (0)
#define PG8_WAIT_V(n) asm volatile("s_waitcnt vmcnt(" #n ")" ::: "memory")
#define PG8_WAIT_L(n) asm volatile("s_waitcnt lgkmcnt(" #n ")" ::: "memory")
#define PG8_BAR __builtin_amdgcn_s_barrier()
#define PG8_SCHED __builtin_amdgcn_sched_barrier(0)
    Unit cur, nxt; int ui = 0;
    if (!S.next(0, cur)) return;
    f32x4 acc[2][2][4][2];
#pragma unroll
    for (int a = 0; a < 2; ++a)
#pragma unroll
        for (int b = 0; b < 2; ++b)
#pragma unroll
            for (int m = 0; m < 4; ++m)
#pragma unroll
                for (int n = 0; n < 2; ++n) acc[a][b][m][n] = (f32x4){0.f, 0.f, 0.f, 0.f};
    bf16x8 At[4][2], B0[2][2], B1[2][2];
    const char* cA = (const char*)g.A + (size_t)cur.pm * tstep; const char* cB = (const char*)g.Bt + (size_t)cur.pn * tstep;
    S.a_ready(cur);
    if constexpr (SP2) {
        PG8_STAGE(PG8_SB(0, 0), cB, voffB); PG8_STAGE(PG8_SB(0, 1), cB + hstep, voffB); PG8_STAGE(PG8_SA(0, 0), cA, voffA); PG8_STAGE(PG8_SA(0, 1), cA + hstep, voffA);
        if (wr == 1) PG8_BAR;
        PG8_WAIT_V(2); PG8_BAR;
        PG8_STAGE(PG8_SB(1, 0), cB + kstep, voffB); PG8_STAGE(PG8_SA(1, 0), cA + kstep, voffA); PG8_STAGE(PG8_SB(1, 1), cB + hstep + kstep, voffB);
        PG8_WAIT_V(6); PG8_BAR;
    } else {
        PG8_STAGE(PG8_SB(0, 0), cB, voffB); PG8_STAGE(PG8_SA(0, 0), cA, voffA); PG8_STAGE(PG8_SB(0, 1), cB + hstep, voffB); PG8_STAGE(PG8_SA(0, 1), cA + hstep, voffA);
        if (wr == 1) PG8_BAR;
        PG8_WAIT_V(4); PG8_BAR;
        PG8_STAGE(PG8_SB(1, 0), cB + kstep, voffB); PG8_STAGE(PG8_SA(1, 0), cA + kstep, voffA); PG8_STAGE(PG8_SB(1, 1), cB + hstep + kstep, voffB);
        PG8_WAIT_V(6); PG8_BAR;
    }
    for (;;) {
        const bool has_next = S.next(ui + 1, nxt);
        const char* nA = has_next ? (const char*)g.A + (size_t)nxt.pm * tstep : cA; const char* nB = has_next ? (const char*)g.Bt + (size_t)nxt.pn * tstep : cB;
        for (int t = 0; t < nt; t += 2) {
            const bool last = (t == nt - 2);
            const char* a1 = cA + (size_t)(t + 1) * kstep;
            const char* a2 = last ? nA : cA + (size_t)(t + 2) * kstep; const char* b2 = last ? nB : cB + (size_t)(t + 2) * kstep;
            const char* a3 = a2 + kstep; const char* b3 = b2 + kstep;
            if (last && has_next) S.a_ready(nxt);
            if constexpr (SP2) {
            PG8_LDB(B0, 0, 0); PG8_LDB(B1, 0, 1); PG8_SCHED; PG8_LDA(At, 0, 0); PG8_STAGE(PG8_SA(1, 1), a1 + hstep, voffA);
            PG8_WAIT_V(8); PG8_WAIT_L(0); PG8_BAR; PG8_MMA(0, 0, At, B0); PG8_MMA(0, 1, At, B1); PG8_BAR; PG8_SCHED;
            PG8_LDA(At, 0, 1); PG8_STAGE(PG8_SB(0, 0), b2, voffB); PG8_STAGE(PG8_SB(0, 1), b2 + hstep, voffB); PG8_STAGE(PG8_SA(0, 0), a2, voffA);
            PG8_WAIT_V(8); PG8_WAIT_L(0); PG8_BAR; PG8_MMA(1, 0, At, B0); PG8_MMA(1, 1, At, B1); PG8_BAR; PG8_SCHED;
            PG8_LDB(B0, 1, 0); PG8_LDB(B1, 1, 1); PG8_SCHED; PG8_LDA(At, 1, 0); PG8_STAGE(PG8_SA(0, 1), a2 + hstep, voffA);
            PG8_WAIT_V(8); PG8_WAIT_L(0); PG8_BAR; PG8_MMA(0, 0, At, B0); PG8_MMA(0, 1, At, B1); PG8_BAR; PG8_SCHED;
            PG8_LDA(At, 1, 1); PG8_STAGE(PG8_SB(1, 0), b3, voffB); PG8_STAGE(PG8_SB(1, 1), b3 + hstep, voffB); PG8_STAGE(PG8_SA(1, 0), a3, voffA);
            PG8_WAIT_V(8); PG8_WAIT_L(0); PG8_BAR; PG8_MMA(1, 0, At, B0); PG8_MMA(1, 1, At, B1); PG8_BAR; PG8_SCHED;
            } else {
            PG8_LDB(B0, 0, 0); PG8_SCHED; PG8_LDA(At, 0, 0); PG8_STAGE(PG8_SA(1, 1), a1 + hstep, voffA);
            PG8_WAIT_L(8); PG8_BAR; PG8_WAIT_L(0); PG8_MMA(0, 0, At, B0); PG8_BAR; PG8_SCHED;
            PG8_LDB(B1, 0, 1); PG8_STAGE(PG8_SB(0, 0), b2, voffB);
            PG8_BAR; PG8_WAIT_L(0); PG8_MMA(0, 1, At, B1); PG8_BAR;
            PG8_LDA(At, 0, 1); PG8_STAGE(PG8_SA(0, 0), a2, voffA);
            PG8_BAR; PG8_WAIT_L(0); PG8_MMA(1, 0, At, B0); PG8_BAR; PG8_SCHED;
            PG8_STAGE(PG8_SB(0, 1), b2 + hstep, voffB);
            PG8_WAIT_V(6); PG8_BAR; PG8_MMA(1, 1, At, B1); PG8_BAR;
            PG8_LDB(B0, 1, 0); PG8_SCHED; PG8_LDA(At, 1, 0); PG8_STAGE(PG8_SA(0, 1), a2 + hstep, voffA);
            PG8_WAIT_L(8); PG8_BAR; PG8_WAIT_L(0); PG8_MMA(0, 0, At, B0); PG8_BAR; PG8_SCHED;
            PG8_LDB(B1, 1, 1); PG8_STAGE(PG8_SB(1, 0), b3, voffB);
            PG8_BAR; PG8_WAIT_L(0); PG8_MMA(0, 1, At, B1); PG8_BAR;
            PG8_LDA(At, 1, 1); PG8_STAGE(PG8_SA(1, 0), a3, voffA);
            PG8_BAR; PG8_WAIT_L(0); PG8_MMA(1, 0, At, B0); PG8_BAR; PG8_SCHED;
            PG8_STAGE(PG8_SB(1, 1), b3 + hstep, voffB);
            PG8_WAIT_V(6); PG8_BAR; PG8_MMA(1, 1, At, B1); PG8_BAR;
            }
        }
        if constexpr (ALIGN_EPI) { if (wr == 0) PG8_BAR; }
        if constexpr (!Epi::AFTER_DRAIN) { E(acc, cur, wr, wc, fr, fq); S.done(cur); }
        else { if (has_next) { E(acc, cur, wr, wc, fr, fq); S.done(cur); } }
        if (!has_next) break;
#pragma unroll
        for (int a = 0; a < 2; ++a)
#pragma unroll
            for (int b = 0; b < 2; ++b)
#pragma unroll
                for (int m = 0; m < 4; ++m)
#pragma unroll
                    for (int n = 0; n < 2; ++n) acc[a][b][m][n] = (f32x4){0.f, 0.f, 0.f, 0.f};
        cur = nxt; cA = nA; cB = nB; ++ui;
        if constexpr (ALIGN_EPI) { if (wr == 1) PG8_BAR; }
    }
    PG8_WAIT_V(0);
    if constexpr (!ALIGN_EPI) { if (wr == 0) PG8_BAR; }
    PG8_BAR;
    if constexpr (Epi::AFTER_DRAIN) { E.fused(acc, cur, wr, wc, fr, fq, lds, wid, lane); S.done(cur); }
#undef PG8_SA
#undef PG8_SB
#undef PG8_STAGE
#undef PG8_LDA
#undef PG8_LDB
#undef PG8_MMA
#undef PG8_WAIT_V
#undef PG8_WAIT_L
#undef PG8_BAR
#undef PG8_SCHED
}
}

#ifndef PG8_SP2
#define PG8_SP2 true
#endif
#ifndef PG8_ALIGN
#define PG8_ALIGN true
#endif
#define GAS __attribute__((address_space(1)))
#define LAS __attribute__((address_space(3)))
typedef unsigned short bf16;
typedef unsigned v4u __attribute__((ext_vector_type(4)));
typedef float f32x4 __attribute__((ext_vector_type(4)));
typedef short bf16x8 __attribute__((ext_vector_type(8)));
typedef GAS unsigned gu32;
typedef GAS unsigned long long gu64;
#define RLX_AGENT __ATOMIC_RELAXED, __HIP_MEMORY_SCOPE_AGENT
#define LDS_WAIT() asm volatile("s_waitcnt lgkmcnt(0)" ::: "memory")
#define VM_WAIT() asm volatile("s_waitcnt vmcnt(0)" ::: "memory")
__device__ __forceinline__ unsigned long long rt() { return __builtin_amdgcn_s_memrealtime(); }
__device__ __forceinline__ unsigned f2bf(float f) { unsigned u = __builtin_bit_cast(unsigned, f); return (u + 0x7fffu + ((u >> 16) & 1u)) >> 16; }
__device__ __forceinline__ unsigned pk2(float lo, float hi) { return f2bf(lo) | (f2bf(hi) << 16); }

#define XB_TMO      128
#define XB_XCNT(j)  (256  + 64 * (j))
#define XB_XSUB(j)  (1280 + 64 * (j))
#define XB_XGEN(j)  (2304 + 64 * (j))
#define XB_TOP      3328
#define XB_TOPGEN   3392
#define XCD_BAR_WORDS 3456
#define XB_SPIN_CAP (1u << 18)

__device__ __forceinline__ unsigned xb_ld(unsigned* p)              { return __hip_atomic_load(p, __ATOMIC_RELAXED, __HIP_MEMORY_SCOPE_AGENT); }
__device__ __forceinline__ unsigned xb_add(unsigned* p, unsigned v) { return __hip_atomic_fetch_add(p, v, __ATOMIC_RELAXED, __HIP_MEMORY_SCOPE_AGENT); }
__device__ __forceinline__ unsigned xb_xcc_id() { return (unsigned)__builtin_amdgcn_s_getreg((3 << 11) | 20) & 0xFu; }
#define XB_SPIN(cond, bar) do { unsigned _sp = 0; while (cond) { __builtin_amdgcn_s_sleep(1); \
    if ((++_sp & 255u) == 0u) { if (xb_ld(&(bar)[XB_TMO])) break; if (_sp > XB_SPIN_CAP) { atomicAdd(&(bar)[XB_TMO], 1u); break; } } } } while (0)

struct XcdBarrier {
    unsigned* bar; unsigned x;
    volatile LAS unsigned* st;
};

__device__ __forceinline__ XcdBarrier xcd_barrier_post(unsigned* bar, volatile LAS unsigned* st) {
    XcdBarrier b; b.bar = bar; b.x = xb_xcc_id(); b.st = st;
    if (threadIdx.x == 0) (void)xb_add(&bar[XB_XCNT(b.x)], 1u);
    return b;
}
__device__ __forceinline__ void xcd_barrier_complete(unsigned* bar, unsigned x, unsigned& nloc, unsigned& nx) {
    const unsigned G = gridDim.x * gridDim.y * gridDim.z;
    unsigned sum, cnt, mine, sp = 0u;
    for (;;) {
        sum = 0u; cnt = 0u; mine = 0u;
#pragma unroll
        for (unsigned j = 0; j < 16; ++j) { const unsigned c = xb_ld(&bar[XB_XCNT(j)]); sum += c; cnt += (c > 0u) ? 1u : 0u; mine = (j == x) ? c : mine; }
        if (sum == G) break;
        __builtin_amdgcn_s_sleep(1);
        if ((++sp & 255u) == 0u) { if (xb_ld(&bar[XB_TMO])) break; if (sp > XB_SPIN_CAP) { atomicAdd(&bar[XB_TMO], 1u); break; } }
    }
    nloc = mine > 0u ? mine : 1u; nx = cnt > 0u ? cnt : 1u;
}

__device__ __forceinline__ void xcd_barrier(const XcdBarrier& b) {
    asm volatile("s_waitcnt vmcnt(0)" ::: "memory");
    __syncthreads();
    if (threadIdx.x == 0) {
        unsigned* bar = b.bar;
        __builtin_amdgcn_s_waitcnt(0);
        unsigned nloc = b.st[0], nx = b.st[1];
        if (nloc == 0u) { xcd_barrier_complete(bar, b.x, nloc, nx); b.st[0] = nloc; b.st[1] = nx; }
        const unsigned old = xb_add(&bar[XB_XSUB(b.x)], 1u);
        const unsigned gen = old / nloc;
        if (old + 1u == (gen + 1u) * nloc) {
            __builtin_amdgcn_fence(__ATOMIC_RELEASE, "agent");
            asm volatile("s_waitcnt vmcnt(0)" ::: "memory");
            const unsigned og = xb_add(&bar[XB_TOP], 1u);
            const unsigned tg = og / nx;
            if (og + 1u == (tg + 1u) * nx) xb_add(&bar[XB_TOPGEN], 1u);
            else XB_SPIN(xb_ld(&bar[XB_TOPGEN]) == tg, bar);
            __builtin_amdgcn_fence(__ATOMIC_ACQUIRE, "agent");
            xb_add(&bar[XB_XGEN(b.x)], 1u);
            asm volatile("s_waitcnt vmcnt(0)" ::: "memory");
        } else {
            XB_SPIN(xb_ld(&bar[XB_XGEN(b.x)]) == gen, bar);
            __builtin_amdgcn_fence(__ATOMIC_ACQUIRE, "agent");
            asm volatile("s_waitcnt vmcnt(0)" ::: "memory");
        }
    }
    __syncthreads();
}
constexpr int NWAVES = 8, NT = NWAVES * 64;
constexpr int BATCH = 4, SEQ = 4096, DM = 2048, CTXL = 256;
constexpr int MX = BATCH * SEQ, MC = BATCH * CTXL, MALL = MX + MC;
constexpr int WA = 1024, WB = 1024, NIN = 10256, NU = 10496;
constexpr int C_AQ = 0, C_AFF = 1024, C_AFB = 2048, C_AI = 3072, C_AZ = 4096, C_BQK = 5120, C_BV = 7168, C_BO = 8192, C_BZ = 9216, C_BG = 10240;
constexpr int HGH = 8, HGD = 128, MLH = 4, MLD = 256;
constexpr float ALPHA = 1.189207115002721f;
constexpr float LN_EPS = 1e-5f, NORM_EPS = 1e-6f;
constexpr int NMOD = 3 * DM;

#ifndef MK_N_LAUNCHES
#define MK_N_LAUNCHES 1
#endif
constexpr int N_PHASES = 8;

constexpr size_t MiB = 1u << 20;
constexpr size_t WS_CTL = 0, CTL_ZERO_BYTES = 1 * MiB;
constexpr size_t WS_MODP = 1 * MiB;
constexpr size_t WS_GATE = 3 * MiB;
constexpr size_t WS_WINT = 4 * MiB;
constexpr size_t WS_WOUTT = 45 * MiB;
constexpr size_t WS_XN = 53 * MiB;
constexpr size_t WS_U = 121 * MiB;
constexpr size_t WS_PE = 470 * MiB, WS_MLS = 473 * MiB, WS_DEC = 478 * MiB;
constexpr size_t WS_MLW = 479 * MiB;
constexpr size_t WS_DQP = 496 * MiB;
constexpr size_t WS_XB = 498 * MiB;
constexpr size_t WS_END = 502 * MiB;
static_assert(WS_WINT + (size_t)NU * DM * 2 <= WS_WOUTT && WS_WOUTT + (size_t)DM * DM * 2 <= WS_XN && WS_XN + (size_t)MALL * DM * 2 <= WS_U && WS_U + (size_t)MALL * NU * 2 <= WS_END, "d_ws map");
constexpr int CW_TMO = 0, CW_BAR = 4096, CW_PANEL = 16384;

constexpr int RING_OFF = 0, RING_BYTES = 131072;
constexpr int LDS_BYTES = 163840;
constexpr int LDSCTL_OFF = LDS_BYTES - 1024, MISC_OFF = LDSCTL_OFF + 320;

struct Frame {
    LAS unsigned char* lds;
    volatile LAS unsigned* MISC;
    gu32* ctl;
    int tid, lane, wave, vcu, G;
    const float *x, *c, *ctx, *c_ctx, *w_mod, *b_mod, *w_in, *conv_w, *conv_b, *hg_lb, *ml_gate_b, *hg_norm_w, *ml_norm_w, *w_out, *ln_g, *ln_b;
    float* out;
    float *modp, *gate;
    bf16 *WinT, *WoutT, *XN, *U;
    bf16 *QTF, *MLW; float *PE, *MLS, *DEC, *DQP;
    bf16 *OAF, *OAB, *HBF, *HBB;
};

typedef float f32x2_t __attribute__((ext_vector_type(2)));
typedef __bf16 bf16x2_t __attribute__((ext_vector_type(2)));
__device__ __forceinline__ unsigned pkbf(float a, float b) { const f32x2_t v = {a, b}; return __builtin_bit_cast(unsigned, __builtin_convertvector(v, bf16x2_t)); }
__device__ __forceinline__ float bf2f(unsigned short u) { return __builtin_bit_cast(float, (unsigned)u << 16); }
__device__ __forceinline__ float lo2f(unsigned u) { return __builtin_bit_cast(float, u << 16); }
__device__ __forceinline__ float hi2f(unsigned u) { return __builtin_bit_cast(float, u & 0xffff0000u); }
__device__ __forceinline__ float siluf(float v) { return v / (1.f + __expf(-v)); }
__device__ __forceinline__ float sigmf(float v) { return 1.f / (1.f + __expf(-v)); }
__device__ __forceinline__ float wave_sum(float v) {
#pragma unroll
    for (int o = 1; o < 64; o <<= 1) v += __shfl_xor(v, o);
    return v;
}

__device__ __forceinline__ void transpose_item(const float* W, int ldw, int nvalid, int K, bf16* WT, LAS float* scr, int kb, int nb, int lane) {
    const int k0 = 64 * kb, n0 = 32 * nb; const int n_l = n0 + (lane & 31);
#pragma unroll 8
    for (int i = 0; i < 32; ++i) { const int kk = 2 * i + (lane >> 5); scr[kk * 33 + (lane & 31)] = n_l < nvalid ? W[(size_t)(k0 + kk) * ldw + n_l] : 0.f; }
    LDS_WAIT(); asm volatile("" ::: "memory");
    const int c = lane & 7;
#pragma unroll
    for (int j = 0; j < 4; ++j) { const int n = (lane >> 3) + 8 * j; const LAS float* s = scr + (8 * c) * 33 + n;
        v4u o; o.x = pk2(s[0 * 33], s[1 * 33]); o.y = pk2(s[2 * 33], s[3 * 33]); o.z = pk2(s[4 * 33], s[5 * 33]); o.w = pk2(s[6 * 33], s[7 * 33]);
        *(GAS v4u*)(WT + (size_t)(n0 + n) * K + k0 + 8 * c) = o; }
    LDS_WAIT(); asm volatile("" ::: "memory");
}
constexpr int KS2 = 2;
__device__ __forceinline__ void p0_prep(Frame& F) {
    LAS float* scr = (LAS float*)(F.lds + RING_OFF + F.wave * 16384);
    LAS float* red = (LAS float*)(F.lds + RING_OFF + 131072);
    for (int it = F.vcu; it < (NMOD / 64) * KS2; it += F.G) {
        const int cg = it >> 1, kh2 = it & 1, n = cg * 64 + F.lane, k0 = kh2 * 1024 + F.wave * 128;
#pragma unroll
        for (int rr = 0; rr < 5; ++rr)
#pragma unroll
            for (int j = 0; j < 2; ++j) { const int k = k0 + F.lane + 64 * j; const float v = rr < 4 ? F.c[rr * DM + k] : F.c_ctx[k]; scr[rr * 128 + F.lane + 64 * j] = siluf(v); }
        LDS_WAIT(); asm volatile("" ::: "memory");
        float a0 = 0.f, a1 = 0.f, a2 = 0.f, a3 = 0.f, a4 = 0.f;
#pragma unroll 16
        for (int k = 0; k < 128; ++k) { const float w = F.w_mod[(size_t)(k0 + k) * NMOD + n];
            a0 += scr[k] * w; a1 += scr[128 + k] * w; a2 += scr[256 + k] * w; a3 += scr[384 + k] * w; a4 += scr[512 + k] * w; }
        LAS float* rp = red + F.wave * 320 + F.lane; rp[0] = a0; rp[64] = a1; rp[128] = a2; rp[192] = a3; rp[256] = a4;
        __syncthreads();
        if (F.tid < 320) { float sacc = 0.f;
#pragma unroll
            for (int ww = 0; ww < 8; ++ww) sacc += red[ww * 320 + F.tid];
            const int rr = F.tid >> 6, nn = cg * 64 + (F.tid & 63);
            F.modp[((size_t)kh2 * 5 + rr) * NMOD + nn] = sacc + (kh2 == 0 ? F.b_mod[nn] : 0.f); }
        __syncthreads();
    }
    const int gw = F.vcu * NWAVES + F.wave, NGW = F.G * NWAVES;
    constexpr int NB_IN = NU / 32, I_IN = (DM / 64) * NB_IN, NB_OUT = DM / 32, I_OUT = (DM / 64) * NB_OUT;
    for (int it = gw; it < I_IN + I_OUT; it += NGW) {
        int r = it;
        if (r < I_IN) { transpose_item(F.w_in, NIN, NIN, DM, F.WinT, scr, r / NB_IN, r % NB_IN, F.lane); continue; } r -= I_IN;
        transpose_item(F.w_out, DM, DM, DM, F.WoutT, scr, r / NB_OUT, r % NB_OUT, F.lane);
    }
}

__device__ __forceinline__ void ln_mod_row2(Frame& F, const float* xa, const float* xb, bf16* oa, bf16* ob, const LAS float* shift, const LAS float* scale) {
    const GAS f32x4* ra = (const GAS f32x4*)xa + F.lane; const GAS f32x4* rb = (const GAS f32x4*)xb + F.lane;
    f32x4 va[8], vb[8]; float sa = 0.f, sb = 0.f;
#pragma unroll
    for (int j = 0; j < 8; ++j) { va[j] = ra[64 * j]; vb[j] = rb[64 * j]; }
#pragma unroll
    for (int j = 0; j < 8; ++j) { sa += (va[j].x + va[j].y) + (va[j].z + va[j].w); sb += (vb[j].x + vb[j].y) + (vb[j].z + vb[j].w); }
    const float ma = wave_sum(sa) * (1.f / DM), mb = wave_sum(sb) * (1.f / DM); float qa = 0.f, qb = 0.f;
#pragma unroll
    for (int j = 0; j < 8; ++j) { va[j] = va[j] - ma; vb[j] = vb[j] - mb; qa += (va[j].x * va[j].x + va[j].y * va[j].y) + (va[j].z * va[j].z + va[j].w * va[j].w); qb += (vb[j].x * vb[j].x + vb[j].y * vb[j].y) + (vb[j].z * vb[j].z + vb[j].w * vb[j].w); }
    const float rsa = 1.f / sqrtf(wave_sum(qa) * (1.f / DM) + LN_EPS), rsb = 1.f / sqrtf(wave_sum(qb) * (1.f / DM) + LN_EPS);
    GAS unsigned long long* o8a = (GAS unsigned long long*)oa + F.lane; GAS unsigned long long* o8b = (GAS unsigned long long*)ob + F.lane;
#pragma unroll
    for (int j = 0; j < 8; ++j) { const int k = 4 * F.lane + 256 * j; const f32x4 sc = *(const LAS f32x4*)(scale + k) + 1.f, sh = *(const LAS f32x4*)(shift + k);
        const f32x4 ha = va[j] * rsa * sc + sh, hb = vb[j] * rsb * sc + sh;
        o8a[64 * j] = (unsigned long long)pk2(ha.x, ha.y) | ((unsigned long long)pk2(ha.z, ha.w) << 32);
        o8b[64 * j] = (unsigned long long)pk2(hb.x, hb.y) | ((unsigned long long)pk2(hb.z, hb.w) << 32); }
}
__device__ __forceinline__ void ln_mod_row(Frame& F, const float* xrow, bf16* orow, const LAS float* shift, const LAS float* scale) {
    const GAS f32x4* xr = (const GAS f32x4*)xrow + F.lane;
    f32x4 v[8]; float s = 0.f;
#pragma unroll
    for (int j = 0; j < 8; ++j) { v[j] = xr[64 * j]; s += (v[j].x + v[j].y) + (v[j].z + v[j].w); }
    const float mean = wave_sum(s) * (1.f / DM); float s2 = 0.f;
#pragma unroll
    for (int j = 0; j < 8; ++j) { v[j] = v[j] - mean; s2 += (v[j].x * v[j].x + v[j].y * v[j].y) + (v[j].z * v[j].z + v[j].w * v[j].w); }
    const float rstd = 1.f / sqrtf(wave_sum(s2) * (1.f / DM) + LN_EPS);
    GAS unsigned long long* o8 = (GAS unsigned long long*)orow + F.lane;
#pragma unroll
    for (int j = 0; j < 8; ++j) { const int k = 4 * F.lane + 256 * j; const f32x4 sc = *(const LAS f32x4*)(scale + k), sh = *(const LAS f32x4*)(shift + k);
        const f32x4 h = v[j] * rstd * (sc + 1.f) + sh;
        o8[64 * j] = (unsigned long long)pk2(h.x, h.y) | ((unsigned long long)pk2(h.z, h.w) << 32); }
}
__device__ __forceinline__ void p1_lnmod(Frame& F) {
    LAS float* md = (LAS float*)(F.lds + RING_OFF);
    for (int e = F.vcu * NT + F.tid; e < BATCH * DM; e += F.G * NT) { const int b = e / DM, n = e % DM;
        F.gate[e] = F.modp[(size_t)b * NMOD + 2 * DM + n] + F.modp[((size_t)5 + b) * NMOD + 2 * DM + n]; }
    for (int blk = F.vcu; blk < 256; blk += F.G) {
        const int b = blk >> 6;
        __syncthreads();
        for (int e = F.tid; e < 4 * DM; e += NT) { const int row = e < 2 * DM ? b : 4, col = e & (2 * DM - 1);
            md[e] = F.modp[(size_t)row * NMOD + col] + F.modp[((size_t)5 + row) * NMOD + col]; }
        __syncthreads();
#pragma unroll 1
        for (int r = 0; r < 8; r += 2) { const int m = blk * 64 + F.wave * 8 + r;
            ln_mod_row2(F, F.x + (size_t)m * DM, F.x + (size_t)(m + 1) * DM, F.XN + (size_t)m * DM, F.XN + (size_t)(m + 1) * DM, md, md + DM); }
        if (F.wave < 4) { const int m = blk * 4 + F.wave; ln_mod_row(F, F.ctx + (size_t)m * DM, F.XN + (size_t)(MX + m) * DM, md + 2 * DM, md + 3 * DM); }
    }
}

__device__ __forceinline__ float rcpf_(float v) { return __builtin_amdgcn_rcpf(v); }
__device__ __forceinline__ float silu_fast(float v) { return v * rcpf_(1.f + __expf(-v)); }
__device__ __forceinline__ void conv_acc8(float (&acc)[8], const v4u u, const f32x4 wa, const f32x4 wb) {
    acc[0] += lo2f(u.x) * wa.x; acc[1] += hi2f(u.x) * wa.y; acc[2] += lo2f(u.y) * wa.z; acc[3] += hi2f(u.y) * wa.w;
    acc[4] += lo2f(u.z) * wb.x; acc[5] += hi2f(u.z) * wb.y; acc[6] += lo2f(u.w) * wb.z; acc[7] += hi2f(u.w) * wb.w;
}
constexpr int NSC = 4;
__device__ __forceinline__ void p3_conv(Frame& F) {
    bf16* QKM = F.XN;
    if (F.G > 2 * NSC && F.vcu < NSC) return;
    const int wk = F.G > 2 * NSC ? F.vcu - NSC : F.vcu, NW = F.G > 2 * NSC ? F.G - NSC : F.G;
    const int gw = wk * NWAVES + F.wave, NGW = NW * NWAVES;
    const int cq = gw & 3, ch = cq * 512 + F.lane * 8;
    f32x4 wa[9], wb[9];
#pragma unroll
    for (int t = 0; t < 9; ++t) { wa[t] = *(const GAS f32x4*)(F.conv_w + t * 2048 + ch); wb[t] = *(const GAS f32x4*)(F.conv_w + t * 2048 + ch + 4); }
    const f32x4 ba = *(const GAS f32x4*)(F.conv_b + ch), bb = *(const GAS f32x4*)(F.conv_b + ch + 4);
    const float sc = ch >= 1024 ? 0.0625f : 1.f;
    constexpr int NLAT = BATCH * 64 * 16, NCTX = BATCH * (CTXL / 4);
    int it0 = gw >> 2, it1 = NLAT + NCTX, its = NGW >> 2;
    if (NW == 252) { const int j = wk - 80; const int lo = wk < 80 ? 8 * wk : 640 + (j < 100 ? 22 * j : 2200 + 21 * (j - 100)); const int len = wk < 80 ? 8 : (j < 100 ? 22 : 21);
        it0 = lo + (F.wave >> 2); it1 = lo + len; its = 2; }
    for (int it = it0; it < it1; it += its) {
        const v4u zero4 = {0u, 0u, 0u, 0u};
        if (it < NLAT) {
            const int b = it >> 10, r = (it >> 4) & 63, c0 = (it & 15) * 4;
            v4u in[3][6];
#pragma unroll
            for (int dr = 0; dr < 3; ++dr)
#pragma unroll
                for (int j = 0; j < 6; ++j) { const int rr = r + dr - 1, cc = c0 + j - 1; const bool ok = rr >= 0 && rr < 64 && cc >= 0 && cc < 64;
                    in[dr][j] = ok ? *(const GAS v4u*)(F.U + (size_t)(b * SEQ + rr * 64 + cc) * NU + C_BQK + ch) : zero4; }
#pragma unroll
            for (int o = 0; o < 4; ++o) {
                float acc[8] = {ba.x, ba.y, ba.z, ba.w, bb.x, bb.y, bb.z, bb.w};
#pragma unroll
                for (int dr = 0; dr < 3; ++dr)
#pragma unroll
                    for (int dc = 0; dc < 3; ++dc) conv_acc8(acc, in[dr][o + dc], wa[dr * 3 + dc], wb[dr * 3 + dc]);
#pragma unroll
                for (int j = 0; j < 8; ++j) acc[j] = silu_fast(acc[j]) * sc;
                v4u ov; ov.x = pk2(acc[0], acc[1]); ov.y = pk2(acc[2], acc[3]); ov.z = pk2(acc[4], acc[5]); ov.w = pk2(acc[6], acc[7]);
                *(GAS v4u*)(QKM + (size_t)(b * SEQ + r * 64 + c0 + o) * DM + ch) = ov;
            }
        } else {
            const int ic = it - NLAT, b = ic >> 6, t0 = (ic & 63) * 4;
            v4u in[6];
#pragma unroll
            for (int j = 0; j < 6; ++j) { const int tt = t0 + j - 1; in[j] = (tt >= 0 && tt < CTXL) ? *(const GAS v4u*)(F.U + (size_t)(MX + b * CTXL + tt) * NU + C_BQK + ch) : zero4; }
#pragma unroll
            for (int o = 0; o < 4; ++o) {
                float acc[8] = {ba.x, ba.y, ba.z, ba.w, bb.x, bb.y, bb.z, bb.w};
#pragma unroll
                for (int dc = 0; dc < 3; ++dc) conv_acc8(acc, in[o + dc], wa[3 + dc], wb[3 + dc]);
#pragma unroll
                for (int j = 0; j < 8; ++j) acc[j] = silu_fast(acc[j]) * sc;
                v4u ov; ov.x = pk2(acc[0], acc[1]); ov.y = pk2(acc[2], acc[3]); ov.z = pk2(acc[4], acc[5]); ov.w = pk2(acc[6], acc[7]);
                *(GAS v4u*)(QKM + (size_t)(MX + b * CTXL + t0 + o) * DM + ch) = ov;
            }
        }
    }
}

__device__ __forceinline__ int scan_row(int b, int dirn, int nb, int i) {
    if (nb < 16) { const int p = nb * 16 + i; const int t = dirn ? (CTXL - 1 - p) : p; return MX + b * CTXL + t; }
    const int p = (nb - 16) * 16 + i; const int t = dirn ? (SEQ - 1 - p) : p; return b * SEQ + t;
}
__device__ __forceinline__ void p4_hgrn2_task(Frame& F, int task) {
    const int vs = task & 3, dirn = (task >> 2) & 1, h = (task >> 3) & 7, b = task >> 6;
    LAS float* Fg = (LAS float*)(F.lds);
    LAS float* Kg = Fg + 2048, *Qg = Kg + 2048;
    LAS float* Vg = Qg + 2048;
    LAS float* LB = Vg + 512;
    LAS float* P = LB + 128;
    const int v = F.tid & 31, kg = F.tid >> 5, k0 = kg * 8;
    const int zcol = (dirn ? C_AFB : C_AFF) + h * HGD;
    __syncthreads();
    if (F.tid < 128) { const int col = h * HGD + F.tid; LB[F.tid] = sigmf(F.hg_lb[(dirn * 2 + 0) * WA + col] - F.hg_lb[(dirn * 2 + 1) * WA + col]); }
    __syncthreads();
    float S[8];
#pragma unroll
    for (int j = 0; j < 8; ++j) S[j] = 0.f;
    bf16* O = dirn ? F.OAB : F.OAF;
#pragma unroll 1
    for (int nb = 0; nb < 16 + 256; ++nb) {
        const bool lat = nb >= 16;
#pragma unroll
        for (int j = 0; j < 4; ++j) { const int e = F.tid + NT * j, i = e >> 7, k = e & 127; const int row = scan_row(b, dirn, nb, i);
            const float z = bf2f(F.U[(size_t)row * NU + zcol + k]); const float lb = LB[k]; const float f = lb + (1.f - lb) * sigmf(z);
            Fg[e] = f; Kg[e] = 1.f - f; Qg[e] = lat ? siluf(bf2f(F.U[(size_t)row * NU + C_AQ + h * HGD + k])) : 0.f; }
        { const int i = F.tid >> 5; const int row = scan_row(b, dirn, nb, i); Vg[F.tid] = bf2f(F.U[(size_t)row * NU + C_AI + h * HGD + vs * 32 + v]); }
        __syncthreads();
#pragma unroll 2
        for (int i = 0; i < 16; ++i) { const float vv = Vg[i * 32 + v]; float a = 0.f;
#pragma unroll
            for (int j = 0; j < 8; ++j) { S[j] = Fg[i * 128 + k0 + j] * S[j] + Kg[i * 128 + k0 + j] * vv; a += S[j] * Qg[i * 128 + k0 + j]; }
            P[(kg * 16 + i) * 32 + v] = a; }
        __syncthreads();
        if (lat) { const int i = F.tid >> 5; float o = 0.f;
#pragma unroll
            for (int g = 0; g < 16; ++g) o += P[(g * 16 + i) * 32 + v];
            const int row = scan_row(b, dirn, nb, i);
            O[(size_t)row * WA + h * HGD + vs * 32 + v] = (bf16)f2bf(o); }
    }
}
__device__ __forceinline__ void p4_mlstm_task(Frame& F, int task) {
    const int vs = task & 7, dirn = (task >> 3) & 1, h = (task >> 4) & 3, b = task >> 6;
    const bf16* QKM = F.XN;
    LAS float* Kb = (LAS float*)(F.lds);
    LAS float* Qb = Kb + 4096;
    LAS float* Vb = Qb + 4096;
    LAS float* LI = Vb + 512, *LF = LI + 16, *EM = LF + 16;
    LAS float* PD = EM + 16;
    LAS float* P = PD + 256;
    const int v = F.tid & 31, kg = F.tid >> 5, k0 = kg * 16;
    float C[16], nn[16]; float m = 0.f;
#pragma unroll
    for (int j = 0; j < 16; ++j) { C[j] = 0.f; nn[j] = 0.f; }
    bf16* O = dirn ? F.HBB : F.HBF;
    const float gbi = F.ml_gate_b[dirn * 4 + h], gbf = F.ml_gate_b[(2 + dirn) * 4 + h];
#pragma unroll 1
    for (int nb = 0; nb < 16 + 256; ++nb) {
        const bool lat = nb >= 16;
        __syncthreads();
#pragma unroll
        for (int j = 0; j < 8; ++j) { const int e = F.tid + NT * j, i = e >> 8, k = e & 255; const int row = scan_row(b, dirn, nb, i);
            Kb[e] = bf2f(QKM[(size_t)row * DM + 1024 + h * MLD + k]); Qb[e] = lat ? bf2f(QKM[(size_t)row * DM + h * MLD + k]) : 0.f; }
        { const int i = F.tid >> 5; const int row = scan_row(b, dirn, nb, i); Vb[F.tid] = bf2f(F.U[(size_t)row * NU + C_BV + h * MLD + vs * 32 + v]); }
        if (F.tid < 16) { const int row = scan_row(b, dirn, nb, F.tid);
            const float gi = bf2f(F.U[(size_t)row * NU + C_BG + dirn * 4 + h]) + gbi, gf = bf2f(F.U[(size_t)row * NU + C_BG + (2 + dirn) * 4 + h]) + gbf;
            LI[F.tid] = gi; LF[F.tid] = gf > 0.f ? -log1pf(__expf(-gf)) : gf - log1pf(__expf(gf)); }
        __syncthreads();
#pragma unroll 2
        for (int i = 0; i < 16; ++i) {
            const float lf = LF[i], li = LI[i]; const float mn = fmaxf(lf + m, li); const float fd = __expf(lf + m - mn), iw = __expf(li - mn); m = mn;
            if (F.tid == 0) EM[i] = __expf(-m);
            const float vv = iw * Vb[i * 32 + v]; float a = 0.f, d = 0.f;
#pragma unroll
            for (int j = 0; j < 16; ++j) { const float kk = Kb[i * 256 + k0 + j], qq = Qb[i * 256 + k0 + j];
                C[j] = fd * C[j] + vv * kk; nn[j] = fd * nn[j] + iw * kk; a += C[j] * qq; d += nn[j] * qq; }
            P[(kg * 16 + i) * 32 + v] = a; if (v == 0) PD[kg * 16 + i] = d; }
        __syncthreads();
        if (lat) { const int i = F.tid >> 5; float num = 0.f, den = 0.f;
#pragma unroll
            for (int g = 0; g < 16; ++g) { num += P[(g * 16 + i) * 32 + v]; den += PD[g * 16 + i]; }
            const int row = scan_row(b, dirn, nb, i);
            O[(size_t)row * WB + h * MLD + vs * 32 + v] = (bf16)f2bf(num / fmaxf(fabsf(den), EM[i])); }
    }
}
__device__ __forceinline__ void p4_scan_naive(Frame& F) {
    for (int task = F.vcu; task < 512; task += F.G) { if (task < 256) p4_hgrn2_task(F, task); else p4_mlstm_task(F, task - 256); }
}

constexpr int NCHUNK = MALL / 64;
__device__ __forceinline__ void gate_fk(float z, float lb, float& f, float& kk) {
    const float e = __expf(-fabsf(z)); const float rb = 1.f / (1.f + e), rs = e * rb;
    const float sg = z >= 0.f ? rb : rs, sn = z >= 0.f ? rs : rb;
    f = lb + (1.f - lb) * sg; kk = (1.f - lb) * sn;
}
template <bool DUMMY>
__device__ __forceinline__ void p3_hg_prep(Frame& F) {
    bf16* dq = F.OAF; bf16* dkf = F.OAB; bf16* dkb = F.HBF;
    LAS unsigned char* L = F.lds;
    constexpr int TQ = 0, TZF = 32768, TZB = 65536, TQF = 98304;
    const int tid = F.tid, dirn = tid >> 8, cl = tid & 255;
    if (F.G > 2 * NSC && F.vcu < NSC) return;
    const int wk = F.G > 2 * NSC ? F.vcu - NSC : F.vcu, NW = F.G > 2 * NSC ? F.G - NSC : F.G;
    v4u pre[3][4];
    auto issue = [&](int it) { const int cid = it >> 2, cb = (it & 3) * 256; const size_t row0 = (size_t)cid * 64;
#pragma unroll
        for (int i = 0; i < 4; ++i) { const int piece = tid + NT * i, row = piece >> 5, c16 = piece & 31; const bf16* ur = F.U + (row0 + row) * NU + cb + c16 * 8;
            pre[0][i] = *(const GAS v4u*)(ur + C_AQ); pre[1][i] = *(const GAS v4u*)(ur + C_AFF); pre[2][i] = *(const GAS v4u*)(ur + C_AFB); } };
    int it = wk;
    if (it < NCHUNK * 4) issue(it);
    for (; it < NCHUNK * 4; it += NW) {
        const int cid = it >> 2, cb = (it & 3) * 256; const size_t row0 = (size_t)cid * 64;
        __syncthreads();
#pragma unroll
        for (int i = 0; i < 4; ++i) { const int piece = tid + NT * i; *(LAS v4u*)(L + TQ + piece * 16) = pre[0][i]; *(LAS v4u*)(L + TZF + piece * 16) = pre[1][i]; *(LAS v4u*)(L + TZB + piece * 16) = pre[2][i]; }
        __syncthreads();
        if (it + NW < NCHUNK * 4) issue(it + NW);
        const int c = cb + cl;
        const float lb = sigmf(F.hg_lb[(dirn * 2) * WA + c] - F.hg_lb[(dirn * 2 + 1) * WA + c]), olb = 1.f - lb;
        LAS unsigned short* zt = (LAS unsigned short*)(L + (dirn ? TZB : TZF)) + cl;
        const LAS unsigned short* qtile = (const LAS unsigned short*)(L + TQ) + cl;
        LAS unsigned short* qf = (LAS unsigned short*)(L + TQF) + cl;
        float P = 1.f; unsigned qb[32];
#pragma unroll
        for (int pp = 0; pp < 64; ++pp) {
            const int p = dirn ? 63 - pp : pp;
            const float z = bf2f(zt[p * 256]), q = bf2f(qtile[p * 256]);
            const float e = __expf(-fabsf(z)); const float rbig = rcpf_(1.f + e), rsm = e * rbig;
            const float sg = z >= 0.f ? rbig : rsm, sn = z >= 0.f ? rsm : rbig;
            const float f = lb + olb * sg, kk = olb * sn; P *= f;
            const float qt = silu_fast(q) * P, kt = kk * rcpf_(P);
            zt[p * 256] = (unsigned short)(pkbf(kt, 0.f) & 0xffffu);
            const unsigned qh = pkbf(qt, 0.f) & 0xffffu;
            if (dirn) { if (pp & 1) qb[pp >> 1] |= qh << 16; else qb[pp >> 1] = qh; } else qf[p * 256] = (unsigned short)qh;
        }
        F.PE[(size_t)(dirn * NCHUNK + cid) * WA + c] = P;
        __syncthreads();
        if (dirn) {
            LAS unsigned short* qw = (LAS unsigned short*)(L + TQ) + cl;
#pragma unroll
            for (int pp = 0; pp < 64; ++pp) qw[(63 - pp) * 256] = (unsigned short)((pp & 1) ? (qb[pp >> 1] >> 16) : (qb[pp >> 1] & 0xffffu));
        }
        __syncthreads();
#pragma unroll
        for (int i = 0; i < 4; ++i) { const int piece = tid + NT * i, row = piece >> 5, c16 = piece & 31; const size_t r = row0 + row; bf16* ur = F.U + r * NU + cb + c16 * 8;
            const v4u vq = *(const LAS v4u*)(L + TQ + piece * 16), vf = *(const LAS v4u*)(L + TZF + piece * 16), vb = *(const LAS v4u*)(L + TZB + piece * 16), vqf = *(const LAS v4u*)(L + TQF + piece * 16);
            *(GAS v4u*)(F.QTF + r * WA + cb + c16 * 8) = vqf;
            if (DUMMY) { if (r < MX) { *(GAS v4u*)(dq + r * WA + cb + c16 * 8) = vq; *(GAS v4u*)(dkf + r * WA + cb + c16 * 8) = vf; *(GAS v4u*)(dkb + r * WA + cb + c16 * 8) = vb; } }
            else { *(GAS v4u*)(ur + C_AQ) = vq; *(GAS v4u*)(ur + C_AFF) = vf; *(GAS v4u*)(ur + C_AFB) = vb; } }
    }
    __syncthreads();
}
template <int CTRL, int RM> __device__ __forceinline__ float dpp_f(float idv, float x) { return __builtin_bit_cast(float, __builtin_amdgcn_update_dpp(__builtin_bit_cast(int, idv), __builtin_bit_cast(int, x), CTRL, RM, 0xf, false)); }
__device__ __forceinline__ float wave_scan_add(float x) {
    x += dpp_f<0x111, 0xf>(0.f, x); x += dpp_f<0x112, 0xf>(0.f, x); x += dpp_f<0x114, 0xf>(0.f, x); x += dpp_f<0x118, 0xf>(0.f, x);
    x += dpp_f<0x142, 0xa>(0.f, x); x += dpp_f<0x143, 0xc>(0.f, x); return x; }
__device__ __forceinline__ float wave_scan_max(float x) { const float ni = -__builtin_inff();
    x = fmaxf(x, dpp_f<0x111, 0xf>(ni, x)); x = fmaxf(x, dpp_f<0x112, 0xf>(ni, x)); x = fmaxf(x, dpp_f<0x114, 0xf>(ni, x)); x = fmaxf(x, dpp_f<0x118, 0xf>(ni, x));
    x = fmaxf(x, dpp_f<0x142, 0xa>(ni, x)); x = fmaxf(x, dpp_f<0x143, 0xc>(ni, x)); return x; }
__device__ __forceinline__ void p3_ml_scalars(Frame& F) {
    const int gw = F.vcu * NWAVES + F.wave;
    if (gw >= 32) return;
    const int dirn = gw & 1, h = (gw >> 1) & 3, b = gw >> 3;
    const float gbi = F.ml_gate_b[dirn * 4 + h], gbf = F.ml_gate_b[(2 + dirn) * 4 + h];
    float m0 = 0.f;
    float* mls = F.MLS + (size_t)(dirn * 4 + h) * MALL * 8;
    auto row_of = [&](int n) -> int { int row0; if (n < 4) { const int cc = dirn ? 3 - n : n; row0 = MX + b * CTXL + cc * 64; } else { const int lc = dirn ? 67 - n : n - 4; row0 = b * SEQ + lc * 64; }
        return row0 + (dirn ? 63 - F.lane : F.lane); };
    unsigned short gi_r[8], gf_r[8];
#pragma unroll
    for (int j = 0; j < 8; ++j) { const int row = row_of(j); gi_r[j] = F.U[(size_t)row * NU + C_BG + dirn * 4 + h]; gf_r[j] = F.U[(size_t)row * NU + C_BG + (2 + dirn) * 4 + h]; }
#pragma unroll 1
    for (int nb = 0; nb < 72; nb += 8) {
#pragma unroll
        for (int j = 0; j < 8; ++j) {
            const int n = nb + j;
            if (n < 68) {
                const int row = row_of(n);
                const float gi = bf2f(gi_r[j]) + gbi, gf = bf2f(gf_r[j]) + gbf;
                if (n + 8 < 68) { const int r2 = row_of(n + 8); gi_r[j] = F.U[(size_t)r2 * NU + C_BG + dirn * 4 + h]; gf_r[j] = F.U[(size_t)r2 * NU + C_BG + (2 + dirn) * 4 + h]; }
                const float lf = gf > 0.f ? -log1pf(__expf(-gf)) : gf - log1pf(__expf(gf));
                const float cs = wave_scan_add(lf);
                const float a = gi - cs; const float cm = wave_scan_max(a);
                const float mx = fmaxf(m0, cm), m63 = __shfl(mx, 63), cs63 = __shfl(cs, 63);
                f32x4 o0; o0.x = a; o0.y = mx; o0.z = __expf(m0 - mx); o0.w = __expf(a - m63);
                f32x4 o1; o1.x = __expf(-(cs + mx)); o1.y = 0.f; o1.z = __expf(m0 - m63); o1.w = 0.f;
                *(f32x4*)(mls + (size_t)row * 8) = o0; *(f32x4*)(mls + (size_t)row * 8 + 4) = o1;
                const int row0 = row - (dirn ? 63 - F.lane : F.lane);
                if (F.lane == 0) F.DEC[(dirn * 4 + h) * NCHUNK + (row0 >> 6)] = __expf(m0 - m63);
                m0 = cs63 + m63;
            }
        }
    }
}

typedef short s16x4 __attribute__((ext_vector_type(4)));
typedef float f32x16 __attribute__((ext_vector_type(16)));
#define MFMA32(a, b, c) __builtin_amdgcn_mfma_f32_32x32x16_bf16((a), (b), (c), 0, 0, 0)
__device__ __forceinline__ bf16x8 pk8(float a0, float a1, float a2, float a3, float a4, float a5, float a6, float a7) {
    const v4u u = {pkbf(a0, a1), pkbf(a2, a3), pkbf(a4, a5), pkbf(a6, a7)}; return __builtin_bit_cast(bf16x8, u); }
__device__ __forceinline__ bf16x8 cat4(s16x4 lo, s16x4 hi) { return __builtin_shufflevector(lo, hi, 0, 1, 2, 3, 4, 5, 6, 7); }
__device__ __forceinline__ s16x4 lds_tr(LAS unsigned char* p) { return __builtin_amdgcn_ds_read_tr16_b64_v4i16((LAS s16x4*)p); }
__device__ __forceinline__ unsigned img_off_a(unsigned row, unsigned ch) { return 2048u * (row >> 3) + 512u * (ch >> 2) + 64u * (row & 7) + 16u * ((ch & 3) ^ ((row >> 2) & 3)); }
__device__ __forceinline__ unsigned img_addr(unsigned row, unsigned ch, unsigned ncb) { return ((row >> 5) * ncb + (ch >> 4)) * 8192u + img_off_a(row & 31, ch & 15); }
__device__ __forceinline__ unsigned v_addr(unsigned row, unsigned ch) { const unsigned r = row & 31; return (row >> 5) * 4096u + 1024u * (r >> 3) + 512u * (ch >> 2) + 64u * (r & 7) + 16u * ((ch & 3) ^ ((r >> 2) & 3)); }

constexpr int SL_QT = 0, SL_KT = 32768, SL_V = 65536, SL_VW = 73728, SL_SF = 81920, SL_XCH = 114688, SL_SC = 131072, SL_W = 144384;
constexpr int SC_PAR = 448, SC_DQW = 896, SC_N0 = 1024, SC_NP = 1280;


__device__ __forceinline__ void p3b_ml_scores(Frame& F) {
    LAS unsigned char* L = F.lds;
    constexpr int BQ = 0, BK = 32768, BX = 65536, BS = 98304;
    LAS float* SCA = (LAS float*)(L + BS);
    const int tid = F.tid, lane = F.lane, w = F.wave, ts = w & 1, tp = (w >> 1) & 1, kh = w >> 2;
    const unsigned hh = lane >> 5, x4 = (lane >> 2) & 3;
    const unsigned LB0 = 2048u * ((lane >> 3) & 3) + 64u * (lane & 7);
    unsigned LBx[2];
#pragma unroll
    for (int e = 0; e < 2; ++e) LBx[e] = LB0 + 16u * ((2u * e + hh) ^ x4) + kh * 8192u;
    v4u pq[4], pk[4]; f32x2_t psc;
    auto issue = [&](int it) { const int lc = it & 63, h = (it >> 6) & 3, b = it >> 8; const size_t row0 = (size_t)b * SEQ + lc * 64;
        int tv = F.tid; asm volatile("" : "+v"(tv));
#pragma unroll
        for (int i = 0; i < 4; ++i) { const int u = ((tv >> 6) + 8 * i) * 8 + ((tv & 63) >> 3), row = 2 * (u >> 3) + ((tv >> 2) & 1), ch = 4 * (u & 7) + (tv & 3);
            pq[i] = *(const GAS v4u*)(F.XN + (row0 + row) * DM + h * MLD + ch * 8); pk[i] = *(const GAS v4u*)(F.XN + (row0 + row) * DM + WB + h * MLD + ch * 8); }
        if (tv < 128) psc = *(const GAS f32x2_t*)(F.MLS + ((size_t)((tv >> 6) * 4 + h) * MALL + row0 + (tv & 63)) * 8); };
    int it = F.vcu;
    if (it < 1024) issue(it);
    for (; it < 1024; it += F.G) {
        const int lc = it & 63, h = (it >> 6) & 3, b = it >> 8; const size_t row0 = (size_t)b * SEQ + lc * 64;
        __syncthreads();
        { int tv = F.tid; asm volatile("" : "+v"(tv));
#pragma unroll
          for (int i = 0; i < 4; ++i) { const int u = ((tv >> 6) + 8 * i) * 8 + ((tv & 63) >> 3), row = 2 * (u >> 3) + ((tv >> 2) & 1), ch = 4 * (u & 7) + (tv & 3); const unsigned a = img_addr(row, ch, 2); *(LAS v4u*)(L + BQ + a) = pq[i]; *(LAS v4u*)(L + BK + a) = pk[i]; }
          if (tv < 128) { SCA[(tv >> 6) * 128 + (tv & 63)] = psc.x; SCA[(tv >> 6) * 128 + 64 + (tv & 63)] = psc.y; } }
        __syncthreads();
        if (it + F.G < 1024) issue(it + F.G);
        f32x16 c;
#pragma unroll
        for (int r = 0; r < 16; ++r) c[r] = 0.f;
#pragma unroll
        for (int s = 0; s < 8; ++s) {
            const bf16x8 a = *(const LAS bf16x8*)(L + BK + ts * 16384 + 512 * (s >> 1) + LBx[s & 1]);
            const bf16x8 bq = *(const LAS bf16x8*)(L + BQ + tp * 16384 + 512 * (s >> 1) + LBx[s & 1]);
            c = MFMA32(a, bq, c);
        }
#pragma unroll
        for (int r = 0; r < 16; ++r) *(LAS float*)(L + BX + (((kh * 4 + ts * 2 + tp) * 16 + r) * 64 + lane) * 4) = c[r];
        __syncthreads();
#pragma unroll
        for (int r = 0; r < 16; ++r) c[r] += *(const LAS float*)(L + BX + ((((1 - kh) * 4 + ts * 2 + tp) * 16 + r) * 64 + lane) * 4);
        const int dirn = kh;
        const bool need = dirn ? (ts >= tp) : (ts <= tp);
        const float mxp = SCA[dirn * 128 + 64 + 32 * tp + (lane & 31)];
        int dl = (lane & 31) - 4 * (int)hh; if (dirn) dl = -dl; asm volatile("" : "+v"(dl));
        const int sg1 = dirn ? -1 : 1; const bool diag = ts == tp;
        float rs = 0.f;
        bf16* wout = F.MLW + ((size_t)((dirn * 4 + h) * 256 + (int)(row0 >> 6)) * 4096) + (32 * tp + (lane & 31)) * 64 + 32 * ts + 4 * hh;
#pragma unroll
        for (int g = 0; g < 4; ++g) {
            const f32x4 av = *(const LAS f32x4*)(SCA + dirn * 128 + 32 * ts + 8 * g + 4 * hh);
            float wv[4];
#pragma unroll
            for (int j = 0; j < 4; ++j) { float v = need ? c[4 * g + j] * __expf(av[j] - mxp) : 0.f;
                if (diag) v = (dl - sg1 * (j + 8 * g) >= 0) ? v : 0.f;
                wv[j] = v; rs += v; }
            *(GAS unsigned long long*)(wout + 8 * g) = (unsigned long long)pkbf(wv[0], wv[1]) | ((unsigned long long)pkbf(wv[2], wv[3]) << 32);
        }
        rs += __shfl_xor(rs, 32);
        if (lane < 32) SCA[256 + (dirn * 2 + ts) * 64 + 32 * tp + lane] = rs;
        __syncthreads();
        if (tid < 128) { const int d = tid >> 6, p = tid & 63; F.MLS[((size_t)(d * 4 + h) * MALL + row0 + p) * 8 + 5] = SCA[256 + (d * 2) * 64 + p] + SCA[256 + (d * 2 + 1) * 64 + p]; }
    }
    __syncthreads();
}

template <bool ML, int SKIP = 0>
__device__ __forceinline__ void scan_task(Frame& F, int task) {
    constexpr int NKT = ML ? 8 : 4, NCB = NKT / 4, NKH = NKT / 2, NOWN = NKT / 4, NPQ = ML ? 4 : 2, DKK = 32 * NKT;
    int vs, dirn, h, b;
    if (ML) { vs = task & 3; dirn = (task >> 2) & 1; h = (task >> 3) & 3; b = task >> 5; } else { vs = task & 1; dirn = (task >> 1) & 1; h = (task >> 2) & 7; b = task >> 5; }
    const int lane = F.lane, w = F.wave, tid = F.tid; const int tp = (w >> 2) & 1, tj = (w >> 1) & 1, kh = w & 1;
    const unsigned hh = lane >> 5, q4 = (lane & 15) >> 2, p4 = lane & 3, blk = (lane >> 4) & 1, x4 = (lane >> 2) & 3;
    LAS unsigned char* L = F.lds;
    LAS float* SC = (LAS float*)(L + SL_SC);
    const unsigned LB0 = 2048u * ((lane >> 3) & 3) + 64u * (lane & 7);
    const unsigned khoff = ML ? kh * 8192u : kh * 1024u;
    unsigned LBx[2], LK[2][2], TRK[2], VK[2], VN[2], WL[2];
#pragma unroll
    for (int e = 0; e < 2; ++e) { LBx[e] = LB0 + 16u * ((2u * e + hh) ^ x4) + khoff; WL[e] = 1024u * ((lane >> 3) & 3) + 64u * (lane & 7) + 16u * ((2u * e + hh) ^ x4);
#pragma unroll
        for (int t = 0; t < 2; ++t) LK[e][t] = LB0 + 16u * ((2u * e + t) ^ x4) + 8u * hh + khoff; }
#pragma unroll
    for (int t = 0; t < 2; ++t) {
        TRK[t] = 2048u * hh + 64u * q4 + 8u * (p4 & 1) + 16u * ((2u * blk + (p4 >> 1)) ^ (2u * hh + t));
        VK[t] = 64u * (4u * hh + q4) + 8u * (p4 & 1) + 16u * ((2u * blk + (p4 >> 1)) ^ (2u * t + hh)) + 512u * tj;
        VN[t] = 1024u * hh + 64u * q4 + 8u * (p4 & 1) + 512u * tj + 16u * ((2u * blk + (p4 >> 1)) ^ (2u * hh + t)); }
    unsigned tkoff[NOWN];
#pragma unroll
    for (int i = 0; i < NOWN; ++i) { const unsigned tk = kh * NKH + tp * NOWN + i; tkoff[i] = (tk >> 2) * 8192u + 512u * (tk & 3); }
    const bf16 *gq, *gk, *gv; int sq, sk; bf16* go;
    if (ML) { gq = F.XN + h * MLD; gk = F.XN + WB + h * MLD; sq = DM; sk = DM; gv = F.U + C_BV + h * MLD + vs * 64; go = (dirn ? F.HBB : F.HBF) + h * MLD + vs * 64; }
    else { if (dirn) { gq = F.U + C_AQ + h * HGD; sq = NU; gk = F.U + C_AFB + h * HGD; } else { gq = F.QTF + h * HGD; sq = WA; gk = F.U + C_AFF + h * HGD; }
        sk = NU; gv = F.U + C_AI + h * HGD + vs * 64; go = (dirn ? F.OAB : F.OAF) + h * HGD + vs * 64; }
    const float* mls = F.MLS + (size_t)(dirn * 4 + h) * MALL * 8;
    const float* pev = F.PE + (size_t)dirn * NCHUNK * WA + h * HGD;
    f32x16 S[NOWN];
#pragma unroll
    for (int i = 0; i < NOWN; ++i)
#pragma unroll
        for (int r = 0; r < 16; ++r) S[i][r] = 0.f;
    v4u pq[NPQ], pk[NPQ], pv, pw; f32x4 ps0, ps1; float pws;
    const bf16* gw_ = F.MLW + (size_t)(dirn * 4 + h) * 256 * 4096;
    auto row0_of = [&](int n) -> int { if (n < 4) { const int cc = dirn ? 3 - n : n; return MX + b * CTXL + cc * 64; } const int lc = dirn ? 67 - n : n - 4; return b * SEQ + lc * 64; };
    int offq[NPQ], offk[NPQ]; unsigned aimg[NPQ];
#pragma unroll
    for (int i = 0; i < NPQ; ++i) { const int u = (w + 8 * i) * 8 + (lane >> 3), NB = NCB * 4, row = 2 * (u / NB) + ((lane >> 2) & 1), ch = 4 * (u % NB) + (lane & 3);
        offq[i] = row * sq + ch * 8; offk[i] = row * sk + ch * 8; aimg[i] = img_addr(row, ch, NCB); }
    const int vu = w * 8 + (lane >> 3), vrow = 2 * (vu >> 1) + ((lane >> 2) & 1), vch = 4 * (vu & 1) + (lane & 3);
    const int offv = vrow * NU + vch * 8, offw = vrow * 64 + vch * 8; const unsigned va = v_addr(vrow, vch);
    auto issue_loads = [&](int n) {
        const int row0 = row0_of(n);
        const bf16* bq_ = gq + (size_t)row0 * sq; const bf16* bk_ = gk + (size_t)row0 * sk;
#pragma unroll
        for (int i = 0; i < NPQ; ++i) { pq[i] = *(const GAS v4u*)(bq_ + offq[i]); pk[i] = *(const GAS v4u*)(bk_ + offk[i]); }
        pv = *(const GAS v4u*)(gv + (size_t)row0 * NU + offv);
        if (ML) { pws = mls[(size_t)(row0 + vrow) * 8 + 3];
            if (n >= 4) pw = *(const GAS v4u*)(gw_ + (size_t)(row0 >> 6) * 4096 + offw);
            if (tid < 64) { ps0 = *(const GAS f32x4*)(mls + (size_t)(row0 + tid) * 8); ps1 = *(const GAS f32x4*)(mls + (size_t)(row0 + tid) * 8 + 4); } }
        else { if (tid < 32) ps0 = *(const GAS f32x4*)(pev + (size_t)(row0 >> 6) * WA + tid * 4); }
    };
    unsigned tch0 = 0u, tch1 = 0u, tdummy = 0u;
    auto touch = [&](int n) {
        const int row0 = row0_of(n);
        if (ML) { const int ln = tid & 255; const bf16* bp = (tid < 256 ? gq + (size_t)row0 * sq : gk + (size_t)row0 * sk) + (size_t)(ln >> 2) * DM + (ln & 3) * 64;
            tch0 = *(const GAS unsigned*)bp;
            if (tid < 64) tch1 = *(const GAS unsigned*)(gv + (size_t)(row0 + tid) * NU);
            else if (tid < 128 && n >= 4) tch1 = *(const GAS unsigned*)(gw_ + (size_t)(row0 >> 6) * 4096 + (tid - 64) * 64); }
        else { if (tid < 256) { const int ln = tid & 127; tch0 = *(const GAS unsigned*)((tid < 128 ? gq + (size_t)(row0 + (ln >> 1)) * sq : gk + (size_t)(row0 + (ln >> 1)) * sk) + (ln & 1) * 64); }
            else if (tid < 320) tch0 = *(const GAS unsigned*)(gv + (size_t)(row0 + tid - 256) * NU); }
    };
    auto store_images = [&](int n) {
#pragma unroll
        for (int i = 0; i < NPQ; ++i) { *(LAS v4u*)(L + SL_QT + aimg[i]) = pq[i]; *(LAS v4u*)(L + SL_KT + aimg[i]) = pk[i]; }
        *(LAS v4u*)(L + SL_V + va) = pv;
        if (!ML && tid < 32) *(LAS f32x4*)(SC + (n & 1) * SC_PAR + tid * 4) = ps0;
        if (ML) { v4u o; o.x = pkbf(lo2f(pv.x) * pws, hi2f(pv.x) * pws); o.y = pkbf(lo2f(pv.y) * pws, hi2f(pv.y) * pws); o.z = pkbf(lo2f(pv.z) * pws, hi2f(pv.z) * pws); o.w = pkbf(lo2f(pv.w) * pws, hi2f(pv.w) * pws);
            *(LAS v4u*)(L + SL_VW + va) = o;
            if (n >= 4) *(LAS v4u*)(L + SL_W + va) = pw;
            if (tid < 64) { LAS float* sp = SC + (n & 1) * SC_PAR + tid; sp[0] = ps0.x; sp[64] = ps0.y; sp[128] = ps0.z; sp[192] = ps0.w; sp[256] = ps1.x; sp[320] = ps1.y; sp[384] = ps1.z; } }
    };
    __syncthreads();
    issue_loads(0); touch(1);
    for (int e = tid; e < 32768 / 16; e += NT) *(LAS v4u*)(L + SL_SF + e * 16) = (v4u){0u, 0u, 0u, 0u};
    store_images(0);
    __syncthreads();
#pragma unroll 1
    for (int n = 0; n < 68; ++n) {
        const bool lat = n >= 4; const int row0 = row0_of(n); const int cid = row0 >> 6;
        tdummy ^= tch0 ^ tch1;
        if (n + 1 < 68 && !(SKIP & 16)) issue_loads(n + 1);
        if (n + 2 < 68 && !(SKIP & 16)) touch(n + 2);
        LAS float* SP = SC + (n & 1) * SC_PAR;
        float dec = 1.f; f32x4 pe[NOWN][4];
        if (ML) dec = SP[384];
        else {
#pragma unroll
            for (int i = 0; i < NOWN; ++i)
#pragma unroll
                for (int g = 0; g < 4; ++g) pe[i][g] = *(const LAS f32x4*)(SP + 32 * (kh * NKH + tp * NOWN + i) + 8 * g + 4 * hh);
        }
        f32x16 o;
        if (lat && !(SKIP & 4)) {
            f32x16 acc_o, acc_i;
#pragma unroll
            for (int r = 0; r < 16; ++r) { acc_o[r] = 0.f; acc_i[r] = 0.f; }
            if (ML) {
                if (kh == 0) {
#pragma unroll
                    for (int ts = 0; ts < 2; ++ts) {
                        const bool need = dirn ? (ts >= tp) : (ts <= tp);
                        if (need) {
                            const bf16x8 a0 = *(const LAS bf16x8*)(L + SL_W + tp * 4096 + 512 * ts + WL[0]), a1 = *(const LAS bf16x8*)(L + SL_W + tp * 4096 + 512 * ts + WL[1]);
                            const s16x4 lo0 = lds_tr(L + SL_V + ts * 4096 + VN[0]), hi0 = lds_tr(L + SL_V + ts * 4096 + 256 + VN[1]);
                            const s16x4 lo1 = lds_tr(L + SL_V + ts * 4096 + 2048 + VN[0]), hi1 = lds_tr(L + SL_V + ts * 4096 + 2048 + 256 + VN[1]);
                            acc_o = MFMA32(a0, cat4(lo0, hi0), acc_o);
                            acc_o = MFMA32(a1, cat4(lo1, hi1), acc_o);
                        }
                    }
                }
            } else
#pragma unroll
            for (int ts = 0; ts < 2; ++ts) {
                const bool need = dirn ? (ts >= tp) : (ts <= tp);
                if (need) {
                    f32x16 c;
#pragma unroll
                    for (int r = 0; r < 16; ++r) c[r] = 0.f;
                    {
                        bf16x8 a_c = *(const LAS bf16x8*)(L + SL_KT + ts * NCB * 8192 + LBx[0]), b_c = *(const LAS bf16x8*)(L + SL_QT + tp * NCB * 8192 + LBx[0]), a_n = a_c, b_n = b_c;
#pragma unroll
                        for (int s = 0; s < NKT; ++s) {
                            if (s + 1 < NKT) { a_n = *(const LAS bf16x8*)(L + SL_KT + ts * NCB * 8192 + 512 * ((s + 1) >> 1) + LBx[(s + 1) & 1]); b_n = *(const LAS bf16x8*)(L + SL_QT + tp * NCB * 8192 + 512 * ((s + 1) >> 1) + LBx[(s + 1) & 1]); }
                            c = MFMA32(a_c, b_c, c);
                            a_c = a_n; b_c = b_n;
                        }
                    }
                    const s16x4 vlo0 = lds_tr(L + SL_V + ts * 4096 + VK[0]), vhi0 = lds_tr(L + SL_V + ts * 4096 + 1024 + VK[1]);
                    const s16x4 vlo1 = lds_tr(L + SL_V + ts * 4096 + 2048 + VK[0]), vhi1 = lds_tr(L + SL_V + ts * 4096 + 3072 + VK[1]);
                    int dl = (lane & 31) - 4 * (int)hh; if (dirn) dl = -dl; asm volatile("" : "+v"(dl));
                    const int sg1 = dirn ? -1 : 1; const bool diag = ts == tp;
#pragma unroll
                    for (int r = 0; r < 16; ++r) { const int ro = (r & 3) + 8 * (r >> 2);
                        float wv = c[r];
                        if (diag) wv = (dl - sg1 * ro >= 0) ? wv : 0.f;
                        c[r] = wv; }
                    acc_o = MFMA32(pk8(c[0], c[1], c[2], c[3], c[4], c[5], c[6], c[7]), cat4(vlo0, vhi0), acc_o);
                    acc_o = MFMA32(pk8(c[8], c[9], c[10], c[11], c[12], c[13], c[14], c[15]), cat4(vlo1, vhi1), acc_o);
                }
            }
            {
#define LD_INTER(i_, LO_, HI_, SF_) do { LO_ = *(const LAS s16x4*)(L + SL_QT + tp * NCB * 8192 + 512 * ((i_) >> 1) + LK[(i_) & 1][0]); HI_ = *(const LAS s16x4*)(L + SL_QT + tp * NCB * 8192 + 512 * ((i_) >> 1) + LK[(i_) & 1][1]); \
                SF_ = *(const LAS bf16x8*)(L + SL_SF + ((((kh * NKH + ((i_) >> 1)) * 2 + tj) * 2 + ((i_) & 1)) * 1024) + lane * 16); } while (0)
                s16x4 lo_c, hi_c, lo_n, hi_n; bf16x8 sf_c, sf_n;
                LD_INTER(0, lo_c, hi_c, sf_c); lo_n = lo_c; hi_n = hi_c; sf_n = sf_c;
#pragma unroll
                for (int i = 0; i < 2 * NKH; ++i) {
                    if (i + 1 < 2 * NKH) LD_INTER(i + 1, lo_n, hi_n, sf_n);
                    acc_i = MFMA32(cat4(lo_c, hi_c), sf_c, acc_i);
                    lo_c = lo_n; hi_c = hi_n; sf_c = sf_n;
                }
#undef LD_INTER
            }
            if (ML) {
                f32x4 wi[4];
#pragma unroll
                for (int g = 0; g < 4; ++g) wi[g] = *(const LAS f32x4*)(SP + 128 + 32 * tp + 8 * g + 4 * hh);
#pragma unroll
                for (int r = 0; r < 16; ++r) o[r] = acc_o[r] + wi[r >> 2][r & 3] * acc_i[r];
            } else {
#pragma unroll
                for (int r = 0; r < 16; ++r) o[r] = acc_o[r] + acc_i[r];
            }
            {
#pragma unroll
                for (int r = 0; r < 8; ++r) { const int rr = kh ? r : r + 8; *(LAS float*)(L + SL_XCH + (((tp * 2 + tj) * 16 + rr) * 64 + lane) * 4) = kh ? o[r] : o[r + 8]; }
            }
        }
        {
            if (ML) {
#pragma unroll
                for (int i = 0; i < NOWN; ++i)
#pragma unroll
                    for (int r = 0; r < 16; ++r) S[i][r] *= dec;
            }
#define LD_GA(ks_, i_, LO_, HI_) do { LO_ = lds_tr(L + SL_KT + ((ks_) >> 1) * NCB * 8192 + 4096 * ((ks_) & 1) + tkoff[i_] + TRK[0]); HI_ = lds_tr(L + SL_KT + ((ks_) >> 1) * NCB * 8192 + 4096 * ((ks_) & 1) + 256 + tkoff[i_] + TRK[1]); } while (0)
#define LD_GB(ks_, LO_, HI_) do { LO_ = lds_tr(L + (ML ? SL_VW : SL_V) + ((ks_) >> 1) * 4096 + 2048 * ((ks_) & 1) + VN[0]); HI_ = lds_tr(L + (ML ? SL_VW : SL_V) + ((ks_) >> 1) * 4096 + 2048 * ((ks_) & 1) + 256 + VN[1]); } while (0)
            s16x4 alo_c, ahi_c, blo_c, bhi_c, alo_n, ahi_n, blo_n, bhi_n;
            LD_GB(0, blo_c, bhi_c); LD_GA(0, 0, alo_c, ahi_c); alo_n = alo_c; ahi_n = ahi_c; blo_n = blo_c; bhi_n = bhi_c;
            constexpr int NG = (SKIP & 8) ? 0 : 4 * NOWN;
#pragma unroll
            for (int j = 0; j < NG; ++j) {
                const int ks = j / NOWN, i = j % NOWN, ks1 = (j + 1) / NOWN, i1 = (j + 1) % NOWN;
                if (j + 1 < NG) { LD_GA(ks1, i1, alo_n, ahi_n); if (i1 == 0) LD_GB(ks1, blo_n, bhi_n); }
                S[i] = MFMA32(cat4(alo_c, ahi_c), cat4(blo_c, bhi_c), S[i]);
                alo_c = alo_n; ahi_c = ahi_n; if (i1 == 0) { blo_c = blo_n; bhi_c = bhi_n; }
                (void)ks;
            }
#undef LD_GA
#undef LD_GB
            if (!ML) {
#pragma unroll
                for (int i = 0; i < NOWN; ++i)
#pragma unroll
                    for (int r = 0; r < 16; ++r) S[i][r] *= pe[i][r >> 2][r & 3];
            }
        }
        __syncthreads();
        if (lat && !(SKIP & 2)) {
            float xv[8];
#pragma unroll
            for (int r8 = 0; r8 < 8; ++r8) { const int r = kh ? r8 + 8 : r8; xv[r8] = *(const LAS float*)(L + SL_XCH + (((tp * 2 + tj) * 16 + r) * 64 + lane) * 4); }
#pragma unroll
            for (int r8 = 0; r8 < 8; ++r8) { const int r = kh ? r8 + 8 : r8; const float ov = (kh ? o[r8 + 8] : o[r8]) + xv[r8];
                const int pr = 32 * tp + (r & 3) + 8 * (r >> 2) + 4 * (int)hh;
                go[(size_t)(row0 + pr) * WA + 32 * tj + (lane & 31)] = (bf16)(pkbf(ov, 0.f) & 0xffffu); }
        }
#pragma unroll
        for (int i = 0; i < NOWN; ++i)
#pragma unroll
            for (int st = 0; st < 2; ++st) {
                const bf16x8 f8 = pk8(S[i][8 * st], S[i][8 * st + 1], S[i][8 * st + 2], S[i][8 * st + 3], S[i][8 * st + 4], S[i][8 * st + 5], S[i][8 * st + 6], S[i][8 * st + 7]);
                *(LAS bf16x8*)(L + SL_SF + ((((kh * NKH + tp * NOWN + i) * 2 + tj) * 2 + st) * 1024) + lane * 16) = f8;
            }
        if (n + 1 < 68 && !(SKIP & 16)) store_images(n + 1);
        __syncthreads();
    }
    if (tdummy == 0x9e3779b9u && tid == 600) F.ctl[30000] = 1u;
}
#ifndef HG_MFMA
#define HG_MFMA 1
#endif
#ifndef ML_MFMA
#define ML_MFMA 1
#endif

__device__ __forceinline__ void nchain_task(Frame& F, int j) {
    const int kq = j & 3, id = j >> 2, dirn = id & 1, h = (id >> 1) & 3, b = id >> 3;
    const int tid = F.tid, lane = F.lane, w = F.wave;
    LAS unsigned char* L = F.lds;
    constexpr int NQ = 0, NK = 8192, NS = 16384;
    LAS float* SN = (LAS float*)(L + NS);
    const bf16* gq = F.XN + h * MLD + kq * 64; const bf16* gk = gq + WB;
    const float* mls = F.MLS + (size_t)(dirn * 4 + h) * MALL * 8;
    float* dqp = F.DQP + (size_t)((dirn * 4 + h) * 4 + kq) * MX;
    auto row0_of = [&](int n) -> int { if (n < 4) { const int cc = dirn ? 3 - n : n; return MX + b * CTXL + cc * 64; } const int lc = dirn ? 67 - n : n - 4; return b * SEQ + lc * 64; };
    v4u pq, pk; float pws = 0.f, pdec = 0.f;
    auto issue = [&](int n) { const int row0 = row0_of(n); const size_t off = (size_t)(row0 + (tid >> 3)) * DM + (tid & 7) * 8;
        pq = *(const GAS v4u*)(gq + off); pk = *(const GAS v4u*)(gk + off);
        if (tid < 64) { pws = mls[(size_t)(row0 + tid) * 8 + 3]; pdec = mls[(size_t)(row0 + tid) * 8 + 6]; } };
    auto stash = [&]() { *(LAS v4u*)(L + NQ + tid * 16) = pq; *(LAS v4u*)(L + NK + tid * 16) = pk; if (tid < 64) { SN[tid] = pws; if (tid == 0) SN[640] = pdec; } };
    __syncthreads();
    issue(0);
    if (tid < 64) SN[64 + tid] = 0.f;
    stash();
    __syncthreads();
#pragma unroll 1
    for (int n = 0; n < 68; ++n) {
        const int row0 = row0_of(n);
        if (n + 1 < 68) issue(n + 1);
        if (n >= 4) {
            const int p = tid >> 3, kk = tid & 7; const v4u u = *(const LAS v4u*)(L + NQ + tid * 16);
            const f32x4 na = *(const LAS f32x4*)(SN + 64 + 8 * kk), nb = *(const LAS f32x4*)(SN + 64 + 8 * kk + 4);
            float d = lo2f(u.x) * na.x + hi2f(u.x) * na.y + lo2f(u.y) * na.z + hi2f(u.y) * na.w + lo2f(u.z) * nb.x + hi2f(u.z) * nb.y + lo2f(u.w) * nb.z + hi2f(u.w) * nb.w;
            d += __shfl_xor(d, 1); d += __shfl_xor(d, 2); d += __shfl_xor(d, 4);
            if (kk == 0) dqp[row0 + p] = d;
        }
        { float a = 0.f;
#pragma unroll
          for (int i = 0; i < 8; ++i) { const int s_ = 8 * w + i; a += SN[s_] * bf2f(*(const LAS unsigned short*)(L + NK + s_ * 128 + lane * 2)); }
          SN[128 + w * 64 + lane] = a; }
        __syncthreads();
        if (tid < 64) { float nn = SN[640] * SN[64 + tid];
#pragma unroll
            for (int ww = 0; ww < 8; ++ww) nn += SN[128 + ww * 64 + tid];
            SN[64 + tid] = nn; }
        if (n + 1 < 68) stash();
        __syncthreads();
    }
}

template <int WHICH, int SKIP = 0>
__device__ __forceinline__ void p4_scan(Frame& F) {
    for (int t = F.vcu; t < 256; t += F.G) {
        if (t < 128 ? !(WHICH & 1) : !(WHICH & 2)) continue;
        if (t < 128) { if (ML_MFMA) scan_task<true, SKIP>(F, t); else { p4_mlstm_task(F, 2 * t); p4_mlstm_task(F, 2 * t + 1); } }
        else { if (HG_MFMA) { scan_task<false, SKIP>(F, t - 128); nchain_task(F, t - 128); } else { p4_hgrn2_task(F, 2 * (t - 128)); p4_hgrn2_task(F, 2 * (t - 128) + 1); } }
    }
}
__device__ __forceinline__ void p5_combine(Frame& F) {
    bf16* Y = F.XN;
    const int gw = F.vcu * NWAVES + F.wave, NGW = F.G * NWAVES;
    for (int row = gw; row < MX; row += NGW) {
        const int ch = F.lane * 16;
        {
            float o[16];
            const v4u a0 = *(const GAS v4u*)(F.OAF + (size_t)row * WA + ch), a1 = *(const GAS v4u*)(F.OAF + (size_t)row * WA + ch + 8);
            const v4u b0 = *(const GAS v4u*)(F.OAB + (size_t)row * WA + ch), b1 = *(const GAS v4u*)(F.OAB + (size_t)row * WA + ch + 8);
            const unsigned ua[8] = {a0.x, a0.y, a0.z, a0.w, a1.x, a1.y, a1.z, a1.w}, ub[8] = {b0.x, b0.y, b0.z, b0.w, b1.x, b1.y, b1.z, b1.w};
            float ss = 0.f;
#pragma unroll
            for (int j = 0; j < 8; ++j) { o[2 * j] = lo2f(ua[j]) + lo2f(ub[j]); o[2 * j + 1] = hi2f(ua[j]) + hi2f(ub[j]); ss += o[2 * j] * o[2 * j] + o[2 * j + 1] * o[2 * j + 1]; }
            ss += __shfl_xor(ss, 1); ss += __shfl_xor(ss, 2); ss += __shfl_xor(ss, 4);
            const float r = 1.f / sqrtf(ss * (1.f / HGD) + NORM_EPS);
            const v4u z0 = *(const GAS v4u*)(F.U + (size_t)row * NU + C_AZ + ch), z1 = *(const GAS v4u*)(F.U + (size_t)row * NU + C_AZ + ch + 8);
            const unsigned uz[8] = {z0.x, z0.y, z0.z, z0.w, z1.x, z1.y, z1.z, z1.w};
            unsigned w[8];
#pragma unroll
            for (int j = 0; j < 8; ++j) { const float y0 = o[2 * j] * r * F.hg_norm_w[ch + 2 * j] * siluf(lo2f(uz[j])), y1 = o[2 * j + 1] * r * F.hg_norm_w[ch + 2 * j + 1] * siluf(hi2f(uz[j])); w[j] = pk2(y0, y1); }
            *(GAS v4u*)(Y + (size_t)row * DM + ch) = (v4u){w[0], w[1], w[2], w[3]}; *(GAS v4u*)(Y + (size_t)row * DM + ch + 8) = (v4u){w[4], w[5], w[6], w[7]};
        }
        {
            float o[16];
            const v4u a0 = *(const GAS v4u*)(F.HBF + (size_t)row * WB + ch), a1 = *(const GAS v4u*)(F.HBF + (size_t)row * WB + ch + 8);
            const v4u b0 = *(const GAS v4u*)(F.HBB + (size_t)row * WB + ch), b1 = *(const GAS v4u*)(F.HBB + (size_t)row * WB + ch + 8);
            const unsigned ua[8] = {a0.x, a0.y, a0.z, a0.w, a1.x, a1.y, a1.z, a1.w}, ub[8] = {b0.x, b0.y, b0.z, b0.w, b1.x, b1.y, b1.z, b1.w};
            float s = 0.f; const int hq = F.lane >> 4;
            float invd[2];
#pragma unroll
            for (int d = 0; d < 2; ++d) { const float* mr = F.MLS + ((size_t)(d * 4 + hq) * MALL + row) * 8; const float* dq = F.DQP + (size_t)((d * 4 + hq) * 4) * MX + row;
                const float den = mr[2] * ((dq[0] + dq[MX]) + (dq[2 * MX] + dq[3 * MX])) + mr[5];
                invd[d] = rcpf_(fmaxf(fabsf(den), mr[4])); }
#pragma unroll
            for (int j = 0; j < 8; ++j) { o[2 * j] = lo2f(ua[j]) * invd[0] + lo2f(ub[j]) * invd[1]; o[2 * j + 1] = hi2f(ua[j]) * invd[0] + hi2f(ub[j]) * invd[1]; s += o[2 * j] + o[2 * j + 1]; }
            s += __shfl_xor(s, 1); s += __shfl_xor(s, 2); s += __shfl_xor(s, 4); s += __shfl_xor(s, 8);
            const float mu = s * (1.f / MLD); float q = 0.f;
#pragma unroll
            for (int j = 0; j < 16; ++j) { o[j] -= mu; q += o[j] * o[j]; }
            q += __shfl_xor(q, 1); q += __shfl_xor(q, 2); q += __shfl_xor(q, 4); q += __shfl_xor(q, 8);
            const float r = 1.f / sqrtf(q * (1.f / MLD) + NORM_EPS);
            const v4u g0 = *(const GAS v4u*)(F.U + (size_t)row * NU + C_BO + ch), g1 = *(const GAS v4u*)(F.U + (size_t)row * NU + C_BO + ch + 8);
            const v4u z0 = *(const GAS v4u*)(F.U + (size_t)row * NU + C_BZ + ch), z1 = *(const GAS v4u*)(F.U + (size_t)row * NU + C_BZ + ch + 8);
            const unsigned ug[8] = {g0.x, g0.y, g0.z, g0.w, g1.x, g1.y, g1.z, g1.w}, uz[8] = {z0.x, z0.y, z0.z, z0.w, z1.x, z1.y, z1.z, z1.w};
            unsigned w[8];
#pragma unroll
            for (int j = 0; j < 8; ++j) { const float y0 = o[2 * j] * r * F.ml_norm_w[ch + 2 * j] * sigmf(lo2f(ug[j])) * siluf(lo2f(uz[j])), y1 = o[2 * j + 1] * r * F.ml_norm_w[ch + 2 * j + 1] * sigmf(hi2f(ug[j])) * siluf(hi2f(uz[j])); w[j] = pk2(y0, y1); }
            *(GAS v4u*)(Y + (size_t)row * DM + WA + ch) = (v4u){w[0], w[1], w[2], w[3]}; *(GAS v4u*)(Y + (size_t)row * DM + WA + ch + 8) = (v4u){w[4], w[5], w[6], w[7]};
        }
    }
}

struct EpiResid {
    static constexpr bool PERM = false, AFTER_DRAIN = false;
    const float* x; const float* gate; float* out;
    __device__ __forceinline__ void operator()(const pg8::f32x4 (&acc)[2][2][4][2], const pg8::Unit& u, int wr, int wc, int fr, int fq) const {
        using pg8::BM; using pg8::HALF;
        const int row0 = u.pm * BM + wr * 64 + fr, col0 = u.pn * BM + wc * 32 + 4 * fq; const int b = (u.pm * BM) / SEQ;
        pg8::f32x4 gv[2][2];
#pragma unroll
        for (int bj = 0; bj < 2; ++bj)
#pragma unroll
            for (int n = 0; n < 2; ++n) gv[bj][n] = *(const pg8::f32x4*)(gate + b * DM + col0 + bj * HALF + n * 16);
#pragma unroll
        for (int ai = 0; ai < 2; ++ai)
#pragma unroll
            for (int m = 0; m < 4; ++m) { const size_t off = (size_t)(row0 + ai * HALF + m * 16) * DM + col0;
#pragma unroll
                for (int bj = 0; bj < 2; ++bj)
#pragma unroll
                    for (int n = 0; n < 2; ++n) { const pg8::f32x4 xv = *(const pg8::f32x4*)(x + off + bj * HALF + n * 16);
                        *(pg8::f32x4*)(out + off + bj * HALF + n * 16) = xv * ALPHA + gv[bj][n] * acc[ai][bj][m][n]; } }
    }
};


struct PanelOrder {
    int c;
    __device__ __forceinline__ bool next(int i, pg8::Unit& u) const { if (i >= 2) return false; u.pm = c >> 2; u.pn = (c & 3) + 4 * i; return true; }
    __device__ __forceinline__ void a_ready(const pg8::Unit&) const {}
    __device__ __forceinline__ void done(const pg8::Unit&) const {}
};
struct EpiLnFused {
    static constexpr bool PERM = false, AFTER_DRAIN = true;
    const float* x; const float* gate; float* out; const float* ln_g; const float* ln_b;
    unsigned long long* xbuf;
    unsigned* cnt;
    __device__ __forceinline__ void zstats(pg8::f32x4 (&acc)[2][2][4][2], const pg8::Unit& u, int wr, int wc, int fr, int fq) const {
        using pg8::BM; using pg8::HALF;
        asm volatile("" : "+v"(fr), "+v"(fq));
        const int row0 = u.pm * BM + wr * 64 + fr, col0 = u.pn * BM + wc * 32 + 4 * fq; const int b = (u.pm * BM) / SEQ;
        pg8::f32x4 gv[2][2];
#pragma unroll
        for (int bj = 0; bj < 2; ++bj)
#pragma unroll
            for (int n = 0; n < 2; ++n) gv[bj][n] = *(const pg8::f32x4*)(gate + b * DM + col0 + bj * HALF + n * 16);
#pragma unroll
        for (int ai = 0; ai < 2; ++ai)
#pragma unroll
            for (int m = 0; m < 4; ++m) { const int row = row0 + ai * HALF + m * 16; const size_t off = (size_t)row * DM + col0;
                float s = 0.f;
#pragma unroll
                for (int bj = 0; bj < 2; ++bj)
#pragma unroll
                    for (int n = 0; n < 2; ++n) { const pg8::f32x4 xv = *(const pg8::f32x4*)(x + off + bj * HALF + n * 16);
                        const pg8::f32x4 z = xv * ALPHA + gv[bj][n] * acc[ai][bj][m][n]; acc[ai][bj][m][n] = z; s += (z[0] + z[1]) + (z[2] + z[3]); }
                s += __shfl_xor(s, 16); s += __shfl_xor(s, 32);
                const float mw = s * (1.0f / 64.0f); float q = 0.f;
#pragma unroll
                for (int bj = 0; bj < 2; ++bj)
#pragma unroll
                    for (int n = 0; n < 2; ++n) { const pg8::f32x4 d = acc[ai][bj][m][n] - mw; q += (d[0] * d[0] + d[1] * d[1]) + (d[2] * d[2] + d[3] * d[3]); }
                q += __shfl_xor(q, 16); q += __shfl_xor(q, 32);
                if (fq == 0) __hip_atomic_store(xbuf + (size_t)row * 32 + u.pn * 4 + wc, ((unsigned long long)__float_as_uint(q) << 32) | __float_as_uint(mw), __ATOMIC_RELAXED, __HIP_MEMORY_SCOPE_AGENT);
            }
    }
    __device__ __forceinline__ void publish(const pg8::Unit& u) const {
        asm volatile("s_waitcnt vmcnt(0)" ::: "memory");
        if ((threadIdx.x & 63) == 0) __hip_atomic_fetch_add(cnt + 64 * u.pm, 1u, __ATOMIC_RELAXED, __HIP_MEMORY_SCOPE_AGENT);
    }
    __device__ __forceinline__ void operator()(const pg8::f32x4 (&acc_c)[2][2][4][2], const pg8::Unit& u, int wr, int wc, int fr, int fq) const {
        using pg8::BM; using pg8::HALF;
        pg8::f32x4 (&acc)[2][2][4][2] = const_cast<pg8::f32x4 (&)[2][2][4][2]>(acc_c);
        zstats(acc, u, wr, wc, fr, fq);
        const int row0 = u.pm * BM + wr * 64 + fr, col0 = u.pn * BM + wc * 32 + 4 * fq;
#pragma unroll
        for (int ai = 0; ai < 2; ++ai)
#pragma unroll
            for (int m = 0; m < 4; ++m) { const size_t off = (size_t)(row0 + ai * HALF + m * 16) * DM + col0;
#pragma unroll
                for (int bj = 0; bj < 2; ++bj)
#pragma unroll
                    for (int n = 0; n < 2; ++n) *(pg8::f32x4*)(out + off + bj * HALF + n * 16) = acc[ai][bj][m][n]; }
        publish(u);
    }
    __device__ __forceinline__ void fused(pg8::f32x4 (&acc)[2][2][4][2], const pg8::Unit& u, int wr, int wc, int fr, int fq, PG8_LAS unsigned char* lds, int wid, int lane) const {
        using pg8::BM; using pg8::HALF;
        typedef float f32x2v __attribute__((ext_vector_type(2)));
        PG8_LAS f32x2v* PH = (PG8_LAS f32x2v*)(lds + 131072);
        PG8_LAS f32x2v* S = (PG8_LAS f32x2v*)(lds + 131072 + 4096);
        zstats(acc, u, wr, wc, fr, fq);
        publish(u);
        if (wid == 0) {
            unsigned spins = 0;
            while ((unsigned)__builtin_amdgcn_readfirstlane(__hip_atomic_load(cnt + 64 * u.pm, __ATOMIC_RELAXED, __HIP_MEMORY_SCOPE_AGENT)) < 64u) { __builtin_amdgcn_s_sleep(2); if (++spins > (1u << 22)) break; }
            __builtin_amdgcn_fence(__ATOMIC_ACQUIRE, "agent");
            asm volatile("s_waitcnt vmcnt(0)" ::: "memory");
        }
        asm volatile("s_waitcnt vmcnt(0) lgkmcnt(0)" ::: "memory"); __builtin_amdgcn_s_barrier(); asm volatile("" ::: "memory");
        { const int t = threadIdx.x, row = t >> 1, half = t & 1; const unsigned long long* sl = xbuf + (size_t)(u.pm * BM + row) * 32 + half * 16;
          float ms = 0.f, mq = 0.f, m2s = 0.f;
#pragma unroll
          for (int i = 0; i < 16; ++i) { const unsigned long long w = __hip_atomic_load(sl + i, __ATOMIC_RELAXED, __HIP_MEMORY_SCOPE_AGENT); const float mt = __uint_as_float((unsigned)w); ms += mt; mq += mt * mt; m2s += __uint_as_float((unsigned)(w >> 32)); }
          const float mh = ms * (1.0f / 16.0f);
          PH[row * 2 + half] = (f32x2v){mh, m2s + 64.0f * fmaxf(mq - 16.0f * mh * mh, 0.f)}; }
        asm volatile("s_waitcnt lgkmcnt(0)" ::: "memory"); __builtin_amdgcn_s_barrier(); asm volatile("" ::: "memory");
        if (threadIdx.x < 256) { const int row = threadIdx.x; const f32x2v a = PH[row * 2], bq = PH[row * 2 + 1];
            const float mean = 0.5f * (a.x + bq.x), da = a.x - mean, db = bq.x - mean; const float m2t = (a.y + bq.y) + 1024.0f * (da * da + db * db);
            S[row] = (f32x2v){mean, 1.0f / sqrtf(m2t * (1.0f / 2048.0f) + LN_EPS)}; }
        asm volatile("s_waitcnt lgkmcnt(0)" ::: "memory"); __builtin_amdgcn_s_barrier(); asm volatile("" ::: "memory");
        const int row0 = u.pm * BM + wr * 64 + fr, col0 = u.pn * BM + wc * 32 + 4 * fq;
#pragma unroll
        for (int bj = 0; bj < 2; ++bj)
#pragma unroll
            for (int n = 0; n < 2; ++n) { const int c = col0 + bj * HALF + n * 16;
                const pg8::f32x4 g2 = *(const pg8::f32x4*)(ln_g + c), b2 = *(const pg8::f32x4*)(ln_b + c), g1 = *(const pg8::f32x4*)(ln_g + c - 4 * BM), b1 = *(const pg8::f32x4*)(ln_b + c - 4 * BM);
#pragma unroll
                for (int ai = 0; ai < 2; ++ai)
#pragma unroll
                    for (int m = 0; m < 4; ++m) { const int rl = ai * HALF + wr * 64 + m * 16 + fr; const f32x2v sr = S[rl]; const size_t off = (size_t)(row0 + ai * HALF + m * 16) * DM + c;
                        const pg8::f32x4 z1 = *(const pg8::f32x4*)(out + off - 4 * BM);
                        *(pg8::f32x4*)(out + off) = (acc[ai][bj][m][n] - sr.x) * sr.y * g2 + b2;
                        acc[ai][bj][m][n] = (z1 - sr.x) * sr.y * g1 + b1; }
#pragma unroll
                for (int ai = 0; ai < 2; ++ai)
#pragma unroll
                    for (int m = 0; m < 4; ++m) { const size_t off = (size_t)(row0 + ai * HALF + m * 16) * DM + c; *(pg8::f32x4*)(out + off - 4 * BM) = acc[ai][bj][m][n]; } }
    }
};

__device__ __forceinline__ void p7_ln(Frame& F) {
    const int gw = F.vcu * NWAVES + F.wave, NGW = F.G * NWAVES;
    for (int row = 2 * gw; row < MX; row += 2 * NGW) {
        GAS f32x4* ra = (GAS f32x4*)(F.out + (size_t)row * DM) + F.lane; GAS f32x4* rb = ra + DM / 4;
        f32x4 va[8], vb[8]; float sa = 0.f, sb = 0.f;
#pragma unroll
        for (int j = 0; j < 8; ++j) { va[j] = ra[64 * j]; vb[j] = rb[64 * j]; }
#pragma unroll
        for (int j = 0; j < 8; ++j) { sa += (va[j].x + va[j].y) + (va[j].z + va[j].w); sb += (vb[j].x + vb[j].y) + (vb[j].z + vb[j].w); }
        const float ma = wave_sum(sa) * (1.f / DM), mb = wave_sum(sb) * (1.f / DM); float qa = 0.f, qb = 0.f;
#pragma unroll
        for (int j = 0; j < 8; ++j) { va[j] = va[j] - ma; vb[j] = vb[j] - mb; qa += (va[j].x * va[j].x + va[j].y * va[j].y) + (va[j].z * va[j].z + va[j].w * va[j].w); qb += (vb[j].x * vb[j].x + vb[j].y * vb[j].y) + (vb[j].z * vb[j].z + vb[j].w * vb[j].w); }
        const float rsa = 1.f / sqrtf(wave_sum(qa) * (1.f / DM) + LN_EPS), rsb = 1.f / sqrtf(wave_sum(qb) * (1.f / DM) + LN_EPS);
#pragma unroll
        for (int j = 0; j < 8; ++j) { const int k = 4 * F.lane + 256 * j; const f32x4 g = *(const f32x4*)(F.ln_g + k), bb = *(const f32x4*)(F.ln_b + k);
            ra[64 * j] = va[j] * rsa * g + bb; rb[64 * j] = vb[j] * rsb * g + bb; }
    }
}

struct Args { const float* in[16]; float* out; unsigned char* ws; int ph_lo, ph_hi, li, pad; };
__global__ void __launch_bounds__(NWAVES * 64, 2) mk_fwd(Args args) {
    extern __shared__ __attribute__((aligned(16))) unsigned char lds[];
    Frame F;
    F.lds = (LAS unsigned char*)lds;
    F.MISC = (volatile LAS unsigned*)(F.lds + MISC_OFF);
    F.tid = threadIdx.x; F.lane = F.tid & 63; F.wave = __builtin_amdgcn_readfirstlane(F.tid >> 6);
    F.G = gridDim.x; { const int bx = blockIdx.x; F.vcu = (F.G % 8 == 0) ? (bx % 8) * (F.G / 8) + bx / 8 : bx; }
    unsigned char* ws = args.ws;
    F.ctl = (gu32*)(ws + WS_CTL);
    F.x = args.in[0]; F.c = args.in[1]; F.ctx = args.in[2]; F.c_ctx = args.in[3]; F.w_mod = args.in[4]; F.b_mod = args.in[5]; F.w_in = args.in[6];
    F.conv_w = args.in[7]; F.conv_b = args.in[8]; F.hg_lb = args.in[9]; F.ml_gate_b = args.in[10]; F.hg_norm_w = args.in[11]; F.ml_norm_w = args.in[12];
    F.w_out = args.in[13]; F.ln_g = args.in[14]; F.ln_b = args.in[15]; F.out = args.out;
    F.modp = (float*)(ws + WS_MODP); F.gate = (float*)(ws + WS_GATE);
    F.QTF = (bf16*)(ws + WS_WINT); F.PE = (float*)(ws + WS_PE); F.MLS = (float*)(ws + WS_MLS); F.DEC = (float*)(ws + WS_DEC); F.MLW = (bf16*)(ws + WS_MLW); F.DQP = (float*)(ws + WS_DQP);
    F.WinT = (bf16*)(ws + WS_WINT); F.WoutT = (bf16*)(ws + WS_WOUTT); F.XN = (bf16*)(ws + WS_XN); F.U = (bf16*)(ws + WS_U);
    F.OAF = (bf16*)args.out; F.OAB = F.OAF + (size_t)MX * WA; F.HBF = F.OAB + (size_t)MX * WA; F.HBB = F.HBF + (size_t)MX * WB;
    for (int u = F.tid; u < (LDS_BYTES - LDSCTL_OFF) / 4; u += NT) ((LAS unsigned*)(F.lds + LDSCTL_OFF))[u] = 0u;
    __syncthreads();
    XcdBarrier bar; bar.bar = (unsigned*)(F.ctl + CW_BAR); bar.x = 0; bar.st = nullptr;
    if (MK_N_LAUNCHES == 1) bar = xcd_barrier_post((unsigned*)(F.ctl + CW_BAR), F.MISC + 8);
    const int lo = args.ph_lo, hi = args.ph_hi;
#ifndef PH_MASK
#define PH_MASK 255
#endif
#define PHON(k) ((PH_MASK >> (k)) & 1)
#ifndef DUP_MASK
#define DUP_MASK 0
#endif
#define DUP(k) ((DUP_MASK >> (k)) & 1)
#ifndef FUSE_LN
#define FUSE_LN 0
#endif
#ifndef DUP4S
#define DUP4S 0
#endif
#ifndef DUP4W
#define DUP4W 3
#endif
#ifndef DUP3W
#define DUP3W 7
#endif
#define IN(k) (lo <= (k) && (k) < hi)
#define SEAM(k) do { if (IN(k) && IN((k) + 1)) xcd_barrier(bar); } while (0)
    if (PHON(0) && IN(0)) { p0_prep(F); if (DUP(0)) p0_prep(F); } SEAM(0);
    if (PHON(1) && IN(1)) { p1_lnmod(F); if (DUP(1)) p1_lnmod(F); } SEAM(1);
    if (PHON(2) && IN(2)) { pg8::Gemm g{F.XN, F.WinT, MALL, NU, DM}; pg8::StaticOrder S; S.init(MALL, NU, F.G, (int)blockIdx.x);
        pg8::EpiBf16<0> E{F.U, NU, nullptr, 0, 0, 1.f};
        pg8::gemm_phase<pg8::EpiBf16<0>, pg8::StaticOrder, PG8_ALIGN, PG8_SP2>(F.lds + RING_OFF, g, S, E); } SEAM(2);
    if (PHON(3) && IN(3)) { if (DUP(3)) { if (DUP3W & 1) p3_hg_prep<true>(F); if (DUP3W & 2) p3_conv(F); if (DUP3W & 4) p3_ml_scalars(F); } p3_conv(F); if (HG_MFMA) p3_hg_prep<false>(F); if (ML_MFMA) p3_ml_scalars(F); xcd_barrier(bar); p3b_ml_scores(F); if (DUP(6)) p3b_ml_scores(F); } SEAM(3);
    if (PHON(4) && IN(4)) { if (DUP(4)) p4_scan<DUP4W, DUP4S>(F); p4_scan<3>(F); } SEAM(4);
    if (PHON(5) && IN(5)) { p5_combine(F); if (DUP(5)) p5_combine(F); if (DUP(7)) { xcd_barrier(bar); xcd_barrier(bar); xcd_barrier(bar); xcd_barrier(bar); } } SEAM(5);
    if (PHON(6) && IN(6)) { pg8::Gemm g{F.XN, F.WoutT, MX, DM, DM}; pg8::StaticOrder S; S.init(MX, DM, F.G, (int)blockIdx.x);
        if (F.G == 256 && FUSE_LN) { PanelOrder PO{F.vcu}; EpiLnFused E{F.x, F.gate, F.out, F.ln_g, F.ln_b, (unsigned long long*)(args.ws + WS_XB), (unsigned*)(F.ctl + CW_PANEL)};
            pg8::gemm_phase<EpiLnFused, PanelOrder, PG8_ALIGN, PG8_SP2>(F.lds + RING_OFF, g, PO, E); }
        else { EpiResid E{F.x, F.gate, F.out};
            pg8::gemm_phase<EpiResid, pg8::StaticOrder, PG8_ALIGN, PG8_SP2>(F.lds + RING_OFF, g, S, E);
            if (DUP(8)) { __syncthreads(); pg8::gemm_phase<EpiResid, pg8::StaticOrder, PG8_ALIGN, PG8_SP2>(F.lds + RING_OFF, g, S, E); } } }
    if (!(F.G == 256 && FUSE_LN)) { SEAM(6); if (PHON(7) && IN(7)) { p7_ln(F); } }
#undef IN
#undef SEAM
}

extern "C" void kernel_launch(void* const* d_in, const int* in_sizes, int n_in, void* d_out, int out_size, void* d_ws, size_t ws_size, hipStream_t stream) {
    static int grid = 0;
    if (grid == 0) {
        if (n_in != 16 || out_size != MX * DM || ws_size < WS_END) { fprintf(stderr, "kernel_launch: unexpected shapes (n_in %d out %d ws %zu)\n", n_in, out_size, ws_size); grid = -1; return; }
        int dev = 0, cus = 0, per_cu = 0;
        if (hipGetDevice(&dev) != hipSuccess || hipDeviceGetAttribute(&cus, hipDeviceAttributeMultiprocessorCount, dev) != hipSuccess) { grid = -1; return; }
        if (hipFuncSetAttribute((const void*)mk_fwd, hipFuncAttributeMaxDynamicSharedMemorySize, LDS_BYTES) != hipSuccess) { fprintf(stderr, "kernel_launch: hipFuncSetAttribute failed\n"); grid = -1; return; }
        if (hipOccupancyMaxActiveBlocksPerMultiprocessor(&per_cu, (const void*)mk_fwd, NT, LDS_BYTES) != hipSuccess || per_cu < 1) { fprintf(stderr, "kernel_launch: occupancy query says %d\n", per_cu); per_cu = 1; }
        (void)hipGetLastError();
        grid = cus;
    }
    if (grid < 0) return;
    if (hipMemsetAsync((char*)d_ws + WS_CTL, 0, CTL_ZERO_BYTES, stream) != hipSuccess) { fprintf(stderr, "kernel_launch: memset failed\n"); return; }
    Args a{};
    for (int i = 0; i < 16; ++i) a.in[i] = (const float*)d_in[i];
    a.out = (float*)d_out; a.ws = (unsigned char*)d_ws;
    for (int li = 0; li < MK_N_LAUNCHES; ++li) {
        a.ph_lo = (MK_N_LAUNCHES == 1) ? 0 : li; a.ph_hi = (MK_N_LAUNCHES == 1) ? N_PHASES : li + 1; a.li = li;
        hipLaunchKernelGGL(mk_fwd, dim3(grid), dim3(NT), LDS_BYTES, stream, a);
        const hipError_t le = hipPeekAtLastError();
        if (le != hipSuccess) { fprintf(stderr, "kernel_launch: launch %d failed: %s\n", li, hipGetErrorName(le)); break; }
    }
}
```

```cpp
#include <hip/hip_runtime.h>
#include <cstdio>
#include <cstdint>
namespace pg8 {
#define PG8_LAS __attribute__((address_space(3)))
typedef unsigned short bf16_t;
typedef short bf16x8 __attribute__((ext_vector_type(8)));
typedef float f32x4 __attribute__((ext_vector_type(4)));
typedef unsigned u32x4 __attribute__((ext_vector_type(4)));
constexpr int BM = 256, BK = 64, HALF = 128, HTB = HALF * BK * 2  , STAGE_BYTES = 8 * HTB, NXCD = 8, WGM = 4;

__host__ __device__ __forceinline__ int lds_byte(int r, int c) { const int st = (r >> 4) * 2 + (c >> 5), rr = r & 15, cc = c & 31, ob = rr * 64 + cc * 2; return st * 1024 + (ob ^ (((ob >> 9) & 1) << 5)); }
__host__ __device__ __forceinline__ void stage_rc(int b, int& R, int& C) { const int st = b / 1024, sb = b % 1024, swz = sb ^ (((sb >> 9) & 1) << 5); R = (st >> 1) * 16 + swz / 64; C = (st & 1) * 32 + (swz % 64) / 2; }
__host__ __device__ __forceinline__ int perm32(int rho) { const int n = rho >> 4, i = rho & 15; return 8 * (i >> 2) + 4 * n + (i & 3); }

struct Unit { int pm, pn; };
struct Gemm { const bf16_t* A; const bf16_t* Bt; int M, N, K; };

struct StaticOrder {
    int nM, nN, nwg, G, c;
    __host__ __device__ void init(int M, int N, int G_, int c_) { nM = M / BM; nN = N / BM; nwg = nM * nN; G = G_; c = c_; }
    __host__ __device__ bool next(int i, Unit& u) const {
        const long L = (long)i * G + c; if (L >= nwg) return false;
        int wgid = (int)L; { const int q = nwg / NXCD, r = nwg % NXCD, xcd = wgid % NXCD, off = wgid / NXCD; wgid = (xcd < r ? xcd * (q + 1) : r * (q + 1) + (xcd - r) * q) + off; }
        const int nig = WGM * nN, gid = wgid / nig, fm = gid * WGM, gsz = (nM - fm) < WGM ? (nM - fm) : WGM;
        u.pm = fm + ((wgid % nig) % gsz); u.pn = (wgid % nig) / gsz; return true;
    }
    __device__ __forceinline__ void a_ready(const Unit&) const {}
    __device__ __forceinline__ void done(const Unit&) const {}
};

__device__ __forceinline__ unsigned cvt_pk_bf16(float lo, float hi) { unsigned r; asm volatile("v_cvt_pk_bf16_f32 %0, %1, %2" : "=v"(r) : "v"(lo), "v"(hi)); return r; }
typedef float f32x2 __attribute__((ext_vector_type(2)));
__device__ __forceinline__ f32x2 gelu_pk(f32x2 v) {
    const f32x2 av = __builtin_elementwise_abs(v), d = av * 0.2316418882f + 1.0f;
    f32x2 t; t.x = __builtin_amdgcn_rcpf(d.x); t.y = __builtin_amdgcn_rcpf(d.y);
    f32x2 q = t * 0.5307027145f + (-0.7265760135f); q = q * t + 0.7107068705f; q = q * t + (-0.142248368f); q = q * t + 0.127414796f; q = q * t;
    const f32x2 s = (v * v) * (-0.72134752044f);
    f32x2 e; e.x = __builtin_amdgcn_exp2f(s.x); e.y = __builtin_amdgcn_exp2f(s.y);
    const f32x2 m = v * (q * e), r = v - m;
    f32x2 o; o.x = v.x < 0.f ? m.x : r.x; o.y = v.y < 0.f ? m.y : r.y; return o;
}

template <int ACT  > struct EpiBf16 {
    static constexpr bool PERM = true, AFTER_DRAIN = false; static_assert(ACT == 0 || ACT == 1, "EpiBf16: ACT is 0 (none) or 1 (gelu_pk)");
    bf16_t* O; int ldc; const float* bias; int split_cols; size_t split_stride; float scale0;
    __device__ __forceinline__ void operator()(const f32x4 (&acc)[2][2][4][2], const Unit& u, int wr, int wc, int fr, int fq) const {
        const int row0 = u.pm * BM + wr * 64 + fr; int colt = u.pn * BM; bf16_t* base = O;
        float sc = 1.f; if (split_cols) { const int t = colt / split_cols; base += (size_t)t * split_stride; colt -= t * split_cols; if (t == 0) sc = scale0; }
        const int col0 = colt + wc * 32 + 8 * fq, bcol0 = u.pn * BM + wc * 32 + 8 * fq;
        f32x4 bv[2][2];
#pragma unroll
        for (int bj = 0; bj < 2; ++bj)
#pragma unroll
            for (int n = 0; n < 2; ++n) bv[bj][n] = bias ? *(const f32x4*)(bias + bcol0 + bj * HALF + 4 * n) : (f32x4){0.f, 0.f, 0.f, 0.f};
#pragma unroll
        for (int ai = 0; ai < 2; ++ai)
#pragma unroll
            for (int m = 0; m < 4; ++m) { bf16_t* rowp = base + (size_t)(row0 + ai * HALF + m * 16) * ldc + col0;
#pragma unroll
                for (int bj = 0; bj < 2; ++bj) { f32x4 v0 = acc[ai][bj][m][0] + bv[bj][0], v1 = acc[ai][bj][m][1] + bv[bj][1];
                    if (ACT == 1) { f32x2 a = gelu_pk((f32x2){v0[0], v0[1]}), b = gelu_pk((f32x2){v0[2], v0[3]}), c = gelu_pk((f32x2){v1[0], v1[1]}), d = gelu_pk((f32x2){v1[2], v1[3]});
                        v0 = (f32x4){a.x, a.y, b.x, b.y}; v1 = (f32x4){c.x, c.y, d.x, d.y}; }
                    v0 = v0 * sc; v1 = v1 * sc; u32x4 w; w.x = cvt_pk_bf16(v0[0], v0[1]); w.y = cvt_pk_bf16(v0[2], v0[3]); w.z = cvt_pk_bf16(v1[0], v1[1]); w.w = cvt_pk_bf16(v1[2], v1[3]);
                    *(u32x4*)(rowp + bj * HALF) = w; } }
    }
};
template <class Epi, class Sched, bool ALIGN_EPI = false, bool SP2 = false>
__device__ __forceinline__ void gemm_phase(PG8_LAS unsigned char* lds, const Gemm g, const Sched& S, const Epi& E) {
    const int tid = threadIdx.x, wid = __builtin_amdgcn_readfirstlane(tid >> 6), lane = tid & 63, wr = wid >> 2, wc = wid & 3, fr = lane & 15, fq = lane >> 4;
    const int K = g.K, nt = K / BK;
    unsigned voffA[2], voffB[2];
#pragma unroll
    for (int i = 0; i < 2; ++i) { int R, C; stage_rc(tid * 16 + i * 8192, R, C); const int Rb = Epi::PERM ? ((R & ~31) + perm32(R & 31)) : R;
        voffA[i] = (unsigned)(R * K + C) * 2u; voffB[i] = (unsigned)(Rb * K + C) * 2u; }
    const size_t kstep = (size_t)(BK * 2);
    const size_t hstep = (size_t)HALF * K * 2;
    const size_t tstep = 2 * hstep;
    const unsigned ldsw = (unsigned)wid * 1024u;
    const int aoff = lds_byte(wr * 64 + fr, fq * 8), boff = lds_byte(wc * 32 + fr, fq * 8);
#define PG8_SA(b, h) (((b) * 2 + (h)) * HTB)
#define PG8_SB(b, h) ((4 + (b) * 2 + (h)) * HTB)
#define PG8_STAGE(bufoff, gbase, voff) do { _Pragma("unroll") for (int _i = 0; _i < 2; ++_i) \
        __builtin_amdgcn_global_load_lds((const unsigned*)((const char*)(gbase) + (voff)[_i]), (PG8_LAS unsigned*)(lds + (bufoff) + ldsw + _i * 8192), 16, 0, 0); } while (0)
#define PG8_LDA(dst, b, h) do { _Pragma("unroll") for (int m = 0; m < 4; ++m) _Pragma("unroll") for (int k = 0; k < 2; ++k) dst[m][k] = *(const PG8_LAS bf16x8*)(lds + PG8_SA(b, h) + aoff + m * 2048 + k * 1024); } while (0)
#define PG8_LDB(dst, b, h) do { _Pragma("unroll") for (int n = 0; n < 2; ++n) _Pragma("unroll") for (int k = 0; k < 2; ++k) dst[n][k] = *(const PG8_LAS bf16x8*)(lds + PG8_SB(b, h) + boff + n * 2048 + k * 1024); } while (0)
#define PG8_MMA(ai, bj, At, Bt) do { __builtin_amdgcn_s_setprio(1); _Pragma("unroll") for (int m = 0; m < 4; ++m) _Pragma("unroll") for (int n = 0; n < 2; ++n) _Pragma("unroll") for (int k = 0; k < 2; ++k) \
        acc[ai][bj][m][n] = __builtin_amdgcn_mfma_f32_16x16x32_bf16(Bt[n][k], At[m][k], acc[ai][bj][m][n], 0, 0, 0); __builtin_amdgcn_s_setprio(0); } while (0)
#define PG8_WAIT_V(n) asm volatile("s_waitcnt vmcnt(" #n ")" ::: "memory")
#define PG8_WAIT_L(n) asm volatile("s_waitcnt lgkmcnt(" #n ")" ::: "memory")
#define PG8_BAR __builtin_amdgcn_s_barrier()
#define PG8_SCHED __builtin_amdgcn_sched_barrier(0)
    Unit cur, nxt; int ui = 0;
    if (!S.next(0, cur)) return;
    f32x4 acc[2][2][4][2];
#pragma unroll
    for (int a = 0; a < 2; ++a)
#pragma unroll
        for (int b = 0; b < 2; ++b)
#pragma unroll
            for (int m = 0; m < 4; ++m)
#pragma unroll
                for (int n = 0; n < 2; ++n) acc[a][b][m][n] = (f32x4){0.f, 0.f, 0.f, 0.f};
    bf16x8 At[4][2], B0[2][2], B1[2][2];
    const char* cA = (const char*)g.A + (size_t)cur.pm * tstep; const char* cB = (const char*)g.Bt + (size_t)cur.pn * tstep;
    S.a_ready(cur);
    if constexpr (SP2) {
        PG8_STAGE(PG8_SB(0, 0), cB, voffB); PG8_STAGE(PG8_SB(0, 1), cB + hstep, voffB); PG8_STAGE(PG8_SA(0, 0), cA, voffA); PG8_STAGE(PG8_SA(0, 1), cA + hstep, voffA);
        if (wr == 1) PG8_BAR;
        PG8_WAIT_V(2); PG8_BAR;
        PG8_STAGE(PG8_SB(1, 0), cB + kstep, voffB); PG8_STAGE(PG8_SA(1, 0), cA + kstep, voffA); PG8_STAGE(PG8_SB(1, 1), cB + hstep + kstep, voffB);
        PG8_WAIT_V(6); PG8_BAR;
    } else {
        PG8_STAGE(PG8_SB(0, 0), cB, voffB); PG8_STAGE(PG8_SA(0, 0), cA, voffA); PG8_STAGE(PG8_SB(0, 1), cB + hstep, voffB); PG8_STAGE(PG8_SA(0, 1), cA + hstep, voffA);
        if (wr == 1) PG8_BAR;
        PG8_WAIT_V(4); PG8_BAR;
        PG8_STAGE(PG8_SB(1, 0), cB + kstep, voffB); PG8_STAGE(PG8_SA(1, 0), cA + kstep, voffA); PG8_STAGE(PG8_SB(1, 1), cB + hstep + kstep, voffB);
        PG8_WAIT_V(6); PG8_BAR;
    }
    for (;;) {
        const bool has_next = S.next(ui + 1, nxt);
        const char* nA = has_next ? (const char*)g.A + (size_t)nxt.pm * tstep : cA; const char* nB = has_next ? (const char*)g.Bt + (size_t)nxt.pn * tstep : cB;
        for (int t = 0; t < nt; t += 2) {
            const bool last = (t == nt - 2);
            const char* a1 = cA + (size_t)(t + 1) * kstep;
            const char* a2 = last ? nA : cA + (size_t)(t + 2) * kstep; const char* b2 = last ? nB : cB + (size_t)(t + 2) * kstep;
            const char* a3 = a2 + kstep; const char* b3 = b2 + kstep;
            if (last && has_next) S.a_ready(nxt);
            if constexpr (SP2) {
            PG8_LDB(B0, 0, 0); PG8_LDB(B1, 0, 1); PG8_SCHED; PG8_LDA(At, 0, 0); PG8_STAGE(PG8_SA(1, 1), a1 + hstep, voffA);
            PG8_WAIT_V(8); PG8_WAIT_L(0); PG8_BAR; PG8_MMA(0, 0, At, B0); PG8_MMA(0, 1, At, B1); PG8_BAR; PG8_SCHED;
            PG8_LDA(At, 0, 1); PG8_STAGE(PG8_SB(0, 0), b2, voffB); PG8_STAGE(PG8_SB(0, 1), b2 + hstep, voffB); PG8_STAGE(PG8_SA(0, 0), a2, voffA);
            PG8_WAIT_V(8); PG8_WAIT_L(0); PG8_BAR; PG8_MMA(1, 0, At, B0); PG8_MMA(1, 1, At, B1); PG8_BAR; PG8_SCHED;
            PG8_LDB(B0, 1, 0); PG8_LDB(B1, 1, 1); PG8_SCHED; PG8_LDA(At, 1, 0); PG8_STAGE(PG8_SA(0, 1), a2 + hstep, voffA);
            PG8_WAIT_V(8); PG8_WAIT_L(0); PG8_BAR; PG8_MMA(0, 0, At, B0); PG8_MMA(0, 1, At, B1); PG8_BAR; PG8_SCHED;
            PG8_LDA(At, 1, 1); PG8_STAGE(PG8_SB(1, 0), b3, voffB); PG8_STAGE(PG8_SB(1, 1), b3 + hstep, voffB); PG8_STAGE(PG8_SA(1, 0), a3, voffA);
            PG8_WAIT_V(8); PG8_WAIT_L(0); PG8_BAR; PG8_MMA(1, 0, At, B0); PG8_MMA(1, 1, At, B1); PG8_BAR; PG8_SCHED;
            } else {
            PG8_LDB(B0, 0, 0); PG8_SCHED; PG8_LDA(At, 0, 0); PG8_STAGE(PG8_SA(1, 1), a1 + hstep, voffA);
            PG8_WAIT_L(8); PG8_BAR; PG8_WAIT_L(0); PG8_MMA(0, 0, At, B0); PG8_BAR; PG8_SCHED;
            PG8_LDB(B1, 0, 1); PG8_STAGE(PG8_SB(0, 0), b2, voffB);
            PG8_BAR; PG8_WAIT_L(0); PG8_MMA(0, 1, At, B1); PG8_BAR;
            PG8_LDA(At, 0, 1); PG8_STAGE(PG8_SA(0, 0), a2, voffA);
            PG8_BAR; PG8_WAIT_L(0); PG8_MMA(1, 0, At, B0); PG8_BAR; PG8_SCHED;
            PG8_STAGE(PG8_SB(0, 1), b2 + hstep, voffB);
            PG8_WAIT_V(6); PG8_BAR; PG8_MMA(1, 1, At, B1); PG8_BAR;
            PG8_LDB(B0, 1, 0); PG8_SCHED; PG8_LDA(At, 1, 0); PG8_STAGE(PG8_SA(0, 1), a2 + hstep, voffA);
            PG8_WAIT_L(8); PG8_BAR; PG8_WAIT_L(0); PG8_MMA(0, 0, At, B0); PG8_BAR; PG8_SCHED;
            PG8_LDB(B1, 1, 1); PG8_STAGE(PG8_SB(1, 0), b3, voffB);
            PG8_BAR; PG8_WAIT_L(0); PG8_MMA(0, 1, At, B1); PG8_BAR;
            PG8_LDA(At, 1, 1); PG8_STAGE(PG8_SA(1, 0), a3, voffA);
            PG8_BAR; PG8_WAIT_L(0); PG8_MMA(1, 0, At, B0); PG8_BAR; PG8_SCHED;
            PG8_STAGE(PG8_SB(1, 1), b3 + hstep, voffB);
            PG8_WAIT_V(6); PG8_BAR; PG8_MMA(1, 1, At, B1); PG8_BAR;
            }
        }
        if constexpr (ALIGN_EPI) { if (wr == 0) PG8_BAR; }
        if constexpr (!Epi::AFTER_DRAIN) { E(acc, cur, wr, wc, fr, fq); S.done(cur); }
        else { if (has_next) { E(acc, cur, wr, wc, fr, fq); S.done(cur); } }
        if (!has_next) break;
#pragma unroll
        for (int a = 0; a < 2; ++a)
#pragma unroll
            for (int b = 0; b < 2; ++b)
#pragma unroll
                for (int m = 0; m < 4; ++m)
#pragma unroll
                    for (int n = 0; n < 2; ++n) acc[a][b][m][n] = (f32x4){0.f, 0.f, 0.f, 0.f};
        cur = nxt; cA = nA; cB = nB; ++ui;
        if constexpr (ALIGN_EPI) { if (wr == 1) PG8_BAR; }
    }
    PG8_WAIT_V(0);
    if constexpr (!ALIGN_EPI) { if (wr == 0) PG8_BAR; }
    PG8_BAR;
    if constexpr (Epi::AFTER_DRAIN) { E.fused(acc, cur, wr, wc, fr, fq, lds, wid, lane); S.done(cur); }
#undef PG8_SA
#undef PG8_SB
#undef PG8_STAGE
#undef PG8_LDA
#undef PG8_LDB
#undef PG8_MMA
#undef PG8_WAIT_V
#undef PG8_WAIT_L
#undef PG8_BAR
#undef PG8_SCHED
}
}

#ifndef PG8_SP2
#define PG8_SP2 true
#endif
#ifndef PG8_ALIGN
#define PG8_ALIGN true
#endif
#define GAS __attribute__((address_space(1)))
#define LAS __attribute__((address_space(3)))
typedef unsigned short bf16;
typedef unsigned v4u __attribute__((ext_vector_type(4)));
typedef float f32x4 __attribute__((ext_vector_type(4)));
typedef short bf16x8 __attribute__((ext_vector_type(8)));
typedef GAS unsigned gu32;
typedef GAS unsigned long long gu64;
#define RLX_AGENT __ATOMIC_RELAXED, __HIP_MEMORY_SCOPE_AGENT
#define LDS_WAIT() asm volatile("s_waitcnt lgkmcnt(0)" ::: "memory")
#define VM_WAIT() asm volatile("s_waitcnt vmcnt(0)" ::: "memory")
__device__ __forceinline__ unsigned long long rt() { return __builtin_amdgcn_s_memrealtime(); }
__device__ __forceinline__ unsigned f2bf(float f) { unsigned u = __builtin_bit_cast(unsigned, f); return (u + 0x7fffu + ((u >> 16) & 1u)) >> 16; }
__device__ __forceinline__ unsigned pk2(float lo, float hi) { return f2bf(lo) | (f2bf(hi) << 16); }

#define XB_TMO      128
#define XB_XCNT(j)  (256  + 64 * (j))
#define XB_XSUB(j)  (1280 + 64 * (j))
#define XB_XGEN(j)  (2304 + 64 * (j))
#define XB_TOP      3328
#define XB_TOPGEN   3392
#define XCD_BAR_WORDS 3456
#define XB_SPIN_CAP (1u << 18)

__device__ __forceinline__ unsigned xb_ld(unsigned* p)              { return __hip_atomic_load(p, __ATOMIC_RELAXED, __HIP_MEMORY_SCOPE_AGENT); }
__device__ __forceinline__ unsigned xb_add(unsigned* p, unsigned v) { return __hip_atomic_fetch_add(p, v, __ATOMIC_RELAXED, __HIP_MEMORY_SCOPE_AGENT); }
__device__ __forceinline__ unsigned xb_xcc_id() { return (unsigned)__builtin_amdgcn_s_getreg((3 << 11) | 20) & 0xFu; }
#define XB_SPIN(cond, bar) do { unsigned _sp = 0; while (cond) { __builtin_amdgcn_s_sleep(1); \
    if ((++_sp & 255u) == 0u) { if (xb_ld(&(bar)[XB_TMO])) break; if (_sp > XB_SPIN_CAP) { atomicAdd(&(bar)[XB_TMO], 1u); break; } } } } while (0)

struct XcdBarrier {
    unsigned* bar; unsigned x;
    volatile LAS unsigned* st;
};

__device__ __forceinline__ XcdBarrier xcd_barrier_post(unsigned* bar, volatile LAS unsigned* st) {
    XcdBarrier b; b.bar = bar; b.x = xb_xcc_id(); b.st = st;
    if (threadIdx.x == 0) (void)xb_add(&bar[XB_XCNT(b.x)], 1u);
    return b;
}
__device__ __forceinline__ void xcd_barrier_complete(unsigned* bar, unsigned x, unsigned& nloc, unsigned& nx) {
    const unsigned G = gridDim.x * gridDim.y * gridDim.z;
    unsigned sum, cnt, mine, sp = 0u;
    for (;;) {
        sum = 0u; cnt = 0u; mine = 0u;
#pragma unroll
        for (unsigned j = 0; j < 16; ++j) { const unsigned c = xb_ld(&bar[XB_XCNT(j)]); sum += c; cnt += (c > 0u) ? 1u : 0u; mine = (j == x) ? c : mine; }
        if (sum == G) break;
        __builtin_amdgcn_s_sleep(1);
        if ((++sp & 255u) == 0u) { if (xb_ld(&bar[XB_TMO])) break; if (sp > XB_SPIN_CAP) { atomicAdd(&bar[XB_TMO], 1u); break; } }
    }
    nloc = mine > 0u ? mine : 1u; nx = cnt > 0u ? cnt : 1u;
}

__device__ __forceinline__ void xcd_barrier(const XcdBarrier& b) {
    asm volatile("s_waitcnt vmcnt(0)" ::: "memory");
    __syncthreads();
    if (threadIdx.x == 0) {
        unsigned* bar = b.bar;
        __builtin_amdgcn_s_waitcnt(0);
        unsigned nloc = b.st[0], nx = b.st[1];
        if (nloc == 0u) { xcd_barrier_complete(bar, b.x, nloc, nx); b.st[0] = nloc; b.st[1] = nx; }
        const unsigned old = xb_add(&bar[XB_XSUB(b.x)], 1u);
        const unsigned gen = old / nloc;
        if (old + 1u == (gen + 1u) * nloc) {
            __builtin_amdgcn_fence(__ATOMIC_RELEASE, "agent");
            asm volatile("s_waitcnt vmcnt(0)" ::: "memory");
            const unsigned og = xb_add(&bar[XB_TOP], 1u);
            const unsigned tg = og / nx;
            if (og + 1u == (tg + 1u) * nx) xb_add(&bar[XB_TOPGEN], 1u);
            else XB_SPIN(xb_ld(&bar[XB_TOPGEN]) == tg, bar);
            __builtin_amdgcn_fence(__ATOMIC_ACQUIRE, "agent");
            xb_add(&bar[XB_XGEN(b.x)], 1u);
            asm volatile("s_waitcnt vmcnt(0)" ::: "memory");
        } else {
            XB_SPIN(xb_ld(&bar[XB_XGEN(b.x)]) == gen, bar);
            __builtin_amdgcn_fence(__ATOMIC_ACQUIRE, "agent");
            asm volatile("s_waitcnt vmcnt(0)" ::: "memory");
        }
    }
    __syncthreads();
}
constexpr int NWAVES = 8, NT = NWAVES * 64;
constexpr int BATCH = 4, SEQ = 4096, DM = 2048, CTXL = 256;
constexpr int MX = BATCH * SEQ, MC = BATCH * CTXL, MALL = MX + MC;
constexpr int WA = 1024, WB = 1024, NIN = 10256, NU = 10496;
constexpr int C_AQ = 0, C_AFF = 1024, C_AFB = 2048, C_AI = 3072, C_AZ = 4096, C_BQK = 5120, C_BV = 7168, C_BO = 8192, C_BZ = 9216, C_BG = 10240;
constexpr int HGH = 8, HGD = 128, MLH = 4, MLD = 256;
constexpr float ALPHA = 1.189207115002721f;
constexpr float LN_EPS = 1e-5f, NORM_EPS = 1e-6f;
constexpr int NMOD = 3 * DM;

#ifndef MK_N_LAUNCHES
#define MK_N_LAUNCHES 1
#endif
constexpr int N_PHASES = 8;

constexpr size_t MiB = 1u << 20;
constexpr size_t WS_CTL = 0, CTL_ZERO_BYTES = 1 * MiB;
constexpr size_t WS_MODP = 1 * MiB;
constexpr size_t WS_GATE = 3 * MiB;
constexpr size_t WS_WINT = 4 * MiB;
constexpr size_t WS_WOUTT = 45 * MiB;
constexpr size_t WS_XN = 53 * MiB;
constexpr size_t WS_U = 121 * MiB;
constexpr size_t WS_PE = 470 * MiB, WS_MLS = 473 * MiB, WS_DEC = 478 * MiB;
constexpr size_t WS_MLW = 479 * MiB;
constexpr size_t WS_DQP = 496 * MiB;
constexpr size_t WS_XB = 498 * MiB;
constexpr size_t WS_END = 502 * MiB;
static_assert(WS_WINT + (size_t)NU * DM * 2 <= WS_WOUTT && WS_WOUTT + (size_t)DM * DM * 2 <= WS_XN && WS_XN + (size_t)MALL * DM * 2 <= WS_U && WS_U + (size_t)MALL * NU * 2 <= WS_END, "d_ws map");
constexpr int CW_TMO = 0, CW_BAR = 4096, CW_PANEL = 16384;

constexpr int RING_OFF = 0, RING_BYTES = 131072;
constexpr int LDS_BYTES = 163840;
constexpr int LDSCTL_OFF = LDS_BYTES - 1024, MISC_OFF = LDSCTL_OFF + 320;

struct Frame {
    LAS unsigned char* lds;
    volatile LAS unsigned* MISC;
    gu32* ctl;
    int tid, lane, wave, vcu, G;
    const float *x, *c, *ctx, *c_ctx, *w_mod, *b_mod, *w_in, *conv_w, *conv_b, *hg_lb, *ml_gate_b, *hg_norm_w, *ml_norm_w, *w_out, *ln_g, *ln_b;
    float* out;
    float *modp, *gate;
    bf16 *WinT, *WoutT, *XN, *U;
    bf16 *QTF, *MLW; float *PE, *MLS, *DEC, *DQP;
    bf16 *OAF, *OAB, *HBF, *HBB;
};

typedef float f32x2_t __attribute__((ext_vector_type(2)));
#define LDS_BARRIER() do { asm volatile("s_waitcnt lgkmcnt(0)" ::: "memory"); __builtin_amdgcn_s_barrier(); asm volatile("" ::: "memory"); } while (0)
typedef __bf16 bf16x2_t __attribute__((ext_vector_type(2)));
__device__ __forceinline__ unsigned pkbf(float a, float b) { const f32x2_t v = {a, b}; return __builtin_bit_cast(unsigned, __builtin_convertvector(v, bf16x2_t)); }
__device__ __forceinline__ float bf2f(unsigned short u) { return __builtin_bit_cast(float, (unsigned)u << 16); }
__device__ __forceinline__ float lo2f(unsigned u) { return __builtin_bit_cast(float, u << 16); }
__device__ __forceinline__ float hi2f(unsigned u) { return __builtin_bit_cast(float, u & 0xffff0000u); }
__device__ __forceinline__ float siluf(float v) { return v / (1.f + __expf(-v)); }
__device__ __forceinline__ float sigmf(float v) { return 1.f / (1.f + __expf(-v)); }
__device__ __forceinline__ float wave_sum(float v) {
#pragma unroll
    for (int o = 1; o < 64; o <<= 1) v += __shfl_xor(v, o);
    return v;
}

__device__ __forceinline__ void transpose_item(const float* W, int ldw, int nvalid, int K, bf16* WT, LAS float* scr, int kb, int nb, int lane) {
    const int k0 = 64 * kb, n0 = 32 * nb; const int n_l = n0 + (lane & 31);
#pragma unroll 8
    for (int i = 0; i < 32; ++i) { const int kk = 2 * i + (lane >> 5); scr[kk * 33 + (lane & 31)] = n_l < nvalid ? W[(size_t)(k0 + kk) * ldw + n_l] : 0.f; }
    LDS_WAIT(); asm volatile("" ::: "memory");
    const int c = lane & 7;
#pragma unroll
    for (int j = 0; j < 4; ++j) { const int n = (lane >> 3) + 8 * j; const LAS float* s = scr + (8 * c) * 33 + n;
        v4u o; o.x = pk2(s[0 * 33], s[1 * 33]); o.y = pk2(s[2 * 33], s[3 * 33]); o.z = pk2(s[4 * 33], s[5 * 33]); o.w = pk2(s[6 * 33], s[7 * 33]);
        *(GAS v4u*)(WT + (size_t)(n0 + n) * K + k0 + 8 * c) = o; }
    LDS_WAIT(); asm volatile("" ::: "memory");
}
constexpr int KS2 = 2;
__device__ __forceinline__ void p0_prep(Frame& F) {
    LAS float* scr = (LAS float*)(F.lds + RING_OFF + F.wave * 16384);
    LAS float* red = (LAS float*)(F.lds + RING_OFF + 131072);
    for (int it = F.vcu; it < (NMOD / 64) * KS2; it += F.G) {
        const int cg = it >> 1, kh2 = it & 1, n = cg * 64 + F.lane, k0 = kh2 * 1024 + F.wave * 128;
#pragma unroll
        for (int rr = 0; rr < 5; ++rr)
#pragma unroll
            for (int j = 0; j < 2; ++j) { const int k = k0 + F.lane + 64 * j; const float v = rr < 4 ? F.c[rr * DM + k] : F.c_ctx[k]; scr[rr * 128 + F.lane + 64 * j] = siluf(v); }
        LDS_WAIT(); asm volatile("" ::: "memory");
        float a0 = 0.f, a1 = 0.f, a2 = 0.f, a3 = 0.f, a4 = 0.f;
#pragma unroll 16
        for (int k = 0; k < 128; ++k) { const float w = F.w_mod[(size_t)(k0 + k) * NMOD + n];
            a0 += scr[k] * w; a1 += scr[128 + k] * w; a2 += scr[256 + k] * w; a3 += scr[384 + k] * w; a4 += scr[512 + k] * w; }
        LAS float* rp = red + F.wave * 320 + F.lane; rp[0] = a0; rp[64] = a1; rp[128] = a2; rp[192] = a3; rp[256] = a4;
        __syncthreads();
        if (F.tid < 320) { float sacc = 0.f;
#pragma unroll
            for (int ww = 0; ww < 8; ++ww) sacc += red[ww * 320 + F.tid];
            const int rr = F.tid >> 6, nn = cg * 64 + (F.tid & 63);
            F.modp[((size_t)kh2 * 5 + rr) * NMOD + nn] = sacc + (kh2 == 0 ? F.b_mod[nn] : 0.f); }
        __syncthreads();
    }
    const int gw = F.vcu * NWAVES + F.wave, NGW = F.G * NWAVES;
    constexpr int NB_IN = NU / 32, I_IN = (DM / 64) * NB_IN, NB_OUT = DM / 32, I_OUT = (DM / 64) * NB_OUT;
    for (int it = gw; it < I_IN + I_OUT; it += NGW) {
        int r = it;
        if (r < I_IN) { transpose_item(F.w_in, NIN, NIN, DM, F.WinT, scr, r / NB_IN, r % NB_IN, F.lane); continue; } r -= I_IN;
        transpose_item(F.w_out, DM, DM, DM, F.WoutT, scr, r / NB_OUT, r % NB_OUT, F.lane);
    }
}

__device__ __forceinline__ void ln_mod_row2(Frame& F, const float* xa, const float* xb, bf16* oa, bf16* ob, const LAS float* shift, const LAS float* scale) {
    const GAS f32x4* ra = (const GAS f32x4*)xa + F.lane; const GAS f32x4* rb = (const GAS f32x4*)xb + F.lane;
    f32x4 va[8], vb[8]; float sa = 0.f, sb = 0.f;
#pragma unroll
    for (int j = 0; j < 8; ++j) { va[j] = ra[64 * j]; vb[j] = rb[64 * j]; }
#pragma unroll
    for (int j = 0; j < 8; ++j) { sa += (va[j].x + va[j].y) + (va[j].z + va[j].w); sb += (vb[j].x + vb[j].y) + (vb[j].z + vb[j].w); }
    const float ma = wave_sum(sa) * (1.f / DM), mb = wave_sum(sb) * (1.f / DM); float qa = 0.f, qb = 0.f;
#pragma unroll
    for (int j = 0; j < 8; ++j) { va[j] = va[j] - ma; vb[j] = vb[j] - mb; qa += (va[j].x * va[j].x + va[j].y * va[j].y) + (va[j].z * va[j].z + va[j].w * va[j].w); qb += (vb[j].x * vb[j].x + vb[j].y * vb[j].y) + (vb[j].z * vb[j].z + vb[j].w * vb[j].w); }
    const float rsa = 1.f / sqrtf(wave_sum(qa) * (1.f / DM) + LN_EPS), rsb = 1.f / sqrtf(wave_sum(qb) * (1.f / DM) + LN_EPS);
    GAS unsigned long long* o8a = (GAS unsigned long long*)oa + F.lane; GAS unsigned long long* o8b = (GAS unsigned long long*)ob + F.lane;
#pragma unroll
    for (int j = 0; j < 8; ++j) { const int k = 4 * F.lane + 256 * j; const f32x4 sc = *(const LAS f32x4*)(scale + k) + 1.f, sh = *(const LAS f32x4*)(shift + k);
        const f32x4 ha = va[j] * rsa * sc + sh, hb = vb[j] * rsb * sc + sh;
        o8a[64 * j] = (unsigned long long)pk2(ha.x, ha.y) | ((unsigned long long)pk2(ha.z, ha.w) << 32);
        o8b[64 * j] = (unsigned long long)pk2(hb.x, hb.y) | ((unsigned long long)pk2(hb.z, hb.w) << 32); }
}
__device__ __forceinline__ void ln_mod_row(Frame& F, const float* xrow, bf16* orow, const LAS float* shift, const LAS float* scale) {
    const GAS f32x4* xr = (const GAS f32x4*)xrow + F.lane;
    f32x4 v[8]; float s = 0.f;
#pragma unroll
    for (int j = 0; j < 8; ++j) { v[j] = xr[64 * j]; s += (v[j].x + v[j].y) + (v[j].z + v[j].w); }
    const float mean = wave_sum(s) * (1.f / DM); float s2 = 0.f;
#pragma unroll
    for (int j = 0; j < 8; ++j) { v[j] = v[j] - mean; s2 += (v[j].x * v[j].x + v[j].y * v[j].y) + (v[j].z * v[j].z + v[j].w * v[j].w); }
    const float rstd = 1.f / sqrtf(wave_sum(s2) * (1.f / DM) + LN_EPS);
    GAS unsigned long long* o8 = (GAS unsigned long long*)orow + F.lane;
#pragma unroll
    for (int j = 0; j < 8; ++j) { const int k = 4 * F.lane + 256 * j; const f32x4 sc = *(const LAS f32x4*)(scale + k), sh = *(const LAS f32x4*)(shift + k);
        const f32x4 h = v[j] * rstd * (sc + 1.f) + sh;
        o8[64 * j] = (unsigned long long)pk2(h.x, h.y) | ((unsigned long long)pk2(h.z, h.w) << 32); }
}
__device__ __forceinline__ void p1_lnmod(Frame& F) {
    LAS float* md = (LAS float*)(F.lds + RING_OFF);
    for (int e = F.vcu * NT + F.tid; e < BATCH * DM; e += F.G * NT) { const int b = e / DM, n = e % DM;
        F.gate[e] = F.modp[(size_t)b * NMOD + 2 * DM + n] + F.modp[((size_t)5 + b) * NMOD + 2 * DM + n]; }
    for (int blk = F.vcu; blk < 256; blk += F.G) {
        const int b = blk >> 6;
        __syncthreads();
        { float m0v[16], m1v[16];
#pragma unroll
          for (int i = 0; i < 16; ++i) { const int e = F.tid + NT * i; const int row = e < 2 * DM ? b : 4, col = e & (2 * DM - 1); m0v[i] = F.modp[(size_t)row * NMOD + col]; m1v[i] = F.modp[((size_t)5 + row) * NMOD + col]; }
#pragma unroll
          for (int i = 0; i < 16; ++i) md[F.tid + NT * i] = m0v[i] + m1v[i]; }
        __syncthreads();
#pragma unroll 1
        for (int r = 0; r < 8; r += 2) { const int m = blk * 64 + F.wave * 8 + r;
            ln_mod_row2(F, F.x + (size_t)m * DM, F.x + (size_t)(m + 1) * DM, F.XN + (size_t)m * DM, F.XN + (size_t)(m + 1) * DM, md, md + DM); }
        if (F.wave < 4) { const int m = blk * 4 + F.wave; ln_mod_row(F, F.ctx + (size_t)m * DM, F.XN + (size_t)(MX + m) * DM, md + 2 * DM, md + 3 * DM); }
    }
}

__device__ __forceinline__ float rcpf_(float v) { return __builtin_amdgcn_rcpf(v); }
__device__ __forceinline__ float silu_fast(float v) { return v * rcpf_(1.f + __expf(-v)); }
__device__ __forceinline__ void conv_acc8(float (&acc)[8], const v4u u, const f32x4 wa, const f32x4 wb) {
    acc[0] += lo2f(u.x) * wa.x; acc[1] += hi2f(u.x) * wa.y; acc[2] += lo2f(u.y) * wa.z; acc[3] += hi2f(u.y) * wa.w;
    acc[4] += lo2f(u.z) * wb.x; acc[5] += hi2f(u.z) * wb.y; acc[6] += lo2f(u.w) * wb.z; acc[7] += hi2f(u.w) * wb.w;
}
constexpr int NSC = 4;
__device__ __forceinline__ void p3_conv(Frame& F) {
    bf16* QKM = F.XN;
    if (F.G > 2 * NSC && F.vcu < NSC) return;
    const int wk = F.G > 2 * NSC ? F.vcu - NSC : F.vcu, NW = F.G > 2 * NSC ? F.G - NSC : F.G;
    const int gw = wk * NWAVES + F.wave, NGW = NW * NWAVES;
    const int cq = gw & 3, ch = cq * 512 + F.lane * 8;
    f32x4 wa[9], wb[9];
#pragma unroll
    for (int t = 0; t < 9; ++t) { wa[t] = *(const GAS f32x4*)(F.conv_w + t * 2048 + ch); wb[t] = *(const GAS f32x4*)(F.conv_w + t * 2048 + ch + 4); }
    const f32x4 ba = *(const GAS f32x4*)(F.conv_b + ch), bb = *(const GAS f32x4*)(F.conv_b + ch + 4);
    const float sc = ch >= 1024 ? 0.0625f : 1.f;
    constexpr int NLAT = BATCH * 64 * 16, NCTX = BATCH * (CTXL / 4);
    int it0 = gw >> 2, it1 = NLAT + NCTX, its = NGW >> 2;
    if (NW == 252) { const int j = wk - 80; const int lo = wk < 80 ? 8 * wk : 640 + (j < 100 ? 22 * j : 2200 + 21 * (j - 100)); const int len = wk < 80 ? 8 : (j < 100 ? 22 : 21);
        it0 = lo + (F.wave >> 2); it1 = lo + len; its = 2; }
    for (int it = it0; it < it1; it += its) {
        const v4u zero4 = {0u, 0u, 0u, 0u};
        if (it < NLAT) {
            const int b = it >> 10, r = (it >> 4) & 63, c0 = (it & 15) * 4;
            v4u in[3][6];
#pragma unroll
            for (int dr = 0; dr < 3; ++dr)
#pragma unroll
                for (int j = 0; j < 6; ++j) { const int rr = r + dr - 1, cc = c0 + j - 1; const bool ok = rr >= 0 && rr < 64 && cc >= 0 && cc < 64;
                    in[dr][j] = ok ? *(const GAS v4u*)(F.U + (size_t)(b * SEQ + rr * 64 + cc) * NU + C_BQK + ch) : zero4; }
#pragma unroll
            for (int o = 0; o < 4; ++o) {
                float acc[8] = {ba.x, ba.y, ba.z, ba.w, bb.x, bb.y, bb.z, bb.w};
#pragma unroll
                for (int dr = 0; dr < 3; ++dr)
#pragma unroll
                    for (int dc = 0; dc < 3; ++dc) conv_acc8(acc, in[dr][o + dc], wa[dr * 3 + dc], wb[dr * 3 + dc]);
#pragma unroll
                for (int j = 0; j < 8; ++j) acc[j] = silu_fast(acc[j]) * sc;
                v4u ov; ov.x = pk2(acc[0], acc[1]); ov.y = pk2(acc[2], acc[3]); ov.z = pk2(acc[4], acc[5]); ov.w = pk2(acc[6], acc[7]);
                *(GAS v4u*)(QKM + (size_t)(b * SEQ + r * 64 + c0 + o) * DM + ch) = ov;
            }
        } else {
            const int ic = it - NLAT, b = ic >> 6, t0 = (ic & 63) * 4;
            v4u in[6];
#pragma unroll
            for (int j = 0; j < 6; ++j) { const int tt = t0 + j - 1; in[j] = (tt >= 0 && tt < CTXL) ? *(const GAS v4u*)(F.U + (size_t)(MX + b * CTXL + tt) * NU + C_BQK + ch) : zero4; }
#pragma unroll
            for (int o = 0; o < 4; ++o) {
                float acc[8] = {ba.x, ba.y, ba.z, ba.w, bb.x, bb.y, bb.z, bb.w};
#pragma unroll
                for (int dc = 0; dc < 3; ++dc) conv_acc8(acc, in[o + dc], wa[3 + dc], wb[3 + dc]);
#pragma unroll
                for (int j = 0; j < 8; ++j) acc[j] = silu_fast(acc[j]) * sc;
                v4u ov; ov.x = pk2(acc[0], acc[1]); ov.y = pk2(acc[2], acc[3]); ov.z = pk2(acc[4], acc[5]); ov.w = pk2(acc[6], acc[7]);
                *(GAS v4u*)(QKM + (size_t)(MX + b * CTXL + t0 + o) * DM + ch) = ov;
            }
        }
    }
}

__device__ __forceinline__ int scan_row(int b, int dirn, int nb, int i) {
    if (nb < 16) { const int p = nb * 16 + i; const int t = dirn ? (CTXL - 1 - p) : p; return MX + b * CTXL + t; }
    const int p = (nb - 16) * 16 + i; const int t = dirn ? (SEQ - 1 - p) : p; return b * SEQ + t;
}
__device__ __forceinline__ void p4_hgrn2_task(Frame& F, int task) {
    const int vs = task & 3, dirn = (task >> 2) & 1, h = (task >> 3) & 7, b = task >> 6;
    LAS float* Fg = (LAS float*)(F.lds);
    LAS float* Kg = Fg + 2048, *Qg = Kg + 2048;
    LAS float* Vg = Qg + 2048;
    LAS float* LB = Vg + 512;
    LAS float* P = LB + 128;
    const int v = F.tid & 31, kg = F.tid >> 5, k0 = kg * 8;
    const int zcol = (dirn ? C_AFB : C_AFF) + h * HGD;
    __syncthreads();
    if (F.tid < 128) { const int col = h * HGD + F.tid; LB[F.tid] = sigmf(F.hg_lb[(dirn * 2 + 0) * WA + col] - F.hg_lb[(dirn * 2 + 1) * WA + col]); }
    __syncthreads();
    float S[8];
#pragma unroll
    for (int j = 0; j < 8; ++j) S[j] = 0.f;
    bf16* O = dirn ? F.OAB : F.OAF;
#pragma unroll 1
    for (int nb = 0; nb < 16 + 256; ++nb) {
        const bool lat = nb >= 16;
#pragma unroll
        for (int j = 0; j < 4; ++j) { const int e = F.tid + NT * j, i = e >> 7, k = e & 127; const int row = scan_row(b, dirn, nb, i);
            const float z = bf2f(F.U[(size_t)row * NU + zcol + k]); const float lb = LB[k]; const float f = lb + (1.f - lb) * sigmf(z);
            Fg[e] = f; Kg[e] = 1.f - f; Qg[e] = lat ? siluf(bf2f(F.U[(size_t)row * NU + C_AQ + h * HGD + k])) : 0.f; }
        { const int i = F.tid >> 5; const int row = scan_row(b, dirn, nb, i); Vg[F.tid] = bf2f(F.U[(size_t)row * NU + C_AI + h * HGD + vs * 32 + v]); }
        __syncthreads();
#pragma unroll 2
        for (int i = 0; i < 16; ++i) { const float vv = Vg[i * 32 + v]; float a = 0.f;
#pragma unroll
            for (int j = 0; j < 8; ++j) { S[j] = Fg[i * 128 + k0 + j] * S[j] + Kg[i * 128 + k0 + j] * vv; a += S[j] * Qg[i * 128 + k0 + j]; }
            P[(kg * 16 + i) * 32 + v] = a; }
        __syncthreads();
        if (lat) { const int i = F.tid >> 5; float o = 0.f;
#pragma unroll
            for (int g = 0; g < 16; ++g) o += P[(g * 16 + i) * 32 + v];
            const int row = scan_row(b, dirn, nb, i);
            O[(size_t)row * WA + h * HGD + vs * 32 + v] = (bf16)f2bf(o); }
    }
}
__device__ __forceinline__ void p4_mlstm_task(Frame& F, int task) {
    const int vs = task & 7, dirn = (task >> 3) & 1, h = (task >> 4) & 3, b = task >> 6;
    const bf16* QKM = F.XN;
    LAS float* Kb = (LAS float*)(F.lds);
    LAS float* Qb = Kb + 4096;
    LAS float* Vb = Qb + 4096;
    LAS float* LI = Vb + 512, *LF = LI + 16, *EM = LF + 16;
    LAS float* PD = EM + 16;
    LAS float* P = PD + 256;
    const int v = F.tid & 31, kg = F.tid >> 5, k0 = kg * 16;
    float C[16], nn[16]; float m = 0.f;
#pragma unroll
    for (int j = 0; j < 16; ++j) { C[j] = 0.f; nn[j] = 0.f; }
    bf16* O = dirn ? F.HBB : F.HBF;
    const float gbi = F.ml_gate_b[dirn * 4 + h], gbf = F.ml_gate_b[(2 + dirn) * 4 + h];
#pragma unroll 1
    for (int nb = 0; nb < 16 + 256; ++nb) {
        const bool lat = nb >= 16;
        __syncthreads();
#pragma unroll
        for (int j = 0; j < 8; ++j) { const int e = F.tid + NT * j, i = e >> 8, k = e & 255; const int row = scan_row(b, dirn, nb, i);
            Kb[e] = bf2f(QKM[(size_t)row * DM + 1024 + h * MLD + k]); Qb[e] = lat ? bf2f(QKM[(size_t)row * DM + h * MLD + k]) : 0.f; }
        { const int i = F.tid >> 5; const int row = scan_row(b, dirn, nb, i); Vb[F.tid] = bf2f(F.U[(size_t)row * NU + C_BV + h * MLD + vs * 32 + v]); }
        if (F.tid < 16) { const int row = scan_row(b, dirn, nb, F.tid);
            const float gi = bf2f(F.U[(size_t)row * NU + C_BG + dirn * 4 + h]) + gbi, gf = bf2f(F.U[(size_t)row * NU + C_BG + (2 + dirn) * 4 + h]) + gbf;
            LI[F.tid] = gi; LF[F.tid] = gf > 0.f ? -log1pf(__expf(-gf)) : gf - log1pf(__expf(gf)); }
        __syncthreads();
#pragma unroll 2
        for (int i = 0; i < 16; ++i) {
            const float lf = LF[i], li = LI[i]; const float mn = fmaxf(lf + m, li); const float fd = __expf(lf + m - mn), iw = __expf(li - mn); m = mn;
            if (F.tid == 0) EM[i] = __expf(-m);
            const float vv = iw * Vb[i * 32 + v]; float a = 0.f, d = 0.f;
#pragma unroll
            for (int j = 0; j < 16; ++j) { const float kk = Kb[i * 256 + k0 + j], qq = Qb[i * 256 + k0 + j];
                C[j] = fd * C[j] + vv * kk; nn[j] = fd * nn[j] + iw * kk; a += C[j] * qq; d += nn[j] * qq; }
            P[(kg * 16 + i) * 32 + v] = a; if (v == 0) PD[kg * 16 + i] = d; }
        __syncthreads();
        if (lat) { const int i = F.tid >> 5; float num = 0.f, den = 0.f;
#pragma unroll
            for (int g = 0; g < 16; ++g) { num += P[(g * 16 + i) * 32 + v]; den += PD[g * 16 + i]; }
            const int row = scan_row(b, dirn, nb, i);
            O[(size_t)row * WB + h * MLD + vs * 32 + v] = (bf16)f2bf(num / fmaxf(fabsf(den), EM[i])); }
    }
}
__device__ __forceinline__ void p4_scan_naive(Frame& F) {
    for (int task = F.vcu; task < 512; task += F.G) { if (task < 256) p4_hgrn2_task(F, task); else p4_mlstm_task(F, task - 256); }
}

constexpr int NCHUNK = MALL / 64;
__device__ __forceinline__ void gate_fk(float z, float lb, float& f, float& kk) {
    const float e = __expf(-fabsf(z)); const float rb = 1.f / (1.f + e), rs = e * rb;
    const float sg = z >= 0.f ? rb : rs, sn = z >= 0.f ? rs : rb;
    f = lb + (1.f - lb) * sg; kk = (1.f - lb) * sn;
}
template <int DIR>
__device__ __forceinline__ float hg_walk(LAS unsigned char* L, int cl, float lb, float olb, unsigned (&qb)[32]) {
    constexpr int TQ = 0, TZF = 32768, TZB = 65536, TQF = 98304;
    LAS unsigned short* zt = (LAS unsigned short*)(L + (DIR ? TZB : TZF)) + cl;
    const LAS unsigned short* qtile = (const LAS unsigned short*)(L + TQ) + cl;
    LAS unsigned short* qf = (LAS unsigned short*)(L + TQF) + cl;
    float P = 1.f;
#pragma unroll
    for (int blk = 0; blk < 4; ++blk) {
        unsigned short zr[16], qr[16];
#pragma unroll
        for (int j = 0; j < 16; ++j) { const int pp = blk * 16 + j, p = DIR ? 63 - pp : pp; zr[j] = zt[p * 256]; qr[j] = qtile[p * 256]; }
#pragma unroll
        for (int j = 0; j < 16; ++j) { const int pp = blk * 16 + j, p = DIR ? 63 - pp : pp;
            const float z = bf2f(zr[j]), q = bf2f(qr[j]);
            const float e = __expf(-fabsf(z)); const float rbig = rcpf_(1.f + e), rsm = e * rbig;
            const float sg = z >= 0.f ? rbig : rsm, sn = z >= 0.f ? rsm : rbig;
            const float f = lb + olb * sg, kk = olb * sn; P *= f;
            const float qt = silu_fast(q) * P, kt = kk * rcpf_(P);
            zt[p * 256] = (unsigned short)(pkbf(kt, 0.f) & 0xffffu);
            const unsigned qh = pkbf(qt, 0.f) & 0xffffu;
            if (DIR) { if (pp & 1) qb[pp >> 1] |= qh << 16; else qb[pp >> 1] = qh; } else qf[p * 256] = (unsigned short)qh; }
    }
    return P;
}
template <bool DUMMY>
__device__ __forceinline__ void p3_hg_prep(Frame& F) {
    bf16* dq = F.OAF; bf16* dkf = F.OAB; bf16* dkb = F.HBF;
    LAS unsigned char* L = F.lds;
    constexpr int TQ = 0, TZF = 32768, TZB = 65536, TQF = 98304;
    const int tid = F.tid, dirn = F.wave >> 2, cl = tid & 255;
    if (F.G > 2 * NSC && F.vcu < NSC) return;
    const int wk = F.G > 2 * NSC ? F.vcu - NSC : F.vcu, NW = F.G > 2 * NSC ? F.G - NSC : F.G;
    v4u pre[3][4];
    auto issue = [&](int it) { const int cid = it >> 2, cb = (it & 3) * 256; const size_t row0 = (size_t)cid * 64;
#pragma unroll
        for (int i = 0; i < 4; ++i) { const int piece = tid + NT * i, row = piece >> 5, c16 = piece & 31; const bf16* ur = F.U + (row0 + row) * NU + cb + c16 * 8;
            pre[0][i] = *(const GAS v4u*)(ur + C_AQ); pre[1][i] = *(const GAS v4u*)(ur + C_AFF); pre[2][i] = *(const GAS v4u*)(ur + C_AFB); } };
    int it = wk;
    if (it < NCHUNK * 4) issue(it);
    for (; it < NCHUNK * 4; it += NW) {
        const int cid = it >> 2, cb = (it & 3) * 256; const size_t row0 = (size_t)cid * 64;
        __syncthreads();
#pragma unroll
        for (int i = 0; i < 4; ++i) { const int piece = tid + NT * i; *(LAS v4u*)(L + TQ + piece * 16) = pre[0][i]; *(LAS v4u*)(L + TZF + piece * 16) = pre[1][i]; *(LAS v4u*)(L + TZB + piece * 16) = pre[2][i]; }
        __syncthreads();
        if (it + NW < NCHUNK * 4) issue(it + NW);
        const int c = cb + cl;
        const float lb = sigmf(F.hg_lb[(dirn * 2) * WA + c] - F.hg_lb[(dirn * 2 + 1) * WA + c]), olb = 1.f - lb;
        unsigned qb[32]; float P;
        if (dirn) P = hg_walk<1>(L, cl, lb, olb, qb); else P = hg_walk<0>(L, cl, lb, olb, qb);
        F.PE[(size_t)(dirn * NCHUNK + cid) * WA + c] = P;
        __syncthreads();
        if (dirn) {
            LAS unsigned short* qw = (LAS unsigned short*)(L + TQ) + cl;
#pragma unroll
            for (int pp = 0; pp < 64; ++pp) qw[(63 - pp) * 256] = (unsigned short)((pp & 1) ? (qb[pp >> 1] >> 16) : (qb[pp >> 1] & 0xffffu));
        }
        __syncthreads();
#pragma unroll
        for (int i = 0; i < 4; ++i) { const int piece = tid + NT * i, row = piece >> 5, c16 = piece & 31; const size_t r = row0 + row; bf16* ur = F.U + r * NU + cb + c16 * 8;
            const v4u vq = *(const LAS v4u*)(L + TQ + piece * 16), vf = *(const LAS v4u*)(L + TZF + piece * 16), vb = *(const LAS v4u*)(L + TZB + piece * 16), vqf = *(const LAS v4u*)(L + TQF + piece * 16);
            *(GAS v4u*)(F.QTF + r * WA + cb + c16 * 8) = vqf;
            if (DUMMY) { if (r < MX) { *(GAS v4u*)(dq + r * WA + cb + c16 * 8) = vq; *(GAS v4u*)(dkf + r * WA + cb + c16 * 8) = vf; *(GAS v4u*)(dkb + r * WA + cb + c16 * 8) = vb; } }
            else { *(GAS v4u*)(ur + C_AQ) = vq; *(GAS v4u*)(ur + C_AFF) = vf; *(GAS v4u*)(ur + C_AFB) = vb; } }
    }
    __syncthreads();
}
template <int CTRL, int RM> __device__ __forceinline__ float dpp_f(float idv, float x) { return __builtin_bit_cast(float, __builtin_amdgcn_update_dpp(__builtin_bit_cast(int, idv), __builtin_bit_cast(int, x), CTRL, RM, 0xf, false)); }
__device__ __forceinline__ float wave_scan_add(float x) {
    x += dpp_f<0x111, 0xf>(0.f, x); x += dpp_f<0x112, 0xf>(0.f, x); x += dpp_f<0x114, 0xf>(0.f, x); x += dpp_f<0x118, 0xf>(0.f, x);
    x += dpp_f<0x142, 0xa>(0.f, x); x += dpp_f<0x143, 0xc>(0.f, x); return x; }
__device__ __forceinline__ float wave_scan_max(float x) { const float ni = -__builtin_inff();
    x = fmaxf(x, dpp_f<0x111, 0xf>(ni, x)); x = fmaxf(x, dpp_f<0x112, 0xf>(ni, x)); x = fmaxf(x, dpp_f<0x114, 0xf>(ni, x)); x = fmaxf(x, dpp_f<0x118, 0xf>(ni, x));
    x = fmaxf(x, dpp_f<0x142, 0xa>(ni, x)); x = fmaxf(x, dpp_f<0x143, 0xc>(ni, x)); return x; }
__device__ __forceinline__ void p3_ml_scalars(Frame& F) {
    const int gw = F.vcu * NWAVES + F.wave;
    if (gw >= 32) return;
    const int dirn = gw & 1, h = (gw >> 1) & 3, b = gw >> 3;
    const float gbi = F.ml_gate_b[dirn * 4 + h], gbf = F.ml_gate_b[(2 + dirn) * 4 + h];
    float m0 = 0.f;
    float* mls = F.MLS + (size_t)(dirn * 4 + h) * MALL * 8;
    auto row_of = [&](int n) -> int { int row0; if (n < 4) { const int cc = dirn ? 3 - n : n; row0 = MX + b * CTXL + cc * 64; } else { const int lc = dirn ? 67 - n : n - 4; row0 = b * SEQ + lc * 64; }
        return row0 + (dirn ? 63 - F.lane : F.lane); };
    unsigned short gi_r[8], gf_r[8];
#pragma unroll
    for (int j = 0; j < 8; ++j) { const int row = row_of(j); gi_r[j] = F.U[(size_t)row * NU + C_BG + dirn * 4 + h]; gf_r[j] = F.U[(size_t)row * NU + C_BG + (2 + dirn) * 4 + h]; }
#pragma unroll 1
    for (int nb = 0; nb < 72; nb += 8) {
#pragma unroll
        for (int j = 0; j < 8; ++j) {
            const int n = nb + j;
            if (n < 68) {
                const int row = row_of(n);
                const float gi = bf2f(gi_r[j]) + gbi, gf = bf2f(gf_r[j]) + gbf;
                if (n + 8 < 68) { const int r2 = row_of(n + 8); gi_r[j] = F.U[(size_t)r2 * NU + C_BG + dirn * 4 + h]; gf_r[j] = F.U[(size_t)r2 * NU + C_BG + (2 + dirn) * 4 + h]; }
                const float lf = fminf(gf, 0.f) - __logf(1.f + __expf(-fabsf(gf)));
                const float cs = wave_scan_add(lf);
                const float a = gi - cs; const float cm = wave_scan_max(a);
                const float mx = fmaxf(m0, cm), m63 = __shfl(mx, 63), cs63 = __shfl(cs, 63);
                f32x4 o0; o0.x = a; o0.y = mx; o0.z = __expf(m0 - mx); o0.w = __expf(a - m63);
                f32x4 o1; o1.x = __expf(-(cs + mx)); o1.y = 0.f; o1.z = __expf(m0 - m63); o1.w = 0.f;
                *(f32x4*)(mls + (size_t)row * 8) = o0; *(f32x4*)(mls + (size_t)row * 8 + 4) = o1;
                const int row0 = row - (dirn ? 63 - F.lane : F.lane);
                if (F.lane == 0) F.DEC[(dirn * 4 + h) * NCHUNK + (row0 >> 6)] = __expf(m0 - m63);
                m0 = cs63 + m63;
            }
        }
    }
}

typedef short s16x4 __attribute__((ext_vector_type(4)));
typedef float f32x16 __attribute__((ext_vector_type(16)));
#define MFMA32(a, b, c) __builtin_amdgcn_mfma_f32_32x32x16_bf16((a), (b), (c), 0, 0, 0)
__device__ __forceinline__ bf16x8 pk8(float a0, float a1, float a2, float a3, float a4, float a5, float a6, float a7) {
    const v4u u = {pkbf(a0, a1), pkbf(a2, a3), pkbf(a4, a5), pkbf(a6, a7)}; return __builtin_bit_cast(bf16x8, u); }
__device__ __forceinline__ bf16x8 cat4(s16x4 lo, s16x4 hi) { return __builtin_shufflevector(lo, hi, 0, 1, 2, 3, 4, 5, 6, 7); }
__device__ __forceinline__ s16x4 lds_tr(LAS unsigned char* p) { return __builtin_amdgcn_ds_read_tr16_b64_v4i16((LAS s16x4*)p); }
__device__ __forceinline__ unsigned img_off_a(unsigned row, unsigned ch) { return 2048u * (row >> 3) + 512u * (ch >> 2) + 64u * (row & 7) + 16u * ((ch & 3) ^ ((row >> 2) & 3)); }
__device__ __forceinline__ unsigned img_addr(unsigned row, unsigned ch, unsigned ncb) { return ((row >> 5) * ncb + (ch >> 4)) * 8192u + img_off_a(row & 31, ch & 15); }
__device__ __forceinline__ unsigned v_addr(unsigned row, unsigned ch) { const unsigned r = row & 31; return (row >> 5) * 4096u + 1024u * (r >> 3) + 512u * (ch >> 2) + 64u * (r & 7) + 16u * ((ch & 3) ^ ((r >> 2) & 3)); }

constexpr int SL_QT = 0, SL_KT = 32768, SL_V = 65536, SL_VW = 73728, SL_SF = 81920, SL_XCH = 114688, SL_SC = 131072, SL_W = 144384;
constexpr int SC_PAR = 448, SC_DQW = 896, SC_N0 = 1024, SC_NP = 1280;


__device__ __forceinline__ void p3b_ml_scores(Frame& F) {
    LAS unsigned char* L = F.lds;
    constexpr int BQ = 0, BK = 32768, BX = 65536, BS = 98304;
    LAS float* SCA = (LAS float*)(L + BS);
    const int tid = F.tid, lane = F.lane, w = F.wave, ts = w & 1, tp = (w >> 1) & 1, kh = w >> 2;
    const unsigned hh = lane >> 5, x4 = (lane >> 2) & 3;
    const unsigned LB0 = 2048u * ((lane >> 3) & 3) + 64u * (lane & 7);
    unsigned LBx[2];
#pragma unroll
    for (int e = 0; e < 2; ++e) LBx[e] = LB0 + 16u * ((2u * e + hh) ^ x4) + kh * 8192u;
    v4u pq[4], pk[4]; f32x2_t psc;
    auto issue = [&](int it) { const int lc = it & 63, h = (it >> 6) & 3, b = it >> 8; const size_t row0 = (size_t)b * SEQ + lc * 64;
        int tv = F.tid; asm volatile("" : "+v"(tv));
#pragma unroll
        for (int i = 0; i < 4; ++i) { const int u = ((tv >> 6) + 8 * i) * 8 + ((tv & 63) >> 3), row = 2 * (u >> 3) + ((tv >> 2) & 1), ch = 4 * (u & 7) + (tv & 3);
            pq[i] = *(const GAS v4u*)(F.XN + (row0 + row) * DM + h * MLD + ch * 8); pk[i] = *(const GAS v4u*)(F.XN + (row0 + row) * DM + WB + h * MLD + ch * 8); }
        if (tv < 128) psc = *(const GAS f32x2_t*)(F.MLS + ((size_t)((tv >> 6) * 4 + h) * MALL + row0 + (tv & 63)) * 8); };
    int it = F.vcu;
    if (it < 1024) issue(it);
    for (; it < 1024; it += F.G) {
        const int lc = it & 63, h = (it >> 6) & 3, b = it >> 8; const size_t row0 = (size_t)b * SEQ + lc * 64;
        __syncthreads();
        { int tv = F.tid; asm volatile("" : "+v"(tv));
#pragma unroll
          for (int i = 0; i < 4; ++i) { const int u = ((tv >> 6) + 8 * i) * 8 + ((tv & 63) >> 3), row = 2 * (u >> 3) + ((tv >> 2) & 1), ch = 4 * (u & 7) + (tv & 3); const unsigned a = img_addr(row, ch, 2); *(LAS v4u*)(L + BQ + a) = pq[i]; *(LAS v4u*)(L + BK + a) = pk[i]; }
          if (tv < 128) { SCA[(tv >> 6) * 128 + (tv & 63)] = psc.x; SCA[(tv >> 6) * 128 + 64 + (tv & 63)] = psc.y; } }
        __syncthreads();
        if (it + F.G < 1024) issue(it + F.G);
        f32x16 c;
#pragma unroll
        for (int r = 0; r < 16; ++r) c[r] = 0.f;
#pragma unroll
        for (int s = 0; s < 8; ++s) {
            const bf16x8 a = *(const LAS bf16x8*)(L + BK + ts * 16384 + 512 * (s >> 1) + LBx[s & 1]);
            const bf16x8 bq = *(const LAS bf16x8*)(L + BQ + tp * 16384 + 512 * (s >> 1) + LBx[s & 1]);
            c = MFMA32(a, bq, c);
        }
#pragma unroll
        for (int r = 0; r < 16; ++r) *(LAS float*)(L + BX + (((kh * 4 + ts * 2 + tp) * 16 + r) * 64 + lane) * 4) = c[r];
        __syncthreads();
#pragma unroll
        for (int r = 0; r < 16; ++r) c[r] += *(const LAS float*)(L + BX + ((((1 - kh) * 4 + ts * 2 + tp) * 16 + r) * 64 + lane) * 4);
        const int dirn = kh;
        const bool need = dirn ? (ts >= tp) : (ts <= tp);
        const float mxp = SCA[dirn * 128 + 64 + 32 * tp + (lane & 31)];
        int dl = (lane & 31) - 4 * (int)hh; if (dirn) dl = -dl; asm volatile("" : "+v"(dl));
        const int sg1 = dirn ? -1 : 1; const bool diag = ts == tp;
        float rs = 0.f;
        bf16* wout = F.MLW + ((size_t)((dirn * 4 + h) * 256 + (int)(row0 >> 6)) * 4096) + (32 * tp + (lane & 31)) * 64 + 32 * ts + 4 * hh;
#pragma unroll
        for (int g = 0; g < 4; ++g) {
            const f32x4 av = *(const LAS f32x4*)(SCA + dirn * 128 + 32 * ts + 8 * g + 4 * hh);
            float wv[4];
#pragma unroll
            for (int j = 0; j < 4; ++j) { float v = need ? c[4 * g + j] * __expf(av[j] - mxp) : 0.f;
                if (diag) v = (dl - sg1 * (j + 8 * g) >= 0) ? v : 0.f;
                wv[j] = v; rs += v; }
            *(GAS unsigned long long*)(wout + 8 * g) = (unsigned long long)pkbf(wv[0], wv[1]) | ((unsigned long long)pkbf(wv[2], wv[3]) << 32);
        }
        rs += __shfl_xor(rs, 32);
        if (lane < 32) SCA[256 + (dirn * 2 + ts) * 64 + 32 * tp + lane] = rs;
        __syncthreads();
        if (tid < 128) { const int d = tid >> 6, p = tid & 63; F.MLS[((size_t)(d * 4 + h) * MALL + row0 + p) * 8 + 5] = SCA[256 + (d * 2) * 64 + p] + SCA[256 + (d * 2 + 1) * 64 + p]; }
    }
    __syncthreads();
}

template <bool ML, int SKIP = 0>
__device__ __forceinline__ void scan_task(Frame& F, int task) {
    constexpr int NKT = ML ? 8 : 4, NCB = NKT / 4, NKH = NKT / 2, NOWN = NKT / 4, NPQ = ML ? 4 : 2, DKK = 32 * NKT;
    int vs, dirn, h, b;
    if (ML) { vs = task & 3; dirn = (task >> 2) & 1; h = (task >> 3) & 3; b = task >> 5; } else { vs = task & 1; dirn = (task >> 1) & 1; h = (task >> 2) & 7; b = task >> 5; }
    const int lane = F.lane, w = F.wave, tid = F.tid; const int tp = (w >> 2) & 1, tj = (w >> 1) & 1, kh = w & 1;
    const unsigned hh = lane >> 5, q4 = (lane & 15) >> 2, p4 = lane & 3, blk = (lane >> 4) & 1, x4 = (lane >> 2) & 3;
    LAS unsigned char* L = F.lds;
    LAS float* SC = (LAS float*)(L + SL_SC);
    const unsigned LB0 = 2048u * ((lane >> 3) & 3) + 64u * (lane & 7);
    const unsigned khoff = ML ? kh * 8192u : kh * 1024u;
    unsigned LBx[2], LK[2][2], TRK[2], VK[2], VN[2], WL[2];
#pragma unroll
    for (int e = 0; e < 2; ++e) { LBx[e] = LB0 + 16u * ((2u * e + hh) ^ x4) + khoff; WL[e] = 1024u * ((lane >> 3) & 3) + 64u * (lane & 7) + 16u * ((2u * e + hh) ^ x4);
#pragma unroll
        for (int t = 0; t < 2; ++t) LK[e][t] = LB0 + 16u * ((2u * e + t) ^ x4) + 8u * hh + khoff; }
#pragma unroll
    for (int t = 0; t < 2; ++t) {
        TRK[t] = 2048u * hh + 64u * q4 + 8u * (p4 & 1) + 16u * ((2u * blk + (p4 >> 1)) ^ (2u * hh + t));
        VK[t] = 64u * (4u * hh + q4) + 8u * (p4 & 1) + 16u * ((2u * blk + (p4 >> 1)) ^ (2u * t + hh)) + 512u * tj;
        VN[t] = 1024u * hh + 64u * q4 + 8u * (p4 & 1) + 512u * tj + 16u * ((2u * blk + (p4 >> 1)) ^ (2u * hh + t)); }
    unsigned tkoff[NOWN];
#pragma unroll
    for (int i = 0; i < NOWN; ++i) { const unsigned tk = kh * NKH + tp * NOWN + i; tkoff[i] = (tk >> 2) * 8192u + 512u * (tk & 3); }
    const bf16 *gq, *gk, *gv; int sq, sk; bf16* go;
    if (ML) { gq = F.XN + h * MLD; gk = F.XN + WB + h * MLD; sq = DM; sk = DM; gv = F.U + C_BV + h * MLD + vs * 64; go = (dirn ? F.HBB : F.HBF) + h * MLD + vs * 64; }
    else { if (dirn) { gq = F.U + C_AQ + h * HGD; sq = NU; gk = F.U + C_AFB + h * HGD; } else { gq = F.QTF + h * HGD; sq = WA; gk = F.U + C_AFF + h * HGD; }
        sk = NU; gv = F.U + C_AI + h * HGD + vs * 64; go = (dirn ? F.OAB : F.OAF) + h * HGD + vs * 64; }
    const float* mls = F.MLS + (size_t)(dirn * 4 + h) * MALL * 8;
    const float* pev = F.PE + (size_t)dirn * NCHUNK * WA + h * HGD;
    f32x16 S[NOWN];
#pragma unroll
    for (int i = 0; i < NOWN; ++i)
#pragma unroll
        for (int r = 0; r < 16; ++r) S[i][r] = 0.f;
    v4u pq[NPQ], pk[NPQ], pv, pw; f32x4 ps0, ps1; float pws;
    const bf16* gw_ = F.MLW + (size_t)(dirn * 4 + h) * 256 * 4096;
    auto row0_of = [&](int n) -> int { if (n < 4) { const int cc = dirn ? 3 - n : n; return MX + b * CTXL + cc * 64; } const int lc = dirn ? 67 - n : n - 4; return b * SEQ + lc * 64; };
    int offq[NPQ], offk[NPQ]; unsigned aimg[NPQ];
#pragma unroll
    for (int i = 0; i < NPQ; ++i) { const int u = (w + 8 * i) * 8 + (lane >> 3), NB = NCB * 4, row = 2 * (u / NB) + ((lane >> 2) & 1), ch = 4 * (u % NB) + (lane & 3);
        offq[i] = row * sq + ch * 8; offk[i] = row * sk + ch * 8; aimg[i] = img_addr(row, ch, NCB); }
    const int vu = w * 8 + (lane >> 3), vrow = 2 * (vu >> 1) + ((lane >> 2) & 1), vch = 4 * (vu & 1) + (lane & 3);
    const int offv = vrow * NU + vch * 8, offw = vrow * 64 + vch * 8; const unsigned va = v_addr(vrow, vch);
    auto issue_loads = [&](int n) {
        const int row0 = row0_of(n);
        const bf16* bq_ = gq + (size_t)row0 * sq; const bf16* bk_ = gk + (size_t)row0 * sk;
#pragma unroll
        for (int i = 0; i < NPQ; ++i) { pq[i] = *(const GAS v4u*)(bq_ + offq[i]); pk[i] = *(const GAS v4u*)(bk_ + offk[i]); }
        pv = *(const GAS v4u*)(gv + (size_t)row0 * NU + offv);
        if (ML) { pws = mls[(size_t)(row0 + vrow) * 8 + 3];
            if (n >= 4) pw = *(const GAS v4u*)(gw_ + (size_t)(row0 >> 6) * 4096 + offw);
            if (tid < 64) { ps0 = *(const GAS f32x4*)(mls + (size_t)(row0 + tid) * 8); ps1 = *(const GAS f32x4*)(mls + (size_t)(row0 + tid) * 8 + 4); } }
        else { if (tid < 32) ps0 = *(const GAS f32x4*)(pev + (size_t)(row0 >> 6) * WA + tid * 4); }
    };
    unsigned tch0 = 0u, tch1 = 0u, tdummy = 0u;
    auto touch = [&](int n) {
        const int row0 = row0_of(n);
        if (ML) { const int ln = tid & 255; const bf16* bp = (tid < 256 ? gq + (size_t)row0 * sq : gk + (size_t)row0 * sk) + (size_t)(ln >> 2) * DM + (ln & 3) * 64;
            tch0 = *(const GAS unsigned*)bp;
            if (tid < 64) tch1 = *(const GAS unsigned*)(gv + (size_t)(row0 + tid) * NU);
            else if (tid < 128 && n >= 4) tch1 = *(const GAS unsigned*)(gw_ + (size_t)(row0 >> 6) * 4096 + (tid - 64) * 64); }
        else { if (tid < 256) { const int ln = tid & 127; tch0 = *(const GAS unsigned*)((tid < 128 ? gq + (size_t)(row0 + (ln >> 1)) * sq : gk + (size_t)(row0 + (ln >> 1)) * sk) + (ln & 1) * 64); }
            else if (tid < 320) tch0 = *(const GAS unsigned*)(gv + (size_t)(row0 + tid - 256) * NU); }
    };
    auto store_images = [&](int n) {
#pragma unroll
        for (int i = 0; i < NPQ; ++i) { *(LAS v4u*)(L + SL_QT + aimg[i]) = pq[i]; *(LAS v4u*)(L + SL_KT + aimg[i]) = pk[i]; }
        *(LAS v4u*)(L + SL_V + va) = pv;
        if (!ML && tid < 32) *(LAS f32x4*)(SC + (n & 1) * SC_PAR + tid * 4) = ps0;
        if (ML) { v4u o; o.x = pkbf(lo2f(pv.x) * pws, hi2f(pv.x) * pws); o.y = pkbf(lo2f(pv.y) * pws, hi2f(pv.y) * pws); o.z = pkbf(lo2f(pv.z) * pws, hi2f(pv.z) * pws); o.w = pkbf(lo2f(pv.w) * pws, hi2f(pv.w) * pws);
            *(LAS v4u*)(L + SL_VW + va) = o;
            if (n >= 4) *(LAS v4u*)(L + SL_W + va) = pw;
            if (tid < 64) { LAS float* sp = SC + (n & 1) * SC_PAR + tid; sp[0] = ps0.x; sp[64] = ps0.y; sp[128] = ps0.z; sp[192] = ps0.w; sp[256] = ps1.x; sp[320] = ps1.y; sp[384] = ps1.z; SC[896 + tid] = ps1.w; } }
    };
    __syncthreads();
    issue_loads(0);
    for (int e = tid; e < 32768 / 16; e += NT) *(LAS v4u*)(L + SL_SF + e * 16) = (v4u){0u, 0u, 0u, 0u};
    store_images(0);
    __syncthreads();
#pragma unroll 1
    for (int n = 0; n < 68; ++n) {
        const bool lat = n >= 4; const int row0 = row0_of(n); const int cid = row0 >> 6;
        if (n + 1 < 68 && !(SKIP & 16)) issue_loads(n + 1);
        LAS float* SP = SC + (n & 1) * SC_PAR;
        float dec = 1.f; f32x4 pe[NOWN][4];
        if (ML) dec = SP[384];
        else {
#pragma unroll
            for (int i = 0; i < NOWN; ++i)
#pragma unroll
                for (int g = 0; g < 4; ++g) pe[i][g] = *(const LAS f32x4*)(SP + 32 * (kh * NKH + tp * NOWN + i) + 8 * g + 4 * hh);
        }
        f32x16 o;
        if (lat && !(SKIP & 4)) {
            f32x16 acc_o, acc_i;
#pragma unroll
            for (int r = 0; r < 16; ++r) { acc_o[r] = 0.f; acc_i[r] = 0.f; }
            if (ML) {
                if (kh == 0) {
#pragma unroll
                    for (int ts = 0; ts < 2; ++ts) {
                        const bool need = dirn ? (ts >= tp) : (ts <= tp);
                        if (need) {
                            const bf16x8 a0 = *(const LAS bf16x8*)(L + SL_W + tp * 4096 + 512 * ts + WL[0]), a1 = *(const LAS bf16x8*)(L + SL_W + tp * 4096 + 512 * ts + WL[1]);
                            const s16x4 lo0 = lds_tr(L + SL_V + ts * 4096 + VN[0]), hi0 = lds_tr(L + SL_V + ts * 4096 + 256 + VN[1]);
                            const s16x4 lo1 = lds_tr(L + SL_V + ts * 4096 + 2048 + VN[0]), hi1 = lds_tr(L + SL_V + ts * 4096 + 2048 + 256 + VN[1]);
                            acc_o = MFMA32(a0, cat4(lo0, hi0), acc_o);
                            acc_o = MFMA32(a1, cat4(lo1, hi1), acc_o);
                        }
                    }
                }
            } else
#pragma unroll
            for (int ts = 0; ts < 2; ++ts) {
                const bool need = dirn ? (ts >= tp) : (ts <= tp);
                if (need) {
                    f32x16 c;
#pragma unroll
                    for (int r = 0; r < 16; ++r) c[r] = 0.f;
                    {
                        bf16x8 a_c = *(const LAS bf16x8*)(L + SL_KT + ts * NCB * 8192 + LBx[0]), b_c = *(const LAS bf16x8*)(L + SL_QT + tp * NCB * 8192 + LBx[0]), a_n = a_c, b_n = b_c;
#pragma unroll
                        for (int s = 0; s < NKT; ++s) {
                            if (s + 1 < NKT) { a_n = *(const LAS bf16x8*)(L + SL_KT + ts * NCB * 8192 + 512 * ((s + 1) >> 1) + LBx[(s + 1) & 1]); b_n = *(const LAS bf16x8*)(L + SL_QT + tp * NCB * 8192 + 512 * ((s + 1) >> 1) + LBx[(s + 1) & 1]); }
                            c = MFMA32(a_c, b_c, c);
                            a_c = a_n; b_c = b_n;
                        }
                    }
                    const s16x4 vlo0 = lds_tr(L + SL_V + ts * 4096 + VK[0]), vhi0 = lds_tr(L + SL_V + ts * 4096 + 1024 + VK[1]);
                    const s16x4 vlo1 = lds_tr(L + SL_V + ts * 4096 + 2048 + VK[0]), vhi1 = lds_tr(L + SL_V + ts * 4096 + 3072 + VK[1]);
                    int dl = (lane & 31) - 4 * (int)hh; if (dirn) dl = -dl; asm volatile("" : "+v"(dl));
                    const int sg1 = dirn ? -1 : 1; const bool diag = ts == tp;
#pragma unroll
                    for (int r = 0; r < 16; ++r) { const int ro = (r & 3) + 8 * (r >> 2);
                        float wv = c[r];
                        if (diag) wv = (dl - sg1 * ro >= 0) ? wv : 0.f;
                        c[r] = wv; }
                    acc_o = MFMA32(pk8(c[0], c[1], c[2], c[3], c[4], c[5], c[6], c[7]), cat4(vlo0, vhi0), acc_o);
                    acc_o = MFMA32(pk8(c[8], c[9], c[10], c[11], c[12], c[13], c[14], c[15]), cat4(vlo1, vhi1), acc_o);
                }
            }
            {
#define LD_INTER(i_, LO_, HI_, SF_) do { LO_ = *(const LAS s16x4*)(L + SL_QT + tp * NCB * 8192 + 512 * ((i_) >> 1) + LK[(i_) & 1][0]); HI_ = *(const LAS s16x4*)(L + SL_QT + tp * NCB * 8192 + 512 * ((i_) >> 1) + LK[(i_) & 1][1]); \
                SF_ = *(const LAS bf16x8*)(L + SL_SF + ((((kh * NKH + ((i_) >> 1)) * 2 + tj) * 2 + ((i_) & 1)) * 1024) + lane * 16); } while (0)
                s16x4 lo_c, hi_c, lo_n, hi_n; bf16x8 sf_c, sf_n;
                LD_INTER(0, lo_c, hi_c, sf_c); lo_n = lo_c; hi_n = hi_c; sf_n = sf_c;
#pragma unroll
                for (int i = 0; i < 2 * NKH; ++i) {
                    if (i + 1 < 2 * NKH) LD_INTER(i + 1, lo_n, hi_n, sf_n);
                    acc_i = MFMA32(cat4(lo_c, hi_c), sf_c, acc_i);
                    lo_c = lo_n; hi_c = hi_n; sf_c = sf_n;
                }
#undef LD_INTER
            }
            if (ML) {
                f32x4 wi[4];
#pragma unroll
                for (int g = 0; g < 4; ++g) wi[g] = *(const LAS f32x4*)(SP + 128 + 32 * tp + 8 * g + 4 * hh);
#pragma unroll
                for (int r = 0; r < 16; ++r) o[r] = acc_o[r] + wi[r >> 2][r & 3] * acc_i[r];
            } else {
#pragma unroll
                for (int r = 0; r < 16; ++r) o[r] = acc_o[r] + acc_i[r];
            }
            {
#pragma unroll
                for (int r = 0; r < 8; ++r) { const int rr = kh ? r : r + 8; *(LAS float*)(L + SL_XCH + (((tp * 2 + tj) * 16 + rr) * 64 + lane) * 4) = kh ? o[r] : o[r + 8]; }
            }
        }
        {
            if (ML) {
#pragma unroll
                for (int i = 0; i < NOWN; ++i)
#pragma unroll
                    for (int r = 0; r < 16; ++r) S[i][r] *= dec;
            }
#define LD_GA(ks_, i_, LO_, HI_) do { LO_ = lds_tr(L + SL_KT + ((ks_) >> 1) * NCB * 8192 + 4096 * ((ks_) & 1) + tkoff[i_] + TRK[0]); HI_ = lds_tr(L + SL_KT + ((ks_) >> 1) * NCB * 8192 + 4096 * ((ks_) & 1) + 256 + tkoff[i_] + TRK[1]); } while (0)
#define LD_GB(ks_, LO_, HI_) do { LO_ = lds_tr(L + (ML ? SL_VW : SL_V) + ((ks_) >> 1) * 4096 + 2048 * ((ks_) & 1) + VN[0]); HI_ = lds_tr(L + (ML ? SL_VW : SL_V) + ((ks_) >> 1) * 4096 + 2048 * ((ks_) & 1) + 256 + VN[1]); } while (0)
            s16x4 alo_c, ahi_c, blo_c, bhi_c, alo_n, ahi_n, blo_n, bhi_n;
            LD_GB(0, blo_c, bhi_c); LD_GA(0, 0, alo_c, ahi_c); alo_n = alo_c; ahi_n = ahi_c; blo_n = blo_c; bhi_n = bhi_c;
            constexpr int NG = (SKIP & 8) ? 0 : 4 * NOWN;
#pragma unroll
            for (int j = 0; j < NG; ++j) {
                const int ks = j / NOWN, i = j % NOWN, ks1 = (j + 1) / NOWN, i1 = (j + 1) % NOWN;
                if (j + 1 < NG) { LD_GA(ks1, i1, alo_n, ahi_n); if (i1 == 0) LD_GB(ks1, blo_n, bhi_n); }
                S[i] = MFMA32(cat4(alo_c, ahi_c), cat4(blo_c, bhi_c), S[i]);
                alo_c = alo_n; ahi_c = ahi_n; if (i1 == 0) { blo_c = blo_n; bhi_c = bhi_n; }
                (void)ks;
            }
#undef LD_GA
#undef LD_GB
            if (!ML) {
#pragma unroll
                for (int i = 0; i < NOWN; ++i)
#pragma unroll
                    for (int r = 0; r < 16; ++r) S[i][r] *= pe[i][r >> 2][r & 3];
            }
        }
        __syncthreads();
#pragma unroll
        for (int i = 0; i < NOWN; ++i)
#pragma unroll
            for (int st = 0; st < 2; ++st) {
                const bf16x8 f8 = pk8(S[i][8 * st], S[i][8 * st + 1], S[i][8 * st + 2], S[i][8 * st + 3], S[i][8 * st + 4], S[i][8 * st + 5], S[i][8 * st + 6], S[i][8 * st + 7]);
                *(LAS bf16x8*)(L + SL_SF + ((((kh * NKH + tp * NOWN + i) * 2 + tj) * 2 + st) * 1024) + lane * 16) = f8;
            }
        if (n + 1 < 68 && !(SKIP & 16)) store_images(n + 1);
        if (lat && !(SKIP & 2)) {
            float xv[8];
#pragma unroll
            for (int r8 = 0; r8 < 8; ++r8) { const int r = kh ? r8 + 8 : r8; xv[r8] = *(const LAS float*)(L + SL_XCH + (((tp * 2 + tj) * 16 + r) * 64 + lane) * 4); }
#pragma unroll
            for (int r8 = 0; r8 < 8; ++r8) { const int r = kh ? r8 + 8 : r8; const float ov = (kh ? o[r8 + 8] : o[r8]) + xv[r8];
                const int pr = 32 * tp + (r & 3) + 8 * (r >> 2) + 4 * (int)hh;
                go[(size_t)(row0 + pr) * WA + 32 * tj + (lane & 31)] = (bf16)(pkbf(ov, 0.f) & 0xffffu); }
        }
        LDS_BARRIER();
    }
}
#ifndef HG_MFMA
#define HG_MFMA 1
#endif
#ifndef ML_MFMA
#define ML_MFMA 1
#endif

__device__ __forceinline__ void nchain_task(Frame& F, int j) {
    const int kq = j & 3, id = j >> 2, dirn = id & 1, h = (id >> 1) & 3, b = id >> 3;
    const int tid = F.tid, lane = F.lane, w = F.wave;
    LAS unsigned char* L = F.lds;
    constexpr int NQ = 0, NK = 8192, NS = 16384;
    LAS float* SN = (LAS float*)(L + NS);
    const bf16* gq = F.XN + h * MLD + kq * 64; const bf16* gk = gq + WB;
    const float* mls = F.MLS + (size_t)(dirn * 4 + h) * MALL * 8;
    float* dqp = F.DQP + (size_t)((dirn * 4 + h) * 4 + kq) * MX;
    auto row0_of = [&](int n) -> int { if (n < 4) { const int cc = dirn ? 3 - n : n; return MX + b * CTXL + cc * 64; } const int lc = dirn ? 67 - n : n - 4; return b * SEQ + lc * 64; };
    v4u pq, pk; float pws = 0.f, pdec = 0.f;
    auto issue = [&](int n) { const int row0 = row0_of(n); const size_t off = (size_t)(row0 + (tid >> 3)) * DM + (tid & 7) * 8;
        pq = *(const GAS v4u*)(gq + off); pk = *(const GAS v4u*)(gk + off);
        if (tid < 64) { pws = mls[(size_t)(row0 + tid) * 8 + 3]; pdec = mls[(size_t)(row0 + tid) * 8 + 6]; } };
    auto stash = [&]() { *(LAS v4u*)(L + NQ + tid * 16) = pq; *(LAS v4u*)(L + NK + tid * 16) = pk; if (tid < 64) { SN[tid] = pws; if (tid == 0) SN[640] = pdec; } };
    __syncthreads();
    issue(0);
    if (tid < 64) SN[64 + tid] = 0.f;
    stash();
    __syncthreads();
#pragma unroll 1
    for (int n = 0; n < 68; ++n) {
        const int row0 = row0_of(n);
        issue(n + 1 < 68 ? n + 1 : 67);
        float dq_keep = 0.f;
        if (n >= 4) {
            const int p = tid >> 3, kk = tid & 7; const v4u u = *(const LAS v4u*)(L + NQ + tid * 16);
            const f32x4 na = *(const LAS f32x4*)(SN + 64 + 8 * kk), nb = *(const LAS f32x4*)(SN + 64 + 8 * kk + 4);
            float d = lo2f(u.x) * na.x + hi2f(u.x) * na.y + lo2f(u.y) * na.z + hi2f(u.y) * na.w + lo2f(u.z) * nb.x + hi2f(u.z) * nb.y + lo2f(u.w) * nb.z + hi2f(u.w) * nb.w;
            d += __shfl_xor(d, 1); d += __shfl_xor(d, 2); d += __shfl_xor(d, 4);
            dq_keep = d;
        }
        { float a = 0.f;
#pragma unroll
          for (int i = 0; i < 8; ++i) { const int s_ = 8 * w + i; a += SN[s_] * bf2f(*(const LAS unsigned short*)(L + NK + s_ * 128 + lane * 2)); }
          SN[128 + w * 64 + lane] = a; }
        __syncthreads();
        if (tid < 64) { float nn = SN[640] * SN[64 + tid];
#pragma unroll
            for (int ww = 0; ww < 8; ++ww) nn += SN[128 + ww * 64 + tid];
            SN[64 + tid] = nn; }
        stash();
        if (n >= 4 && (tid & 7) == 0) dqp[row0 + (tid >> 3)] = dq_keep;
        LDS_BARRIER();
    }
}

template <int WHICH, int SKIP = 0>
__device__ __forceinline__ void p4_scan(Frame& F) {
    for (int t = F.vcu; t < 256; t += F.G) {
        if (t < 128 ? !(WHICH & 1) : !(WHICH & 2)) continue;
        if (t < 128) { if (ML_MFMA) scan_task<true, SKIP>(F, t); else { p4_mlstm_task(F, 2 * t); p4_mlstm_task(F, 2 * t + 1); } }
        else { if (HG_MFMA) { scan_task<false, SKIP>(F, t - 128); nchain_task(F, t - 128); } else { p4_hgrn2_task(F, 2 * (t - 128)); p4_hgrn2_task(F, 2 * (t - 128) + 1); } }
    }
}
__device__ __forceinline__ void p5_combine(Frame& F) {
    bf16* Y = F.XN;
    const int gw = F.vcu * NWAVES + F.wave, NGW = F.G * NWAVES;
    for (int row = gw; row < MX; row += NGW) {
        const int ch = F.lane * 16;
        {
            float o[16];
            const v4u a0 = *(const GAS v4u*)(F.OAF + (size_t)row * WA + ch), a1 = *(const GAS v4u*)(F.OAF + (size_t)row * WA + ch + 8);
            const v4u b0 = *(const GAS v4u*)(F.OAB + (size_t)row * WA + ch), b1 = *(const GAS v4u*)(F.OAB + (size_t)row * WA + ch + 8);
            const unsigned ua[8] = {a0.x, a0.y, a0.z, a0.w, a1.x, a1.y, a1.z, a1.w}, ub[8] = {b0.x, b0.y, b0.z, b0.w, b1.x, b1.y, b1.z, b1.w};
            float ss = 0.f;
#pragma unroll
            for (int j = 0; j < 8; ++j) { o[2 * j] = lo2f(ua[j]) + lo2f(ub[j]); o[2 * j + 1] = hi2f(ua[j]) + hi2f(ub[j]); ss += o[2 * j] * o[2 * j] + o[2 * j + 1] * o[2 * j + 1]; }
            ss += __shfl_xor(ss, 1); ss += __shfl_xor(ss, 2); ss += __shfl_xor(ss, 4);
            const float r = 1.f / sqrtf(ss * (1.f / HGD) + NORM_EPS);
            const v4u z0 = *(const GAS v4u*)(F.U + (size_t)row * NU + C_AZ + ch), z1 = *(const GAS v4u*)(F.U + (size_t)row * NU + C_AZ + ch + 8);
            const unsigned uz[8] = {z0.x, z0.y, z0.z, z0.w, z1.x, z1.y, z1.z, z1.w};
            unsigned w[8];
#pragma unroll
            for (int j = 0; j < 8; ++j) { const float y0 = o[2 * j] * r * F.hg_norm_w[ch + 2 * j] * siluf(lo2f(uz[j])), y1 = o[2 * j + 1] * r * F.hg_norm_w[ch + 2 * j + 1] * siluf(hi2f(uz[j])); w[j] = pk2(y0, y1); }
            *(GAS v4u*)(Y + (size_t)row * DM + ch) = (v4u){w[0], w[1], w[2], w[3]}; *(GAS v4u*)(Y + (size_t)row * DM + ch + 8) = (v4u){w[4], w[5], w[6], w[7]};
        }
        {
            float o[16];
            const v4u a0 = *(const GAS v4u*)(F.HBF + (size_t)row * WB + ch), a1 = *(const GAS v4u*)(F.HBF + (size_t)row * WB + ch + 8);
            const v4u b0 = *(const GAS v4u*)(F.HBB + (size_t)row * WB + ch), b1 = *(const GAS v4u*)(F.HBB + (size_t)row * WB + ch + 8);
            const unsigned ua[8] = {a0.x, a0.y, a0.z, a0.w, a1.x, a1.y, a1.z, a1.w}, ub[8] = {b0.x, b0.y, b0.z, b0.w, b1.x, b1.y, b1.z, b1.w};
            float s = 0.f; const int hq = F.lane >> 4;
            float invd[2];
#pragma unroll
            for (int d = 0; d < 2; ++d) { const float* mr = F.MLS + ((size_t)(d * 4 + hq) * MALL + row) * 8; const float* dq = F.DQP + (size_t)((d * 4 + hq) * 4) * MX + row;
                const float den = mr[2] * ((dq[0] + dq[MX]) + (dq[2 * MX] + dq[3 * MX])) + mr[5];
                invd[d] = rcpf_(fmaxf(fabsf(den), mr[4])); }
#pragma unroll
            for (int j = 0; j < 8; ++j) { o[2 * j] = lo2f(ua[j]) * invd[0] + lo2f(ub[j]) * invd[1]; o[2 * j + 1] = hi2f(ua[j]) * invd[0] + hi2f(ub[j]) * invd[1]; s += o[2 * j] + o[2 * j + 1]; }
            s += __shfl_xor(s, 1); s += __shfl_xor(s, 2); s += __shfl_xor(s, 4); s += __shfl_xor(s, 8);
            const float mu = s * (1.f / MLD); float q = 0.f;
#pragma unroll
            for (int j = 0; j < 16; ++j) { o[j] -= mu; q += o[j] * o[j]; }
            q += __shfl_xor(q, 1); q += __shfl_xor(q, 2); q += __shfl_xor(q, 4); q += __shfl_xor(q, 8);
            const float r = 1.f / sqrtf(q * (1.f / MLD) + NORM_EPS);
            const v4u g0 = *(const GAS v4u*)(F.U + (size_t)row * NU + C_BO + ch), g1 = *(const GAS v4u*)(F.U + (size_t)row * NU + C_BO + ch + 8);
            const v4u z0 = *(const GAS v4u*)(F.U + (size_t)row * NU + C_BZ + ch), z1 = *(const GAS v4u*)(F.U + (size_t)row * NU + C_BZ + ch + 8);
            const unsigned ug[8] = {g0.x, g0.y, g0.z, g0.w, g1.x, g1.y, g1.z, g1.w}, uz[8] = {z0.x, z0.y, z0.z, z0.w, z1.x, z1.y, z1.z, z1.w};
            unsigned w[8];
#pragma unroll
            for (int j = 0; j < 8; ++j) { const float y0 = o[2 * j] * r * F.ml_norm_w[ch + 2 * j] * sigmf(lo2f(ug[j])) * siluf(lo2f(uz[j])), y1 = o[2 * j + 1] * r * F.ml_norm_w[ch + 2 * j + 1] * sigmf(hi2f(ug[j])) * siluf(hi2f(uz[j])); w[j] = pk2(y0, y1); }
            *(GAS v4u*)(Y + (size_t)row * DM + WA + ch) = (v4u){w[0], w[1], w[2], w[3]}; *(GAS v4u*)(Y + (size_t)row * DM + WA + ch + 8) = (v4u){w[4], w[5], w[6], w[7]};
        }
    }
}

struct EpiResid {
    static constexpr bool PERM = false, AFTER_DRAIN = false;
    const float* x; const float* gate; float* out;
    __device__ __forceinline__ void operator()(const pg8::f32x4 (&acc)[2][2][4][2], const pg8::Unit& u, int wr, int wc, int fr, int fq) const {
        using pg8::BM; using pg8::HALF;
        const int row0 = u.pm * BM + wr * 64 + fr, col0 = u.pn * BM + wc * 32 + 4 * fq; const int b = (u.pm * BM) / SEQ;
        pg8::f32x4 gv[2][2];
#pragma unroll
        for (int bj = 0; bj < 2; ++bj)
#pragma unroll
            for (int n = 0; n < 2; ++n) gv[bj][n] = *(const pg8::f32x4*)(gate + b * DM + col0 + bj * HALF + n * 16);
#pragma unroll
        for (int ai = 0; ai < 2; ++ai) {
            pg8::f32x4 xv[4][2][2];
#pragma unroll
            for (int m = 0; m < 4; ++m) { const size_t off = (size_t)(row0 + ai * HALF + m * 16) * DM + col0;
#pragma unroll
                for (int bj = 0; bj < 2; ++bj)
#pragma unroll
                    for (int n = 0; n < 2; ++n) xv[m][bj][n] = *(const pg8::f32x4*)(x + off + bj * HALF + n * 16); }
#pragma unroll
            for (int m = 0; m < 4; ++m) { const size_t off = (size_t)(row0 + ai * HALF + m * 16) * DM + col0;
#pragma unroll
                for (int bj = 0; bj < 2; ++bj)
#pragma unroll
                    for (int n = 0; n < 2; ++n) *(pg8::f32x4*)(out + off + bj * HALF + n * 16) = xv[m][bj][n] * ALPHA + gv[bj][n] * acc[ai][bj][m][n]; }
        }
    }
};


struct PanelOrder {
    int c;
    __device__ __forceinline__ bool next(int i, pg8::Unit& u) const { if (i >= 2) return false; u.pm = c >> 2; u.pn = (c & 3) + 4 * i; return true; }
    __device__ __forceinline__ void a_ready(const pg8::Unit&) const {}
    __device__ __forceinline__ void done(const pg8::Unit&) const {}
};
struct EpiLnFused {
    static constexpr bool PERM = false, AFTER_DRAIN = true;
    const float* x; const float* gate; float* out; const float* ln_g; const float* ln_b;
    unsigned long long* xbuf;
    unsigned* cnt;
    __device__ __forceinline__ void zstats(pg8::f32x4 (&acc)[2][2][4][2], const pg8::Unit& u, int wr, int wc, int fr, int fq) const {
        using pg8::BM; using pg8::HALF;
        asm volatile("" : "+v"(fr), "+v"(fq));
        const int row0 = u.pm * BM + wr * 64 + fr, col0 = u.pn * BM + wc * 32 + 4 * fq; const int b = (u.pm * BM) / SEQ;
        pg8::f32x4 gv[2][2];
#pragma unroll
        for (int bj = 0; bj < 2; ++bj)
#pragma unroll
            for (int n = 0; n < 2; ++n) gv[bj][n] = *(const pg8::f32x4*)(gate + b * DM + col0 + bj * HALF + n * 16);
#pragma unroll
        for (int ai = 0; ai < 2; ++ai)
#pragma unroll
            for (int m = 0; m < 4; ++m) { const int row = row0 + ai * HALF + m * 16; const size_t off = (size_t)row * DM + col0;
                float s = 0.f;
#pragma unroll
                for (int bj = 0; bj < 2; ++bj)
#pragma unroll
                    for (int n = 0; n < 2; ++n) { const pg8::f32x4 xv = *(const pg8::f32x4*)(x + off + bj * HALF + n * 16);
                        const pg8::f32x4 z = xv * ALPHA + gv[bj][n] * acc[ai][bj][m][n]; acc[ai][bj][m][n] = z; s += (z[0] + z[1]) + (z[2] + z[3]); }
                s += __shfl_xor(s, 16); s += __shfl_xor(s, 32);
                const float mw = s * (1.0f / 64.0f); float q = 0.f;
#pragma unroll
                for (int bj = 0; bj < 2; ++bj)
#pragma unroll
                    for (int n = 0; n < 2; ++n) { const pg8::f32x4 d = acc[ai][bj][m][n] - mw; q += (d[0] * d[0] + d[1] * d[1]) + (d[2] * d[2] + d[3] * d[3]); }
                q += __shfl_xor(q, 16); q += __shfl_xor(q, 32);
                if (fq == 0) __hip_atomic_store(xbuf + (size_t)row * 32 + u.pn * 4 + wc, ((unsigned long long)__float_as_uint(q) << 32) | __float_as_uint(mw), __ATOMIC_RELAXED, __HIP_MEMORY_SCOPE_AGENT);
            }
    }
    __device__ __forceinline__ void publish(const pg8::Unit& u) const {
        asm volatile("s_waitcnt vmcnt(0)" ::: "memory");
        if ((threadIdx.x & 63) == 0) __hip_atomic_fetch_add(cnt + 64 * u.pm, 1u, __ATOMIC_RELAXED, __HIP_MEMORY_SCOPE_AGENT);
    }
    __device__ __forceinline__ void operator()(const pg8::f32x4 (&acc_c)[2][2][4][2], const pg8::Unit& u, int wr, int wc, int fr, int fq) const {
        using pg8::BM; using pg8::HALF;
        pg8::f32x4 (&acc)[2][2][4][2] = const_cast<pg8::f32x4 (&)[2][2][4][2]>(acc_c);
        zstats(acc, u, wr, wc, fr, fq);
        const int row0 = u.pm * BM + wr * 64 + fr, col0 = u.pn * BM + wc * 32 + 4 * fq;
#pragma unroll
        for (int ai = 0; ai < 2; ++ai)
#pragma unroll
            for (int m = 0; m < 4; ++m) { const size_t off = (size_t)(row0 + ai * HALF + m * 16) * DM + col0;
#pragma unroll
                for (int bj = 0; bj < 2; ++bj)
#pragma unroll
                    for (int n = 0; n < 2; ++n) *(pg8::f32x4*)(out + off + bj * HALF + n * 16) = acc[ai][bj][m][n]; }
        publish(u);
    }
    __device__ __forceinline__ void fused(pg8::f32x4 (&acc)[2][2][4][2], const pg8::Unit& u, int wr, int wc, int fr, int fq, PG8_LAS unsigned char* lds, int wid, int lane) const {
        using pg8::BM; using pg8::HALF;
        typedef float f32x2v __attribute__((ext_vector_type(2)));
        PG8_LAS f32x2v* PH = (PG8_LAS f32x2v*)(lds + 131072);
        PG8_LAS f32x2v* S = (PG8_LAS f32x2v*)(lds + 131072 + 4096);
        zstats(acc, u, wr, wc, fr, fq);
        publish(u);
        if (wid == 0) {
            unsigned spins = 0;
            while ((unsigned)__builtin_amdgcn_readfirstlane(__hip_atomic_load(cnt + 64 * u.pm, __ATOMIC_RELAXED, __HIP_MEMORY_SCOPE_AGENT)) < 64u) { __builtin_amdgcn_s_sleep(2); if (++spins > (1u << 22)) break; }
            __builtin_amdgcn_fence(__ATOMIC_ACQUIRE, "agent");
            asm volatile("s_waitcnt vmcnt(0)" ::: "memory");
        }
        asm volatile("s_waitcnt vmcnt(0) lgkmcnt(0)" ::: "memory"); __builtin_amdgcn_s_barrier(); asm volatile("" ::: "memory");
        { const int t = threadIdx.x, row = t >> 1, half = t & 1; const unsigned long long* sl = xbuf + (size_t)(u.pm * BM + row) * 32 + half * 16;
          float ms = 0.f, mq = 0.f, m2s = 0.f;
#pragma unroll
          for (int i = 0; i < 16; ++i) { const unsigned long long w = __hip_atomic_load(sl + i, __ATOMIC_RELAXED, __HIP_MEMORY_SCOPE_AGENT); const float mt = __uint_as_float((unsigned)w); ms += mt; mq += mt * mt; m2s += __uint_as_float((unsigned)(w >> 32)); }
          const float mh = ms * (1.0f / 16.0f);
          PH[row * 2 + half] = (f32x2v){mh, m2s + 64.0f * fmaxf(mq - 16.0f * mh * mh, 0.f)}; }
        asm volatile("s_waitcnt lgkmcnt(0)" ::: "memory"); __builtin_amdgcn_s_barrier(); asm volatile("" ::: "memory");
        if (threadIdx.x < 256) { const int row = threadIdx.x; const f32x2v a = PH[row * 2], bq = PH[row * 2 + 1];
            const float mean = 0.5f * (a.x + bq.x), da = a.x - mean, db = bq.x - mean; const float m2t = (a.y + bq.y) + 1024.0f * (da * da + db * db);
            S[row] = (f32x2v){mean, 1.0f / sqrtf(m2t * (1.0f / 2048.0f) + LN_EPS)}; }
        asm volatile("s_waitcnt lgkmcnt(0)" ::: "memory"); __builtin_amdgcn_s_barrier(); asm volatile("" ::: "memory");
        const int row0 = u.pm * BM + wr * 64 + fr, col0 = u.pn * BM + wc * 32 + 4 * fq;
#pragma unroll
        for (int bj = 0; bj < 2; ++bj)
#pragma unroll
            for (int n = 0; n < 2; ++n) { const int c = col0 + bj * HALF + n * 16;
                const pg8::f32x4 g2 = *(const pg8::f32x4*)(ln_g + c), b2 = *(const pg8::f32x4*)(ln_b + c), g1 = *(const pg8::f32x4*)(ln_g + c - 4 * BM), b1 = *(const pg8::f32x4*)(ln_b + c - 4 * BM);
#pragma unroll
                for (int ai = 0; ai < 2; ++ai)
#pragma unroll
                    for (int m = 0; m < 4; ++m) { const int rl = ai * HALF + wr * 64 + m * 16 + fr; const f32x2v sr = S[rl]; const size_t off = (size_t)(row0 + ai * HALF + m * 16) * DM + c;
                        const pg8::f32x4 z1 = *(const pg8::f32x4*)(out + off - 4 * BM);
                        *(pg8::f32x4*)(out + off) = (acc[ai][bj][m][n] - sr.x) * sr.y * g2 + b2;
                        acc[ai][bj][m][n] = (z1 - sr.x) * sr.y * g1 + b1; }
#pragma unroll
                for (int ai = 0; ai < 2; ++ai)
#pragma unroll
                    for (int m = 0; m < 4; ++m) { const size_t off = (size_t)(row0 + ai * HALF + m * 16) * DM + c; *(pg8::f32x4*)(out + off - 4 * BM) = acc[ai][bj][m][n]; } }
    }
};

__device__ __forceinline__ void p7_ln(Frame& F) {
    const int gw = F.vcu * NWAVES + F.wave, NGW = F.G * NWAVES;
    for (int row = 2 * gw; row < MX; row += 2 * NGW) {
        GAS f32x4* ra = (GAS f32x4*)(F.out + (size_t)row * DM) + F.lane; GAS f32x4* rb = ra + DM / 4;
        f32x4 va[8], vb[8]; float sa = 0.f, sb = 0.f;
#pragma unroll
        for (int j = 0; j < 8; ++j) { va[j] = ra[64 * j]; vb[j] = rb[64 * j]; }
#pragma unroll
        for (int j = 0; j < 8; ++j) { sa += (va[j].x + va[j].y) + (va[j].z + va[j].w); sb += (vb[j].x + vb[j].y) + (vb[j].z + vb[j].w); }
        const float ma = wave_sum(sa) * (1.f / DM), mb = wave_sum(sb) * (1.f / DM); float qa = 0.f, qb = 0.f;
#pragma unroll
        for (int j = 0; j < 8; ++j) { va[j] = va[j] - ma; vb[j] = vb[j] - mb; qa += (va[j].x * va[j].x + va[j].y * va[j].y) + (va[j].z * va[j].z + va[j].w * va[j].w); qb += (vb[j].x * vb[j].x + vb[j].y * vb[j].y) + (vb[j].z * vb[j].z + vb[j].w * vb[j].w); }
        const float rsa = 1.f / sqrtf(wave_sum(qa) * (1.f / DM) + LN_EPS), rsb = 1.f / sqrtf(wave_sum(qb) * (1.f / DM) + LN_EPS);
        f32x4 gg[8], bbv[8];
#pragma unroll
        for (int j = 0; j < 8; ++j) { const int k = 4 * F.lane + 256 * j; gg[j] = *(const f32x4*)(F.ln_g + k); bbv[j] = *(const f32x4*)(F.ln_b + k); }
#pragma unroll
        for (int j = 0; j < 8; ++j) { ra[64 * j] = va[j] * rsa * gg[j] + bbv[j]; rb[64 * j] = vb[j] * rsb * gg[j] + bbv[j]; }
    }
}

struct Args { const float* in[16]; float* out; unsigned char* ws; int ph_lo, ph_hi, li, pad; };
__global__ void __launch_bounds__(NWAVES * 64, 2) mk_fwd(Args args) {
    extern __shared__ __attribute__((aligned(16))) unsigned char lds[];
    Frame F;
    F.lds = (LAS unsigned char*)lds;
    F.MISC = (volatile LAS unsigned*)(F.lds + MISC_OFF);
    F.tid = threadIdx.x; F.lane = F.tid & 63; F.wave = __builtin_amdgcn_readfirstlane(F.tid >> 6);
    F.G = gridDim.x; { const int bx = blockIdx.x; F.vcu = (F.G % 8 == 0) ? (bx % 8) * (F.G / 8) + bx / 8 : bx; }
    unsigned char* ws = args.ws;
    F.ctl = (gu32*)(ws + WS_CTL);
    F.x = args.in[0]; F.c = args.in[1]; F.ctx = args.in[2]; F.c_ctx = args.in[3]; F.w_mod = args.in[4]; F.b_mod = args.in[5]; F.w_in = args.in[6];
    F.conv_w = args.in[7]; F.conv_b = args.in[8]; F.hg_lb = args.in[9]; F.ml_gate_b = args.in[10]; F.hg_norm_w = args.in[11]; F.ml_norm_w = args.in[12];
    F.w_out = args.in[13]; F.ln_g = args.in[14]; F.ln_b = args.in[15]; F.out = args.out;
    F.modp = (float*)(ws + WS_MODP); F.gate = (float*)(ws + WS_GATE);
    F.QTF = (bf16*)(ws + WS_WINT); F.PE = (float*)(ws + WS_PE); F.MLS = (float*)(ws + WS_MLS); F.DEC = (float*)(ws + WS_DEC); F.MLW = (bf16*)(ws + WS_MLW); F.DQP = (float*)(ws + WS_DQP);
    F.WinT = (bf16*)(ws + WS_WINT); F.WoutT = (bf16*)(ws + WS_WOUTT); F.XN = (bf16*)(ws + WS_XN); F.U = (bf16*)(ws + WS_U);
    F.OAF = (bf16*)args.out; F.OAB = F.OAF + (size_t)MX * WA; F.HBF = F.OAB + (size_t)MX * WA; F.HBB = F.HBF + (size_t)MX * WB;
    for (int u = F.tid; u < (LDS_BYTES - LDSCTL_OFF) / 4; u += NT) ((LAS unsigned*)(F.lds + LDSCTL_OFF))[u] = 0u;
    __syncthreads();
    XcdBarrier bar; bar.bar = (unsigned*)(F.ctl + CW_BAR); bar.x = 0; bar.st = nullptr;
    if (MK_N_LAUNCHES == 1) bar = xcd_barrier_post((unsigned*)(F.ctl + CW_BAR), F.MISC + 8);
    const int lo = args.ph_lo, hi = args.ph_hi;
#ifndef PH_MASK
#define PH_MASK 255
#endif
#define PHON(k) ((PH_MASK >> (k)) & 1)
#ifndef DUP_MASK
#define DUP_MASK 0
#endif
#define DUP(k) ((DUP_MASK >> (k)) & 1)
#ifndef FUSE_LN
#define FUSE_LN 0
#endif
#ifndef DUP4S
#define DUP4S 0
#endif
#ifndef DUP4W
#define DUP4W 3
#endif
#ifndef DUP3W
#define DUP3W 7
#endif
#define IN(k) (lo <= (k) && (k) < hi)
#define SEAM(k) do { if (IN(k) && IN((k) + 1)) xcd_barrier(bar); } while (0)
    if (PHON(0) && IN(0)) { p0_prep(F); if (DUP(0)) p0_prep(F); } SEAM(0);
    if (PHON(1) && IN(1)) { p1_lnmod(F); if (DUP(1)) p1_lnmod(F); } SEAM(1);
    if (PHON(2) && IN(2)) { pg8::Gemm g{F.XN, F.WinT, MALL, NU, DM}; pg8::StaticOrder S; S.init(MALL, NU, F.G, (int)blockIdx.x);
        pg8::EpiBf16<0> E{F.U, NU, nullptr, 0, 0, 1.f};
        pg8::gemm_phase<pg8::EpiBf16<0>, pg8::StaticOrder, PG8_ALIGN, PG8_SP2>(F.lds + RING_OFF, g, S, E); } SEAM(2);
    if (PHON(3) && IN(3)) { if (DUP(3)) { if (DUP3W & 1) p3_hg_prep<true>(F); if (DUP3W & 2) p3_conv(F); if (DUP3W & 4) p3_ml_scalars(F); } p3_conv(F); if (HG_MFMA) p3_hg_prep<false>(F); if (ML_MFMA) p3_ml_scalars(F); xcd_barrier(bar); p3b_ml_scores(F); if (DUP(6)) p3b_ml_scores(F); } SEAM(3);
    if (PHON(4) && IN(4)) { if (DUP(4)) p4_scan<DUP4W, DUP4S>(F); p4_scan<3>(F); } SEAM(4);
    if (PHON(5) && IN(5)) { p5_combine(F); if (DUP(5)) p5_combine(F); if (DUP(7)) { xcd_barrier(bar); xcd_barrier(bar); xcd_barrier(bar); xcd_barrier(bar); } } SEAM(5);
    if (PHON(6) && IN(6)) { pg8::Gemm g{F.XN, F.WoutT, MX, DM, DM}; pg8::StaticOrder S; S.init(MX, DM, F.G, (int)blockIdx.x);
        if (F.G == 256 && FUSE_LN) { PanelOrder PO{F.vcu}; EpiLnFused E{F.x, F.gate, F.out, F.ln_g, F.ln_b, (unsigned long long*)(args.ws + WS_XB), (unsigned*)(F.ctl + CW_PANEL)};
            pg8::gemm_phase<EpiLnFused, PanelOrder, PG8_ALIGN, PG8_SP2>(F.lds + RING_OFF, g, PO, E); }
        else { EpiResid E{F.x, F.gate, F.out};
            pg8::gemm_phase<EpiResid, pg8::StaticOrder, PG8_ALIGN, PG8_SP2>(F.lds + RING_OFF, g, S, E);
            if (DUP(8)) { __syncthreads(); pg8::gemm_phase<EpiResid, pg8::StaticOrder, PG8_ALIGN, PG8_SP2>(F.lds + RING_OFF, g, S, E); } } }
    if (!(F.G == 256 && FUSE_LN)) { SEAM(6); if (PHON(7) && IN(7)) { p7_ln(F); } }
#undef IN
#undef SEAM
}

extern "C" void kernel_launch(void* const* d_in, const int* in_sizes, int n_in, void* d_out, int out_size, void* d_ws, size_t ws_size, hipStream_t stream) {
    static int grid = 0;
    if (grid == 0) {
        if (n_in != 16 || out_size != MX * DM || ws_size < WS_END) { fprintf(stderr, "kernel_launch: unexpected shapes (n_in %d out %d ws %zu)\n", n_in, out_size, ws_size); grid = -1; return; }
        int dev = 0, cus = 0, per_cu = 0;
        if (hipGetDevice(&dev) != hipSuccess || hipDeviceGetAttribute(&cus, hipDeviceAttributeMultiprocessorCount, dev) != hipSuccess) { grid = -1; return; }
        if (hipFuncSetAttribute((const void*)mk_fwd, hipFuncAttributeMaxDynamicSharedMemorySize, LDS_BYTES) != hipSuccess) { fprintf(stderr, "kernel_launch: hipFuncSetAttribute failed\n"); grid = -1; return; }
        if (hipOccupancyMaxActiveBlocksPerMultiprocessor(&per_cu, (const void*)mk_fwd, NT, LDS_BYTES) != hipSuccess || per_cu < 1) { fprintf(stderr, "kernel_launch: occupancy query says %d\n", per_cu); per_cu = 1; }
        (void)hipGetLastError();
        grid = cus;
    }
    if (grid < 0) return;
    if (hipMemsetAsync((char*)d_ws + WS_CTL, 0, CTL_ZERO_BYTES, stream) != hipSuccess) { fprintf(stderr, "kernel_launch: memset failed\n"); return; }
    Args a{};
    for (int i = 0; i < 16; ++i) a.in[i] = (const float*)d_in[i];
    a.out = (float*)d_out; a.ws = (unsigned char*)d_ws;
    for (int li = 0; li < MK_N_LAUNCHES; ++li) {
        a.ph_lo = (MK_N_LAUNCHES == 1) ? 0 : li; a.ph_hi = (MK_N_LAUNCHES == 1) ? N_PHASES : li + 1; a.li = li;
        hipLaunchKernelGGL(mk_fwd, dim3(grid), dim3(NT), LDS_BYTES, stream, a);
        const hipError_t le = hipPeekAtLastError();
        if (le != hipSuccess) { fprintf(stderr, "kernel_launch: launch %d failed: %s\n", li, hipGetErrorName(le)); break; }
    }
}
```

```cpp
#include <hip/hip_runtime.h>
#include <cstdio>
#include <cstdint>
namespace pg8 {
#define PG8_LAS __attribute__((address_space(3)))
typedef unsigned short bf16_t;
typedef short bf16x8 __attribute__((ext_vector_type(8)));
typedef float f32x4 __attribute__((ext_vector_type(4)));
typedef unsigned u32x4 __attribute__((ext_vector_type(4)));
constexpr int BM = 256, BK = 64, HALF = 128, HTB = HALF * BK * 2  , STAGE_BYTES = 8 * HTB, NXCD = 8, WGM = 4;

__host__ __device__ __forceinline__ int lds_byte(int r, int c) { const int st = (r >> 4) * 2 + (c >> 5), rr = r & 15, cc = c & 31, ob = rr * 64 + cc * 2; return st * 1024 + (ob ^ (((ob >> 9) & 1) << 5)); }
__host__ __device__ __forceinline__ void stage_rc(int b, int& R, int& C) { const int st = b / 1024, sb = b % 1024, swz = sb ^ (((sb >> 9) & 1) << 5); R = (st >> 1) * 16 + swz / 64; C = (st & 1) * 32 + (swz % 64) / 2; }
__host__ __device__ __forceinline__ int perm32(int rho) { const int n = rho >> 4, i = rho & 15; return 8 * (i >> 2) + 4 * n + (i & 3); }

struct Unit { int pm, pn; };
struct Gemm { const bf16_t* A; const bf16_t* Bt; int M, N, K; };

struct StaticOrder {
    int nM, nN, nwg, G, c;
    __host__ __device__ void init(int M, int N, int G_, int c_) { nM = M / BM; nN = N / BM; nwg = nM * nN; G = G_; c = c_; }
    __host__ __device__ bool next(int i, Unit& u) const {
        const long L = (long)i * G + c; if (L >= nwg) return false;
        int wgid = (int)L; { const int q = nwg / NXCD, r = nwg % NXCD, xcd = wgid % NXCD, off = wgid / NXCD; wgid = (xcd < r ? xcd * (q + 1) : r * (q + 1) + (xcd - r) * q) + off; }
        const int nig = WGM * nN, gid = wgid / nig, fm = gid * WGM, gsz = (nM - fm) < WGM ? (nM - fm) : WGM;
        u.pm = fm + ((wgid % nig) % gsz); u.pn = (wgid % nig) / gsz; return true;
    }
    __device__ __forceinline__ void a_ready(const Unit&) const {}
    __device__ __forceinline__ void done(const Unit&) const {}
};

__device__ __forceinline__ unsigned cvt_pk_bf16(float lo, float hi) { unsigned r; asm volatile("v_cvt_pk_bf16_f32 %0, %1, %2" : "=v"(r) : "v"(lo), "v"(hi)); return r; }
typedef float f32x2 __attribute__((ext_vector_type(2)));
__device__ __forceinline__ f32x2 gelu_pk(f32x2 v) {
    const f32x2 av = __builtin_elementwise_abs(v), d = av * 0.2316418882f + 1.0f;
    f32x2 t; t.x = __builtin_amdgcn_rcpf(d.x); t.y = __builtin_amdgcn_rcpf(d.y);
    f32x2 q = t * 0.5307027145f + (-0.7265760135f); q = q * t + 0.7107068705f; q = q * t + (-0.142248368f); q = q * t + 0.127414796f; q = q * t;
    const f32x2 s = (v * v) * (-0.72134752044f);
    f32x2 e; e.x = __builtin_amdgcn_exp2f(s.x); e.y = __builtin_amdgcn_exp2f(s.y);
    const f32x2 m = v * (q * e), r = v - m;
    f32x2 o; o.x = v.x < 0.f ? m.x : r.x; o.y = v.y < 0.f ? m.y : r.y; return o;
}

template <int ACT  > struct EpiBf16 {
    static constexpr bool PERM = true, AFTER_DRAIN = false; static_assert(ACT == 0 || ACT == 1, "EpiBf16: ACT is 0 (none) or 1 (gelu_pk)");
    bf16_t* O; int ldc; const float* bias; int split_cols; size_t split_stride; float scale0;
    __device__ __forceinline__ void operator()(const f32x4 (&acc)[2][2][4][2], const Unit& u, int wr, int wc, int fr, int fq) const {
        const int row0 = u.pm * BM + wr * 64 + fr; int colt = u.pn * BM; bf16_t* base = O;
        float sc = 1.f; if (split_cols) { const int t = colt / split_cols; base += (size_t)t * split_stride; colt -= t * split_cols; if (t == 0) sc = scale0; }
        const int col0 = colt + wc * 32 + 8 * fq, bcol0 = u.pn * BM + wc * 32 + 8 * fq;
        f32x4 bv[2][2];
#pragma unroll
        for (int bj = 0; bj < 2; ++bj)
#pragma unroll
            for (int n = 0; n < 2; ++n) bv[bj][n] = bias ? *(const f32x4*)(bias + bcol0 + bj * HALF + 4 * n) : (f32x4){0.f, 0.f, 0.f, 0.f};
#pragma unroll
        for (int ai = 0; ai < 2; ++ai)
#pragma unroll
            for (int m = 0; m < 4; ++m) { bf16_t* rowp = base + (size_t)(row0 + ai * HALF + m * 16) * ldc + col0;
#pragma unroll
                for (int bj = 0; bj < 2; ++bj) { f32x4 v0 = acc[ai][bj][m][0] + bv[bj][0], v1 = acc[ai][bj][m][1] + bv[bj][1];
                    if (ACT == 1) { f32x2 a = gelu_pk((f32x2){v0[0], v0[1]}), b = gelu_pk((f32x2){v0[2], v0[3]}), c = gelu_pk((f32x2){v1[0], v1[1]}), d = gelu_pk((f32x2){v1[2], v1[3]});
                        v0 = (f32x4){a.x, a.y, b.x, b.y}; v1 = (f32x4){c.x, c.y, d.x, d.y}; }
                    v0 = v0 * sc; v1 = v1 * sc; u32x4 w; w.x = cvt_pk_bf16(v0[0], v0[1]); w.y = cvt_pk_bf16(v0[2], v0[3]); w.z = cvt_pk_bf16(v1[0], v1[1]); w.w = cvt_pk_bf16(v1[2], v1[3]);
                    *(u32x4*)(rowp + bj * HALF) = w; } }
    }
};
template <class Epi, class Sched, bool ALIGN_EPI = false, bool SP2 = false>
__device__ __forceinline__ void gemm_phase(PG8_LAS unsigned char* lds, const Gemm g, const Sched& S, const Epi& E) {
    const int tid = threadIdx.x, wid = __builtin_amdgcn_readfirstlane(tid >> 6), lane = tid & 63, wr = wid >> 2, wc = wid & 3, fr = lane & 15, fq = lane >> 4;
    const int K = g.K, nt = K / BK;
    unsigned voffA[2], voffB[2];
#pragma unroll
    for (int i = 0; i < 2; ++i) { int R, C; stage_rc(tid * 16 + i * 8192, R, C); const int Rb = Epi::PERM ? ((R & ~31) + perm32(R & 31)) : R;
        voffA[i] = (unsigned)(R * K + C) * 2u; voffB[i] = (unsigned)(Rb * K + C) * 2u; }
    const size_t kstep = (size_t)(BK * 2);
    const size_t hstep = (size_t)HALF * K * 2;
    const size_t tstep = 2 * hstep;
    const unsigned ldsw = (unsigned)wid * 1024u;
    const int aoff = lds_byte(wr * 64 + fr, fq * 8), boff = lds_byte(wc * 32 + fr, fq * 8);
#define PG8_SA(b, h) (((b) * 2 + (h)) * HTB)
#define PG8_SB(b, h) ((4 + (b) * 2 + (h)) * HTB)
#define PG8_STAGE(bufoff, gbase, voff) do { _Pragma("unroll") for (int _i = 0; _i < 2; ++_i) \
        __builtin_amdgcn_global_load_lds((const unsigned*)((const char*)(gbase) + (voff)[_i]), (PG8_LAS unsigned*)(lds + (bufoff) + ldsw + _i * 8192), 16, 0, 0); } while (0)
#define PG8_LDA(dst, b, h) do { _Pragma("unroll") for (int m = 0; m < 4; ++m) _Pragma("unroll") for (int k = 0; k < 2; ++k) dst[m][k] = *(const PG8_LAS bf16x8*)(lds + PG8_SA(b, h) + aoff + m * 2048 + k * 1024); } while (0)
#define PG8_LDB(dst, b, h) do { _Pragma("unroll") for (int n = 0; n < 2; ++n) _Pragma("unroll") for (int k = 0; k < 2; ++k) dst[n][k] = *(const PG8_LAS bf16x8*)(lds + PG8_SB(b, h) + boff + n * 2048 + k * 1024); } while (0)
#define PG8_MMA(ai, bj, At, Bt) do { __builtin_amdgcn_s_setprio(1); _Pragma("unroll") for (int m = 0; m < 4; ++m) _Pragma("unroll") for (int n = 0; n < 2; ++n) _Pragma("unroll") for (int k = 0; k < 2; ++k) \
        acc[ai][bj][m][n] = __builtin_amdgcn_mfma_f32_16x16x32_bf16(Bt[n][k], At[m][k], acc[ai][bj][m][n], 0, 0, 0); __builtin_amdgcn_s_setprio(0); } while (0)
#define PG8_WAIT_V(n) asm volatile("s_waitcnt vmcnt(" #n ")" ::: "memory")
#define PG8_WAIT_L(n) asm volatile("s_waitcnt lgkmcnt(" #n ")" ::: "memory")
#define PG8_BAR __builtin_amdgcn_s_barrier()
#define PG8_SCHED __builtin_amdgcn_sched_barrier(0)
    Unit cur, nxt; int ui = 0;
    if (!S.next(0, cur)) return;
    f32x4 acc[2][2][4][2];
#pragma unroll
    for (int a = 0; a < 2; ++a)
#pragma unroll
        for (int b = 0; b < 2; ++b)
#pragma unroll
            for (int m = 0; m < 4; ++m)
#pragma unroll
                for (int n = 0; n < 2; ++n) acc[a][b][m][n] = (f32x4){0.f, 0.f, 0.f, 0.f};
    bf16x8 At[4][2], B0[2][2], B1[2][2];
    const char* cA = (const char*)g.A + (size_t)cur.pm * tstep; const char* cB = (const char*)g.Bt + (size_t)cur.pn * tstep;
    S.a_ready(cur);
    if constexpr (SP2) {
        PG8_STAGE(PG8_SB(0, 0), cB, voffB); PG8_STAGE(PG8_SB(0, 1), cB + hstep, voffB); PG8_STAGE(PG8_SA(0, 0), cA, voffA); PG8_STAGE(PG8_SA(0, 1), cA + hstep, voffA);
        if (wr == 1) PG8_BAR;
        PG8_WAIT_V(2); PG8_BAR;
        PG8_STAGE(PG8_SB(1, 0), cB + kstep, voffB); PG8_STAGE(PG8_SA(1, 0), cA + kstep, voffA); PG8_STAGE(PG8_SB(1, 1), cB + hstep + kstep, voffB);
        PG8_WAIT_V(6); PG8_BAR;
    } else {
        PG8_STAGE(PG8_SB(0, 0), cB, voffB); PG8_STAGE(PG8_SA(0, 0), cA, voffA); PG8_STAGE(PG8_SB(0, 1), cB + hstep, voffB); PG8_STAGE(PG8_SA(0, 1), cA + hstep, voffA);
        if (wr == 1) PG8_BAR;
        PG8_WAIT_V(4); PG8_BAR;
        PG8_STAGE(PG8_SB(1, 0), cB + kstep, voffB); PG8_STAGE(PG8_SA(1, 0), cA + kstep, voffA); PG8_STAGE(PG8_SB(1, 1), cB + hstep + kstep, voffB);
        PG8_WAIT_V(6); PG8_BAR;
    }
    for (;;) {
        const bool has_next = S.next(ui + 1, nxt);
        const char* nA = has_next ? (const char*)g.A + (size_t)nxt.pm * tstep : cA; const char* nB = has_next ? (const char*)g.Bt + (size_t)nxt.pn * tstep : cB;
        for (int t = 0; t < nt; t += 2) {
            const bool last = (t == nt - 2);
            const char* a1 = cA + (size_t)(t + 1) * kstep;
            const char* a2 = last ? nA : cA + (size_t)(t + 2) * kstep; const char* b2 = last ? nB : cB + (size_t)(t + 2) * kstep;
            const char* a3 = a2 + kstep; const char* b3 = b2 + kstep;
            if (last && has_next) S.a_ready(nxt);
            if constexpr (SP2) {
            PG8_LDB(B0, 0, 0); PG8_LDB(B1, 0, 1); PG8_SCHED; PG8_LDA(At, 0, 0); PG8_STAGE(PG8_SA(1, 1), a1 + hstep, voffA);
            PG8_WAIT_V(8); PG8_WAIT_L(0); PG8_BAR; PG8_MMA(0, 0, At, B0); PG8_MMA(0, 1, At, B1); PG8_BAR; PG8_SCHED;
            PG8_LDA(At, 0, 1); PG8_STAGE(PG8_SB(0, 0), b2, voffB); PG8_STAGE(PG8_SB(0, 1), b2 + hstep, voffB); PG8_STAGE(PG8_SA(0, 0), a2, voffA);
            PG8_WAIT_V(8); PG8_WAIT_L(0); PG8_BAR; PG8_MMA(1, 0, At, B0); PG8_MMA(1, 1, At, B1); PG8_BAR; PG8_SCHED;
            PG8_LDB(B0, 1, 0); PG8_LDB(B1, 1, 1); PG8_SCHED; PG8_LDA(At, 1, 0); PG8_STAGE(PG8_SA(0, 1), a2 + hstep, voffA);
            PG8_WAIT_V(8); PG8_WAIT_L(0); PG8_BAR; PG8_MMA(0, 0, At, B0); PG8_MMA(0, 1, At, B1); PG8_BAR; PG8_SCHED;
            PG8_LDA(At, 1, 1); PG8_STAGE(PG8_SB(1, 0), b3, voffB); PG8_STAGE(PG8_SB(1, 1), b3 + hstep, voffB); PG8_STAGE(PG8_SA(1, 0), a3, voffA);
            PG8_WAIT_V(8); PG8_WAIT_L(0); PG8_BAR; PG8_MMA(1, 0, At, B0); PG8_MMA(1, 1, At, B1); PG8_BAR; PG8_SCHED;
            } else {
            PG8_LDB(B0, 0, 0); PG8_SCHED; PG8_LDA(At, 0, 0); PG8_STAGE(PG8_SA(1, 1), a1 + hstep, voffA);
            PG8_WAIT_L(8); PG8_BAR; PG8_WAIT_L(0); PG8_MMA(0, 0, At, B0); PG8_BAR; PG8_SCHED;
            PG8_LDB(B1, 0, 1); PG8_STAGE(PG8_SB(0, 0), b2, voffB);
            PG8_BAR; PG8_WAIT_L(0); PG8_MMA(0, 1, At, B1); PG8_BAR;
            PG8_LDA(At, 0, 1); PG8_STAGE(PG8_SA(0, 0), a2, voffA);
            PG8_BAR; PG8_WAIT_L(0); PG8_MMA(1, 0, At, B0); PG8_BAR; PG8_SCHED;
            PG8_STAGE(PG8_SB(0, 1), b2 + hstep, voffB);
            PG8_WAIT_V(6); PG8_BAR; PG8_MMA(1, 1, At, B1); PG8_BAR;
            PG8_LDB(B0, 1, 0); PG8_SCHED; PG8_LDA(At, 1, 0); PG8_STAGE(PG8_SA(0, 1), a2 + hstep, voffA);
            PG8_WAIT_L(8); PG8_BAR; PG8_WAIT_L(0); PG8_MMA(0, 0, At, B0); PG8_BAR; PG8_SCHED;
            PG8_LDB(B1, 1, 1); PG8_STAGE(PG8_SB(1, 0), b3, voffB);
            PG8_BAR; PG8_WAIT_L(0); PG8_MMA(0, 1, At, B1); PG8_BAR;
            PG8_LDA(At, 1, 1); PG8_STAGE(PG8_SA(1, 0), a3, voffA);
            PG8_BAR; PG8_WAIT_L(0); PG8_MMA(1, 0, At, B0); PG8_BAR; PG8_SCHED;
            PG8_STAGE(PG8_SB(1, 1), b3 + hstep, voffB);
            PG8_WAIT_V(6); PG8_BAR; PG8_MMA(1, 1, At, B1); PG8_BAR;
            }
        }
        if constexpr (ALIGN_EPI) { if (wr == 0) PG8_BAR; }
        if constexpr (!Epi::AFTER_DRAIN) { E(acc, cur, wr, wc, fr, fq); S.done(cur); }
        else { if (has_next) { E(acc, cur, wr, wc, fr, fq); S.done(cur); } }
        if (!has_next) break;
#pragma unroll
        for (int a = 0; a < 2; ++a)
#pragma unroll
            for (int b = 0; b < 2; ++b)
#pragma unroll
                for (int m = 0; m < 4; ++m)
#pragma unroll
                    for (int n = 0; n < 2; ++n) acc[a][b][m][n] = (f32x4){0.f, 0.f, 0.f, 0.f};
        cur = nxt; cA = nA; cB = nB; ++ui;
        if constexpr (ALIGN_EPI) { if (wr == 1) PG8_BAR; }
    }
    PG8_WAIT_V(0);
    if constexpr (!ALIGN_EPI) { if (wr == 0) PG8_BAR; }
    PG8_BAR;
    if constexpr (Epi::AFTER_DRAIN) { E.fused(acc, cur, wr, wc, fr, fq, lds, wid, lane); S.done(cur); }
#undef PG8_SA
#undef PG8_SB
#undef PG8_STAGE
#undef PG8_LDA
#undef PG8_LDB
#undef PG8_MMA
#undef PG8_WAIT_V
#undef PG8_WAIT_L
#undef PG8_BAR
#undef PG8_SCHED
}
}

#ifndef PG8_SP2
#define PG8_SP2 true
#endif
#ifndef PG8_ALIGN
#define PG8_ALIGN true
#endif
#define GAS __attribute__((address_space(1)))
#define LAS __attribute__((address_space(3)))
typedef unsigned short bf16;
typedef unsigned v4u __attribute__((ext_vector_type(4)));
typedef float f32x4 __attribute__((ext_vector_type(4)));
typedef short bf16x8 __attribute__((ext_vector_type(8)));
typedef GAS unsigned gu32;
typedef GAS unsigned long long gu64;
#define RLX_AGENT __ATOMIC_RELAXED, __HIP_MEMORY_SCOPE_AGENT
#define LDS_WAIT() asm volatile("s_waitcnt lgkmcnt(0)" ::: "memory")
#define VM_WAIT() asm volatile("s_waitcnt vmcnt(0)" ::: "memory")
__device__ __forceinline__ unsigned long long rt() { return __builtin_amdgcn_s_memrealtime(); }
__device__ __forceinline__ unsigned f2bf(float f) { unsigned u = __builtin_bit_cast(unsigned, f); return (u + 0x7fffu + ((u >> 16) & 1u)) >> 16; }
__device__ __forceinline__ unsigned pk2(float lo, float hi) { return f2bf(lo) | (f2bf(hi) << 16); }

#define XB_TMO      128
#define XB_XCNT(j)  (256  + 64 * (j))
#define XB_XSUB(j)  (1280 + 64 * (j))
#define XB_XGEN(j)  (2304 + 64 * (j))
#define XB_TOP      3328
#define XB_TOPGEN   3392
#define XCD_BAR_WORDS 3456
#define XB_SPIN_CAP (1u << 18)

__device__ __forceinline__ unsigned xb_ld(unsigned* p)              { return __hip_atomic_load(p, __ATOMIC_RELAXED, __HIP_MEMORY_SCOPE_AGENT); }
__device__ __forceinline__ unsigned xb_add(unsigned* p, unsigned v) { return __hip_atomic_fetch_add(p, v, __ATOMIC_RELAXED, __HIP_MEMORY_SCOPE_AGENT); }
__device__ __forceinline__ unsigned xb_xcc_id() { return (unsigned)__builtin_amdgcn_s_getreg((3 << 11) | 20) & 0xFu; }
#define XB_SPIN(cond, bar) do { unsigned _sp = 0; while (cond) { __builtin_amdgcn_s_sleep(1); \
    if ((++_sp & 255u) == 0u) { if (xb_ld(&(bar)[XB_TMO])) break; if (_sp > XB_SPIN_CAP) { atomicAdd(&(bar)[XB_TMO], 1u); break; } } } } while (0)

struct XcdBarrier {
    unsigned* bar; unsigned x;
    volatile LAS unsigned* st;
};

__device__ __forceinline__ XcdBarrier xcd_barrier_post(unsigned* bar, volatile LAS unsigned* st) {
    XcdBarrier b; b.bar = bar; b.x = xb_xcc_id(); b.st = st;
    if (threadIdx.x == 0) (void)xb_add(&bar[XB_XCNT(b.x)], 1u);
    return b;
}
__device__ __forceinline__ void xcd_barrier_complete(unsigned* bar, unsigned x, unsigned& nloc, unsigned& nx) {
    const unsigned G = gridDim.x * gridDim.y * gridDim.z;
    unsigned sum, cnt, mine, sp = 0u;
    for (;;) {
        sum = 0u; cnt = 0u; mine = 0u;
#pragma unroll
        for (unsigned j = 0; j < 16; ++j) { const unsigned c = xb_ld(&bar[XB_XCNT(j)]); sum += c; cnt += (c > 0u) ? 1u : 0u; mine = (j == x) ? c : mine; }
        if (sum == G) break;
        __builtin_amdgcn_s_sleep(1);
        if ((++sp & 255u) == 0u) { if (xb_ld(&bar[XB_TMO])) break; if (sp > XB_SPIN_CAP) { atomicAdd(&bar[XB_TMO], 1u); break; } }
    }
    nloc = mine > 0u ? mine : 1u; nx = cnt > 0u ? cnt : 1u;
}

__device__ __forceinline__ void xcd_barrier(const XcdBarrier& b) {
    asm volatile("s_waitcnt vmcnt(0)" ::: "memory");
    __syncthreads();
    if (threadIdx.x == 0) {
        unsigned* bar = b.bar;
        __builtin_amdgcn_s_waitcnt(0);
        unsigned nloc = b.st[0], nx = b.st[1];
        if (nloc == 0u) { xcd_barrier_complete(bar, b.x, nloc, nx); b.st[0] = nloc; b.st[1] = nx; }
        const unsigned old = xb_add(&bar[XB_XSUB(b.x)], 1u);
        const unsigned gen = old / nloc;
        if (old + 1u == (gen + 1u) * nloc) {
            __builtin_amdgcn_fence(__ATOMIC_RELEASE, "agent");
            asm volatile("s_waitcnt vmcnt(0)" ::: "memory");
            const unsigned og = xb_add(&bar[XB_TOP], 1u);
            const unsigned tg = og / nx;
            if (og + 1u == (tg + 1u) * nx) xb_add(&bar[XB_TOPGEN], 1u);
            else XB_SPIN(xb_ld(&bar[XB_TOPGEN]) == tg, bar);
            __builtin_amdgcn_fence(__ATOMIC_ACQUIRE, "agent");
            xb_add(&bar[XB_XGEN(b.x)], 1u);
            asm volatile("s_waitcnt vmcnt(0)" ::: "memory");
        } else {
            XB_SPIN(xb_ld(&bar[XB_XGEN(b.x)]) == gen, bar);
            __builtin_amdgcn_fence(__ATOMIC_ACQUIRE, "agent");
            asm volatile("s_waitcnt vmcnt(0)" ::: "memory");
        }
    }
    __syncthreads();
}
constexpr int NWAVES = 8, NT = NWAVES * 64;
constexpr int BATCH = 4, SEQ = 4096, DM = 2048, CTXL = 256;
constexpr int MX = BATCH * SEQ, MC = BATCH * CTXL, MALL = MX + MC;
constexpr int WA = 1024, WB = 1024, NIN = 10256, NU = 10496;
constexpr int C_AQ = 0, C_AFF = 1024, C_AFB = 2048, C_AI = 3072, C_AZ = 4096, C_BQK = 5120, C_BV = 7168, C_BO = 8192, C_BZ = 9216, C_BG = 10240;
constexpr int HGH = 8, HGD = 128, MLH = 4, MLD = 256;
constexpr float ALPHA = 1.189207115002721f;
constexpr float LN_EPS = 1e-5f, NORM_EPS = 1e-6f;
constexpr int NMOD = 3 * DM;

#ifndef MK_N_LAUNCHES
#define MK_N_LAUNCHES 1
#endif
constexpr int N_PHASES = 8;

constexpr size_t MiB = 1u << 20;
constexpr size_t WS_CTL = 0, CTL_ZERO_BYTES = 1 * MiB;
constexpr size_t WS_MODP = 1 * MiB;
constexpr size_t WS_GATE = 3 * MiB;
constexpr size_t WS_WINT = 4 * MiB;
constexpr size_t WS_WOUTT = 45 * MiB;
constexpr size_t WS_XN = 53 * MiB;
constexpr size_t WS_U = 121 * MiB;
constexpr size_t WS_PE = 470 * MiB, WS_MLS = 473 * MiB, WS_DEC = 478 * MiB;
constexpr size_t WS_MLW = 479 * MiB;
constexpr size_t WS_DQP = 496 * MiB;
constexpr size_t WS_XB = 498 * MiB;
constexpr size_t WS_END = 502 * MiB;
static_assert(WS_WINT + (size_t)NU * DM * 2 <= WS_WOUTT && WS_WOUTT + (size_t)DM * DM * 2 <= WS_XN && WS_XN + (size_t)MALL * DM * 2 <= WS_U && WS_U + (size_t)MALL * NU * 2 <= WS_END, "d_ws map");
constexpr int CW_TMO = 0, CW_BAR = 4096, CW_PANEL = 16384;

constexpr int RING_OFF = 0, RING_BYTES = 131072;
constexpr int LDS_BYTES = 163840;
constexpr int LDSCTL_OFF = LDS_BYTES - 1024, MISC_OFF = LDSCTL_OFF + 320;

struct Frame {
    LAS unsigned char* lds;
    volatile LAS unsigned* MISC;
    gu32* ctl;
    int tid, lane, wave, vcu, G;
    const float *x, *c, *ctx, *c_ctx, *w_mod, *b_mod, *w_in, *conv_w, *conv_b, *hg_lb, *ml_gate_b, *hg_norm_w, *ml_norm_w, *w_out, *ln_g, *ln_b;
    float* out;
    float *modp, *gate;
    bf16 *WinT, *WoutT, *XN, *U;
    bf16 *QTF, *MLW; float *PE, *MLS, *DEC, *DQP;
    bf16 *OAF, *OAB, *HBF, *HBB;
};

typedef float f32x2_t __attribute__((ext_vector_type(2)));
#define LDS_BARRIER() do { asm volatile("s_waitcnt lgkmcnt(0)" ::: "memory"); __builtin_amdgcn_s_barrier(); asm volatile("" ::: "memory"); } while (0)
typedef __bf16 bf16x2_t __attribute__((ext_vector_type(2)));
__device__ __forceinline__ unsigned pkbf(float a, float b) { const f32x2_t v = {a, b}; return __builtin_bit_cast(unsigned, __builtin_convertvector(v, bf16x2_t)); }
__device__ __forceinline__ float bf2f(unsigned short u) { return __builtin_bit_cast(float, (unsigned)u << 16); }
__device__ __forceinline__ float lo2f(unsigned u) { return __builtin_bit_cast(float, u << 16); }
__device__ __forceinline__ float hi2f(unsigned u) { return __builtin_bit_cast(float, u & 0xffff0000u); }
__device__ __forceinline__ float siluf(float v) { return v / (1.f + __expf(-v)); }
__device__ __forceinline__ float sigmf(float v) { return 1.f / (1.f + __expf(-v)); }
__device__ __forceinline__ float wave_sum(float v) {
#pragma unroll
    for (int o = 1; o < 64; o <<= 1) v += __shfl_xor(v, o);
    return v;
}

__device__ __forceinline__ void transpose_item(const float* W, int ldw, int nvalid, int K, bf16* WT, LAS float* scr, int kb, int nb, int lane) {
    const int k0 = 64 * kb, n0 = 32 * nb; const int n_l = n0 + (lane & 31);
#pragma unroll 8
    for (int i = 0; i < 32; ++i) { const int kk = 2 * i + (lane >> 5); scr[kk * 33 + (lane & 31)] = n_l < nvalid ? W[(size_t)(k0 + kk) * ldw + n_l] : 0.f; }
    LDS_WAIT(); asm volatile("" ::: "memory");
    const int c = lane & 7;
#pragma unroll
    for (int j = 0; j < 4; ++j) { const int n = (lane >> 3) + 8 * j; const LAS float* s = scr + (8 * c) * 33 + n;
        v4u o; o.x = pk2(s[0 * 33], s[1 * 33]); o.y = pk2(s[2 * 33], s[3 * 33]); o.z = pk2(s[4 * 33], s[5 * 33]); o.w = pk2(s[6 * 33], s[7 * 33]);
        *(GAS v4u*)(WT + (size_t)(n0 + n) * K + k0 + 8 * c) = o; }
    LDS_WAIT(); asm volatile("" ::: "memory");
}
constexpr int KS2 = 2;
__device__ __forceinline__ void p0_prep(Frame& F) {
    LAS float* scr = (LAS float*)(F.lds + RING_OFF + F.wave * 16384);
    LAS float* red = (LAS float*)(F.lds + RING_OFF + 131072);
    for (int it = F.vcu; it < (NMOD / 64) * KS2; it += F.G) {
        const int cg = it >> 1, kh2 = it & 1, n = cg * 64 + F.lane, k0 = kh2 * 1024 + F.wave * 128;
#pragma unroll
        for (int rr = 0; rr < 5; ++rr)
#pragma unroll
            for (int j = 0; j < 2; ++j) { const int k = k0 + F.lane + 64 * j; const float v = rr < 4 ? F.c[rr * DM + k] : F.c_ctx[k]; scr[rr * 128 + F.lane + 64 * j] = siluf(v); }
        LDS_WAIT(); asm volatile("" ::: "memory");
        float a0 = 0.f, a1 = 0.f, a2 = 0.f, a3 = 0.f, a4 = 0.f;
#pragma unroll 16
        for (int k = 0; k < 128; ++k) { const float w = F.w_mod[(size_t)(k0 + k) * NMOD + n];
            a0 += scr[k] * w; a1 += scr[128 + k] * w; a2 += scr[256 + k] * w; a3 += scr[384 + k] * w; a4 += scr[512 + k] * w; }
        LAS float* rp = red + F.wave * 320 + F.lane; rp[0] = a0; rp[64] = a1; rp[128] = a2; rp[192] = a3; rp[256] = a4;
        __syncthreads();
        if (F.tid < 320) { float sacc = 0.f;
#pragma unroll
            for (int ww = 0; ww < 8; ++ww) sacc += red[ww * 320 + F.tid];
            const int rr = F.tid >> 6, nn = cg * 64 + (F.tid & 63);
            F.modp[((size_t)kh2 * 5 + rr) * NMOD + nn] = sacc + (kh2 == 0 ? F.b_mod[nn] : 0.f); }
        __syncthreads();
    }
    const int gw = F.vcu * NWAVES + F.wave, NGW = F.G * NWAVES;
    constexpr int NB_IN = NU / 32, I_IN = (DM / 64) * NB_IN, NB_OUT = DM / 32, I_OUT = (DM / 64) * NB_OUT;
    for (int it = gw; it < I_IN + I_OUT; it += NGW) {
        int r = it;
        if (r < I_IN) { transpose_item(F.w_in, NIN, NIN, DM, F.WinT, scr, r / NB_IN, r % NB_IN, F.lane); continue; } r -= I_IN;
        transpose_item(F.w_out, DM, DM, DM, F.WoutT, scr, r / NB_OUT, r % NB_OUT, F.lane);
    }
}

__device__ __forceinline__ void ln_mod_row2(Frame& F, const float* xa, const float* xb, bf16* oa, bf16* ob, const LAS float* shift, const LAS float* scale) {
    const GAS f32x4* ra = (const GAS f32x4*)xa + F.lane; const GAS f32x4* rb = (const GAS f32x4*)xb + F.lane;
    f32x4 va[8], vb[8]; float sa = 0.f, sb = 0.f;
#pragma unroll
    for (int j = 0; j < 8; ++j) { va[j] = ra[64 * j]; vb[j] = rb[64 * j]; }
#pragma unroll
    for (int j = 0; j < 8; ++j) { sa += (va[j].x + va[j].y) + (va[j].z + va[j].w); sb += (vb[j].x + vb[j].y) + (vb[j].z + vb[j].w); }
    const float ma = wave_sum(sa) * (1.f / DM), mb = wave_sum(sb) * (1.f / DM); float qa = 0.f, qb = 0.f;
#pragma unroll
    for (int j = 0; j < 8; ++j) { va[j] = va[j] - ma; vb[j] = vb[j] - mb; qa += (va[j].x * va[j].x + va[j].y * va[j].y) + (va[j].z * va[j].z + va[j].w * va[j].w); qb += (vb[j].x * vb[j].x + vb[j].y * vb[j].y) + (vb[j].z * vb[j].z + vb[j].w * vb[j].w); }
    const float rsa = 1.f / sqrtf(wave_sum(qa) * (1.f / DM) + LN_EPS), rsb = 1.f / sqrtf(wave_sum(qb) * (1.f / DM) + LN_EPS);
    GAS unsigned long long* o8a = (GAS unsigned long long*)oa + F.lane; GAS unsigned long long* o8b = (GAS unsigned long long*)ob + F.lane;
#pragma unroll
    for (int j = 0; j < 8; ++j) { const int k = 4 * F.lane + 256 * j; const f32x4 sc = *(const LAS f32x4*)(scale + k) + 1.f, sh = *(const LAS f32x4*)(shift + k);
        const f32x4 ha = va[j] * rsa * sc + sh, hb = vb[j] * rsb * sc + sh;
        o8a[64 * j] = (unsigned long long)pk2(ha.x, ha.y) | ((unsigned long long)pk2(ha.z, ha.w) << 32);
        o8b[64 * j] = (unsigned long long)pk2(hb.x, hb.y) | ((unsigned long long)pk2(hb.z, hb.w) << 32); }
}
__device__ __forceinline__ void ln_mod_row(Frame& F, const float* xrow, bf16* orow, const LAS float* shift, const LAS float* scale) {
    const GAS f32x4* xr = (const GAS f32x4*)xrow + F.lane;
    f32x4 v[8]; float s = 0.f;
#pragma unroll
    for (int j = 0; j < 8; ++j) { v[j] = xr[64 * j]; s += (v[j].x + v[j].y) + (v[j].z + v[j].w); }
    const float mean = wave_sum(s) * (1.f / DM); float s2 = 0.f;
#pragma unroll
    for (int j = 0; j < 8; ++j) { v[j] = v[j] - mean; s2 += (v[j].x * v[j].x + v[j].y * v[j].y) + (v[j].z * v[j].z + v[j].w * v[j].w); }
    const float rstd = 1.f / sqrtf(wave_sum(s2) * (1.f / DM) + LN_EPS);
    GAS unsigned long long* o8 = (GAS unsigned long long*)orow + F.lane;
#pragma unroll
    for (int j = 0; j < 8; ++j) { const int k = 4 * F.lane + 256 * j; const f32x4 sc = *(const LAS f32x4*)(scale + k), sh = *(const LAS f32x4*)(shift + k);
        const f32x4 h = v[j] * rstd * (sc + 1.f) + sh;
        o8[64 * j] = (unsigned long long)pk2(h.x, h.y) | ((unsigned long long)pk2(h.z, h.w) << 32); }
}
__device__ __forceinline__ void p1_lnmod(Frame& F) {
    LAS float* md = (LAS float*)(F.lds + RING_OFF);
    for (int e = F.vcu * NT + F.tid; e < BATCH * DM; e += F.G * NT) { const int b = e / DM, n = e % DM;
        F.gate[e] = F.modp[(size_t)b * NMOD + 2 * DM + n] + F.modp[((size_t)5 + b) * NMOD + 2 * DM + n]; }
    for (int blk = F.vcu; blk < 256; blk += F.G) {
        const int b = blk >> 6;
        __syncthreads();
        { float m0v[16], m1v[16];
#pragma unroll
          for (int i = 0; i < 16; ++i) { const int e = F.tid + NT * i; const int row = e < 2 * DM ? b : 4, col = e & (2 * DM - 1); m0v[i] = F.modp[(size_t)row * NMOD + col]; m1v[i] = F.modp[((size_t)5 + row) * NMOD + col]; }
#pragma unroll
          for (int i = 0; i < 16; ++i) md[F.tid + NT * i] = m0v[i] + m1v[i]; }
        __syncthreads();
#pragma unroll 1
        for (int r = 0; r < 8; r += 2) { const int m = blk * 64 + F.wave * 8 + r;
            ln_mod_row2(F, F.x + (size_t)m * DM, F.x + (size_t)(m + 1) * DM, F.XN + (size_t)m * DM, F.XN + (size_t)(m + 1) * DM, md, md + DM); }
        if (F.wave < 4) { const int m = blk * 4 + F.wave; ln_mod_row(F, F.ctx + (size_t)m * DM, F.XN + (size_t)(MX + m) * DM, md + 2 * DM, md + 3 * DM); }
    }
}

__device__ __forceinline__ float rcpf_(float v) { return __builtin_amdgcn_rcpf(v); }
__device__ __forceinline__ float silu_fast(float v) { return v * rcpf_(1.f + __expf(-v)); }
__device__ __forceinline__ void conv_acc8(float (&acc)[8], const v4u u, const f32x4 wa, const f32x4 wb) {
    acc[0] += lo2f(u.x) * wa.x; acc[1] += hi2f(u.x) * wa.y; acc[2] += lo2f(u.y) * wa.z; acc[3] += hi2f(u.y) * wa.w;
    acc[4] += lo2f(u.z) * wb.x; acc[5] += hi2f(u.z) * wb.y; acc[6] += lo2f(u.w) * wb.z; acc[7] += hi2f(u.w) * wb.w;
}
constexpr int NSC = 4;
__device__ __forceinline__ void p3_conv(Frame& F) {
    bf16* QKM = F.XN;
    if (F.G > 2 * NSC && F.vcu < NSC) return;
    const int wk = F.G > 2 * NSC ? F.vcu - NSC : F.vcu, NW = F.G > 2 * NSC ? F.G - NSC : F.G;
    const int gw = wk * NWAVES + F.wave, NGW = NW * NWAVES;
    const int cq = gw & 3, ch = cq * 512 + F.lane * 8;
    f32x4 wa[9], wb[9];
#pragma unroll
    for (int t = 0; t < 9; ++t) { wa[t] = *(const GAS f32x4*)(F.conv_w + t * 2048 + ch); wb[t] = *(const GAS f32x4*)(F.conv_w + t * 2048 + ch + 4); }
    const f32x4 ba = *(const GAS f32x4*)(F.conv_b + ch), bb = *(const GAS f32x4*)(F.conv_b + ch + 4);
    const float sc = ch >= 1024 ? 0.0625f : 1.f;
    constexpr int NLAT = BATCH * 64 * 16, NCTX = BATCH * (CTXL / 4);
    int it0 = gw >> 2, it1 = NLAT + NCTX, its = NGW >> 2;
    if (NW == 252) { const int j = wk - 80; const int lo = wk < 80 ? 8 * wk : 640 + (j < 100 ? 22 * j : 2200 + 21 * (j - 100)); const int len = wk < 80 ? 8 : (j < 100 ? 22 : 21);
        it0 = lo + (F.wave >> 2); it1 = lo + len; its = 2; }
    for (int it = it0; it < it1; it += its) {
        const v4u zero4 = {0u, 0u, 0u, 0u};
        if (it < NLAT) {
            const int b = it >> 10, r = (it >> 4) & 63, c0 = (it & 15) * 4;
            v4u in[3][6];
#pragma unroll
            for (int dr = 0; dr < 3; ++dr)
#pragma unroll
                for (int j = 0; j < 6; ++j) { const int rr = r + dr - 1, cc = c0 + j - 1; const bool ok = rr >= 0 && rr < 64 && cc >= 0 && cc < 64;
                    in[dr][j] = ok ? *(const GAS v4u*)(F.U + (size_t)(b * SEQ + rr * 64 + cc) * NU + C_BQK + ch) : zero4; }
#pragma unroll
            for (int o = 0; o < 4; ++o) {
                float acc[8] = {ba.x, ba.y, ba.z, ba.w, bb.x, bb.y, bb.z, bb.w};
#pragma unroll
                for (int dr = 0; dr < 3; ++dr)
#pragma unroll
                    for (int dc = 0; dc < 3; ++dc) conv_acc8(acc, in[dr][o + dc], wa[dr * 3 + dc], wb[dr * 3 + dc]);
#pragma unroll
                for (int j = 0; j < 8; ++j) acc[j] = silu_fast(acc[j]) * sc;
                v4u ov; ov.x = pk2(acc[0], acc[1]); ov.y = pk2(acc[2], acc[3]); ov.z = pk2(acc[4], acc[5]); ov.w = pk2(acc[6], acc[7]);
                *(GAS v4u*)(QKM + (size_t)(b * SEQ + r * 64 + c0 + o) * DM + ch) = ov;
            }
        } else {
            const int ic = it - NLAT, b = ic >> 6, t0 = (ic & 63) * 4;
            v4u in[6];
#pragma unroll
            for (int j = 0; j < 6; ++j) { const int tt = t0 + j - 1; in[j] = (tt >= 0 && tt < CTXL) ? *(const GAS v4u*)(F.U + (size_t)(MX + b * CTXL + tt) * NU + C_BQK + ch) : zero4; }
#pragma unroll
            for (int o = 0; o < 4; ++o) {
                float acc[8] = {ba.x, ba.y, ba.z, ba.w, bb.x, bb.y, bb.z, bb.w};
#pragma unroll
                for (int dc = 0; dc < 3; ++dc) conv_acc8(acc, in[o + dc], wa[3 + dc], wb[3 + dc]);
#pragma unroll
                for (int j = 0; j < 8; ++j) acc[j] = silu_fast(acc[j]) * sc;
                v4u ov; ov.x = pk2(acc[0], acc[1]); ov.y = pk2(acc[2], acc[3]); ov.z = pk2(acc[4], acc[5]); ov.w = pk2(acc[6], acc[7]);
                *(GAS v4u*)(QKM + (size_t)(MX + b * CTXL + t0 + o) * DM + ch) = ov;
            }
        }
    }
}

__device__ __forceinline__ int scan_row(int b, int dirn, int nb, int i) {
    if (nb < 16) { const int p = nb * 16 + i; const int t = dirn ? (CTXL - 1 - p) : p; return MX + b * CTXL + t; }
    const int p = (nb - 16) * 16 + i; const int t = dirn ? (SEQ - 1 - p) : p; return b * SEQ + t;
}
__device__ __forceinline__ void p4_hgrn2_task(Frame& F, int task) {
    const int vs = task & 3, dirn = (task >> 2) & 1, h = (task >> 3) & 7, b = task >> 6;
    LAS float* Fg = (LAS float*)(F.lds);
    LAS float* Kg = Fg + 2048, *Qg = Kg + 2048;
    LAS float* Vg = Qg + 2048;
    LAS float* LB = Vg + 512;
    LAS float* P = LB + 128;
    const int v = F.tid & 31, kg = F.tid >> 5, k0 = kg * 8;
    const int zcol = (dirn ? C_AFB : C_AFF) + h * HGD;
    __syncthreads();
    if (F.tid < 128) { const int col = h * HGD + F.tid; LB[F.tid] = sigmf(F.hg_lb[(dirn * 2 + 0) * WA + col] - F.hg_lb[(dirn * 2 + 1) * WA + col]); }
    __syncthreads();
    float S[8];
#pragma unroll
    for (int j = 0; j < 8; ++j) S[j] = 0.f;
    bf16* O = dirn ? F.OAB : F.OAF;
#pragma unroll 1
    for (int nb = 0; nb < 16 + 256; ++nb) {
        const bool lat = nb >= 16;
#pragma unroll
        for (int j = 0; j < 4; ++j) { const int e = F.tid + NT * j, i = e >> 7, k = e & 127; const int row = scan_row(b, dirn, nb, i);
            const float z = bf2f(F.U[(size_t)row * NU + zcol + k]); const float lb = LB[k]; const float f = lb + (1.f - lb) * sigmf(z);
            Fg[e] = f; Kg[e] = 1.f - f; Qg[e] = lat ? siluf(bf2f(F.U[(size_t)row * NU + C_AQ + h * HGD + k])) : 0.f; }
        { const int i = F.tid >> 5; const int row = scan_row(b, dirn, nb, i); Vg[F.tid] = bf2f(F.U[(size_t)row * NU + C_AI + h * HGD + vs * 32 + v]); }
        __syncthreads();
#pragma unroll 2
        for (int i = 0; i < 16; ++i) { const float vv = Vg[i * 32 + v]; float a = 0.f;
#pragma unroll
            for (int j = 0; j < 8; ++j) { S[j] = Fg[i * 128 + k0 + j] * S[j] + Kg[i * 128 + k0 + j] * vv; a += S[j] * Qg[i * 128 + k0 + j]; }
            P[(kg * 16 + i) * 32 + v] = a; }
        __syncthreads();
        if (lat) { const int i = F.tid >> 5; float o = 0.f;
#pragma unroll
            for (int g = 0; g < 16; ++g) o += P[(g * 16 + i) * 32 + v];
            const int row = scan_row(b, dirn, nb, i);
            O[(size_t)row * WA + h * HGD + vs * 32 + v] = (bf16)f2bf(o); }
    }
}
__device__ __forceinline__ void p4_mlstm_task(Frame& F, int task) {
    const int vs = task & 7, dirn = (task >> 3) & 1, h = (task >> 4) & 3, b = task >> 6;
    const bf16* QKM = F.XN;
    LAS float* Kb = (LAS float*)(F.lds);
    LAS float* Qb = Kb + 4096;
    LAS float* Vb = Qb + 4096;
    LAS float* LI = Vb + 512, *LF = LI + 16, *EM = LF + 16;
    LAS float* PD = EM + 16;
    LAS float* P = PD + 256;
    const int v = F.tid & 31, kg = F.tid >> 5, k0 = kg * 16;
    float C[16], nn[16]; float m = 0.f;
#pragma unroll
    for (int j = 0; j < 16; ++j) { C[j] = 0.f; nn[j] = 0.f; }
    bf16* O = dirn ? F.HBB : F.HBF;
    const float gbi = F.ml_gate_b[dirn * 4 + h], gbf = F.ml_gate_b[(2 + dirn) * 4 + h];
#pragma unroll 1
    for (int nb = 0; nb < 16 + 256; ++nb) {
        const bool lat = nb >= 16;
        __syncthreads();
#pragma unroll
        for (int j = 0; j < 8; ++j) { const int e = F.tid + NT * j, i = e >> 8, k = e & 255; const int row = scan_row(b, dirn, nb, i);
            Kb[e] = bf2f(QKM[(size_t)row * DM + 1024 + h * MLD + k]); Qb[e] = lat ? bf2f(QKM[(size_t)row * DM + h * MLD + k]) : 0.f; }
        { const int i = F.tid >> 5; const int row = scan_row(b, dirn, nb, i); Vb[F.tid] = bf2f(F.U[(size_t)row * NU + C_BV + h * MLD + vs * 32 + v]); }
        if (F.tid < 16) { const int row = scan_row(b, dirn, nb, F.tid);
            const float gi = bf2f(F.U[(size_t)row * NU + C_BG + dirn * 4 + h]) + gbi, gf = bf2f(F.U[(size_t)row * NU + C_BG + (2 + dirn) * 4 + h]) + gbf;
            LI[F.tid] = gi; LF[F.tid] = gf > 0.f ? -log1pf(__expf(-gf)) : gf - log1pf(__expf(gf)); }
        __syncthreads();
#pragma unroll 2
        for (int i = 0; i < 16; ++i) {
            const float lf = LF[i], li = LI[i]; const float mn = fmaxf(lf + m, li); const float fd = __expf(lf + m - mn), iw = __expf(li - mn); m = mn;
            if (F.tid == 0) EM[i] = __expf(-m);
            const float vv = iw * Vb[i * 32 + v]; float a = 0.f, d = 0.f;
#pragma unroll
            for (int j = 0; j < 16; ++j) { const float kk = Kb[i * 256 + k0 + j], qq = Qb[i * 256 + k0 + j];
                C[j] = fd * C[j] + vv * kk; nn[j] = fd * nn[j] + iw * kk; a += C[j] * qq; d += nn[j] * qq; }
            P[(kg * 16 + i) * 32 + v] = a; if (v == 0) PD[kg * 16 + i] = d; }
        __syncthreads();
        if (lat) { const int i = F.tid >> 5; float num = 0.f, den = 0.f;
#pragma unroll
            for (int g = 0; g < 16; ++g) { num += P[(g * 16 + i) * 32 + v]; den += PD[g * 16 + i]; }
            const int row = scan_row(b, dirn, nb, i);
            O[(size_t)row * WB + h * MLD + vs * 32 + v] = (bf16)f2bf(num / fmaxf(fabsf(den), EM[i])); }
    }
}
__device__ __forceinline__ void p4_scan_naive(Frame& F) {
    for (int task = F.vcu; task < 512; task += F.G) { if (task < 256) p4_hgrn2_task(F, task); else p4_mlstm_task(F, task - 256); }
}

constexpr int NCHUNK = MALL / 64;
__device__ __forceinline__ void gate_fk(float z, float lb, float& f, float& kk) {
    const float e = __expf(-fabsf(z)); const float rb = 1.f / (1.f + e), rs = e * rb;
    const float sg = z >= 0.f ? rb : rs, sn = z >= 0.f ? rs : rb;
    f = lb + (1.f - lb) * sg; kk = (1.f - lb) * sn;
}
template <int DIR>
__device__ __forceinline__ float hg_walk(LAS unsigned char* L, int cl, float lb, float olb, unsigned (&qb)[32]) {
    constexpr int TQ = 0, TZF = 32768, TZB = 65536, TQF = 98304;
    LAS unsigned short* zt = (LAS unsigned short*)(L + (DIR ? TZB : TZF)) + cl;
    const LAS unsigned short* qtile = (const LAS unsigned short*)(L + TQ) + cl;
    LAS unsigned short* qf = (LAS unsigned short*)(L + TQF) + cl;
    float P = 1.f;
#pragma unroll
    for (int blk = 0; blk < 4; ++blk) {
        unsigned short zr[16], qr[16];
#pragma unroll
        for (int j = 0; j < 16; ++j) { const int pp = blk * 16 + j, p = DIR ? 63 - pp : pp; zr[j] = zt[p * 256]; qr[j] = qtile[p * 256]; }
#pragma unroll
        for (int j = 0; j < 16; ++j) { const int pp = blk * 16 + j, p = DIR ? 63 - pp : pp;
            const float z = bf2f(zr[j]), q = bf2f(qr[j]);
            const float e = __expf(-fabsf(z)); const float rbig = rcpf_(1.f + e), rsm = e * rbig;
            const float sg = z >= 0.f ? rbig : rsm, sn = z >= 0.f ? rsm : rbig;
            const float f = lb + olb * sg, kk = olb * sn; P *= f;
            const float qt = silu_fast(q) * P, kt = kk * rcpf_(P);
            zt[p * 256] = (unsigned short)(pkbf(kt, 0.f) & 0xffffu);
            const unsigned qh = pkbf(qt, 0.f) & 0xffffu;
            if (DIR) { if (pp & 1) qb[pp >> 1] |= qh << 16; else qb[pp >> 1] = qh; } else qf[p * 256] = (unsigned short)qh; }
    }
    return P;
}
template <bool DUMMY>
__device__ __forceinline__ void p3_hg_prep(Frame& F) {
    bf16* dq = F.OAF; bf16* dkf = F.OAB; bf16* dkb = F.HBF;
    LAS unsigned char* L = F.lds;
    constexpr int TQ = 0, TZF = 32768, TZB = 65536, TQF = 98304;
    const int tid = F.tid, dirn = F.wave >> 2, cl = tid & 255;
    if (F.G > 2 * NSC && F.vcu < NSC) return;
    const int wk = F.G > 2 * NSC ? F.vcu - NSC : F.vcu, NW = F.G > 2 * NSC ? F.G - NSC : F.G;
    v4u pre[3][4];
    auto issue = [&](int it) { const int cid = it >> 2, cb = (it & 3) * 256; const size_t row0 = (size_t)cid * 64;
#pragma unroll
        for (int i = 0; i < 4; ++i) { const int piece = tid + NT * i, row = piece >> 5, c16 = piece & 31; const bf16* ur = F.U + (row0 + row) * NU + cb + c16 * 8;
            pre[0][i] = *(const GAS v4u*)(ur + C_AQ); pre[1][i] = *(const GAS v4u*)(ur + C_AFF); pre[2][i] = *(const GAS v4u*)(ur + C_AFB); } };
    int it = wk;
    if (it < NCHUNK * 4) issue(it);
    for (; it < NCHUNK * 4; it += NW) {
        const int cid = it >> 2, cb = (it & 3) * 256; const size_t row0 = (size_t)cid * 64;
        __syncthreads();
#pragma unroll
        for (int i = 0; i < 4; ++i) { const int piece = tid + NT * i; *(LAS v4u*)(L + TQ + piece * 16) = pre[0][i]; *(LAS v4u*)(L + TZF + piece * 16) = pre[1][i]; *(LAS v4u*)(L + TZB + piece * 16) = pre[2][i]; }
        __syncthreads();
        if (it + NW < NCHUNK * 4) issue(it + NW);
        const int c = cb + cl;
        const float lb = sigmf(F.hg_lb[(dirn * 2) * WA + c] - F.hg_lb[(dirn * 2 + 1) * WA + c]), olb = 1.f - lb;
        unsigned qb[32]; float P;
        if (dirn) P = hg_walk<1>(L, cl, lb, olb, qb); else P = hg_walk<0>(L, cl, lb, olb, qb);
        F.PE[(size_t)(dirn * NCHUNK + cid) * WA + c] = P;
        __syncthreads();
        if (dirn) {
            LAS unsigned short* qw = (LAS unsigned short*)(L + TQ) + cl;
#pragma unroll
            for (int pp = 0; pp < 64; ++pp) qw[(63 - pp) * 256] = (unsigned short)((pp & 1) ? (qb[pp >> 1] >> 16) : (qb[pp >> 1] & 0xffffu));
        }
        __syncthreads();
#pragma unroll
        for (int i = 0; i < 4; ++i) { const int piece = tid + NT * i, row = piece >> 5, c16 = piece & 31; const size_t r = row0 + row; bf16* ur = F.U + r * NU + cb + c16 * 8;
            const v4u vq = *(const LAS v4u*)(L + TQ + piece * 16), vf = *(const LAS v4u*)(L + TZF + piece * 16), vb = *(const LAS v4u*)(L + TZB + piece * 16), vqf = *(const LAS v4u*)(L + TQF + piece * 16);
            *(GAS v4u*)(F.QTF + r * WA + cb + c16 * 8) = vqf;
            if (DUMMY) { if (r < MX) { *(GAS v4u*)(dq + r * WA + cb + c16 * 8) = vq; *(GAS v4u*)(dkf + r * WA + cb + c16 * 8) = vf; *(GAS v4u*)(dkb + r * WA + cb + c16 * 8) = vb; } }
            else { *(GAS v4u*)(ur + C_AQ) = vq; *(GAS v4u*)(ur + C_AFF) = vf; *(GAS v4u*)(ur + C_AFB) = vb; } }
    }
    __syncthreads();
}
template <int CTRL, int RM> __device__ __forceinline__ float dpp_f(float idv, float x) { return __builtin_bit_cast(float, __builtin_amdgcn_update_dpp(__builtin_bit_cast(int, idv), __builtin_bit_cast(int, x), CTRL, RM, 0xf, false)); }
__device__ __forceinline__ float wave_scan_add(float x) {
    x += dpp_f<0x111, 0xf>(0.f, x); x += dpp_f<0x112, 0xf>(0.f, x); x += dpp_f<0x114, 0xf>(0.f, x); x += dpp_f<0x118, 0xf>(0.f, x);
    x += dpp_f<0x142, 0xa>(0.f, x); x += dpp_f<0x143, 0xc>(0.f, x); return x; }
__device__ __forceinline__ float wave_scan_max(float x) { const float ni = -__builtin_inff();
    x = fmaxf(x, dpp_f<0x111, 0xf>(ni, x)); x = fmaxf(x, dpp_f<0x112, 0xf>(ni, x)); x = fmaxf(x, dpp_f<0x114, 0xf>(ni, x)); x = fmaxf(x, dpp_f<0x118, 0xf>(ni, x));
    x = fmaxf(x, dpp_f<0x142, 0xa>(ni, x)); x = fmaxf(x, dpp_f<0x143, 0xc>(ni, x)); return x; }
__device__ __forceinline__ void p3_ml_scalars(Frame& F) {
    const int gw = F.vcu * NWAVES + F.wave;
    if (gw >= 32) return;
    const int dirn = gw & 1, h = (gw >> 1) & 3, b = gw >> 3;
    const float gbi = F.ml_gate_b[dirn * 4 + h], gbf = F.ml_gate_b[(2 + dirn) * 4 + h];
    float m0 = 0.f;
    float* mls = F.MLS + (size_t)(dirn * 4 + h) * MALL * 8;
    auto row_of = [&](int n) -> int { int row0; if (n < 4) { const int cc = dirn ? 3 - n : n; row0 = MX + b * CTXL + cc * 64; } else { const int lc = dirn ? 67 - n : n - 4; row0 = b * SEQ + lc * 64; }
        return row0 + (dirn ? 63 - F.lane : F.lane); };
    unsigned short gi_r[8], gf_r[8];
#pragma unroll
    for (int j = 0; j < 8; ++j) { const int row = row_of(j); gi_r[j] = F.U[(size_t)row * NU + C_BG + dirn * 4 + h]; gf_r[j] = F.U[(size_t)row * NU + C_BG + (2 + dirn) * 4 + h]; }
#pragma unroll 1
    for (int nb = 0; nb < 72; nb += 8) {
#pragma unroll
        for (int j = 0; j < 8; ++j) {
            const int n = nb + j;
            if (n < 68) {
                const int row = row_of(n);
                const float gi = bf2f(gi_r[j]) + gbi, gf = bf2f(gf_r[j]) + gbf;
                if (n + 8 < 68) { const int r2 = row_of(n + 8); gi_r[j] = F.U[(size_t)r2 * NU + C_BG + dirn * 4 + h]; gf_r[j] = F.U[(size_t)r2 * NU + C_BG + (2 + dirn) * 4 + h]; }
                const float lf = fminf(gf, 0.f) - __logf(1.f + __expf(-fabsf(gf)));
                const float cs = wave_scan_add(lf);
                const float a = gi - cs; const float cm = wave_scan_max(a);
                const float mx = fmaxf(m0, cm), m63 = __shfl(mx, 63), cs63 = __shfl(cs, 63);
                f32x4 o0; o0.x = a; o0.y = mx; o0.z = __expf(m0 - mx); o0.w = __expf(a - m63);
                f32x4 o1; o1.x = __expf(-(cs + mx)); o1.y = 0.f; o1.z = __expf(m0 - m63); o1.w = 0.f;
                *(f32x4*)(mls + (size_t)row * 8) = o0; *(f32x4*)(mls + (size_t)row * 8 + 4) = o1;
                const int row0 = row - (dirn ? 63 - F.lane : F.lane);
                if (F.lane == 0) F.DEC[(dirn * 4 + h) * NCHUNK + (row0 >> 6)] = __expf(m0 - m63);
                m0 = cs63 + m63;
            }
        }
    }
}

typedef short s16x4 __attribute__((ext_vector_type(4)));
typedef float f32x16 __attribute__((ext_vector_type(16)));
#define MFMA32(a, b, c) __builtin_amdgcn_mfma_f32_32x32x16_bf16((a), (b), (c), 0, 0, 0)
__device__ __forceinline__ bf16x8 pk8(float a0, float a1, float a2, float a3, float a4, float a5, float a6, float a7) {
    const v4u u = {pkbf(a0, a1), pkbf(a2, a3), pkbf(a4, a5), pkbf(a6, a7)}; return __builtin_bit_cast(bf16x8, u); }
__device__ __forceinline__ bf16x8 cat4(s16x4 lo, s16x4 hi) { return __builtin_shufflevector(lo, hi, 0, 1, 2, 3, 4, 5, 6, 7); }
__device__ __forceinline__ s16x4 lds_tr(LAS unsigned char* p) { return __builtin_amdgcn_ds_read_tr16_b64_v4i16((LAS s16x4*)p); }
__device__ __forceinline__ unsigned img_off_a(unsigned row, unsigned ch) { return 2048u * (row >> 3) + 512u * (ch >> 2) + 64u * (row & 7) + 16u * ((ch & 3) ^ ((row >> 2) & 3)); }
__device__ __forceinline__ unsigned img_addr(unsigned row, unsigned ch, unsigned ncb) { return ((row >> 5) * ncb + (ch >> 4)) * 8192u + img_off_a(row & 31, ch & 15); }
__device__ __forceinline__ unsigned v_addr(unsigned row, unsigned ch) { const unsigned r = row & 31; return (row >> 5) * 4096u + 1024u * (r >> 3) + 512u * (ch >> 2) + 64u * (r & 7) + 16u * ((ch & 3) ^ ((r >> 2) & 3)); }

constexpr int SL_QT = 0, SL_KT = 32768, SL_V = 65536, SL_VW = 73728, SL_SF = 81920, SL_XCH = 114688, SL_SC = 131072, SL_W = 144384;
constexpr int SC_PAR = 448, SC_DQW = 896, SC_N0 = 1024, SC_NP = 1280;


__device__ __forceinline__ void p3b_ml_scores(Frame& F) {
    LAS unsigned char* L = F.lds;
    constexpr int BQ = 0, BK = 32768, BX = 65536, BS = 98304;
    LAS float* SCA = (LAS float*)(L + BS);
    const int tid = F.tid, lane = F.lane, w = F.wave, ts = w & 1, tp = (w >> 1) & 1, kh = w >> 2;
    const unsigned hh = lane >> 5, x4 = (lane >> 2) & 3;
    const unsigned LB0 = 2048u * ((lane >> 3) & 3) + 64u * (lane & 7);
    unsigned LBx[2];
#pragma unroll
    for (int e = 0; e < 2; ++e) LBx[e] = LB0 + 16u * ((2u * e + hh) ^ x4) + kh * 8192u;
    v4u pq[4], pk[4]; f32x2_t psc;
    auto issue = [&](int it) { const int lc = it & 63, h = (it >> 6) & 3, b = it >> 8; const size_t row0 = (size_t)b * SEQ + lc * 64;
        int tv = F.tid; asm volatile("" : "+v"(tv));
#pragma unroll
        for (int i = 0; i < 4; ++i) { const int u = ((tv >> 6) + 8 * i) * 8 + ((tv & 63) >> 3), row = 2 * (u >> 3) + ((tv >> 2) & 1), ch = 4 * (u & 7) + (tv & 3);
            pq[i] = *(const GAS v4u*)(F.XN + (row0 + row) * DM + h * MLD + ch * 8); pk[i] = *(const GAS v4u*)(F.XN + (row0 + row) * DM + WB + h * MLD + ch * 8); }
        if (tv < 128) psc = *(const GAS f32x2_t*)(F.MLS + ((size_t)((tv >> 6) * 4 + h) * MALL + row0 + (tv & 63)) * 8); };
    int it = F.vcu;
    if (it < 1024) issue(it);
    for (; it < 1024; it += F.G) {
        const int lc = it & 63, h = (it >> 6) & 3, b = it >> 8; const size_t row0 = (size_t)b * SEQ + lc * 64;
        __syncthreads();
        { int tv = F.tid; asm volatile("" : "+v"(tv));
#pragma unroll
          for (int i = 0; i < 4; ++i) { const int u = ((tv >> 6) + 8 * i) * 8 + ((tv & 63) >> 3), row = 2 * (u >> 3) + ((tv >> 2) & 1), ch = 4 * (u & 7) + (tv & 3); const unsigned a = img_addr(row, ch, 2); *(LAS v4u*)(L + BQ + a) = pq[i]; *(LAS v4u*)(L + BK + a) = pk[i]; }
          if (tv < 128) { SCA[(tv >> 6) * 128 + (tv & 63)] = psc.x; SCA[(tv >> 6) * 128 + 64 + (tv & 63)] = psc.y; } }
        __syncthreads();
        if (it + F.G < 1024) issue(it + F.G);
        f32x16 c;
#pragma unroll
        for (int r = 0; r < 16; ++r) c[r] = 0.f;
#pragma unroll
        for (int s = 0; s < 8; ++s) {
            const bf16x8 a = *(const LAS bf16x8*)(L + BK + ts * 16384 + 512 * (s >> 1) + LBx[s & 1]);
            const bf16x8 bq = *(const LAS bf16x8*)(L + BQ + tp * 16384 + 512 * (s >> 1) + LBx[s & 1]);
            c = MFMA32(a, bq, c);
        }
#pragma unroll
        for (int r = 0; r < 16; ++r) *(LAS float*)(L + BX + (((kh * 4 + ts * 2 + tp) * 16 + r) * 64 + lane) * 4) = c[r];
        __syncthreads();
#pragma unroll
        for (int r = 0; r < 16; ++r) c[r] += *(const LAS float*)(L + BX + ((((1 - kh) * 4 + ts * 2 + tp) * 16 + r) * 64 + lane) * 4);
        const int dirn = kh;
        const bool need = dirn ? (ts >= tp) : (ts <= tp);
        const float mxp = SCA[dirn * 128 + 64 + 32 * tp + (lane & 31)];
        int dl = (lane & 31) - 4 * (int)hh; if (dirn) dl = -dl; asm volatile("" : "+v"(dl));
        const int sg1 = dirn ? -1 : 1; const bool diag = ts == tp;
        float rs = 0.f;
        bf16* wout = F.MLW + ((size_t)((dirn * 4 + h) * 256 + (int)(row0 >> 6)) * 4096) + (32 * tp + (lane & 31)) * 64 + 32 * ts + 4 * hh;
#pragma unroll
        for (int g = 0; g < 4; ++g) {
            const f32x4 av = *(const LAS f32x4*)(SCA + dirn * 128 + 32 * ts + 8 * g + 4 * hh);
            float wv[4];
#pragma unroll
            for (int j = 0; j < 4; ++j) { float v = need ? c[4 * g + j] * __expf(av[j] - mxp) : 0.f;
                if (diag) v = (dl - sg1 * (j + 8 * g) >= 0) ? v : 0.f;
                wv[j] = v; rs += v; }
            *(GAS unsigned long long*)(wout + 8 * g) = (unsigned long long)pkbf(wv[0], wv[1]) | ((unsigned long long)pkbf(wv[2], wv[3]) << 32);
        }
        rs += __shfl_xor(rs, 32);
        if (lane < 32) SCA[256 + (dirn * 2 + ts) * 64 + 32 * tp + lane] = rs;
        __syncthreads();
        if (tid < 128) { const int d = tid >> 6, p = tid & 63; F.MLS[((size_t)(d * 4 + h) * MALL + row0 + p) * 8 + 5] = SCA[256 + (d * 2) * 64 + p] + SCA[256 + (d * 2 + 1) * 64 + p]; }
    }
    __syncthreads();
}

template <bool ML, int SKIP = 0>
__device__ __forceinline__ void scan_task(Frame& F, int task) {
    constexpr int NKT = ML ? 8 : 4, NCB = NKT / 4, NKH = NKT / 2, NOWN = NKT / 4, NPQ = ML ? 4 : 2, DKK = 32 * NKT;
    int vs, dirn, h, b;
    if (ML) { vs = task & 3; dirn = (task >> 2) & 1; h = (task >> 3) & 3; b = task >> 5; } else { vs = task & 1; dirn = (task >> 1) & 1; h = (task >> 2) & 7; b = task >> 5; }
    const int lane = F.lane, w = F.wave, tid = F.tid; const int tp = (w >> 2) & 1, tj = (w >> 1) & 1, kh = w & 1;
    const unsigned hh = lane >> 5, q4 = (lane & 15) >> 2, p4 = lane & 3, blk = (lane >> 4) & 1, x4 = (lane >> 2) & 3;
    LAS unsigned char* L = F.lds;
    LAS float* SC = (LAS float*)(L + SL_SC);
    const unsigned LB0 = 2048u * ((lane >> 3) & 3) + 64u * (lane & 7);
    const unsigned khoff = ML ? kh * 8192u : kh * 1024u;
    unsigned LBx[2], LK[2][2], TRK[2], VK[2], VN[2], WL[2];
#pragma unroll
    for (int e = 0; e < 2; ++e) { LBx[e] = LB0 + 16u * ((2u * e + hh) ^ x4) + khoff; WL[e] = 1024u * ((lane >> 3) & 3) + 64u * (lane & 7) + 16u * ((2u * e + hh) ^ x4);
#pragma unroll
        for (int t = 0; t < 2; ++t) LK[e][t] = LB0 + 16u * ((2u * e + t) ^ x4) + 8u * hh + khoff; }
#pragma unroll
    for (int t = 0; t < 2; ++t) {
        TRK[t] = 2048u * hh + 64u * q4 + 8u * (p4 & 1) + 16u * ((2u * blk + (p4 >> 1)) ^ (2u * hh + t));
        VK[t] = 64u * (4u * hh + q4) + 8u * (p4 & 1) + 16u * ((2u * blk + (p4 >> 1)) ^ (2u * t + hh)) + 512u * tj;
        VN[t] = 1024u * hh + 64u * q4 + 8u * (p4 & 1) + 512u * tj + 16u * ((2u * blk + (p4 >> 1)) ^ (2u * hh + t)); }
    unsigned tkoff[NOWN];
#pragma unroll
    for (int i = 0; i < NOWN; ++i) { const unsigned tk = kh * NKH + tp * NOWN + i; tkoff[i] = (tk >> 2) * 8192u + 512u * (tk & 3); }
    const bf16 *gq, *gk, *gv; int sq, sk; bf16* go;
    if (ML) { gq = F.XN + h * MLD; gk = F.XN + WB + h * MLD; sq = DM; sk = DM; gv = F.U + C_BV + h * MLD + vs * 64; go = (dirn ? F.HBB : F.HBF) + h * MLD + vs * 64; }
    else { if (dirn) { gq = F.U + C_AQ + h * HGD; sq = NU; gk = F.U + C_AFB + h * HGD; } else { gq = F.QTF + h * HGD; sq = WA; gk = F.U + C_AFF + h * HGD; }
        sk = NU; gv = F.U + C_AI + h * HGD + vs * 64; go = (dirn ? F.OAB : F.OAF) + h * HGD + vs * 64; }
    const float* mls = F.MLS + (size_t)(dirn * 4 + h) * MALL * 8;
    const float* pev = F.PE + (size_t)dirn * NCHUNK * WA + h * HGD;
    f32x16 S[NOWN];
#pragma unroll
    for (int i = 0; i < NOWN; ++i)
#pragma unroll
        for (int r = 0; r < 16; ++r) S[i][r] = 0.f;
    v4u pq[NPQ], pk[NPQ], pv, pw; f32x4 ps0, ps1; float pws;
    const bf16* gw_ = F.MLW + (size_t)(dirn * 4 + h) * 256 * 4096;
    auto row0_of = [&](int n) -> int { if (n < 4) { const int cc = dirn ? 3 - n : n; return MX + b * CTXL + cc * 64; } const int lc = dirn ? 67 - n : n - 4; return b * SEQ + lc * 64; };
    int offq[NPQ], offk[NPQ]; unsigned aimg[NPQ];
#pragma unroll
    for (int i = 0; i < NPQ; ++i) { const int u = (w + 8 * i) * 8 + (lane >> 3), NB = NCB * 4, row = 2 * (u / NB) + ((lane >> 2) & 1), ch = 4 * (u % NB) + (lane & 3);
        offq[i] = row * sq + ch * 8; offk[i] = row * sk + ch * 8; aimg[i] = img_addr(row, ch, NCB); }
    const int vu = w * 8 + (lane >> 3), vrow = 2 * (vu >> 1) + ((lane >> 2) & 1), vch = 4 * (vu & 1) + (lane & 3);
    const int offv = vrow * NU + vch * 8, offw = vrow * 64 + vch * 8; const unsigned va = v_addr(vrow, vch);
    auto issue_loads = [&](int n) {
        const int row0 = row0_of(n);
        const bf16* bq_ = gq + (size_t)row0 * sq; const bf16* bk_ = gk + (size_t)row0 * sk;
#pragma unroll
        for (int i = 0; i < NPQ; ++i) { pq[i] = *(const GAS v4u*)(bq_ + offq[i]); pk[i] = *(const GAS v4u*)(bk_ + offk[i]); }
        pv = *(const GAS v4u*)(gv + (size_t)row0 * NU + offv);
        if (ML) { pws = mls[(size_t)(row0 + vrow) * 8 + 3];
            if (n >= 4) pw = *(const GAS v4u*)(gw_ + (size_t)(row0 >> 6) * 4096 + offw);
            if (tid < 64) { ps0 = *(const GAS f32x4*)(mls + (size_t)(row0 + tid) * 8); ps1 = *(const GAS f32x4*)(mls + (size_t)(row0 + tid) * 8 + 4); } }
        else { if (tid < 32) ps0 = *(const GAS f32x4*)(pev + (size_t)(row0 >> 6) * WA + tid * 4); }
    };
    unsigned tch0 = 0u, tch1 = 0u, tdummy = 0u;
    auto touch = [&](int n) {
        const int row0 = row0_of(n);
        if (ML) { const int ln = tid & 255; const bf16* bp = (tid < 256 ? gq + (size_t)row0 * sq : gk + (size_t)row0 * sk) + (size_t)(ln >> 2) * DM + (ln & 3) * 64;
            tch0 = *(const GAS unsigned*)bp;
            if (tid < 64) tch1 = *(const GAS unsigned*)(gv + (size_t)(row0 + tid) * NU);
            else if (tid < 128 && n >= 4) tch1 = *(const GAS unsigned*)(gw_ + (size_t)(row0 >> 6) * 4096 + (tid - 64) * 64); }
        else { if (tid < 256) { const int ln = tid & 127; tch0 = *(const GAS unsigned*)((tid < 128 ? gq + (size_t)(row0 + (ln >> 1)) * sq : gk + (size_t)(row0 + (ln >> 1)) * sk) + (ln & 1) * 64); }
            else if (tid < 320) tch0 = *(const GAS unsigned*)(gv + (size_t)(row0 + tid - 256) * NU); }
    };
    auto store_images = [&](int n) {
#pragma unroll
        for (int i = 0; i < NPQ; ++i) { *(LAS v4u*)(L + SL_QT + aimg[i]) = pq[i]; *(LAS v4u*)(L + SL_KT + aimg[i]) = pk[i]; }
        *(LAS v4u*)(L + SL_V + va) = pv;
        if (!ML && tid < 32) *(LAS f32x4*)(SC + (n & 1) * SC_PAR + tid * 4) = ps0;
        if (ML) { v4u o; o.x = pkbf(lo2f(pv.x) * pws, hi2f(pv.x) * pws); o.y = pkbf(lo2f(pv.y) * pws, hi2f(pv.y) * pws); o.z = pkbf(lo2f(pv.z) * pws, hi2f(pv.z) * pws); o.w = pkbf(lo2f(pv.w) * pws, hi2f(pv.w) * pws);
            *(LAS v4u*)(L + SL_VW + va) = o;
            if (n >= 4) *(LAS v4u*)(L + SL_W + va) = pw;
            if (tid < 64) { LAS float* sp = SC + (n & 1) * SC_PAR + tid; sp[0] = ps0.x; sp[64] = ps0.y; sp[128] = ps0.z; sp[192] = ps0.w; sp[256] = ps1.x; sp[320] = ps1.y; sp[384] = ps1.z; SC[896 + tid] = ps1.w; } }
    };
    __syncthreads();
    issue_loads(0);
    for (int e = tid; e < 32768 / 16; e += NT) *(LAS v4u*)(L + SL_SF + e * 16) = (v4u){0u, 0u, 0u, 0u};
    store_images(0);
    __syncthreads();
#pragma unroll 1
    for (int n = 0; n < 68; ++n) {
        const bool lat = n >= 4; const int row0 = row0_of(n); const int cid = row0 >> 6;
        if (n + 1 < 68 && !(SKIP & 16)) issue_loads(n + 1);
        LAS float* SP = SC + (n & 1) * SC_PAR;
        float dec = 1.f; f32x4 pe[NOWN][4];
        if (ML) dec = SP[384];
        else {
#pragma unroll
            for (int i = 0; i < NOWN; ++i)
#pragma unroll
                for (int g = 0; g < 4; ++g) pe[i][g] = *(const LAS f32x4*)(SP + 32 * (kh * NKH + tp * NOWN + i) + 8 * g + 4 * hh);
        }
        f32x16 o;
        if (lat && !(SKIP & 4)) {
            f32x16 acc_o, acc_i;
#pragma unroll
            for (int r = 0; r < 16; ++r) { acc_o[r] = 0.f; acc_i[r] = 0.f; }
            if (ML) {
                if (kh == 0) {
#pragma unroll
                    for (int ts = 0; ts < 2; ++ts) {
                        const bool need = dirn ? (ts >= tp) : (ts <= tp);
                        if (need) {
                            const bf16x8 a0 = *(const LAS bf16x8*)(L + SL_W + tp * 4096 + 512 * ts + WL[0]), a1 = *(const LAS bf16x8*)(L + SL_W + tp * 4096 + 512 * ts + WL[1]);
                            const s16x4 lo0 = lds_tr(L + SL_V + ts * 4096 + VN[0]), hi0 = lds_tr(L + SL_V + ts * 4096 + 256 + VN[1]);
                            const s16x4 lo1 = lds_tr(L + SL_V + ts * 4096 + 2048 + VN[0]), hi1 = lds_tr(L + SL_V + ts * 4096 + 2048 + 256 + VN[1]);
                            acc_o = MFMA32(a0, cat4(lo0, hi0), acc_o);
                            acc_o = MFMA32(a1, cat4(lo1, hi1), acc_o);
                        }
                    }
                }
            } else
#pragma unroll
            for (int ts = 0; ts < 2; ++ts) {
                const bool need = dirn ? (ts >= tp) : (ts <= tp);
                if (need) {
                    f32x16 c;
#pragma unroll
                    for (int r = 0; r < 16; ++r) c[r] = 0.f;
                    {
                        bf16x8 a_c = *(const LAS bf16x8*)(L + SL_KT + ts * NCB * 8192 + LBx[0]), b_c = *(const LAS bf16x8*)(L + SL_QT + tp * NCB * 8192 + LBx[0]), a_n = a_c, b_n = b_c;
#pragma unroll
                        for (int s = 0; s < NKT; ++s) {
                            if (s + 1 < NKT) { a_n = *(const LAS bf16x8*)(L + SL_KT + ts * NCB * 8192 + 512 * ((s + 1) >> 1) + LBx[(s + 1) & 1]); b_n = *(const LAS bf16x8*)(L + SL_QT + tp * NCB * 8192 + 512 * ((s + 1) >> 1) + LBx[(s + 1) & 1]); }
                            c = MFMA32(a_c, b_c, c);
                            a_c = a_n; b_c = b_n;
                        }
                    }
                    const s16x4 vlo0 = lds_tr(L + SL_V + ts * 4096 + VK[0]), vhi0 = lds_tr(L + SL_V + ts * 4096 + 1024 + VK[1]);
                    const s16x4 vlo1 = lds_tr(L + SL_V + ts * 4096 + 2048 + VK[0]), vhi1 = lds_tr(L + SL_V + ts * 4096 + 3072 + VK[1]);
                    int dl = (lane & 31) - 4 * (int)hh; if (dirn) dl = -dl; asm volatile("" : "+v"(dl));
                    const int sg1 = dirn ? -1 : 1; const bool diag = ts == tp;
#pragma unroll
                    for (int r = 0; r < 16; ++r) { const int ro = (r & 3) + 8 * (r >> 2);
                        float wv = c[r];
                        if (diag) wv = (dl - sg1 * ro >= 0) ? wv : 0.f;
                        c[r] = wv; }
                    acc_o = MFMA32(pk8(c[0], c[1], c[2], c[3], c[4], c[5], c[6], c[7]), cat4(vlo0, vhi0), acc_o);
                    acc_o = MFMA32(pk8(c[8], c[9], c[10], c[11], c[12], c[13], c[14], c[15]), cat4(vlo1, vhi1), acc_o);
                }
            }
            {
#define LD_INTER(i_, LO_, HI_, SF_) do { LO_ = *(const LAS s16x4*)(L + SL_QT + tp * NCB * 8192 + 512 * ((i_) >> 1) + LK[(i_) & 1][0]); HI_ = *(const LAS s16x4*)(L + SL_QT + tp * NCB * 8192 + 512 * ((i_) >> 1) + LK[(i_) & 1][1]); \
                SF_ = *(const LAS bf16x8*)(L + SL_SF + ((((kh * NKH + ((i_) >> 1)) * 2 + tj) * 2 + ((i_) & 1)) * 1024) + lane * 16); } while (0)
                s16x4 lo_c, hi_c, lo_n, hi_n; bf16x8 sf_c, sf_n;
                LD_INTER(0, lo_c, hi_c, sf_c); lo_n = lo_c; hi_n = hi_c; sf_n = sf_c;
#pragma unroll
                for (int i = 0; i < 2 * NKH; ++i) {
                    if (i + 1 < 2 * NKH) LD_INTER(i + 1, lo_n, hi_n, sf_n);
                    acc_i = MFMA32(cat4(lo_c, hi_c), sf_c, acc_i);
                    lo_c = lo_n; hi_c = hi_n; sf_c = sf_n;
                }
#undef LD_INTER
            }
            if (ML) {
                f32x4 wi[4];
#pragma unroll
                for (int g = 0; g < 4; ++g) wi[g] = *(const LAS f32x4*)(SP + 128 + 32 * tp + 8 * g + 4 * hh);
#pragma unroll
                for (int r = 0; r < 16; ++r) o[r] = acc_o[r] + wi[r >> 2][r & 3] * acc_i[r];
            } else {
#pragma unroll
                for (int r = 0; r < 16; ++r) o[r] = acc_o[r] + acc_i[r];
            }
            {
#pragma unroll
                for (int r = 0; r < 8; ++r) { const int rr = kh ? r : r + 8; *(LAS float*)(L + SL_XCH + (((tp * 2 + tj) * 16 + rr) * 64 + lane) * 4) = kh ? o[r] : o[r + 8]; }
            }
        }
        {
            if (ML) {
#pragma unroll
                for (int i = 0; i < NOWN; ++i)
#pragma unroll
                    for (int r = 0; r < 16; ++r) S[i][r] *= dec;
            }
#define LD_GA(ks_, i_, LO_, HI_) do { LO_ = lds_tr(L + SL_KT + ((ks_) >> 1) * NCB * 8192 + 4096 * ((ks_) & 1) + tkoff[i_] + TRK[0]); HI_ = lds_tr(L + SL_KT + ((ks_) >> 1) * NCB * 8192 + 4096 * ((ks_) & 1) + 256 + tkoff[i_] + TRK[1]); } while (0)
#define LD_GB(ks_, LO_, HI_) do { LO_ = lds_tr(L + (ML ? SL_VW : SL_V) + ((ks_) >> 1) * 4096 + 2048 * ((ks_) & 1) + VN[0]); HI_ = lds_tr(L + (ML ? SL_VW : SL_V) + ((ks_) >> 1) * 4096 + 2048 * ((ks_) & 1) + 256 + VN[1]); } while (0)
            s16x4 alo_c, ahi_c, blo_c, bhi_c, alo_n, ahi_n, blo_n, bhi_n;
            LD_GB(0, blo_c, bhi_c); LD_GA(0, 0, alo_c, ahi_c); alo_n = alo_c; ahi_n = ahi_c; blo_n = blo_c; bhi_n = bhi_c;
            constexpr int NG = (SKIP & 8) ? 0 : 4 * NOWN;
#pragma unroll
            for (int j = 0; j < NG; ++j) {
                const int ks = j / NOWN, i = j % NOWN, ks1 = (j + 1) / NOWN, i1 = (j + 1) % NOWN;
                if (j + 1 < NG) { LD_GA(ks1, i1, alo_n, ahi_n); if (i1 == 0) LD_GB(ks1, blo_n, bhi_n); }
                S[i] = MFMA32(cat4(alo_c, ahi_c), cat4(blo_c, bhi_c), S[i]);
                alo_c = alo_n; ahi_c = ahi_n; if (i1 == 0) { blo_c = blo_n; bhi_c = bhi_n; }
                (void)ks;
            }
#undef LD_GA
#undef LD_GB
            if (!ML) {
#pragma unroll
                for (int i = 0; i < NOWN; ++i)
#pragma unroll
                    for (int r = 0; r < 16; ++r) S[i][r] *= pe[i][r >> 2][r & 3];
            }
        }
        __syncthreads();
#pragma unroll
        for (int i = 0; i < NOWN; ++i)
#pragma unroll
            for (int st = 0; st < 2; ++st) {
                const bf16x8 f8 = pk8(S[i][8 * st], S[i][8 * st + 1], S[i][8 * st + 2], S[i][8 * st + 3], S[i][8 * st + 4], S[i][8 * st + 5], S[i][8 * st + 6], S[i][8 * st + 7]);
                *(LAS bf16x8*)(L + SL_SF + ((((kh * NKH + tp * NOWN + i) * 2 + tj) * 2 + st) * 1024) + lane * 16) = f8;
            }
        if (n + 1 < 68 && !(SKIP & 16)) store_images(n + 1);
        if (lat && !(SKIP & 2)) {
            float xv[8];
#pragma unroll
            for (int r8 = 0; r8 < 8; ++r8) { const int r = kh ? r8 + 8 : r8; xv[r8] = *(const LAS float*)(L + SL_XCH + (((tp * 2 + tj) * 16 + r) * 64 + lane) * 4); }
#pragma unroll
            for (int r8 = 0; r8 < 8; ++r8) { const int r = kh ? r8 + 8 : r8; const float ov = (kh ? o[r8 + 8] : o[r8]) + xv[r8];
                const int pr = 32 * tp + (r & 3) + 8 * (r >> 2) + 4 * (int)hh;
                go[(size_t)(row0 + pr) * WA + 32 * tj + (lane & 31)] = (bf16)(pkbf(ov, 0.f) & 0xffffu); }
        }
        LDS_BARRIER();
    }
}
#ifndef HG_MFMA
#define HG_MFMA 1
#endif
#ifndef ML_MFMA
#define ML_MFMA 1
#endif

__device__ __forceinline__ void nchain_task(Frame& F, int j) {
    const int kq = j & 3, id = j >> 2, dirn = id & 1, h = (id >> 1) & 3, b = id >> 3;
    const int tid = F.tid, lane = F.lane, w = F.wave;
    LAS unsigned char* L = F.lds;
    constexpr int NQ = 0, NK = 8192, NS = 16384;
    LAS float* SN = (LAS float*)(L + NS);
    const bf16* gq = F.XN + h * MLD + kq * 64; const bf16* gk = gq + WB;
    const float* mls = F.MLS + (size_t)(dirn * 4 + h) * MALL * 8;
    float* dqp = F.DQP + (size_t)((dirn * 4 + h) * 4 + kq) * MX;
    auto row0_of = [&](int n) -> int { if (n > 67) n = 67; if (n < 4) { const int cc = dirn ? 3 - n : n; return MX + b * CTXL + cc * 64; } const int lc = dirn ? 67 - n : n - 4; return b * SEQ + lc * 64; };
    struct Stg { v4u q, k; float ws, dec; };
    Stg A, B, C; A.ws = A.dec = B.ws = B.dec = C.ws = C.dec = 0.f;
    auto issue = [&](int n, Stg& t) { const int row0 = row0_of(n); const size_t off = (size_t)(row0 + (tid >> 3)) * DM + (tid & 7) * 8;
        t.q = *(const GAS v4u*)(gq + off); t.k = *(const GAS v4u*)(gk + off);
        if (tid < 64) { t.ws = mls[(size_t)(row0 + tid) * 8 + 3]; t.dec = mls[(size_t)(row0 + tid) * 8 + 6]; } };
    auto stash = [&](const Stg& t) { *(LAS v4u*)(L + NQ + tid * 16) = t.q; *(LAS v4u*)(L + NK + tid * 16) = t.k; if (tid < 64) { SN[tid] = t.ws; if (tid == 0) SN[640] = t.dec; } };
    auto step = [&](int n, Stg& ld, const Stg& st) {
        const int row0 = row0_of(n); const bool on = n < 68;
        issue(n + 2, ld);
        float dq_keep = 0.f;
        if (on && n >= 4) {
            const int kk = tid & 7; const v4u u = *(const LAS v4u*)(L + NQ + tid * 16);
            const f32x4 na = *(const LAS f32x4*)(SN + 64 + 8 * kk), nb = *(const LAS f32x4*)(SN + 64 + 8 * kk + 4);
            float d = lo2f(u.x) * na.x + hi2f(u.x) * na.y + lo2f(u.y) * na.z + hi2f(u.y) * na.w + lo2f(u.z) * nb.x + hi2f(u.z) * nb.y + lo2f(u.w) * nb.z + hi2f(u.w) * nb.w;
            d += __shfl_xor(d, 1); d += __shfl_xor(d, 2); d += __shfl_xor(d, 4);
            dq_keep = d;
        }
        { float a = 0.f;
#pragma unroll
          for (int i = 0; i < 8; ++i) { const int s_ = 8 * w + i; a += SN[s_] * bf2f(*(const LAS unsigned short*)(L + NK + s_ * 128 + lane * 2)); }
          SN[128 + w * 64 + lane] = a; }
        __syncthreads();
        if (on && tid < 64) { float nn = SN[640] * SN[64 + tid];
#pragma unroll
            for (int ww = 0; ww < 8; ++ww) nn += SN[128 + ww * 64 + tid];
            SN[64 + tid] = nn; }
        stash(st);
        if (on && n >= 4 && (tid & 7) == 0) dqp[row0 + (tid >> 3)] = dq_keep;
        LDS_BARRIER();
    };
    __syncthreads();
    issue(0, A); issue(1, B);
    if (tid < 64) SN[64 + tid] = 0.f;
    stash(A);
    __syncthreads();
#pragma unroll 1
    for (int n = 0; n < 69; n += 3) { step(n, C, B); step(n + 1, A, C); step(n + 2, B, A); }
}

template <int WHICH, int SKIP = 0>
__device__ __forceinline__ void p4_scan(Frame& F) {
    for (int t = F.vcu; t < 256; t += F.G) {
        if (t < 128 ? !(WHICH & 1) : !(WHICH & 2)) continue;
        if (t < 128) { if (ML_MFMA) scan_task<true, SKIP>(F, t); else { p4_mlstm_task(F, 2 * t); p4_mlstm_task(F, 2 * t + 1); } }
        else { if (HG_MFMA) { scan_task<false, SKIP>(F, t - 128); nchain_task(F, t - 128); } else { p4_hgrn2_task(F, 2 * (t - 128)); p4_hgrn2_task(F, 2 * (t - 128) + 1); } }
    }
}
__device__ __forceinline__ void p5_combine(Frame& F) {
    bf16* Y = F.XN;
    const int gw = F.vcu * NWAVES + F.wave, NGW = F.G * NWAVES;
    for (int row = gw; row < MX; row += NGW) {
        const int ch = F.lane * 16;
        {
            float o[16];
            const v4u a0 = *(const GAS v4u*)(F.OAF + (size_t)row * WA + ch), a1 = *(const GAS v4u*)(F.OAF + (size_t)row * WA + ch + 8);
            const v4u b0 = *(const GAS v4u*)(F.OAB + (size_t)row * WA + ch), b1 = *(const GAS v4u*)(F.OAB + (size_t)row * WA + ch + 8);
            const unsigned ua[8] = {a0.x, a0.y, a0.z, a0.w, a1.x, a1.y, a1.z, a1.w}, ub[8] = {b0.x, b0.y, b0.z, b0.w, b1.x, b1.y, b1.z, b1.w};
            float ss = 0.f;
#pragma unroll
            for (int j = 0; j < 8; ++j) { o[2 * j] = lo2f(ua[j]) + lo2f(ub[j]); o[2 * j + 1] = hi2f(ua[j]) + hi2f(ub[j]); ss += o[2 * j] * o[2 * j] + o[2 * j + 1] * o[2 * j + 1]; }
            ss += __shfl_xor(ss, 1); ss += __shfl_xor(ss, 2); ss += __shfl_xor(ss, 4);
            const float r = 1.f / sqrtf(ss * (1.f / HGD) + NORM_EPS);
            const v4u z0 = *(const GAS v4u*)(F.U + (size_t)row * NU + C_AZ + ch), z1 = *(const GAS v4u*)(F.U + (size_t)row * NU + C_AZ + ch + 8);
            const unsigned uz[8] = {z0.x, z0.y, z0.z, z0.w, z1.x, z1.y, z1.z, z1.w};
            unsigned w[8];
#pragma unroll
            for (int j = 0; j < 8; ++j) { const float y0 = o[2 * j] * r * F.hg_norm_w[ch + 2 * j] * siluf(lo2f(uz[j])), y1 = o[2 * j + 1] * r * F.hg_norm_w[ch + 2 * j + 1] * siluf(hi2f(uz[j])); w[j] = pk2(y0, y1); }
            *(GAS v4u*)(Y + (size_t)row * DM + ch) = (v4u){w[0], w[1], w[2], w[3]}; *(GAS v4u*)(Y + (size_t)row * DM + ch + 8) = (v4u){w[4], w[5], w[6], w[7]};
        }
        {
            float o[16];
            const v4u a0 = *(const GAS v4u*)(F.HBF + (size_t)row * WB + ch), a1 = *(const GAS v4u*)(F.HBF + (size_t)row * WB + ch + 8);
            const v4u b0 = *(const GAS v4u*)(F.HBB + (size_t)row * WB + ch), b1 = *(const GAS v4u*)(F.HBB + (size_t)row * WB + ch + 8);
            const unsigned ua[8] = {a0.x, a0.y, a0.z, a0.w, a1.x, a1.y, a1.z, a1.w}, ub[8] = {b0.x, b0.y, b0.z, b0.w, b1.x, b1.y, b1.z, b1.w};
            float s = 0.f; const int hq = F.lane >> 4;
            float invd[2];
#pragma unroll
            for (int d = 0; d < 2; ++d) { const float* mr = F.MLS + ((size_t)(d * 4 + hq) * MALL + row) * 8; const float* dq = F.DQP + (size_t)((d * 4 + hq) * 4) * MX + row;
                const float den = mr[2] * ((dq[0] + dq[MX]) + (dq[2 * MX] + dq[3 * MX])) + mr[5];
                invd[d] = rcpf_(fmaxf(fabsf(den), mr[4])); }
#pragma unroll
            for (int j = 0; j < 8; ++j) { o[2 * j] = lo2f(ua[j]) * invd[0] + lo2f(ub[j]) * invd[1]; o[2 * j + 1] = hi2f(ua[j]) * invd[0] + hi2f(ub[j]) * invd[1]; s += o[2 * j] + o[2 * j + 1]; }
            s += __shfl_xor(s, 1); s += __shfl_xor(s, 2); s += __shfl_xor(s, 4); s += __shfl_xor(s, 8);
            const float mu = s * (1.f / MLD); float q = 0.f;
#pragma unroll
            for (int j = 0; j < 16; ++j) { o[j] -= mu; q += o[j] * o[j]; }
            q += __shfl_xor(q, 1); q += __shfl_xor(q, 2); q += __shfl_xor(q, 4); q += __shfl_xor(q, 8);
            const float r = 1.f / sqrtf(q * (1.f / MLD) + NORM_EPS);
            const v4u g0 = *(const GAS v4u*)(F.U + (size_t)row * NU + C_BO + ch), g1 = *(const GAS v4u*)(F.U + (size_t)row * NU + C_BO + ch + 8);
            const v4u z0 = *(const GAS v4u*)(F.U + (size_t)row * NU + C_BZ + ch), z1 = *(const GAS v4u*)(F.U + (size_t)row * NU + C_BZ + ch + 8);
            const unsigned ug[8] = {g0.x, g0.y, g0.z, g0.w, g1.x, g1.y, g1.z, g1.w}, uz[8] = {z0.x, z0.y, z0.z, z0.w, z1.x, z1.y, z1.z, z1.w};
            unsigned w[8];
#pragma unroll
            for (int j = 0; j < 8; ++j) { const float y0 = o[2 * j] * r * F.ml_norm_w[ch + 2 * j] * sigmf(lo2f(ug[j])) * siluf(lo2f(uz[j])), y1 = o[2 * j + 1] * r * F.ml_norm_w[ch + 2 * j + 1] * sigmf(hi2f(ug[j])) * siluf(hi2f(uz[j])); w[j] = pk2(y0, y1); }
            *(GAS v4u*)(Y + (size_t)row * DM + WA + ch) = (v4u){w[0], w[1], w[2], w[3]}; *(GAS v4u*)(Y + (size_t)row * DM + WA + ch + 8) = (v4u){w[4], w[5], w[6], w[7]};
        }
    }
}

struct EpiResid {
    static constexpr bool PERM = false, AFTER_DRAIN = false;
    const float* x; const float* gate; float* out;
    __device__ __forceinline__ void operator()(const pg8::f32x4 (&acc)[2][2][4][2], const pg8::Unit& u, int wr, int wc, int fr, int fq) const {
        using pg8::BM; using pg8::HALF;
        const int row0 = u.pm * BM + wr * 64 + fr, col0 = u.pn * BM + wc * 32 + 4 * fq; const int b = (u.pm * BM) / SEQ;
        pg8::f32x4 gv[2][2];
#pragma unroll
        for (int bj = 0; bj < 2; ++bj)
#pragma unroll
            for (int n = 0; n < 2; ++n) gv[bj][n] = *(const pg8::f32x4*)(gate + b * DM + col0 + bj * HALF + n * 16);
#pragma unroll
        for (int ai = 0; ai < 2; ++ai) {
            pg8::f32x4 xv[4][2][2];
#pragma unroll
            for (int m = 0; m < 4; ++m) { const size_t off = (size_t)(row0 + ai * HALF + m * 16) * DM + col0;
#pragma unroll
                for (int bj = 0; bj < 2; ++bj)
#pragma unroll
                    for (int n = 0; n < 2; ++n) xv[m][bj][n] = *(const pg8::f32x4*)(x + off + bj * HALF + n * 16); }
#pragma unroll
            for (int m = 0; m < 4; ++m) { const size_t off = (size_t)(row0 + ai * HALF + m * 16) * DM + col0;
#pragma unroll
                for (int bj = 0; bj < 2; ++bj)
#pragma unroll
                    for (int n = 0; n < 2; ++n) *(pg8::f32x4*)(out + off + bj * HALF + n * 16) = xv[m][bj][n] * ALPHA + gv[bj][n] * acc[ai][bj][m][n]; }
        }
    }
};


struct PanelOrder {
    int c;
    __device__ __forceinline__ bool next(int i, pg8::Unit& u) const { if (i >= 2) return false; u.pm = c >> 2; u.pn = (c & 3) + 4 * i; return true; }
    __device__ __forceinline__ void a_ready(const pg8::Unit&) const {}
    __device__ __forceinline__ void done(const pg8::Unit&) const {}
};
struct EpiLnFused {
    static constexpr bool PERM = false, AFTER_DRAIN = true;
    const float* x; const float* gate; float* out; const float* ln_g; const float* ln_b;
    unsigned long long* xbuf;
    unsigned* cnt;
    __device__ __forceinline__ void zstats(pg8::f32x4 (&acc)[2][2][4][2], const pg8::Unit& u, int wr, int wc, int fr, int fq) const {
        using pg8::BM; using pg8::HALF;
        asm volatile("" : "+v"(fr), "+v"(fq));
        const int row0 = u.pm * BM + wr * 64 + fr, col0 = u.pn * BM + wc * 32 + 4 * fq; const int b = (u.pm * BM) / SEQ;
        pg8::f32x4 gv[2][2];
#pragma unroll
        for (int bj = 0; bj < 2; ++bj)
#pragma unroll
            for (int n = 0; n < 2; ++n) gv[bj][n] = *(const pg8::f32x4*)(gate + b * DM + col0 + bj * HALF + n * 16);
#pragma unroll
        for (int ai = 0; ai < 2; ++ai)
#pragma unroll
            for (int m = 0; m < 4; ++m) { const int row = row0 + ai * HALF + m * 16; const size_t off = (size_t)row * DM + col0;
                float s = 0.f;
#pragma unroll
                for (int bj = 0; bj < 2; ++bj)
#pragma unroll
                    for (int n = 0; n < 2; ++n) { const pg8::f32x4 xv = *(const pg8::f32x4*)(x + off + bj * HALF + n * 16);
                        const pg8::f32x4 z = xv * ALPHA + gv[bj][n] * acc[ai][bj][m][n]; acc[ai][bj][m][n] = z; s += (z[0] + z[1]) + (z[2] + z[3]); }
                s += __shfl_xor(s, 16); s += __shfl_xor(s, 32);
                const float mw = s * (1.0f / 64.0f); float q = 0.f;
#pragma unroll
                for (int bj = 0; bj < 2; ++bj)
#pragma unroll
                    for (int n = 0; n < 2; ++n) { const pg8::f32x4 d = acc[ai][bj][m][n] - mw; q += (d[0] * d[0] + d[1] * d[1]) + (d[2] * d[2] + d[3] * d[3]); }
                q += __shfl_xor(q, 16); q += __shfl_xor(q, 32);
                if (fq == 0) __hip_atomic_store(xbuf + (size_t)row * 32 + u.pn * 4 + wc, ((unsigned long long)__float_as_uint(q) << 32) | __float_as_uint(mw), __ATOMIC_RELAXED, __HIP_MEMORY_SCOPE_AGENT);
            }
    }
    __device__ __forceinline__ void publish(const pg8::Unit& u) const {
        asm volatile("s_waitcnt vmcnt(0)" ::: "memory");
        if ((threadIdx.x & 63) == 0) __hip_atomic_fetch_add(cnt + 64 * u.pm, 1u, __ATOMIC_RELAXED, __HIP_MEMORY_SCOPE_AGENT);
    }
    __device__ __forceinline__ void operator()(const pg8::f32x4 (&acc_c)[2][2][4][2], const pg8::Unit& u, int wr, int wc, int fr, int fq) const {
        using pg8::BM; using pg8::HALF;
        pg8::f32x4 (&acc)[2][2][4][2] = const_cast<pg8::f32x4 (&)[2][2][4][2]>(acc_c);
        zstats(acc, u, wr, wc, fr, fq);
        const int row0 = u.pm * BM + wr * 64 + fr, col0 = u.pn * BM + wc * 32 + 4 * fq;
#pragma unroll
        for (int ai = 0; ai < 2; ++ai)
#pragma unroll
            for (int m = 0; m < 4; ++m) { const size_t off = (size_t)(row0 + ai * HALF + m * 16) * DM + col0;
#pragma unroll
                for (int bj = 0; bj < 2; ++bj)
#pragma unroll
                    for (int n = 0; n < 2; ++n) *(pg8::f32x4*)(out + off + bj * HALF + n * 16) = acc[ai][bj][m][n]; }
        publish(u);
    }
    __device__ __forceinline__ void fused(pg8::f32x4 (&acc)[2][2][4][2], const pg8::Unit& u, int wr, int wc, int fr, int fq, PG8_LAS unsigned char* lds, int wid, int lane) const {
        using pg8::BM; using pg8::HALF;
        typedef float f32x2v __attribute__((ext_vector_type(2)));
        PG8_LAS f32x2v* PH = (PG8_LAS f32x2v*)(lds + 131072);
        PG8_LAS f32x2v* S = (PG8_LAS f32x2v*)(lds + 131072 + 4096);
        zstats(acc, u, wr, wc, fr, fq);
        publish(u);
        if (wid == 0) {
            unsigned spins = 0;
            while ((unsigned)__builtin_amdgcn_readfirstlane(__hip_atomic_load(cnt + 64 * u.pm, __ATOMIC_RELAXED, __HIP_MEMORY_SCOPE_AGENT)) < 64u) { __builtin_amdgcn_s_sleep(2); if (++spins > (1u << 22)) break; }
            __builtin_amdgcn_fence(__ATOMIC_ACQUIRE, "agent");
            asm volatile("s_waitcnt vmcnt(0)" ::: "memory");
        }
        asm volatile("s_waitcnt vmcnt(0) lgkmcnt(0)" ::: "memory"); __builtin_amdgcn_s_barrier(); asm volatile("" ::: "memory");
        { const int t = threadIdx.x, row = t >> 1, half = t & 1; const unsigned long long* sl = xbuf + (size_t)(u.pm * BM + row) * 32 + half * 16;
          float ms = 0.f, mq = 0.f, m2s = 0.f;
#pragma unroll
          for (int i = 0; i < 16; ++i) { const unsigned long long w = __hip_atomic_load(sl + i, __ATOMIC_RELAXED, __HIP_MEMORY_SCOPE_AGENT); const float mt = __uint_as_float((unsigned)w); ms += mt; mq += mt * mt; m2s += __uint_as_float((unsigned)(w >> 32)); }
          const float mh = ms * (1.0f / 16.0f);
          PH[row * 2 + half] = (f32x2v){mh, m2s + 64.0f * fmaxf(mq - 16.0f * mh * mh, 0.f)}; }
        asm volatile("s_waitcnt lgkmcnt(0)" ::: "memory"); __builtin_amdgcn_s_barrier(); asm volatile("" ::: "memory");
        if (threadIdx.x < 256) { const int row = threadIdx.x; const f32x2v a = PH[row * 2], bq = PH[row * 2 + 1];
            const float mean = 0.5f * (a.x + bq.x), da = a.x - mean, db = bq.x - mean; const float m2t = (a.y + bq.y) + 1024.0f * (da * da + db * db);
            S[row] = (f32x2v){mean, 1.0f / sqrtf(m2t * (1.0f / 2048.0f) + LN_EPS)}; }
        asm volatile("s_waitcnt lgkmcnt(0)" ::: "memory"); __builtin_amdgcn_s_barrier(); asm volatile("" ::: "memory");
        const int row0 = u.pm * BM + wr * 64 + fr, col0 = u.pn * BM + wc * 32 + 4 * fq;
#pragma unroll
        for (int bj = 0; bj < 2; ++bj)
#pragma unroll
            for (int n = 0; n < 2; ++n) { const int c = col0 + bj * HALF + n * 16;
                const pg8::f32x4 g2 = *(const pg8::f32x4*)(ln_g + c), b2 = *(const pg8::f32x4*)(ln_b + c), g1 = *(const pg8::f32x4*)(ln_g + c - 4 * BM), b1 = *(const pg8::f32x4*)(ln_b + c - 4 * BM);
#pragma unroll
                for (int ai = 0; ai < 2; ++ai)
#pragma unroll
                    for (int m = 0; m < 4; ++m) { const int rl = ai * HALF + wr * 64 + m * 16 + fr; const f32x2v sr = S[rl]; const size_t off = (size_t)(row0 + ai * HALF + m * 16) * DM + c;
                        const pg8::f32x4 z1 = *(const pg8::f32x4*)(out + off - 4 * BM);
                        *(pg8::f32x4*)(out + off) = (acc[ai][bj][m][n] - sr.x) * sr.y * g2 + b2;
                        acc[ai][bj][m][n] = (z1 - sr.x) * sr.y * g1 + b1; }
#pragma unroll
                for (int ai = 0; ai < 2; ++ai)
#pragma unroll
                    for (int m = 0; m < 4; ++m) { const size_t off = (size_t)(row0 + ai * HALF + m * 16) * DM + c; *(pg8::f32x4*)(out + off - 4 * BM) = acc[ai][bj][m][n]; } }
    }
};

__device__ __forceinline__ void p7_ln(Frame& F) {
    const int gw = F.vcu * NWAVES + F.wave, NGW = F.G * NWAVES;
    for (int row = 2 * gw; row < MX; row += 2 * NGW) {
        GAS f32x4* ra = (GAS f32x4*)(F.out + (size_t)row * DM) + F.lane; GAS f32x4* rb = ra + DM / 4;
        f32x4 va[8], vb[8]; float sa = 0.f, sb = 0.f;
#pragma unroll
        for (int j = 0; j < 8; ++j) { va[j] = ra[64 * j]; vb[j] = rb[64 * j]; }
#pragma unroll
        for (int j = 0; j < 8; ++j) { sa += (va[j].x + va[j].y) + (va[j].z + va[j].w); sb += (vb[j].x + vb[j].y) + (vb[j].z + vb[j].w); }
        const float ma = wave_sum(sa) * (1.f / DM), mb = wave_sum(sb) * (1.f / DM); float qa = 0.f, qb = 0.f;
#pragma unroll
        for (int j = 0; j < 8; ++j) { va[j] = va[j] - ma; vb[j] = vb[j] - mb; qa += (va[j].x * va[j].x + va[j].y * va[j].y) + (va[j].z * va[j].z + va[j].w * va[j].w); qb += (vb[j].x * vb[j].x + vb[j].y * vb[j].y) + (vb[j].z * vb[j].z + vb[j].w * vb[j].w); }
        const float rsa = 1.f / sqrtf(wave_sum(qa) * (1.f / DM) + LN_EPS), rsb = 1.f / sqrtf(wave_sum(qb) * (1.f / DM) + LN_EPS);
        f32x4 gg[8], bbv[8];
#pragma unroll
        for (int j = 0; j < 8; ++j) { const int k = 4 * F.lane + 256 * j; gg[j] = *(const f32x4*)(F.ln_g + k); bbv[j] = *(const f32x4*)(F.ln_b + k); }
#pragma unroll
        for (int j = 0; j < 8; ++j) { ra[64 * j] = va[j] * rsa * gg[j] + bbv[j]; rb[64 * j] = vb[j] * rsb * gg[j] + bbv[j]; }
    }
}

struct Args { const float* in[16]; float* out; unsigned char* ws; int ph_lo, ph_hi, li, pad; };
__global__ void __launch_bounds__(NWAVES * 64, 2) mk_fwd(Args args) {
    extern __shared__ __attribute__((aligned(16))) unsigned char lds[];
    Frame F;
    F.lds = (LAS unsigned char*)lds;
    F.MISC = (volatile LAS unsigned*)(F.lds + MISC_OFF);
    F.tid = threadIdx.x; F.lane = F.tid & 63; F.wave = __builtin_amdgcn_readfirstlane(F.tid >> 6);
    F.G = gridDim.x; { const int bx = blockIdx.x; F.vcu = (F.G % 8 == 0) ? (bx % 8) * (F.G / 8) + bx / 8 : bx; }
    unsigned char* ws = args.ws;
    F.ctl = (gu32*)(ws + WS_CTL);
    F.x = args.in[0]; F.c = args.in[1]; F.ctx = args.in[2]; F.c_ctx = args.in[3]; F.w_mod = args.in[4]; F.b_mod = args.in[5]; F.w_in = args.in[6];
    F.conv_w = args.in[7]; F.conv_b = args.in[8]; F.hg_lb = args.in[9]; F.ml_gate_b = args.in[10]; F.hg_norm_w = args.in[11]; F.ml_norm_w = args.in[12];
    F.w_out = args.in[13]; F.ln_g = args.in[14]; F.ln_b = args.in[15]; F.out = args.out;
    F.modp = (float*)(ws + WS_MODP); F.gate = (float*)(ws + WS_GATE);
    F.QTF = (bf16*)(ws + WS_WINT); F.PE = (float*)(ws + WS_PE); F.MLS = (float*)(ws + WS_MLS); F.DEC = (float*)(ws + WS_DEC); F.MLW = (bf16*)(ws + WS_MLW); F.DQP = (float*)(ws + WS_DQP);
    F.WinT = (bf16*)(ws + WS_WINT); F.WoutT = (bf16*)(ws + WS_WOUTT); F.XN = (bf16*)(ws + WS_XN); F.U = (bf16*)(ws + WS_U);
    F.OAF = (bf16*)args.out; F.OAB = F.OAF + (size_t)MX * WA; F.HBF = F.OAB + (size_t)MX * WA; F.HBB = F.HBF + (size_t)MX * WB;
    for (int u = F.tid; u < (LDS_BYTES - LDSCTL_OFF) / 4; u += NT) ((LAS unsigned*)(F.lds + LDSCTL_OFF))[u] = 0u;
    __syncthreads();
    XcdBarrier bar; bar.bar = (unsigned*)(F.ctl + CW_BAR); bar.x = 0; bar.st = nullptr;
    if (MK_N_LAUNCHES == 1) bar = xcd_barrier_post((unsigned*)(F.ctl + CW_BAR), F.MISC + 8);
    const int lo = args.ph_lo, hi = args.ph_hi;
#ifndef PH_MASK
#define PH_MASK 255
#endif
#define PHON(k) ((PH_MASK >> (k)) & 1)
#ifndef DUP_MASK
#define DUP_MASK 0
#endif
#define DUP(k) ((DUP_MASK >> (k)) & 1)
#ifndef FUSE_LN
#define FUSE_LN 0
#endif
#ifndef DUP4S
#define DUP4S 0
#endif
#ifndef DUP4W
#define DUP4W 3
#endif
#ifndef DUP3W
#define DUP3W 7
#endif
#define IN(k) (lo <= (k) && (k) < hi)
#define SEAM(k) do { if (IN(k) && IN((k) + 1)) xcd_barrier(bar); } while (0)
    if (PHON(0) && IN(0)) { p0_prep(F); if (DUP(0)) p0_prep(F); } SEAM(0);
    if (PHON(1) && IN(1)) { p1_lnmod(F); if (DUP(1)) p1_lnmod(F); } SEAM(1);
    if (PHON(2) && IN(2)) { pg8::Gemm g{F.XN, F.WinT, MALL, NU, DM}; pg8::StaticOrder S; S.init(MALL, NU, F.G, (int)blockIdx.x);
        pg8::EpiBf16<0> E{F.U, NU, nullptr, 0, 0, 1.f};
        pg8::gemm_phase<pg8::EpiBf16<0>, pg8::StaticOrder, PG8_ALIGN, PG8_SP2>(F.lds + RING_OFF, g, S, E); } SEAM(2);
    if (PHON(3) && IN(3)) { if (DUP(3)) { if (DUP3W & 1) p3_hg_prep<true>(F); if (DUP3W & 2) p3_conv(F); if (DUP3W & 4) p3_ml_scalars(F); } p3_conv(F); if (HG_MFMA) p3_hg_prep<false>(F); if (ML_MFMA) p3_ml_scalars(F); xcd_barrier(bar); p3b_ml_scores(F); if (DUP(6)) p3b_ml_scores(F); } SEAM(3);
    if (PHON(4) && IN(4)) { if (DUP(4)) p4_scan<DUP4W, DUP4S>(F); p4_scan<3>(F); } SEAM(4);
    if (PHON(5) && IN(5)) { p5_combine(F); if (DUP(5)) p5_combine(F); if (DUP(7)) { xcd_barrier(bar); xcd_barrier(bar); xcd_barrier(bar); xcd_barrier(bar); } } SEAM(5);
    if (PHON(6) && IN(6)) { pg8::Gemm g{F.XN, F.WoutT, MX, DM, DM}; pg8::StaticOrder S; S.init(MX, DM, F.G, (int)blockIdx.x);
        if (F.G == 256 && FUSE_LN) { PanelOrder PO{F.vcu}; EpiLnFused E{F.x, F.gate, F.out, F.ln_g, F.ln_b, (unsigned long long*)(args.ws + WS_XB), (unsigned*)(F.ctl + CW_PANEL)};
            pg8::gemm_phase<EpiLnFused, PanelOrder, PG8_ALIGN, PG8_SP2>(F.lds + RING_OFF, g, PO, E); }
        else { EpiResid E{F.x, F.gate, F.out};
            pg8::gemm_phase<EpiResid, pg8::StaticOrder, PG8_ALIGN, PG8_SP2>(F.lds + RING_OFF, g, S, E);
            if (DUP(8)) { __syncthreads(); pg8::gemm_phase<EpiResid, pg8::StaticOrder, PG8_ALIGN, PG8_SP2>(F.lds + RING_OFF, g, S, E); } } }
    if (!(F.G == 256 && FUSE_LN)) { SEAM(6); if (PHON(7) && IN(7)) { p7_ln(F); } }
#undef IN
#undef SEAM
}

extern "C" void kernel_launch(void* const* d_in, const int* in_sizes, int n_in, void* d_out, int out_size, void* d_ws, size_t ws_size, hipStream_t stream) {
    static int grid = 0;
    if (grid == 0) {
        if (n_in != 16 || out_size != MX * DM || ws_size < WS_END) { fprintf(stderr, "kernel_launch: unexpected shapes (n_in %d out %d ws %zu)\n", n_in, out_size, ws_size); grid = -1; return; }
        int dev = 0, cus = 0, per_cu = 0;
        if (hipGetDevice(&dev) != hipSuccess || hipDeviceGetAttribute(&cus, hipDeviceAttributeMultiprocessorCount, dev) != hipSuccess) { grid = -1; return; }
        if (hipFuncSetAttribute((const void*)mk_fwd, hipFuncAttributeMaxDynamicSharedMemorySize, LDS_BYTES) != hipSuccess) { fprintf(stderr, "kernel_launch: hipFuncSetAttribute failed\n"); grid = -1; return; }
        if (hipOccupancyMaxActiveBlocksPerMultiprocessor(&per_cu, (const void*)mk_fwd, NT, LDS_BYTES) != hipSuccess || per_cu < 1) { fprintf(stderr, "kernel_launch: occupancy query says %d\n", per_cu); per_cu = 1; }
        (void)hipGetLastError();
        grid = cus;
    }
    if (grid < 0) return;
    if (hipMemsetAsync((char*)d_ws + WS_CTL, 0, CTL_ZERO_BYTES, stream) != hipSuccess) { fprintf(stderr, "kernel_launch: memset failed\n"); return; }
    Args a{};
    for (int i = 0; i < 16; ++i) a.in[i] = (const float*)d_in[i];
    a.out = (float*)d_out; a.ws = (unsigned char*)d_ws;
    for (int li = 0; li < MK_N_LAUNCHES; ++li) {
        a.ph_lo = (MK_N_LAUNCHES == 1) ? 0 : li; a.ph_hi = (MK_N_LAUNCHES == 1) ? N_PHASES : li + 1; a.li = li;
        hipLaunchKernelGGL(mk_fwd, dim3(grid), dim3(NT), LDS_BYTES, stream, a);
        const hipError_t le = hipPeekAtLastError();
        if (le != hipSuccess) { fprintf(stderr, "kernel_launch: launch %d failed: %s\n", li, hipGetErrorName(le)); break; }
    }
}
```

```cpp
#include <hip/hip_runtime.h>
#include <cstdio>
#include <cstdint>
namespace pg8 {
#define PG8_LAS __attribute__((address_space(3)))
typedef unsigned short bf16_t;
typedef short bf16x8 __attribute__((ext_vector_type(8)));
typedef float f32x4 __attribute__((ext_vector_type(4)));
typedef unsigned u32x4 __attribute__((ext_vector_type(4)));
constexpr int BM = 256, BK = 64, HALF = 128, HTB = HALF * BK * 2  , STAGE_BYTES = 8 * HTB, NXCD = 8, WGM = 4;

__host__ __device__ __forceinline__ int lds_byte(int r, int c) { const int st = (r >> 4) * 2 + (c >> 5), rr = r & 15, cc = c & 31, ob = rr * 64 + cc * 2; return st * 1024 + (ob ^ (((ob >> 9) & 1) << 5)); }
__host__ __device__ __forceinline__ void stage_rc(int b, int& R, int& C) { const int st = b / 1024, sb = b % 1024, swz = sb ^ (((sb >> 9) & 1) << 5); R = (st >> 1) * 16 + swz / 64; C = (st & 1) * 32 + (swz % 64) / 2; }
__host__ __device__ __forceinline__ int perm32(int rho) { const int n = rho >> 4, i = rho & 15; return 8 * (i >> 2) + 4 * n + (i & 3); }

struct Unit { int pm, pn; };
struct Gemm { const bf16_t* A; const bf16_t* Bt; int M, N, K; };

struct StaticOrder {
    int nM, nN, nwg, G, c;
    __host__ __device__ void init(int M, int N, int G_, int c_) { nM = M / BM; nN = N / BM; nwg = nM * nN; G = G_; c = c_; }
    __host__ __device__ bool next(int i, Unit& u) const {
        const long L = (long)i * G + c; if (L >= nwg) return false;
        int wgid = (int)L; { const int q = nwg / NXCD, r = nwg % NXCD, xcd = wgid % NXCD, off = wgid / NXCD; wgid = (xcd < r ? xcd * (q + 1) : r * (q + 1) + (xcd - r) * q) + off; }
        const int nig = WGM * nN, gid = wgid / nig, fm = gid * WGM, gsz = (nM - fm) < WGM ? (nM - fm) : WGM;
        u.pm = fm + ((wgid % nig) % gsz); u.pn = (wgid % nig) / gsz; return true;
    }
    __device__ __forceinline__ void a_ready(const Unit&) const {}
    __device__ __forceinline__ void done(const Unit&) const {}
};

__device__ __forceinline__ unsigned cvt_pk_bf16(float lo, float hi) { unsigned r; asm volatile("v_cvt_pk_bf16_f32 %0, %1, %2" : "=v"(r) : "v"(lo), "v"(hi)); return r; }
typedef float f32x2 __attribute__((ext_vector_type(2)));
__device__ __forceinline__ f32x2 gelu_pk(f32x2 v) {
    const f32x2 av = __builtin_elementwise_abs(v), d = av * 0.2316418882f + 1.0f;
    f32x2 t; t.x = __builtin_amdgcn_rcpf(d.x); t.y = __builtin_amdgcn_rcpf(d.y);
    f32x2 q = t * 0.5307027145f + (-0.7265760135f); q = q * t + 0.7107068705f; q = q * t + (-0.142248368f); q = q * t + 0.127414796f; q = q * t;
    const f32x2 s = (v * v) * (-0.72134752044f);
    f32x2 e; e.x = __builtin_amdgcn_exp2f(s.x); e.y = __builtin_amdgcn_exp2f(s.y);
    const f32x2 m = v * (q * e), r = v - m;
    f32x2 o; o.x = v.x < 0.f ? m.x : r.x; o.y = v.y < 0.f ? m.y : r.y; return o;
}

template <int ACT  > struct EpiBf16 {
    static constexpr bool PERM = true, AFTER_DRAIN = false; static_assert(ACT == 0 || ACT == 1 || ACT == 2, "EpiBf16: ACT is 0 (none), 1 (gelu_pk) or 2 (SiLU on the column tiles pn < act_tiles)");
    bf16_t* O; int ldc; const float* bias; int split_cols; size_t split_stride; float scale0; int act_tiles;
    __device__ __forceinline__ void operator()(const f32x4 (&acc)[2][2][4][2], const Unit& u, int wr, int wc, int fr, int fq) const {
        const int row0 = u.pm * BM + wr * 64 + fr; int colt = u.pn * BM; bf16_t* base = O;
        float sc = 1.f; if (split_cols) { const int t = colt / split_cols; base += (size_t)t * split_stride; colt -= t * split_cols; if (t == 0) sc = scale0; }
        const int col0 = colt + wc * 32 + 8 * fq, bcol0 = u.pn * BM + wc * 32 + 8 * fq;
        f32x4 bv[2][2];
#pragma unroll
        for (int bj = 0; bj < 2; ++bj)
#pragma unroll
            for (int n = 0; n < 2; ++n) bv[bj][n] = bias ? *(const f32x4*)(bias + bcol0 + bj * HALF + 4 * n) : (f32x4){0.f, 0.f, 0.f, 0.f};
#pragma unroll
        for (int ai = 0; ai < 2; ++ai)
#pragma unroll
            for (int m = 0; m < 4; ++m) { bf16_t* rowp = base + (size_t)(row0 + ai * HALF + m * 16) * ldc + col0;
#pragma unroll
                for (int bj = 0; bj < 2; ++bj) { f32x4 v0 = acc[ai][bj][m][0] + bv[bj][0], v1 = acc[ai][bj][m][1] + bv[bj][1];
                    if (ACT == 1) { f32x2 a = gelu_pk((f32x2){v0[0], v0[1]}), b = gelu_pk((f32x2){v0[2], v0[3]}), c = gelu_pk((f32x2){v1[0], v1[1]}), d = gelu_pk((f32x2){v1[2], v1[3]});
                        v0 = (f32x4){a.x, a.y, b.x, b.y}; v1 = (f32x4){c.x, c.y, d.x, d.y}; }
                    if (ACT == 2 && u.pn < act_tiles) {
#pragma unroll
                        for (int e = 0; e < 4; ++e) { v0[e] = v0[e] * __builtin_amdgcn_rcpf(1.0f + __expf(-v0[e])); v1[e] = v1[e] * __builtin_amdgcn_rcpf(1.0f + __expf(-v1[e])); } }
                    v0 = v0 * sc; v1 = v1 * sc; u32x4 w; w.x = cvt_pk_bf16(v0[0], v0[1]); w.y = cvt_pk_bf16(v0[2], v0[3]); w.z = cvt_pk_bf16(v1[0], v1[1]); w.w = cvt_pk_bf16(v1[2], v1[3]);
                    *(u32x4*)(rowp + bj * HALF) = w; } }
    }
};
template <class Epi, class Sched, bool ALIGN_EPI = false, bool SP2 = false>
__device__ __forceinline__ void gemm_phase(PG8_LAS unsigned char* lds, const Gemm g, const Sched& S, const Epi& E) {
    const int tid = threadIdx.x, wid = __builtin_amdgcn_readfirstlane(tid >> 6), lane = tid & 63, wr = wid >> 2, wc = wid & 3, fr = lane & 15, fq = lane >> 4;
    const int K = g.K, nt = K / BK;
    unsigned voffA[2], voffB[2];
#pragma unroll
    for (int i = 0; i < 2; ++i) { int R, C; stage_rc(tid * 16 + i * 8192, R, C); const int Rb = Epi::PERM ? ((R & ~31) + perm32(R & 31)) : R;
        voffA[i] = (unsigned)(R * K + C) * 2u; voffB[i] = (unsigned)(Rb * K + C) * 2u; }
    const size_t kstep = (size_t)(BK * 2);
    const size_t hstep = (size_t)HALF * K * 2;
    const size_t tstep = 2 * hstep;
    const unsigned ldsw = (unsigned)wid * 1024u;
    const int aoff = lds_byte(wr * 64 + fr, fq * 8), boff = lds_byte(wc * 32 + fr, fq * 8);
#define PG8_SA(b, h) (((b) * 2 + (h)) * HTB)
#define PG8_SB(b, h) ((4 + (b) * 2 + (h)) * HTB)
#define PG8_STAGE(bufoff, gbase, voff) do { _Pragma("unroll") for (int _i = 0; _i < 2; ++_i) \
        __builtin_amdgcn_global_load_lds((const unsigned*)((const char*)(gbase) + (voff)[_i]), (PG8_LAS unsigned*)(lds + (bufoff) + ldsw + _i * 8192), 16, 0, 0); } while (0)
#define PG8_LDA(dst, b, h) do { _Pragma("unroll") for (int m = 0; m < 4; ++m) _Pragma("unroll") for (int k = 0; k < 2; ++k) dst[m][k] = *(const PG8_LAS bf16x8*)(lds + PG8_SA(b, h) + aoff + m * 2048 + k * 1024); } while (0)
#define PG8_LDB(dst, b, h) do { _Pragma("unroll") for (int n = 0; n < 2; ++n) _Pragma("unroll") for (int k = 0; k < 2; ++k) dst[n][k] = *(const PG8_LAS bf16x8*)(lds + PG8_SB(b, h) + boff + n * 2048 + k * 1024); } while (0)
#define PG8_MMA(ai, bj, At, Bt) do { __builtin_amdgcn_s_setprio(1); _Pragma("unroll") for (int m = 0; m < 4; ++m) _Pragma("unroll") for (int n = 0; n < 2; ++n) _Pragma("unroll") for (int k = 0; k < 2; ++k) \
        acc[ai][bj][m][n] = __builtin_amdgcn_mfma_f32_16x16x32_bf16(Bt[n][k], At[m][k], acc[ai][bj][m][n], 0, 0, 0); __builtin_amdgcn_s_setprio(0); } while (0)
#define PG8_WAIT_V(n) asm volatile("s_waitcnt vmcnt(" #n ")" ::: "memory")
#define PG8_WAIT_L(n) asm volatile("s_waitcnt lgkmcnt(" #n ")" ::: "memory")
#define PG8_BAR __builtin_amdgcn_s_barrier()
#define PG8_SCHED __builtin_amdgcn_sched_barrier(0)
    Unit cur, nxt; int ui = 0;
    if (!S.next(0, cur)) return;
    f32x4 acc[2][2][4][2];
#pragma unroll
    for (int a = 0; a < 2; ++a)
#pragma unroll
        for (int b = 0; b < 2; ++b)
#pragma unroll
            for (int m = 0; m < 4; ++m)
#pragma unroll
                for (int n = 0; n < 2; ++n) acc[a][b][m][n] = (f32x4){0.f, 0.f, 0.f, 0.f};
    bf16x8 At[4][2], B0[2][2], B1[2][2];
    const char* cA = (const char*)g.A + (size_t)cur.pm * tstep; const char* cB = (const char*)g.Bt + (size_t)cur.pn * tstep;
    S.a_ready(cur);
    if constexpr (SP2) {
        PG8_STAGE(PG8_SB(0, 0), cB, voffB); PG8_STAGE(PG8_SB(0, 1), cB + hstep, voffB); PG8_STAGE(PG8_SA(0, 0), cA, voffA); PG8_STAGE(PG8_SA(0, 1), cA + hstep, voffA);
        if (wr == 1) PG8_BAR;
        PG8_WAIT_V(2); PG8_BAR;
        PG8_STAGE(PG8_SB(1, 0), cB + kstep, voffB); PG8_STAGE(PG8_SA(1, 0), cA + kstep, voffA); PG8_STAGE(PG8_SB(1, 1), cB + hstep + kstep, voffB);
        PG8_WAIT_V(6); PG8_BAR;
    } else {
        PG8_STAGE(PG8_SB(0, 0), cB, voffB); PG8_STAGE(PG8_SA(0, 0), cA, voffA); PG8_STAGE(PG8_SB(0, 1), cB + hstep, voffB); PG8_STAGE(PG8_SA(0, 1), cA + hstep, voffA);
        if (wr == 1) PG8_BAR;
        PG8_WAIT_V(4); PG8_BAR;
        PG8_STAGE(PG8_SB(1, 0), cB + kstep, voffB); PG8_STAGE(PG8_SA(1, 0), cA + kstep, voffA); PG8_STAGE(PG8_SB(1, 1), cB + hstep + kstep, voffB);
        PG8_WAIT_V(6); PG8_BAR;
    }
    for (;;) {
        const bool has_next = S.next(ui + 1, nxt);
        const char* nA = has_next ? (const char*)g.A + (size_t)nxt.pm * tstep : cA; const char* nB = has_next ? (const char*)g.Bt + (size_t)nxt.pn * tstep : cB;
        for (int t = 0; t < nt; t += 2) {
            const bool last = (t == nt - 2);
            const char* a1 = cA + (size_t)(t + 1) * kstep;
            const char* a2 = last ? nA : cA + (size_t)(t + 2) * kstep; const char* b2 = last ? nB : cB + (size_t)(t + 2) * kstep;
            const char* a3 = a2 + kstep; const char* b3 = b2 + kstep;
            if (last && has_next) S.a_ready(nxt);
            if constexpr (SP2) {
            PG8_LDB(B0, 0, 0); PG8_LDB(B1, 0, 1); PG8_SCHED; PG8_LDA(At, 0, 0); PG8_STAGE(PG8_SA(1, 1), a1 + hstep, voffA);
            PG8_WAIT_V(8); PG8_WAIT_L(0); PG8_BAR; PG8_MMA(0, 0, At, B0); PG8_MMA(0, 1, At, B1); PG8_BAR; PG8_SCHED;
            PG8_LDA(At, 0, 1); PG8_STAGE(PG8_SB(0, 0), b2, voffB); PG8_STAGE(PG8_SB(0, 1), b2 + hstep, voffB); PG8_STAGE(PG8_SA(0, 0), a2, voffA);
            PG8_WAIT_V(8); PG8_WAIT_L(0); PG8_BAR; PG8_MMA(1, 0, At, B0); PG8_MMA(1, 1, At, B1); PG8_BAR; PG8_SCHED;
            PG8_LDB(B0, 1, 0); PG8_LDB(B1, 1, 1); PG8_SCHED; PG8_LDA(At, 1, 0); PG8_STAGE(PG8_SA(0, 1), a2 + hstep, voffA);
            PG8_WAIT_V(8); PG8_WAIT_L(0); PG8_BAR; PG8_MMA(0, 0, At, B0); PG8_MMA(0, 1, At, B1); PG8_BAR; PG8_SCHED;
            PG8_LDA(At, 1, 1); PG8_STAGE(PG8_SB(1, 0), b3, voffB); PG8_STAGE(PG8_SB(1, 1), b3 + hstep, voffB); PG8_STAGE(PG8_SA(1, 0), a3, voffA);
            PG8_WAIT_V(8); PG8_WAIT_L(0); PG8_BAR; PG8_MMA(1, 0, At, B0); PG8_MMA(1, 1, At, B1); PG8_BAR; PG8_SCHED;
            } else {
            PG8_LDB(B0, 0, 0); PG8_SCHED; PG8_LDA(At, 0, 0); PG8_STAGE(PG8_SA(1, 1), a1 + hstep, voffA);
            PG8_WAIT_L(8); PG8_BAR; PG8_WAIT_L(0); PG8_MMA(0, 0, At, B0); PG8_BAR; PG8_SCHED;
            PG8_LDB(B1, 0, 1); PG8_STAGE(PG8_SB(0, 0), b2, voffB);
            PG8_BAR; PG8_WAIT_L(0); PG8_MMA(0, 1, At, B1); PG8_BAR;
            PG8_LDA(At, 0, 1); PG8_STAGE(PG8_SA(0, 0), a2, voffA);
            PG8_BAR; PG8_WAIT_L(0); PG8_MMA(1, 0, At, B0); PG8_BAR; PG8_SCHED;
            PG8_STAGE(PG8_SB(0, 1), b2 + hstep, voffB);
            PG8_WAIT_V(6); PG8_BAR; PG8_MMA(1, 1, At, B1); PG8_BAR;
            PG8_LDB(B0, 1, 0); PG8_SCHED; PG8_LDA(At, 1, 0); PG8_STAGE(PG8_SA(0, 1), a2 + hstep, voffA);
            PG8_WAIT_L(8); PG8_BAR; PG8_WAIT_L(0); PG8_MMA(0, 0, At, B0); PG8_BAR; PG8_SCHED;
            PG8_LDB(B1, 1, 1); PG8_STAGE(PG8_SB(1, 0), b3, voffB);
            PG8_BAR; PG8_WAIT_L(0); PG8_MMA(0, 1, At, B1); PG8_BAR;
            PG8_LDA(At, 1, 1); PG8_STAGE(PG8_SA(1, 0), a3, voffA);
            PG8_BAR; PG8_WAIT_L(0); PG8_MMA(1, 0, At, B0); PG8_BAR; PG8_SCHED;
            PG8_STAGE(PG8_SB(1, 1), b3 + hstep, voffB);
            PG8_WAIT_V(6); PG8_BAR; PG8_MMA(1, 1, At, B1); PG8_BAR;
            }
        }
        if constexpr (ALIGN_EPI) { if (wr == 0) PG8_BAR; }
        if constexpr (!Epi::AFTER_DRAIN) { E(acc, cur, wr, wc, fr, fq); S.done(cur); }
        else { if (has_next) { E(acc, cur, wr, wc, fr, fq); S.done(cur); } }
        if (!has_next) break;
#pragma unroll
        for (int a = 0; a < 2; ++a)
#pragma unroll
            for (int b = 0; b < 2; ++b)
#pragma unroll
                for (int m = 0; m < 4; ++m)
#pragma unroll
                    for (int n = 0; n < 2; ++n) acc[a][b][m][n] = (f32x4){0.f, 0.f, 0.f, 0.f};
        cur = nxt; cA = nA; cB = nB; ++ui;
        if constexpr (ALIGN_EPI) { if (wr == 1) PG8_BAR; }
    }
    PG8_WAIT_V(0);
    if constexpr (!ALIGN_EPI) { if (wr == 0) PG8_BAR; }
    PG8_BAR;
    if constexpr (Epi::AFTER_DRAIN) { E.fused(acc, cur, wr, wc, fr, fq, lds, wid, lane); S.done(cur); }
#undef PG8_SA
#undef PG8_SB
#undef PG8_STAGE
#undef PG8_LDA
#undef PG8_LDB
#undef PG8_MMA
#undef PG8_WAIT_V
#undef PG8_WAIT_L
#undef PG8_BAR
#undef PG8_SCHED
}
}

#ifndef PG8_SP2
#define PG8_SP2 true
#endif
#ifndef PG8_ALIGN
#define PG8_ALIGN true
#endif
#define GAS __attribute__((address_space(1)))
#define LAS __attribute__((address_space(3)))
typedef unsigned short bf16;
typedef unsigned v4u __attribute__((ext_vector_type(4)));
typedef float f32x4 __attribute__((ext_vector_type(4)));
typedef short bf16x8 __attribute__((ext_vector_type(8)));
typedef GAS unsigned gu32;
typedef GAS unsigned long long gu64;
#define RLX_AGENT __ATOMIC_RELAXED, __HIP_MEMORY_SCOPE_AGENT
#define LDS_WAIT() asm volatile("s_waitcnt lgkmcnt(0)" ::: "memory")
#define VM_WAIT() asm volatile("s_waitcnt vmcnt(0)" ::: "memory")
__device__ __forceinline__ unsigned long long rt() { return __builtin_amdgcn_s_memrealtime(); }
__device__ __forceinline__ unsigned f2bf(float f) { unsigned u = __builtin_bit_cast(unsigned, f); return (u + 0x7fffu + ((u >> 16) & 1u)) >> 16; }
__device__ __forceinline__ unsigned pk2(float lo, float hi) { return f2bf(lo) | (f2bf(hi) << 16); }

#define XB_TMO      128
#define XB_XCNT(j)  (256  + 64 * (j))
#define XB_XSUB(j)  (1280 + 64 * (j))
#define XB_XGEN(j)  (2304 + 64 * (j))
#define XB_TOP      3328
#define XB_TOPGEN   3392
#define XCD_BAR_WORDS 3456
#define XB_SPIN_CAP (1u << 18)

__device__ __forceinline__ unsigned xb_ld(unsigned* p)              { return __hip_atomic_load(p, __ATOMIC_RELAXED, __HIP_MEMORY_SCOPE_AGENT); }
__device__ __forceinline__ unsigned xb_add(unsigned* p, unsigned v) { return __hip_atomic_fetch_add(p, v, __ATOMIC_RELAXED, __HIP_MEMORY_SCOPE_AGENT); }
__device__ __forceinline__ unsigned xb_xcc_id() { return (unsigned)__builtin_amdgcn_s_getreg((3 << 11) | 20) & 0xFu; }
#define XB_SPIN(cond, bar) do { unsigned _sp = 0; while (cond) { __builtin_amdgcn_s_sleep(1); \
    if ((++_sp & 255u) == 0u) { if (xb_ld(&(bar)[XB_TMO])) break; if (_sp > XB_SPIN_CAP) { atomicAdd(&(bar)[XB_TMO], 1u); break; } } } } while (0)

struct XcdBarrier {
    unsigned* bar; unsigned x;
    volatile LAS unsigned* st;
};

__device__ __forceinline__ XcdBarrier xcd_barrier_post(unsigned* bar, volatile LAS unsigned* st) {
    XcdBarrier b; b.bar = bar; b.x = xb_xcc_id(); b.st = st;
    if (threadIdx.x == 0) (void)xb_add(&bar[XB_XCNT(b.x)], 1u);
    return b;
}
__device__ __forceinline__ void xcd_barrier_complete(unsigned* bar, unsigned x, unsigned& nloc, unsigned& nx) {
    const unsigned G = gridDim.x * gridDim.y * gridDim.z;
    unsigned sum, cnt, mine, sp = 0u;
    for (;;) {
        sum = 0u; cnt = 0u; mine = 0u;
#pragma unroll
        for (unsigned j = 0; j < 16; ++j) { const unsigned c = xb_ld(&bar[XB_XCNT(j)]); sum += c; cnt += (c > 0u) ? 1u : 0u; mine = (j == x) ? c : mine; }
        if (sum == G) break;
        __builtin_amdgcn_s_sleep(1);
        if ((++sp & 255u) == 0u) { if (xb_ld(&bar[XB_TMO])) break; if (sp > XB_SPIN_CAP) { atomicAdd(&bar[XB_TMO], 1u); break; } }
    }
    nloc = mine > 0u ? mine : 1u; nx = cnt > 0u ? cnt : 1u;
}

__device__ __forceinline__ void xcd_barrier(const XcdBarrier& b) {
    asm volatile("s_waitcnt vmcnt(0)" ::: "memory");
    __syncthreads();
    if (threadIdx.x == 0) {
        unsigned* bar = b.bar;
        __builtin_amdgcn_s_waitcnt(0);
        unsigned nloc = b.st[0], nx = b.st[1];
        if (nloc == 0u) { xcd_barrier_complete(bar, b.x, nloc, nx); b.st[0] = nloc; b.st[1] = nx; }
        const unsigned old = xb_add(&bar[XB_XSUB(b.x)], 1u);
        const unsigned gen = old / nloc;
        if (old + 1u == (gen + 1u) * nloc) {
            __builtin_amdgcn_fence(__ATOMIC_RELEASE, "agent");
            asm volatile("s_waitcnt vmcnt(0)" ::: "memory");
            const unsigned og = xb_add(&bar[XB_TOP], 1u);
            const unsigned tg = og / nx;
            if (og + 1u == (tg + 1u) * nx) xb_add(&bar[XB_TOPGEN], 1u);
            else XB_SPIN(xb_ld(&bar[XB_TOPGEN]) == tg, bar);
            __builtin_amdgcn_fence(__ATOMIC_ACQUIRE, "agent");
            xb_add(&bar[XB_XGEN(b.x)], 1u);
            asm volatile("s_waitcnt vmcnt(0)" ::: "memory");
        } else {
            XB_SPIN(xb_ld(&bar[XB_XGEN(b.x)]) == gen, bar);
            __builtin_amdgcn_fence(__ATOMIC_ACQUIRE, "agent");
            asm volatile("s_waitcnt vmcnt(0)" ::: "memory");
        }
    }
    __syncthreads();
}
constexpr int NWAVES = 8, NT = NWAVES * 64;
constexpr int BATCH = 4, SEQ = 4096, DM = 2048, CTXL = 256;
constexpr int MX = BATCH * SEQ, MC = BATCH * CTXL, MALL = MX + MC;
constexpr int WA = 1024, WB = 1024, NIN = 10256, NU = 10496;
constexpr int C_AQ = 0, C_AFF = 1024, C_AFB = 2048, C_AI = 3072, C_AZ = 4096, C_BQK = 5120, C_BV = 7168, C_BO = 8192, C_BZ = 9216, C_BG = 10240;
constexpr int HGH = 8, HGD = 128, MLH = 4, MLD = 256;
constexpr float ALPHA = 1.189207115002721f;
constexpr float LN_EPS = 1e-5f, NORM_EPS = 1e-6f;
constexpr int NMOD = 3 * DM;

#ifndef MK_N_LAUNCHES
#define MK_N_LAUNCHES 1
#endif
constexpr int N_PHASES = 8;

constexpr size_t MiB = 1u << 20;
constexpr size_t WS_CTL = 0, CTL_ZERO_BYTES = 1 * MiB;
constexpr size_t WS_MODP = 1 * MiB;
constexpr size_t WS_GATE = 3 * MiB;
constexpr size_t WS_WINT = 4 * MiB;
constexpr size_t WS_WOUTT = 45 * MiB;
constexpr size_t WS_XN = 53 * MiB;
constexpr size_t WS_U = 121 * MiB;
constexpr size_t WS_PE = 470 * MiB, WS_MLS = 473 * MiB, WS_DEC = 478 * MiB;
constexpr size_t WS_MLW = 479 * MiB;
constexpr size_t WS_DQP = 496 * MiB;
constexpr size_t WS_XB = 498 * MiB;
constexpr size_t WS_END = 502 * MiB;
static_assert(WS_WINT + (size_t)NU * DM * 2 <= WS_WOUTT && WS_WOUTT + (size_t)DM * DM * 2 <= WS_XN && WS_XN + (size_t)MALL * DM * 2 <= WS_U && WS_U + (size_t)MALL * NU * 2 <= WS_END, "d_ws map");
constexpr int CW_TMO = 0, CW_BAR = 4096, CW_PANEL = 16384;

constexpr int RING_OFF = 0, RING_BYTES = 131072;
constexpr int LDS_BYTES = 163840;
constexpr int LDSCTL_OFF = LDS_BYTES - 1024, MISC_OFF = LDSCTL_OFF + 320;

struct Frame {
    LAS unsigned char* lds;
    volatile LAS unsigned* MISC;
    gu32* ctl;
    int tid, lane, wave, vcu, G;
    const float *x, *c, *ctx, *c_ctx, *w_mod, *b_mod, *w_in, *conv_w, *conv_b, *hg_lb, *ml_gate_b, *hg_norm_w, *ml_norm_w, *w_out, *ln_g, *ln_b;
    float* out;
    float *modp, *gate;
    bf16 *WinT, *WoutT, *XN, *U;
    bf16 *QTF, *MLW; float *PE, *MLS, *DEC, *DQP;
    bf16 *OAF, *OAB, *HBF, *HBB;
};

typedef float f32x2_t __attribute__((ext_vector_type(2)));
#define LDS_BARRIER() do { asm volatile("s_waitcnt lgkmcnt(0)" ::: "memory"); __builtin_amdgcn_s_barrier(); asm volatile("" ::: "memory"); } while (0)
typedef __bf16 bf16x2_t __attribute__((ext_vector_type(2)));
__device__ __forceinline__ unsigned pkbf(float a, float b) { const f32x2_t v = {a, b}; return __builtin_bit_cast(unsigned, __builtin_convertvector(v, bf16x2_t)); }
__device__ __forceinline__ float bf2f(unsigned short u) { return __builtin_bit_cast(float, (unsigned)u << 16); }
__device__ __forceinline__ float lo2f(unsigned u) { return __builtin_bit_cast(float, u << 16); }
__device__ __forceinline__ float hi2f(unsigned u) { return __builtin_bit_cast(float, u & 0xffff0000u); }
__device__ __forceinline__ float siluf(float v) { return v / (1.f + __expf(-v)); }
__device__ __forceinline__ float sigmf(float v) { return 1.f / (1.f + __expf(-v)); }
__device__ __forceinline__ float wave_sum(float v) {
#pragma unroll
    for (int o = 1; o < 64; o <<= 1) v += __shfl_xor(v, o);
    return v;
}

__device__ __forceinline__ void transpose_item(const float* W, int ldw, int nvalid, int K, bf16* WT, LAS float* scr, int kb, int nb, int lane) {
    const int k0 = 64 * kb, n0 = 32 * nb; const int n_l = n0 + (lane & 31);
#pragma unroll 8
    for (int i = 0; i < 32; ++i) { const int kk = 2 * i + (lane >> 5); scr[kk * 33 + (lane & 31)] = n_l < nvalid ? W[(size_t)(k0 + kk) * ldw + n_l] : 0.f; }
    LDS_WAIT(); asm volatile("" ::: "memory");
    const int c = lane & 7;
#pragma unroll
    for (int j = 0; j < 4; ++j) { const int n = (lane >> 3) + 8 * j; const LAS float* s = scr + (8 * c) * 33 + n;
        v4u o; o.x = pk2(s[0 * 33], s[1 * 33]); o.y = pk2(s[2 * 33], s[3 * 33]); o.z = pk2(s[4 * 33], s[5 * 33]); o.w = pk2(s[6 * 33], s[7 * 33]);
        *(GAS v4u*)(WT + (size_t)(n0 + n) * K + k0 + 8 * c) = o; }
    LDS_WAIT(); asm volatile("" ::: "memory");
}
constexpr int KS2 = 2;
__device__ __forceinline__ void p0_prep(Frame& F) {
    LAS float* scr = (LAS float*)(F.lds + RING_OFF + F.wave * 16384);
    LAS float* red = (LAS float*)(F.lds + RING_OFF + 131072);
    for (int it = F.vcu; it < (NMOD / 64) * KS2; it += F.G) {
        const int cg = it >> 1, kh2 = it & 1, n = cg * 64 + F.lane, k0 = kh2 * 1024 + F.wave * 128;
#pragma unroll
        for (int rr = 0; rr < 5; ++rr)
#pragma unroll
            for (int j = 0; j < 2; ++j) { const int k = k0 + F.lane + 64 * j; const float v = rr < 4 ? F.c[rr * DM + k] : F.c_ctx[k]; scr[rr * 128 + F.lane + 64 * j] = siluf(v); }
        LDS_WAIT(); asm volatile("" ::: "memory");
        float a0 = 0.f, a1 = 0.f, a2 = 0.f, a3 = 0.f, a4 = 0.f;
#pragma unroll 16
        for (int k = 0; k < 128; ++k) { const float w = F.w_mod[(size_t)(k0 + k) * NMOD + n];
            a0 += scr[k] * w; a1 += scr[128 + k] * w; a2 += scr[256 + k] * w; a3 += scr[384 + k] * w; a4 += scr[512 + k] * w; }
        LAS float* rp = red + F.wave * 320 + F.lane; rp[0] = a0; rp[64] = a1; rp[128] = a2; rp[192] = a3; rp[256] = a4;
        __syncthreads();
        if (F.tid < 320) { float sacc = 0.f;
#pragma unroll
            for (int ww = 0; ww < 8; ++ww) sacc += red[ww * 320 + F.tid];
            const int rr = F.tid >> 6, nn = cg * 64 + (F.tid & 63);
            F.modp[((size_t)kh2 * 5 + rr) * NMOD + nn] = sacc + (kh2 == 0 ? F.b_mod[nn] : 0.f); }
        __syncthreads();
    }
    const int gw = F.vcu * NWAVES + F.wave, NGW = F.G * NWAVES;
    constexpr int NB_IN = NU / 32, I_IN = (DM / 64) * NB_IN, NB_OUT = DM / 32, I_OUT = (DM / 64) * NB_OUT;
    for (int it = gw; it < I_IN + I_OUT; it += NGW) {
        int r = it;
        if (r < I_IN) { transpose_item(F.w_in, NIN, NIN, DM, F.WinT, scr, r / NB_IN, r % NB_IN, F.lane); continue; } r -= I_IN;
        transpose_item(F.w_out, DM, DM, DM, F.WoutT, scr, r / NB_OUT, r % NB_OUT, F.lane);
    }
}

__device__ __forceinline__ void ln_mod_row2(Frame& F, const float* xa, const float* xb, bf16* oa, bf16* ob, const LAS float* shift, const LAS float* scale) {
    const GAS f32x4* ra = (const GAS f32x4*)xa + F.lane; const GAS f32x4* rb = (const GAS f32x4*)xb + F.lane;
    f32x4 va[8], vb[8]; float sa = 0.f, sb = 0.f;
#pragma unroll
    for (int j = 0; j < 8; ++j) { va[j] = ra[64 * j]; vb[j] = rb[64 * j]; }
#pragma unroll
    for (int j = 0; j < 8; ++j) { sa += (va[j].x + va[j].y) + (va[j].z + va[j].w); sb += (vb[j].x + vb[j].y) + (vb[j].z + vb[j].w); }
    const float ma = wave_sum(sa) * (1.f / DM), mb = wave_sum(sb) * (1.f / DM); float qa = 0.f, qb = 0.f;
#pragma unroll
    for (int j = 0; j < 8; ++j) { va[j] = va[j] - ma; vb[j] = vb[j] - mb; qa += (va[j].x * va[j].x + va[j].y * va[j].y) + (va[j].z * va[j].z + va[j].w * va[j].w); qb += (vb[j].x * vb[j].x + vb[j].y * vb[j].y) + (vb[j].z * vb[j].z + vb[j].w * vb[j].w); }
    const float rsa = 1.f / sqrtf(wave_sum(qa) * (1.f / DM) + LN_EPS), rsb = 1.f / sqrtf(wave_sum(qb) * (1.f / DM) + LN_EPS);
    GAS unsigned long long* o8a = (GAS unsigned long long*)oa + F.lane; GAS unsigned long long* o8b = (GAS unsigned long long*)ob + F.lane;
#pragma unroll
    for (int j = 0; j < 8; ++j) { const int k = 4 * F.lane + 256 * j; const f32x4 sc = *(const LAS f32x4*)(scale + k) + 1.f, sh = *(const LAS f32x4*)(shift + k);
        const f32x4 ha = va[j] * rsa * sc + sh, hb = vb[j] * rsb * sc + sh;
        o8a[64 * j] = (unsigned long long)pk2(ha.x, ha.y) | ((unsigned long long)pk2(ha.z, ha.w) << 32);
        o8b[64 * j] = (unsigned long long)pk2(hb.x, hb.y) | ((unsigned long long)pk2(hb.z, hb.w) << 32); }
}
__device__ __forceinline__ void ln_mod_row(Frame& F, const float* xrow, bf16* orow, const LAS float* shift, const LAS float* scale) {
    const GAS f32x4* xr = (const GAS f32x4*)xrow + F.lane;
    f32x4 v[8]; float s = 0.f;
#pragma unroll
    for (int j = 0; j < 8; ++j) { v[j] = xr[64 * j]; s += (v[j].x + v[j].y) + (v[j].z + v[j].w); }
    const float mean = wave_sum(s) * (1.f / DM); float s2 = 0.f;
#pragma unroll
    for (int j = 0; j < 8; ++j) { v[j] = v[j] - mean; s2 += (v[j].x * v[j].x + v[j].y * v[j].y) + (v[j].z * v[j].z + v[j].w * v[j].w); }
    const float rstd = 1.f / sqrtf(wave_sum(s2) * (1.f / DM) + LN_EPS);
    GAS unsigned long long* o8 = (GAS unsigned long long*)orow + F.lane;
#pragma unroll
    for (int j = 0; j < 8; ++j) { const int k = 4 * F.lane + 256 * j; const f32x4 sc = *(const LAS f32x4*)(scale + k), sh = *(const LAS f32x4*)(shift + k);
        const f32x4 h = v[j] * rstd * (sc + 1.f) + sh;
        o8[64 * j] = (unsigned long long)pk2(h.x, h.y) | ((unsigned long long)pk2(h.z, h.w) << 32); }
}
__device__ __forceinline__ void p1_lnmod(Frame& F) {
    LAS float* md = (LAS float*)(F.lds + RING_OFF);
    for (int e = F.vcu * NT + F.tid; e < BATCH * DM; e += F.G * NT) { const int b = e / DM, n = e % DM;
        F.gate[e] = F.modp[(size_t)b * NMOD + 2 * DM + n] + F.modp[((size_t)5 + b) * NMOD + 2 * DM + n]; }
    for (int blk = F.vcu; blk < 256; blk += F.G) {
        const int b = blk >> 6;
        __syncthreads();
        { float m0v[16], m1v[16];
#pragma unroll
          for (int i = 0; i < 16; ++i) { const int e = F.tid + NT * i; const int row = e < 2 * DM ? b : 4, col = e & (2 * DM - 1); m0v[i] = F.modp[(size_t)row * NMOD + col]; m1v[i] = F.modp[((size_t)5 + row) * NMOD + col]; }
#pragma unroll
          for (int i = 0; i < 16; ++i) md[F.tid + NT * i] = m0v[i] + m1v[i]; }
        __syncthreads();
#pragma unroll 1
        for (int r = 0; r < 8; r += 2) { const int m = blk * 64 + F.wave * 8 + r;
            ln_mod_row2(F, F.x + (size_t)m * DM, F.x + (size_t)(m + 1) * DM, F.XN + (size_t)m * DM, F.XN + (size_t)(m + 1) * DM, md, md + DM); }
        if (F.wave < 4) { const int m = blk * 4 + F.wave; ln_mod_row(F, F.ctx + (size_t)m * DM, F.XN + (size_t)(MX + m) * DM, md + 2 * DM, md + 3 * DM); }
    }
}

__device__ __forceinline__ float rcpf_(float v) { return __builtin_amdgcn_rcpf(v); }
__device__ __forceinline__ float silu_fast(float v) { return v * rcpf_(1.f + __expf(-v)); }
__device__ __forceinline__ void conv_acc8(float (&acc)[8], const v4u u, const f32x4 wa, const f32x4 wb) {
    acc[0] += lo2f(u.x) * wa.x; acc[1] += hi2f(u.x) * wa.y; acc[2] += lo2f(u.y) * wa.z; acc[3] += hi2f(u.y) * wa.w;
    acc[4] += lo2f(u.z) * wb.x; acc[5] += hi2f(u.z) * wb.y; acc[6] += lo2f(u.w) * wb.z; acc[7] += hi2f(u.w) * wb.w;
}
constexpr int NSC = 4;
__device__ __forceinline__ void p3_conv(Frame& F) {
    bf16* QKM = F.XN;
    if (F.G > 2 * NSC && F.vcu < NSC) return;
    const int wk = F.G > 2 * NSC ? F.vcu - NSC : F.vcu, NW = F.G > 2 * NSC ? F.G - NSC : F.G;
    const int gw = wk * NWAVES + F.wave, NGW = NW * NWAVES;
    const int cq = gw & 3, ch = cq * 512 + F.lane * 8;
    f32x4 wa[9], wb[9];
#pragma unroll
    for (int t = 0; t < 9; ++t) { wa[t] = *(const GAS f32x4*)(F.conv_w + t * 2048 + ch); wb[t] = *(const GAS f32x4*)(F.conv_w + t * 2048 + ch + 4); }
    const f32x4 ba = *(const GAS f32x4*)(F.conv_b + ch), bb = *(const GAS f32x4*)(F.conv_b + ch + 4);
    const float sc = ch >= 1024 ? 0.0625f : 1.f;
    constexpr int NLAT = BATCH * 64 * 16, NCTX = BATCH * (CTXL / 4);
    int it0 = gw >> 2, it1 = NLAT + NCTX, its = NGW >> 2;
    if (NW == 252) { const int j = wk - 80; const int lo = wk < 80 ? 8 * wk : 640 + (j < 100 ? 22 * j : 2200 + 21 * (j - 100)); const int len = wk < 80 ? 8 : (j < 100 ? 22 : 21);
        it0 = lo + (F.wave >> 2); it1 = lo + len; its = 2; }
    for (int it = it0; it < it1; it += its) {
        const v4u zero4 = {0u, 0u, 0u, 0u};
        if (it < NLAT) {
            const int b = it >> 10, r = (it >> 4) & 63, c0 = (it & 15) * 4;
            v4u in[3][6];
#pragma unroll
            for (int dr = 0; dr < 3; ++dr)
#pragma unroll
                for (int j = 0; j < 6; ++j) { const int rr = r + dr - 1, cc = c0 + j - 1; const bool ok = rr >= 0 && rr < 64 && cc >= 0 && cc < 64;
                    in[dr][j] = ok ? *(const GAS v4u*)(F.U + (size_t)(b * SEQ + rr * 64 + cc) * NU + C_BQK + ch) : zero4; }
#pragma unroll
            for (int o = 0; o < 4; ++o) {
                float acc[8] = {ba.x, ba.y, ba.z, ba.w, bb.x, bb.y, bb.z, bb.w};
#pragma unroll
                for (int dr = 0; dr < 3; ++dr)
#pragma unroll
                    for (int dc = 0; dc < 3; ++dc) conv_acc8(acc, in[dr][o + dc], wa[dr * 3 + dc], wb[dr * 3 + dc]);
#pragma unroll
                for (int j = 0; j < 8; ++j) acc[j] = silu_fast(acc[j]) * sc;
                v4u ov; ov.x = pk2(acc[0], acc[1]); ov.y = pk2(acc[2], acc[3]); ov.z = pk2(acc[4], acc[5]); ov.w = pk2(acc[6], acc[7]);
                *(GAS v4u*)(QKM + (size_t)(b * SEQ + r * 64 + c0 + o) * DM + ch) = ov;
            }
        } else {
            const int ic = it - NLAT, b = ic >> 6, t0 = (ic & 63) * 4;
            v4u in[6];
#pragma unroll
            for (int j = 0; j < 6; ++j) { const int tt = t0 + j - 1; in[j] = (tt >= 0 && tt < CTXL) ? *(const GAS v4u*)(F.U + (size_t)(MX + b * CTXL + tt) * NU + C_BQK + ch) : zero4; }
#pragma unroll
            for (int o = 0; o < 4; ++o) {
                float acc[8] = {ba.x, ba.y, ba.z, ba.w, bb.x, bb.y, bb.z, bb.w};
#pragma unroll
                for (int dc = 0; dc < 3; ++dc) conv_acc8(acc, in[o + dc], wa[3 + dc], wb[3 + dc]);
#pragma unroll
                for (int j = 0; j < 8; ++j) acc[j] = silu_fast(acc[j]) * sc;
                v4u ov; ov.x = pk2(acc[0], acc[1]); ov.y = pk2(acc[2], acc[3]); ov.z = pk2(acc[4], acc[5]); ov.w = pk2(acc[6], acc[7]);
                *(GAS v4u*)(QKM + (size_t)(MX + b * CTXL + t0 + o) * DM + ch) = ov;
            }
        }
    }
}

__device__ __forceinline__ int scan_row(int b, int dirn, int nb, int i) {
    if (nb < 16) { const int p = nb * 16 + i; const int t = dirn ? (CTXL - 1 - p) : p; return MX + b * CTXL + t; }
    const int p = (nb - 16) * 16 + i; const int t = dirn ? (SEQ - 1 - p) : p; return b * SEQ + t;
}
__device__ __forceinline__ void p4_hgrn2_task(Frame& F, int task) {
    const int vs = task & 3, dirn = (task >> 2) & 1, h = (task >> 3) & 7, b = task >> 6;
    LAS float* Fg = (LAS float*)(F.lds);
    LAS float* Kg = Fg + 2048, *Qg = Kg + 2048;
    LAS float* Vg = Qg + 2048;
    LAS float* LB = Vg + 512;
    LAS float* P = LB + 128;
    const int v = F.tid & 31, kg = F.tid >> 5, k0 = kg * 8;
    const int zcol = (dirn ? C_AFB : C_AFF) + h * HGD;
    __syncthreads();
    if (F.tid < 128) { const int col = h * HGD + F.tid; LB[F.tid] = sigmf(F.hg_lb[(dirn * 2 + 0) * WA + col] - F.hg_lb[(dirn * 2 + 1) * WA + col]); }
    __syncthreads();
    float S[8];
#pragma unroll
    for (int j = 0; j < 8; ++j) S[j] = 0.f;
    bf16* O = dirn ? F.OAB : F.OAF;
#pragma unroll 1
    for (int nb = 0; nb < 16 + 256; ++nb) {
        const bool lat = nb >= 16;
#pragma unroll
        for (int j = 0; j < 4; ++j) { const int e = F.tid + NT * j, i = e >> 7, k = e & 127; const int row = scan_row(b, dirn, nb, i);
            const float z = bf2f(F.U[(size_t)row * NU + zcol + k]); const float lb = LB[k]; const float f = lb + (1.f - lb) * sigmf(z);
            Fg[e] = f; Kg[e] = 1.f - f; Qg[e] = lat ? siluf(bf2f(F.U[(size_t)row * NU + C_AQ + h * HGD + k])) : 0.f; }
        { const int i = F.tid >> 5; const int row = scan_row(b, dirn, nb, i); Vg[F.tid] = bf2f(F.U[(size_t)row * NU + C_AI + h * HGD + vs * 32 + v]); }
        __syncthreads();
#pragma unroll 2
        for (int i = 0; i < 16; ++i) { const float vv = Vg[i * 32 + v]; float a = 0.f;
#pragma unroll
            for (int j = 0; j < 8; ++j) { S[j] = Fg[i * 128 + k0 + j] * S[j] + Kg[i * 128 + k0 + j] * vv; a += S[j] * Qg[i * 128 + k0 + j]; }
            P[(kg * 16 + i) * 32 + v] = a; }
        __syncthreads();
        if (lat) { const int i = F.tid >> 5; float o = 0.f;
#pragma unroll
            for (int g = 0; g < 16; ++g) o += P[(g * 16 + i) * 32 + v];
            const int row = scan_row(b, dirn, nb, i);
            O[(size_t)row * WA + h * HGD + vs * 32 + v] = (bf16)f2bf(o); }
    }
}
__device__ __forceinline__ void p4_mlstm_task(Frame& F, int task) {
    const int vs = task & 7, dirn = (task >> 3) & 1, h = (task >> 4) & 3, b = task >> 6;
    const bf16* QKM = F.XN;
    LAS float* Kb = (LAS float*)(F.lds);
    LAS float* Qb = Kb + 4096;
    LAS float* Vb = Qb + 4096;
    LAS float* LI = Vb + 512, *LF = LI + 16, *EM = LF + 16;
    LAS float* PD = EM + 16;
    LAS float* P = PD + 256;
    const int v = F.tid & 31, kg = F.tid >> 5, k0 = kg * 16;
    float C[16], nn[16]; float m = 0.f;
#pragma unroll
    for (int j = 0; j < 16; ++j) { C[j] = 0.f; nn[j] = 0.f; }
    bf16* O = dirn ? F.HBB : F.HBF;
    const float gbi = F.ml_gate_b[dirn * 4 + h], gbf = F.ml_gate_b[(2 + dirn) * 4 + h];
#pragma unroll 1
    for (int nb = 0; nb < 16 + 256; ++nb) {
        const bool lat = nb >= 16;
        __syncthreads();
#pragma unroll
        for (int j = 0; j < 8; ++j) { const int e = F.tid + NT * j, i = e >> 8, k = e & 255; const int row = scan_row(b, dirn, nb, i);
            Kb[e] = bf2f(QKM[(size_t)row * DM + 1024 + h * MLD + k]); Qb[e] = lat ? bf2f(QKM[(size_t)row * DM + h * MLD + k]) : 0.f; }
        { const int i = F.tid >> 5; const int row = scan_row(b, dirn, nb, i); Vb[F.tid] = bf2f(F.U[(size_t)row * NU + C_BV + h * MLD + vs * 32 + v]); }
        if (F.tid < 16) { const int row = scan_row(b, dirn, nb, F.tid);
            const float gi = bf2f(F.U[(size_t)row * NU + C_BG + dirn * 4 + h]) + gbi, gf = bf2f(F.U[(size_t)row * NU + C_BG + (2 + dirn) * 4 + h]) + gbf;
            LI[F.tid] = gi; LF[F.tid] = gf > 0.f ? -log1pf(__expf(-gf)) : gf - log1pf(__expf(gf)); }
        __syncthreads();
#pragma unroll 2
        for (int i = 0; i < 16; ++i) {
            const float lf = LF[i], li = LI[i]; const float mn = fmaxf(lf + m, li); const float fd = __expf(lf + m - mn), iw = __expf(li - mn); m = mn;
            if (F.tid == 0) EM[i] = __expf(-m);
            const float vv = iw * Vb[i * 32 + v]; float a = 0.f, d = 0.f;
#pragma unroll
            for (int j = 0; j < 16; ++j) { const float kk = Kb[i * 256 + k0 + j], qq = Qb[i * 256 + k0 + j];
                C[j] = fd * C[j] + vv * kk; nn[j] = fd * nn[j] + iw * kk; a += C[j] * qq; d += nn[j] * qq; }
            P[(kg * 16 + i) * 32 + v] = a; if (v == 0) PD[kg * 16 + i] = d; }
        __syncthreads();
        if (lat) { const int i = F.tid >> 5; float num = 0.f, den = 0.f;
#pragma unroll
            for (int g = 0; g < 16; ++g) { num += P[(g * 16 + i) * 32 + v]; den += PD[g * 16 + i]; }
            const int row = scan_row(b, dirn, nb, i);
            O[(size_t)row * WB + h * MLD + vs * 32 + v] = (bf16)f2bf(num / fmaxf(fabsf(den), EM[i])); }
    }
}
__device__ __forceinline__ void p4_scan_naive(Frame& F) {
    for (int task = F.vcu; task < 512; task += F.G) { if (task < 256) p4_hgrn2_task(F, task); else p4_mlstm_task(F, task - 256); }
}

constexpr int NCHUNK = MALL / 64;
__device__ __forceinline__ void gate_fk(float z, float lb, float& f, float& kk) {
    const float e = __expf(-fabsf(z)); const float rb = 1.f / (1.f + e), rs = e * rb;
    const float sg = z >= 0.f ? rb : rs, sn = z >= 0.f ? rs : rb;
    f = lb + (1.f - lb) * sg; kk = (1.f - lb) * sn;
}
template <int DIR>
__device__ __forceinline__ float hg_walk(LAS unsigned char* L, int cl, float lb, float olb, unsigned (&qb)[32]) {
    constexpr int TQ = 0, TZF = 32768, TZB = 65536, TQF = 98304;
    LAS unsigned short* zt = (LAS unsigned short*)(L + (DIR ? TZB : TZF)) + cl;
    const LAS unsigned short* qtile = (const LAS unsigned short*)(L + TQ) + cl;
    LAS unsigned short* qf = (LAS unsigned short*)(L + TQF) + cl;
    float P = 1.f;
#pragma unroll
    for (int blk = 0; blk < 4; ++blk) {
        unsigned short zr[16], qr[16];
#pragma unroll
        for (int j = 0; j < 16; ++j) { const int pp = blk * 16 + j, p = DIR ? 63 - pp : pp; zr[j] = zt[p * 256]; qr[j] = qtile[p * 256]; }
#pragma unroll
        for (int j = 0; j < 16; ++j) { const int pp = blk * 16 + j, p = DIR ? 63 - pp : pp;
            const float z = bf2f(zr[j]), q = bf2f(qr[j]);
            const float e = __expf(-fabsf(z)); const float rbig = rcpf_(1.f + e), rsm = e * rbig;
            const float sg = z >= 0.f ? rbig : rsm, sn = z >= 0.f ? rsm : rbig;
            const float f = lb + olb * sg, kk = olb * sn; P *= f;
            const float qt = q * P, kt = kk * rcpf_(P);
            zt[p * 256] = (unsigned short)(pkbf(kt, 0.f) & 0xffffu);
            const unsigned qh = pkbf(qt, 0.f) & 0xffffu;
            if (DIR) { if (pp & 1) qb[pp >> 1] |= qh << 16; else qb[pp >> 1] = qh; } else qf[p * 256] = (unsigned short)qh; }
    }
    return P;
}
template <bool DUMMY>
__device__ __forceinline__ void p3_hg_prep(Frame& F) {
    bf16* dq = F.OAF; bf16* dkf = F.OAB; bf16* dkb = F.HBF;
    LAS unsigned char* L = F.lds;
    constexpr int TQ = 0, TZF = 32768, TZB = 65536, TQF = 98304;
    const int tid = F.tid, dirn = F.wave >> 2, cl = tid & 255;
    if (F.G > 2 * NSC && F.vcu < NSC) return;
    const int wk = F.G > 2 * NSC ? F.vcu - NSC : F.vcu, NW = F.G > 2 * NSC ? F.G - NSC : F.G;
    v4u pre[3][4];
    auto issue = [&](int it) { const int cid = it >> 2, cb = (it & 3) * 256; const size_t row0 = (size_t)cid * 64;
#pragma unroll
        for (int i = 0; i < 4; ++i) { const int piece = tid + NT * i, row = piece >> 5, c16 = piece & 31; const bf16* ur = F.U + (row0 + row) * NU + cb + c16 * 8;
            pre[0][i] = *(const GAS v4u*)(ur + C_AQ); pre[1][i] = *(const GAS v4u*)(ur + C_AFF); pre[2][i] = *(const GAS v4u*)(ur + C_AFB); } };
    int it = wk;
    if (it < NCHUNK * 4) issue(it);
    for (; it < NCHUNK * 4; it += NW) {
        const int cid = it >> 2, cb = (it & 3) * 256; const size_t row0 = (size_t)cid * 64;
        __syncthreads();
#pragma unroll
        for (int i = 0; i < 4; ++i) { const int piece = tid + NT * i; *(LAS v4u*)(L + TQ + piece * 16) = pre[0][i]; *(LAS v4u*)(L + TZF + piece * 16) = pre[1][i]; *(LAS v4u*)(L + TZB + piece * 16) = pre[2][i]; }
        __syncthreads();
        if (it + NW < NCHUNK * 4) issue(it + NW);
        const int c = cb + cl;
        const float lb = sigmf(F.hg_lb[(dirn * 2) * WA + c] - F.hg_lb[(dirn * 2 + 1) * WA + c]), olb = 1.f - lb;
        unsigned qb[32]; float P;
        if (dirn) P = hg_walk<1>(L, cl, lb, olb, qb); else P = hg_walk<0>(L, cl, lb, olb, qb);
        F.PE[(size_t)(dirn * NCHUNK + cid) * WA + c] = P;
        __syncthreads();
        if (dirn) {
            LAS unsigned short* qw = (LAS unsigned short*)(L + TQ) + cl;
#pragma unroll
            for (int pp = 0; pp < 64; ++pp) qw[(63 - pp) * 256] = (unsigned short)((pp & 1) ? (qb[pp >> 1] >> 16) : (qb[pp >> 1] & 0xffffu));
        }
        __syncthreads();
#pragma unroll
        for (int i = 0; i < 4; ++i) { const int piece = tid + NT * i, row = piece >> 5, c16 = piece & 31; const size_t r = row0 + row; bf16* ur = F.U + r * NU + cb + c16 * 8;
            const v4u vq = *(const LAS v4u*)(L + TQ + piece * 16), vf = *(const LAS v4u*)(L + TZF + piece * 16), vb = *(const LAS v4u*)(L + TZB + piece * 16), vqf = *(const LAS v4u*)(L + TQF + piece * 16);
            *(GAS v4u*)(F.QTF + r * WA + cb + c16 * 8) = vqf;
            if (DUMMY) { if (r < MX) { *(GAS v4u*)(dq + r * WA + cb + c16 * 8) = vq; *(GAS v4u*)(dkf + r * WA + cb + c16 * 8) = vf; *(GAS v4u*)(dkb + r * WA + cb + c16 * 8) = vb; } }
            else { *(GAS v4u*)(ur + C_AQ) = vq; *(GAS v4u*)(ur + C_AFF) = vf; *(GAS v4u*)(ur + C_AFB) = vb; } }
    }
    __syncthreads();
}
template <int CTRL, int RM> __device__ __forceinline__ float dpp_f(float idv, float x) { return __builtin_bit_cast(float, __builtin_amdgcn_update_dpp(__builtin_bit_cast(int, idv), __builtin_bit_cast(int, x), CTRL, RM, 0xf, false)); }
__device__ __forceinline__ float wave_scan_add(float x) {
    x += dpp_f<0x111, 0xf>(0.f, x); x += dpp_f<0x112, 0xf>(0.f, x); x += dpp_f<0x114, 0xf>(0.f, x); x += dpp_f<0x118, 0xf>(0.f, x);
    x += dpp_f<0x142, 0xa>(0.f, x); x += dpp_f<0x143, 0xc>(0.f, x); return x; }
__device__ __forceinline__ float wave_scan_max(float x) { const float ni = -__builtin_inff();
    x = fmaxf(x, dpp_f<0x111, 0xf>(ni, x)); x = fmaxf(x, dpp_f<0x112, 0xf>(ni, x)); x = fmaxf(x, dpp_f<0x114, 0xf>(ni, x)); x = fmaxf(x, dpp_f<0x118, 0xf>(ni, x));
    x = fmaxf(x, dpp_f<0x142, 0xa>(ni, x)); x = fmaxf(x, dpp_f<0x143, 0xc>(ni, x)); return x; }
__device__ __forceinline__ void p3_ml_scalars(Frame& F) {
    const int gw = F.vcu * NWAVES + F.wave;
    if (gw >= 32) return;
    const int dirn = gw & 1, h = (gw >> 1) & 3, b = gw >> 3;
    const float gbi = F.ml_gate_b[dirn * 4 + h], gbf = F.ml_gate_b[(2 + dirn) * 4 + h];
    float m0 = 0.f;
    float* mls = F.MLS + (size_t)(dirn * 4 + h) * MALL * 8;
    auto row_of = [&](int n) -> int { int row0; if (n < 4) { const int cc = dirn ? 3 - n : n; row0 = MX + b * CTXL + cc * 64; } else { const int lc = dirn ? 67 - n : n - 4; row0 = b * SEQ + lc * 64; }
        return row0 + (dirn ? 63 - F.lane : F.lane); };
    unsigned short gi_r[8], gf_r[8];
#pragma unroll
    for (int j = 0; j < 8; ++j) { const int row = row_of(j); gi_r[j] = F.U[(size_t)row * NU + C_BG + dirn * 4 + h]; gf_r[j] = F.U[(size_t)row * NU + C_BG + (2 + dirn) * 4 + h]; }
#pragma unroll 1
    for (int nb = 0; nb < 72; nb += 8) {
#pragma unroll
        for (int j = 0; j < 8; ++j) {
            const int n = nb + j;
            if (n < 68) {
                const int row = row_of(n);
                const float gi = bf2f(gi_r[j]) + gbi, gf = bf2f(gf_r[j]) + gbf;
                if (n + 8 < 68) { const int r2 = row_of(n + 8); gi_r[j] = F.U[(size_t)r2 * NU + C_BG + dirn * 4 + h]; gf_r[j] = F.U[(size_t)r2 * NU + C_BG + (2 + dirn) * 4 + h]; }
                const float lf = fminf(gf, 0.f) - __logf(1.f + __expf(-fabsf(gf)));
                const float cs = wave_scan_add(lf);
                const float a = gi - cs; const float cm = wave_scan_max(a);
                const float mx = fmaxf(m0, cm), m63 = __shfl(mx, 63), cs63 = __shfl(cs, 63);
                f32x4 o0; o0.x = a; o0.y = mx; o0.z = __expf(m0 - mx); o0.w = __expf(a - m63);
                f32x4 o1; o1.x = __expf(-(cs + mx)); o1.y = 0.f; o1.z = __expf(m0 - m63); o1.w = 0.f;
                *(f32x4*)(mls + (size_t)row * 8) = o0; *(f32x4*)(mls + (size_t)row * 8 + 4) = o1;
                const int row0 = row - (dirn ? 63 - F.lane : F.lane);
                if (F.lane == 0) F.DEC[(dirn * 4 + h) * NCHUNK + (row0 >> 6)] = __expf(m0 - m63);
                m0 = cs63 + m63;
            }
        }
    }
}

typedef short s16x4 __attribute__((ext_vector_type(4)));
typedef float f32x16 __attribute__((ext_vector_type(16)));
#define MFMA32(a, b, c) __builtin_amdgcn_mfma_f32_32x32x16_bf16((a), (b), (c), 0, 0, 0)
__device__ __forceinline__ bf16x8 pk8(float a0, float a1, float a2, float a3, float a4, float a5, float a6, float a7) {
    const v4u u = {pkbf(a0, a1), pkbf(a2, a3), pkbf(a4, a5), pkbf(a6, a7)}; return __builtin_bit_cast(bf16x8, u); }
__device__ __forceinline__ bf16x8 cat4(s16x4 lo, s16x4 hi) { return __builtin_shufflevector(lo, hi, 0, 1, 2, 3, 4, 5, 6, 7); }
__device__ __forceinline__ s16x4 lds_tr(LAS unsigned char* p) { return __builtin_amdgcn_ds_read_tr16_b64_v4i16((LAS s16x4*)p); }
__device__ __forceinline__ unsigned img_off_a(unsigned row, unsigned ch) { return 2048u * (row >> 3) + 512u * (ch >> 2) + 64u * (row & 7) + 16u * ((ch & 3) ^ ((row >> 2) & 3)); }
__device__ __forceinline__ unsigned img_addr(unsigned row, unsigned ch, unsigned ncb) { return ((row >> 5) * ncb + (ch >> 4)) * 8192u + img_off_a(row & 31, ch & 15); }
__device__ __forceinline__ unsigned v_addr(unsigned row, unsigned ch) { const unsigned r = row & 31; return (row >> 5) * 4096u + 1024u * (r >> 3) + 512u * (ch >> 2) + 64u * (r & 7) + 16u * ((ch & 3) ^ ((r >> 2) & 3)); }

constexpr int SL_QT = 0, SL_KT = 32768, SL_V = 65536, SL_VW = 73728, SL_SF = 81920, SL_XCH = 114688, SL_SC = 131072, SL_W = 144384;
constexpr int SC_PAR = 448, SC_DQW = 896, SC_N0 = 1024, SC_NP = 1280;


__device__ __forceinline__ void p3b_ml_scores(Frame& F) {
    LAS unsigned char* L = F.lds;
    constexpr int BQ = 0, BK = 32768, BX = 65536, BS = 98304;
    LAS float* SCA = (LAS float*)(L + BS);
    const int tid = F.tid, lane = F.lane, w = F.wave, ts = w & 1, tp = (w >> 1) & 1, kh = w >> 2;
    const unsigned hh = lane >> 5, x4 = (lane >> 2) & 3;
    const unsigned LB0 = 2048u * ((lane >> 3) & 3) + 64u * (lane & 7);
    unsigned LBx[2];
#pragma unroll
    for (int e = 0; e < 2; ++e) LBx[e] = LB0 + 16u * ((2u * e + hh) ^ x4) + kh * 8192u;
    v4u pq[4], pk[4]; f32x2_t psc;
    auto issue = [&](int it) { const int lc = it & 63, h = (it >> 6) & 3, b = it >> 8; const size_t row0 = (size_t)b * SEQ + lc * 64;
        int tv = F.tid; asm volatile("" : "+v"(tv));
#pragma unroll
        for (int i = 0; i < 4; ++i) { const int u = ((tv >> 6) + 8 * i) * 8 + ((tv & 63) >> 3), row = 2 * (u >> 3) + ((tv >> 2) & 1), ch = 4 * (u & 7) + (tv & 3);
            pq[i] = *(const GAS v4u*)(F.XN + (row0 + row) * DM + h * MLD + ch * 8); pk[i] = *(const GAS v4u*)(F.XN + (row0 + row) * DM + WB + h * MLD + ch * 8); }
        if (tv < 128) psc = *(const GAS f32x2_t*)(F.MLS + ((size_t)((tv >> 6) * 4 + h) * MALL + row0 + (tv & 63)) * 8); };
    int it = F.vcu;
    if (it < 1024) issue(it);
    for (; it < 1024; it += F.G) {
        const int lc = it & 63, h = (it >> 6) & 3, b = it >> 8; const size_t row0 = (size_t)b * SEQ + lc * 64;
        __syncthreads();
        { int tv = F.tid; asm volatile("" : "+v"(tv));
#pragma unroll
          for (int i = 0; i < 4; ++i) { const int u = ((tv >> 6) + 8 * i) * 8 + ((tv & 63) >> 3), row = 2 * (u >> 3) + ((tv >> 2) & 1), ch = 4 * (u & 7) + (tv & 3); const unsigned a = img_addr(row, ch, 2); *(LAS v4u*)(L + BQ + a) = pq[i]; *(LAS v4u*)(L + BK + a) = pk[i]; }
          if (tv < 128) { SCA[(tv >> 6) * 128 + (tv & 63)] = psc.x; SCA[(tv >> 6) * 128 + 64 + (tv & 63)] = psc.y; } }
        __syncthreads();
        if (it + F.G < 1024) issue(it + F.G);
        f32x16 c;
#pragma unroll
        for (int r = 0; r < 16; ++r) c[r] = 0.f;
#pragma unroll
        for (int s = 0; s < 8; ++s) {
            const bf16x8 a = *(const LAS bf16x8*)(L + BK + ts * 16384 + 512 * (s >> 1) + LBx[s & 1]);
            const bf16x8 bq = *(const LAS bf16x8*)(L + BQ + tp * 16384 + 512 * (s >> 1) + LBx[s & 1]);
            c = MFMA32(a, bq, c);
        }
#pragma unroll
        for (int r = 0; r < 16; ++r) *(LAS float*)(L + BX + (((kh * 4 + ts * 2 + tp) * 16 + r) * 64 + lane) * 4) = c[r];
        __syncthreads();
#pragma unroll
        for (int r = 0; r < 16; ++r) c[r] += *(const LAS float*)(L + BX + ((((1 - kh) * 4 + ts * 2 + tp) * 16 + r) * 64 + lane) * 4);
        const int dirn = kh;
        const bool need = dirn ? (ts >= tp) : (ts <= tp);
        const float mxp = SCA[dirn * 128 + 64 + 32 * tp + (lane & 31)];
        int dl = (lane & 31) - 4 * (int)hh; if (dirn) dl = -dl; asm volatile("" : "+v"(dl));
        const int sg1 = dirn ? -1 : 1; const bool diag = ts == tp;
        float rs = 0.f;
        bf16* wout = F.MLW + ((size_t)((dirn * 4 + h) * 256 + (int)(row0 >> 6)) * 4096) + (32 * tp + (lane & 31)) * 64 + 32 * ts + 4 * hh;
#pragma unroll
        for (int g = 0; g < 4; ++g) {
            const f32x4 av = *(const LAS f32x4*)(SCA + dirn * 128 + 32 * ts + 8 * g + 4 * hh);
            float wv[4];
#pragma unroll
            for (int j = 0; j < 4; ++j) { float v = need ? c[4 * g + j] * __expf(av[j] - mxp) : 0.f;
                if (diag) v = (dl - sg1 * (j + 8 * g) >= 0) ? v : 0.f;
                wv[j] = v; rs += v; }
            *(GAS unsigned long long*)(wout + 8 * g) = (unsigned long long)pkbf(wv[0], wv[1]) | ((unsigned long long)pkbf(wv[2], wv[3]) << 32);
        }
        rs += __shfl_xor(rs, 32);
        if (lane < 32) SCA[256 + (dirn * 2 + ts) * 64 + 32 * tp + lane] = rs;
        __syncthreads();
        if (tid < 128) { const int d = tid >> 6, p = tid & 63; F.MLS[((size_t)(d * 4 + h) * MALL + row0 + p) * 8 + 5] = SCA[256 + (d * 2) * 64 + p] + SCA[256 + (d * 2 + 1) * 64 + p]; }
    }
    __syncthreads();
}

template <bool ML, int SKIP = 0>
__device__ __forceinline__ void scan_task(Frame& F, int task) {
    constexpr int NKT = ML ? 8 : 4, NCB = NKT / 4, NKH = NKT / 2, NOWN = NKT / 4, NPQ = ML ? 4 : 2, DKK = 32 * NKT;
    int vs, dirn, h, b;
    if (ML) { vs = task & 3; dirn = (task >> 2) & 1; h = (task >> 3) & 3; b = task >> 5; } else { vs = task & 1; dirn = (task >> 1) & 1; h = (task >> 2) & 7; b = task >> 5; }
    const int lane = F.lane, w = F.wave, tid = F.tid; const int tp = (w >> 2) & 1, tj = (w >> 1) & 1, kh = w & 1;
    const unsigned hh = lane >> 5, q4 = (lane & 15) >> 2, p4 = lane & 3, blk = (lane >> 4) & 1, x4 = (lane >> 2) & 3;
    LAS unsigned char* L = F.lds;
    LAS float* SC = (LAS float*)(L + SL_SC);
    const unsigned LB0 = 2048u * ((lane >> 3) & 3) + 64u * (lane & 7);
    const unsigned khoff = ML ? kh * 8192u : kh * 1024u;
    unsigned LBx[2], LK[2][2], TRK[2], VK[2], VN[2], WL[2];
#pragma unroll
    for (int e = 0; e < 2; ++e) { LBx[e] = LB0 + 16u * ((2u * e + hh) ^ x4) + khoff; WL[e] = 1024u * ((lane >> 3) & 3) + 64u * (lane & 7) + 16u * ((2u * e + hh) ^ x4);
#pragma unroll
        for (int t = 0; t < 2; ++t) LK[e][t] = LB0 + 16u * ((2u * e + t) ^ x4) + 8u * hh + khoff; }
#pragma unroll
    for (int t = 0; t < 2; ++t) {
        TRK[t] = 2048u * hh + 64u * q4 + 8u * (p4 & 1) + 16u * ((2u * blk + (p4 >> 1)) ^ (2u * hh + t));
        VK[t] = 64u * (4u * hh + q4) + 8u * (p4 & 1) + 16u * ((2u * blk + (p4 >> 1)) ^ (2u * t + hh)) + 512u * tj;
        VN[t] = 1024u * hh + 64u * q4 + 8u * (p4 & 1) + 512u * tj + 16u * ((2u * blk + (p4 >> 1)) ^ (2u * hh + t)); }
    unsigned tkoff[NOWN];
#pragma unroll
    for (int i = 0; i < NOWN; ++i) { const unsigned tk = kh * NKH + tp * NOWN + i; tkoff[i] = (tk >> 2) * 8192u + 512u * (tk & 3); }
    const bf16 *gq, *gk, *gv; int sq, sk; bf16* go;
    if (ML) { gq = F.XN + h * MLD; gk = F.XN + WB + h * MLD; sq = DM; sk = DM; gv = F.U + C_BV + h * MLD + vs * 64; go = (dirn ? F.HBB : F.HBF) + h * MLD + vs * 64; }
    else { if (dirn) { gq = F.U + C_AQ + h * HGD; sq = NU; gk = F.U + C_AFB + h * HGD; } else { gq = F.QTF + h * HGD; sq = WA; gk = F.U + C_AFF + h * HGD; }
        sk = NU; gv = F.U + C_AI + h * HGD + vs * 64; go = (dirn ? F.OAB : F.OAF) + h * HGD + vs * 64; }
    const float* mls = F.MLS + (size_t)(dirn * 4 + h) * MALL * 8;
    const float* pev = F.PE + (size_t)dirn * NCHUNK * WA + h * HGD;
    f32x16 S[NOWN];
#pragma unroll
    for (int i = 0; i < NOWN; ++i)
#pragma unroll
        for (int r = 0; r < 16; ++r) S[i][r] = 0.f;
    v4u pq[NPQ], pk[NPQ], pv, pw; f32x4 ps0, ps1; float pws;
    const bf16* gw_ = F.MLW + (size_t)(dirn * 4 + h) * 256 * 4096;
    auto row0_of = [&](int n) -> int { if (n < 4) { const int cc = dirn ? 3 - n : n; return MX + b * CTXL + cc * 64; } const int lc = dirn ? 67 - n : n - 4; return b * SEQ + lc * 64; };
    int offq[NPQ], offk[NPQ]; unsigned aimg[NPQ];
#pragma unroll
    for (int i = 0; i < NPQ; ++i) { const int u = (w + 8 * i) * 8 + (lane >> 3), NB = NCB * 4, row = 2 * (u / NB) + ((lane >> 2) & 1), ch = 4 * (u % NB) + (lane & 3);
        offq[i] = row * sq + ch * 8; offk[i] = row * sk + ch * 8; aimg[i] = img_addr(row, ch, NCB); }
    const int vu = w * 8 + (lane >> 3), vrow = 2 * (vu >> 1) + ((lane >> 2) & 1), vch = 4 * (vu & 1) + (lane & 3);
    const int offv = vrow * NU + vch * 8, offw = vrow * 64 + vch * 8; const unsigned va = v_addr(vrow, vch);
    auto issue_loads = [&](int n) {
        const int row0 = row0_of(n);
        const bf16* bq_ = gq + (size_t)row0 * sq; const bf16* bk_ = gk + (size_t)row0 * sk;
#pragma unroll
        for (int i = 0; i < NPQ; ++i) { pq[i] = *(const GAS v4u*)(bq_ + offq[i]); pk[i] = *(const GAS v4u*)(bk_ + offk[i]); }
        pv = *(const GAS v4u*)(gv + (size_t)row0 * NU + offv);
        if (ML) { pws = mls[(size_t)(row0 + vrow) * 8 + 3];
            if (n >= 4) pw = *(const GAS v4u*)(gw_ + (size_t)(row0 >> 6) * 4096 + offw);
            if (tid < 64) { ps0 = *(const GAS f32x4*)(mls + (size_t)(row0 + tid) * 8); ps1 = *(const GAS f32x4*)(mls + (size_t)(row0 + tid) * 8 + 4); } }
        else { if (tid < 32) ps0 = *(const GAS f32x4*)(pev + (size_t)(row0 >> 6) * WA + tid * 4); }
    };
    unsigned tch0 = 0u, tch1 = 0u, tdummy = 0u;
    auto touch = [&](int n) {
        const int row0 = row0_of(n);
        if (ML) { const int ln = tid & 255; const bf16* bp = (tid < 256 ? gq + (size_t)row0 * sq : gk + (size_t)row0 * sk) + (size_t)(ln >> 2) * DM + (ln & 3) * 64;
            tch0 = *(const GAS unsigned*)bp;
            if (tid < 64) tch1 = *(const GAS unsigned*)(gv + (size_t)(row0 + tid) * NU);
            else if (tid < 128 && n >= 4) tch1 = *(const GAS unsigned*)(gw_ + (size_t)(row0 >> 6) * 4096 + (tid - 64) * 64); }
        else { if (tid < 256) { const int ln = tid & 127; tch0 = *(const GAS unsigned*)((tid < 128 ? gq + (size_t)(row0 + (ln >> 1)) * sq : gk + (size_t)(row0 + (ln >> 1)) * sk) + (ln & 1) * 64); }
            else if (tid < 320) tch0 = *(const GAS unsigned*)(gv + (size_t)(row0 + tid - 256) * NU); }
    };
    auto store_images = [&](int n) {
#pragma unroll
        for (int i = 0; i < NPQ; ++i) { *(LAS v4u*)(L + SL_QT + aimg[i]) = pq[i]; *(LAS v4u*)(L + SL_KT + aimg[i]) = pk[i]; }
        *(LAS v4u*)(L + SL_V + va) = pv;
        if (!ML && tid < 32) *(LAS f32x4*)(SC + (n & 1) * SC_PAR + tid * 4) = ps0;
        if (ML) { v4u o; o.x = pkbf(lo2f(pv.x) * pws, hi2f(pv.x) * pws); o.y = pkbf(lo2f(pv.y) * pws, hi2f(pv.y) * pws); o.z = pkbf(lo2f(pv.z) * pws, hi2f(pv.z) * pws); o.w = pkbf(lo2f(pv.w) * pws, hi2f(pv.w) * pws);
            *(LAS v4u*)(L + SL_VW + va) = o;
            if (n >= 4) *(LAS v4u*)(L + SL_W + va) = pw;
            if (tid < 64) { LAS float* sp = SC + (n & 1) * SC_PAR + tid; sp[0] = ps0.x; sp[64] = ps0.y; sp[128] = ps0.z; sp[192] = ps0.w; sp[256] = ps1.x; sp[320] = ps1.y; sp[384] = ps1.z; SC[896 + tid] = ps1.w; } }
    };
    __syncthreads();
    issue_loads(0);
    for (int e = tid; e < 32768 / 16; e += NT) *(LAS v4u*)(L + SL_SF + e * 16) = (v4u){0u, 0u, 0u, 0u};
    store_images(0);
    __syncthreads();
#pragma unroll 1
    for (int n = 0; n < 68; ++n) {
        const bool lat = n >= 4; const int row0 = row0_of(n); const int cid = row0 >> 6;
        if (n + 1 < 68 && !(SKIP & 16)) issue_loads(n + 1);
        LAS float* SP = SC + (n & 1) * SC_PAR;
        float dec = 1.f; f32x4 pe[NOWN][4];
        if (ML) dec = SP[384];
        else {
#pragma unroll
            for (int i = 0; i < NOWN; ++i)
#pragma unroll
                for (int g = 0; g < 4; ++g) pe[i][g] = *(const LAS f32x4*)(SP + 32 * (kh * NKH + tp * NOWN + i) + 8 * g + 4 * hh);
        }
        f32x16 o;
        if (lat && !(SKIP & 4)) {
            f32x16 acc_o, acc_i;
#pragma unroll
            for (int r = 0; r < 16; ++r) { acc_o[r] = 0.f; acc_i[r] = 0.f; }
            if (ML) {
                if (kh == 0) {
#pragma unroll
                    for (int ts = 0; ts < 2; ++ts) {
                        const bool need = dirn ? (ts >= tp) : (ts <= tp);
                        if (need) {
                            const bf16x8 a0 = *(const LAS bf16x8*)(L + SL_W + tp * 4096 + 512 * ts + WL[0]), a1 = *(const LAS bf16x8*)(L + SL_W + tp * 4096 + 512 * ts + WL[1]);
                            const s16x4 lo0 = lds_tr(L + SL_V + ts * 4096 + VN[0]), hi0 = lds_tr(L + SL_V + ts * 4096 + 256 + VN[1]);
                            const s16x4 lo1 = lds_tr(L + SL_V + ts * 4096 + 2048 + VN[0]), hi1 = lds_tr(L + SL_V + ts * 4096 + 2048 + 256 + VN[1]);
                            acc_o = MFMA32(a0, cat4(lo0, hi0), acc_o);
                            acc_o = MFMA32(a1, cat4(lo1, hi1), acc_o);
                        }
                    }
                }
            } else
#pragma unroll
            for (int ts = 0; ts < 2; ++ts) {
                const bool need = dirn ? (ts >= tp) : (ts <= tp);
                if (need) {
                    f32x16 c;
#pragma unroll
                    for (int r = 0; r < 16; ++r) c[r] = 0.f;
                    {
                        bf16x8 a_c = *(const LAS bf16x8*)(L + SL_KT + ts * NCB * 8192 + LBx[0]), b_c = *(const LAS bf16x8*)(L + SL_QT + tp * NCB * 8192 + LBx[0]), a_n = a_c, b_n = b_c;
#pragma unroll
                        for (int s = 0; s < NKT; ++s) {
                            if (s + 1 < NKT) { a_n = *(const LAS bf16x8*)(L + SL_KT + ts * NCB * 8192 + 512 * ((s + 1) >> 1) + LBx[(s + 1) & 1]); b_n = *(const LAS bf16x8*)(L + SL_QT + tp * NCB * 8192 + 512 * ((s + 1) >> 1) + LBx[(s + 1) & 1]); }
                            c = MFMA32(a_c, b_c, c);
                            a_c = a_n; b_c = b_n;
                        }
                    }
                    const s16x4 vlo0 = lds_tr(L + SL_V + ts * 4096 + VK[0]), vhi0 = lds_tr(L + SL_V + ts * 4096 + 1024 + VK[1]);
                    const s16x4 vlo1 = lds_tr(L + SL_V + ts * 4096 + 2048 + VK[0]), vhi1 = lds_tr(L + SL_V + ts * 4096 + 3072 + VK[1]);
                    int dl = (lane & 31) - 4 * (int)hh; if (dirn) dl = -dl; asm volatile("" : "+v"(dl));
                    const int sg1 = dirn ? -1 : 1; const bool diag = ts == tp;
#pragma unroll
                    for (int r = 0; r < 16; ++r) { const int ro = (r & 3) + 8 * (r >> 2);
                        float wv = c[r];
                        if (diag) wv = (dl - sg1 * ro >= 0) ? wv : 0.f;
                        c[r] = wv; }
                    acc_o = MFMA32(pk8(c[0], c[1], c[2], c[3], c[4], c[5], c[6], c[7]), cat4(vlo0, vhi0), acc_o);
                    acc_o = MFMA32(pk8(c[8], c[9], c[10], c[11], c[12], c[13], c[14], c[15]), cat4(vlo1, vhi1), acc_o);
                }
            }
            {
#define LD_INTER(i_, LO_, HI_, SF_) do { LO_ = *(const LAS s16x4*)(L + SL_QT + tp * NCB * 8192 + 512 * ((i_) >> 1) + LK[(i_) & 1][0]); HI_ = *(const LAS s16x4*)(L + SL_QT + tp * NCB * 8192 + 512 * ((i_) >> 1) + LK[(i_) & 1][1]); \
                SF_ = *(const LAS bf16x8*)(L + SL_SF + ((((kh * NKH + ((i_) >> 1)) * 2 + tj) * 2 + ((i_) & 1)) * 1024) + lane * 16); } while (0)
                s16x4 lo_c, hi_c, lo_n, hi_n; bf16x8 sf_c, sf_n;
                LD_INTER(0, lo_c, hi_c, sf_c); lo_n = lo_c; hi_n = hi_c; sf_n = sf_c;
#pragma unroll
                for (int i = 0; i < 2 * NKH; ++i) {
                    if (i + 1 < 2 * NKH) LD_INTER(i + 1, lo_n, hi_n, sf_n);
                    acc_i = MFMA32(cat4(lo_c, hi_c), sf_c, acc_i);
                    lo_c = lo_n; hi_c = hi_n; sf_c = sf_n;
                }
#undef LD_INTER
            }
            if (ML) {
                f32x4 wi[4];
#pragma unroll
                for (int g = 0; g < 4; ++g) wi[g] = *(const LAS f32x4*)(SP + 128 + 32 * tp + 8 * g + 4 * hh);
#pragma unroll
                for (int r = 0; r < 16; ++r) o[r] = acc_o[r] + wi[r >> 2][r & 3] * acc_i[r];
            } else {
#pragma unroll
                for (int r = 0; r < 16; ++r) o[r] = acc_o[r] + acc_i[r];
            }
            {
#pragma unroll
                for (int r = 0; r < 8; ++r) { const int rr = kh ? r : r + 8; *(LAS float*)(L + SL_XCH + (((tp * 2 + tj) * 16 + rr) * 64 + lane) * 4) = kh ? o[r] : o[r + 8]; }
            }
        }
        {
            if (ML) {
#pragma unroll
                for (int i = 0; i < NOWN; ++i)
#pragma unroll
                    for (int r = 0; r < 16; ++r) S[i][r] *= dec;
            }
#define LD_GA(ks_, i_, LO_, HI_) do { LO_ = lds_tr(L + SL_KT + ((ks_) >> 1) * NCB * 8192 + 4096 * ((ks_) & 1) + tkoff[i_] + TRK[0]); HI_ = lds_tr(L + SL_KT + ((ks_) >> 1) * NCB * 8192 + 4096 * ((ks_) & 1) + 256 + tkoff[i_] + TRK[1]); } while (0)
#define LD_GB(ks_, LO_, HI_) do { LO_ = lds_tr(L + (ML ? SL_VW : SL_V) + ((ks_) >> 1) * 4096 + 2048 * ((ks_) & 1) + VN[0]); HI_ = lds_tr(L + (ML ? SL_VW : SL_V) + ((ks_) >> 1) * 4096 + 2048 * ((ks_) & 1) + 256 + VN[1]); } while (0)
            s16x4 alo_c, ahi_c, blo_c, bhi_c, alo_n, ahi_n, blo_n, bhi_n;
            LD_GB(0, blo_c, bhi_c); LD_GA(0, 0, alo_c, ahi_c); alo_n = alo_c; ahi_n = ahi_c; blo_n = blo_c; bhi_n = bhi_c;
            constexpr int NG = (SKIP & 8) ? 0 : 4 * NOWN;
#pragma unroll
            for (int j = 0; j < NG; ++j) {
                const int ks = j / NOWN, i = j % NOWN, ks1 = (j + 1) / NOWN, i1 = (j + 1) % NOWN;
                if (j + 1 < NG) { LD_GA(ks1, i1, alo_n, ahi_n); if (i1 == 0) LD_GB(ks1, blo_n, bhi_n); }
                S[i] = MFMA32(cat4(alo_c, ahi_c), cat4(blo_c, bhi_c), S[i]);
                alo_c = alo_n; ahi_c = ahi_n; if (i1 == 0) { blo_c = blo_n; bhi_c = bhi_n; }
                (void)ks;
            }
#undef LD_GA
#undef LD_GB
            if (!ML) {
#pragma unroll
                for (int i = 0; i < NOWN; ++i)
#pragma unroll
                    for (int r = 0; r < 16; ++r) S[i][r] *= pe[i][r >> 2][r & 3];
            }
        }
        __syncthreads();
#pragma unroll
        for (int i = 0; i < NOWN; ++i)
#pragma unroll
            for (int st = 0; st < 2; ++st) {
                const bf16x8 f8 = pk8(S[i][8 * st], S[i][8 * st + 1], S[i][8 * st + 2], S[i][8 * st + 3], S[i][8 * st + 4], S[i][8 * st + 5], S[i][8 * st + 6], S[i][8 * st + 7]);
                *(LAS bf16x8*)(L + SL_SF + ((((kh * NKH + tp * NOWN + i) * 2 + tj) * 2 + st) * 1024) + lane * 16) = f8;
            }
        if (n + 1 < 68 && !(SKIP & 16)) store_images(n + 1);
        if (lat && !(SKIP & 2)) {
            float xv[8];
#pragma unroll
            for (int r8 = 0; r8 < 8; ++r8) { const int r = kh ? r8 + 8 : r8; xv[r8] = *(const LAS float*)(L + SL_XCH + (((tp * 2 + tj) * 16 + r) * 64 + lane) * 4); }
#pragma unroll
            for (int r8 = 0; r8 < 8; ++r8) { const int r = kh ? r8 + 8 : r8; const float ov = (kh ? o[r8 + 8] : o[r8]) + xv[r8];
                const int pr = 32 * tp + (r & 3) + 8 * (r >> 2) + 4 * (int)hh;
                go[(size_t)(row0 + pr) * WA + 32 * tj + (lane & 31)] = (bf16)(pkbf(ov, 0.f) & 0xffffu); }
        }
        LDS_BARRIER();
    }
}
#ifndef HG_MFMA
#define HG_MFMA 1
#endif
#ifndef ML_MFMA
#define ML_MFMA 1
#endif

__device__ __forceinline__ void nchain_task(Frame& F, int j) {
    const int kq = j & 3, id = j >> 2, dirn = id & 1, h = (id >> 1) & 3, b = id >> 3;
    const int tid = F.tid, lane = F.lane, w = F.wave;
    LAS unsigned char* L = F.lds;
    constexpr int NQ = 0, NK = 8192, NS = 16384;
    LAS float* SN = (LAS float*)(L + NS);
    const bf16* gq = F.XN + h * MLD + kq * 64; const bf16* gk = gq + WB;
    const float* mls = F.MLS + (size_t)(dirn * 4 + h) * MALL * 8;
    float* dqp = F.DQP + (size_t)((dirn * 4 + h) * 4 + kq) * MX;
    auto row0_of = [&](int n) -> int { if (n > 67) n = 67; if (n < 4) { const int cc = dirn ? 3 - n : n; return MX + b * CTXL + cc * 64; } const int lc = dirn ? 67 - n : n - 4; return b * SEQ + lc * 64; };
    struct Stg { v4u q, k; float ws, dec; };
    Stg A, B, C; A.ws = A.dec = B.ws = B.dec = C.ws = C.dec = 0.f;
    auto issue = [&](int n, Stg& t) { const int row0 = row0_of(n); const size_t off = (size_t)(row0 + (tid >> 3)) * DM + (tid & 7) * 8;
        t.q = *(const GAS v4u*)(gq + off); t.k = *(const GAS v4u*)(gk + off);
        if (tid < 64) { t.ws = mls[(size_t)(row0 + tid) * 8 + 3]; t.dec = mls[(size_t)(row0 + tid) * 8 + 6]; } };
    auto stash = [&](const Stg& t) { *(LAS v4u*)(L + NQ + tid * 16) = t.q; *(LAS v4u*)(L + NK + tid * 16) = t.k; if (tid < 64) { SN[tid] = t.ws; if (tid == 0) SN[640] = t.dec; } };
    auto step = [&](int n, Stg& ld, const Stg& st) {
        const int row0 = row0_of(n); const bool on = n < 68;
        issue(n + 2, ld);
        float dq_keep = 0.f;
        if (on && n >= 4) {
            const int kk = tid & 7; const v4u u = *(const LAS v4u*)(L + NQ + tid * 16);
            const f32x4 na = *(const LAS f32x4*)(SN + 64 + 8 * kk), nb = *(const LAS f32x4*)(SN + 64 + 8 * kk + 4);
            float d = lo2f(u.x) * na.x + hi2f(u.x) * na.y + lo2f(u.y) * na.z + hi2f(u.y) * na.w + lo2f(u.z) * nb.x + hi2f(u.z) * nb.y + lo2f(u.w) * nb.z + hi2f(u.w) * nb.w;
            d += __shfl_xor(d, 1); d += __shfl_xor(d, 2); d += __shfl_xor(d, 4);
            dq_keep = d;
        }
        { float a = 0.f;
#pragma unroll
          for (int i = 0; i < 8; ++i) { const int s_ = 8 * w + i; a += SN[s_] * bf2f(*(const LAS unsigned short*)(L + NK + s_ * 128 + lane * 2)); }
          SN[128 + w * 64 + lane] = a; }
        __syncthreads();
        if (on && tid < 64) { float nn = SN[640] * SN[64 + tid];
#pragma unroll
            for (int ww = 0; ww < 8; ++ww) nn += SN[128 + ww * 64 + tid];
            SN[64 + tid] = nn; }
        stash(st);
        if (on && n >= 4 && (tid & 7) == 0) dqp[row0 + (tid >> 3)] = dq_keep;
        LDS_BARRIER();
    };
    __syncthreads();
    issue(0, A); issue(1, B);
    if (tid < 64) SN[64 + tid] = 0.f;
    stash(A);
    __syncthreads();
#pragma unroll 1
    for (int n = 0; n < 69; n += 3) { step(n, C, B); step(n + 1, A, C); step(n + 2, B, A); }
}

template <int WHICH, int SKIP = 0>
__device__ __forceinline__ void p4_scan(Frame& F) {
    for (int t = F.vcu; t < 256; t += F.G) {
        if (t < 128 ? !(WHICH & 1) : !(WHICH & 2)) continue;
        if (t < 128) { if (ML_MFMA) scan_task<true, SKIP>(F, t); else { p4_mlstm_task(F, 2 * t); p4_mlstm_task(F, 2 * t + 1); } }
        else { if (HG_MFMA) { scan_task<false, SKIP>(F, t - 128); nchain_task(F, t - 128); } else { p4_hgrn2_task(F, 2 * (t - 128)); p4_hgrn2_task(F, 2 * (t - 128) + 1); } }
    }
}
__device__ __forceinline__ void p5_combine(Frame& F) {
    bf16* Y = F.XN;
    const int gw = F.vcu * NWAVES + F.wave, NGW = F.G * NWAVES;
    for (int row = gw; row < MX; row += NGW) {
        const int ch = F.lane * 16;
        {
            float o[16];
            const v4u a0 = *(const GAS v4u*)(F.OAF + (size_t)row * WA + ch), a1 = *(const GAS v4u*)(F.OAF + (size_t)row * WA + ch + 8);
            const v4u b0 = *(const GAS v4u*)(F.OAB + (size_t)row * WA + ch), b1 = *(const GAS v4u*)(F.OAB + (size_t)row * WA + ch + 8);
            const unsigned ua[8] = {a0.x, a0.y, a0.z, a0.w, a1.x, a1.y, a1.z, a1.w}, ub[8] = {b0.x, b0.y, b0.z, b0.w, b1.x, b1.y, b1.z, b1.w};
            float ss = 0.f;
#pragma unroll
            for (int j = 0; j < 8; ++j) { o[2 * j] = lo2f(ua[j]) + lo2f(ub[j]); o[2 * j + 1] = hi2f(ua[j]) + hi2f(ub[j]); ss += o[2 * j] * o[2 * j] + o[2 * j + 1] * o[2 * j + 1]; }
            ss += __shfl_xor(ss, 1); ss += __shfl_xor(ss, 2); ss += __shfl_xor(ss, 4);
            const float r = 1.f / sqrtf(ss * (1.f / HGD) + NORM_EPS);
            const v4u z0 = *(const GAS v4u*)(F.U + (size_t)row * NU + C_AZ + ch), z1 = *(const GAS v4u*)(F.U + (size_t)row * NU + C_AZ + ch + 8);
            const unsigned uz[8] = {z0.x, z0.y, z0.z, z0.w, z1.x, z1.y, z1.z, z1.w};
            unsigned w[8];
#pragma unroll
            for (int j = 0; j < 8; ++j) { const float y0 = o[2 * j] * r * F.hg_norm_w[ch + 2 * j] * siluf(lo2f(uz[j])), y1 = o[2 * j + 1] * r * F.hg_norm_w[ch + 2 * j + 1] * siluf(hi2f(uz[j])); w[j] = pk2(y0, y1); }
            *(GAS v4u*)(Y + (size_t)row * DM + ch) = (v4u){w[0], w[1], w[2], w[3]}; *(GAS v4u*)(Y + (size_t)row * DM + ch + 8) = (v4u){w[4], w[5], w[6], w[7]};
        }
        {
            float o[16];
            const v4u a0 = *(const GAS v4u*)(F.HBF + (size_t)row * WB + ch), a1 = *(const GAS v4u*)(F.HBF + (size_t)row * WB + ch + 8);
            const v4u b0 = *(const GAS v4u*)(F.HBB + (size_t)row * WB + ch), b1 = *(const GAS v4u*)(F.HBB + (size_t)row * WB + ch + 8);
            const unsigned ua[8] = {a0.x, a0.y, a0.z, a0.w, a1.x, a1.y, a1.z, a1.w}, ub[8] = {b0.x, b0.y, b0.z, b0.w, b1.x, b1.y, b1.z, b1.w};
            float s = 0.f; const int hq = F.lane >> 4;
            float invd[2];
#pragma unroll
            for (int d = 0; d < 2; ++d) { const float* mr = F.MLS + ((size_t)(d * 4 + hq) * MALL + row) * 8; const float* dq = F.DQP + (size_t)((d * 4 + hq) * 4) * MX + row;
                const float den = mr[2] * ((dq[0] + dq[MX]) + (dq[2 * MX] + dq[3 * MX])) + mr[5];
                invd[d] = rcpf_(fmaxf(fabsf(den), mr[4])); }
#pragma unroll
            for (int j = 0; j < 8; ++j) { o[2 * j] = lo2f(ua[j]) * invd[0] + lo2f(ub[j]) * invd[1]; o[2 * j + 1] = hi2f(ua[j]) * invd[0] + hi2f(ub[j]) * invd[1]; s += o[2 * j] + o[2 * j + 1]; }
            s += __shfl_xor(s, 1); s += __shfl_xor(s, 2); s += __shfl_xor(s, 4); s += __shfl_xor(s, 8);
            const float mu = s * (1.f / MLD); float q = 0.f;
#pragma unroll
            for (int j = 0; j < 16; ++j) { o[j] -= mu; q += o[j] * o[j]; }
            q += __shfl_xor(q, 1); q += __shfl_xor(q, 2); q += __shfl_xor(q, 4); q += __shfl_xor(q, 8);
            const float r = 1.f / sqrtf(q * (1.f / MLD) + NORM_EPS);
            const v4u g0 = *(const GAS v4u*)(F.U + (size_t)row * NU + C_BO + ch), g1 = *(const GAS v4u*)(F.U + (size_t)row * NU + C_BO + ch + 8);
            const v4u z0 = *(const GAS v4u*)(F.U + (size_t)row * NU + C_BZ + ch), z1 = *(const GAS v4u*)(F.U + (size_t)row * NU + C_BZ + ch + 8);
            const unsigned ug[8] = {g0.x, g0.y, g0.z, g0.w, g1.x, g1.y, g1.z, g1.w}, uz[8] = {z0.x, z0.y, z0.z, z0.w, z1.x, z1.y, z1.z, z1.w};
            unsigned w[8];
#pragma unroll
            for (int j = 0; j < 8; ++j) { const float y0 = o[2 * j] * r * F.ml_norm_w[ch + 2 * j] * sigmf(lo2f(ug[j])) * siluf(lo2f(uz[j])), y1 = o[2 * j + 1] * r * F.ml_norm_w[ch + 2 * j + 1] * sigmf(hi2f(ug[j])) * siluf(hi2f(uz[j])); w[j] = pk2(y0, y1); }
            *(GAS v4u*)(Y + (size_t)row * DM + WA + ch) = (v4u){w[0], w[1], w[2], w[3]}; *(GAS v4u*)(Y + (size_t)row * DM + WA + ch + 8) = (v4u){w[4], w[5], w[6], w[7]};
        }
    }
}

struct EpiResid {
    static constexpr bool PERM = false, AFTER_DRAIN = false;
    const float* x; const float* gate; float* out;
    __device__ __forceinline__ void operator()(const pg8::f32x4 (&acc)[2][2][4][2], const pg8::Unit& u, int wr, int wc, int fr, int fq) const {
        using pg8::BM; using pg8::HALF;
        const int row0 = u.pm * BM + wr * 64 + fr, col0 = u.pn * BM + wc * 32 + 4 * fq; const int b = (u.pm * BM) / SEQ;
        pg8::f32x4 gv[2][2];
#pragma unroll
        for (int bj = 0; bj < 2; ++bj)
#pragma unroll
            for (int n = 0; n < 2; ++n) gv[bj][n] = *(const pg8::f32x4*)(gate + b * DM + col0 + bj * HALF + n * 16);
#pragma unroll
        for (int ai = 0; ai < 2; ++ai) {
            pg8::f32x4 xv[4][2][2];
#pragma unroll
            for (int m = 0; m < 4; ++m) { const size_t off = (size_t)(row0 + ai * HALF + m * 16) * DM + col0;
#pragma unroll
                for (int bj = 0; bj < 2; ++bj)
#pragma unroll
                    for (int n = 0; n < 2; ++n) xv[m][bj][n] = *(const pg8::f32x4*)(x + off + bj * HALF + n * 16); }
#pragma unroll
            for (int m = 0; m < 4; ++m) { const size_t off = (size_t)(row0 + ai * HALF + m * 16) * DM + col0;
#pragma unroll
                for (int bj = 0; bj < 2; ++bj)
#pragma unroll
                    for (int n = 0; n < 2; ++n) *(pg8::f32x4*)(out + off + bj * HALF + n * 16) = xv[m][bj][n] * ALPHA + gv[bj][n] * acc[ai][bj][m][n]; }
        }
    }
};


struct PanelOrder {
    int c;
    __device__ __forceinline__ bool next(int i, pg8::Unit& u) const { if (i >= 2) return false; u.pm = c >> 2; u.pn = (c & 3) + 4 * i; return true; }
    __device__ __forceinline__ void a_ready(const pg8::Unit&) const {}
    __device__ __forceinline__ void done(const pg8::Unit&) const {}
};
struct EpiLnFused {
    static constexpr bool PERM = false, AFTER_DRAIN = true;
    const float* x; const float* gate; float* out; const float* ln_g; const float* ln_b;
    unsigned long long* xbuf;
    unsigned* cnt;
    __device__ __forceinline__ void zstats(pg8::f32x4 (&acc)[2][2][4][2], const pg8::Unit& u, int wr, int wc, int fr, int fq) const {
        using pg8::BM; using pg8::HALF;
        asm volatile("" : "+v"(fr), "+v"(fq));
        const int row0 = u.pm * BM + wr * 64 + fr, col0 = u.pn * BM + wc * 32 + 4 * fq; const int b = (u.pm * BM) / SEQ;
        pg8::f32x4 gv[2][2];
#pragma unroll
        for (int bj = 0; bj < 2; ++bj)
#pragma unroll
            for (int n = 0; n < 2; ++n) gv[bj][n] = *(const pg8::f32x4*)(gate + b * DM + col0 + bj * HALF + n * 16);
#pragma unroll
        for (int ai = 0; ai < 2; ++ai)
#pragma unroll
            for (int m = 0; m < 4; ++m) { const int row = row0 + ai * HALF + m * 16; const size_t off = (size_t)row * DM + col0;
                float s = 0.f;
#pragma unroll
                for (int bj = 0; bj < 2; ++bj)
#pragma unroll
                    for (int n = 0; n < 2; ++n) { const pg8::f32x4 xv = *(const pg8::f32x4*)(x + off + bj * HALF + n * 16);
                        const pg8::f32x4 z = xv * ALPHA + gv[bj][n] * acc[ai][bj][m][n]; acc[ai][bj][m][n] = z; s += (z[0] + z[1]) + (z[2] + z[3]); }
                s += __shfl_xor(s, 16); s += __shfl_xor(s, 32);
                const float mw = s * (1.0f / 64.0f); float q = 0.f;
#pragma unroll
                for (int bj = 0; bj < 2; ++bj)
#pragma unroll
                    for (int n = 0; n < 2; ++n) { const pg8::f32x4 d = acc[ai][bj][m][n] - mw; q += (d[0] * d[0] + d[1] * d[1]) + (d[2] * d[2] + d[3] * d[3]); }
                q += __shfl_xor(q, 16); q += __shfl_xor(q, 32);
                if (fq == 0) __hip_atomic_store(xbuf + (size_t)row * 32 + u.pn * 4 + wc, ((unsigned long long)__float_as_uint(q) << 32) | __float_as_uint(mw), __ATOMIC_RELAXED, __HIP_MEMORY_SCOPE_AGENT);
            }
    }
    __device__ __forceinline__ void publish(const pg8::Unit& u) const {
        asm volatile("s_waitcnt vmcnt(0)" ::: "memory");
        if ((threadIdx.x & 63) == 0) __hip_atomic_fetch_add(cnt + 64 * u.pm, 1u, __ATOMIC_RELAXED, __HIP_MEMORY_SCOPE_AGENT);
    }
    __device__ __forceinline__ void operator()(const pg8::f32x4 (&acc_c)[2][2][4][2], const pg8::Unit& u, int wr, int wc, int fr, int fq) const {
        using pg8::BM; using pg8::HALF;
        pg8::f32x4 (&acc)[2][2][4][2] = const_cast<pg8::f32x4 (&)[2][2][4][2]>(acc_c);
        zstats(acc, u, wr, wc, fr, fq);
        const int row0 = u.pm * BM + wr * 64 + fr, col0 = u.pn * BM + wc * 32 + 4 * fq;
#pragma unroll
        for (int ai = 0; ai < 2; ++ai)
#pragma unroll
            for (int m = 0; m < 4; ++m) { const size_t off = (size_t)(row0 + ai * HALF + m * 16) * DM + col0;
#pragma unroll
                for (int bj = 0; bj < 2; ++bj)
#pragma unroll
                    for (int n = 0; n < 2; ++n) *(pg8::f32x4*)(out + off + bj * HALF + n * 16) = acc[ai][bj][m][n]; }
        publish(u);
    }
    __device__ __forceinline__ void fused(pg8::f32x4 (&acc)[2][2][4][2], const pg8::Unit& u, int wr, int wc, int fr, int fq, PG8_LAS unsigned char* lds, int wid, int lane) const {
        using pg8::BM; using pg8::HALF;
        typedef float f32x2v __attribute__((ext_vector_type(2)));
        PG8_LAS f32x2v* PH = (PG8_LAS f32x2v*)(lds + 131072);
        PG8_LAS f32x2v* S = (PG8_LAS f32x2v*)(lds + 131072 + 4096);
        zstats(acc, u, wr, wc, fr, fq);
        publish(u);
        if (wid == 0) {
            unsigned spins = 0;
            while ((unsigned)__builtin_amdgcn_readfirstlane(__hip_atomic_load(cnt + 64 * u.pm, __ATOMIC_RELAXED, __HIP_MEMORY_SCOPE_AGENT)) < 64u) { __builtin_amdgcn_s_sleep(2); if (++spins > (1u << 22)) break; }
            __builtin_amdgcn_fence(__ATOMIC_ACQUIRE, "agent");
            asm volatile("s_waitcnt vmcnt(0)" ::: "memory");
        }
        asm volatile("s_waitcnt vmcnt(0) lgkmcnt(0)" ::: "memory"); __builtin_amdgcn_s_barrier(); asm volatile("" ::: "memory");
        { const int t = threadIdx.x, row = t >> 1, half = t & 1; const unsigned long long* sl = xbuf + (size_t)(u.pm * BM + row) * 32 + half * 16;
          float ms = 0.f, mq = 0.f, m2s = 0.f;
#pragma unroll
          for (int i = 0; i < 16; ++i) { const unsigned long long w = __hip_atomic_load(sl + i, __ATOMIC_RELAXED, __HIP_MEMORY_SCOPE_AGENT); const float mt = __uint_as_float((unsigned)w); ms += mt; mq += mt * mt; m2s += __uint_as_float((unsigned)(w >> 32)); }
          const float mh = ms * (1.0f / 16.0f);
          PH[row * 2 + half] = (f32x2v){mh, m2s + 64.0f * fmaxf(mq - 16.0f * mh * mh, 0.f)}; }
        asm volatile("s_waitcnt lgkmcnt(0)" ::: "memory"); __builtin_amdgcn_s_barrier(); asm volatile("" ::: "memory");
        if (threadIdx.x < 256) { const int row = threadIdx.x; const f32x2v a = PH[row * 2], bq = PH[row * 2 + 1];
            const float mean = 0.5f * (a.x + bq.x), da = a.x - mean, db = bq.x - mean; const float m2t = (a.y + bq.y) + 1024.0f * (da * da + db * db);
            S[row] = (f32x2v){mean, 1.0f / sqrtf(m2t * (1.0f / 2048.0f) + LN_EPS)}; }
        asm volatile("s_waitcnt lgkmcnt(0)" ::: "memory"); __builtin_amdgcn_s_barrier(); asm volatile("" ::: "memory");
        const int row0 = u.pm * BM + wr * 64 + fr, col0 = u.pn * BM + wc * 32 + 4 * fq;
#pragma unroll
        for (int bj = 0; bj < 2; ++bj)
#pragma unroll
            for (int n = 0; n < 2; ++n) { const int c = col0 + bj * HALF + n * 16;
                const pg8::f32x4 g2 = *(const pg8::f32x4*)(ln_g + c), b2 = *(const pg8::f32x4*)(ln_b + c), g1 = *(const pg8::f32x4*)(ln_g + c - 4 * BM), b1 = *(const pg8::f32x4*)(ln_b + c - 4 * BM);
#pragma unroll
                for (int ai = 0; ai < 2; ++ai)
#pragma unroll
                    for (int m = 0; m < 4; ++m) { const int rl = ai * HALF + wr * 64 + m * 16 + fr; const f32x2v sr = S[rl]; const size_t off = (size_t)(row0 + ai * HALF + m * 16) * DM + c;
                        const pg8::f32x4 z1 = *(const pg8::f32x4*)(out + off - 4 * BM);
                        *(pg8::f32x4*)(out + off) = (acc[ai][bj][m][n] - sr.x) * sr.y * g2 + b2;
                        acc[ai][bj][m][n] = (z1 - sr.x) * sr.y * g1 + b1; }
#pragma unroll
                for (int ai = 0; ai < 2; ++ai)
#pragma unroll
                    for (int m = 0; m < 4; ++m) { const size_t off = (size_t)(row0 + ai * HALF + m * 16) * DM + c; *(pg8::f32x4*)(out + off - 4 * BM) = acc[ai][bj][m][n]; } }
    }
};

__device__ __forceinline__ void p7_ln(Frame& F) {
    const int gw = F.vcu * NWAVES + F.wave, NGW = F.G * NWAVES;
    for (int row = 2 * gw; row < MX; row += 2 * NGW) {
        GAS f32x4* ra = (GAS f32x4*)(F.out + (size_t)row * DM) + F.lane; GAS f32x4* rb = ra + DM / 4;
        f32x4 va[8], vb[8]; float sa = 0.f, sb = 0.f;
#pragma unroll
        for (int j = 0; j < 8; ++j) { va[j] = ra[64 * j]; vb[j] = rb[64 * j]; }
#pragma unroll
        for (int j = 0; j < 8; ++j) { sa += (va[j].x + va[j].y) + (va[j].z + va[j].w); sb += (vb[j].x + vb[j].y) + (vb[j].z + vb[j].w); }
        const float ma = wave_sum(sa) * (1.f / DM), mb = wave_sum(sb) * (1.f / DM); float qa = 0.f, qb = 0.f;
#pragma unroll
        for (int j = 0; j < 8; ++j) { va[j] = va[j] - ma; vb[j] = vb[j] - mb; qa += (va[j].x * va[j].x + va[j].y * va[j].y) + (va[j].z * va[j].z + va[j].w * va[j].w); qb += (vb[j].x * vb[j].x + vb[j].y * vb[j].y) + (vb[j].z * vb[j].z + vb[j].w * vb[j].w); }
        const float rsa = 1.f / sqrtf(wave_sum(qa) * (1.f / DM) + LN_EPS), rsb = 1.f / sqrtf(wave_sum(qb) * (1.f / DM) + LN_EPS);
        f32x4 gg[8], bbv[8];
#pragma unroll
        for (int j = 0; j < 8; ++j) { const int k = 4 * F.lane + 256 * j; gg[j] = *(const f32x4*)(F.ln_g + k); bbv[j] = *(const f32x4*)(F.ln_b + k); }
#pragma unroll
        for (int j = 0; j < 8; ++j) { ra[64 * j] = va[j] * rsa * gg[j] + bbv[j]; rb[64 * j] = vb[j] * rsb * gg[j] + bbv[j]; }
    }
}

struct Args { const float* in[16]; float* out; unsigned char* ws; int ph_lo, ph_hi, li, pad; };
__global__ void __launch_bounds__(NWAVES * 64, 2) mk_fwd(Args args) {
    extern __shared__ __attribute__((aligned(16))) unsigned char lds[];
    Frame F;
    F.lds = (LAS unsigned char*)lds;
    F.MISC = (volatile LAS unsigned*)(F.lds + MISC_OFF);
    F.tid = threadIdx.x; F.lane = F.tid & 63; F.wave = __builtin_amdgcn_readfirstlane(F.tid >> 6);
    F.G = gridDim.x; { const int bx = blockIdx.x; F.vcu = (F.G % 8 == 0) ? (bx % 8) * (F.G / 8) + bx / 8 : bx; }
    unsigned char* ws = args.ws;
    F.ctl = (gu32*)(ws + WS_CTL);
    F.x = args.in[0]; F.c = args.in[1]; F.ctx = args.in[2]; F.c_ctx = args.in[3]; F.w_mod = args.in[4]; F.b_mod = args.in[5]; F.w_in = args.in[6];
    F.conv_w = args.in[7]; F.conv_b = args.in[8]; F.hg_lb = args.in[9]; F.ml_gate_b = args.in[10]; F.hg_norm_w = args.in[11]; F.ml_norm_w = args.in[12];
    F.w_out = args.in[13]; F.ln_g = args.in[14]; F.ln_b = args.in[15]; F.out = args.out;
    F.modp = (float*)(ws + WS_MODP); F.gate = (float*)(ws + WS_GATE);
    F.QTF = (bf16*)(ws + WS_WINT); F.PE = (float*)(ws + WS_PE); F.MLS = (float*)(ws + WS_MLS); F.DEC = (float*)(ws + WS_DEC); F.MLW = (bf16*)(ws + WS_MLW); F.DQP = (float*)(ws + WS_DQP);
    F.WinT = (bf16*)(ws + WS_WINT); F.WoutT = (bf16*)(ws + WS_WOUTT); F.XN = (bf16*)(ws + WS_XN); F.U = (bf16*)(ws + WS_U);
    F.OAF = (bf16*)args.out; F.OAB = F.OAF + (size_t)MX * WA; F.HBF = F.OAB + (size_t)MX * WA; F.HBB = F.HBF + (size_t)MX * WB;
    for (int u = F.tid; u < (LDS_BYTES - LDSCTL_OFF) / 4; u += NT) ((LAS unsigned*)(F.lds + LDSCTL_OFF))[u] = 0u;
    __syncthreads();
    XcdBarrier bar; bar.bar = (unsigned*)(F.ctl + CW_BAR); bar.x = 0; bar.st = nullptr;
    if (MK_N_LAUNCHES == 1) bar = xcd_barrier_post((unsigned*)(F.ctl + CW_BAR), F.MISC + 8);
    const int lo = args.ph_lo, hi = args.ph_hi;
#ifndef PH_MASK
#define PH_MASK 255
#endif
#define PHON(k) ((PH_MASK >> (k)) & 1)
#ifndef DUP_MASK
#define DUP_MASK 0
#endif
#define DUP(k) ((DUP_MASK >> (k)) & 1)
#ifndef FUSE_LN
#define FUSE_LN 0
#endif
#ifndef DUP4S
#define DUP4S 0
#endif
#ifndef DUP4W
#define DUP4W 3
#endif
#ifndef DUP3W
#define DUP3W 7
#endif
#define IN(k) (lo <= (k) && (k) < hi)
#define SEAM(k) do { if (IN(k) && IN((k) + 1)) xcd_barrier(bar); } while (0)
    if (PHON(0) && IN(0)) { p0_prep(F); if (DUP(0)) p0_prep(F); } SEAM(0);
    if (PHON(1) && IN(1)) { p1_lnmod(F); if (DUP(1)) p1_lnmod(F); } SEAM(1);
    if (PHON(2) && IN(2)) { pg8::Gemm g{F.XN, F.WinT, MALL, NU, DM}; pg8::StaticOrder S; S.init(MALL, NU, F.G, (int)blockIdx.x);
        pg8::EpiBf16<2> E{F.U, NU, nullptr, 0, 0, 1.f, 4};
        pg8::gemm_phase<pg8::EpiBf16<2>, pg8::StaticOrder, PG8_ALIGN, PG8_SP2>(F.lds + RING_OFF, g, S, E); } SEAM(2);
    if (PHON(3) && IN(3)) { if (DUP(3)) { if (DUP3W & 1) p3_hg_prep<true>(F); if (DUP3W & 2) p3_conv(F); if (DUP3W & 4) p3_ml_scalars(F); } p3_conv(F); if (HG_MFMA) p3_hg_prep<false>(F); if (ML_MFMA) p3_ml_scalars(F); xcd_barrier(bar); p3b_ml_scores(F); if (DUP(6)) p3b_ml_scores(F); } SEAM(3);
    if (PHON(4) && IN(4)) { if (DUP(4)) p4_scan<DUP4W, DUP4S>(F); p4_scan<3>(F); } SEAM(4);
    if (PHON(5) && IN(5)) { p5_combine(F); if (DUP(5)) p5_combine(F); if (DUP(7)) { xcd_barrier(bar); xcd_barrier(bar); xcd_barrier(bar); xcd_barrier(bar); } } SEAM(5);
    if (PHON(6) && IN(6)) { pg8::Gemm g{F.XN, F.WoutT, MX, DM, DM}; pg8::StaticOrder S; S.init(MX, DM, F.G, (int)blockIdx.x);
        if (F.G == 256 && FUSE_LN) { PanelOrder PO{F.vcu}; EpiLnFused E{F.x, F.gate, F.out, F.ln_g, F.ln_b, (unsigned long long*)(args.ws + WS_XB), (unsigned*)(F.ctl + CW_PANEL)};
            pg8::gemm_phase<EpiLnFused, PanelOrder, PG8_ALIGN, PG8_SP2>(F.lds + RING_OFF, g, PO, E); }
        else { EpiResid E{F.x, F.gate, F.out};
            pg8::gemm_phase<EpiResid, pg8::StaticOrder, PG8_ALIGN, PG8_SP2>(F.lds + RING_OFF, g, S, E);
            if (DUP(8)) { __syncthreads(); pg8::gemm_phase<EpiResid, pg8::StaticOrder, PG8_ALIGN, PG8_SP2>(F.lds + RING_OFF, g, S, E); } } }
    if (!(F.G == 256 && FUSE_LN)) { SEAM(6); if (PHON(7) && IN(7)) { p7_ln(F); } }
#undef IN
#undef SEAM
}

extern "C" void kernel_launch(void* const* d_in, const int* in_sizes, int n_in, void* d_out, int out_size, void* d_ws, size_t ws_size, hipStream_t stream) {
    static int grid = 0;
    if (grid == 0) {
        if (n_in != 16 || out_size != MX * DM || ws_size < WS_END) { fprintf(stderr, "kernel_launch: unexpected shapes (n_in %d out %d ws %zu)\n", n_in, out_size, ws_size); grid = -1; return; }
        int dev = 0, cus = 0, per_cu = 0;
        if (hipGetDevice(&dev) != hipSuccess || hipDeviceGetAttribute(&cus, hipDeviceAttributeMultiprocessorCount, dev) != hipSuccess) { grid = -1; return; }
        if (hipFuncSetAttribute((const void*)mk_fwd, hipFuncAttributeMaxDynamicSharedMemorySize, LDS_BYTES) != hipSuccess) { fprintf(stderr, "kernel_launch: hipFuncSetAttribute failed\n"); grid = -1; return; }
        if (hipOccupancyMaxActiveBlocksPerMultiprocessor(&per_cu, (const void*)mk_fwd, NT, LDS_BYTES) != hipSuccess || per_cu < 1) { fprintf(stderr, "kernel_launch: occupancy query says %d\n", per_cu); per_cu = 1; }
        (void)hipGetLastError();
        grid = cus;
    }
    if (grid < 0) return;
    if (hipMemsetAsync((char*)d_ws + WS_CTL, 0, CTL_ZERO_BYTES, stream) != hipSuccess) { fprintf(stderr, "kernel_launch: memset failed\n"); return; }
    Args a{};
    for (int i = 0; i < 16; ++i) a.in[i] = (const float*)d_in[i];
    a.out = (float*)d_out; a.ws = (unsigned char*)d_ws;
    for (int li = 0; li < MK_N_LAUNCHES; ++li) {
        a.ph_lo = (MK_N_LAUNCHES == 1) ? 0 : li; a.ph_hi = (MK_N_LAUNCHES == 1) ? N_PHASES : li + 1; a.li = li;
        hipLaunchKernelGGL(mk_fwd, dim3(grid), dim3(NT), LDS_BYTES, stream, a);
        const hipError_t le = hipPeekAtLastError();
        if (le != hipSuccess) { fprintf(stderr, "kernel_launch: launch %d failed: %s\n", li, hipGetErrorName(le)); break; }
    }
}
```

```cpp
#include <hip/hip_runtime.h>
#include <cstdio>
#include <cstdint>
namespace pg8 {
#define PG8_LAS __attribute__((address_space(3)))
typedef unsigned short bf16_t;
typedef short bf16x8 __attribute__((ext_vector_type(8)));
typedef float f32x4 __attribute__((ext_vector_type(4)));
typedef unsigned u32x4 __attribute__((ext_vector_type(4)));
constexpr int BM = 256, BK = 64, HALF = 128, HTB = HALF * BK * 2  , STAGE_BYTES = 8 * HTB, NXCD = 8, WGM = 4;

__host__ __device__ __forceinline__ int lds_byte(int r, int c) { const int st = (r >> 4) * 2 + (c >> 5), rr = r & 15, cc = c & 31, ob = rr * 64 + cc * 2; return st * 1024 + (ob ^ (((ob >> 9) & 1) << 5)); }
__host__ __device__ __forceinline__ void stage_rc(int b, int& R, int& C) { const int st = b / 1024, sb = b % 1024, swz = sb ^ (((sb >> 9) & 1) << 5); R = (st >> 1) * 16 + swz / 64; C = (st & 1) * 32 + (swz % 64) / 2; }
__host__ __device__ __forceinline__ int perm32(int rho) { const int n = rho >> 4, i = rho & 15; return 8 * (i >> 2) + 4 * n + (i & 3); }

struct Unit { int pm, pn; };
struct Gemm { const bf16_t* A; const bf16_t* Bt; int M, N, K; };

struct StaticOrder {
    int nM, nN, nwg, G, c;
    __host__ __device__ void init(int M, int N, int G_, int c_) { nM = M / BM; nN = N / BM; nwg = nM * nN; G = G_; c = c_; }
    __host__ __device__ bool next(int i, Unit& u) const {
        const long L = (long)i * G + c; if (L >= nwg) return false;
        int wgid = (int)L; { const int q = nwg / NXCD, r = nwg % NXCD, xcd = wgid % NXCD, off = wgid / NXCD; wgid = (xcd < r ? xcd * (q + 1) : r * (q + 1) + (xcd - r) * q) + off; }
        const int nig = WGM * nN, gid = wgid / nig, fm = gid * WGM, gsz = (nM - fm) < WGM ? (nM - fm) : WGM;
        u.pm = fm + ((wgid % nig) % gsz); u.pn = (wgid % nig) / gsz; return true;
    }
    __device__ __forceinline__ void a_ready(const Unit&) const {}
    __device__ __forceinline__ void done(const Unit&) const {}
};

__device__ __forceinline__ unsigned cvt_pk_bf16(float lo, float hi) { unsigned r; asm volatile("v_cvt_pk_bf16_f32 %0, %1, %2" : "=v"(r) : "v"(lo), "v"(hi)); return r; }
typedef float f32x2 __attribute__((ext_vector_type(2)));
__device__ __forceinline__ f32x2 gelu_pk(f32x2 v) {
    const f32x2 av = __builtin_elementwise_abs(v), d = av * 0.2316418882f + 1.0f;
    f32x2 t; t.x = __builtin_amdgcn_rcpf(d.x); t.y = __builtin_amdgcn_rcpf(d.y);
    f32x2 q = t * 0.5307027145f + (-0.7265760135f); q = q * t + 0.7107068705f; q = q * t + (-0.142248368f); q = q * t + 0.127414796f; q = q * t;
    const f32x2 s = (v * v) * (-0.72134752044f);
    f32x2 e; e.x = __builtin_amdgcn_exp2f(s.x); e.y = __builtin_amdgcn_exp2f(s.y);
    const f32x2 m = v * (q * e), r = v - m;
    f32x2 o; o.x = v.x < 0.f ? m.x : r.x; o.y = v.y < 0.f ? m.y : r.y; return o;
}

template <int ACT  > struct EpiBf16 {
    static constexpr bool PERM = true, AFTER_DRAIN = false, SPLIT = (ACT != 1), ADJ = (ACT != 1); static constexpr int HALF_STORES = 8; static_assert(ACT == 0 || ACT == 1 || ACT == 2, "EpiBf16: ACT is 0 (none), 1 (gelu_pk) or 2 (SiLU on the column tiles pn < act_tiles)");
    bf16_t* O; int ldc; const float* bias; int split_cols; size_t split_stride; float scale0; int act_tiles;
    __device__ __forceinline__ void operator()(const f32x4 (&acc)[2][2][4][2], const Unit& u, int wr, int wc, int fr, int fq) const {
        const int row0 = u.pm * BM + wr * 64 + fr; int colt = u.pn * BM; bf16_t* base = O;
        float sc = 1.f; if (split_cols) { const int t = colt / split_cols; base += (size_t)t * split_stride; colt -= t * split_cols; if (t == 0) sc = scale0; }
        const int col0 = colt + wc * (ADJ ? 64 : 32) + 8 * fq, bcol0 = u.pn * BM + wc * (ADJ ? 64 : 32) + 8 * fq; constexpr int BJS = ADJ ? 32 : HALF;
        f32x4 bv[2][2];
#pragma unroll
        for (int bj = 0; bj < 2; ++bj)
#pragma unroll
            for (int n = 0; n < 2; ++n) bv[bj][n] = bias ? *(const f32x4*)(bias + bcol0 + bj * BJS + 4 * n) : (f32x4){0.f, 0.f, 0.f, 0.f};
#pragma unroll
        for (int ai = 0; ai < 2; ++ai)
#pragma unroll
            for (int m = 0; m < 4; ++m) { bf16_t* rowp = base + (size_t)(row0 + ai * HALF + m * 16) * ldc + col0;
#pragma unroll
                for (int bj = 0; bj < 2; ++bj) { f32x4 v0 = acc[ai][bj][m][0] + bv[bj][0], v1 = acc[ai][bj][m][1] + bv[bj][1];
                    if (ACT == 1) { f32x2 a = gelu_pk((f32x2){v0[0], v0[1]}), b = gelu_pk((f32x2){v0[2], v0[3]}), c = gelu_pk((f32x2){v1[0], v1[1]}), d = gelu_pk((f32x2){v1[2], v1[3]});
                        v0 = (f32x4){a.x, a.y, b.x, b.y}; v1 = (f32x4){c.x, c.y, d.x, d.y}; }
                    if (ACT == 2 && u.pn < act_tiles) {
#pragma unroll
                        for (int e = 0; e < 4; ++e) { v0[e] = v0[e] * __builtin_amdgcn_rcpf(1.0f + __expf(-v0[e])); v1[e] = v1[e] * __builtin_amdgcn_rcpf(1.0f + __expf(-v1[e])); } }
                    v0 = v0 * sc; v1 = v1 * sc; u32x4 w; w.x = cvt_pk_bf16(v0[0], v0[1]); w.y = cvt_pk_bf16(v0[2], v0[3]); w.z = cvt_pk_bf16(v1[0], v1[1]); w.w = cvt_pk_bf16(v1[2], v1[3]);
                    *(u32x4*)(rowp + bj * BJS) = w; } }
    }
    template <bool ACTV> __device__ __forceinline__ void half_t(const f32x4 (&acc)[2][2][4][2], const Unit& u, const int ai, int wr, int wc, int fr, int fq) const {
        unsigned frv = (unsigned)fr; asm volatile("" : "+v"(frv));
        const bool odd = (frv & 1u) != 0u;
        const unsigned off0 = ((unsigned)(u.pm * BM + wr * 64 + ai * HALF) + (frv & ~1u)) * (unsigned)ldc * 2u + (unsigned)(u.pn * BM + wc * 64 + 8 * fq) * 2u + (frv & 1u) * 64u;
        char* const ob = (char*)O;
#pragma unroll
        for (int m = 0; m < 4; ++m) { u32x4 w[2];
#pragma unroll
            for (int bj = 0; bj < 2; ++bj) { f32x4 v0 = acc[ai][bj][m][0], v1 = acc[ai][bj][m][1];
                if (ACTV) {
#pragma unroll
                    for (int e = 0; e < 4; ++e) { v0[e] = v0[e] * __builtin_amdgcn_rcpf(1.0f + __expf(-v0[e])); v1[e] = v1[e] * __builtin_amdgcn_rcpf(1.0f + __expf(-v1[e])); } }
                w[bj].x = cvt_pk_bf16(v0[0], v0[1]); w[bj].y = cvt_pk_bf16(v0[2], v0[3]); w[bj].z = cvt_pk_bf16(v1[0], v1[1]); w[bj].w = cvt_pk_bf16(v1[2], v1[3]); }
            u32x4 sa, sb;
#pragma unroll
            for (int e = 0; e < 4; ++e) { const unsigned t = odd ? w[0][e] : w[1][e];
                const unsigned r = (unsigned)__builtin_amdgcn_update_dpp(0, (int)t, 0xB1, 0xf, 0xf, false);
                sa[e] = odd ? r : w[0][e]; sb[e] = odd ? w[1][e] : r; }
            *(u32x4*)(ob + (size_t)(off0 + (unsigned)(m * 16 * ldc) * 2u)) = sa;
            *(u32x4*)(ob + (size_t)(off0 + (unsigned)((m * 16 + 1) * ldc) * 2u)) = sb; }
    }
    __device__ __forceinline__ void half(const f32x4 (&acc)[2][2][4][2], const Unit& u, const int ai, int wr, int wc, int fr, int fq) const {
        if (ACT == 2 && u.pn < act_tiles) half_t<true>(acc, u, ai, wr, wc, fr, fq); else half_t<false>(acc, u, ai, wr, wc, fr, fq);
    }
};
template <class Epi, class Sched, bool ALIGN_EPI = false, bool SP2 = false>
__device__ __forceinline__ void gemm_phase(PG8_LAS unsigned char* lds, const Gemm g, const Sched& S, const Epi& E) {
    const int tid = threadIdx.x, wid = __builtin_amdgcn_readfirstlane(tid >> 6), lane = tid & 63, wr = wid >> 2, wc = wid & 3, fr = lane & 15, fq = lane >> 4;
    const int K = g.K, nt = K / BK;
    unsigned voffA[2], voffB[2];
#pragma unroll
    for (int i = 0; i < 2; ++i) { int R, C; stage_rc(tid * 16 + i * 8192, R, C); const int Rb = Epi::PERM ? ((R & ~31) + perm32(R & 31)) : R;
        voffA[i] = (unsigned)(R * K + C) * 2u; voffB[i] = (unsigned)((Epi::ADJ ? 64 * (R >> 5) + perm32(R & 31) : Rb) * K + C) * 2u; }
    const size_t kstep = (size_t)(BK * 2);
    const size_t hstep = (size_t)HALF * K * 2;
    const size_t hstepB = Epi::ADJ ? (size_t)32 * K * 2 : hstep;
    const size_t tstep = 2 * hstep;
    const unsigned ldsw = (unsigned)wid * 1024u;
    const int aoff = lds_byte(wr * 64 + fr, fq * 8), boff = lds_byte(wc * 32 + fr, fq * 8);
#define PG8_SA(b, h) (((b) * 2 + (h)) * HTB)
#define PG8_SB(b, h) ((4 + (b) * 2 + (h)) * HTB)
#define PG8_STAGE(bufoff, gbase, voff) do { _Pragma("unroll") for (int _i = 0; _i < 2; ++_i) \
        __builtin_amdgcn_global_load_lds((const unsigned*)((const char*)(gbase) + (voff)[_i]), (PG8_LAS unsigned*)(lds + (bufoff) + ldsw + _i * 8192), 16, 0, 0); } while (0)
#define PG8_LDA(dst, b, h) do { _Pragma("unroll") for (int m = 0; m < 4; ++m) _Pragma("unroll") for (int k = 0; k < 2; ++k) dst[m][k] = *(const PG8_LAS bf16x8*)(lds + PG8_SA(b, h) + aoff + m * 2048 + k * 1024); } while (0)
#define PG8_LDB(dst, b, h) do { _Pragma("unroll") for (int n = 0; n < 2; ++n) _Pragma("unroll") for (int k = 0; k < 2; ++k) dst[n][k] = *(const PG8_LAS bf16x8*)(lds + PG8_SB(b, h) + boff + n * 2048 + k * 1024); } while (0)
#define PG8_MMA(ai, bj, At, Bt) do { __builtin_amdgcn_s_setprio(1); _Pragma("unroll") for (int m = 0; m < 4; ++m) _Pragma("unroll") for (int n = 0; n < 2; ++n) _Pragma("unroll") for (int k = 0; k < 2; ++k) \
        acc[ai][bj][m][n] = __builtin_amdgcn_mfma_f32_16x16x32_bf16(Bt[n][k], At[m][k], acc[ai][bj][m][n], 0, 0, 0); __builtin_amdgcn_s_setprio(0); } while (0)
#define PG8_WAIT_V(n) asm volatile("s_waitcnt vmcnt(" #n ")" ::: "memory")
#define PG8_WAIT_V1 do { if constexpr (Epi::HALF_STORES == 8) PG8_WAIT_V(16); else PG8_WAIT_V(8); } while (0)
#define PG8_WAIT_V2 do { if constexpr (Epi::HALF_STORES == 8) PG8_WAIT_V(24); else PG8_WAIT_V(8); } while (0)
#define PG8_WAIT_L(n) asm volatile("s_waitcnt lgkmcnt(" #n ")" ::: "memory")
#define PG8_BAR __builtin_amdgcn_s_barrier()
#define PG8_SCHED __builtin_amdgcn_sched_barrier(0)
    Unit cur, nxt, prv; int ui = 0;
    if (!S.next(0, cur)) return;
    f32x4 acc[2][2][4][2];
#pragma unroll
    for (int a = 0; a < 2; ++a)
#pragma unroll
        for (int b = 0; b < 2; ++b)
#pragma unroll
            for (int m = 0; m < 4; ++m)
#pragma unroll
                for (int n = 0; n < 2; ++n) acc[a][b][m][n] = (f32x4){0.f, 0.f, 0.f, 0.f};
    bf16x8 At[4][2], B0[2][2], B1[2][2];
    const char* cA = (const char*)g.A + (size_t)cur.pm * tstep; const char* cB = (const char*)g.Bt + (size_t)cur.pn * tstep;
    S.a_ready(cur);
    if constexpr (SP2) {
        PG8_STAGE(PG8_SB(0, 0), cB, voffB); PG8_STAGE(PG8_SB(0, 1), cB + hstepB, voffB); PG8_STAGE(PG8_SA(0, 0), cA, voffA); PG8_STAGE(PG8_SA(0, 1), cA + hstep, voffA);
        if (wr == 1) PG8_BAR;
        PG8_WAIT_V(2); PG8_BAR;
        PG8_STAGE(PG8_SB(1, 0), cB + kstep, voffB); PG8_STAGE(PG8_SA(1, 0), cA + kstep, voffA); PG8_STAGE(PG8_SB(1, 1), cB + hstepB + kstep, voffB);
        PG8_WAIT_V(6); PG8_BAR;
    } else {
        PG8_STAGE(PG8_SB(0, 0), cB, voffB); PG8_STAGE(PG8_SA(0, 0), cA, voffA); PG8_STAGE(PG8_SB(0, 1), cB + hstepB, voffB); PG8_STAGE(PG8_SA(0, 1), cA + hstep, voffA);
        if (wr == 1) PG8_BAR;
        PG8_WAIT_V(4); PG8_BAR;
        PG8_STAGE(PG8_SB(1, 0), cB + kstep, voffB); PG8_STAGE(PG8_SA(1, 0), cA + kstep, voffA); PG8_STAGE(PG8_SB(1, 1), cB + hstepB + kstep, voffB);
        PG8_WAIT_V(6); PG8_BAR;
    }
    for (;;) {
        const bool has_next = S.next(ui + 1, nxt);
        const char* nA = has_next ? (const char*)g.A + (size_t)nxt.pm * tstep : cA; const char* nB = has_next ? (const char*)g.Bt + (size_t)nxt.pn * tstep : cB;
        for (int t = 0; t < nt; t += 2) {
            const bool last = (t == nt - 2);
            const char* a1 = cA + (size_t)(t + 1) * kstep;
            const char* a2 = last ? nA : cA + (size_t)(t + 2) * kstep; const char* b2 = last ? nB : cB + (size_t)(t + 2) * kstep;
            const char* a3 = a2 + kstep; const char* b3 = b2 + kstep;
            if (last && has_next) S.a_ready(nxt);
            if constexpr (SP2 && Epi::SPLIT) {
            const bool pend = (t == 0) && (ui > 0);
            PG8_LDB(B0, 0, 0); PG8_LDB(B1, 0, 1); PG8_SCHED; PG8_LDA(At, 0, 0); PG8_STAGE(PG8_SA(1, 1), a1 + hstep, voffA);
            if (pend) PG8_WAIT_V1; else PG8_WAIT_V(8);
            PG8_WAIT_L(0); PG8_BAR; PG8_MMA(0, 0, At, B0); PG8_MMA(0, 1, At, B1); PG8_BAR; PG8_SCHED;
            PG8_LDA(At, 0, 1); PG8_STAGE(PG8_SB(0, 0), b2, voffB); PG8_STAGE(PG8_SB(0, 1), b2 + hstepB, voffB); PG8_STAGE(PG8_SA(0, 0), a2, voffA); PG8_SCHED;
            if (pend) { E.half(acc, prv, 1, wr, wc, fr, fq); PG8_SCHED;
#pragma unroll
                for (int b = 0; b < 2; ++b)
#pragma unroll
                    for (int m = 0; m < 4; ++m)
#pragma unroll
                        for (int n = 0; n < 2; ++n) acc[1][b][m][n] = (f32x4){0.f, 0.f, 0.f, 0.f};
                PG8_WAIT_V2; } else PG8_WAIT_V(8);
            PG8_WAIT_L(0); PG8_BAR; PG8_MMA(1, 0, At, B0); PG8_MMA(1, 1, At, B1); PG8_BAR; PG8_SCHED;
            PG8_LDB(B0, 1, 0); PG8_LDB(B1, 1, 1); PG8_SCHED; PG8_LDA(At, 1, 0); PG8_STAGE(PG8_SA(0, 1), a2 + hstep, voffA);
            if (pend) PG8_WAIT_V1; else PG8_WAIT_V(8);
            PG8_WAIT_L(0); PG8_BAR; PG8_MMA(0, 0, At, B0); PG8_MMA(0, 1, At, B1); PG8_BAR; PG8_SCHED;
            PG8_LDA(At, 1, 1); PG8_STAGE(PG8_SB(1, 0), b3, voffB); PG8_STAGE(PG8_SB(1, 1), b3 + hstepB, voffB); PG8_STAGE(PG8_SA(1, 0), a3, voffA); PG8_SCHED;
            if (last) { E.half(acc, cur, 0, wr, wc, fr, fq); PG8_SCHED;
#pragma unroll
                for (int b = 0; b < 2; ++b)
#pragma unroll
                    for (int m = 0; m < 4; ++m)
#pragma unroll
                        for (int n = 0; n < 2; ++n) acc[0][b][m][n] = (f32x4){0.f, 0.f, 0.f, 0.f};
                PG8_WAIT_V1; } else if (pend) PG8_WAIT_V1; else PG8_WAIT_V(8);
            PG8_WAIT_L(0); PG8_BAR; PG8_MMA(1, 0, At, B0); PG8_MMA(1, 1, At, B1); PG8_BAR; PG8_SCHED;
            } else if constexpr (SP2) {
            PG8_LDB(B0, 0, 0); PG8_LDB(B1, 0, 1); PG8_SCHED; PG8_LDA(At, 0, 0); PG8_STAGE(PG8_SA(1, 1), a1 + hstep, voffA);
            PG8_WAIT_V(8); PG8_WAIT_L(0); PG8_BAR; PG8_MMA(0, 0, At, B0); PG8_MMA(0, 1, At, B1); PG8_BAR; PG8_SCHED;
            PG8_LDA(At, 0, 1); PG8_STAGE(PG8_SB(0, 0), b2, voffB); PG8_STAGE(PG8_SB(0, 1), b2 + hstepB, voffB); PG8_STAGE(PG8_SA(0, 0), a2, voffA);
            PG8_WAIT_V(8); PG8_WAIT_L(0); PG8_BAR; PG8_MMA(1, 0, At, B0); PG8_MMA(1, 1, At, B1); PG8_BAR; PG8_SCHED;
            PG8_LDB(B0, 1, 0); PG8_LDB(B1, 1, 1); PG8_SCHED; PG8_LDA(At, 1, 0); PG8_STAGE(PG8_SA(0, 1), a2 + hstep, voffA);
            PG8_WAIT_V(8); PG8_WAIT_L(0); PG8_BAR; PG8_MMA(0, 0, At, B0); PG8_MMA(0, 1, At, B1); PG8_BAR; PG8_SCHED;
            PG8_LDA(At, 1, 1); PG8_STAGE(PG8_SB(1, 0), b3, voffB); PG8_STAGE(PG8_SB(1, 1), b3 + hstepB, voffB); PG8_STAGE(PG8_SA(1, 0), a3, voffA);
            PG8_WAIT_V(8); PG8_WAIT_L(0); PG8_BAR; PG8_MMA(1, 0, At, B0); PG8_MMA(1, 1, At, B1); PG8_BAR; PG8_SCHED;
            } else {
            PG8_LDB(B0, 0, 0); PG8_SCHED; PG8_LDA(At, 0, 0); PG8_STAGE(PG8_SA(1, 1), a1 + hstep, voffA);
            PG8_WAIT_L(8); PG8_BAR; PG8_WAIT_L(0); PG8_MMA(0, 0, At, B0); PG8_BAR; PG8_SCHED;
            PG8_LDB(B1, 0, 1); PG8_STAGE(PG8_SB(0, 0), b2, voffB);
            PG8_BAR; PG8_WAIT_L(0); PG8_MMA(0, 1, At, B1); PG8_BAR;
            PG8_LDA(At, 0, 1); PG8_STAGE(PG8_SA(0, 0), a2, voffA);
            PG8_BAR; PG8_WAIT_L(0); PG8_MMA(1, 0, At, B0); PG8_BAR; PG8_SCHED;
            PG8_STAGE(PG8_SB(0, 1), b2 + hstepB, voffB);
            PG8_WAIT_V(6); PG8_BAR; PG8_MMA(1, 1, At, B1); PG8_BAR;
            PG8_LDB(B0, 1, 0); PG8_SCHED; PG8_LDA(At, 1, 0); PG8_STAGE(PG8_SA(0, 1), a2 + hstep, voffA);
            PG8_WAIT_L(8); PG8_BAR; PG8_WAIT_L(0); PG8_MMA(0, 0, At, B0); PG8_BAR; PG8_SCHED;
            PG8_LDB(B1, 1, 1); PG8_STAGE(PG8_SB(1, 0), b3, voffB);
            PG8_BAR; PG8_WAIT_L(0); PG8_MMA(0, 1, At, B1); PG8_BAR;
            PG8_LDA(At, 1, 1); PG8_STAGE(PG8_SA(1, 0), a3, voffA);
            PG8_BAR; PG8_WAIT_L(0); PG8_MMA(1, 0, At, B0); PG8_BAR; PG8_SCHED;
            PG8_STAGE(PG8_SB(1, 1), b3 + hstepB, voffB);
            PG8_WAIT_V(6); PG8_BAR; PG8_MMA(1, 1, At, B1); PG8_BAR;
            }
        }
        if constexpr (SP2 && Epi::SPLIT) {
            if (!has_next) { E.half(acc, cur, 1, wr, wc, fr, fq); S.done(cur); break; }
            prv = cur; cur = nxt; cA = nA; cB = nB; ++ui; continue;
        }
        if constexpr (ALIGN_EPI) { if (wr == 0) PG8_BAR; }
        if constexpr (!Epi::AFTER_DRAIN) { E(acc, cur, wr, wc, fr, fq); S.done(cur); }
        else { if (has_next) { E(acc, cur, wr, wc, fr, fq); S.done(cur); } }
        if (!has_next) break;
#pragma unroll
        for (int a = 0; a < 2; ++a)
#pragma unroll
            for (int b = 0; b < 2; ++b)
#pragma unroll
                for (int m = 0; m < 4; ++m)
#pragma unroll
                    for (int n = 0; n < 2; ++n) acc[a][b][m][n] = (f32x4){0.f, 0.f, 0.f, 0.f};
        cur = nxt; cA = nA; cB = nB; ++ui;
        if constexpr (ALIGN_EPI) { if (wr == 1) PG8_BAR; }
    }
    PG8_WAIT_V(0);
    if constexpr (!ALIGN_EPI || (SP2 && Epi::SPLIT)) { if (wr == 0) PG8_BAR; }
    PG8_BAR;
    if constexpr (Epi::AFTER_DRAIN) { E.fused(acc, cur, wr, wc, fr, fq, lds, wid, lane); S.done(cur); }
#undef PG8_SA
#undef PG8_SB
#undef PG8_STAGE
#undef PG8_LDA
#undef PG8_LDB
#undef PG8_MMA
#undef PG8_WAIT_V
#undef PG8_WAIT_V1
#undef PG8_WAIT_V2
#undef PG8_WAIT_L
#undef PG8_BAR
#undef PG8_SCHED
}
}

#ifndef PG8_SP2
#define PG8_SP2 true
#endif
#ifndef PG8_ALIGN
#define PG8_ALIGN true
#endif
#define GAS __attribute__((address_space(1)))
#define LAS __attribute__((address_space(3)))
typedef unsigned short bf16;
typedef unsigned v4u __attribute__((ext_vector_type(4)));
typedef float f32x4 __attribute__((ext_vector_type(4)));
typedef short bf16x8 __attribute__((ext_vector_type(8)));
typedef GAS unsigned gu32;
typedef GAS unsigned long long gu64;
#define RLX_AGENT __ATOMIC_RELAXED, __HIP_MEMORY_SCOPE_AGENT
#define LDS_WAIT() asm volatile("s_waitcnt lgkmcnt(0)" ::: "memory")
#define VM_WAIT() asm volatile("s_waitcnt vmcnt(0)" ::: "memory")
__device__ __forceinline__ unsigned long long rt() { return __builtin_amdgcn_s_memrealtime(); }
__device__ __forceinline__ unsigned f2bf(float f) { unsigned u = __builtin_bit_cast(unsigned, f); return (u + 0x7fffu + ((u >> 16) & 1u)) >> 16; }
__device__ __forceinline__ unsigned pk2(float lo, float hi) { return f2bf(lo) | (f2bf(hi) << 16); }

#define XB_TMO      128
#define XB_XCNT(j)  (256  + 64 * (j))
#define XB_XSUB(j)  (1280 + 64 * (j))
#define XB_XGEN(j)  (2304 + 64 * (j))
#define XB_TOP      3328
#define XB_TOPGEN   3392
#define XCD_BAR_WORDS 3456
#define XB_SPIN_CAP (1u << 18)

__device__ __forceinline__ unsigned xb_ld(unsigned* p)              { return __hip_atomic_load(p, __ATOMIC_RELAXED, __HIP_MEMORY_SCOPE_AGENT); }
__device__ __forceinline__ unsigned xb_add(unsigned* p, unsigned v) { return __hip_atomic_fetch_add(p, v, __ATOMIC_RELAXED, __HIP_MEMORY_SCOPE_AGENT); }
__device__ __forceinline__ unsigned xb_xcc_id() { return (unsigned)__builtin_amdgcn_s_getreg((3 << 11) | 20) & 0xFu; }
#define XB_SPIN(cond, bar) do { unsigned _sp = 0; while (cond) { __builtin_amdgcn_s_sleep(1); \
    if ((++_sp & 255u) == 0u) { if (xb_ld(&(bar)[XB_TMO])) break; if (_sp > XB_SPIN_CAP) { atomicAdd(&(bar)[XB_TMO], 1u); break; } } } } while (0)

struct XcdBarrier {
    unsigned* bar; unsigned x;
    volatile LAS unsigned* st;
};

__device__ __forceinline__ XcdBarrier xcd_barrier_post(unsigned* bar, volatile LAS unsigned* st) {
    XcdBarrier b; b.bar = bar; b.x = xb_xcc_id(); b.st = st;
    if (threadIdx.x == 0) (void)xb_add(&bar[XB_XCNT(b.x)], 1u);
    return b;
}
__device__ __forceinline__ void xcd_barrier_complete(unsigned* bar, unsigned x, unsigned& nloc, unsigned& nx) {
    const unsigned G = gridDim.x * gridDim.y * gridDim.z;
    unsigned sum, cnt, mine, sp = 0u;
    for (;;) {
        sum = 0u; cnt = 0u; mine = 0u;
#pragma unroll
        for (unsigned j = 0; j < 16; ++j) { const unsigned c = xb_ld(&bar[XB_XCNT(j)]); sum += c; cnt += (c > 0u) ? 1u : 0u; mine = (j == x) ? c : mine; }
        if (sum == G) break;
        __builtin_amdgcn_s_sleep(1);
        if ((++sp & 255u) == 0u) { if (xb_ld(&bar[XB_TMO])) break; if (sp > XB_SPIN_CAP) { atomicAdd(&bar[XB_TMO], 1u); break; } }
    }
    nloc = mine > 0u ? mine : 1u; nx = cnt > 0u ? cnt : 1u;
}

__device__ __forceinline__ void xcd_barrier(const XcdBarrier& b) {
    asm volatile("s_waitcnt vmcnt(0)" ::: "memory");
    __syncthreads();
    if (threadIdx.x == 0) {
        unsigned* bar = b.bar;
        __builtin_amdgcn_s_waitcnt(0);
        unsigned nloc = b.st[0], nx = b.st[1];
        if (nloc == 0u) { xcd_barrier_complete(bar, b.x, nloc, nx); b.st[0] = nloc; b.st[1] = nx; }
        const unsigned old = xb_add(&bar[XB_XSUB(b.x)], 1u);
        const unsigned gen = old / nloc;
        if (old + 1u == (gen + 1u) * nloc) {
            __builtin_amdgcn_fence(__ATOMIC_RELEASE, "agent");
            asm volatile("s_waitcnt vmcnt(0)" ::: "memory");
            const unsigned og = xb_add(&bar[XB_TOP], 1u);
            const unsigned tg = og / nx;
            if (og + 1u == (tg + 1u) * nx) xb_add(&bar[XB_TOPGEN], 1u);
            else XB_SPIN(xb_ld(&bar[XB_TOPGEN]) == tg, bar);
            __builtin_amdgcn_fence(__ATOMIC_ACQUIRE, "agent");
            xb_add(&bar[XB_XGEN(b.x)], 1u);
            asm volatile("s_waitcnt vmcnt(0)" ::: "memory");
        } else {
            XB_SPIN(xb_ld(&bar[XB_XGEN(b.x)]) == gen, bar);
            __builtin_amdgcn_fence(__ATOMIC_ACQUIRE, "agent");
            asm volatile("s_waitcnt vmcnt(0)" ::: "memory");
        }
    }
    __syncthreads();
}
constexpr int NWAVES = 8, NT = NWAVES * 64;
constexpr int BATCH = 4, SEQ = 4096, DM = 2048, CTXL = 256;
constexpr int MX = BATCH * SEQ, MC = BATCH * CTXL, MALL = MX + MC;
constexpr int WA = 1024, WB = 1024, NIN = 10256, NU = 10496;
constexpr int C_AQ = 0, C_AFF = 1024, C_AFB = 2048, C_AI = 3072, C_AZ = 4096, C_BQK = 5120, C_BV = 7168, C_BO = 8192, C_BZ = 9216, C_BG = 10240;
constexpr int HGH = 8, HGD = 128, MLH = 4, MLD = 256;
constexpr float ALPHA = 1.189207115002721f;
constexpr float LN_EPS = 1e-5f, NORM_EPS = 1e-6f;
constexpr int NMOD = 3 * DM;

#ifndef MK_N_LAUNCHES
#define MK_N_LAUNCHES 1
#endif
constexpr int N_PHASES = 8;

constexpr size_t MiB = 1u << 20;
constexpr size_t WS_CTL = 0, CTL_ZERO_BYTES = 1 * MiB;
constexpr size_t WS_MODP = 1 * MiB;
constexpr size_t WS_GATE = 3 * MiB;
constexpr size_t WS_WINT = 4 * MiB;
constexpr size_t WS_WOUTT = 45 * MiB;
constexpr size_t WS_XN = 53 * MiB;
constexpr size_t WS_U = 121 * MiB;
constexpr size_t WS_PE = 470 * MiB, WS_MLS = 473 * MiB, WS_DEC = 478 * MiB;
constexpr size_t WS_MLW = 479 * MiB;
constexpr size_t WS_DQP = 496 * MiB;
constexpr size_t WS_XB = 498 * MiB;
constexpr size_t WS_END = 502 * MiB;
static_assert(WS_WINT + (size_t)NU * DM * 2 <= WS_WOUTT && WS_WOUTT + (size_t)DM * DM * 2 <= WS_XN && WS_XN + (size_t)MALL * DM * 2 <= WS_U && WS_U + (size_t)MALL * NU * 2 <= WS_END, "d_ws map");
constexpr int CW_TMO = 0, CW_BAR = 4096, CW_PANEL = 16384;

constexpr int RING_OFF = 0, RING_BYTES = 131072;
constexpr int LDS_BYTES = 163840;
constexpr int LDSCTL_OFF = LDS_BYTES - 1024, MISC_OFF = LDSCTL_OFF + 320;

struct Frame {
    LAS unsigned char* lds;
    volatile LAS unsigned* MISC;
    gu32* ctl;
    int tid, lane, wave, vcu, G;
    const float *x, *c, *ctx, *c_ctx, *w_mod, *b_mod, *w_in, *conv_w, *conv_b, *hg_lb, *ml_gate_b, *hg_norm_w, *ml_norm_w, *w_out, *ln_g, *ln_b;
    float* out;
    float *modp, *gate;
    bf16 *WinT, *WoutT, *XN, *U;
    bf16 *QTF, *MLW; float *PE, *MLS, *DEC, *DQP;
    bf16 *OAF, *OAB, *HBF, *HBB;
};

typedef float f32x2_t __attribute__((ext_vector_type(2)));
#define LDS_BARRIER() do { asm volatile("s_waitcnt lgkmcnt(0)" ::: "memory"); __builtin_amdgcn_s_barrier(); asm volatile("" ::: "memory"); } while (0)
typedef __bf16 bf16x2_t __attribute__((ext_vector_type(2)));
__device__ __forceinline__ unsigned pkbf(float a, float b) { const f32x2_t v = {a, b}; return __builtin_bit_cast(unsigned, __builtin_convertvector(v, bf16x2_t)); }
__device__ __forceinline__ float bf2f(unsigned short u) { return __builtin_bit_cast(float, (unsigned)u << 16); }
__device__ __forceinline__ float lo2f(unsigned u) { return __builtin_bit_cast(float, u << 16); }
__device__ __forceinline__ float hi2f(unsigned u) { return __builtin_bit_cast(float, u & 0xffff0000u); }
__device__ __forceinline__ float siluf(float v) { return v / (1.f + __expf(-v)); }
__device__ __forceinline__ float sigmf(float v) { return 1.f / (1.f + __expf(-v)); }
__device__ __forceinline__ float wave_sum(float v) {
#pragma unroll
    for (int o = 1; o < 64; o <<= 1) v += __shfl_xor(v, o);
    return v;
}

__device__ __forceinline__ void transpose_item(const float* W, int ldw, int nvalid, int K, bf16* WT, LAS float* scr, int kb, int nb, int lane) {
    const int k0 = 64 * kb, n0 = 32 * nb; const int n_l = n0 + (lane & 31);
#pragma unroll 8
    for (int i = 0; i < 32; ++i) { const int kk = 2 * i + (lane >> 5); scr[kk * 33 + (lane & 31)] = n_l < nvalid ? W[(size_t)(k0 + kk) * ldw + n_l] : 0.f; }
    LDS_WAIT(); asm volatile("" ::: "memory");
    const int c = lane & 7;
#pragma unroll
    for (int j = 0; j < 4; ++j) { const int n = (lane >> 3) + 8 * j; const LAS float* s = scr + (8 * c) * 33 + n;
        v4u o; o.x = pk2(s[0 * 33], s[1 * 33]); o.y = pk2(s[2 * 33], s[3 * 33]); o.z = pk2(s[4 * 33], s[5 * 33]); o.w = pk2(s[6 * 33], s[7 * 33]);
        *(GAS v4u*)(WT + (size_t)(n0 + n) * K + k0 + 8 * c) = o; }
    LDS_WAIT(); asm volatile("" ::: "memory");
}
constexpr int KS2 = 2;
__device__ __forceinline__ void p0_prep(Frame& F) {
    LAS float* scr = (LAS float*)(F.lds + RING_OFF + F.wave * 16384);
    LAS float* red = (LAS float*)(F.lds + RING_OFF + 131072);
    for (int it = F.vcu; it < (NMOD / 64) * KS2; it += F.G) {
        const int cg = it >> 1, kh2 = it & 1, n = cg * 64 + F.lane, k0 = kh2 * 1024 + F.wave * 128;
#pragma unroll
        for (int rr = 0; rr < 5; ++rr)
#pragma unroll
            for (int j = 0; j < 2; ++j) { const int k = k0 + F.lane + 64 * j; const float v = rr < 4 ? F.c[rr * DM + k] : F.c_ctx[k]; scr[rr * 128 + F.lane + 64 * j] = siluf(v); }
        LDS_WAIT(); asm volatile("" ::: "memory");
        float a0 = 0.f, a1 = 0.f, a2 = 0.f, a3 = 0.f, a4 = 0.f;
#pragma unroll 16
        for (int k = 0; k < 128; ++k) { const float w = F.w_mod[(size_t)(k0 + k) * NMOD + n];
            a0 += scr[k] * w; a1 += scr[128 + k] * w; a2 += scr[256 + k] * w; a3 += scr[384 + k] * w; a4 += scr[512 + k] * w; }
        LAS float* rp = red + F.wave * 320 + F.lane; rp[0] = a0; rp[64] = a1; rp[128] = a2; rp[192] = a3; rp[256] = a4;
        __syncthreads();
        if (F.tid < 320) { float sacc = 0.f;
#pragma unroll
            for (int ww = 0; ww < 8; ++ww) sacc += red[ww * 320 + F.tid];
            const int rr = F.tid >> 6, nn = cg * 64 + (F.tid & 63);
            F.modp[((size_t)kh2 * 5 + rr) * NMOD + nn] = sacc + (kh2 == 0 ? F.b_mod[nn] : 0.f); }
        __syncthreads();
    }
    const int gw = F.vcu * NWAVES + F.wave, NGW = F.G * NWAVES;
    constexpr int NB_IN = NU / 32, I_IN = (DM / 64) * NB_IN, NB_OUT = DM / 32, I_OUT = (DM / 64) * NB_OUT;
    for (int it = gw; it < I_IN + I_OUT; it += NGW) {
        int r = it;
        if (r < I_IN) { transpose_item(F.w_in, NIN, NIN, DM, F.WinT, scr, r / NB_IN, r % NB_IN, F.lane); continue; } r -= I_IN;
        transpose_item(F.w_out, DM, DM, DM, F.WoutT, scr, r / NB_OUT, r % NB_OUT, F.lane);
    }
}

__device__ __forceinline__ void ln_mod_row2(Frame& F, const float* xa, const float* xb, bf16* oa, bf16* ob, const LAS float* shift, const LAS float* scale) {
    const GAS f32x4* ra = (const GAS f32x4*)xa + F.lane; const GAS f32x4* rb = (const GAS f32x4*)xb + F.lane;
    f32x4 va[8], vb[8]; float sa = 0.f, sb = 0.f;
#pragma unroll
    for (int j = 0; j < 8; ++j) { va[j] = ra[64 * j]; vb[j] = rb[64 * j]; }
#pragma unroll
    for (int j = 0; j < 8; ++j) { sa += (va[j].x + va[j].y) + (va[j].z + va[j].w); sb += (vb[j].x + vb[j].y) + (vb[j].z + vb[j].w); }
    const float ma = wave_sum(sa) * (1.f / DM), mb = wave_sum(sb) * (1.f / DM); float qa = 0.f, qb = 0.f;
#pragma unroll
    for (int j = 0; j < 8; ++j) { va[j] = va[j] - ma; vb[j] = vb[j] - mb; qa += (va[j].x * va[j].x + va[j].y * va[j].y) + (va[j].z * va[j].z + va[j].w * va[j].w); qb += (vb[j].x * vb[j].x + vb[j].y * vb[j].y) + (vb[j].z * vb[j].z + vb[j].w * vb[j].w); }
    const float rsa = 1.f / sqrtf(wave_sum(qa) * (1.f / DM) + LN_EPS), rsb = 1.f / sqrtf(wave_sum(qb) * (1.f / DM) + LN_EPS);
    GAS unsigned long long* o8a = (GAS unsigned long long*)oa + F.lane; GAS unsigned long long* o8b = (GAS unsigned long long*)ob + F.lane;
#pragma unroll
    for (int j = 0; j < 8; ++j) { const int k = 4 * F.lane + 256 * j; const f32x4 sc = *(const LAS f32x4*)(scale + k) + 1.f, sh = *(const LAS f32x4*)(shift + k);
        const f32x4 ha = va[j] * rsa * sc + sh, hb = vb[j] * rsb * sc + sh;
        o8a[64 * j] = (unsigned long long)pk2(ha.x, ha.y) | ((unsigned long long)pk2(ha.z, ha.w) << 32);
        o8b[64 * j] = (unsigned long long)pk2(hb.x, hb.y) | ((unsigned long long)pk2(hb.z, hb.w) << 32); }
}
__device__ __forceinline__ void ln_mod_row(Frame& F, const float* xrow, bf16* orow, const LAS float* shift, const LAS float* scale) {
    const GAS f32x4* xr = (const GAS f32x4*)xrow + F.lane;
    f32x4 v[8]; float s = 0.f;
#pragma unroll
    for (int j = 0; j < 8; ++j) { v[j] = xr[64 * j]; s += (v[j].x + v[j].y) + (v[j].z + v[j].w); }
    const float mean = wave_sum(s) * (1.f / DM); float s2 = 0.f;
#pragma unroll
    for (int j = 0; j < 8; ++j) { v[j] = v[j] - mean; s2 += (v[j].x * v[j].x + v[j].y * v[j].y) + (v[j].z * v[j].z + v[j].w * v[j].w); }
    const float rstd = 1.f / sqrtf(wave_sum(s2) * (1.f / DM) + LN_EPS);
    GAS unsigned long long* o8 = (GAS unsigned long long*)orow + F.lane;
#pragma unroll
    for (int j = 0; j < 8; ++j) { const int k = 4 * F.lane + 256 * j; const f32x4 sc = *(const LAS f32x4*)(scale + k), sh = *(const LAS f32x4*)(shift + k);
        const f32x4 h = v[j] * rstd * (sc + 1.f) + sh;
        o8[64 * j] = (unsigned long long)pk2(h.x, h.y) | ((unsigned long long)pk2(h.z, h.w) << 32); }
}
__device__ __forceinline__ void p1_lnmod(Frame& F) {
    LAS float* md = (LAS float*)(F.lds + RING_OFF);
    for (int e = F.vcu * NT + F.tid; e < BATCH * DM; e += F.G * NT) { const int b = e / DM, n = e % DM;
        F.gate[e] = F.modp[(size_t)b * NMOD + 2 * DM + n] + F.modp[((size_t)5 + b) * NMOD + 2 * DM + n]; }
    for (int blk = F.vcu; blk < 256; blk += F.G) {
        const int b = blk >> 6;
        __syncthreads();
        { float m0v[16], m1v[16];
#pragma unroll
          for (int i = 0; i < 16; ++i) { const int e = F.tid + NT * i; const int row = e < 2 * DM ? b : 4, col = e & (2 * DM - 1); m0v[i] = F.modp[(size_t)row * NMOD + col]; m1v[i] = F.modp[((size_t)5 + row) * NMOD + col]; }
#pragma unroll
          for (int i = 0; i < 16; ++i) md[F.tid + NT * i] = m0v[i] + m1v[i]; }
        __syncthreads();
#pragma unroll 1
        for (int r = 0; r < 8; r += 2) { const int m = blk * 64 + F.wave * 8 + r;
            ln_mod_row2(F, F.x + (size_t)m * DM, F.x + (size_t)(m + 1) * DM, F.XN + (size_t)m * DM, F.XN + (size_t)(m + 1) * DM, md, md + DM); }
        if (F.wave < 4) { const int m = blk * 4 + F.wave; ln_mod_row(F, F.ctx + (size_t)m * DM, F.XN + (size_t)(MX + m) * DM, md + 2 * DM, md + 3 * DM); }
    }
}

__device__ __forceinline__ float rcpf_(float v) { return __builtin_amdgcn_rcpf(v); }
__device__ __forceinline__ float silu_fast(float v) { return v * rcpf_(1.f + __expf(-v)); }
__device__ __forceinline__ void conv_acc8(float (&acc)[8], const v4u u, const f32x4 wa, const f32x4 wb) {
    acc[0] += lo2f(u.x) * wa.x; acc[1] += hi2f(u.x) * wa.y; acc[2] += lo2f(u.y) * wa.z; acc[3] += hi2f(u.y) * wa.w;
    acc[4] += lo2f(u.z) * wb.x; acc[5] += hi2f(u.z) * wb.y; acc[6] += lo2f(u.w) * wb.z; acc[7] += hi2f(u.w) * wb.w;
}
constexpr int NSC = 4;
__device__ __forceinline__ void p3_conv(Frame& F) {
    bf16* QKM = F.XN;
    if (F.G > 2 * NSC && F.vcu < NSC) return;
    const int wk = F.G > 2 * NSC ? F.vcu - NSC : F.vcu, NW = F.G > 2 * NSC ? F.G - NSC : F.G;
    const int gw = wk * NWAVES + F.wave, NGW = NW * NWAVES;
    const int cq = gw & 3, ch = cq * 512 + F.lane * 8;
    f32x4 wa[9], wb[9];
#pragma unroll
    for (int t = 0; t < 9; ++t) { wa[t] = *(const GAS f32x4*)(F.conv_w + t * 2048 + ch); wb[t] = *(const GAS f32x4*)(F.conv_w + t * 2048 + ch + 4); }
    const f32x4 ba = *(const GAS f32x4*)(F.conv_b + ch), bb = *(const GAS f32x4*)(F.conv_b + ch + 4);
    const float sc = ch >= 1024 ? 0.0625f : 1.f;
    constexpr int NLAT = BATCH * 64 * 16, NCTX = BATCH * (CTXL / 4);
    int it0 = gw >> 2, it1 = NLAT + NCTX, its = NGW >> 2;
    if (NW == 252) { const int j = wk - 80; const int lo = wk < 80 ? 8 * wk : 640 + (j < 100 ? 22 * j : 2200 + 21 * (j - 100)); const int len = wk < 80 ? 8 : (j < 100 ? 22 : 21);
        it0 = lo + (F.wave >> 2); it1 = lo + len; its = 2; }
    for (int it = it0; it < it1; it += its) {
        const v4u zero4 = {0u, 0u, 0u, 0u};
        if (it < NLAT) {
            const int b = it >> 10, r = (it >> 4) & 63, c0 = (it & 15) * 4;
            v4u in[3][6];
#pragma unroll
            for (int dr = 0; dr < 3; ++dr)
#pragma unroll
                for (int j = 0; j < 6; ++j) { const int rr = r + dr - 1, cc = c0 + j - 1; const bool ok = rr >= 0 && rr < 64 && cc >= 0 && cc < 64;
                    in[dr][j] = ok ? *(const GAS v4u*)(F.U + (size_t)(b * SEQ + rr * 64 + cc) * NU + C_BQK + ch) : zero4; }
#pragma unroll
            for (int o = 0; o < 4; ++o) {
                float acc[8] = {ba.x, ba.y, ba.z, ba.w, bb.x, bb.y, bb.z, bb.w};
#pragma unroll
                for (int dr = 0; dr < 3; ++dr)
#pragma unroll
                    for (int dc = 0; dc < 3; ++dc) conv_acc8(acc, in[dr][o + dc], wa[dr * 3 + dc], wb[dr * 3 + dc]);
#pragma unroll
                for (int j = 0; j < 8; ++j) acc[j] = silu_fast(acc[j]) * sc;
                v4u ov; ov.x = pk2(acc[0], acc[1]); ov.y = pk2(acc[2], acc[3]); ov.z = pk2(acc[4], acc[5]); ov.w = pk2(acc[6], acc[7]);
                *(GAS v4u*)(QKM + (size_t)(b * SEQ + r * 64 + c0 + o) * DM + ch) = ov;
            }
        } else {
            const int ic = it - NLAT, b = ic >> 6, t0 = (ic & 63) * 4;
            v4u in[6];
#pragma unroll
            for (int j = 0; j < 6; ++j) { const int tt = t0 + j - 1; in[j] = (tt >= 0 && tt < CTXL) ? *(const GAS v4u*)(F.U + (size_t)(MX + b * CTXL + tt) * NU + C_BQK + ch) : zero4; }
#pragma unroll
            for (int o = 0; o < 4; ++o) {
                float acc[8] = {ba.x, ba.y, ba.z, ba.w, bb.x, bb.y, bb.z, bb.w};
#pragma unroll
                for (int dc = 0; dc < 3; ++dc) conv_acc8(acc, in[o + dc], wa[3 + dc], wb[3 + dc]);
#pragma unroll
                for (int j = 0; j < 8; ++j) acc[j] = silu_fast(acc[j]) * sc;
                v4u ov; ov.x = pk2(acc[0], acc[1]); ov.y = pk2(acc[2], acc[3]); ov.z = pk2(acc[4], acc[5]); ov.w = pk2(acc[6], acc[7]);
                *(GAS v4u*)(QKM + (size_t)(MX + b * CTXL + t0 + o) * DM + ch) = ov;
            }
        }
    }
}

__device__ __forceinline__ int scan_row(int b, int dirn, int nb, int i) {
    if (nb < 16) { const int p = nb * 16 + i; const int t = dirn ? (CTXL - 1 - p) : p; return MX + b * CTXL + t; }
    const int p = (nb - 16) * 16 + i; const int t = dirn ? (SEQ - 1 - p) : p; return b * SEQ + t;
}
__device__ __forceinline__ void p4_hgrn2_task(Frame& F, int task) {
    const int vs = task & 3, dirn = (task >> 2) & 1, h = (task >> 3) & 7, b = task >> 6;
    LAS float* Fg = (LAS float*)(F.lds);
    LAS float* Kg = Fg + 2048, *Qg = Kg + 2048;
    LAS float* Vg = Qg + 2048;
    LAS float* LB = Vg + 512;
    LAS float* P = LB + 128;
    const int v = F.tid & 31, kg = F.tid >> 5, k0 = kg * 8;
    const int zcol = (dirn ? C_AFB : C_AFF) + h * HGD;
    __syncthreads();
    if (F.tid < 128) { const int col = h * HGD + F.tid; LB[F.tid] = sigmf(F.hg_lb[(dirn * 2 + 0) * WA + col] - F.hg_lb[(dirn * 2 + 1) * WA + col]); }
    __syncthreads();
    float S[8];
#pragma unroll
    for (int j = 0; j < 8; ++j) S[j] = 0.f;
    bf16* O = dirn ? F.OAB : F.OAF;
#pragma unroll 1
    for (int nb = 0; nb < 16 + 256; ++nb) {
        const bool lat = nb >= 16;
#pragma unroll
        for (int j = 0; j < 4; ++j) { const int e = F.tid + NT * j, i = e >> 7, k = e & 127; const int row = scan_row(b, dirn, nb, i);
            const float z = bf2f(F.U[(size_t)row * NU + zcol + k]); const float lb = LB[k]; const float f = lb + (1.f - lb) * sigmf(z);
            Fg[e] = f; Kg[e] = 1.f - f; Qg[e] = lat ? siluf(bf2f(F.U[(size_t)row * NU + C_AQ + h * HGD + k])) : 0.f; }
        { const int i = F.tid >> 5; const int row = scan_row(b, dirn, nb, i); Vg[F.tid] = bf2f(F.U[(size_t)row * NU + C_AI + h * HGD + vs * 32 + v]); }
        __syncthreads();
#pragma unroll 2
        for (int i = 0; i < 16; ++i) { const float vv = Vg[i * 32 + v]; float a = 0.f;
#pragma unroll
            for (int j = 0; j < 8; ++j) { S[j] = Fg[i * 128 + k0 + j] * S[j] + Kg[i * 128 + k0 + j] * vv; a += S[j] * Qg[i * 128 + k0 + j]; }
            P[(kg * 16 + i) * 32 + v] = a; }
        __syncthreads();
        if (lat) { const int i = F.tid >> 5; float o = 0.f;
#pragma unroll
            for (int g = 0; g < 16; ++g) o += P[(g * 16 + i) * 32 + v];
            const int row = scan_row(b, dirn, nb, i);
            O[(size_t)row * WA + h * HGD + vs * 32 + v] = (bf16)f2bf(o); }
    }
}
__device__ __forceinline__ void p4_mlstm_task(Frame& F, int task) {
    const int vs = task & 7, dirn = (task >> 3) & 1, h = (task >> 4) & 3, b = task >> 6;
    const bf16* QKM = F.XN;
    LAS float* Kb = (LAS float*)(F.lds);
    LAS float* Qb = Kb + 4096;
    LAS float* Vb = Qb + 4096;
    LAS float* LI = Vb + 512, *LF = LI + 16, *EM = LF + 16;
    LAS float* PD = EM + 16;
    LAS float* P = PD + 256;
    const int v = F.tid & 31, kg = F.tid >> 5, k0 = kg * 16;
    float C[16], nn[16]; float m = 0.f;
#pragma unroll
    for (int j = 0; j < 16; ++j) { C[j] = 0.f; nn[j] = 0.f; }
    bf16* O = dirn ? F.HBB : F.HBF;
    const float gbi = F.ml_gate_b[dirn * 4 + h], gbf = F.ml_gate_b[(2 + dirn) * 4 + h];
#pragma unroll 1
    for (int nb = 0; nb < 16 + 256; ++nb) {
        const bool lat = nb >= 16;
        __syncthreads();
#pragma unroll
        for (int j = 0; j < 8; ++j) { const int e = F.tid + NT * j, i = e >> 8, k = e & 255; const int row = scan_row(b, dirn, nb, i);
            Kb[e] = bf2f(QKM[(size_t)row * DM + 1024 + h * MLD + k]); Qb[e] = lat ? bf2f(QKM[(size_t)row * DM + h * MLD + k]) : 0.f; }
        { const int i = F.tid >> 5; const int row = scan_row(b, dirn, nb, i); Vb[F.tid] = bf2f(F.U[(size_t)row * NU + C_BV + h * MLD + vs * 32 + v]); }
        if (F.tid < 16) { const int row = scan_row(b, dirn, nb, F.tid);
            const float gi = bf2f(F.U[(size_t)row * NU + C_BG + dirn * 4 + h]) + gbi, gf = bf2f(F.U[(size_t)row * NU + C_BG + (2 + dirn) * 4 + h]) + gbf;
            LI[F.tid] = gi; LF[F.tid] = gf > 0.f ? -log1pf(__expf(-gf)) : gf - log1pf(__expf(gf)); }
        __syncthreads();
#pragma unroll 2
        for (int i = 0; i < 16; ++i) {
            const float lf = LF[i], li = LI[i]; const float mn = fmaxf(lf + m, li); const float fd = __expf(lf + m - mn), iw = __expf(li - mn); m = mn;
            if (F.tid == 0) EM[i] = __expf(-m);
            const float vv = iw * Vb[i * 32 + v]; float a = 0.f, d = 0.f;
#pragma unroll
            for (int j = 0; j < 16; ++j) { const float kk = Kb[i * 256 + k0 + j], qq = Qb[i * 256 + k0 + j];
                C[j] = fd * C[j] + vv * kk; nn[j] = fd * nn[j] + iw * kk; a += C[j] * qq; d += nn[j] * qq; }
            P[(kg * 16 + i) * 32 + v] = a; if (v == 0) PD[kg * 16 + i] = d; }
        __syncthreads();
        if (lat) { const int i = F.tid >> 5; float num = 0.f, den = 0.f;
#pragma unroll
            for (int g = 0; g < 16; ++g) { num += P[(g * 16 + i) * 32 + v]; den += PD[g * 16 + i]; }
            const int row = scan_row(b, dirn, nb, i);
            O[(size_t)row * WB + h * MLD + vs * 32 + v] = (bf16)f2bf(num / fmaxf(fabsf(den), EM[i])); }
    }
}
__device__ __forceinline__ void p4_scan_naive(Frame& F) {
    for (int task = F.vcu; task < 512; task += F.G) { if (task < 256) p4_hgrn2_task(F, task); else p4_mlstm_task(F, task - 256); }
}

constexpr int NCHUNK = MALL / 64;
__device__ __forceinline__ void gate_fk(float z, float lb, float& f, float& kk) {
    const float e = __expf(-fabsf(z)); const float rb = 1.f / (1.f + e), rs = e * rb;
    const float sg = z >= 0.f ? rb : rs, sn = z >= 0.f ? rs : rb;
    f = lb + (1.f - lb) * sg; kk = (1.f - lb) * sn;
}
template <int DIR>
__device__ __forceinline__ float hg_walk(LAS unsigned char* L, int cl, float lb, float olb, unsigned (&qb)[32]) {
    constexpr int TQ = 0, TZF = 32768, TZB = 65536, TQF = 98304;
    LAS unsigned short* zt = (LAS unsigned short*)(L + (DIR ? TZB : TZF)) + cl;
    const LAS unsigned short* qtile = (const LAS unsigned short*)(L + TQ) + cl;
    LAS unsigned short* qf = (LAS unsigned short*)(L + TQF) + cl;
    float P = 1.f;
#pragma unroll
    for (int blk = 0; blk < 4; ++blk) {
        unsigned short zr[16], qr[16];
#pragma unroll
        for (int j = 0; j < 16; ++j) { const int pp = blk * 16 + j, p = DIR ? 63 - pp : pp; zr[j] = zt[p * 256]; qr[j] = qtile[p * 256]; }
#pragma unroll
        for (int j = 0; j < 16; ++j) { const int pp = blk * 16 + j, p = DIR ? 63 - pp : pp;
            const float z = bf2f(zr[j]), q = bf2f(qr[j]);
            const float e = __expf(-fabsf(z)); const float rbig = rcpf_(1.f + e), rsm = e * rbig;
            const float sg = z >= 0.f ? rbig : rsm, sn = z >= 0.f ? rsm : rbig;
            const float f = lb + olb * sg, kk = olb * sn; P *= f;
            const float qt = q * P, kt = kk * rcpf_(P);
            zt[p * 256] = (unsigned short)(pkbf(kt, 0.f) & 0xffffu);
            const unsigned qh = pkbf(qt, 0.f) & 0xffffu;
            if (DIR) { if (pp & 1) qb[pp >> 1] |= qh << 16; else qb[pp >> 1] = qh; } else qf[p * 256] = (unsigned short)qh; }
    }
    return P;
}
template <bool DUMMY>
__device__ __forceinline__ void p3_hg_prep(Frame& F) {
    bf16* dq = F.OAF; bf16* dkf = F.OAB; bf16* dkb = F.HBF;
    LAS unsigned char* L = F.lds;
    constexpr int TQ = 0, TZF = 32768, TZB = 65536, TQF = 98304;
    const int tid = F.tid, dirn = F.wave >> 2, cl = tid & 255;
    if (F.G > 2 * NSC && F.vcu < NSC) return;
    const int wk = F.G > 2 * NSC ? F.vcu - NSC : F.vcu, NW = F.G > 2 * NSC ? F.G - NSC : F.G;
    v4u pre[3][4];
    auto issue = [&](int it) { const int cid = it >> 2, cb = (it & 3) * 256; const size_t row0 = (size_t)cid * 64;
#pragma unroll
        for (int i = 0; i < 4; ++i) { const int piece = tid + NT * i, row = piece >> 5, c16 = piece & 31; const bf16* ur = F.U + (row0 + row) * NU + cb + c16 * 8;
            pre[0][i] = *(const GAS v4u*)(ur + C_AQ); pre[1][i] = *(const GAS v4u*)(ur + C_AFF); pre[2][i] = *(const GAS v4u*)(ur + C_AFB); } };
    int it = wk;
    if (it < NCHUNK * 4) issue(it);
    for (; it < NCHUNK * 4; it += NW) {
        const int cid = it >> 2, cb = (it & 3) * 256; const size_t row0 = (size_t)cid * 64;
        __syncthreads();
#pragma unroll
        for (int i = 0; i < 4; ++i) { const int piece = tid + NT * i; *(LAS v4u*)(L + TQ + piece * 16) = pre[0][i]; *(LAS v4u*)(L + TZF + piece * 16) = pre[1][i]; *(LAS v4u*)(L + TZB + piece * 16) = pre[2][i]; }
        __syncthreads();
        if (it + NW < NCHUNK * 4) issue(it + NW);
        const int c = cb + cl;
        const float lb = sigmf(F.hg_lb[(dirn * 2) * WA + c] - F.hg_lb[(dirn * 2 + 1) * WA + c]), olb = 1.f - lb;
        unsigned qb[32]; float P;
        if (dirn) P = hg_walk<1>(L, cl, lb, olb, qb); else P = hg_walk<0>(L, cl, lb, olb, qb);
        F.PE[(size_t)(dirn * NCHUNK + cid) * WA + c] = P;
        __syncthreads();
        if (dirn) {
            LAS unsigned short* qw = (LAS unsigned short*)(L + TQ) + cl;
#pragma unroll
            for (int pp = 0; pp < 64; ++pp) qw[(63 - pp) * 256] = (unsigned short)((pp & 1) ? (qb[pp >> 1] >> 16) : (qb[pp >> 1] & 0xffffu));
        }
        __syncthreads();
#pragma unroll
        for (int i = 0; i < 4; ++i) { const int piece = tid + NT * i, row = piece >> 5, c16 = piece & 31; const size_t r = row0 + row; bf16* ur = F.U + r * NU + cb + c16 * 8;
            const v4u vq = *(const LAS v4u*)(L + TQ + piece * 16), vf = *(const LAS v4u*)(L + TZF + piece * 16), vb = *(const LAS v4u*)(L + TZB + piece * 16), vqf = *(const LAS v4u*)(L + TQF + piece * 16);
            *(GAS v4u*)(F.QTF + r * WA + cb + c16 * 8) = vqf;
            if (DUMMY) { if (r < MX) { *(GAS v4u*)(dq + r * WA + cb + c16 * 8) = vq; *(GAS v4u*)(dkf + r * WA + cb + c16 * 8) = vf; *(GAS v4u*)(dkb + r * WA + cb + c16 * 8) = vb; } }
            else { *(GAS v4u*)(ur + C_AQ) = vq; *(GAS v4u*)(ur + C_AFF) = vf; *(GAS v4u*)(ur + C_AFB) = vb; } }
    }
    __syncthreads();
}
template <int CTRL, int RM> __device__ __forceinline__ float dpp_f(float idv, float x) { return __builtin_bit_cast(float, __builtin_amdgcn_update_dpp(__builtin_bit_cast(int, idv), __builtin_bit_cast(int, x), CTRL, RM, 0xf, false)); }
__device__ __forceinline__ float wave_scan_add(float x) {
    x += dpp_f<0x111, 0xf>(0.f, x); x += dpp_f<0x112, 0xf>(0.f, x); x += dpp_f<0x114, 0xf>(0.f, x); x += dpp_f<0x118, 0xf>(0.f, x);
    x += dpp_f<0x142, 0xa>(0.f, x); x += dpp_f<0x143, 0xc>(0.f, x); return x; }
__device__ __forceinline__ float wave_scan_max(float x) { const float ni = -__builtin_inff();
    x = fmaxf(x, dpp_f<0x111, 0xf>(ni, x)); x = fmaxf(x, dpp_f<0x112, 0xf>(ni, x)); x = fmaxf(x, dpp_f<0x114, 0xf>(ni, x)); x = fmaxf(x, dpp_f<0x118, 0xf>(ni, x));
    x = fmaxf(x, dpp_f<0x142, 0xa>(ni, x)); x = fmaxf(x, dpp_f<0x143, 0xc>(ni, x)); return x; }
__device__ __forceinline__ void p3_ml_scalars(Frame& F) {
    const int gw = F.vcu * NWAVES + F.wave;
    if (gw >= 32) return;
    const int dirn = gw & 1, h = (gw >> 1) & 3, b = gw >> 3;
    const float gbi = F.ml_gate_b[dirn * 4 + h], gbf = F.ml_gate_b[(2 + dirn) * 4 + h];
    float m0 = 0.f;
    float* mls = F.MLS + (size_t)(dirn * 4 + h) * MALL * 8;
    auto row_of = [&](int n) -> int { int row0; if (n < 4) { const int cc = dirn ? 3 - n : n; row0 = MX + b * CTXL + cc * 64; } else { const int lc = dirn ? 67 - n : n - 4; row0 = b * SEQ + lc * 64; }
        return row0 + (dirn ? 63 - F.lane : F.lane); };
    unsigned short gi_r[8], gf_r[8];
#pragma unroll
    for (int j = 0; j < 8; ++j) { const int row = row_of(j); gi_r[j] = F.U[(size_t)row * NU + C_BG + dirn * 4 + h]; gf_r[j] = F.U[(size_t)row * NU + C_BG + (2 + dirn) * 4 + h]; }
#pragma unroll 1
    for (int nb = 0; nb < 72; nb += 8) {
#pragma unroll
        for (int j = 0; j < 8; ++j) {
            const int n = nb + j;
            if (n < 68) {
                const int row = row_of(n);
                const float gi = bf2f(gi_r[j]) + gbi, gf = bf2f(gf_r[j]) + gbf;
                if (n + 8 < 68) { const int r2 = row_of(n + 8); gi_r[j] = F.U[(size_t)r2 * NU + C_BG + dirn * 4 + h]; gf_r[j] = F.U[(size_t)r2 * NU + C_BG + (2 + dirn) * 4 + h]; }
                const float lf = fminf(gf, 0.f) - __logf(1.f + __expf(-fabsf(gf)));
                const float cs = wave_scan_add(lf);
                const float a = gi - cs; const float cm = wave_scan_max(a);
                const float mx = fmaxf(m0, cm), m63 = __shfl(mx, 63), cs63 = __shfl(cs, 63);
                f32x4 o0; o0.x = a; o0.y = mx; o0.z = __expf(m0 - mx); o0.w = __expf(a - m63);
                f32x4 o1; o1.x = __expf(-(cs + mx)); o1.y = 0.f; o1.z = __expf(m0 - m63); o1.w = 0.f;
                *(f32x4*)(mls + (size_t)row * 8) = o0; *(f32x4*)(mls + (size_t)row * 8 + 4) = o1;
                const int row0 = row - (dirn ? 63 - F.lane : F.lane);
                if (F.lane == 0) F.DEC[(dirn * 4 + h) * NCHUNK + (row0 >> 6)] = __expf(m0 - m63);
                m0 = cs63 + m63;
            }
        }
    }
}

typedef short s16x4 __attribute__((ext_vector_type(4)));
typedef float f32x16 __attribute__((ext_vector_type(16)));
#define MFMA32(a, b, c) __builtin_amdgcn_mfma_f32_32x32x16_bf16((a), (b), (c), 0, 0, 0)
__device__ __forceinline__ bf16x8 pk8(float a0, float a1, float a2, float a3, float a4, float a5, float a6, float a7) {
    const v4u u = {pkbf(a0, a1), pkbf(a2, a3), pkbf(a4, a5), pkbf(a6, a7)}; return __builtin_bit_cast(bf16x8, u); }
__device__ __forceinline__ bf16x8 cat4(s16x4 lo, s16x4 hi) { return __builtin_shufflevector(lo, hi, 0, 1, 2, 3, 4, 5, 6, 7); }
__device__ __forceinline__ s16x4 lds_tr(LAS unsigned char* p) { return __builtin_amdgcn_ds_read_tr16_b64_v4i16((LAS s16x4*)p); }
__device__ __forceinline__ unsigned img_off_a(unsigned row, unsigned ch) { return 2048u * (row >> 3) + 512u * (ch >> 2) + 64u * (row & 7) + 16u * ((ch & 3) ^ ((row >> 2) & 3)); }
__device__ __forceinline__ unsigned img_addr(unsigned row, unsigned ch, unsigned ncb) { return ((row >> 5) * ncb + (ch >> 4)) * 8192u + img_off_a(row & 31, ch & 15); }
__device__ __forceinline__ unsigned v_addr(unsigned row, unsigned ch) { const unsigned r = row & 31; return (row >> 5) * 4096u + 1024u * (r >> 3) + 512u * (ch >> 2) + 64u * (r & 7) + 16u * ((ch & 3) ^ ((r >> 2) & 3)); }

constexpr int SL_QT = 0, SL_KT = 32768, SL_V = 65536, SL_VW = 73728, SL_SF = 81920, SL_XCH = 114688, SL_SC = 131072, SL_W = 144384;
constexpr int SC_PAR = 448, SC_DQW = 896, SC_N0 = 1024, SC_NP = 1280;


__device__ __forceinline__ void p3b_ml_scores(Frame& F) {
    LAS unsigned char* L = F.lds;
    constexpr int BQ = 0, BK = 32768, BX = 65536, BS = 98304;
    LAS float* SCA = (LAS float*)(L + BS);
    const int tid = F.tid, lane = F.lane, w = F.wave, ts = w & 1, tp = (w >> 1) & 1, kh = w >> 2;
    const unsigned hh = lane >> 5, x4 = (lane >> 2) & 3;
    const unsigned LB0 = 2048u * ((lane >> 3) & 3) + 64u * (lane & 7);
    unsigned LBx[2];
#pragma unroll
    for (int e = 0; e < 2; ++e) LBx[e] = LB0 + 16u * ((2u * e + hh) ^ x4) + kh * 8192u;
    v4u pq[4], pk[4]; f32x2_t psc;
    auto issue = [&](int it) { const int lc = it & 63, h = (it >> 6) & 3, b = it >> 8; const size_t row0 = (size_t)b * SEQ + lc * 64;
        int tv = F.tid; asm volatile("" : "+v"(tv));
#pragma unroll
        for (int i = 0; i < 4; ++i) { const int u = ((tv >> 6) + 8 * i) * 8 + ((tv & 63) >> 3), row = 2 * (u >> 3) + ((tv >> 2) & 1), ch = 4 * (u & 7) + (tv & 3);
            pq[i] = *(const GAS v4u*)(F.XN + (row0 + row) * DM + h * MLD + ch * 8); pk[i] = *(const GAS v4u*)(F.XN + (row0 + row) * DM + WB + h * MLD + ch * 8); }
        if (tv < 128) psc = *(const GAS f32x2_t*)(F.MLS + ((size_t)((tv >> 6) * 4 + h) * MALL + row0 + (tv & 63)) * 8); };
    int it = F.vcu;
    if (it < 1024) issue(it);
    for (; it < 1024; it += F.G) {
        const int lc = it & 63, h = (it >> 6) & 3, b = it >> 8; const size_t row0 = (size_t)b * SEQ + lc * 64;
        __syncthreads();
        { int tv = F.tid; asm volatile("" : "+v"(tv));
#pragma unroll
          for (int i = 0; i < 4; ++i) { const int u = ((tv >> 6) + 8 * i) * 8 + ((tv & 63) >> 3), row = 2 * (u >> 3) + ((tv >> 2) & 1), ch = 4 * (u & 7) + (tv & 3); const unsigned a = img_addr(row, ch, 2); *(LAS v4u*)(L + BQ + a) = pq[i]; *(LAS v4u*)(L + BK + a) = pk[i]; }
          if (tv < 128) { SCA[(tv >> 6) * 128 + (tv & 63)] = psc.x; SCA[(tv >> 6) * 128 + 64 + (tv & 63)] = psc.y; } }
        __syncthreads();
        if (it + F.G < 1024) issue(it + F.G);
        f32x16 c;
#pragma unroll
        for (int r = 0; r < 16; ++r) c[r] = 0.f;
#pragma unroll
        for (int s = 0; s < 8; ++s) {
            const bf16x8 a = *(const LAS bf16x8*)(L + BK + ts * 16384 + 512 * (s >> 1) + LBx[s & 1]);
            const bf16x8 bq = *(const LAS bf16x8*)(L + BQ + tp * 16384 + 512 * (s >> 1) + LBx[s & 1]);
            c = MFMA32(a, bq, c);
        }
#pragma unroll
        for (int r = 0; r < 16; ++r) *(LAS float*)(L + BX + (((kh * 4 + ts * 2 + tp) * 16 + r) * 64 + lane) * 4) = c[r];
        __syncthreads();
#pragma unroll
        for (int r = 0; r < 16; ++r) c[r] += *(const LAS float*)(L + BX + ((((1 - kh) * 4 + ts * 2 + tp) * 16 + r) * 64 + lane) * 4);
        const int dirn = kh;
        const bool need = dirn ? (ts >= tp) : (ts <= tp);
        const float mxp = SCA[dirn * 128 + 64 + 32 * tp + (lane & 31)];
        int dl = (lane & 31) - 4 * (int)hh; if (dirn) dl = -dl; asm volatile("" : "+v"(dl));
        const int sg1 = dirn ? -1 : 1; const bool diag = ts == tp;
        float rs = 0.f;
        bf16* wout = F.MLW + ((size_t)((dirn * 4 + h) * 256 + (int)(row0 >> 6)) * 4096) + (32 * tp + (lane & 31)) * 64 + 32 * ts + 4 * hh;
#pragma unroll
        for (int g = 0; g < 4; ++g) {
            const f32x4 av = *(const LAS f32x4*)(SCA + dirn * 128 + 32 * ts + 8 * g + 4 * hh);
            float wv[4];
#pragma unroll
            for (int j = 0; j < 4; ++j) { float v = need ? c[4 * g + j] * __expf(av[j] - mxp) : 0.f;
                if (diag) v = (dl - sg1 * (j + 8 * g) >= 0) ? v : 0.f;
                wv[j] = v; rs += v; }
            *(GAS unsigned long long*)(wout + 8 * g) = (unsigned long long)pkbf(wv[0], wv[1]) | ((unsigned long long)pkbf(wv[2], wv[3]) << 32);
        }
        rs += __shfl_xor(rs, 32);
        if (lane < 32) SCA[256 + (dirn * 2 + ts) * 64 + 32 * tp + lane] = rs;
        __syncthreads();
        if (tid < 128) { const int d = tid >> 6, p = tid & 63; F.MLS[((size_t)(d * 4 + h) * MALL + row0 + p) * 8 + 5] = SCA[256 + (d * 2) * 64 + p] + SCA[256 + (d * 2 + 1) * 64 + p]; }
    }
    __syncthreads();
}

template <bool ML, int SKIP = 0>
__device__ __forceinline__ void scan_task(Frame& F, int task) {
    constexpr int NKT = ML ? 8 : 4, NCB = NKT / 4, NKH = NKT / 2, NOWN = NKT / 4, NPQ = ML ? 4 : 2, DKK = 32 * NKT;
    int vs, dirn, h, b;
    if (ML) { vs = task & 3; dirn = (task >> 2) & 1; h = (task >> 3) & 3; b = task >> 5; } else { vs = task & 1; dirn = (task >> 1) & 1; h = (task >> 2) & 7; b = task >> 5; }
    const int lane = F.lane, w = F.wave, tid = F.tid; const int tp = (w >> 2) & 1, tj = (w >> 1) & 1, kh = w & 1;
    const unsigned hh = lane >> 5, q4 = (lane & 15) >> 2, p4 = lane & 3, blk = (lane >> 4) & 1, x4 = (lane >> 2) & 3;
    LAS unsigned char* L = F.lds;
    LAS float* SC = (LAS float*)(L + SL_SC);
    const unsigned LB0 = 2048u * ((lane >> 3) & 3) + 64u * (lane & 7);
    const unsigned khoff = ML ? kh * 8192u : kh * 1024u;
    unsigned LBx[2], LK[2][2], TRK[2], VK[2], VN[2], WL[2];
#pragma unroll
    for (int e = 0; e < 2; ++e) { LBx[e] = LB0 + 16u * ((2u * e + hh) ^ x4) + khoff; WL[e] = 1024u * ((lane >> 3) & 3) + 64u * (lane & 7) + 16u * ((2u * e + hh) ^ x4);
#pragma unroll
        for (int t = 0; t < 2; ++t) LK[e][t] = LB0 + 16u * ((2u * e + t) ^ x4) + 8u * hh + khoff; }
#pragma unroll
    for (int t = 0; t < 2; ++t) {
        TRK[t] = 2048u * hh + 64u * q4 + 8u * (p4 & 1) + 16u * ((2u * blk + (p4 >> 1)) ^ (2u * hh + t));
        VK[t] = 64u * (4u * hh + q4) + 8u * (p4 & 1) + 16u * ((2u * blk + (p4 >> 1)) ^ (2u * t + hh)) + 512u * tj;
        VN[t] = 1024u * hh + 64u * q4 + 8u * (p4 & 1) + 512u * tj + 16u * ((2u * blk + (p4 >> 1)) ^ (2u * hh + t)); }
    unsigned tkoff[NOWN];
#pragma unroll
    for (int i = 0; i < NOWN; ++i) { const unsigned tk = kh * NKH + tp * NOWN + i; tkoff[i] = (tk >> 2) * 8192u + 512u * (tk & 3); }
    const bf16 *gq, *gk, *gv; int sq, sk; bf16* go;
    if (ML) { gq = F.XN + h * MLD; gk = F.XN + WB + h * MLD; sq = DM; sk = DM; gv = F.U + C_BV + h * MLD + vs * 64; go = (dirn ? F.HBB : F.HBF) + h * MLD + vs * 64; }
    else { if (dirn) { gq = F.U + C_AQ + h * HGD; sq = NU; gk = F.U + C_AFB + h * HGD; } else { gq = F.QTF + h * HGD; sq = WA; gk = F.U + C_AFF + h * HGD; }
        sk = NU; gv = F.U + C_AI + h * HGD + vs * 64; go = (dirn ? F.OAB : F.OAF) + h * HGD + vs * 64; }
    const float* mls = F.MLS + (size_t)(dirn * 4 + h) * MALL * 8;
    const float* pev = F.PE + (size_t)dirn * NCHUNK * WA + h * HGD;
    f32x16 S[NOWN];
#pragma unroll
    for (int i = 0; i < NOWN; ++i)
#pragma unroll
        for (int r = 0; r < 16; ++r) S[i][r] = 0.f;
    v4u pq[NPQ], pk[NPQ], pv, pw; f32x4 ps0, ps1; float pws;
    const bf16* gw_ = F.MLW + (size_t)(dirn * 4 + h) * 256 * 4096;
    auto row0_of = [&](int n) -> int { if (n < 4) { const int cc = dirn ? 3 - n : n; return MX + b * CTXL + cc * 64; } const int lc = dirn ? 67 - n : n - 4; return b * SEQ + lc * 64; };
    int offq[NPQ], offk[NPQ]; unsigned aimg[NPQ];
#pragma unroll
    for (int i = 0; i < NPQ; ++i) { const int u = (w + 8 * i) * 8 + (lane >> 3), NB = NCB * 4, row = 2 * (u / NB) + ((lane >> 2) & 1), ch = 4 * (u % NB) + (lane & 3);
        offq[i] = row * sq + ch * 8; offk[i] = row * sk + ch * 8; aimg[i] = img_addr(row, ch, NCB); }
    const int vu = w * 8 + (lane >> 3), vrow = 2 * (vu >> 1) + ((lane >> 2) & 1), vch = 4 * (vu & 1) + (lane & 3);
    const int offv = vrow * NU + vch * 8, offw = vrow * 64 + vch * 8; const unsigned va = v_addr(vrow, vch);
    auto issue_loads = [&](int n) {
        const int row0 = row0_of(n);
        const bf16* bq_ = gq + (size_t)row0 * sq; const bf16* bk_ = gk + (size_t)row0 * sk;
#pragma unroll
        for (int i = 0; i < NPQ; ++i) { pq[i] = *(const GAS v4u*)(bq_ + offq[i]); pk[i] = *(const GAS v4u*)(bk_ + offk[i]); }
        pv = *(const GAS v4u*)(gv + (size_t)row0 * NU + offv);
        if (ML) { pws = mls[(size_t)(row0 + vrow) * 8 + 3];
            if (n >= 4) pw = *(const GAS v4u*)(gw_ + (size_t)(row0 >> 6) * 4096 + offw);
            if (tid < 64) { ps0 = *(const GAS f32x4*)(mls + (size_t)(row0 + tid) * 8); ps1 = *(const GAS f32x4*)(mls + (size_t)(row0 + tid) * 8 + 4); } }
        else { if (tid < 32) ps0 = *(const GAS f32x4*)(pev + (size_t)(row0 >> 6) * WA + tid * 4); }
    };
    unsigned tch0 = 0u, tch1 = 0u, tdummy = 0u;
    auto touch = [&](int n) {
        const int row0 = row0_of(n);
        if (ML) { const int ln = tid & 255; const bf16* bp = (tid < 256 ? gq + (size_t)row0 * sq : gk + (size_t)row0 * sk) + (size_t)(ln >> 2) * DM + (ln & 3) * 64;
            tch0 = *(const GAS unsigned*)bp;
            if (tid < 64) tch1 = *(const GAS unsigned*)(gv + (size_t)(row0 + tid) * NU);
            else if (tid < 128 && n >= 4) tch1 = *(const GAS unsigned*)(gw_ + (size_t)(row0 >> 6) * 4096 + (tid - 64) * 64); }
        else { if (tid < 256) { const int ln = tid & 127; tch0 = *(const GAS unsigned*)((tid < 128 ? gq + (size_t)(row0 + (ln >> 1)) * sq : gk + (size_t)(row0 + (ln >> 1)) * sk) + (ln & 1) * 64); }
            else if (tid < 320) tch0 = *(const GAS unsigned*)(gv + (size_t)(row0 + tid - 256) * NU); }
    };
    auto store_images = [&](int n) {
#pragma unroll
        for (int i = 0; i < NPQ; ++i) { *(LAS v4u*)(L + SL_QT + aimg[i]) = pq[i]; *(LAS v4u*)(L + SL_KT + aimg[i]) = pk[i]; }
        *(LAS v4u*)(L + SL_V + va) = pv;
        if (!ML && tid < 32) *(LAS f32x4*)(SC + (n & 1) * SC_PAR + tid * 4) = ps0;
        if (ML) { v4u o; o.x = pkbf(lo2f(pv.x) * pws, hi2f(pv.x) * pws); o.y = pkbf(lo2f(pv.y) * pws, hi2f(pv.y) * pws); o.z = pkbf(lo2f(pv.z) * pws, hi2f(pv.z) * pws); o.w = pkbf(lo2f(pv.w) * pws, hi2f(pv.w) * pws);
            *(LAS v4u*)(L + SL_VW + va) = o;
            if (n >= 4) *(LAS v4u*)(L + SL_W + va) = pw;
            if (tid < 64) { LAS float* sp = SC + (n & 1) * SC_PAR + tid; sp[0] = ps0.x; sp[64] = ps0.y; sp[128] = ps0.z; sp[192] = ps0.w; sp[256] = ps1.x; sp[320] = ps1.y; sp[384] = ps1.z; SC[896 + tid] = ps1.w; } }
    };
    __syncthreads();
    issue_loads(0);
    for (int e = tid; e < 32768 / 16; e += NT) *(LAS v4u*)(L + SL_SF + e * 16) = (v4u){0u, 0u, 0u, 0u};
    store_images(0);
    __syncthreads();
#pragma unroll 1
    for (int n = 0; n < 68; ++n) {
        const bool lat = n >= 4; const int row0 = row0_of(n); const int cid = row0 >> 6;
        if (n + 1 < 68 && !(SKIP & 16)) issue_loads(n + 1);
        LAS float* SP = SC + (n & 1) * SC_PAR;
        float dec = 1.f; f32x4 pe[NOWN][4];
        if (ML) dec = SP[384];
        else {
#pragma unroll
            for (int i = 0; i < NOWN; ++i)
#pragma unroll
                for (int g = 0; g < 4; ++g) pe[i][g] = *(const LAS f32x4*)(SP + 32 * (kh * NKH + tp * NOWN + i) + 8 * g + 4 * hh);
        }
        f32x16 o;
        if (lat && !(SKIP & 4)) {
            f32x16 acc_o, acc_i;
#pragma unroll
            for (int r = 0; r < 16; ++r) { acc_o[r] = 0.f; acc_i[r] = 0.f; }
            if (ML) {
                if (kh == 0) {
#pragma unroll
                    for (int ts = 0; ts < 2; ++ts) {
                        const bool need = dirn ? (ts >= tp) : (ts <= tp);
                        if (need) {
                            const bf16x8 a0 = *(const LAS bf16x8*)(L + SL_W + tp * 4096 + 512 * ts + WL[0]), a1 = *(const LAS bf16x8*)(L + SL_W + tp * 4096 + 512 * ts + WL[1]);
                            const s16x4 lo0 = lds_tr(L + SL_V + ts * 4096 + VN[0]), hi0 = lds_tr(L + SL_V + ts * 4096 + 256 + VN[1]);
                            const s16x4 lo1 = lds_tr(L + SL_V + ts * 4096 + 2048 + VN[0]), hi1 = lds_tr(L + SL_V + ts * 4096 + 2048 + 256 + VN[1]);
                            acc_o = MFMA32(a0, cat4(lo0, hi0), acc_o);
                            acc_o = MFMA32(a1, cat4(lo1, hi1), acc_o);
                        }
                    }
                }
            } else
#pragma unroll
            for (int ts = 0; ts < 2; ++ts) {
                const bool need = dirn ? (ts >= tp) : (ts <= tp);
                if (need) {
                    f32x16 c;
#pragma unroll
                    for (int r = 0; r < 16; ++r) c[r] = 0.f;
                    {
                        bf16x8 a_c = *(const LAS bf16x8*)(L + SL_KT + ts * NCB * 8192 + LBx[0]), b_c = *(const LAS bf16x8*)(L + SL_QT + tp * NCB * 8192 + LBx[0]), a_n = a_c, b_n = b_c;
#pragma unroll
                        for (int s = 0; s < NKT; ++s) {
                            if (s + 1 < NKT) { a_n = *(const LAS bf16x8*)(L + SL_KT + ts * NCB * 8192 + 512 * ((s + 1) >> 1) + LBx[(s + 1) & 1]); b_n = *(const LAS bf16x8*)(L + SL_QT + tp * NCB * 8192 + 512 * ((s + 1) >> 1) + LBx[(s + 1) & 1]); }
                            c = MFMA32(a_c, b_c, c);
                            a_c = a_n; b_c = b_n;
                        }
                    }
                    const s16x4 vlo0 = lds_tr(L + SL_V + ts * 4096 + VK[0]), vhi0 = lds_tr(L + SL_V + ts * 4096 + 1024 + VK[1]);
                    const s16x4 vlo1 = lds_tr(L + SL_V + ts * 4096 + 2048 + VK[0]), vhi1 = lds_tr(L + SL_V + ts * 4096 + 3072 + VK[1]);
                    int dl = (lane & 31) - 4 * (int)hh; if (dirn) dl = -dl; asm volatile("" : "+v"(dl));
                    const int sg1 = dirn ? -1 : 1; const bool diag = ts == tp;
#pragma unroll
                    for (int r = 0; r < 16; ++r) { const int ro = (r & 3) + 8 * (r >> 2);
                        float wv = c[r];
                        if (diag) wv = (dl - sg1 * ro >= 0) ? wv : 0.f;
                        c[r] = wv; }
                    acc_o = MFMA32(pk8(c[0], c[1], c[2], c[3], c[4], c[5], c[6], c[7]), cat4(vlo0, vhi0), acc_o);
                    acc_o = MFMA32(pk8(c[8], c[9], c[10], c[11], c[12], c[13], c[14], c[15]), cat4(vlo1, vhi1), acc_o);
                }
            }
            {
#define LD_INTER(i_, LO_, HI_, SF_) do { LO_ = *(const LAS s16x4*)(L + SL_QT + tp * NCB * 8192 + 512 * ((i_) >> 1) + LK[(i_) & 1][0]); HI_ = *(const LAS s16x4*)(L + SL_QT + tp * NCB * 8192 + 512 * ((i_) >> 1) + LK[(i_) & 1][1]); \
                SF_ = *(const LAS bf16x8*)(L + SL_SF + ((((kh * NKH + ((i_) >> 1)) * 2 + tj) * 2 + ((i_) & 1)) * 1024) + lane * 16); } while (0)
                s16x4 lo_c, hi_c, lo_n, hi_n; bf16x8 sf_c, sf_n;
                LD_INTER(0, lo_c, hi_c, sf_c); lo_n = lo_c; hi_n = hi_c; sf_n = sf_c;
#pragma unroll
                for (int i = 0; i < 2 * NKH; ++i) {
                    if (i + 1 < 2 * NKH) LD_INTER(i + 1, lo_n, hi_n, sf_n);
                    acc_i = MFMA32(cat4(lo_c, hi_c), sf_c, acc_i);
                    lo_c = lo_n; hi_c = hi_n; sf_c = sf_n;
                }
#undef LD_INTER
            }
            if (ML) {
                f32x4 wi[4];
#pragma unroll
                for (int g = 0; g < 4; ++g) wi[g] = *(const LAS f32x4*)(SP + 128 + 32 * tp + 8 * g + 4 * hh);
#pragma unroll
                for (int r = 0; r < 16; ++r) o[r] = acc_o[r] + wi[r >> 2][r & 3] * acc_i[r];
            } else {
#pragma unroll
                for (int r = 0; r < 16; ++r) o[r] = acc_o[r] + acc_i[r];
            }
            {
#pragma unroll
                for (int r = 0; r < 8; ++r) { const int rr = kh ? r : r + 8; *(LAS float*)(L + SL_XCH + (((tp * 2 + tj) * 16 + rr) * 64 + lane) * 4) = kh ? o[r] : o[r + 8]; }
            }
        }
        {
            if (ML) {
#pragma unroll
                for (int i = 0; i < NOWN; ++i)
#pragma unroll
                    for (int r = 0; r < 16; ++r) S[i][r] *= dec;
            }
#define LD_GA(ks_, i_, LO_, HI_) do { LO_ = lds_tr(L + SL_KT + ((ks_) >> 1) * NCB * 8192 + 4096 * ((ks_) & 1) + tkoff[i_] + TRK[0]); HI_ = lds_tr(L + SL_KT + ((ks_) >> 1) * NCB * 8192 + 4096 * ((ks_) & 1) + 256 + tkoff[i_] + TRK[1]); } while (0)
#define LD_GB(ks_, LO_, HI_) do { LO_ = lds_tr(L + (ML ? SL_VW : SL_V) + ((ks_) >> 1) * 4096 + 2048 * ((ks_) & 1) + VN[0]); HI_ = lds_tr(L + (ML ? SL_VW : SL_V) + ((ks_) >> 1) * 4096 + 2048 * ((ks_) & 1) + 256 + VN[1]); } while (0)
            s16x4 alo_c, ahi_c, blo_c, bhi_c, alo_n, ahi_n, blo_n, bhi_n;
            LD_GB(0, blo_c, bhi_c); LD_GA(0, 0, alo_c, ahi_c); alo_n = alo_c; ahi_n = ahi_c; blo_n = blo_c; bhi_n = bhi_c;
            constexpr int NG = (SKIP & 8) ? 0 : 4 * NOWN;
#pragma unroll
            for (int j = 0; j < NG; ++j) {
                const int ks = j / NOWN, i = j % NOWN, ks1 = (j + 1) / NOWN, i1 = (j + 1) % NOWN;
                if (j + 1 < NG) { LD_GA(ks1, i1, alo_n, ahi_n); if (i1 == 0) LD_GB(ks1, blo_n, bhi_n); }
                S[i] = MFMA32(cat4(alo_c, ahi_c), cat4(blo_c, bhi_c), S[i]);
                alo_c = alo_n; ahi_c = ahi_n; if (i1 == 0) { blo_c = blo_n; bhi_c = bhi_n; }
                (void)ks;
            }
#undef LD_GA
#undef LD_GB
            if (!ML) {
#pragma unroll
                for (int i = 0; i < NOWN; ++i)
#pragma unroll
                    for (int r = 0; r < 16; ++r) S[i][r] *= pe[i][r >> 2][r & 3];
            }
        }
        __syncthreads();
#pragma unroll
        for (int i = 0; i < NOWN; ++i)
#pragma unroll
            for (int st = 0; st < 2; ++st) {
                const bf16x8 f8 = pk8(S[i][8 * st], S[i][8 * st + 1], S[i][8 * st + 2], S[i][8 * st + 3], S[i][8 * st + 4], S[i][8 * st + 5], S[i][8 * st + 6], S[i][8 * st + 7]);
                *(LAS bf16x8*)(L + SL_SF + ((((kh * NKH + tp * NOWN + i) * 2 + tj) * 2 + st) * 1024) + lane * 16) = f8;
            }
        if (n + 1 < 68 && !(SKIP & 16)) store_images(n + 1);
        if (lat && !(SKIP & 2)) {
            float xv[8];
#pragma unroll
            for (int r8 = 0; r8 < 8; ++r8) { const int r = kh ? r8 + 8 : r8; xv[r8] = *(const LAS float*)(L + SL_XCH + (((tp * 2 + tj) * 16 + r) * 64 + lane) * 4); }
#pragma unroll
            for (int r8 = 0; r8 < 8; ++r8) { const int r = kh ? r8 + 8 : r8; const float ov = (kh ? o[r8 + 8] : o[r8]) + xv[r8];
                const int pr = 32 * tp + (r & 3) + 8 * (r >> 2) + 4 * (int)hh;
                go[(size_t)(row0 + pr) * WA + 32 * tj + (lane & 31)] = (bf16)(pkbf(ov, 0.f) & 0xffffu); }
        }
        LDS_BARRIER();
    }
}
#ifndef HG_MFMA
#define HG_MFMA 1
#endif
#ifndef ML_MFMA
#define ML_MFMA 1
#endif

__device__ __forceinline__ void nchain_task(Frame& F, int j) {
    const int kq = j & 3, id = j >> 2, dirn = id & 1, h = (id >> 1) & 3, b = id >> 3;
    const int tid = F.tid, lane = F.lane, w = F.wave;
    LAS unsigned char* L = F.lds;
    constexpr int NQ = 0, NK = 8192, NS = 16384;
    LAS float* SN = (LAS float*)(L + NS);
    const bf16* gq = F.XN + h * MLD + kq * 64; const bf16* gk = gq + WB;
    const float* mls = F.MLS + (size_t)(dirn * 4 + h) * MALL * 8;
    float* dqp = F.DQP + (size_t)((dirn * 4 + h) * 4 + kq) * MX;
    auto row0_of = [&](int n) -> int { if (n > 67) n = 67; if (n < 4) { const int cc = dirn ? 3 - n : n; return MX + b * CTXL + cc * 64; } const int lc = dirn ? 67 - n : n - 4; return b * SEQ + lc * 64; };
    struct Stg { v4u q, k; float ws, dec; };
    Stg A, B, C; A.ws = A.dec = B.ws = B.dec = C.ws = C.dec = 0.f;
    auto issue = [&](int n, Stg& t) { const int row0 = row0_of(n); const size_t off = (size_t)(row0 + (tid >> 3)) * DM + (tid & 7) * 8;
        t.q = *(const GAS v4u*)(gq + off); t.k = *(const GAS v4u*)(gk + off);
        if (tid < 64) { t.ws = mls[(size_t)(row0 + tid) * 8 + 3]; t.dec = mls[(size_t)(row0 + tid) * 8 + 6]; } };
    auto stash = [&](const Stg& t) { *(LAS v4u*)(L + NQ + tid * 16) = t.q; *(LAS v4u*)(L + NK + tid * 16) = t.k; if (tid < 64) { SN[tid] = t.ws; if (tid == 0) SN[640] = t.dec; } };
    auto step = [&](int n, Stg& ld, const Stg& st) {
        const int row0 = row0_of(n); const bool on = n < 68;
        issue(n + 2, ld);
        float dq_keep = 0.f;
        if (on && n >= 4) {
            const int kk = tid & 7; const v4u u = *(const LAS v4u*)(L + NQ + tid * 16);
            const f32x4 na = *(const LAS f32x4*)(SN + 64 + 8 * kk), nb = *(const LAS f32x4*)(SN + 64 + 8 * kk + 4);
            float d = lo2f(u.x) * na.x + hi2f(u.x) * na.y + lo2f(u.y) * na.z + hi2f(u.y) * na.w + lo2f(u.z) * nb.x + hi2f(u.z) * nb.y + lo2f(u.w) * nb.z + hi2f(u.w) * nb.w;
            d += __shfl_xor(d, 1); d += __shfl_xor(d, 2); d += __shfl_xor(d, 4);
            dq_keep = d;
        }
        { float a = 0.f;
#pragma unroll
          for (int i = 0; i < 8; ++i) { const int s_ = 8 * w + i; a += SN[s_] * bf2f(*(const LAS unsigned short*)(L + NK + s_ * 128 + lane * 2)); }
          SN[128 + w * 64 + lane] = a; }
        __syncthreads();
        if (on && tid < 64) { float nn = SN[640] * SN[64 + tid];
#pragma unroll
            for (int ww = 0; ww < 8; ++ww) nn += SN[128 + ww * 64 + tid];
            SN[64 + tid] = nn; }
        stash(st);
        if (on && n >= 4 && (tid & 7) == 0) dqp[row0 + (tid >> 3)] = dq_keep;
        LDS_BARRIER();
    };
    __syncthreads();
    issue(0, A); issue(1, B);
    if (tid < 64) SN[64 + tid] = 0.f;
    stash(A);
    __syncthreads();
#pragma unroll 1
    for (int n = 0; n < 69; n += 3) { step(n, C, B); step(n + 1, A, C); step(n + 2, B, A); }
}

template <int WHICH, int SKIP = 0>
__device__ __forceinline__ void p4_scan(Frame& F) {
    for (int t = F.vcu; t < 256; t += F.G) {
        if (t < 128 ? !(WHICH & 1) : !(WHICH & 2)) continue;
        if (t < 128) { if (ML_MFMA) scan_task<true, SKIP>(F, t); else { p4_mlstm_task(F, 2 * t); p4_mlstm_task(F, 2 * t + 1); } }
        else { if (HG_MFMA) { scan_task<false, SKIP>(F, t - 128); nchain_task(F, t - 128); } else { p4_hgrn2_task(F, 2 * (t - 128)); p4_hgrn2_task(F, 2 * (t - 128) + 1); } }
    }
}
__device__ __forceinline__ void p5_combine(Frame& F) {
    bf16* Y = F.XN;
    const int gw = F.vcu * NWAVES + F.wave, NGW = F.G * NWAVES;
    for (int row = gw; row < MX; row += NGW) {
        const int ch = F.lane * 16;
        {
            float o[16];
            const v4u a0 = *(const GAS v4u*)(F.OAF + (size_t)row * WA + ch), a1 = *(const GAS v4u*)(F.OAF + (size_t)row * WA + ch + 8);
            const v4u b0 = *(const GAS v4u*)(F.OAB + (size_t)row * WA + ch), b1 = *(const GAS v4u*)(F.OAB + (size_t)row * WA + ch + 8);
            const unsigned ua[8] = {a0.x, a0.y, a0.z, a0.w, a1.x, a1.y, a1.z, a1.w}, ub[8] = {b0.x, b0.y, b0.z, b0.w, b1.x, b1.y, b1.z, b1.w};
            float ss = 0.f;
#pragma unroll
            for (int j = 0; j < 8; ++j) { o[2 * j] = lo2f(ua[j]) + lo2f(ub[j]); o[2 * j + 1] = hi2f(ua[j]) + hi2f(ub[j]); ss += o[2 * j] * o[2 * j] + o[2 * j + 1] * o[2 * j + 1]; }
            ss += __shfl_xor(ss, 1); ss += __shfl_xor(ss, 2); ss += __shfl_xor(ss, 4);
            const float r = 1.f / sqrtf(ss * (1.f / HGD) + NORM_EPS);
            const v4u z0 = *(const GAS v4u*)(F.U + (size_t)row * NU + C_AZ + ch), z1 = *(const GAS v4u*)(F.U + (size_t)row * NU + C_AZ + ch + 8);
            const unsigned uz[8] = {z0.x, z0.y, z0.z, z0.w, z1.x, z1.y, z1.z, z1.w};
            unsigned w[8];
#pragma unroll
            for (int j = 0; j < 8; ++j) { const float y0 = o[2 * j] * r * F.hg_norm_w[ch + 2 * j] * siluf(lo2f(uz[j])), y1 = o[2 * j + 1] * r * F.hg_norm_w[ch + 2 * j + 1] * siluf(hi2f(uz[j])); w[j] = pk2(y0, y1); }
            *(GAS v4u*)(Y + (size_t)row * DM + ch) = (v4u){w[0], w[1], w[2], w[3]}; *(GAS v4u*)(Y + (size_t)row * DM + ch + 8) = (v4u){w[4], w[5], w[6], w[7]};
        }
        {
            float o[16];
            const v4u a0 = *(const GAS v4u*)(F.HBF + (size_t)row * WB + ch), a1 = *(const GAS v4u*)(F.HBF + (size_t)row * WB + ch + 8);
            const v4u b0 = *(const GAS v4u*)(F.HBB + (size_t)row * WB + ch), b1 = *(const GAS v4u*)(F.HBB + (size_t)row * WB + ch + 8);
            const unsigned ua[8] = {a0.x, a0.y, a0.z, a0.w, a1.x, a1.y, a1.z, a1.w}, ub[8] = {b0.x, b0.y, b0.z, b0.w, b1.x, b1.y, b1.z, b1.w};
            float s = 0.f; const int hq = F.lane >> 4;
            float invd[2];
#pragma unroll
            for (int d = 0; d < 2; ++d) { const float* mr = F.MLS + ((size_t)(d * 4 + hq) * MALL + row) * 8; const float* dq = F.DQP + (size_t)((d * 4 + hq) * 4) * MX + row;
                const float den = mr[2] * ((dq[0] + dq[MX]) + (dq[2 * MX] + dq[3 * MX])) + mr[5];
                invd[d] = rcpf_(fmaxf(fabsf(den), mr[4])); }
#pragma unroll
            for (int j = 0; j < 8; ++j) { o[2 * j] = lo2f(ua[j]) * invd[0] + lo2f(ub[j]) * invd[1]; o[2 * j + 1] = hi2f(ua[j]) * invd[0] + hi2f(ub[j]) * invd[1]; s += o[2 * j] + o[2 * j + 1]; }
            s += __shfl_xor(s, 1); s += __shfl_xor(s, 2); s += __shfl_xor(s, 4); s += __shfl_xor(s, 8);
            const float mu = s * (1.f / MLD); float q = 0.f;
#pragma unroll
            for (int j = 0; j < 16; ++j) { o[j] -= mu; q += o[j] * o[j]; }
            q += __shfl_xor(q, 1); q += __shfl_xor(q, 2); q += __shfl_xor(q, 4); q += __shfl_xor(q, 8);
            const float r = 1.f / sqrtf(q * (1.f / MLD) + NORM_EPS);
            const v4u g0 = *(const GAS v4u*)(F.U + (size_t)row * NU + C_BO + ch), g1 = *(const GAS v4u*)(F.U + (size_t)row * NU + C_BO + ch + 8);
            const v4u z0 = *(const GAS v4u*)(F.U + (size_t)row * NU + C_BZ + ch), z1 = *(const GAS v4u*)(F.U + (size_t)row * NU + C_BZ + ch + 8);
            const unsigned ug[8] = {g0.x, g0.y, g0.z, g0.w, g1.x, g1.y, g1.z, g1.w}, uz[8] = {z0.x, z0.y, z0.z, z0.w, z1.x, z1.y, z1.z, z1.w};
            unsigned w[8];
#pragma unroll
            for (int j = 0; j < 8; ++j) { const float y0 = o[2 * j] * r * F.ml_norm_w[ch + 2 * j] * sigmf(lo2f(ug[j])) * siluf(lo2f(uz[j])), y1 = o[2 * j + 1] * r * F.ml_norm_w[ch + 2 * j + 1] * sigmf(hi2f(ug[j])) * siluf(hi2f(uz[j])); w[j] = pk2(y0, y1); }
            *(GAS v4u*)(Y + (size_t)row * DM + WA + ch) = (v4u){w[0], w[1], w[2], w[3]}; *(GAS v4u*)(Y + (size_t)row * DM + WA + ch + 8) = (v4u){w[4], w[5], w[6], w[7]};
        }
    }
}

struct EpiNullSplit {
    static constexpr bool PERM = true, AFTER_DRAIN = false, SPLIT = true, ADJ = false; static constexpr int HALF_STORES = 0;
    __device__ __forceinline__ void operator()(const pg8::f32x4 (&acc)[2][2][4][2], const pg8::Unit& u, int wr, int wc, int fr, int fq) const {}
    __device__ __forceinline__ void half(const pg8::f32x4 (&acc)[2][2][4][2], const pg8::Unit& u, const int ai, int wr, int wc, int fr, int fq) const {
#pragma unroll
        for (int bj = 0; bj < 2; ++bj)
#pragma unroll
            for (int m = 0; m < 4; ++m)
#pragma unroll
                for (int n = 0; n < 2; ++n) asm volatile("" :: "v"(acc[ai][bj][m][n]));
    }
};
struct EpiNoStoreSplit {
    static constexpr bool PERM = true, AFTER_DRAIN = false, SPLIT = true, ADJ = false; static constexpr int HALF_STORES = 0;
    __device__ __forceinline__ void operator()(const pg8::f32x4 (&acc)[2][2][4][2], const pg8::Unit& u, int wr, int wc, int fr, int fq) const {}
    __device__ __forceinline__ void half(const pg8::f32x4 (&acc)[2][2][4][2], const pg8::Unit& u, const int ai, int wr, int wc, int fr, int fq) const {
#pragma unroll
        for (int bj = 0; bj < 2; ++bj)
#pragma unroll
            for (int m = 0; m < 4; ++m) { pg8::f32x4 v0 = acc[ai][bj][m][0], v1 = acc[ai][bj][m][1];
                pg8::u32x4 w; w.x = pg8::cvt_pk_bf16(v0[0], v0[1]); w.y = pg8::cvt_pk_bf16(v0[2], v0[3]); w.z = pg8::cvt_pk_bf16(v1[0], v1[1]); w.w = pg8::cvt_pk_bf16(v1[2], v1[3]);
                asm volatile("" :: "v"(w)); }
    }
};

struct EpiResid {
    static constexpr bool PERM = false, AFTER_DRAIN = false, SPLIT = false, ADJ = false;
    const float* x; const float* gate; float* out;
    __device__ __forceinline__ void operator()(const pg8::f32x4 (&acc)[2][2][4][2], const pg8::Unit& u, int wr, int wc, int fr, int fq) const {
        using pg8::BM; using pg8::HALF;
        const int row0 = u.pm * BM + wr * 64 + fr, col0 = u.pn * BM + wc * 32 + 4 * fq; const int b = (u.pm * BM) / SEQ;
        pg8::f32x4 gv[2][2];
#pragma unroll
        for (int bj = 0; bj < 2; ++bj)
#pragma unroll
            for (int n = 0; n < 2; ++n) gv[bj][n] = *(const pg8::f32x4*)(gate + b * DM + col0 + bj * HALF + n * 16);
#pragma unroll
        for (int ai = 0; ai < 2; ++ai) {
            pg8::f32x4 xv[4][2][2];
#pragma unroll
            for (int m = 0; m < 4; ++m) { const size_t off = (size_t)(row0 + ai * HALF + m * 16) * DM + col0;
#pragma unroll
                for (int bj = 0; bj < 2; ++bj)
#pragma unroll
                    for (int n = 0; n < 2; ++n) xv[m][bj][n] = *(const pg8::f32x4*)(x + off + bj * HALF + n * 16); }
#pragma unroll
            for (int m = 0; m < 4; ++m) { const size_t off = (size_t)(row0 + ai * HALF + m * 16) * DM + col0;
#pragma unroll
                for (int bj = 0; bj < 2; ++bj)
#pragma unroll
                    for (int n = 0; n < 2; ++n) *(pg8::f32x4*)(out + off + bj * HALF + n * 16) = xv[m][bj][n] * ALPHA + gv[bj][n] * acc[ai][bj][m][n]; }
        }
    }
};


struct PanelOrder {
    int c;
    __device__ __forceinline__ bool next(int i, pg8::Unit& u) const { if (i >= 2) return false; u.pm = c >> 2; u.pn = (c & 3) + 4 * i; return true; }
    __device__ __forceinline__ void a_ready(const pg8::Unit&) const {}
    __device__ __forceinline__ void done(const pg8::Unit&) const {}
};
struct EpiLnFused {
    static constexpr bool PERM = false, AFTER_DRAIN = true, SPLIT = false, ADJ = false;
    const float* x; const float* gate; float* out; const float* ln_g; const float* ln_b;
    unsigned long long* xbuf;
    unsigned* cnt;
    __device__ __forceinline__ void zstats(pg8::f32x4 (&acc)[2][2][4][2], const pg8::Unit& u, int wr, int wc, int fr, int fq) const {
        using pg8::BM; using pg8::HALF;
        asm volatile("" : "+v"(fr), "+v"(fq));
        const int row0 = u.pm * BM + wr * 64 + fr, col0 = u.pn * BM + wc * 32 + 4 * fq; const int b = (u.pm * BM) / SEQ;
        pg8::f32x4 gv[2][2];
#pragma unroll
        for (int bj = 0; bj < 2; ++bj)
#pragma unroll
            for (int n = 0; n < 2; ++n) gv[bj][n] = *(const pg8::f32x4*)(gate + b * DM + col0 + bj * HALF + n * 16);
#pragma unroll
        for (int ai = 0; ai < 2; ++ai)
#pragma unroll
            for (int m = 0; m < 4; ++m) { const int row = row0 + ai * HALF + m * 16; const size_t off = (size_t)row * DM + col0;
                float s = 0.f;
#pragma unroll
                for (int bj = 0; bj < 2; ++bj)
#pragma unroll
                    for (int n = 0; n < 2; ++n) { const pg8::f32x4 xv = *(const pg8::f32x4*)(x + off + bj * HALF + n * 16);
                        const pg8::f32x4 z = xv * ALPHA + gv[bj][n] * acc[ai][bj][m][n]; acc[ai][bj][m][n] = z; s += (z[0] + z[1]) + (z[2] + z[3]); }
                s += __shfl_xor(s, 16); s += __shfl_xor(s, 32);
                const float mw = s * (1.0f / 64.0f); float q = 0.f;
#pragma unroll
                for (int bj = 0; bj < 2; ++bj)
#pragma unroll
                    for (int n = 0; n < 2; ++n) { const pg8::f32x4 d = acc[ai][bj][m][n] - mw; q += (d[0] * d[0] + d[1] * d[1]) + (d[2] * d[2] + d[3] * d[3]); }
                q += __shfl_xor(q, 16); q += __shfl_xor(q, 32);
                if (fq == 0) __hip_atomic_store(xbuf + (size_t)row * 32 + u.pn * 4 + wc, ((unsigned long long)__float_as_uint(q) << 32) | __float_as_uint(mw), __ATOMIC_RELAXED, __HIP_MEMORY_SCOPE_AGENT);
            }
    }
    __device__ __forceinline__ void publish(const pg8::Unit& u) const {
        asm volatile("s_waitcnt vmcnt(0)" ::: "memory");
        if ((threadIdx.x & 63) == 0) __hip_atomic_fetch_add(cnt + 64 * u.pm, 1u, __ATOMIC_RELAXED, __HIP_MEMORY_SCOPE_AGENT);
    }
    __device__ __forceinline__ void operator()(const pg8::f32x4 (&acc_c)[2][2][4][2], const pg8::Unit& u, int wr, int wc, int fr, int fq) const {
        using pg8::BM; using pg8::HALF;
        pg8::f32x4 (&acc)[2][2][4][2] = const_cast<pg8::f32x4 (&)[2][2][4][2]>(acc_c);
        zstats(acc, u, wr, wc, fr, fq);
        const int row0 = u.pm * BM + wr * 64 + fr, col0 = u.pn * BM + wc * 32 + 4 * fq;
#pragma unroll
        for (int ai = 0; ai < 2; ++ai)
#pragma unroll
            for (int m = 0; m < 4; ++m) { const size_t off = (size_t)(row0 + ai * HALF + m * 16) * DM + col0;
#pragma unroll
                for (int bj = 0; bj < 2; ++bj)
#pragma unroll
                    for (int n = 0; n < 2; ++n) *(pg8::f32x4*)(out + off + bj * HALF + n * 16) = acc[ai][bj][m][n]; }
        publish(u);
    }
    __device__ __forceinline__ void fused(pg8::f32x4 (&acc)[2][2][4][2], const pg8::Unit& u, int wr, int wc, int fr, int fq, PG8_LAS unsigned char* lds, int wid, int lane) const {
        using pg8::BM; using pg8::HALF;
        typedef float f32x2v __attribute__((ext_vector_type(2)));
        PG8_LAS f32x2v* PH = (PG8_LAS f32x2v*)(lds + 131072);
        PG8_LAS f32x2v* S = (PG8_LAS f32x2v*)(lds + 131072 + 4096);
        zstats(acc, u, wr, wc, fr, fq);
        publish(u);
        if (wid == 0) {
            unsigned spins = 0;
            while ((unsigned)__builtin_amdgcn_readfirstlane(__hip_atomic_load(cnt + 64 * u.pm, __ATOMIC_RELAXED, __HIP_MEMORY_SCOPE_AGENT)) < 64u) { __builtin_amdgcn_s_sleep(2); if (++spins > (1u << 22)) break; }
            __builtin_amdgcn_fence(__ATOMIC_ACQUIRE, "agent");
            asm volatile("s_waitcnt vmcnt(0)" ::: "memory");
        }
        asm volatile("s_waitcnt vmcnt(0) lgkmcnt(0)" ::: "memory"); __builtin_amdgcn_s_barrier(); asm volatile("" ::: "memory");
        { const int t = threadIdx.x, row = t >> 1, half = t & 1; const unsigned long long* sl = xbuf + (size_t)(u.pm * BM + row) * 32 + half * 16;
          float ms = 0.f, mq = 0.f, m2s = 0.f;
#pragma unroll
          for (int i = 0; i < 16; ++i) { const unsigned long long w = __hip_atomic_load(sl + i, __ATOMIC_RELAXED, __HIP_MEMORY_SCOPE_AGENT); const float mt = __uint_as_float((unsigned)w); ms += mt; mq += mt * mt; m2s += __uint_as_float((unsigned)(w >> 32)); }
          const float mh = ms * (1.0f / 16.0f);
          PH[row * 2 + half] = (f32x2v){mh, m2s + 64.0f * fmaxf(mq - 16.0f * mh * mh, 0.f)}; }
        asm volatile("s_waitcnt lgkmcnt(0)" ::: "memory"); __builtin_amdgcn_s_barrier(); asm volatile("" ::: "memory");
        if (threadIdx.x < 256) { const int row = threadIdx.x; const f32x2v a = PH[row * 2], bq = PH[row * 2 + 1];
            const float mean = 0.5f * (a.x + bq.x), da = a.x - mean, db = bq.x - mean; const float m2t = (a.y + bq.y) + 1024.0f * (da * da + db * db);
            S[row] = (f32x2v){mean, 1.0f / sqrtf(m2t * (1.0f / 2048.0f) + LN_EPS)}; }
        asm volatile("s_waitcnt lgkmcnt(0)" ::: "memory"); __builtin_amdgcn_s_barrier(); asm volatile("" ::: "memory");
        const int row0 = u.pm * BM + wr * 64 + fr, col0 = u.pn * BM + wc * 32 + 4 * fq;
#pragma unroll
        for (int bj = 0; bj < 2; ++bj)
#pragma unroll
            for (int n = 0; n < 2; ++n) { const int c = col0 + bj * HALF + n * 16;
                const pg8::f32x4 g2 = *(const pg8::f32x4*)(ln_g + c), b2 = *(const pg8::f32x4*)(ln_b + c), g1 = *(const pg8::f32x4*)(ln_g + c - 4 * BM), b1 = *(const pg8::f32x4*)(ln_b + c - 4 * BM);
#pragma unroll
                for (int ai = 0; ai < 2; ++ai)
#pragma unroll
                    for (int m = 0; m < 4; ++m) { const int rl = ai * HALF + wr * 64 + m * 16 + fr; const f32x2v sr = S[rl]; const size_t off = (size_t)(row0 + ai * HALF + m * 16) * DM + c;
                        const pg8::f32x4 z1 = *(const pg8::f32x4*)(out + off - 4 * BM);
                        *(pg8::f32x4*)(out + off) = (acc[ai][bj][m][n] - sr.x) * sr.y * g2 + b2;
                        acc[ai][bj][m][n] = (z1 - sr.x) * sr.y * g1 + b1; }
#pragma unroll
                for (int ai = 0; ai < 2; ++ai)
#pragma unroll
                    for (int m = 0; m < 4; ++m) { const size_t off = (size_t)(row0 + ai * HALF + m * 16) * DM + c; *(pg8::f32x4*)(out + off - 4 * BM) = acc[ai][bj][m][n]; } }
    }
};

__device__ __forceinline__ void p7_ln(Frame& F) {
    const int gw = F.vcu * NWAVES + F.wave, NGW = F.G * NWAVES;
    for (int row = 2 * gw; row < MX; row += 2 * NGW) {
        GAS f32x4* ra = (GAS f32x4*)(F.out + (size_t)row * DM) + F.lane; GAS f32x4* rb = ra + DM / 4;
        f32x4 va[8], vb[8]; float sa = 0.f, sb = 0.f;
#pragma unroll
        for (int j = 0; j < 8; ++j) { va[j] = ra[64 * j]; vb[j] = rb[64 * j]; }
#pragma unroll
        for (int j = 0; j < 8; ++j) { sa += (va[j].x + va[j].y) + (va[j].z + va[j].w); sb += (vb[j].x + vb[j].y) + (vb[j].z + vb[j].w); }
        const float ma = wave_sum(sa) * (1.f / DM), mb = wave_sum(sb) * (1.f / DM); float qa = 0.f, qb = 0.f;
#pragma unroll
        for (int j = 0; j < 8; ++j) { va[j] = va[j] - ma; vb[j] = vb[j] - mb; qa += (va[j].x * va[j].x + va[j].y * va[j].y) + (va[j].z * va[j].z + va[j].w * va[j].w); qb += (vb[j].x * vb[j].x + vb[j].y * vb[j].y) + (vb[j].z * vb[j].z + vb[j].w * vb[j].w); }
        const float rsa = 1.f / sqrtf(wave_sum(qa) * (1.f / DM) + LN_EPS), rsb = 1.f / sqrtf(wave_sum(qb) * (1.f / DM) + LN_EPS);
        f32x4 gg[8], bbv[8];
#pragma unroll
        for (int j = 0; j < 8; ++j) { const int k = 4 * F.lane + 256 * j; gg[j] = *(const f32x4*)(F.ln_g + k); bbv[j] = *(const f32x4*)(F.ln_b + k); }
#pragma unroll
        for (int j = 0; j < 8; ++j) { ra[64 * j] = va[j] * rsa * gg[j] + bbv[j]; rb[64 * j] = vb[j] * rsb * gg[j] + bbv[j]; }
    }
}

struct Args { const float* in[16]; float* out; unsigned char* ws; int ph_lo, ph_hi, li, pad; };
__global__ void __launch_bounds__(NWAVES * 64, 2) mk_fwd(Args args) {
    extern __shared__ __attribute__((aligned(16))) unsigned char lds[];
    Frame F;
    F.lds = (LAS unsigned char*)lds;
    F.MISC = (volatile LAS unsigned*)(F.lds + MISC_OFF);
    F.tid = threadIdx.x; F.lane = F.tid & 63; F.wave = __builtin_amdgcn_readfirstlane(F.tid >> 6);
    F.G = gridDim.x; { const int bx = blockIdx.x; F.vcu = (F.G % 8 == 0) ? (bx % 8) * (F.G / 8) + bx / 8 : bx; }
    unsigned char* ws = args.ws;
    F.ctl = (gu32*)(ws + WS_CTL);
    F.x = args.in[0]; F.c = args.in[1]; F.ctx = args.in[2]; F.c_ctx = args.in[3]; F.w_mod = args.in[4]; F.b_mod = args.in[5]; F.w_in = args.in[6];
    F.conv_w = args.in[7]; F.conv_b = args.in[8]; F.hg_lb = args.in[9]; F.ml_gate_b = args.in[10]; F.hg_norm_w = args.in[11]; F.ml_norm_w = args.in[12];
    F.w_out = args.in[13]; F.ln_g = args.in[14]; F.ln_b = args.in[15]; F.out = args.out;
    F.modp = (float*)(ws + WS_MODP); F.gate = (float*)(ws + WS_GATE);
    F.QTF = (bf16*)(ws + WS_WINT); F.PE = (float*)(ws + WS_PE); F.MLS = (float*)(ws + WS_MLS); F.DEC = (float*)(ws + WS_DEC); F.MLW = (bf16*)(ws + WS_MLW); F.DQP = (float*)(ws + WS_DQP);
    F.WinT = (bf16*)(ws + WS_WINT); F.WoutT = (bf16*)(ws + WS_WOUTT); F.XN = (bf16*)(ws + WS_XN); F.U = (bf16*)(ws + WS_U);
    F.OAF = (bf16*)args.out; F.OAB = F.OAF + (size_t)MX * WA; F.HBF = F.OAB + (size_t)MX * WA; F.HBB = F.HBF + (size_t)MX * WB;
    for (int u = F.tid; u < (LDS_BYTES - LDSCTL_OFF) / 4; u += NT) ((LAS unsigned*)(F.lds + LDSCTL_OFF))[u] = 0u;
    __syncthreads();
    XcdBarrier bar; bar.bar = (unsigned*)(F.ctl + CW_BAR); bar.x = 0; bar.st = nullptr;
    if (MK_N_LAUNCHES == 1) bar = xcd_barrier_post((unsigned*)(F.ctl + CW_BAR), F.MISC + 8);
    const int lo = args.ph_lo, hi = args.ph_hi;
#ifndef PH_MASK
#define PH_MASK 255
#endif
#define PHON(k) ((PH_MASK >> (k)) & 1)
#ifndef DUP_MASK
#define DUP_MASK 0
#endif
#define DUP(k) ((DUP_MASK >> (k)) & 1)
#ifndef FUSE_LN
#define FUSE_LN 0
#endif
#ifndef DUP4S
#define DUP4S 0
#endif
#ifndef DUP4W
#define DUP4W 3
#endif
#ifndef DUP3W
#define DUP3W 7
#endif
#define IN(k) (lo <= (k) && (k) < hi)
#define SEAM(k) do { if (IN(k) && IN((k) + 1)) xcd_barrier(bar); } while (0)
    if (PHON(0) && IN(0)) { p0_prep(F); if (DUP(0)) p0_prep(F); } SEAM(0);
    if (PHON(1) && IN(1)) { p1_lnmod(F); if (DUP(1)) p1_lnmod(F); } SEAM(1);
    if (PHON(2) && IN(2)) { pg8::Gemm g{F.XN, F.WinT, MALL, NU, DM}; pg8::StaticOrder S; S.init(MALL, NU, F.G, (int)blockIdx.x);
        pg8::EpiBf16<2> E{F.U, NU, nullptr, 0, 0, 1.f, 4};
        if (DUP(2)) { EpiNullSplit EN; pg8::gemm_phase<EpiNullSplit, pg8::StaticOrder, PG8_ALIGN, PG8_SP2>(F.lds + RING_OFF, g, S, EN); __syncthreads(); }
        if (DUP(10)) { EpiNoStoreSplit EN; pg8::gemm_phase<EpiNoStoreSplit, pg8::StaticOrder, PG8_ALIGN, PG8_SP2>(F.lds + RING_OFF, g, S, EN); __syncthreads(); }
        if (DUP(9)) { pg8::gemm_phase<pg8::EpiBf16<2>, pg8::StaticOrder, PG8_ALIGN, PG8_SP2>(F.lds + RING_OFF, g, S, E); __syncthreads(); }
        pg8::gemm_phase<pg8::EpiBf16<2>, pg8::StaticOrder, PG8_ALIGN, PG8_SP2>(F.lds + RING_OFF, g, S, E); } SEAM(2);
    if (PHON(3) && IN(3)) { if (DUP(3)) { if (DUP3W & 1) p3_hg_prep<true>(F); if (DUP3W & 2) p3_conv(F); if (DUP3W & 4) p3_ml_scalars(F); } p3_conv(F); if (HG_MFMA) p3_hg_prep<false>(F); if (ML_MFMA) p3_ml_scalars(F); xcd_barrier(bar); p3b_ml_scores(F); if (DUP(6)) p3b_ml_scores(F); } SEAM(3);
    if (PHON(4) && IN(4)) { if (DUP(4)) p4_scan<DUP4W, DUP4S>(F); p4_scan<3>(F); } SEAM(4);
    if (PHON(5) && IN(5)) { p5_combine(F); if (DUP(5)) p5_combine(F); if (DUP(7)) { xcd_barrier(bar); xcd_barrier(bar); xcd_barrier(bar); xcd_barrier(bar); } } SEAM(5);
    if (PHON(6) && IN(6)) { pg8::Gemm g{F.XN, F.WoutT, MX, DM, DM}; pg8::StaticOrder S; S.init(MX, DM, F.G, (int)blockIdx.x);
        if (F.G == 256 && FUSE_LN) { PanelOrder PO{F.vcu}; EpiLnFused E{F.x, F.gate, F.out, F.ln_g, F.ln_b, (unsigned long long*)(args.ws + WS_XB), (unsigned*)(F.ctl + CW_PANEL)};
            pg8::gemm_phase<EpiLnFused, PanelOrder, PG8_ALIGN, PG8_SP2>(F.lds + RING_OFF, g, PO, E); }
        else { EpiResid E{F.x, F.gate, F.out};
            pg8::gemm_phase<EpiResid, pg8::StaticOrder, PG8_ALIGN, PG8_SP2>(F.lds + RING_OFF, g, S, E);
            if (DUP(8)) { __syncthreads(); pg8::gemm_phase<EpiResid, pg8::StaticOrder, PG8_ALIGN, PG8_SP2>(F.lds + RING_OFF, g, S, E); } } }
    if (!(F.G == 256 && FUSE_LN)) { SEAM(6); if (PHON(7) && IN(7)) { p7_ln(F); } }
#undef IN
#undef SEAM
}

extern "C" void kernel_launch(void* const* d_in, const int* in_sizes, int n_in, void* d_out, int out_size, void* d_ws, size_t ws_size, hipStream_t stream) {
    static int grid = 0;
    if (grid == 0) {
        if (n_in != 16 || out_size != MX * DM || ws_size < WS_END) { fprintf(stderr, "kernel_launch: unexpected shapes (n_in %d out %d ws %zu)\n", n_in, out_size, ws_size); grid = -1; return; }
        int dev = 0, cus = 0, per_cu = 0;
        if (hipGetDevice(&dev) != hipSuccess || hipDeviceGetAttribute(&cus, hipDeviceAttributeMultiprocessorCount, dev) != hipSuccess) { grid = -1; return; }
        if (hipFuncSetAttribute((const void*)mk_fwd, hipFuncAttributeMaxDynamicSharedMemorySize, LDS_BYTES) != hipSuccess) { fprintf(stderr, "kernel_launch: hipFuncSetAttribute failed\n"); grid = -1; return; }
        if (hipOccupancyMaxActiveBlocksPerMultiprocessor(&per_cu, (const void*)mk_fwd, NT, LDS_BYTES) != hipSuccess || per_cu < 1) { fprintf(stderr, "kernel_launch: occupancy query says %d\n", per_cu); per_cu = 1; }
        (void)hipGetLastError();
        grid = cus;
    }
    if (grid < 0) return;
    if (hipMemsetAsync((char*)d_ws + WS_CTL, 0, CTL_ZERO_BYTES, stream) != hipSuccess) { fprintf(stderr, "kernel_launch: memset failed\n"); return; }
    Args a{};
    for (int i = 0; i < 16; ++i) a.in[i] = (const float*)d_in[i];
    a.out = (float*)d_out; a.ws = (unsigned char*)d_ws;
    for (int li = 0; li < MK_N_LAUNCHES; ++li) {
        a.ph_lo = (MK_N_LAUNCHES == 1) ? 0 : li; a.ph_hi = (MK_N_LAUNCHES == 1) ? N_PHASES : li + 1; a.li = li;
        hipLaunchKernelGGL(mk_fwd, dim3(grid), dim3(NT), LDS_BYTES, stream, a);
        const hipError_t le = hipPeekAtLastError();
        if (le != hipSuccess) { fprintf(stderr, "kernel_launch: launch %d failed: %s\n", li, hipGetErrorName(le)); break; }
    }
}
```

```cpp
#include <hip/hip_runtime.h>
#include <cstdio>
#include <cstdint>
namespace pg8 {
#define PG8_LAS __attribute__((address_space(3)))
typedef unsigned short bf16_t;
typedef short bf16x8 __attribute__((ext_vector_type(8)));
typedef float f32x4 __attribute__((ext_vector_type(4)));
typedef unsigned u32x4 __attribute__((ext_vector_type(4)));
constexpr int BM = 256, BK = 64, HALF = 128, HTB = HALF * BK * 2  , STAGE_BYTES = 8 * HTB, NXCD = 8, WGM = 4;

__host__ __device__ __forceinline__ int lds_byte(int r, int c) { const int st = (r >> 4) * 2 + (c >> 5), rr = r & 15, cc = c & 31, ob = rr * 64 + cc * 2; return st * 1024 + (ob ^ (((ob >> 9) & 1) << 5)); }
__host__ __device__ __forceinline__ void stage_rc(int b, int& R, int& C) { const int st = b / 1024, sb = b % 1024, swz = sb ^ (((sb >> 9) & 1) << 5); R = (st >> 1) * 16 + swz / 64; C = (st & 1) * 32 + (swz % 64) / 2; }
__host__ __device__ __forceinline__ int perm32(int rho) { const int n = rho >> 4, i = rho & 15; return 8 * (i >> 2) + 4 * n + (i & 3); }

struct Unit { int pm, pn; };
struct Gemm { const bf16_t* A; const bf16_t* Bt; int M, N, K; };

struct StaticOrder {
    int nM, nN, nwg, G, c;
    __host__ __device__ void init(int M, int N, int G_, int c_) { nM = M / BM; nN = N / BM; nwg = nM * nN; G = G_; c = c_; }
    __host__ __device__ bool next(int i, Unit& u) const {
        const long L = (long)i * G + c; if (L >= nwg) return false;
        int wgid = (int)L; { const int q = nwg / NXCD, r = nwg % NXCD, xcd = wgid % NXCD, off = wgid / NXCD; wgid = (xcd < r ? xcd * (q + 1) : r * (q + 1) + (xcd - r) * q) + off; }
        const int nig = WGM * nN, gid = wgid / nig, fm = gid * WGM, gsz = (nM - fm) < WGM ? (nM - fm) : WGM;
        u.pm = fm + ((wgid % nig) % gsz); u.pn = (wgid % nig) / gsz; return true;
    }
    __device__ __forceinline__ void a_ready(const Unit&) const {}
    __device__ __forceinline__ void done(const Unit&) const {}
};

__device__ __forceinline__ unsigned cvt_pk_bf16(float lo, float hi) { unsigned r; asm volatile("v_cvt_pk_bf16_f32 %0, %1, %2" : "=v"(r) : "v"(lo), "v"(hi)); return r; }
typedef float f32x2 __attribute__((ext_vector_type(2)));
__device__ __forceinline__ f32x2 gelu_pk(f32x2 v) {
    const f32x2 av = __builtin_elementwise_abs(v), d = av * 0.2316418882f + 1.0f;
    f32x2 t; t.x = __builtin_amdgcn_rcpf(d.x); t.y = __builtin_amdgcn_rcpf(d.y);
    f32x2 q = t * 0.5307027145f + (-0.7265760135f); q = q * t + 0.7107068705f; q = q * t + (-0.142248368f); q = q * t + 0.127414796f; q = q * t;
    const f32x2 s = (v * v) * (-0.72134752044f);
    f32x2 e; e.x = __builtin_amdgcn_exp2f(s.x); e.y = __builtin_amdgcn_exp2f(s.y);
    const f32x2 m = v * (q * e), r = v - m;
    f32x2 o; o.x = v.x < 0.f ? m.x : r.x; o.y = v.y < 0.f ? m.y : r.y; return o;
}

template <int ACT  > struct EpiBf16 {
    static constexpr bool PERM = true, AFTER_DRAIN = false, SPLIT = (ACT != 1), ADJ = (ACT != 1); static constexpr int HALF_STORES = 8; static_assert(ACT == 0 || ACT == 1 || ACT == 2, "EpiBf16: ACT is 0 (none), 1 (gelu_pk) or 2 (SiLU on the column tiles pn < act_tiles)");
    bf16_t* O; int ldc; const float* bias; int split_cols; size_t split_stride; float scale0; int act_tiles;
    __device__ __forceinline__ void operator()(const f32x4 (&acc)[2][2][4][2], const Unit& u, int wr, int wc, int fr, int fq) const {
        const int row0 = u.pm * BM + wr * 64 + fr; int colt = u.pn * BM; bf16_t* base = O;
        float sc = 1.f; if (split_cols) { const int t = colt / split_cols; base += (size_t)t * split_stride; colt -= t * split_cols; if (t == 0) sc = scale0; }
        const int col0 = colt + wc * (ADJ ? 64 : 32) + 8 * fq, bcol0 = u.pn * BM + wc * (ADJ ? 64 : 32) + 8 * fq; constexpr int BJS = ADJ ? 32 : HALF;
        f32x4 bv[2][2];
#pragma unroll
        for (int bj = 0; bj < 2; ++bj)
#pragma unroll
            for (int n = 0; n < 2; ++n) bv[bj][n] = bias ? *(const f32x4*)(bias + bcol0 + bj * BJS + 4 * n) : (f32x4){0.f, 0.f, 0.f, 0.f};
#pragma unroll
        for (int ai = 0; ai < 2; ++ai)
#pragma unroll
            for (int m = 0; m < 4; ++m) { bf16_t* rowp = base + (size_t)(row0 + ai * HALF + m * 16) * ldc + col0;
#pragma unroll
                for (int bj = 0; bj < 2; ++bj) { f32x4 v0 = acc[ai][bj][m][0] + bv[bj][0], v1 = acc[ai][bj][m][1] + bv[bj][1];
                    if (ACT == 1) { f32x2 a = gelu_pk((f32x2){v0[0], v0[1]}), b = gelu_pk((f32x2){v0[2], v0[3]}), c = gelu_pk((f32x2){v1[0], v1[1]}), d = gelu_pk((f32x2){v1[2], v1[3]});
                        v0 = (f32x4){a.x, a.y, b.x, b.y}; v1 = (f32x4){c.x, c.y, d.x, d.y}; }
                    if (ACT == 2 && u.pn < act_tiles) {
#pragma unroll
                        for (int e = 0; e < 4; ++e) { v0[e] = v0[e] * __builtin_amdgcn_rcpf(1.0f + __expf(-v0[e])); v1[e] = v1[e] * __builtin_amdgcn_rcpf(1.0f + __expf(-v1[e])); } }
                    v0 = v0 * sc; v1 = v1 * sc; u32x4 w; w.x = cvt_pk_bf16(v0[0], v0[1]); w.y = cvt_pk_bf16(v0[2], v0[3]); w.z = cvt_pk_bf16(v1[0], v1[1]); w.w = cvt_pk_bf16(v1[2], v1[3]);
                    *(u32x4*)(rowp + bj * BJS) = w; } }
    }
    template <bool ACTV> __device__ __forceinline__ void half_t(const f32x4 (&acc)[2][2][4][2], const Unit& u, const int ai, int wr, int wc, int fr, int fq) const {
        unsigned frv = (unsigned)fr; asm volatile("" : "+v"(frv));
        const bool odd = (frv & 1u) != 0u;
        const unsigned off0 = ((unsigned)(u.pm * BM + wr * 64 + ai * HALF) + (frv & ~1u)) * (unsigned)ldc * 2u + (unsigned)(u.pn * BM + wc * 64 + 8 * fq) * 2u + (frv & 1u) * 64u;
        char* const ob = (char*)O;
#pragma unroll
        for (int m = 0; m < 4; ++m) { u32x4 w[2];
#pragma unroll
            for (int bj = 0; bj < 2; ++bj) { f32x4 v0 = acc[ai][bj][m][0], v1 = acc[ai][bj][m][1];
                if (ACTV) {
#pragma unroll
                    for (int e = 0; e < 4; ++e) { v0[e] = v0[e] * __builtin_amdgcn_rcpf(1.0f + __expf(-v0[e])); v1[e] = v1[e] * __builtin_amdgcn_rcpf(1.0f + __expf(-v1[e])); } }
                w[bj].x = cvt_pk_bf16(v0[0], v0[1]); w[bj].y = cvt_pk_bf16(v0[2], v0[3]); w[bj].z = cvt_pk_bf16(v1[0], v1[1]); w[bj].w = cvt_pk_bf16(v1[2], v1[3]); }
            u32x4 sa, sb;
#pragma unroll
            for (int e = 0; e < 4; ++e) { const unsigned t = odd ? w[0][e] : w[1][e];
                const unsigned r = (unsigned)__builtin_amdgcn_update_dpp(0, (int)t, 0xB1, 0xf, 0xf, false);
                sa[e] = odd ? r : w[0][e]; sb[e] = odd ? w[1][e] : r; }
            *(u32x4*)(ob + (size_t)(off0 + (unsigned)(m * 16 * ldc) * 2u)) = sa;
            *(u32x4*)(ob + (size_t)(off0 + (unsigned)((m * 16 + 1) * ldc) * 2u)) = sb; }
    }
    __device__ __forceinline__ void half(const f32x4 (&acc)[2][2][4][2], const Unit& u, const int ai, int wr, int wc, int fr, int fq) const {
        if (ACT == 2 && u.pn < act_tiles) half_t<true>(acc, u, ai, wr, wc, fr, fq); else half_t<false>(acc, u, ai, wr, wc, fr, fq);
    }
};
template <class Epi, class Sched, bool ALIGN_EPI = false, bool SP2 = false>
__device__ __forceinline__ void gemm_phase(PG8_LAS unsigned char* lds, const Gemm g, const Sched& S, const Epi& E) {
    const int tid = threadIdx.x, wid = __builtin_amdgcn_readfirstlane(tid >> 6), lane = tid & 63, wr = wid >> 2, wc = wid & 3, fr = lane & 15, fq = lane >> 4;
    const int K = g.K, nt = K / BK;
    unsigned voffA[2], voffB[2];
#pragma unroll
    for (int i = 0; i < 2; ++i) { int R, C; stage_rc(tid * 16 + i * 8192, R, C); const int Rb = Epi::PERM ? ((R & ~31) + perm32(R & 31)) : R;
        voffA[i] = (unsigned)(R * K + C) * 2u; voffB[i] = (unsigned)((Epi::ADJ ? 64 * (R >> 5) + perm32(R & 31) : Rb) * K + C) * 2u; }
    const size_t kstep = (size_t)(BK * 2);
    const size_t hstep = (size_t)HALF * K * 2;
    const size_t hstepB = Epi::ADJ ? (size_t)32 * K * 2 : hstep;
    const size_t tstep = 2 * hstep;
    const unsigned ldsw = (unsigned)wid * 1024u;
    const int aoff = lds_byte(wr * 64 + fr, fq * 8), boff = lds_byte(wc * 32 + fr, fq * 8);
#define PG8_SA(b, h) (((b) * 2 + (h)) * HTB)
#define PG8_SB(b, h) ((4 + (b) * 2 + (h)) * HTB)
#define PG8_STAGE(bufoff, gbase, voff) do { _Pragma("unroll") for (int _i = 0; _i < 2; ++_i) \
        __builtin_amdgcn_global_load_lds((const unsigned*)((const char*)(gbase) + (voff)[_i]), (PG8_LAS unsigned*)(lds + (bufoff) + ldsw + _i * 8192), 16, 0, 0); } while (0)
#define PG8_LDA(dst, b, h) do { _Pragma("unroll") for (int m = 0; m < 4; ++m) _Pragma("unroll") for (int k = 0; k < 2; ++k) dst[m][k] = *(const PG8_LAS bf16x8*)(lds + PG8_SA(b, h) + aoff + m * 2048 + k * 1024); } while (0)
#define PG8_LDB(dst, b, h) do { _Pragma("unroll") for (int n = 0; n < 2; ++n) _Pragma("unroll") for (int k = 0; k < 2; ++k) dst[n][k] = *(const PG8_LAS bf16x8*)(lds + PG8_SB(b, h) + boff + n * 2048 + k * 1024); } while (0)
#define PG8_MMA(ai, bj, At, Bt) do { __builtin_amdgcn_s_setprio(1); _Pragma("unroll") for (int m = 0; m < 4; ++m) _Pragma("unroll") for (int n = 0; n < 2; ++n) _Pragma("unroll") for (int k = 0; k < 2; ++k) \
        acc[ai][bj][m][n] = __builtin_amdgcn_mfma_f32_16x16x32_bf16(Bt[n][k], At[m][k], acc[ai][bj][m][n], 0, 0, 0); __builtin_amdgcn_s_setprio(0); } while (0)
#define PG8_WAIT_V(n) asm volatile("s_waitcnt vmcnt(" #n ")" ::: "memory")
#define PG8_WAIT_V1 do { if constexpr (Epi::HALF_STORES == 8) PG8_WAIT_V(16); else PG8_WAIT_V(8); } while (0)
#define PG8_WAIT_V2 do { if constexpr (Epi::HALF_STORES == 8) PG8_WAIT_V(24); else PG8_WAIT_V(8); } while (0)
#define PG8_WAIT_L(n) asm volatile("s_waitcnt lgkmcnt(" #n ")" ::: "memory")
#define PG8_BAR __builtin_amdgcn_s_barrier()
#define PG8_SCHED __builtin_amdgcn_sched_barrier(0)
    Unit cur, nxt, prv; int ui = 0;
    if (!S.next(0, cur)) return;
    f32x4 acc[2][2][4][2];
#pragma unroll
    for (int a = 0; a < 2; ++a)
#pragma unroll
        for (int b = 0; b < 2; ++b)
#pragma unroll
            for (int m = 0; m < 4; ++m)
#pragma unroll
                for (int n = 0; n < 2; ++n) acc[a][b][m][n] = (f32x4){0.f, 0.f, 0.f, 0.f};
    bf16x8 At[4][2], B0[2][2], B1[2][2];
    const char* cA = (const char*)g.A + (size_t)cur.pm * tstep; const char* cB = (const char*)g.Bt + (size_t)cur.pn * tstep;
    S.a_ready(cur);
    if constexpr (SP2) {
        PG8_STAGE(PG8_SB(0, 0), cB, voffB); PG8_STAGE(PG8_SB(0, 1), cB + hstepB, voffB); PG8_STAGE(PG8_SA(0, 0), cA, voffA); PG8_STAGE(PG8_SA(0, 1), cA + hstep, voffA);
        if (wr == 1) PG8_BAR;
        PG8_WAIT_V(2); PG8_BAR;
        PG8_STAGE(PG8_SB(1, 0), cB + kstep, voffB); PG8_STAGE(PG8_SA(1, 0), cA + kstep, voffA); PG8_STAGE(PG8_SB(1, 1), cB + hstepB + kstep, voffB);
        PG8_WAIT_V(6); PG8_BAR;
    } else {
        PG8_STAGE(PG8_SB(0, 0), cB, voffB); PG8_STAGE(PG8_SA(0, 0), cA, voffA); PG8_STAGE(PG8_SB(0, 1), cB + hstepB, voffB); PG8_STAGE(PG8_SA(0, 1), cA + hstep, voffA);
        if (wr == 1) PG8_BAR;
        PG8_WAIT_V(4); PG8_BAR;
        PG8_STAGE(PG8_SB(1, 0), cB + kstep, voffB); PG8_STAGE(PG8_SA(1, 0), cA + kstep, voffA); PG8_STAGE(PG8_SB(1, 1), cB + hstepB + kstep, voffB);
        PG8_WAIT_V(6); PG8_BAR;
    }
    for (;;) {
        const bool has_next = S.next(ui + 1, nxt);
        const char* nA = has_next ? (const char*)g.A + (size_t)nxt.pm * tstep : cA; const char* nB = has_next ? (const char*)g.Bt + (size_t)nxt.pn * tstep : cB;
        for (int t = 0; t < nt; t += 2) {
            const bool last = (t == nt - 2);
            const char* a1 = cA + (size_t)(t + 1) * kstep;
            const char* a2 = last ? nA : cA + (size_t)(t + 2) * kstep; const char* b2 = last ? nB : cB + (size_t)(t + 2) * kstep;
            const char* a3 = a2 + kstep; const char* b3 = b2 + kstep;
            if (last && has_next) S.a_ready(nxt);
            if constexpr (SP2 && Epi::SPLIT) {
            const bool pend = (t == 0) && (ui > 0);
            PG8_LDB(B0, 0, 0); PG8_LDB(B1, 0, 1); PG8_SCHED; PG8_LDA(At, 0, 0); PG8_STAGE(PG8_SA(1, 1), a1 + hstep, voffA);
            if (pend) PG8_WAIT_V1; else PG8_WAIT_V(8);
            PG8_WAIT_L(0); PG8_BAR; PG8_MMA(0, 0, At, B0); PG8_MMA(0, 1, At, B1); PG8_BAR; PG8_SCHED;
            PG8_LDA(At, 0, 1); PG8_STAGE(PG8_SB(0, 0), b2, voffB); PG8_STAGE(PG8_SB(0, 1), b2 + hstepB, voffB); PG8_STAGE(PG8_SA(0, 0), a2, voffA); PG8_SCHED;
            if (pend) { E.half(acc, prv, 1, wr, wc, fr, fq); PG8_SCHED;
#pragma unroll
                for (int b = 0; b < 2; ++b)
#pragma unroll
                    for (int m = 0; m < 4; ++m)
#pragma unroll
                        for (int n = 0; n < 2; ++n) acc[1][b][m][n] = (f32x4){0.f, 0.f, 0.f, 0.f};
                PG8_WAIT_V2; } else PG8_WAIT_V(8);
            PG8_WAIT_L(0); PG8_BAR; PG8_MMA(1, 0, At, B0); PG8_MMA(1, 1, At, B1); PG8_BAR; PG8_SCHED;
            PG8_LDB(B0, 1, 0); PG8_LDB(B1, 1, 1); PG8_SCHED; PG8_LDA(At, 1, 0); PG8_STAGE(PG8_SA(0, 1), a2 + hstep, voffA);
            if (pend) PG8_WAIT_V1; else PG8_WAIT_V(8);
            PG8_WAIT_L(0); PG8_BAR; PG8_MMA(0, 0, At, B0); PG8_MMA(0, 1, At, B1); PG8_BAR; PG8_SCHED;
            PG8_LDA(At, 1, 1); PG8_STAGE(PG8_SB(1, 0), b3, voffB); PG8_STAGE(PG8_SB(1, 1), b3 + hstepB, voffB); PG8_STAGE(PG8_SA(1, 0), a3, voffA); PG8_SCHED;
            if (last) { E.half(acc, cur, 0, wr, wc, fr, fq); PG8_SCHED;
#pragma unroll
                for (int b = 0; b < 2; ++b)
#pragma unroll
                    for (int m = 0; m < 4; ++m)
#pragma unroll
                        for (int n = 0; n < 2; ++n) acc[0][b][m][n] = (f32x4){0.f, 0.f, 0.f, 0.f};
                PG8_WAIT_V1; } else if (pend) PG8_WAIT_V1; else PG8_WAIT_V(8);
            PG8_WAIT_L(0); PG8_BAR; PG8_MMA(1, 0, At, B0); PG8_MMA(1, 1, At, B1); PG8_BAR; PG8_SCHED;
            } else if constexpr (SP2) {
            PG8_LDB(B0, 0, 0); PG8_LDB(B1, 0, 1); PG8_SCHED; PG8_LDA(At, 0, 0); PG8_STAGE(PG8_SA(1, 1), a1 + hstep, voffA);
            PG8_WAIT_V(8); PG8_WAIT_L(0); PG8_BAR; PG8_MMA(0, 0, At, B0); PG8_MMA(0, 1, At, B1); PG8_BAR; PG8_SCHED;
            PG8_LDA(At, 0, 1); PG8_STAGE(PG8_SB(0, 0), b2, voffB); PG8_STAGE(PG8_SB(0, 1), b2 + hstepB, voffB); PG8_STAGE(PG8_SA(0, 0), a2, voffA);
            PG8_WAIT_V(8); PG8_WAIT_L(0); PG8_BAR; PG8_MMA(1, 0, At, B0); PG8_MMA(1, 1, At, B1); PG8_BAR; PG8_SCHED;
            PG8_LDB(B0, 1, 0); PG8_LDB(B1, 1, 1); PG8_SCHED; PG8_LDA(At, 1, 0); PG8_STAGE(PG8_SA(0, 1), a2 + hstep, voffA);
            PG8_WAIT_V(8); PG8_WAIT_L(0); PG8_BAR; PG8_MMA(0, 0, At, B0); PG8_MMA(0, 1, At, B1); PG8_BAR; PG8_SCHED;
            PG8_LDA(At, 1, 1); PG8_STAGE(PG8_SB(1, 0), b3, voffB); PG8_STAGE(PG8_SB(1, 1), b3 + hstepB, voffB); PG8_STAGE(PG8_SA(1, 0), a3, voffA);
            PG8_WAIT_V(8); PG8_WAIT_L(0); PG8_BAR; PG8_MMA(1, 0, At, B0); PG8_MMA(1, 1, At, B1); PG8_BAR; PG8_SCHED;
            } else {
            PG8_LDB(B0, 0, 0); PG8_SCHED; PG8_LDA(At, 0, 0); PG8_STAGE(PG8_SA(1, 1), a1 + hstep, voffA);
            PG8_WAIT_L(8); PG8_BAR; PG8_WAIT_L(0); PG8_MMA(0, 0, At, B0); PG8_BAR; PG8_SCHED;
            PG8_LDB(B1, 0, 1); PG8_STAGE(PG8_SB(0, 0), b2, voffB);
            PG8_BAR; PG8_WAIT_L(0); PG8_MMA(0, 1, At, B1); PG8_BAR;
            PG8_LDA(At, 0, 1); PG8_STAGE(PG8_SA(0, 0), a2, voffA);
            PG8_BAR; PG8_WAIT_L(0); PG8_MMA(1, 0, At, B0); PG8_BAR; PG8_SCHED;
            PG8_STAGE(PG8_SB(0, 1), b2 + hstepB, voffB);
            PG8_WAIT_V(6); PG8_BAR; PG8_MMA(1, 1, At, B1); PG8_BAR;
            PG8_LDB(B0, 1, 0); PG8_SCHED; PG8_LDA(At, 1, 0); PG8_STAGE(PG8_SA(0, 1), a2 + hstep, voffA);
            PG8_WAIT_L(8); PG8_BAR; PG8_WAIT_L(0); PG8_MMA(0, 0, At, B0); PG8_BAR; PG8_SCHED;
            PG8_LDB(B1, 1, 1); PG8_STAGE(PG8_SB(1, 0), b3, voffB);
            PG8_BAR; PG8_WAIT_L(0); PG8_MMA(0, 1, At, B1); PG8_BAR;
            PG8_LDA(At, 1, 1); PG8_STAGE(PG8_SA(1, 0), a3, voffA);
            PG8_BAR; PG8_WAIT_L(0); PG8_MMA(1, 0, At, B0); PG8_BAR; PG8_SCHED;
            PG8_STAGE(PG8_SB(1, 1), b3 + hstepB, voffB);
            PG8_WAIT_V(6); PG8_BAR; PG8_MMA(1, 1, At, B1); PG8_BAR;
            }
        }
        if constexpr (SP2 && Epi::SPLIT) {
            if (!has_next) { E.half(acc, cur, 1, wr, wc, fr, fq); S.done(cur); break; }
            prv = cur; cur = nxt; cA = nA; cB = nB; ++ui; continue;
        }
        if constexpr (ALIGN_EPI) { if (wr == 0) PG8_BAR; }
        if constexpr (!Epi::AFTER_DRAIN) { E(acc, cur, wr, wc, fr, fq); S.done(cur); }
        else { if (has_next) { E(acc, cur, wr, wc, fr, fq); S.done(cur); } }
        if (!has_next) break;
#pragma unroll
        for (int a = 0; a < 2; ++a)
#pragma unroll
            for (int b = 0; b < 2; ++b)
#pragma unroll
                for (int m = 0; m < 4; ++m)
#pragma unroll
                    for (int n = 0; n < 2; ++n) acc[a][b][m][n] = (f32x4){0.f, 0.f, 0.f, 0.f};
        cur = nxt; cA = nA; cB = nB; ++ui;
        if constexpr (ALIGN_EPI) { if (wr == 1) PG8_BAR; }
    }
    PG8_WAIT_V(0);
    if constexpr (!ALIGN_EPI || (SP2 && Epi::SPLIT)) { if (wr == 0) PG8_BAR; }
    PG8_BAR;
    if constexpr (Epi::AFTER_DRAIN) { E.fused(acc, cur, wr, wc, fr, fq, lds, wid, lane); S.done(cur); }
#undef PG8_SA
#undef PG8_SB
#undef PG8_STAGE
#undef PG8_LDA
#undef PG8_LDB
#undef PG8_MMA
#undef PG8_WAIT_V
#undef PG8_WAIT_V1
#undef PG8_WAIT_V2
#undef PG8_WAIT_L
#undef PG8_BAR
#undef PG8_SCHED
}
}

#ifndef PG8_SP2
#define PG8_SP2 true
#endif
#ifndef PG8_ALIGN
#define PG8_ALIGN true
#endif
#define GAS __attribute__((address_space(1)))
#define LAS __attribute__((address_space(3)))
typedef unsigned short bf16;
typedef unsigned v4u __attribute__((ext_vector_type(4)));
typedef float f32x4 __attribute__((ext_vector_type(4)));
typedef short bf16x8 __attribute__((ext_vector_type(8)));
typedef GAS unsigned gu32;
typedef GAS unsigned long long gu64;
#define RLX_AGENT __ATOMIC_RELAXED, __HIP_MEMORY_SCOPE_AGENT
#define LDS_WAIT() asm volatile("s_waitcnt lgkmcnt(0)" ::: "memory")
#define VM_WAIT() asm volatile("s_waitcnt vmcnt(0)" ::: "memory")
__device__ __forceinline__ unsigned long long rt() { return __builtin_amdgcn_s_memrealtime(); }
__device__ __forceinline__ unsigned f2bf(float f) { unsigned u = __builtin_bit_cast(unsigned, f); return (u + 0x7fffu + ((u >> 16) & 1u)) >> 16; }
__device__ __forceinline__ unsigned pk2(float lo, float hi) { return f2bf(lo) | (f2bf(hi) << 16); }

#define XB_TMO      128
#define XB_XCNT(j)  (256  + 64 * (j))
#define XB_XSUB(j)  (1280 + 64 * (j))
#define XB_XGEN(j)  (2304 + 64 * (j))
#define XB_TOP      3328
#define XB_TOPGEN   3392
#define XCD_BAR_WORDS 3456
#define XB_SPIN_CAP (1u << 18)

__device__ __forceinline__ unsigned xb_ld(unsigned* p)              { return __hip_atomic_load(p, __ATOMIC_RELAXED, __HIP_MEMORY_SCOPE_AGENT); }
__device__ __forceinline__ unsigned xb_add(unsigned* p, unsigned v) { return __hip_atomic_fetch_add(p, v, __ATOMIC_RELAXED, __HIP_MEMORY_SCOPE_AGENT); }
__device__ __forceinline__ unsigned xb_xcc_id() { return (unsigned)__builtin_amdgcn_s_getreg((3 << 11) | 20) & 0xFu; }
#define XB_SPIN(cond, bar) do { unsigned _sp = 0; while (cond) { __builtin_amdgcn_s_sleep(1); \
    if ((++_sp & 255u) == 0u) { if (xb_ld(&(bar)[XB_TMO])) break; if (_sp > XB_SPIN_CAP) { atomicAdd(&(bar)[XB_TMO], 1u); break; } } } } while (0)

struct XcdBarrier {
    unsigned* bar; unsigned x;
    volatile LAS unsigned* st;
};

__device__ __forceinline__ XcdBarrier xcd_barrier_post(unsigned* bar, volatile LAS unsigned* st) {
    XcdBarrier b; b.bar = bar; b.x = xb_xcc_id(); b.st = st;
    if (threadIdx.x == 0) (void)xb_add(&bar[XB_XCNT(b.x)], 1u);
    return b;
}
__device__ __forceinline__ void xcd_barrier_complete(unsigned* bar, unsigned x, unsigned& nloc, unsigned& nx) {
    const unsigned G = gridDim.x * gridDim.y * gridDim.z;
    unsigned sum, cnt, mine, sp = 0u;
    for (;;) {
        sum = 0u; cnt = 0u; mine = 0u;
#pragma unroll
        for (unsigned j = 0; j < 16; ++j) { const unsigned c = xb_ld(&bar[XB_XCNT(j)]); sum += c; cnt += (c > 0u) ? 1u : 0u; mine = (j == x) ? c : mine; }
        if (sum == G) break;
        __builtin_amdgcn_s_sleep(1);
        if ((++sp & 255u) == 0u) { if (xb_ld(&bar[XB_TMO])) break; if (sp > XB_SPIN_CAP) { atomicAdd(&bar[XB_TMO], 1u); break; } }
    }
    nloc = mine > 0u ? mine : 1u; nx = cnt > 0u ? cnt : 1u;
}

__device__ __forceinline__ void xcd_barrier(const XcdBarrier& b) {
    asm volatile("s_waitcnt vmcnt(0)" ::: "memory");
    __syncthreads();
    if (threadIdx.x == 0) {
        unsigned* bar = b.bar;
        __builtin_amdgcn_s_waitcnt(0);
        unsigned nloc = b.st[0], nx = b.st[1];
        if (nloc == 0u) { xcd_barrier_complete(bar, b.x, nloc, nx); b.st[0] = nloc; b.st[1] = nx; }
        const unsigned old = xb_add(&bar[XB_XSUB(b.x)], 1u);
        const unsigned gen = old / nloc;
        if (old + 1u == (gen + 1u) * nloc) {
            __builtin_amdgcn_fence(__ATOMIC_RELEASE, "agent");
            asm volatile("s_waitcnt vmcnt(0)" ::: "memory");
            const unsigned og = xb_add(&bar[XB_TOP], 1u);
            const unsigned tg = og / nx;
            if (og + 1u == (tg + 1u) * nx) xb_add(&bar[XB_TOPGEN], 1u);
            else XB_SPIN(xb_ld(&bar[XB_TOPGEN]) == tg, bar);
            __builtin_amdgcn_fence(__ATOMIC_ACQUIRE, "agent");
            xb_add(&bar[XB_XGEN(b.x)], 1u);
            asm volatile("s_waitcnt vmcnt(0)" ::: "memory");
        } else {
            XB_SPIN(xb_ld(&bar[XB_XGEN(b.x)]) == gen, bar);
            __builtin_amdgcn_fence(__ATOMIC_ACQUIRE, "agent");
            asm volatile("s_waitcnt vmcnt(0)" ::: "memory");
        }
    }
    __syncthreads();
}
constexpr int NWAVES = 8, NT = NWAVES * 64;
constexpr int BATCH = 4, SEQ = 4096, DM = 2048, CTXL = 256;
constexpr int MX = BATCH * SEQ, MC = BATCH * CTXL, MALL = MX + MC;
constexpr int WA = 1024, WB = 1024, NIN = 10256, NU = 10496;
constexpr int C_AQ = 0, C_AFF = 1024, C_AFB = 2048, C_AI = 3072, C_AZ = 4096, C_BQK = 5120, C_BV = 7168, C_BO = 8192, C_BZ = 9216, C_BG = 10240;
constexpr int HGH = 8, HGD = 128, MLH = 4, MLD = 256;
constexpr float ALPHA = 1.189207115002721f;
constexpr float LN_EPS = 1e-5f, NORM_EPS = 1e-6f;
constexpr int NMOD = 3 * DM;

#ifndef MK_N_LAUNCHES
#define MK_N_LAUNCHES 1
#endif
constexpr int N_PHASES = 8;

constexpr size_t MiB = 1u << 20;
constexpr size_t WS_CTL = 0, CTL_ZERO_BYTES = 1 * MiB;
constexpr size_t WS_MODP = 1 * MiB;
constexpr size_t WS_GATE = 3 * MiB;
constexpr size_t WS_WINT = 4 * MiB;
constexpr size_t WS_WOUTT = 45 * MiB;
constexpr size_t WS_XN = 53 * MiB;
constexpr size_t WS_U = 121 * MiB;
constexpr size_t WS_PE = 470 * MiB, WS_MLS = 473 * MiB, WS_DEC = 478 * MiB;
constexpr size_t WS_MLW = 479 * MiB;
constexpr size_t WS_DQP = 496 * MiB;
constexpr size_t WS_XB = 498 * MiB;
constexpr size_t WS_END = 502 * MiB;
static_assert(WS_WINT + (size_t)NU * DM * 2 <= WS_WOUTT && WS_WOUTT + (size_t)DM * DM * 2 <= WS_XN && WS_XN + (size_t)MALL * DM * 2 <= WS_U && WS_U + (size_t)MALL * NU * 2 <= WS_END, "d_ws map");
constexpr int CW_TMO = 0, CW_BAR = 4096, CW_PANEL = 16384;

constexpr int RING_OFF = 0, RING_BYTES = 131072;
constexpr int LDS_BYTES = 163840;
constexpr int LDSCTL_OFF = LDS_BYTES - 1024, MISC_OFF = LDSCTL_OFF + 320;

struct Frame {
    LAS unsigned char* lds;
    volatile LAS unsigned* MISC;
    gu32* ctl;
    int tid, lane, wave, vcu, G;
    const float *x, *c, *ctx, *c_ctx, *w_mod, *b_mod, *w_in, *conv_w, *conv_b, *hg_lb, *ml_gate_b, *hg_norm_w, *ml_norm_w, *w_out, *ln_g, *ln_b;
    float* out;
    float *modp, *gate;
    bf16 *WinT, *WoutT, *XN, *U;
    bf16 *QTF, *MLW; float *PE, *MLS, *DEC, *DQP;
    bf16 *OAF, *OAB, *HBF, *HBB;
};

typedef float f32x2_t __attribute__((ext_vector_type(2)));
#define LDS_BARRIER() do { asm volatile("s_waitcnt lgkmcnt(0)" ::: "memory"); __builtin_amdgcn_s_barrier(); asm volatile("" ::: "memory"); } while (0)
typedef __bf16 bf16x2_t __attribute__((ext_vector_type(2)));
__device__ __forceinline__ unsigned pkbf(float a, float b) { const f32x2_t v = {a, b}; return __builtin_bit_cast(unsigned, __builtin_convertvector(v, bf16x2_t)); }
__device__ __forceinline__ float bf2f(unsigned short u) { return __builtin_bit_cast(float, (unsigned)u << 16); }
__device__ __forceinline__ float lo2f(unsigned u) { return __builtin_bit_cast(float, u << 16); }
__device__ __forceinline__ float hi2f(unsigned u) { return __builtin_bit_cast(float, u & 0xffff0000u); }
__device__ __forceinline__ float siluf(float v) { return v / (1.f + __expf(-v)); }
__device__ __forceinline__ float sigmf(float v) { return 1.f / (1.f + __expf(-v)); }
__device__ __forceinline__ float wave_sum(float v) {
#pragma unroll
    for (int o = 1; o < 64; o <<= 1) v += __shfl_xor(v, o);
    return v;
}

constexpr int TLDW = 36;
__device__ __forceinline__ void transpose_item(const float* W, int ldw, int nvalid, int K, bf16* WT, LAS unsigned* T, int kb, int nb, int lane) {
    const int q = lane >> 4, cl = lane & 15, n = 64 * nb + 4 * cl; const bool ok = n < nvalid;
    const GAS float* p = (const GAS float*)W + (size_t)(64 * kb + 2 * q) * ldw + (ok ? n : 0);
    f32x4 v[16];
#pragma unroll
    for (int i = 0; i < 16; ++i) v[i] = *(const GAS f32x4*)(p + (size_t)(8 * (i >> 1) + (i & 1)) * ldw);
#pragma unroll
    for (int jj = 0; jj < 8; ++jj)
#pragma unroll
        for (int e = 0; e < 4; ++e) T[(4 * cl + e) * TLDW + 4 * jj + q] = ok ? pk2(v[2 * jj][e], v[2 * jj + 1][e]) : 0u;
    LDS_WAIT(); asm volatile("" ::: "memory");
    const int c = lane & 7;
#pragma unroll
    for (int t = 0; t < 8; ++t) { const int nn = 8 * t + (lane >> 3); const v4u o = *(const LAS v4u*)(T + nn * TLDW + 4 * c);
        *(GAS v4u*)((GAS bf16*)WT + (size_t)(64 * nb + nn) * K + 64 * kb + 8 * c) = o; }
    LDS_WAIT(); asm volatile("" ::: "memory");
}
constexpr int KS2 = 2;
__device__ __forceinline__ void p0_prep(Frame& F) {
    LAS float* scr = (LAS float*)(F.lds + RING_OFF + F.wave * 16384);
    LAS float* red = (LAS float*)(F.lds + RING_OFF + 131072);
    constexpr int NGEMV = (NMOD / 64) * KS2;
    for (int it = F.vcu; it < NGEMV; it += F.G) {
        const int cg = it >> 1, kh2 = it & 1, k0 = kh2 * 1024 + F.wave * 128, q = F.lane >> 4, cl = F.lane & 15;
        const GAS float* wp = (const GAS float*)F.w_mod + (size_t)(k0 + q) * NMOD + cg * 64 + 4 * cl;
        f32x4 w[32];
#pragma unroll
        for (int i = 0; i < 32; ++i) w[i] = *(const GAS f32x4*)(wp + (size_t)(4 * i) * NMOD);
#pragma unroll
        for (int rr = 0; rr < 5; ++rr)
#pragma unroll
            for (int j = 0; j < 2; ++j) { const int k = k0 + F.lane + 64 * j; const float v = rr < 4 ? F.c[rr * DM + k] : F.c_ctx[k]; scr[rr * 128 + F.lane + 64 * j] = siluf(v); }
        LDS_WAIT(); asm volatile("" ::: "memory");
        f32x4 a[5];
#pragma unroll
        for (int rr = 0; rr < 5; ++rr) a[rr] = (f32x4){0.f, 0.f, 0.f, 0.f};
#pragma unroll
        for (int i = 0; i < 32; ++i)
#pragma unroll
            for (int rr = 0; rr < 5; ++rr) a[rr] += scr[rr * 128 + 4 * i + q] * w[i];
#pragma unroll
        for (int rr = 0; rr < 5; ++rr)
#pragma unroll
            for (int e = 0; e < 4; ++e) { float t = a[rr][e]; t += __shfl_xor(t, 16); t += __shfl_xor(t, 32); a[rr][e] = t; }
        if (q == 0) {
#pragma unroll
            for (int rr = 0; rr < 5; ++rr) *(LAS f32x4*)(red + F.wave * 320 + rr * 64 + 4 * cl) = a[rr]; }
        __syncthreads();
        if (F.tid < 320) { float sacc = 0.f;
#pragma unroll
            for (int ww = 0; ww < 8; ++ww) sacc += red[ww * 320 + F.tid];
            const int rr = F.tid >> 6, nn = cg * 64 + (F.tid & 63);
            F.modp[((size_t)kh2 * 5 + rr) * NMOD + nn] = sacc + (kh2 == 0 ? F.b_mod[nn] : 0.f); }
        __syncthreads();
    }
    constexpr int NB_IN = NU / 64, I_IN = (DM / 64) * NB_IN, NB_OUT = DM / 64, I_OUT = (DM / 64) * NB_OUT, I_ALL = I_IN + I_OUT;
    int base, cnt;
    if (F.G == 256) { static_assert(NGEMV * 21 + (256 - NGEMV) * 35 == I_ALL, "P0 block split"); base = F.vcu < NGEMV ? 21 * F.vcu : 21 * NGEMV + 35 * (F.vcu - NGEMV); cnt = F.vcu < NGEMV ? 21 : 35; }
    else { const int per = (I_ALL + F.G - 1) / F.G; base = F.vcu * per; cnt = I_ALL - base < per ? I_ALL - base : per; }
    for (int o = F.wave; o < cnt; o += NWAVES) {
        int r = base + o;
        if (r < I_IN) { transpose_item(F.w_in, NIN, NIN, DM, F.WinT, (LAS unsigned*)scr, r / NB_IN, r % NB_IN, F.lane); continue; } r -= I_IN;
        transpose_item(F.w_out, DM, DM, DM, F.WoutT, (LAS unsigned*)scr, r / NB_OUT, r % NB_OUT, F.lane);
    }
}

__device__ __forceinline__ void ln_mod_row2(Frame& F, const float* xa, const float* xb, bf16* oa, bf16* ob, const LAS float* shift, const LAS float* scale) {
    const GAS f32x4* ra = (const GAS f32x4*)xa + F.lane; const GAS f32x4* rb = (const GAS f32x4*)xb + F.lane;
    f32x4 va[8], vb[8]; float sa = 0.f, sb = 0.f;
#pragma unroll
    for (int j = 0; j < 8; ++j) { va[j] = ra[64 * j]; vb[j] = rb[64 * j]; }
#pragma unroll
    for (int j = 0; j < 8; ++j) { sa += (va[j].x + va[j].y) + (va[j].z + va[j].w); sb += (vb[j].x + vb[j].y) + (vb[j].z + vb[j].w); }
    const float ma = wave_sum(sa) * (1.f / DM), mb = wave_sum(sb) * (1.f / DM); float qa = 0.f, qb = 0.f;
#pragma unroll
    for (int j = 0; j < 8; ++j) { va[j] = va[j] - ma; vb[j] = vb[j] - mb; qa += (va[j].x * va[j].x + va[j].y * va[j].y) + (va[j].z * va[j].z + va[j].w * va[j].w); qb += (vb[j].x * vb[j].x + vb[j].y * vb[j].y) + (vb[j].z * vb[j].z + vb[j].w * vb[j].w); }
    const float rsa = 1.f / sqrtf(wave_sum(qa) * (1.f / DM) + LN_EPS), rsb = 1.f / sqrtf(wave_sum(qb) * (1.f / DM) + LN_EPS);
    GAS unsigned long long* o8a = (GAS unsigned long long*)oa + F.lane; GAS unsigned long long* o8b = (GAS unsigned long long*)ob + F.lane;
#pragma unroll
    for (int j = 0; j < 8; ++j) { const int k = 4 * F.lane + 256 * j; const f32x4 sc = *(const LAS f32x4*)(scale + k) + 1.f, sh = *(const LAS f32x4*)(shift + k);
        const f32x4 ha = va[j] * rsa * sc + sh, hb = vb[j] * rsb * sc + sh;
        o8a[64 * j] = (unsigned long long)pk2(ha.x, ha.y) | ((unsigned long long)pk2(ha.z, ha.w) << 32);
        o8b[64 * j] = (unsigned long long)pk2(hb.x, hb.y) | ((unsigned long long)pk2(hb.z, hb.w) << 32); }
}
__device__ __forceinline__ void ln_mod_row(Frame& F, const float* xrow, bf16* orow, const LAS float* shift, const LAS float* scale) {
    const GAS f32x4* xr = (const GAS f32x4*)xrow + F.lane;
    f32x4 v[8]; float s = 0.f;
#pragma unroll
    for (int j = 0; j < 8; ++j) { v[j] = xr[64 * j]; s += (v[j].x + v[j].y) + (v[j].z + v[j].w); }
    const float mean = wave_sum(s) * (1.f / DM); float s2 = 0.f;
#pragma unroll
    for (int j = 0; j < 8; ++j) { v[j] = v[j] - mean; s2 += (v[j].x * v[j].x + v[j].y * v[j].y) + (v[j].z * v[j].z + v[j].w * v[j].w); }
    const float rstd = 1.f / sqrtf(wave_sum(s2) * (1.f / DM) + LN_EPS);
    GAS unsigned long long* o8 = (GAS unsigned long long*)orow + F.lane;
#pragma unroll
    for (int j = 0; j < 8; ++j) { const int k = 4 * F.lane + 256 * j; const f32x4 sc = *(const LAS f32x4*)(scale + k), sh = *(const LAS f32x4*)(shift + k);
        const f32x4 h = v[j] * rstd * (sc + 1.f) + sh;
        o8[64 * j] = (unsigned long long)pk2(h.x, h.y) | ((unsigned long long)pk2(h.z, h.w) << 32); }
}
__device__ __forceinline__ void p1_lnmod(Frame& F) {
    LAS float* md = (LAS float*)(F.lds + RING_OFF);
    for (int e = F.vcu * NT + F.tid; e < BATCH * DM; e += F.G * NT) { const int b = e / DM, n = e % DM;
        F.gate[e] = F.modp[(size_t)b * NMOD + 2 * DM + n] + F.modp[((size_t)5 + b) * NMOD + 2 * DM + n]; }
    for (int blk = F.vcu; blk < 256; blk += F.G) {
        const int b = blk >> 6;
        __syncthreads();
        { float m0v[16], m1v[16];
#pragma unroll
          for (int i = 0; i < 16; ++i) { const int e = F.tid + NT * i; const int row = e < 2 * DM ? b : 4, col = e & (2 * DM - 1); m0v[i] = F.modp[(size_t)row * NMOD + col]; m1v[i] = F.modp[((size_t)5 + row) * NMOD + col]; }
#pragma unroll
          for (int i = 0; i < 16; ++i) md[F.tid + NT * i] = m0v[i] + m1v[i]; }
        __syncthreads();
#pragma unroll 1
        for (int r = 0; r < 8; r += 2) { const int m = blk * 64 + F.wave * 8 + r;
            ln_mod_row2(F, F.x + (size_t)m * DM, F.x + (size_t)(m + 1) * DM, F.XN + (size_t)m * DM, F.XN + (size_t)(m + 1) * DM, md, md + DM); }
        if (F.wave < 4) { const int m = blk * 4 + F.wave; ln_mod_row(F, F.ctx + (size_t)m * DM, F.XN + (size_t)(MX + m) * DM, md + 2 * DM, md + 3 * DM); }
    }
}

__device__ __forceinline__ float rcpf_(float v) { return __builtin_amdgcn_rcpf(v); }
__device__ __forceinline__ float silu_fast(float v) { return v * rcpf_(1.f + __expf(-v)); }
__device__ __forceinline__ void conv_acc8(float (&acc)[8], const v4u u, const f32x4 wa, const f32x4 wb) {
    acc[0] += lo2f(u.x) * wa.x; acc[1] += hi2f(u.x) * wa.y; acc[2] += lo2f(u.y) * wa.z; acc[3] += hi2f(u.y) * wa.w;
    acc[4] += lo2f(u.z) * wb.x; acc[5] += hi2f(u.z) * wb.y; acc[6] += lo2f(u.w) * wb.z; acc[7] += hi2f(u.w) * wb.w;
}
constexpr int NSC = 4;
__device__ __forceinline__ void p3_conv(Frame& F) {
    bf16* QKM = F.XN;
    if (F.G > 2 * NSC && F.vcu < NSC) return;
    const int wk = F.G > 2 * NSC ? F.vcu - NSC : F.vcu, NW = F.G > 2 * NSC ? F.G - NSC : F.G;
    const int gw = wk * NWAVES + F.wave, NGW = NW * NWAVES;
    const int cq = gw & 3, ch = cq * 512 + F.lane * 8;
    f32x4 wa[9], wb[9];
#pragma unroll
    for (int t = 0; t < 9; ++t) { wa[t] = *(const GAS f32x4*)(F.conv_w + t * 2048 + ch); wb[t] = *(const GAS f32x4*)(F.conv_w + t * 2048 + ch + 4); }
    const f32x4 ba = *(const GAS f32x4*)(F.conv_b + ch), bb = *(const GAS f32x4*)(F.conv_b + ch + 4);
    const float sc = ch >= 1024 ? 0.0625f : 1.f;
    constexpr int NLAT = BATCH * 64 * 16, NCTX = BATCH * (CTXL / 4);
    int it0 = gw >> 2, it1 = NLAT + NCTX, its = NGW >> 2;
    if (NW == 252) { const int j = wk - 80; const int lo = wk < 80 ? 8 * wk : 640 + (j < 100 ? 22 * j : 2200 + 21 * (j - 100)); const int len = wk < 80 ? 8 : (j < 100 ? 22 : 21);
        it0 = lo + (F.wave >> 2); it1 = lo + len; its = 2; }
    for (int it = it0; it < it1; it += its) {
        const v4u zero4 = {0u, 0u, 0u, 0u};
        if (it < NLAT) {
            const int b = it >> 10, r = (it >> 4) & 63, c0 = (it & 15) * 4;
            v4u in[3][6];
#pragma unroll
            for (int dr = 0; dr < 3; ++dr)
#pragma unroll
                for (int j = 0; j < 6; ++j) { const int rr = r + dr - 1, cc = c0 + j - 1; const bool ok = rr >= 0 && rr < 64 && cc >= 0 && cc < 64;
                    in[dr][j] = ok ? *(const GAS v4u*)(F.U + (size_t)(b * SEQ + rr * 64 + cc) * NU + C_BQK + ch) : zero4; }
#pragma unroll
            for (int o = 0; o < 4; ++o) {
                float acc[8] = {ba.x, ba.y, ba.z, ba.w, bb.x, bb.y, bb.z, bb.w};
#pragma unroll
                for (int dr = 0; dr < 3; ++dr)
#pragma unroll
                    for (int dc = 0; dc < 3; ++dc) conv_acc8(acc, in[dr][o + dc], wa[dr * 3 + dc], wb[dr * 3 + dc]);
#pragma unroll
                for (int j = 0; j < 8; ++j) acc[j] = silu_fast(acc[j]) * sc;
                v4u ov; ov.x = pk2(acc[0], acc[1]); ov.y = pk2(acc[2], acc[3]); ov.z = pk2(acc[4], acc[5]); ov.w = pk2(acc[6], acc[7]);
                *(GAS v4u*)(QKM + (size_t)(b * SEQ + r * 64 + c0 + o) * DM + ch) = ov;
            }
        } else {
            const int ic = it - NLAT, b = ic >> 6, t0 = (ic & 63) * 4;
            v4u in[6];
#pragma unroll
            for (int j = 0; j < 6; ++j) { const int tt = t0 + j - 1; in[j] = (tt >= 0 && tt < CTXL) ? *(const GAS v4u*)(F.U + (size_t)(MX + b * CTXL + tt) * NU + C_BQK + ch) : zero4; }
#pragma unroll
            for (int o = 0; o < 4; ++o) {
                float acc[8] = {ba.x, ba.y, ba.z, ba.w, bb.x, bb.y, bb.z, bb.w};
#pragma unroll
                for (int dc = 0; dc < 3; ++dc) conv_acc8(acc, in[o + dc], wa[3 + dc], wb[3 + dc]);
#pragma unroll
                for (int j = 0; j < 8; ++j) acc[j] = silu_fast(acc[j]) * sc;
                v4u ov; ov.x = pk2(acc[0], acc[1]); ov.y = pk2(acc[2], acc[3]); ov.z = pk2(acc[4], acc[5]); ov.w = pk2(acc[6], acc[7]);
                *(GAS v4u*)(QKM + (size_t)(MX + b * CTXL + t0 + o) * DM + ch) = ov;
            }
        }
    }
}

__device__ __forceinline__ int scan_row(int b, int dirn, int nb, int i) {
    if (nb < 16) { const int p = nb * 16 + i; const int t = dirn ? (CTXL - 1 - p) : p; return MX + b * CTXL + t; }
    const int p = (nb - 16) * 16 + i; const int t = dirn ? (SEQ - 1 - p) : p; return b * SEQ + t;
}
__device__ __forceinline__ void p4_hgrn2_task(Frame& F, int task) {
    const int vs = task & 3, dirn = (task >> 2) & 1, h = (task >> 3) & 7, b = task >> 6;
    LAS float* Fg = (LAS float*)(F.lds);
    LAS float* Kg = Fg + 2048, *Qg = Kg + 2048;
    LAS float* Vg = Qg + 2048;
    LAS float* LB = Vg + 512;
    LAS float* P = LB + 128;
    const int v = F.tid & 31, kg = F.tid >> 5, k0 = kg * 8;
    const int zcol = (dirn ? C_AFB : C_AFF) + h * HGD;
    __syncthreads();
    if (F.tid < 128) { const int col = h * HGD + F.tid; LB[F.tid] = sigmf(F.hg_lb[(dirn * 2 + 0) * WA + col] - F.hg_lb[(dirn * 2 + 1) * WA + col]); }
    __syncthreads();
    float S[8];
#pragma unroll
    for (int j = 0; j < 8; ++j) S[j] = 0.f;
    bf16* O = dirn ? F.OAB : F.OAF;
#pragma unroll 1
    for (int nb = 0; nb < 16 + 256; ++nb) {
        const bool lat = nb >= 16;
#pragma unroll
        for (int j = 0; j < 4; ++j) { const int e = F.tid + NT * j, i = e >> 7, k = e & 127; const int row = scan_row(b, dirn, nb, i);
            const float z = bf2f(F.U[(size_t)row * NU + zcol + k]); const float lb = LB[k]; const float f = lb + (1.f - lb) * sigmf(z);
            Fg[e] = f; Kg[e] = 1.f - f; Qg[e] = lat ? siluf(bf2f(F.U[(size_t)row * NU + C_AQ + h * HGD + k])) : 0.f; }
        { const int i = F.tid >> 5; const int row = scan_row(b, dirn, nb, i); Vg[F.tid] = bf2f(F.U[(size_t)row * NU + C_AI + h * HGD + vs * 32 + v]); }
        __syncthreads();
#pragma unroll 2
        for (int i = 0; i < 16; ++i) { const float vv = Vg[i * 32 + v]; float a = 0.f;
#pragma unroll
            for (int j = 0; j < 8; ++j) { S[j] = Fg[i * 128 + k0 + j] * S[j] + Kg[i * 128 + k0 + j] * vv; a += S[j] * Qg[i * 128 + k0 + j]; }
            P[(kg * 16 + i) * 32 + v] = a; }
        __syncthreads();
        if (lat) { const int i = F.tid >> 5; float o = 0.f;
#pragma unroll
            for (int g = 0; g < 16; ++g) o += P[(g * 16 + i) * 32 + v];
            const int row = scan_row(b, dirn, nb, i);
            O[(size_t)row * WA + h * HGD + vs * 32 + v] = (bf16)f2bf(o); }
    }
}
__device__ __forceinline__ void p4_mlstm_task(Frame& F, int task) {
    const int vs = task & 7, dirn = (task >> 3) & 1, h = (task >> 4) & 3, b = task >> 6;
    const bf16* QKM = F.XN;
    LAS float* Kb = (LAS float*)(F.lds);
    LAS float* Qb = Kb + 4096;
    LAS float* Vb = Qb + 4096;
    LAS float* LI = Vb + 512, *LF = LI + 16, *EM = LF + 16;
    LAS float* PD = EM + 16;
    LAS float* P = PD + 256;
    const int v = F.tid & 31, kg = F.tid >> 5, k0 = kg * 16;
    float C[16], nn[16]; float m = 0.f;
#pragma unroll
    for (int j = 0; j < 16; ++j) { C[j] = 0.f; nn[j] = 0.f; }
    bf16* O = dirn ? F.HBB : F.HBF;
    const float gbi = F.ml_gate_b[dirn * 4 + h], gbf = F.ml_gate_b[(2 + dirn) * 4 + h];
#pragma unroll 1
    for (int nb = 0; nb < 16 + 256; ++nb) {
        const bool lat = nb >= 16;
        __syncthreads();
#pragma unroll
        for (int j = 0; j < 8; ++j) { const int e = F.tid + NT * j, i = e >> 8, k = e & 255; const int row = scan_row(b, dirn, nb, i);
            Kb[e] = bf2f(QKM[(size_t)row * DM + 1024 + h * MLD + k]); Qb[e] = lat ? bf2f(QKM[(size_t)row * DM + h * MLD + k]) : 0.f; }
        { const int i = F.tid >> 5; const int row = scan_row(b, dirn, nb, i); Vb[F.tid] = bf2f(F.U[(size_t)row * NU + C_BV + h * MLD + vs * 32 + v]); }
        if (F.tid < 16) { const int row = scan_row(b, dirn, nb, F.tid);
            const float gi = bf2f(F.U[(size_t)row * NU + C_BG + dirn * 4 + h]) + gbi, gf = bf2f(F.U[(size_t)row * NU + C_BG + (2 + dirn) * 4 + h]) + gbf;
            LI[F.tid] = gi; LF[F.tid] = gf > 0.f ? -log1pf(__expf(-gf)) : gf - log1pf(__expf(gf)); }
        __syncthreads();
#pragma unroll 2
        for (int i = 0; i < 16; ++i) {
            const float lf = LF[i], li = LI[i]; const float mn = fmaxf(lf + m, li); const float fd = __expf(lf + m - mn), iw = __expf(li - mn); m = mn;
            if (F.tid == 0) EM[i] = __expf(-m);
            const float vv = iw * Vb[i * 32 + v]; float a = 0.f, d = 0.f;
#pragma unroll
            for (int j = 0; j < 16; ++j) { const float kk = Kb[i * 256 + k0 + j], qq = Qb[i * 256 + k0 + j];
                C[j] = fd * C[j] + vv * kk; nn[j] = fd * nn[j] + iw * kk; a += C[j] * qq; d += nn[j] * qq; }
            P[(kg * 16 + i) * 32 + v] = a; if (v == 0) PD[kg * 16 + i] = d; }
        __syncthreads();
        if (lat) { const int i = F.tid >> 5; float num = 0.f, den = 0.f;
#pragma unroll
            for (int g = 0; g < 16; ++g) { num += P[(g * 16 + i) * 32 + v]; den += PD[g * 16 + i]; }
            const int row = scan_row(b, dirn, nb, i);
            O[(size_t)row * WB + h * MLD + vs * 32 + v] = (bf16)f2bf(num / fmaxf(fabsf(den), EM[i])); }
    }
}
__device__ __forceinline__ void p4_scan_naive(Frame& F) {
    for (int task = F.vcu; task < 512; task += F.G) { if (task < 256) p4_hgrn2_task(F, task); else p4_mlstm_task(F, task - 256); }
}

constexpr int NCHUNK = MALL / 64;
__device__ __forceinline__ void gate_fk(float z, float lb, float& f, float& kk) {
    const float e = __expf(-fabsf(z)); const float rb = 1.f / (1.f + e), rs = e * rb;
    const float sg = z >= 0.f ? rb : rs, sn = z >= 0.f ? rs : rb;
    f = lb + (1.f - lb) * sg; kk = (1.f - lb) * sn;
}
template <int DIR>
__device__ __forceinline__ float hg_walk(LAS unsigned char* L, int cl, float lb, float olb, unsigned (&qb)[32]) {
    constexpr int TQ = 0, TZF = 32768, TZB = 65536, TQF = 98304;
    LAS unsigned short* zt = (LAS unsigned short*)(L + (DIR ? TZB : TZF)) + cl;
    const LAS unsigned short* qtile = (const LAS unsigned short*)(L + TQ) + cl;
    LAS unsigned short* qf = (LAS unsigned short*)(L + TQF) + cl;
    float P = 1.f;
#pragma unroll
    for (int blk = 0; blk < 4; ++blk) {
        unsigned short zr[16], qr[16];
#pragma unroll
        for (int j = 0; j < 16; ++j) { const int pp = blk * 16 + j, p = DIR ? 63 - pp : pp; zr[j] = zt[p * 256]; qr[j] = qtile[p * 256]; }
#pragma unroll
        for (int j = 0; j < 16; ++j) { const int pp = blk * 16 + j, p = DIR ? 63 - pp : pp;
            const float z = bf2f(zr[j]), q = bf2f(qr[j]);
            const float e = __expf(-fabsf(z)); const float rbig = rcpf_(1.f + e), rsm = e * rbig;
            const float sg = z >= 0.f ? rbig : rsm, sn = z >= 0.f ? rsm : rbig;
            const float f = lb + olb * sg, kk = olb * sn; P *= f;
            const float qt = q * P, kt = kk * rcpf_(P);
            zt[p * 256] = (unsigned short)(pkbf(kt, 0.f) & 0xffffu);
            const unsigned qh = pkbf(qt, 0.f) & 0xffffu;
            if (DIR) { if (pp & 1) qb[pp >> 1] |= qh << 16; else qb[pp >> 1] = qh; } else qf[p * 256] = (unsigned short)qh; }
    }
    return P;
}
template <bool DUMMY>
__device__ __forceinline__ void p3_hg_prep(Frame& F) {
    bf16* dq = F.OAF; bf16* dkf = F.OAB; bf16* dkb = F.HBF;
    LAS unsigned char* L = F.lds;
    constexpr int TQ = 0, TZF = 32768, TZB = 65536, TQF = 98304;
    const int tid = F.tid, dirn = F.wave >> 2, cl = tid & 255;
    if (F.G > 2 * NSC && F.vcu < NSC) return;
    const int wk = F.G > 2 * NSC ? F.vcu - NSC : F.vcu, NW = F.G > 2 * NSC ? F.G - NSC : F.G;
    v4u pre[3][4];
    auto issue = [&](int it) { const int cid = it >> 2, cb = (it & 3) * 256; const size_t row0 = (size_t)cid * 64;
#pragma unroll
        for (int i = 0; i < 4; ++i) { const int piece = tid + NT * i, row = piece >> 5, c16 = piece & 31; const bf16* ur = F.U + (row0 + row) * NU + cb + c16 * 8;
            pre[0][i] = *(const GAS v4u*)(ur + C_AQ); pre[1][i] = *(const GAS v4u*)(ur + C_AFF); pre[2][i] = *(const GAS v4u*)(ur + C_AFB); } };
    int it = wk;
    if (it < NCHUNK * 4) issue(it);
    for (; it < NCHUNK * 4; it += NW) {
        const int cid = it >> 2, cb = (it & 3) * 256; const size_t row0 = (size_t)cid * 64;
        __syncthreads();
#pragma unroll
        for (int i = 0; i < 4; ++i) { const int piece = tid + NT * i; *(LAS v4u*)(L + TQ + piece * 16) = pre[0][i]; *(LAS v4u*)(L + TZF + piece * 16) = pre[1][i]; *(LAS v4u*)(L + TZB + piece * 16) = pre[2][i]; }
        __syncthreads();
        if (it + NW < NCHUNK * 4) issue(it + NW);
        const int c = cb + cl;
        const float lb = sigmf(F.hg_lb[(dirn * 2) * WA + c] - F.hg_lb[(dirn * 2 + 1) * WA + c]), olb = 1.f - lb;
        unsigned qb[32]; float P;
        if (dirn) P = hg_walk<1>(L, cl, lb, olb, qb); else P = hg_walk<0>(L, cl, lb, olb, qb);
        F.PE[(size_t)(dirn * NCHUNK + cid) * WA + c] = P;
        __syncthreads();
        if (dirn) {
            LAS unsigned short* qw = (LAS unsigned short*)(L + TQ) + cl;
#pragma unroll
            for (int pp = 0; pp < 64; ++pp) qw[(63 - pp) * 256] = (unsigned short)((pp & 1) ? (qb[pp >> 1] >> 16) : (qb[pp >> 1] & 0xffffu));
        }
        __syncthreads();
#pragma unroll
        for (int i = 0; i < 4; ++i) { const int piece = tid + NT * i, row = piece >> 5, c16 = piece & 31; const size_t r = row0 + row; bf16* ur = F.U + r * NU + cb + c16 * 8;
            const v4u vq = *(const LAS v4u*)(L + TQ + piece * 16), vf = *(const LAS v4u*)(L + TZF + piece * 16), vb = *(const LAS v4u*)(L + TZB + piece * 16), vqf = *(const LAS v4u*)(L + TQF + piece * 16);
            *(GAS v4u*)(F.QTF + r * WA + cb + c16 * 8) = vqf;
            if (DUMMY) { if (r < MX) { *(GAS v4u*)(dq + r * WA + cb + c16 * 8) = vq; *(GAS v4u*)(dkf + r * WA + cb + c16 * 8) = vf; *(GAS v4u*)(dkb + r * WA + cb + c16 * 8) = vb; } }
            else { *(GAS v4u*)(ur + C_AQ) = vq; *(GAS v4u*)(ur + C_AFF) = vf; *(GAS v4u*)(ur + C_AFB) = vb; } }
    }
    __syncthreads();
}
template <int CTRL, int RM> __device__ __forceinline__ float dpp_f(float idv, float x) { return __builtin_bit_cast(float, __builtin_amdgcn_update_dpp(__builtin_bit_cast(int, idv), __builtin_bit_cast(int, x), CTRL, RM, 0xf, false)); }
__device__ __forceinline__ float wave_scan_add(float x) {
    x += dpp_f<0x111, 0xf>(0.f, x); x += dpp_f<0x112, 0xf>(0.f, x); x += dpp_f<0x114, 0xf>(0.f, x); x += dpp_f<0x118, 0xf>(0.f, x);
    x += dpp_f<0x142, 0xa>(0.f, x); x += dpp_f<0x143, 0xc>(0.f, x); return x; }
__device__ __forceinline__ float wave_scan_max(float x) { const float ni = -__builtin_inff();
    x = fmaxf(x, dpp_f<0x111, 0xf>(ni, x)); x = fmaxf(x, dpp_f<0x112, 0xf>(ni, x)); x = fmaxf(x, dpp_f<0x114, 0xf>(ni, x)); x = fmaxf(x, dpp_f<0x118, 0xf>(ni, x));
    x = fmaxf(x, dpp_f<0x142, 0xa>(ni, x)); x = fmaxf(x, dpp_f<0x143, 0xc>(ni, x)); return x; }
__device__ __forceinline__ void p3_ml_scalars(Frame& F) {
    const int gw = F.vcu * NWAVES + F.wave;
    if (gw >= 32) return;
    const int dirn = gw & 1, h = (gw >> 1) & 3, b = gw >> 3;
    const float gbi = F.ml_gate_b[dirn * 4 + h], gbf = F.ml_gate_b[(2 + dirn) * 4 + h];
    float m0 = 0.f;
    float* mls = F.MLS + (size_t)(dirn * 4 + h) * MALL * 8;
    auto row_of = [&](int n) -> int { int row0; if (n < 4) { const int cc = dirn ? 3 - n : n; row0 = MX + b * CTXL + cc * 64; } else { const int lc = dirn ? 67 - n : n - 4; row0 = b * SEQ + lc * 64; }
        return row0 + (dirn ? 63 - F.lane : F.lane); };
    unsigned short gi_r[8], gf_r[8];
#pragma unroll
    for (int j = 0; j < 8; ++j) { const int row = row_of(j); gi_r[j] = F.U[(size_t)row * NU + C_BG + dirn * 4 + h]; gf_r[j] = F.U[(size_t)row * NU + C_BG + (2 + dirn) * 4 + h]; }
#pragma unroll 1
    for (int nb = 0; nb < 72; nb += 8) {
#pragma unroll
        for (int j = 0; j < 8; ++j) {
            const int n = nb + j;
            if (n < 68) {
                const int row = row_of(n);
                const float gi = bf2f(gi_r[j]) + gbi, gf = bf2f(gf_r[j]) + gbf;
                if (n + 8 < 68) { const int r2 = row_of(n + 8); gi_r[j] = F.U[(size_t)r2 * NU + C_BG + dirn * 4 + h]; gf_r[j] = F.U[(size_t)r2 * NU + C_BG + (2 + dirn) * 4 + h]; }
                const float lf = fminf(gf, 0.f) - __logf(1.f + __expf(-fabsf(gf)));
                const float cs = wave_scan_add(lf);
                const float a = gi - cs; const float cm = wave_scan_max(a);
                const float mx = fmaxf(m0, cm), m63 = __shfl(mx, 63), cs63 = __shfl(cs, 63);
                f32x4 o0; o0.x = a; o0.y = mx; o0.z = __expf(m0 - mx); o0.w = __expf(a - m63);
                f32x4 o1; o1.x = __expf(-(cs + mx)); o1.y = 0.f; o1.z = __expf(m0 - m63); o1.w = 0.f;
                *(f32x4*)(mls + (size_t)row * 8) = o0; *(f32x4*)(mls + (size_t)row * 8 + 4) = o1;
                const int row0 = row - (dirn ? 63 - F.lane : F.lane);
                if (F.lane == 0) F.DEC[(dirn * 4 + h) * NCHUNK + (row0 >> 6)] = __expf(m0 - m63);
                m0 = cs63 + m63;
            }
        }
    }
}

typedef short s16x4 __attribute__((ext_vector_type(4)));
typedef float f32x16 __attribute__((ext_vector_type(16)));
#define MFMA32(a, b, c) __builtin_amdgcn_mfma_f32_32x32x16_bf16((a), (b), (c), 0, 0, 0)
__device__ __forceinline__ bf16x8 pk8(float a0, float a1, float a2, float a3, float a4, float a5, float a6, float a7) {
    const v4u u = {pkbf(a0, a1), pkbf(a2, a3), pkbf(a4, a5), pkbf(a6, a7)}; return __builtin_bit_cast(bf16x8, u); }
__device__ __forceinline__ bf16x8 cat4(s16x4 lo, s16x4 hi) { return __builtin_shufflevector(lo, hi, 0, 1, 2, 3, 4, 5, 6, 7); }
__device__ __forceinline__ s16x4 lds_tr(LAS unsigned char* p) { return __builtin_amdgcn_ds_read_tr16_b64_v4i16((LAS s16x4*)p); }
__device__ __forceinline__ unsigned img_off_a(unsigned row, unsigned ch) { return 2048u * (row >> 3) + 512u * (ch >> 2) + 64u * (row & 7) + 16u * ((ch & 3) ^ ((row >> 2) & 3)); }
__device__ __forceinline__ unsigned img_addr(unsigned row, unsigned ch, unsigned ncb) { return ((row >> 5) * ncb + (ch >> 4)) * 8192u + img_off_a(row & 31, ch & 15); }
__device__ __forceinline__ unsigned v_addr(unsigned row, unsigned ch) { const unsigned r = row & 31; return (row >> 5) * 4096u + 1024u * (r >> 3) + 512u * (ch >> 2) + 64u * (r & 7) + 16u * ((ch & 3) ^ ((r >> 2) & 3)); }

constexpr int SL_QT = 0, SL_KT = 32768, SL_V = 65536, SL_VW = 73728, SL_SF = 81920, SL_XCH = 114688, SL_SC = 131072, SL_W = 144384;
constexpr int SC_PAR = 448, SC_DQW = 896, SC_N0 = 1024, SC_NP = 1280;


__device__ __forceinline__ void p3b_ml_scores(Frame& F) {
    LAS unsigned char* L = F.lds;
    constexpr int BQ = 0, BK = 32768, BX = 65536, BS = 98304;
    LAS float* SCA = (LAS float*)(L + BS);
    const int tid = F.tid, lane = F.lane, w = F.wave, ts = w & 1, tp = (w >> 1) & 1, kh = w >> 2;
    const unsigned hh = lane >> 5, x4 = (lane >> 2) & 3;
    const unsigned LB0 = 2048u * ((lane >> 3) & 3) + 64u * (lane & 7);
    unsigned LBx[2];
#pragma unroll
    for (int e = 0; e < 2; ++e) LBx[e] = LB0 + 16u * ((2u * e + hh) ^ x4) + kh * 8192u;
    v4u pq[4], pk[4]; f32x2_t psc;
    auto issue = [&](int it) { const int lc = it & 63, h = (it >> 6) & 3, b = it >> 8; const size_t row0 = (size_t)b * SEQ + lc * 64;
        int tv = F.tid; asm volatile("" : "+v"(tv));
#pragma unroll
        for (int i = 0; i < 4; ++i) { const int u = ((tv >> 6) + 8 * i) * 8 + ((tv & 63) >> 3), row = 2 * (u >> 3) + ((tv >> 2) & 1), ch = 4 * (u & 7) + (tv & 3);
            pq[i] = *(const GAS v4u*)(F.XN + (row0 + row) * DM + h * MLD + ch * 8); pk[i] = *(const GAS v4u*)(F.XN + (row0 + row) * DM + WB + h * MLD + ch * 8); }
        if (tv < 128) psc = *(const GAS f32x2_t*)(F.MLS + ((size_t)((tv >> 6) * 4 + h) * MALL + row0 + (tv & 63)) * 8); };
    int it = F.vcu;
    if (it < 1024) issue(it);
    for (; it < 1024; it += F.G) {
        const int lc = it & 63, h = (it >> 6) & 3, b = it >> 8; const size_t row0 = (size_t)b * SEQ + lc * 64;
        __syncthreads();
        { int tv = F.tid; asm volatile("" : "+v"(tv));
#pragma unroll
          for (int i = 0; i < 4; ++i) { const int u = ((tv >> 6) + 8 * i) * 8 + ((tv & 63) >> 3), row = 2 * (u >> 3) + ((tv >> 2) & 1), ch = 4 * (u & 7) + (tv & 3); const unsigned a = img_addr(row, ch, 2); *(LAS v4u*)(L + BQ + a) = pq[i]; *(LAS v4u*)(L + BK + a) = pk[i]; }
          if (tv < 128) { SCA[(tv >> 6) * 128 + (tv & 63)] = psc.x; SCA[(tv >> 6) * 128 + 64 + (tv & 63)] = psc.y; } }
        __syncthreads();
        if (it + F.G < 1024) issue(it + F.G);
        f32x16 c;
#pragma unroll
        for (int r = 0; r < 16; ++r) c[r] = 0.f;
#pragma unroll
        for (int s = 0; s < 8; ++s) {
            const bf16x8 a = *(const LAS bf16x8*)(L + BK + ts * 16384 + 512 * (s >> 1) + LBx[s & 1]);
            const bf16x8 bq = *(const LAS bf16x8*)(L + BQ + tp * 16384 + 512 * (s >> 1) + LBx[s & 1]);
            c = MFMA32(a, bq, c);
        }
#pragma unroll
        for (int r = 0; r < 16; ++r) *(LAS float*)(L + BX + (((kh * 4 + ts * 2 + tp) * 16 + r) * 64 + lane) * 4) = c[r];
        __syncthreads();
#pragma unroll
        for (int r = 0; r < 16; ++r) c[r] += *(const LAS float*)(L + BX + ((((1 - kh) * 4 + ts * 2 + tp) * 16 + r) * 64 + lane) * 4);
        const int dirn = kh;
        const bool need = dirn ? (ts >= tp) : (ts <= tp);
        const float mxp = SCA[dirn * 128 + 64 + 32 * tp + (lane & 31)];
        int dl = (lane & 31) - 4 * (int)hh; if (dirn) dl = -dl; asm volatile("" : "+v"(dl));
        const int sg1 = dirn ? -1 : 1; const bool diag = ts == tp;
        float rs = 0.f;
        bf16* wout = F.MLW + ((size_t)((dirn * 4 + h) * 256 + (int)(row0 >> 6)) * 4096) + (32 * tp + (lane & 31)) * 64 + 32 * ts + 4 * hh;
#pragma unroll
        for (int g = 0; g < 4; ++g) {
            const f32x4 av = *(const LAS f32x4*)(SCA + dirn * 128 + 32 * ts + 8 * g + 4 * hh);
            float wv[4];
#pragma unroll
            for (int j = 0; j < 4; ++j) { float v = need ? c[4 * g + j] * __expf(av[j] - mxp) : 0.f;
                if (diag) v = (dl - sg1 * (j + 8 * g) >= 0) ? v : 0.f;
                wv[j] = v; rs += v; }
            *(GAS unsigned long long*)(wout + 8 * g) = (unsigned long long)pkbf(wv[0], wv[1]) | ((unsigned long long)pkbf(wv[2], wv[3]) << 32);
        }
        rs += __shfl_xor(rs, 32);
        if (lane < 32) SCA[256 + (dirn * 2 + ts) * 64 + 32 * tp + lane] = rs;
        __syncthreads();
        if (tid < 128) { const int d = tid >> 6, p = tid & 63; F.MLS[((size_t)(d * 4 + h) * MALL + row0 + p) * 8 + 5] = SCA[256 + (d * 2) * 64 + p] + SCA[256 + (d * 2 + 1) * 64 + p]; }
    }
    __syncthreads();
}

template <bool ML, int SKIP = 0>
__device__ __forceinline__ void scan_task(Frame& F, int task) {
    constexpr int NKT = ML ? 8 : 4, NCB = NKT / 4, NKH = NKT / 2, NOWN = NKT / 4, NPQ = ML ? 4 : 2, DKK = 32 * NKT;
    int vs, dirn, h, b;
    if (ML) { vs = task & 3; dirn = (task >> 2) & 1; h = (task >> 3) & 3; b = task >> 5; } else { vs = task & 1; dirn = (task >> 1) & 1; h = (task >> 2) & 7; b = task >> 5; }
    const int lane = F.lane, w = F.wave, tid = F.tid; const int tp = (w >> 2) & 1, tj = (w >> 1) & 1, kh = w & 1;
    const unsigned hh = lane >> 5, q4 = (lane & 15) >> 2, p4 = lane & 3, blk = (lane >> 4) & 1, x4 = (lane >> 2) & 3;
    LAS unsigned char* L = F.lds;
    LAS float* SC = (LAS float*)(L + SL_SC);
    const unsigned LB0 = 2048u * ((lane >> 3) & 3) + 64u * (lane & 7);
    const unsigned khoff = ML ? kh * 8192u : kh * 1024u;
    unsigned LBx[2], LK[2][2], TRK[2], VK[2], VN[2], WL[2];
#pragma unroll
    for (int e = 0; e < 2; ++e) { LBx[e] = LB0 + 16u * ((2u * e + hh) ^ x4) + khoff; WL[e] = 1024u * ((lane >> 3) & 3) + 64u * (lane & 7) + 16u * ((2u * e + hh) ^ x4);
#pragma unroll
        for (int t = 0; t < 2; ++t) LK[e][t] = LB0 + 16u * ((2u * e + t) ^ x4) + 8u * hh + khoff; }
#pragma unroll
    for (int t = 0; t < 2; ++t) {
        TRK[t] = 2048u * hh + 64u * q4 + 8u * (p4 & 1) + 16u * ((2u * blk + (p4 >> 1)) ^ (2u * hh + t));
        VK[t] = 64u * (4u * hh + q4) + 8u * (p4 & 1) + 16u * ((2u * blk + (p4 >> 1)) ^ (2u * t + hh)) + 512u * tj;
        VN[t] = 1024u * hh + 64u * q4 + 8u * (p4 & 1) + 512u * tj + 16u * ((2u * blk + (p4 >> 1)) ^ (2u * hh + t)); }
    unsigned tkoff[NOWN];
#pragma unroll
    for (int i = 0; i < NOWN; ++i) { const unsigned tk = kh * NKH + tp * NOWN + i; tkoff[i] = (tk >> 2) * 8192u + 512u * (tk & 3); }
    const bf16 *gq, *gk, *gv; int sq, sk; bf16* go;
    if (ML) { gq = F.XN + h * MLD; gk = F.XN + WB + h * MLD; sq = DM; sk = DM; gv = F.U + C_BV + h * MLD + vs * 64; go = (dirn ? F.HBB : F.HBF) + h * MLD + vs * 64; }
    else { if (dirn) { gq = F.U + C_AQ + h * HGD; sq = NU; gk = F.U + C_AFB + h * HGD; } else { gq = F.QTF + h * HGD; sq = WA; gk = F.U + C_AFF + h * HGD; }
        sk = NU; gv = F.U + C_AI + h * HGD + vs * 64; go = (dirn ? F.OAB : F.OAF) + h * HGD + vs * 64; }
    const float* mls = F.MLS + (size_t)(dirn * 4 + h) * MALL * 8;
    const float* pev = F.PE + (size_t)dirn * NCHUNK * WA + h * HGD;
    f32x16 S[NOWN];
#pragma unroll
    for (int i = 0; i < NOWN; ++i)
#pragma unroll
        for (int r = 0; r < 16; ++r) S[i][r] = 0.f;
    v4u pq[NPQ], pk[NPQ], pv, pw; f32x4 ps0, ps1; float pws;
    const bf16* gw_ = F.MLW + (size_t)(dirn * 4 + h) * 256 * 4096;
    auto row0_of = [&](int n) -> int { if (n < 4) { const int cc = dirn ? 3 - n : n; return MX + b * CTXL + cc * 64; } const int lc = dirn ? 67 - n : n - 4; return b * SEQ + lc * 64; };
    int offq[NPQ], offk[NPQ]; unsigned aimg[NPQ];
#pragma unroll
    for (int i = 0; i < NPQ; ++i) { const int u = (w + 8 * i) * 8 + (lane >> 3), NB = NCB * 4, row = 2 * (u / NB) + ((lane >> 2) & 1), ch = 4 * (u % NB) + (lane & 3);
        offq[i] = row * sq + ch * 8; offk[i] = row * sk + ch * 8; aimg[i] = img_addr(row, ch, NCB); }
    const int vu = w * 8 + (lane >> 3), vrow = 2 * (vu >> 1) + ((lane >> 2) & 1), vch = 4 * (vu & 1) + (lane & 3);
    const int offv = vrow * NU + vch * 8, offw = vrow * 64 + vch * 8; const unsigned va = v_addr(vrow, vch);
    auto issue_loads = [&](int n) {
        const int row0 = row0_of(n);
        const bf16* bq_ = gq + (size_t)row0 * sq; const bf16* bk_ = gk + (size_t)row0 * sk;
#pragma unroll
        for (int i = 0; i < NPQ; ++i) { pq[i] = *(const GAS v4u*)(bq_ + offq[i]); pk[i] = *(const GAS v4u*)(bk_ + offk[i]); }
        pv = *(const GAS v4u*)(gv + (size_t)row0 * NU + offv);
        if (ML) { pws = mls[(size_t)(row0 + vrow) * 8 + 3];
            if (n >= 4) pw = *(const GAS v4u*)(gw_ + (size_t)(row0 >> 6) * 4096 + offw);
            if (tid < 64) { ps0 = *(const GAS f32x4*)(mls + (size_t)(row0 + tid) * 8); ps1 = *(const GAS f32x4*)(mls + (size_t)(row0 + tid) * 8 + 4); } }
        else { if (tid < 32) ps0 = *(const GAS f32x4*)(pev + (size_t)(row0 >> 6) * WA + tid * 4); }
    };
    unsigned tch0 = 0u, tch1 = 0u, tdummy = 0u;
    auto touch = [&](int n) {
        const int row0 = row0_of(n);
        if (ML) { const int ln = tid & 255; const bf16* bp = (tid < 256 ? gq + (size_t)row0 * sq : gk + (size_t)row0 * sk) + (size_t)(ln >> 2) * DM + (ln & 3) * 64;
            tch0 = *(const GAS unsigned*)bp;
            if (tid < 64) tch1 = *(const GAS unsigned*)(gv + (size_t)(row0 + tid) * NU);
            else if (tid < 128 && n >= 4) tch1 = *(const GAS unsigned*)(gw_ + (size_t)(row0 >> 6) * 4096 + (tid - 64) * 64); }
        else { if (tid < 256) { const int ln = tid & 127; tch0 = *(const GAS unsigned*)((tid < 128 ? gq + (size_t)(row0 + (ln >> 1)) * sq : gk + (size_t)(row0 + (ln >> 1)) * sk) + (ln & 1) * 64); }
            else if (tid < 320) tch0 = *(const GAS unsigned*)(gv + (size_t)(row0 + tid - 256) * NU); }
    };
    auto store_images = [&](int n) {
#pragma unroll
        for (int i = 0; i < NPQ; ++i) { *(LAS v4u*)(L + SL_QT + aimg[i]) = pq[i]; *(LAS v4u*)(L + SL_KT + aimg[i]) = pk[i]; }
        *(LAS v4u*)(L + SL_V + va) = pv;
        if (!ML && tid < 32) *(LAS f32x4*)(SC + (n & 1) * SC_PAR + tid * 4) = ps0;
        if (ML) { v4u o; o.x = pkbf(lo2f(pv.x) * pws, hi2f(pv.x) * pws); o.y = pkbf(lo2f(pv.y) * pws, hi2f(pv.y) * pws); o.z = pkbf(lo2f(pv.z) * pws, hi2f(pv.z) * pws); o.w = pkbf(lo2f(pv.w) * pws, hi2f(pv.w) * pws);
            *(LAS v4u*)(L + SL_VW + va) = o;
            if (n >= 4) *(LAS v4u*)(L + SL_W + va) = pw;
            if (tid < 64) { LAS float* sp = SC + (n & 1) * SC_PAR + tid; sp[0] = ps0.x; sp[64] = ps0.y; sp[128] = ps0.z; sp[192] = ps0.w; sp[256] = ps1.x; sp[320] = ps1.y; sp[384] = ps1.z; SC[896 + tid] = ps1.w; } }
    };
    __syncthreads();
    issue_loads(0);
    for (int e = tid; e < 32768 / 16; e += NT) *(LAS v4u*)(L + SL_SF + e * 16) = (v4u){0u, 0u, 0u, 0u};
    store_images(0);
    __syncthreads();
#pragma unroll 1
    for (int n = 0; n < 68; ++n) {
        const bool lat = n >= 4; const int row0 = row0_of(n); const int cid = row0 >> 6;
        if (n + 1 < 68 && !(SKIP & 16)) issue_loads(n + 1);
        LAS float* SP = SC + (n & 1) * SC_PAR;
        float dec = 1.f; f32x4 pe[NOWN][4];
        if (ML) dec = SP[384];
        else {
#pragma unroll
            for (int i = 0; i < NOWN; ++i)
#pragma unroll
                for (int g = 0; g < 4; ++g) pe[i][g] = *(const LAS f32x4*)(SP + 32 * (kh * NKH + tp * NOWN + i) + 8 * g + 4 * hh);
        }
        f32x16 o;
        if (lat && !(SKIP & 4)) {
            f32x16 acc_o, acc_i;
#pragma unroll
            for (int r = 0; r < 16; ++r) { acc_o[r] = 0.f; acc_i[r] = 0.f; }
            if (ML) {
                if (kh == 0) {
#pragma unroll
                    for (int ts = 0; ts < 2; ++ts) {
                        const bool need = dirn ? (ts >= tp) : (ts <= tp);
                        if (need) {
                            const bf16x8 a0 = *(const LAS bf16x8*)(L + SL_W + tp * 4096 + 512 * ts + WL[0]), a1 = *(const LAS bf16x8*)(L + SL_W + tp * 4096 + 512 * ts + WL[1]);
                            const s16x4 lo0 = lds_tr(L + SL_V + ts * 4096 + VN[0]), hi0 = lds_tr(L + SL_V + ts * 4096 + 256 + VN[1]);
                            const s16x4 lo1 = lds_tr(L + SL_V + ts * 4096 + 2048 + VN[0]), hi1 = lds_tr(L + SL_V + ts * 4096 + 2048 + 256 + VN[1]);
                            acc_o = MFMA32(a0, cat4(lo0, hi0), acc_o);
                            acc_o = MFMA32(a1, cat4(lo1, hi1), acc_o);
                        }
                    }
                }
            } else
#pragma unroll
            for (int ts = 0; ts < 2; ++ts) {
                const bool need = dirn ? (ts >= tp) : (ts <= tp);
                if (need) {
                    f32x16 c;
#pragma unroll
                    for (int r = 0; r < 16; ++r) c[r] = 0.f;
                    {
                        bf16x8 a_c = *(const LAS bf16x8*)(L + SL_KT + ts * NCB * 8192 + LBx[0]), b_c = *(const LAS bf16x8*)(L + SL_QT + tp * NCB * 8192 + LBx[0]), a_n = a_c, b_n = b_c;
#pragma unroll
                        for (int s = 0; s < NKT; ++s) {
                            if (s + 1 < NKT) { a_n = *(const LAS bf16x8*)(L + SL_KT + ts * NCB * 8192 + 512 * ((s + 1) >> 1) + LBx[(s + 1) & 1]); b_n = *(const LAS bf16x8*)(L + SL_QT + tp * NCB * 8192 + 512 * ((s + 1) >> 1) + LBx[(s + 1) & 1]); }
                            c = MFMA32(a_c, b_c, c);
                            a_c = a_n; b_c = b_n;
                        }
                    }
                    const s16x4 vlo0 = lds_tr(L + SL_V + ts * 4096 + VK[0]), vhi0 = lds_tr(L + SL_V + ts * 4096 + 1024 + VK[1]);
                    const s16x4 vlo1 = lds_tr(L + SL_V + ts * 4096 + 2048 + VK[0]), vhi1 = lds_tr(L + SL_V + ts * 4096 + 3072 + VK[1]);
                    int dl = (lane & 31) - 4 * (int)hh; if (dirn) dl = -dl; asm volatile("" : "+v"(dl));
                    const int sg1 = dirn ? -1 : 1; const bool diag = ts == tp;
#pragma unroll
                    for (int r = 0; r < 16; ++r) { const int ro = (r & 3) + 8 * (r >> 2);
                        float wv = c[r];
                        if (diag) wv = (dl - sg1 * ro >= 0) ? wv : 0.f;
                        c[r] = wv; }
                    acc_o = MFMA32(pk8(c[0], c[1], c[2], c[3], c[4], c[5], c[6], c[7]), cat4(vlo0, vhi0), acc_o);
                    acc_o = MFMA32(pk8(c[8], c[9], c[10], c[11], c[12], c[13], c[14], c[15]), cat4(vlo1, vhi1), acc_o);
                }
            }
            {
#define LD_INTER(i_, LO_, HI_, SF_) do { LO_ = *(const LAS s16x4*)(L + SL_QT + tp * NCB * 8192 + 512 * ((i_) >> 1) + LK[(i_) & 1][0]); HI_ = *(const LAS s16x4*)(L + SL_QT + tp * NCB * 8192 + 512 * ((i_) >> 1) + LK[(i_) & 1][1]); \
                SF_ = *(const LAS bf16x8*)(L + SL_SF + ((((kh * NKH + ((i_) >> 1)) * 2 + tj) * 2 + ((i_) & 1)) * 1024) + lane * 16); } while (0)
                s16x4 lo_c, hi_c, lo_n, hi_n; bf16x8 sf_c, sf_n;
                LD_INTER(0, lo_c, hi_c, sf_c); lo_n = lo_c; hi_n = hi_c; sf_n = sf_c;
#pragma unroll
                for (int i = 0; i < 2 * NKH; ++i) {
                    if (i + 1 < 2 * NKH) LD_INTER(i + 1, lo_n, hi_n, sf_n);
                    acc_i = MFMA32(cat4(lo_c, hi_c), sf_c, acc_i);
                    lo_c = lo_n; hi_c = hi_n; sf_c = sf_n;
                }
#undef LD_INTER
            }
            if (ML) {
                f32x4 wi[4];
#pragma unroll
                for (int g = 0; g < 4; ++g) wi[g] = *(const LAS f32x4*)(SP + 128 + 32 * tp + 8 * g + 4 * hh);
#pragma unroll
                for (int r = 0; r < 16; ++r) o[r] = acc_o[r] + wi[r >> 2][r & 3] * acc_i[r];
            } else {
#pragma unroll
                for (int r = 0; r < 16; ++r) o[r] = acc_o[r] + acc_i[r];
            }
            {
#pragma unroll
                for (int r = 0; r < 8; ++r) { const int rr = kh ? r : r + 8; *(LAS float*)(L + SL_XCH + (((tp * 2 + tj) * 16 + rr) * 64 + lane) * 4) = kh ? o[r] : o[r + 8]; }
            }
        }
        {
            if (ML) {
#pragma unroll
                for (int i = 0; i < NOWN; ++i)
#pragma unroll
                    for (int r = 0; r < 16; ++r) S[i][r] *= dec;
            }
#define LD_GA(ks_, i_, LO_, HI_) do { LO_ = lds_tr(L + SL_KT + ((ks_) >> 1) * NCB * 8192 + 4096 * ((ks_) & 1) + tkoff[i_] + TRK[0]); HI_ = lds_tr(L + SL_KT + ((ks_) >> 1) * NCB * 8192 + 4096 * ((ks_) & 1) + 256 + tkoff[i_] + TRK[1]); } while (0)
#define LD_GB(ks_, LO_, HI_) do { LO_ = lds_tr(L + (ML ? SL_VW : SL_V) + ((ks_) >> 1) * 4096 + 2048 * ((ks_) & 1) + VN[0]); HI_ = lds_tr(L + (ML ? SL_VW : SL_V) + ((ks_) >> 1) * 4096 + 2048 * ((ks_) & 1) + 256 + VN[1]); } while (0)
            s16x4 alo_c, ahi_c, blo_c, bhi_c, alo_n, ahi_n, blo_n, bhi_n;
            LD_GB(0, blo_c, bhi_c); LD_GA(0, 0, alo_c, ahi_c); alo_n = alo_c; ahi_n = ahi_c; blo_n = blo_c; bhi_n = bhi_c;
            constexpr int NG = (SKIP & 8) ? 0 : 4 * NOWN;
#pragma unroll
            for (int j = 0; j < NG; ++j) {
                const int ks = j / NOWN, i = j % NOWN, ks1 = (j + 1) / NOWN, i1 = (j + 1) % NOWN;
                if (j + 1 < NG) { LD_GA(ks1, i1, alo_n, ahi_n); if (i1 == 0) LD_GB(ks1, blo_n, bhi_n); }
                S[i] = MFMA32(cat4(alo_c, ahi_c), cat4(blo_c, bhi_c), S[i]);
                alo_c = alo_n; ahi_c = ahi_n; if (i1 == 0) { blo_c = blo_n; bhi_c = bhi_n; }
                (void)ks;
            }
#undef LD_GA
#undef LD_GB
            if (!ML) {
#pragma unroll
                for (int i = 0; i < NOWN; ++i)
#pragma unroll
                    for (int r = 0; r < 16; ++r) S[i][r] *= pe[i][r >> 2][r & 3];
            }
        }
        __syncthreads();
#pragma unroll
        for (int i = 0; i < NOWN; ++i)
#pragma unroll
            for (int st = 0; st < 2; ++st) {
                const bf16x8 f8 = pk8(S[i][8 * st], S[i][8 * st + 1], S[i][8 * st + 2], S[i][8 * st + 3], S[i][8 * st + 4], S[i][8 * st + 5], S[i][8 * st + 6], S[i][8 * st + 7]);
                *(LAS bf16x8*)(L + SL_SF + ((((kh * NKH + tp * NOWN + i) * 2 + tj) * 2 + st) * 1024) + lane * 16) = f8;
            }
        if (n + 1 < 68 && !(SKIP & 16)) store_images(n + 1);
        if (lat && !(SKIP & 2)) {
            float xv[8];
#pragma unroll
            for (int r8 = 0; r8 < 8; ++r8) { const int r = kh ? r8 + 8 : r8; xv[r8] = *(const LAS float*)(L + SL_XCH + (((tp * 2 + tj) * 16 + r) * 64 + lane) * 4); }
#pragma unroll
            for (int r8 = 0; r8 < 8; ++r8) { const int r = kh ? r8 + 8 : r8; const float ov = (kh ? o[r8 + 8] : o[r8]) + xv[r8];
                const int pr = 32 * tp + (r & 3) + 8 * (r >> 2) + 4 * (int)hh;
                go[(size_t)(row0 + pr) * WA + 32 * tj + (lane & 31)] = (bf16)(pkbf(ov, 0.f) & 0xffffu); }
        }
        LDS_BARRIER();
    }
}
#ifndef HG_MFMA
#define HG_MFMA 1
#endif
#ifndef ML_MFMA
#define ML_MFMA 1
#endif

__device__ __forceinline__ void nchain_task(Frame& F, int j) {
    const int kq = j & 3, id = j >> 2, dirn = id & 1, h = (id >> 1) & 3, b = id >> 3;
    const int tid = F.tid, lane = F.lane, w = F.wave;
    LAS unsigned char* L = F.lds;
    constexpr int NQ = 0, NK = 8192, NS = 16384;
    LAS float* SN = (LAS float*)(L + NS);
    const bf16* gq = F.XN + h * MLD + kq * 64; const bf16* gk = gq + WB;
    const float* mls = F.MLS + (size_t)(dirn * 4 + h) * MALL * 8;
    float* dqp = F.DQP + (size_t)((dirn * 4 + h) * 4 + kq) * MX;
    auto row0_of = [&](int n) -> int { if (n > 67) n = 67; if (n < 4) { const int cc = dirn ? 3 - n : n; return MX + b * CTXL + cc * 64; } const int lc = dirn ? 67 - n : n - 4; return b * SEQ + lc * 64; };
    struct Stg { v4u q, k; float ws, dec; };
    Stg A, B, C; A.ws = A.dec = B.ws = B.dec = C.ws = C.dec = 0.f;
    auto issue = [&](int n, Stg& t) { const int row0 = row0_of(n); const size_t off = (size_t)(row0 + (tid >> 3)) * DM + (tid & 7) * 8;
        t.q = *(const GAS v4u*)(gq + off); t.k = *(const GAS v4u*)(gk + off);
        if (tid < 64) { t.ws = mls[(size_t)(row0 + tid) * 8 + 3]; t.dec = mls[(size_t)(row0 + tid) * 8 + 6]; } };
    auto stash = [&](const Stg& t) { *(LAS v4u*)(L + NQ + tid * 16) = t.q; *(LAS v4u*)(L + NK + tid * 16) = t.k; if (tid < 64) { SN[tid] = t.ws; if (tid == 0) SN[640] = t.dec; } };
    auto step = [&](int n, Stg& ld, const Stg& st) {
        const int row0 = row0_of(n); const bool on = n < 68;
        issue(n + 2, ld);
        float dq_keep = 0.f;
        if (on && n >= 4) {
            const int kk = tid & 7; const v4u u = *(const LAS v4u*)(L + NQ + tid * 16);
            const f32x4 na = *(const LAS f32x4*)(SN + 64 + 8 * kk), nb = *(const LAS f32x4*)(SN + 64 + 8 * kk + 4);
            float d = lo2f(u.x) * na.x + hi2f(u.x) * na.y + lo2f(u.y) * na.z + hi2f(u.y) * na.w + lo2f(u.z) * nb.x + hi2f(u.z) * nb.y + lo2f(u.w) * nb.z + hi2f(u.w) * nb.w;
            d += __shfl_xor(d, 1); d += __shfl_xor(d, 2); d += __shfl_xor(d, 4);
            dq_keep = d;
        }
        { float a = 0.f;
#pragma unroll
          for (int i = 0; i < 8; ++i) { const int s_ = 8 * w + i; a += SN[s_] * bf2f(*(const LAS unsigned short*)(L + NK + s_ * 128 + lane * 2)); }
          SN[128 + w * 64 + lane] = a; }
        __syncthreads();
        if (on && tid < 64) { float nn = SN[640] * SN[64 + tid];
#pragma unroll
            for (int ww = 0; ww < 8; ++ww) nn += SN[128 + ww * 64 + tid];
            SN[64 + tid] = nn; }
        stash(st);
        if (on && n >= 4 && (tid & 7) == 0) dqp[row0 + (tid >> 3)] = dq_keep;
        LDS_BARRIER();
    };
    __syncthreads();
    issue(0, A); issue(1, B);
    if (tid < 64) SN[64 + tid] = 0.f;
    stash(A);
    __syncthreads();
#pragma unroll 1
    for (int n = 0; n < 69; n += 3) { step(n, C, B); step(n + 1, A, C); step(n + 2, B, A); }
}

template <int WHICH, int SKIP = 0>
__device__ __forceinline__ void p4_scan(Frame& F) {
    for (int t = F.vcu; t < 256; t += F.G) {
        if (t < 128 ? !(WHICH & 1) : !(WHICH & 2)) continue;
        if (t < 128) { if (ML_MFMA) scan_task<true, SKIP>(F, t); else { p4_mlstm_task(F, 2 * t); p4_mlstm_task(F, 2 * t + 1); } }
        else { if (HG_MFMA) { scan_task<false, SKIP>(F, t - 128); nchain_task(F, t - 128); } else { p4_hgrn2_task(F, 2 * (t - 128)); p4_hgrn2_task(F, 2 * (t - 128) + 1); } }
    }
}
__device__ __forceinline__ void p5_combine(Frame& F) {
    bf16* Y = F.XN;
    const int gw = F.vcu * NWAVES + F.wave, NGW = F.G * NWAVES;
    for (int row = gw; row < MX; row += NGW) {
        const int ch = F.lane * 16;
        {
            float o[16];
            const v4u a0 = *(const GAS v4u*)(F.OAF + (size_t)row * WA + ch), a1 = *(const GAS v4u*)(F.OAF + (size_t)row * WA + ch + 8);
            const v4u b0 = *(const GAS v4u*)(F.OAB + (size_t)row * WA + ch), b1 = *(const GAS v4u*)(F.OAB + (size_t)row * WA + ch + 8);
            const unsigned ua[8] = {a0.x, a0.y, a0.z, a0.w, a1.x, a1.y, a1.z, a1.w}, ub[8] = {b0.x, b0.y, b0.z, b0.w, b1.x, b1.y, b1.z, b1.w};
            float ss = 0.f;
#pragma unroll
            for (int j = 0; j < 8; ++j) { o[2 * j] = lo2f(ua[j]) + lo2f(ub[j]); o[2 * j + 1] = hi2f(ua[j]) + hi2f(ub[j]); ss += o[2 * j] * o[2 * j] + o[2 * j + 1] * o[2 * j + 1]; }
            ss += __shfl_xor(ss, 1); ss += __shfl_xor(ss, 2); ss += __shfl_xor(ss, 4);
            const float r = 1.f / sqrtf(ss * (1.f / HGD) + NORM_EPS);
            const v4u z0 = *(const GAS v4u*)(F.U + (size_t)row * NU + C_AZ + ch), z1 = *(const GAS v4u*)(F.U + (size_t)row * NU + C_AZ + ch + 8);
            const unsigned uz[8] = {z0.x, z0.y, z0.z, z0.w, z1.x, z1.y, z1.z, z1.w};
            unsigned w[8];
#pragma unroll
            for (int j = 0; j < 8; ++j) { const float y0 = o[2 * j] * r * F.hg_norm_w[ch + 2 * j] * siluf(lo2f(uz[j])), y1 = o[2 * j + 1] * r * F.hg_norm_w[ch + 2 * j + 1] * siluf(hi2f(uz[j])); w[j] = pk2(y0, y1); }
            *(GAS v4u*)(Y + (size_t)row * DM + ch) = (v4u){w[0], w[1], w[2], w[3]}; *(GAS v4u*)(Y + (size_t)row * DM + ch + 8) = (v4u){w[4], w[5], w[6], w[7]};
        }
        {
            float o[16];
            const v4u a0 = *(const GAS v4u*)(F.HBF + (size_t)row * WB + ch), a1 = *(const GAS v4u*)(F.HBF + (size_t)row * WB + ch + 8);
            const v4u b0 = *(const GAS v4u*)(F.HBB + (size_t)row * WB + ch), b1 = *(const GAS v4u*)(F.HBB + (size_t)row * WB + ch + 8);
            const unsigned ua[8] = {a0.x, a0.y, a0.z, a0.w, a1.x, a1.y, a1.z, a1.w}, ub[8] = {b0.x, b0.y, b0.z, b0.w, b1.x, b1.y, b1.z, b1.w};
            float s = 0.f; const int hq = F.lane >> 4;
            float invd[2];
#pragma unroll
            for (int d = 0; d < 2; ++d) { const float* mr = F.MLS + ((size_t)(d * 4 + hq) * MALL + row) * 8; const float* dq = F.DQP + (size_t)((d * 4 + hq) * 4) * MX + row;
                const float den = mr[2] * ((dq[0] + dq[MX]) + (dq[2 * MX] + dq[3 * MX])) + mr[5];
                invd[d] = rcpf_(fmaxf(fabsf(den), mr[4])); }
#pragma unroll
            for (int j = 0; j < 8; ++j) { o[2 * j] = lo2f(ua[j]) * invd[0] + lo2f(ub[j]) * invd[1]; o[2 * j + 1] = hi2f(ua[j]) * invd[0] + hi2f(ub[j]) * invd[1]; s += o[2 * j] + o[2 * j + 1]; }
            s += __shfl_xor(s, 1); s += __shfl_xor(s, 2); s += __shfl_xor(s, 4); s += __shfl_xor(s, 8);
            const float mu = s * (1.f / MLD); float q = 0.f;
#pragma unroll
            for (int j = 0; j < 16; ++j) { o[j] -= mu; q += o[j] * o[j]; }
            q += __shfl_xor(q, 1); q += __shfl_xor(q, 2); q += __shfl_xor(q, 4); q += __shfl_xor(q, 8);
            const float r = 1.f / sqrtf(q * (1.f / MLD) + NORM_EPS);
            const v4u g0 = *(const GAS v4u*)(F.U + (size_t)row * NU + C_BO + ch), g1 = *(const GAS v4u*)(F.U + (size_t)row * NU + C_BO + ch + 8);
            const v4u z0 = *(const GAS v4u*)(F.U + (size_t)row * NU + C_BZ + ch), z1 = *(const GAS v4u*)(F.U + (size_t)row * NU + C_BZ + ch + 8);
            const unsigned ug[8] = {g0.x, g0.y, g0.z, g0.w, g1.x, g1.y, g1.z, g1.w}, uz[8] = {z0.x, z0.y, z0.z, z0.w, z1.x, z1.y, z1.z, z1.w};
            unsigned w[8];
#pragma unroll
            for (int j = 0; j < 8; ++j) { const float y0 = o[2 * j] * r * F.ml_norm_w[ch + 2 * j] * sigmf(lo2f(ug[j])) * siluf(lo2f(uz[j])), y1 = o[2 * j + 1] * r * F.ml_norm_w[ch + 2 * j + 1] * sigmf(hi2f(ug[j])) * siluf(hi2f(uz[j])); w[j] = pk2(y0, y1); }
            *(GAS v4u*)(Y + (size_t)row * DM + WA + ch) = (v4u){w[0], w[1], w[2], w[3]}; *(GAS v4u*)(Y + (size_t)row * DM + WA + ch + 8) = (v4u){w[4], w[5], w[6], w[7]};
        }
    }
}

struct EpiNullSplit {
    static constexpr bool PERM = true, AFTER_DRAIN = false, SPLIT = true, ADJ = false; static constexpr int HALF_STORES = 0;
    __device__ __forceinline__ void operator()(const pg8::f32x4 (&acc)[2][2][4][2], const pg8::Unit& u, int wr, int wc, int fr, int fq) const {}
    __device__ __forceinline__ void half(const pg8::f32x4 (&acc)[2][2][4][2], const pg8::Unit& u, const int ai, int wr, int wc, int fr, int fq) const {
#pragma unroll
        for (int bj = 0; bj < 2; ++bj)
#pragma unroll
            for (int m = 0; m < 4; ++m)
#pragma unroll
                for (int n = 0; n < 2; ++n) asm volatile("" :: "v"(acc[ai][bj][m][n]));
    }
};
struct EpiNoStoreSplit {
    static constexpr bool PERM = true, AFTER_DRAIN = false, SPLIT = true, ADJ = false; static constexpr int HALF_STORES = 0;
    __device__ __forceinline__ void operator()(const pg8::f32x4 (&acc)[2][2][4][2], const pg8::Unit& u, int wr, int wc, int fr, int fq) const {}
    __device__ __forceinline__ void half(const pg8::f32x4 (&acc)[2][2][4][2], const pg8::Unit& u, const int ai, int wr, int wc, int fr, int fq) const {
#pragma unroll
        for (int bj = 0; bj < 2; ++bj)
#pragma unroll
            for (int m = 0; m < 4; ++m) { pg8::f32x4 v0 = acc[ai][bj][m][0], v1 = acc[ai][bj][m][1];
                pg8::u32x4 w; w.x = pg8::cvt_pk_bf16(v0[0], v0[1]); w.y = pg8::cvt_pk_bf16(v0[2], v0[3]); w.z = pg8::cvt_pk_bf16(v1[0], v1[1]); w.w = pg8::cvt_pk_bf16(v1[2], v1[3]);
                asm volatile("" :: "v"(w)); }
    }
};

struct EpiResid {
    static constexpr bool PERM = false, AFTER_DRAIN = false, SPLIT = false, ADJ = false;
    const float* x; const float* gate; float* out;
    __device__ __forceinline__ void operator()(const pg8::f32x4 (&acc)[2][2][4][2], const pg8::Unit& u, int wr, int wc, int fr, int fq) const {
        using pg8::BM; using pg8::HALF;
        const int row0 = u.pm * BM + wr * 64 + fr, col0 = u.pn * BM + wc * 32 + 4 * fq; const int b = (u.pm * BM) / SEQ;
        pg8::f32x4 gv[2][2];
#pragma unroll
        for (int bj = 0; bj < 2; ++bj)
#pragma unroll
            for (int n = 0; n < 2; ++n) gv[bj][n] = *(const pg8::f32x4*)(gate + b * DM + col0 + bj * HALF + n * 16);
#pragma unroll
        for (int ai = 0; ai < 2; ++ai) {
            pg8::f32x4 xv[4][2][2];
#pragma unroll
            for (int m = 0; m < 4; ++m) { const size_t off = (size_t)(row0 + ai * HALF + m * 16) * DM + col0;
#pragma unroll
                for (int bj = 0; bj < 2; ++bj)
#pragma unroll
                    for (int n = 0; n < 2; ++n) xv[m][bj][n] = *(const pg8::f32x4*)(x + off + bj * HALF + n * 16); }
#pragma unroll
            for (int m = 0; m < 4; ++m) { const size_t off = (size_t)(row0 + ai * HALF + m * 16) * DM + col0;
#pragma unroll
                for (int bj = 0; bj < 2; ++bj)
#pragma unroll
                    for (int n = 0; n < 2; ++n) *(pg8::f32x4*)(out + off + bj * HALF + n * 16) = xv[m][bj][n] * ALPHA + gv[bj][n] * acc[ai][bj][m][n]; }
        }
    }
};


struct PanelOrder {
    int c;
    __device__ __forceinline__ bool next(int i, pg8::Unit& u) const { if (i >= 2) return false; u.pm = c >> 2; u.pn = (c & 3) + 4 * i; return true; }
    __device__ __forceinline__ void a_ready(const pg8::Unit&) const {}
    __device__ __forceinline__ void done(const pg8::Unit&) const {}
};
struct EpiLnFused {
    static constexpr bool PERM = false, AFTER_DRAIN = true, SPLIT = false, ADJ = false;
    const float* x; const float* gate; float* out; const float* ln_g; const float* ln_b;
    unsigned long long* xbuf;
    unsigned* cnt;
    __device__ __forceinline__ void zstats(pg8::f32x4 (&acc)[2][2][4][2], const pg8::Unit& u, int wr, int wc, int fr, int fq) const {
        using pg8::BM; using pg8::HALF;
        asm volatile("" : "+v"(fr), "+v"(fq));
        const int row0 = u.pm * BM + wr * 64 + fr, col0 = u.pn * BM + wc * 32 + 4 * fq; const int b = (u.pm * BM) / SEQ;
        pg8::f32x4 gv[2][2];
#pragma unroll
        for (int bj = 0; bj < 2; ++bj)
#pragma unroll
            for (int n = 0; n < 2; ++n) gv[bj][n] = *(const pg8::f32x4*)(gate + b * DM + col0 + bj * HALF + n * 16);
#pragma unroll
        for (int ai = 0; ai < 2; ++ai)
#pragma unroll
            for (int m = 0; m < 4; ++m) { const int row = row0 + ai * HALF + m * 16; const size_t off = (size_t)row * DM + col0;
                float s = 0.f;
#pragma unroll
                for (int bj = 0; bj < 2; ++bj)
#pragma unroll
                    for (int n = 0; n < 2; ++n) { const pg8::f32x4 xv = *(const pg8::f32x4*)(x + off + bj * HALF + n * 16);
                        const pg8::f32x4 z = xv * ALPHA + gv[bj][n] * acc[ai][bj][m][n]; acc[ai][bj][m][n] = z; s += (z[0] + z[1]) + (z[2] + z[3]); }
                s += __shfl_xor(s, 16); s += __shfl_xor(s, 32);
                const float mw = s * (1.0f / 64.0f); float q = 0.f;
#pragma unroll
                for (int bj = 0; bj < 2; ++bj)
#pragma unroll
                    for (int n = 0; n < 2; ++n) { const pg8::f32x4 d = acc[ai][bj][m][n] - mw; q += (d[0] * d[0] + d[1] * d[1]) + (d[2] * d[2] + d[3] * d[3]); }
                q += __shfl_xor(q, 16); q += __shfl_xor(q, 32);
                if (fq == 0) __hip_atomic_store(xbuf + (size_t)row * 32 + u.pn * 4 + wc, ((unsigned long long)__float_as_uint(q) << 32) | __float_as_uint(mw), __ATOMIC_RELAXED, __HIP_MEMORY_SCOPE_AGENT);
            }
    }
    __device__ __forceinline__ void publish(const pg8::Unit& u) const {
        asm volatile("s_waitcnt vmcnt(0)" ::: "memory");
        if ((threadIdx.x & 63) == 0) __hip_atomic_fetch_add(cnt + 64 * u.pm, 1u, __ATOMIC_RELAXED, __HIP_MEMORY_SCOPE_AGENT);
    }
    __device__ __forceinline__ void operator()(const pg8::f32x4 (&acc_c)[2][2][4][2], const pg8::Unit& u, int wr, int wc, int fr, int fq) const {
        using pg8::BM; using pg8::HALF;
        pg8::f32x4 (&acc)[2][2][4][2] = const_cast<pg8::f32x4 (&)[2][2][4][2]>(acc_c);
        zstats(acc, u, wr, wc, fr, fq);
        const int row0 = u.pm * BM + wr * 64 + fr, col0 = u.pn * BM + wc * 32 + 4 * fq;
#pragma unroll
        for (int ai = 0; ai < 2; ++ai)
#pragma unroll
            for (int m = 0; m < 4; ++m) { const size_t off = (size_t)(row0 + ai * HALF + m * 16) * DM + col0;
#pragma unroll
                for (int bj = 0; bj < 2; ++bj)
#pragma unroll
                    for (int n = 0; n < 2; ++n) *(pg8::f32x4*)(out + off + bj * HALF + n * 16) = acc[ai][bj][m][n]; }
        publish(u);
    }
    __device__ __forceinline__ void fused(pg8::f32x4 (&acc)[2][2][4][2], const pg8::Unit& u, int wr, int wc, int fr, int fq, PG8_LAS unsigned char* lds, int wid, int lane) const {
        using pg8::BM; using pg8::HALF;
        typedef float f32x2v __attribute__((ext_vector_type(2)));
        PG8_LAS f32x2v* PH = (PG8_LAS f32x2v*)(lds + 131072);
        PG8_LAS f32x2v* S = (PG8_LAS f32x2v*)(lds + 131072 + 4096);
        zstats(acc, u, wr, wc, fr, fq);
        publish(u);
        if (wid == 0) {
            unsigned spins = 0;
            while ((unsigned)__builtin_amdgcn_readfirstlane(__hip_atomic_load(cnt + 64 * u.pm, __ATOMIC_RELAXED, __HIP_MEMORY_SCOPE_AGENT)) < 64u) { __builtin_amdgcn_s_sleep(2); if (++spins > (1u << 22)) break; }
            __builtin_amdgcn_fence(__ATOMIC_ACQUIRE, "agent");
            asm volatile("s_waitcnt vmcnt(0)" ::: "memory");
        }
        asm volatile("s_waitcnt vmcnt(0) lgkmcnt(0)" ::: "memory"); __builtin_amdgcn_s_barrier(); asm volatile("" ::: "memory");
        { const int t = threadIdx.x, row = t >> 1, half = t & 1; const unsigned long long* sl = xbuf + (size_t)(u.pm * BM + row) * 32 + half * 16;
          float ms = 0.f, mq = 0.f, m2s = 0.f;
#pragma unroll
          for (int i = 0; i < 16; ++i) { const unsigned long long w = __hip_atomic_load(sl + i, __ATOMIC_RELAXED, __HIP_MEMORY_SCOPE_AGENT); const float mt = __uint_as_float((unsigned)w); ms += mt; mq += mt * mt; m2s += __uint_as_float((unsigned)(w >> 32)); }
          const float mh = ms * (1.0f / 16.0f);
          PH[row * 2 + half] = (f32x2v){mh, m2s + 64.0f * fmaxf(mq - 16.0f * mh * mh, 0.f)}; }
        asm volatile("s_waitcnt lgkmcnt(0)" ::: "memory"); __builtin_amdgcn_s_barrier(); asm volatile("" ::: "memory");
        if (threadIdx.x < 256) { const int row = threadIdx.x; const f32x2v a = PH[row * 2], bq = PH[row * 2 + 1];
            const float mean = 0.5f * (a.x + bq.x), da = a.x - mean, db = bq.x - mean; const float m2t = (a.y + bq.y) + 1024.0f * (da * da + db * db);
            S[row] = (f32x2v){mean, 1.0f / sqrtf(m2t * (1.0f / 2048.0f) + LN_EPS)}; }
        asm volatile("s_waitcnt lgkmcnt(0)" ::: "memory"); __builtin_amdgcn_s_barrier(); asm volatile("" ::: "memory");
        const int row0 = u.pm * BM + wr * 64 + fr, col0 = u.pn * BM + wc * 32 + 4 * fq;
#pragma unroll
        for (int bj = 0; bj < 2; ++bj)
#pragma unroll
            for (int n = 0; n < 2; ++n) { const int c = col0 + bj * HALF + n * 16;
                const pg8::f32x4 g2 = *(const pg8::f32x4*)(ln_g + c), b2 = *(const pg8::f32x4*)(ln_b + c), g1 = *(const pg8::f32x4*)(ln_g + c - 4 * BM), b1 = *(const pg8::f32x4*)(ln_b + c - 4 * BM);
#pragma unroll
                for (int ai = 0; ai < 2; ++ai)
#pragma unroll
                    for (int m = 0; m < 4; ++m) { const int rl = ai * HALF + wr * 64 + m * 16 + fr; const f32x2v sr = S[rl]; const size_t off = (size_t)(row0 + ai * HALF + m * 16) * DM + c;
                        const pg8::f32x4 z1 = *(const pg8::f32x4*)(out + off - 4 * BM);
                        *(pg8::f32x4*)(out + off) = (acc[ai][bj][m][n] - sr.x) * sr.y * g2 + b2;
                        acc[ai][bj][m][n] = (z1 - sr.x) * sr.y * g1 + b1; }
#pragma unroll
                for (int ai = 0; ai < 2; ++ai)
#pragma unroll
                    for (int m = 0; m < 4; ++m) { const size_t off = (size_t)(row0 + ai * HALF + m * 16) * DM + c; *(pg8::f32x4*)(out + off - 4 * BM) = acc[ai][bj][m][n]; } }
    }
};

__device__ __forceinline__ void p7_ln(Frame& F) {
    const int gw = F.vcu * NWAVES + F.wave, NGW = F.G * NWAVES;
    for (int row = 2 * gw; row < MX; row += 2 * NGW) {
        GAS f32x4* ra = (GAS f32x4*)(F.out + (size_t)row * DM) + F.lane; GAS f32x4* rb = ra + DM / 4;
        f32x4 va[8], vb[8]; float sa = 0.f, sb = 0.f;
#pragma unroll
        for (int j = 0; j < 8; ++j) { va[j] = ra[64 * j]; vb[j] = rb[64 * j]; }
#pragma unroll
        for (int j = 0; j < 8; ++j) { sa += (va[j].x + va[j].y) + (va[j].z + va[j].w); sb += (vb[j].x + vb[j].y) + (vb[j].z + vb[j].w); }
        const float ma = wave_sum(sa) * (1.f / DM), mb = wave_sum(sb) * (1.f / DM); float qa = 0.f, qb = 0.f;
#pragma unroll
        for (int j = 0; j < 8; ++j) { va[j] = va[j] - ma; vb[j] = vb[j] - mb; qa += (va[j].x * va[j].x + va[j].y * va[j].y) + (va[j].z * va[j].z + va[j].w * va[j].w); qb += (vb[j].x * vb[j].x + vb[j].y * vb[j].y) + (vb[j].z * vb[j].z + vb[j].w * vb[j].w); }
        const float rsa = 1.f / sqrtf(wave_sum(qa) * (1.f / DM) + LN_EPS), rsb = 1.f / sqrtf(wave_sum(qb) * (1.f / DM) + LN_EPS);
        f32x4 gg[8], bbv[8];
#pragma unroll
        for (int j = 0; j < 8; ++j) { const int k = 4 * F.lane + 256 * j; gg[j] = *(const f32x4*)(F.ln_g + k); bbv[j] = *(const f32x4*)(F.ln_b + k); }
#pragma unroll
        for (int j = 0; j < 8; ++j) { ra[64 * j] = va[j] * rsa * gg[j] + bbv[j]; rb[64 * j] = vb[j] * rsb * gg[j] + bbv[j]; }
    }
}

struct Args { const float* in[16]; float* out; unsigned char* ws; int ph_lo, ph_hi, li, pad; };
__global__ void __launch_bounds__(NWAVES * 64, 2) mk_fwd(Args args) {
    extern __shared__ __attribute__((aligned(16))) unsigned char lds[];
    Frame F;
    F.lds = (LAS unsigned char*)lds;
    F.MISC = (volatile LAS unsigned*)(F.lds + MISC_OFF);
    F.tid = threadIdx.x; F.lane = F.tid & 63; F.wave = __builtin_amdgcn_readfirstlane(F.tid >> 6);
    F.G = gridDim.x; { const int bx = blockIdx.x; F.vcu = (F.G % 8 == 0) ? (bx % 8) * (F.G / 8) + bx / 8 : bx; }
    unsigned char* ws = args.ws;
    F.ctl = (gu32*)(ws + WS_CTL);
    F.x = args.in[0]; F.c = args.in[1]; F.ctx = args.in[2]; F.c_ctx = args.in[3]; F.w_mod = args.in[4]; F.b_mod = args.in[5]; F.w_in = args.in[6];
    F.conv_w = args.in[7]; F.conv_b = args.in[8]; F.hg_lb = args.in[9]; F.ml_gate_b = args.in[10]; F.hg_norm_w = args.in[11]; F.ml_norm_w = args.in[12];
    F.w_out = args.in[13]; F.ln_g = args.in[14]; F.ln_b = args.in[15]; F.out = args.out;
    F.modp = (float*)(ws + WS_MODP); F.gate = (float*)(ws + WS_GATE);
    F.QTF = (bf16*)(ws + WS_WINT); F.PE = (float*)(ws + WS_PE); F.MLS = (float*)(ws + WS_MLS); F.DEC = (float*)(ws + WS_DEC); F.MLW = (bf16*)(ws + WS_MLW); F.DQP = (float*)(ws + WS_DQP);
    F.WinT = (bf16*)(ws + WS_WINT); F.WoutT = (bf16*)(ws + WS_WOUTT); F.XN = (bf16*)(ws + WS_XN); F.U = (bf16*)(ws + WS_U);
    F.OAF = (bf16*)args.out; F.OAB = F.OAF + (size_t)MX * WA; F.HBF = F.OAB + (size_t)MX * WA; F.HBB = F.HBF + (size_t)MX * WB;
    for (int u = F.tid; u < (LDS_BYTES - LDSCTL_OFF) / 4; u += NT) ((LAS unsigned*)(F.lds + LDSCTL_OFF))[u] = 0u;
    __syncthreads();
    XcdBarrier bar; bar.bar = (unsigned*)(F.ctl + CW_BAR); bar.x = 0; bar.st = nullptr;
    if (MK_N_LAUNCHES == 1) bar = xcd_barrier_post((unsigned*)(F.ctl + CW_BAR), F.MISC + 8);
    const int lo = args.ph_lo, hi = args.ph_hi;
#ifndef PH_MASK
#define PH_MASK 255
#endif
#define PHON(k) ((PH_MASK >> (k)) & 1)
#ifndef DUP_MASK
#define DUP_MASK 0
#endif
#define DUP(k) ((DUP_MASK >> (k)) & 1)
#ifndef FUSE_LN
#define FUSE_LN 0
#endif
#ifndef DUP4S
#define DUP4S 0
#endif
#ifndef DUP4W
#define DUP4W 3
#endif
#ifndef DUP3W
#define DUP3W 7
#endif
#define IN(k) (lo <= (k) && (k) < hi)
#define SEAM(k) do { if (IN(k) && IN((k) + 1)) xcd_barrier(bar); } while (0)
    if (PHON(0) && IN(0)) { p0_prep(F); if (DUP(0)) p0_prep(F); } SEAM(0);
    if (PHON(1) && IN(1)) { p1_lnmod(F); if (DUP(1)) p1_lnmod(F); } SEAM(1);
    if (PHON(2) && IN(2)) { pg8::Gemm g{F.XN, F.WinT, MALL, NU, DM}; pg8::StaticOrder S; S.init(MALL, NU, F.G, (int)blockIdx.x);
        pg8::EpiBf16<2> E{F.U, NU, nullptr, 0, 0, 1.f, 4};
        if (DUP(2)) { EpiNullSplit EN; pg8::gemm_phase<EpiNullSplit, pg8::StaticOrder, PG8_ALIGN, PG8_SP2>(F.lds + RING_OFF, g, S, EN); __syncthreads(); }
        if (DUP(10)) { EpiNoStoreSplit EN; pg8::gemm_phase<EpiNoStoreSplit, pg8::StaticOrder, PG8_ALIGN, PG8_SP2>(F.lds + RING_OFF, g, S, EN); __syncthreads(); }
        if (DUP(9)) { pg8::gemm_phase<pg8::EpiBf16<2>, pg8::StaticOrder, PG8_ALIGN, PG8_SP2>(F.lds + RING_OFF, g, S, E); __syncthreads(); }
        pg8::gemm_phase<pg8::EpiBf16<2>, pg8::StaticOrder, PG8_ALIGN, PG8_SP2>(F.lds + RING_OFF, g, S, E); } SEAM(2);
    if (PHON(3) && IN(3)) { if (DUP(3)) { if (DUP3W & 1) p3_hg_prep<true>(F); if (DUP3W & 2) p3_conv(F); if (DUP3W & 4) p3_ml_scalars(F); } p3_conv(F); if (HG_MFMA) p3_hg_prep<false>(F); if (ML_MFMA) p3_ml_scalars(F); xcd_barrier(bar); p3b_ml_scores(F); if (DUP(6)) p3b_ml_scores(F); } SEAM(3);
    if (PHON(4) && IN(4)) { if (DUP(4)) p4_scan<DUP4W, DUP4S>(F); p4_scan<3>(F); } SEAM(4);
    if (PHON(5) && IN(5)) { p5_combine(F); if (DUP(5)) p5_combine(F); if (DUP(7)) { xcd_barrier(bar); xcd_barrier(bar); xcd_barrier(bar); xcd_barrier(bar); } } SEAM(5);
    if (PHON(6) && IN(6)) { pg8::Gemm g{F.XN, F.WoutT, MX, DM, DM}; pg8::StaticOrder S; S.init(MX, DM, F.G, (int)blockIdx.x);
        if (F.G == 256 && FUSE_LN) { PanelOrder PO{F.vcu}; EpiLnFused E{F.x, F.gate, F.out, F.ln_g, F.ln_b, (unsigned long long*)(args.ws + WS_XB), (unsigned*)(F.ctl + CW_PANEL)};
            pg8::gemm_phase<EpiLnFused, PanelOrder, PG8_ALIGN, PG8_SP2>(F.lds + RING_OFF, g, PO, E); }
        else { EpiResid E{F.x, F.gate, F.out};
            pg8::gemm_phase<EpiResid, pg8::StaticOrder, PG8_ALIGN, PG8_SP2>(F.lds + RING_OFF, g, S, E);
            if (DUP(8)) { __syncthreads(); pg8::gemm_phase<EpiResid, pg8::StaticOrder, PG8_ALIGN, PG8_SP2>(F.lds + RING_OFF, g, S, E); } } }
    if (!(F.G == 256 && FUSE_LN)) { SEAM(6); if (PHON(7) && IN(7)) { p7_ln(F); } }
#undef IN
#undef SEAM
}

extern "C" void kernel_launch(void* const* d_in, const int* in_sizes, int n_in, void* d_out, int out_size, void* d_ws, size_t ws_size, hipStream_t stream) {
    static int grid = 0;
    if (grid == 0) {
        if (n_in != 16 || out_size != MX * DM || ws_size < WS_END) { fprintf(stderr, "kernel_launch: unexpected shapes (n_in %d out %d ws %zu)\n", n_in, out_size, ws_size); grid = -1; return; }
        int dev = 0, cus = 0, per_cu = 0;
        if (hipGetDevice(&dev) != hipSuccess || hipDeviceGetAttribute(&cus, hipDeviceAttributeMultiprocessorCount, dev) != hipSuccess) { grid = -1; return; }
        if (hipFuncSetAttribute((const void*)mk_fwd, hipFuncAttributeMaxDynamicSharedMemorySize, LDS_BYTES) != hipSuccess) { fprintf(stderr, "kernel_launch: hipFuncSetAttribute failed\n"); grid = -1; return; }
        if (hipOccupancyMaxActiveBlocksPerMultiprocessor(&per_cu, (const void*)mk_fwd, NT, LDS_BYTES) != hipSuccess || per_cu < 1) { fprintf(stderr, "kernel_launch: occupancy query says %d\n", per_cu); per_cu = 1; }
        (void)hipGetLastError();
        grid = cus;
    }
    if (grid < 0) return;
    if (hipMemsetAsync((char*)d_ws + WS_CTL, 0, CTL_ZERO_BYTES, stream) != hipSuccess) { fprintf(stderr, "kernel_launch: memset failed\n"); return; }
    Args a{};
    for (int i = 0; i < 16; ++i) a.in[i] = (const float*)d_in[i];
    a.out = (float*)d_out; a.ws = (unsigned char*)d_ws;
    for (int li = 0; li < MK_N_LAUNCHES; ++li) {
        a.ph_lo = (MK_N_LAUNCHES == 1) ? 0 : li; a.ph_hi = (MK_N_LAUNCHES == 1) ? N_PHASES : li + 1; a.li = li;
        hipLaunchKernelGGL(mk_fwd, dim3(grid), dim3(NT), LDS_BYTES, stream, a);
        const hipError_t le = hipPeekAtLastError();
        if (le != hipSuccess) { fprintf(stderr, "kernel_launch: launch %d failed: %s\n", li, hipGetErrorName(le)); break; }
    }
}
```

```cpp
#include <hip/hip_runtime.h>
#include <cstdio>
#include <cstdint>
namespace pg8 {
#define PG8_LAS __attribute__((address_space(3)))
typedef unsigned short bf16_t;
typedef short bf16x8 __attribute__((ext_vector_type(8)));
typedef float f32x4 __attribute__((ext_vector_type(4)));
typedef unsigned u32x4 __attribute__((ext_vector_type(4)));
constexpr int BM = 256, BK = 64, HALF = 128, HTB = HALF * BK * 2  , STAGE_BYTES = 8 * HTB, NXCD = 8, WGM = 4;

__host__ __device__ __forceinline__ int lds_byte(int r, int c) { const int st = (r >> 4) * 2 + (c >> 5), rr = r & 15, cc = c & 31, ob = rr * 64 + cc * 2; return st * 1024 + (ob ^ (((ob >> 9) & 1) << 5)); }
__host__ __device__ __forceinline__ void stage_rc(int b, int& R, int& C) { const int st = b / 1024, sb = b % 1024, swz = sb ^ (((sb >> 9) & 1) << 5); R = (st >> 1) * 16 + swz / 64; C = (st & 1) * 32 + (swz % 64) / 2; }
__host__ __device__ __forceinline__ int perm32(int rho) { const int n = rho >> 4, i = rho & 15; return 8 * (i >> 2) + 4 * n + (i & 3); }

struct Unit { int pm, pn; };
struct Gemm { const bf16_t* A; const bf16_t* Bt; int M, N, K; };

struct StaticOrder {
    int nM, nN, nwg, G, c;
    __host__ __device__ void init(int M, int N, int G_, int c_) { nM = M / BM; nN = N / BM; nwg = nM * nN; G = G_; c = c_; }
    __host__ __device__ bool next(int i, Unit& u) const {
        const long L = (long)i * G + c; if (L >= nwg) return false;
        int wgid = (int)L; { const int q = nwg / NXCD, r = nwg % NXCD, xcd = wgid % NXCD, off = wgid / NXCD; wgid = (xcd < r ? xcd * (q + 1) : r * (q + 1) + (xcd - r) * q) + off; }
        const int nig = WGM * nN, gid = wgid / nig, fm = gid * WGM, gsz = (nM - fm) < WGM ? (nM - fm) : WGM;
        u.pm = fm + ((wgid % nig) % gsz); u.pn = (wgid % nig) / gsz; return true;
    }
    __device__ __forceinline__ void a_ready(const Unit&) const {}
    __device__ __forceinline__ void done(const Unit&) const {}
};

__device__ __forceinline__ unsigned cvt_pk_bf16(float lo, float hi) { unsigned r; asm volatile("v_cvt_pk_bf16_f32 %0, %1, %2" : "=v"(r) : "v"(lo), "v"(hi)); return r; }
typedef float f32x2 __attribute__((ext_vector_type(2)));
__device__ __forceinline__ f32x2 gelu_pk(f32x2 v) {
    const f32x2 av = __builtin_elementwise_abs(v), d = av * 0.2316418882f + 1.0f;
    f32x2 t; t.x = __builtin_amdgcn_rcpf(d.x); t.y = __builtin_amdgcn_rcpf(d.y);
    f32x2 q = t * 0.5307027145f + (-0.7265760135f); q = q * t + 0.7107068705f; q = q * t + (-0.142248368f); q = q * t + 0.127414796f; q = q * t;
    const f32x2 s = (v * v) * (-0.72134752044f);
    f32x2 e; e.x = __builtin_amdgcn_exp2f(s.x); e.y = __builtin_amdgcn_exp2f(s.y);
    const f32x2 m = v * (q * e), r = v - m;
    f32x2 o; o.x = v.x < 0.f ? m.x : r.x; o.y = v.y < 0.f ? m.y : r.y; return o;
}

template <int ACT  > struct EpiBf16 {
    static constexpr bool PERM = true, AFTER_DRAIN = false, SPLIT = (ACT != 1), ADJ = (ACT != 1); static constexpr int HALF_STORES = 8; static_assert(ACT == 0 || ACT == 1 || ACT == 2, "EpiBf16: ACT is 0 (none), 1 (gelu_pk) or 2 (SiLU on the column tiles pn < act_tiles)");
    bf16_t* O; int ldc; const float* bias; int split_cols; size_t split_stride; float scale0; int act_tiles; float* gates; int gate_tile; int prod_lo, prod_hi; unsigned* pad;
    __device__ __forceinline__ void operator()(const f32x4 (&acc)[2][2][4][2], const Unit& u, int wr, int wc, int fr, int fq) const {
        const int row0 = u.pm * BM + wr * 64 + fr; int colt = u.pn * BM; bf16_t* base = O;
        float sc = 1.f; if (split_cols) { const int t = colt / split_cols; base += (size_t)t * split_stride; colt -= t * split_cols; if (t == 0) sc = scale0; }
        const int col0 = colt + wc * (ADJ ? 64 : 32) + 8 * fq, bcol0 = u.pn * BM + wc * (ADJ ? 64 : 32) + 8 * fq; constexpr int BJS = ADJ ? 32 : HALF;
        f32x4 bv[2][2];
#pragma unroll
        for (int bj = 0; bj < 2; ++bj)
#pragma unroll
            for (int n = 0; n < 2; ++n) bv[bj][n] = bias ? *(const f32x4*)(bias + bcol0 + bj * BJS + 4 * n) : (f32x4){0.f, 0.f, 0.f, 0.f};
#pragma unroll
        for (int ai = 0; ai < 2; ++ai)
#pragma unroll
            for (int m = 0; m < 4; ++m) { bf16_t* rowp = base + (size_t)(row0 + ai * HALF + m * 16) * ldc + col0;
#pragma unroll
                for (int bj = 0; bj < 2; ++bj) { f32x4 v0 = acc[ai][bj][m][0] + bv[bj][0], v1 = acc[ai][bj][m][1] + bv[bj][1];
                    if (ACT == 1) { f32x2 a = gelu_pk((f32x2){v0[0], v0[1]}), b = gelu_pk((f32x2){v0[2], v0[3]}), c = gelu_pk((f32x2){v1[0], v1[1]}), d = gelu_pk((f32x2){v1[2], v1[3]});
                        v0 = (f32x4){a.x, a.y, b.x, b.y}; v1 = (f32x4){c.x, c.y, d.x, d.y}; }
                    if (ACT == 2 && u.pn < act_tiles) {
#pragma unroll
                        for (int e = 0; e < 4; ++e) { v0[e] = v0[e] * __builtin_amdgcn_rcpf(1.0f + __expf(-v0[e])); v1[e] = v1[e] * __builtin_amdgcn_rcpf(1.0f + __expf(-v1[e])); } }
                    v0 = v0 * sc; v1 = v1 * sc; u32x4 w; w.x = cvt_pk_bf16(v0[0], v0[1]); w.y = cvt_pk_bf16(v0[2], v0[3]); w.z = cvt_pk_bf16(v1[0], v1[1]); w.w = cvt_pk_bf16(v1[2], v1[3]);
                    *(u32x4*)(rowp + bj * BJS) = w; } }
    }
    template <bool ACTV> __device__ __forceinline__ void half_t(const f32x4 (&acc)[2][2][4][2], const Unit& u, const int ai, int wr, int wc, int fr, int fq) const {
        unsigned frv = (unsigned)fr; asm volatile("" : "+v"(frv));
        const bool odd = (frv & 1u) != 0u;
        const unsigned off0 = ((unsigned)(u.pm * BM + wr * 64 + ai * HALF) + (frv & ~1u)) * (unsigned)ldc * 2u + (unsigned)(u.pn * BM + wc * 64 + 8 * fq) * 2u + (frv & 1u) * 64u;
        char* const ob = (char*)O;
#pragma unroll
        for (int m = 0; m < 4; ++m) { u32x4 w[2];
#pragma unroll
            for (int bj = 0; bj < 2; ++bj) { f32x4 v0 = acc[ai][bj][m][0], v1 = acc[ai][bj][m][1];
                if (ACTV) {
#pragma unroll
                    for (int e = 0; e < 4; ++e) { v0[e] = v0[e] * __builtin_amdgcn_rcpf(1.0f + __expf(-v0[e])); v1[e] = v1[e] * __builtin_amdgcn_rcpf(1.0f + __expf(-v1[e])); } }
                w[bj].x = cvt_pk_bf16(v0[0], v0[1]); w[bj].y = cvt_pk_bf16(v0[2], v0[3]); w[bj].z = cvt_pk_bf16(v1[0], v1[1]); w[bj].w = cvt_pk_bf16(v1[2], v1[3]); }
            u32x4 sa, sb;
#pragma unroll
            for (int e = 0; e < 4; ++e) { const unsigned t = odd ? w[0][e] : w[1][e];
                const unsigned r = (unsigned)__builtin_amdgcn_update_dpp(0, (int)t, 0xB1, 0xf, 0xf, false);
                sa[e] = odd ? r : w[0][e]; sb[e] = odd ? w[1][e] : r; }
            *(u32x4*)(ob + (size_t)(off0 + (unsigned)(m * 16 * ldc) * 2u)) = sa;
            *(u32x4*)(ob + (size_t)(off0 + (unsigned)((m * 16 + 1) * ldc) * 2u)) = sb; }
    }
    __device__ __forceinline__ void half_prod(const f32x4 (&acc)[2][2][4][2], const Unit& u, const int ai, int wr, int wc, int fr, int fq) const {
        unsigned frv = (unsigned)fr; asm volatile("" : "+v"(frv));
        const unsigned off0 = ((unsigned)(u.pm * BM + wr * 64 + ai * HALF) + frv) * (unsigned)ldc * 2u + (unsigned)(prod_lo * BM + (u.pn - prod_lo) * 128 + wc * 32 + 8 * fq) * 2u;
        char* const ob = (char*)O;
#pragma unroll
        for (int m = 0; m < 4; ++m) { float p[8];
#pragma unroll
            for (int n = 0; n < 2; ++n)
#pragma unroll
                for (int e = 0; e < 4; ++e) { const float o = acc[ai][0][m][n][e], z = acc[ai][1][m][n][e];
                    p[4 * n + e] = z * __builtin_amdgcn_rcpf(1.0f + __expf(-o)) * __builtin_amdgcn_rcpf(1.0f + __expf(-z)); }
            u32x4 w; w.x = cvt_pk_bf16(p[0], p[1]); w.y = cvt_pk_bf16(p[2], p[3]); w.z = cvt_pk_bf16(p[4], p[5]); w.w = cvt_pk_bf16(p[6], p[7]);
            *(u32x4*)(ob + (size_t)(off0 + (unsigned)(m * 16 * ldc) * 2u)) = w;
            pad[(blockIdx.x * 8u + (unsigned)(wr * 4 + wc)) * 64u + (frv + 16u * (unsigned)fq)] = w.x; }
    }
    __device__ __forceinline__ void half(const f32x4 (&acc)[2][2][4][2], const Unit& u, const int ai, int wr, int wc, int fr, int fq) const {
        if (ACT == 2 && u.pn < act_tiles) half_t<true>(acc, u, ai, wr, wc, fr, fq); else if (ACT == 2 && u.pn >= prod_lo && u.pn < prod_hi) half_prod(acc, u, ai, wr, wc, fr, fq); else half_t<false>(acc, u, ai, wr, wc, fr, fq);
        if (gates != nullptr && u.pn == gate_tile && wc == 0 && fq < 2) {
            float* gp = gates + (size_t)(u.pm * BM + wr * 64 + ai * HALF + fr) * 16 + 8 * fq;
#pragma unroll
            for (int m = 0; m < 4; ++m) { *(f32x4*)(gp + (size_t)(m * 16) * 16) = acc[ai][0][m][0]; *(f32x4*)(gp + (size_t)(m * 16) * 16 + 4) = acc[ai][0][m][1]; } }
    }
};
template <class Epi, class Sched, bool ALIGN_EPI = false, bool SP2 = false>
__device__ __forceinline__ void gemm_phase(PG8_LAS unsigned char* lds, const Gemm g, const Sched& S, const Epi& E) {
    const int tid = threadIdx.x, wid = __builtin_amdgcn_readfirstlane(tid >> 6), lane = tid & 63, wr = wid >> 2, wc = wid & 3, fr = lane & 15, fq = lane >> 4;
    const int K = g.K, nt = K / BK;
    unsigned voffA[2], voffB[2];
#pragma unroll
    for (int i = 0; i < 2; ++i) { int R, C; stage_rc(tid * 16 + i * 8192, R, C); const int Rb = Epi::PERM ? ((R & ~31) + perm32(R & 31)) : R;
        voffA[i] = (unsigned)(R * K + C) * 2u; voffB[i] = (unsigned)((Epi::ADJ ? 64 * (R >> 5) + perm32(R & 31) : Rb) * K + C) * 2u; }
    const size_t kstep = (size_t)(BK * 2);
    const size_t hstep = (size_t)HALF * K * 2;
    const size_t hstepB = Epi::ADJ ? (size_t)32 * K * 2 : hstep;
    const size_t tstep = 2 * hstep;
    const unsigned ldsw = (unsigned)wid * 1024u;
    const int aoff = lds_byte(wr * 64 + fr, fq * 8), boff = lds_byte(wc * 32 + fr, fq * 8);
#define PG8_SA(b, h) (((b) * 2 + (h)) * HTB)
#define PG8_SB(b, h) ((4 + (b) * 2 + (h)) * HTB)
#define PG8_STAGE(bufoff, gbase, voff) do { _Pragma("unroll") for (int _i = 0; _i < 2; ++_i) \
        __builtin_amdgcn_global_load_lds((const unsigned*)((const char*)(gbase) + (voff)[_i]), (PG8_LAS unsigned*)(lds + (bufoff) + ldsw + _i * 8192), 16, 0, 0); } while (0)
#define PG8_LDA(dst, b, h) do { _Pragma("unroll") for (int m = 0; m < 4; ++m) _Pragma("unroll") for (int k = 0; k < 2; ++k) dst[m][k] = *(const PG8_LAS bf16x8*)(lds + PG8_SA(b, h) + aoff + m * 2048 + k * 1024); } while (0)
#define PG8_LDB(dst, b, h) do { _Pragma("unroll") for (int n = 0; n < 2; ++n) _Pragma("unroll") for (int k = 0; k < 2; ++k) dst[n][k] = *(const PG8_LAS bf16x8*)(lds + PG8_SB(b, h) + boff + n * 2048 + k * 1024); } while (0)
#define PG8_MMA(ai, bj, At, Bt) do { __builtin_amdgcn_s_setprio(1); _Pragma("unroll") for (int m = 0; m < 4; ++m) _Pragma("unroll") for (int n = 0; n < 2; ++n) _Pragma("unroll") for (int k = 0; k < 2; ++k) \
        acc[ai][bj][m][n] = __builtin_amdgcn_mfma_f32_16x16x32_bf16(Bt[n][k], At[m][k], acc[ai][bj][m][n], 0, 0, 0); __builtin_amdgcn_s_setprio(0); } while (0)
#define PG8_WAIT_V(n) asm volatile("s_waitcnt vmcnt(" #n ")" ::: "memory")
#define PG8_WAIT_V1 do { if constexpr (Epi::HALF_STORES == 8) PG8_WAIT_V(16); else PG8_WAIT_V(8); } while (0)
#define PG8_WAIT_V2 do { if constexpr (Epi::HALF_STORES == 8) PG8_WAIT_V(24); else PG8_WAIT_V(8); } while (0)
#define PG8_WAIT_L(n) asm volatile("s_waitcnt lgkmcnt(" #n ")" ::: "memory")
#define PG8_BAR __builtin_amdgcn_s_barrier()
#define PG8_SCHED __builtin_amdgcn_sched_barrier(0)
    Unit cur, nxt, prv; int ui = 0;
    if (!S.next(0, cur)) return;
    f32x4 acc[2][2][4][2];
#pragma unroll
    for (int a = 0; a < 2; ++a)
#pragma unroll
        for (int b = 0; b < 2; ++b)
#pragma unroll
            for (int m = 0; m < 4; ++m)
#pragma unroll
                for (int n = 0; n < 2; ++n) acc[a][b][m][n] = (f32x4){0.f, 0.f, 0.f, 0.f};
    bf16x8 At[4][2], B0[2][2], B1[2][2];
    const char* cA = (const char*)g.A + (size_t)cur.pm * tstep; const char* cB = (const char*)g.Bt + (size_t)cur.pn * tstep;
    S.a_ready(cur);
    if constexpr (SP2) {
        PG8_STAGE(PG8_SB(0, 0), cB, voffB); PG8_STAGE(PG8_SB(0, 1), cB + hstepB, voffB); PG8_STAGE(PG8_SA(0, 0), cA, voffA); PG8_STAGE(PG8_SA(0, 1), cA + hstep, voffA);
        if (wr == 1) PG8_BAR;
        PG8_WAIT_V(2); PG8_BAR;
        PG8_STAGE(PG8_SB(1, 0), cB + kstep, voffB); PG8_STAGE(PG8_SA(1, 0), cA + kstep, voffA); PG8_STAGE(PG8_SB(1, 1), cB + hstepB + kstep, voffB);
        PG8_WAIT_V(6); PG8_BAR;
    } else {
        PG8_STAGE(PG8_SB(0, 0), cB, voffB); PG8_STAGE(PG8_SA(0, 0), cA, voffA); PG8_STAGE(PG8_SB(0, 1), cB + hstepB, voffB); PG8_STAGE(PG8_SA(0, 1), cA + hstep, voffA);
        if (wr == 1) PG8_BAR;
        PG8_WAIT_V(4); PG8_BAR;
        PG8_STAGE(PG8_SB(1, 0), cB + kstep, voffB); PG8_STAGE(PG8_SA(1, 0), cA + kstep, voffA); PG8_STAGE(PG8_SB(1, 1), cB + hstepB + kstep, voffB);
        PG8_WAIT_V(6); PG8_BAR;
    }
    for (;;) {
        const bool has_next = S.next(ui + 1, nxt);
        const char* nA = has_next ? (const char*)g.A + (size_t)nxt.pm * tstep : cA; const char* nB = has_next ? (const char*)g.Bt + (size_t)nxt.pn * tstep : cB;
        for (int t = 0; t < nt; t += 2) {
            const bool last = (t == nt - 2);
            const char* a1 = cA + (size_t)(t + 1) * kstep;
            const char* a2 = last ? nA : cA + (size_t)(t + 2) * kstep; const char* b2 = last ? nB : cB + (size_t)(t + 2) * kstep;
            const char* a3 = a2 + kstep; const char* b3 = b2 + kstep;
            if (last && has_next) S.a_ready(nxt);
            if constexpr (SP2 && Epi::SPLIT) {
            const bool pend = (t == 0) && (ui > 0);
            PG8_LDB(B0, 0, 0); PG8_LDB(B1, 0, 1); PG8_SCHED; PG8_LDA(At, 0, 0); PG8_STAGE(PG8_SA(1, 1), a1 + hstep, voffA);
            if (pend) PG8_WAIT_V1; else PG8_WAIT_V(8);
            PG8_WAIT_L(0); PG8_BAR; PG8_MMA(0, 0, At, B0); PG8_MMA(0, 1, At, B1); PG8_BAR; PG8_SCHED;
            PG8_LDA(At, 0, 1); PG8_STAGE(PG8_SB(0, 0), b2, voffB); PG8_STAGE(PG8_SB(0, 1), b2 + hstepB, voffB); PG8_STAGE(PG8_SA(0, 0), a2, voffA); PG8_SCHED;
            if (pend) { E.half(acc, prv, 1, wr, wc, fr, fq); PG8_SCHED;
#pragma unroll
                for (int b = 0; b < 2; ++b)
#pragma unroll
                    for (int m = 0; m < 4; ++m)
#pragma unroll
                        for (int n = 0; n < 2; ++n) acc[1][b][m][n] = (f32x4){0.f, 0.f, 0.f, 0.f};
                PG8_WAIT_V2; } else PG8_WAIT_V(8);
            PG8_WAIT_L(0); PG8_BAR; PG8_MMA(1, 0, At, B0); PG8_MMA(1, 1, At, B1); PG8_BAR; PG8_SCHED;
            PG8_LDB(B0, 1, 0); PG8_LDB(B1, 1, 1); PG8_SCHED; PG8_LDA(At, 1, 0); PG8_STAGE(PG8_SA(0, 1), a2 + hstep, voffA);
            if (pend) PG8_WAIT_V1; else PG8_WAIT_V(8);
            PG8_WAIT_L(0); PG8_BAR; PG8_MMA(0, 0, At, B0); PG8_MMA(0, 1, At, B1); PG8_BAR; PG8_SCHED;
            PG8_LDA(At, 1, 1); PG8_STAGE(PG8_SB(1, 0), b3, voffB); PG8_STAGE(PG8_SB(1, 1), b3 + hstepB, voffB); PG8_STAGE(PG8_SA(1, 0), a3, voffA); PG8_SCHED;
            if (last) { E.half(acc, cur, 0, wr, wc, fr, fq); PG8_SCHED;
#pragma unroll
                for (int b = 0; b < 2; ++b)
#pragma unroll
                    for (int m = 0; m < 4; ++m)
#pragma unroll
                        for (int n = 0; n < 2; ++n) acc[0][b][m][n] = (f32x4){0.f, 0.f, 0.f, 0.f};
                PG8_WAIT_V1; } else if (pend) PG8_WAIT_V1; else PG8_WAIT_V(8);
            PG8_WAIT_L(0); PG8_BAR; PG8_MMA(1, 0, At, B0); PG8_MMA(1, 1, At, B1); PG8_BAR; PG8_SCHED;
            } else if constexpr (SP2) {
            PG8_LDB(B0, 0, 0); PG8_LDB(B1, 0, 1); PG8_SCHED; PG8_LDA(At, 0, 0); PG8_STAGE(PG8_SA(1, 1), a1 + hstep, voffA);
            PG8_WAIT_V(8); PG8_WAIT_L(0); PG8_BAR; PG8_MMA(0, 0, At, B0); PG8_MMA(0, 1, At, B1); PG8_BAR; PG8_SCHED;
            PG8_LDA(At, 0, 1); PG8_STAGE(PG8_SB(0, 0), b2, voffB); PG8_STAGE(PG8_SB(0, 1), b2 + hstepB, voffB); PG8_STAGE(PG8_SA(0, 0), a2, voffA);
            PG8_WAIT_V(8); PG8_WAIT_L(0); PG8_BAR; PG8_MMA(1, 0, At, B0); PG8_MMA(1, 1, At, B1); PG8_BAR; PG8_SCHED;
            PG8_LDB(B0, 1, 0); PG8_LDB(B1, 1, 1); PG8_SCHED; PG8_LDA(At, 1, 0); PG8_STAGE(PG8_SA(0, 1), a2 + hstep, voffA);
            PG8_WAIT_V(8); PG8_WAIT_L(0); PG8_BAR; PG8_MMA(0, 0, At, B0); PG8_MMA(0, 1, At, B1); PG8_BAR; PG8_SCHED;
            PG8_LDA(At, 1, 1); PG8_STAGE(PG8_SB(1, 0), b3, voffB); PG8_STAGE(PG8_SB(1, 1), b3 + hstepB, voffB); PG8_STAGE(PG8_SA(1, 0), a3, voffA);
            PG8_WAIT_V(8); PG8_WAIT_L(0); PG8_BAR; PG8_MMA(1, 0, At, B0); PG8_MMA(1, 1, At, B1); PG8_BAR; PG8_SCHED;
            } else {
            PG8_LDB(B0, 0, 0); PG8_SCHED; PG8_LDA(At, 0, 0); PG8_STAGE(PG8_SA(1, 1), a1 + hstep, voffA);
            PG8_WAIT_L(8); PG8_BAR; PG8_WAIT_L(0); PG8_MMA(0, 0, At, B0); PG8_BAR; PG8_SCHED;
            PG8_LDB(B1, 0, 1); PG8_STAGE(PG8_SB(0, 0), b2, voffB);
            PG8_BAR; PG8_WAIT_L(0); PG8_MMA(0, 1, At, B1); PG8_BAR;
            PG8_LDA(At, 0, 1); PG8_STAGE(PG8_SA(0, 0), a2, voffA);
            PG8_BAR; PG8_WAIT_L(0); PG8_MMA(1, 0, At, B0); PG8_BAR; PG8_SCHED;
            PG8_STAGE(PG8_SB(0, 1), b2 + hstepB, voffB);
            PG8_WAIT_V(6); PG8_BAR; PG8_MMA(1, 1, At, B1); PG8_BAR;
            PG8_LDB(B0, 1, 0); PG8_SCHED; PG8_LDA(At, 1, 0); PG8_STAGE(PG8_SA(0, 1), a2 + hstep, voffA);
            PG8_WAIT_L(8); PG8_BAR; PG8_WAIT_L(0); PG8_MMA(0, 0, At, B0); PG8_BAR; PG8_SCHED;
            PG8_LDB(B1, 1, 1); PG8_STAGE(PG8_SB(1, 0), b3, voffB);
            PG8_BAR; PG8_WAIT_L(0); PG8_MMA(0, 1, At, B1); PG8_BAR;
            PG8_LDA(At, 1, 1); PG8_STAGE(PG8_SA(1, 0), a3, voffA);
            PG8_BAR; PG8_WAIT_L(0); PG8_MMA(1, 0, At, B0); PG8_BAR; PG8_SCHED;
            PG8_STAGE(PG8_SB(1, 1), b3 + hstepB, voffB);
            PG8_WAIT_V(6); PG8_BAR; PG8_MMA(1, 1, At, B1); PG8_BAR;
            }
        }
        if constexpr (SP2 && Epi::SPLIT) {
            if (!has_next) { E.half(acc, cur, 1, wr, wc, fr, fq); S.done(cur); break; }
            prv = cur; cur = nxt; cA = nA; cB = nB; ++ui; continue;
        }
        if constexpr (ALIGN_EPI) { if (wr == 0) PG8_BAR; }
        if constexpr (!Epi::AFTER_DRAIN) { E(acc, cur, wr, wc, fr, fq); S.done(cur); }
        else { if (has_next) { E(acc, cur, wr, wc, fr, fq); S.done(cur); } }
        if (!has_next) break;
#pragma unroll
        for (int a = 0; a < 2; ++a)
#pragma unroll
            for (int b = 0; b < 2; ++b)
#pragma unroll
                for (int m = 0; m < 4; ++m)
#pragma unroll
                    for (int n = 0; n < 2; ++n) acc[a][b][m][n] = (f32x4){0.f, 0.f, 0.f, 0.f};
        cur = nxt; cA = nA; cB = nB; ++ui;
        if constexpr (ALIGN_EPI) { if (wr == 1) PG8_BAR; }
    }
    PG8_WAIT_V(0);
    if constexpr (!ALIGN_EPI || (SP2 && Epi::SPLIT)) { if (wr == 0) PG8_BAR; }
    PG8_BAR;
    if constexpr (Epi::AFTER_DRAIN) { E.fused(acc, cur, wr, wc, fr, fq, lds, wid, lane); S.done(cur); }
#undef PG8_SA
#undef PG8_SB
#undef PG8_STAGE
#undef PG8_LDA
#undef PG8_LDB
#undef PG8_MMA
#undef PG8_WAIT_V
#undef PG8_WAIT_V1
#undef PG8_WAIT_V2
#undef PG8_WAIT_L
#undef PG8_BAR
#undef PG8_SCHED
}
}

#ifndef PG8_SP2
#define PG8_SP2 true
#endif
#ifndef PG8_ALIGN
#define PG8_ALIGN true
#endif
#define GAS __attribute__((address_space(1)))
#define LAS __attribute__((address_space(3)))
typedef unsigned short bf16;
typedef unsigned v4u __attribute__((ext_vector_type(4)));
typedef float f32x4 __attribute__((ext_vector_type(4)));
typedef short bf16x8 __attribute__((ext_vector_type(8)));
typedef GAS unsigned gu32;
typedef GAS unsigned long long gu64;
#define RLX_AGENT __ATOMIC_RELAXED, __HIP_MEMORY_SCOPE_AGENT
#define LDS_WAIT() asm volatile("s_waitcnt lgkmcnt(0)" ::: "memory")
#define VM_WAIT() asm volatile("s_waitcnt vmcnt(0)" ::: "memory")
__device__ __forceinline__ unsigned long long rt() { return __builtin_amdgcn_s_memrealtime(); }
__device__ __forceinline__ unsigned f2bf(float f) { unsigned u = __builtin_bit_cast(unsigned, f); return (u + 0x7fffu + ((u >> 16) & 1u)) >> 16; }
__device__ __forceinline__ unsigned pk2(float lo, float hi) { return f2bf(lo) | (f2bf(hi) << 16); }

#define XB_TMO      128
#define XB_XCNT(j)  (256  + 64 * (j))
#define XB_XSUB(j)  (1280 + 64 * (j))
#define XB_XGEN(j)  (2304 + 64 * (j))
#define XB_TOP      3328
#define XB_TOPGEN   3392
#define XCD_BAR_WORDS 3456
#define XB_SPIN_CAP (1u << 18)

__device__ __forceinline__ unsigned xb_ld(unsigned* p)              { return __hip_atomic_load(p, __ATOMIC_RELAXED, __HIP_MEMORY_SCOPE_AGENT); }
__device__ __forceinline__ unsigned xb_add(unsigned* p, unsigned v) { return __hip_atomic_fetch_add(p, v, __ATOMIC_RELAXED, __HIP_MEMORY_SCOPE_AGENT); }
__device__ __forceinline__ unsigned xb_xcc_id() { return (unsigned)__builtin_amdgcn_s_getreg((3 << 11) | 20) & 0xFu; }
#define XB_SPIN(cond, bar) do { unsigned _sp = 0; while (cond) { __builtin_amdgcn_s_sleep(1); \
    if ((++_sp & 255u) == 0u) { if (xb_ld(&(bar)[XB_TMO])) break; if (_sp > XB_SPIN_CAP) { atomicAdd(&(bar)[XB_TMO], 1u); break; } } } } while (0)

struct XcdBarrier {
    unsigned* bar; unsigned x;
    volatile LAS unsigned* st;
};

__device__ __forceinline__ XcdBarrier xcd_barrier_post(unsigned* bar, volatile LAS unsigned* st) {
    XcdBarrier b; b.bar = bar; b.x = xb_xcc_id(); b.st = st;
    if (threadIdx.x == 0) (void)xb_add(&bar[XB_XCNT(b.x)], 1u);
    return b;
}
__device__ __forceinline__ void xcd_barrier_complete(unsigned* bar, unsigned x, unsigned& nloc, unsigned& nx) {
    const unsigned G = gridDim.x * gridDim.y * gridDim.z;
    unsigned sum, cnt, mine, sp = 0u;
    for (;;) {
        sum = 0u; cnt = 0u; mine = 0u;
#pragma unroll
        for (unsigned j = 0; j < 16; ++j) { const unsigned c = xb_ld(&bar[XB_XCNT(j)]); sum += c; cnt += (c > 0u) ? 1u : 0u; mine = (j == x) ? c : mine; }
        if (sum == G) break;
        __builtin_amdgcn_s_sleep(1);
        if ((++sp & 255u) == 0u) { if (xb_ld(&bar[XB_TMO])) break; if (sp > XB_SPIN_CAP) { atomicAdd(&bar[XB_TMO], 1u); break; } }
    }
    nloc = mine > 0u ? mine : 1u; nx = cnt > 0u ? cnt : 1u;
}

__device__ __forceinline__ void xcd_barrier(const XcdBarrier& b) {
    asm volatile("s_waitcnt vmcnt(0)" ::: "memory");
    __syncthreads();
    if (threadIdx.x == 0) {
        unsigned* bar = b.bar;
        __builtin_amdgcn_s_waitcnt(0);
        unsigned nloc = b.st[0], nx = b.st[1];
        if (nloc == 0u) { xcd_barrier_complete(bar, b.x, nloc, nx); b.st[0] = nloc; b.st[1] = nx; }
        const unsigned old = xb_add(&bar[XB_XSUB(b.x)], 1u);
        const unsigned gen = old / nloc;
        if (old + 1u == (gen + 1u) * nloc) {
            __builtin_amdgcn_fence(__ATOMIC_RELEASE, "agent");
            asm volatile("s_waitcnt vmcnt(0)" ::: "memory");
            const unsigned og = xb_add(&bar[XB_TOP], 1u);
            const unsigned tg = og / nx;
            if (og + 1u == (tg + 1u) * nx) xb_add(&bar[XB_TOPGEN], 1u);
            else XB_SPIN(xb_ld(&bar[XB_TOPGEN]) == tg, bar);
            __builtin_amdgcn_fence(__ATOMIC_ACQUIRE, "agent");
            xb_add(&bar[XB_XGEN(b.x)], 1u);
            asm volatile("s_waitcnt vmcnt(0)" ::: "memory");
        } else {
            XB_SPIN(xb_ld(&bar[XB_XGEN(b.x)]) == gen, bar);
            __builtin_amdgcn_fence(__ATOMIC_ACQUIRE, "agent");
            asm volatile("s_waitcnt vmcnt(0)" ::: "memory");
        }
    }
    __syncthreads();
}
constexpr int NWAVES = 8, NT = NWAVES * 64;
constexpr int BATCH = 4, SEQ = 4096, DM = 2048, CTXL = 256;
constexpr int MX = BATCH * SEQ, MC = BATCH * CTXL, MALL = MX + MC;
constexpr int WA = 1024, WB = 1024, NIN = 10256, NU = 10496;
constexpr int C_AQ = 0, C_AFF = 1024, C_AFB = 2048, C_AI = 3072, C_AZ = 4096, C_BQK = 5120, C_BV = 7168, C_BO = 8192, C_BZ = 9216, C_BG = 10240;
constexpr int HGH = 8, HGD = 128, MLH = 4, MLD = 256;
constexpr float ALPHA = 1.189207115002721f;
constexpr float LN_EPS = 1e-5f, NORM_EPS = 1e-6f;
constexpr int NMOD = 3 * DM;

#ifndef MK_N_LAUNCHES
#define MK_N_LAUNCHES 1
#endif
constexpr int N_PHASES = 8;

constexpr size_t MiB = 1u << 20;
constexpr size_t WS_CTL = 0, CTL_ZERO_BYTES = 128 * 1024;
constexpr size_t WS_MODP = 1 * MiB;
constexpr size_t WS_GATE = 3 * MiB;
constexpr size_t WS_WINT = 4 * MiB;
constexpr size_t WS_WOUTT = 45 * MiB;
constexpr size_t WS_XN = 53 * MiB;
constexpr size_t WS_U = 121 * MiB;
constexpr size_t WS_PE = 470 * MiB, WS_MLS = 473 * MiB, WS_DEC = 478 * MiB;
constexpr size_t WS_MLW = 479 * MiB;
constexpr size_t WS_DQP = 496 * MiB;
constexpr size_t WS_GG = 502 * MiB;
constexpr size_t WS_END = 504 * MiB;
static_assert(WS_WINT + (size_t)NU * DM * 2 <= WS_WOUTT && WS_WOUTT + (size_t)DM * DM * 2 <= WS_XN && WS_XN + (size_t)MALL * DM * 2 <= WS_U && WS_U + (size_t)MALL * NU * 2 <= WS_PE && WS_GG + ((size_t)MALL * 16 + 65536 + 256 * 8 * 64) * 4 <= WS_END, "d_ws map");
constexpr int CW_GEMV = 24576;
constexpr int CW_TMO = 0, CW_BAR = 4096;

constexpr int RING_OFF = 0, RING_BYTES = 131072;
constexpr int LDS_BYTES = 163840;
constexpr int LDSCTL_OFF = LDS_BYTES - 1024, MISC_OFF = LDSCTL_OFF + 320;

struct Frame {
    LAS unsigned char* lds;
    volatile LAS unsigned* MISC;
    gu32* ctl;
    int tid, lane, wave, vcu, G;
    const float *x, *c, *ctx, *c_ctx, *w_mod, *b_mod, *w_in, *conv_w, *conv_b, *hg_lb, *ml_gate_b, *hg_norm_w, *ml_norm_w, *w_out, *ln_g, *ln_b;
    float* out;
    float *modp, *gate;
    bf16 *WinT, *WoutT, *XN, *U;
    bf16 *QTF, *MLW; float *PE, *MLS, *DEC, *DQP, *GG;
    bf16 *OAF, *OAB, *HBF, *HBB;
};

typedef float f32x2_t __attribute__((ext_vector_type(2)));
#define LDS_BARRIER() do { asm volatile("s_waitcnt lgkmcnt(0)" ::: "memory"); __builtin_amdgcn_s_barrier(); asm volatile("" ::: "memory"); } while (0)
typedef __bf16 bf16x2_t __attribute__((ext_vector_type(2)));
#define NTL(p) __builtin_nontemporal_load(p)
__device__ __forceinline__ unsigned pkbf(float a, float b) { const f32x2_t v = {a, b}; return __builtin_bit_cast(unsigned, __builtin_convertvector(v, bf16x2_t)); }
__device__ __forceinline__ float bf2f(unsigned short u) { return __builtin_bit_cast(float, (unsigned)u << 16); }
__device__ __forceinline__ float lo2f(unsigned u) { return __builtin_bit_cast(float, u << 16); }
__device__ __forceinline__ float hi2f(unsigned u) { return __builtin_bit_cast(float, u & 0xffff0000u); }
__device__ __forceinline__ float siluf(float v) { return v / (1.f + __expf(-v)); }
__device__ __forceinline__ float sigmf(float v) { return 1.f / (1.f + __expf(-v)); }
__device__ __forceinline__ float wave_sum(float v) {
#pragma unroll
    for (int o = 1; o < 64; o <<= 1) v += __shfl_xor(v, o);
    return v;
}

constexpr int TLDW = 36;
template <bool ILV>
__device__ __forceinline__ void transpose_item(const float* W, int ldw, int nvalid, int K, bf16* WT, LAS unsigned* T, int kb, int nb, int lane) {
    const int q = lane >> 4, cl = lane & 15; int n = 64 * nb + 4 * cl;
    if (ILV && nb >= C_BO / 64 && nb < C_BG / 64) { const int g = nb - C_BO / 64, r = 4 * cl; n = r < 32 ? C_BO + 32 * g + r : C_BZ + 32 * g + (r - 32); }
    const bool ok = n < nvalid;
    const GAS float* p = (const GAS float*)W + (size_t)(64 * kb + 2 * q) * ldw + (ok ? n : 0);
    f32x4 v[16];
#pragma unroll
    for (int i = 0; i < 16; ++i) v[i] = NTL((const GAS f32x4*)(p + (size_t)(8 * (i >> 1) + (i & 1)) * ldw));
#pragma unroll
    for (int jj = 0; jj < 8; ++jj)
#pragma unroll
        for (int e = 0; e < 4; ++e) T[(4 * cl + e) * TLDW + 4 * jj + q] = ok ? pk2(v[2 * jj][e], v[2 * jj + 1][e]) : 0u;
    LDS_WAIT(); asm volatile("" ::: "memory");
    const int c = lane & 7;
#pragma unroll
    for (int t = 0; t < 8; ++t) { const int nn = 8 * t + (lane >> 3); const v4u o = *(const LAS v4u*)(T + nn * TLDW + 4 * c);
        *(GAS v4u*)((GAS bf16*)WT + (size_t)(64 * nb + nn) * K + 64 * kb + 8 * c) = o; }
    LDS_WAIT(); asm volatile("" ::: "memory");
}
constexpr int KS2 = 2;
__device__ __forceinline__ void p0_prep(Frame& F, const bool signal) {
    LAS float* scr = (LAS float*)(F.lds + RING_OFF + F.wave * 16384);
    LAS float* red = (LAS float*)(F.lds + RING_OFF + 131072);
    constexpr int NGEMV = (NMOD / 64) * KS2;
    for (int it = F.vcu; it < NGEMV; it += F.G) {
        const int cg = it >> 1, kh2 = it & 1, k0 = kh2 * 1024 + F.wave * 128, q = F.lane >> 4, cl = F.lane & 15;
        const GAS float* wp = (const GAS float*)F.w_mod + (size_t)(k0 + q) * NMOD + cg * 64 + 4 * cl;
        f32x4 w[32];
#pragma unroll
        for (int i = 0; i < 32; ++i) w[i] = NTL((const GAS f32x4*)(wp + (size_t)(4 * i) * NMOD));
#pragma unroll
        for (int rr = 0; rr < 5; ++rr)
#pragma unroll
            for (int j = 0; j < 2; ++j) { const int k = k0 + F.lane + 64 * j; const float v = rr < 4 ? F.c[rr * DM + k] : F.c_ctx[k]; scr[rr * 128 + F.lane + 64 * j] = siluf(v); }
        LDS_WAIT(); asm volatile("" ::: "memory");
        f32x4 a[5];
#pragma unroll
        for (int rr = 0; rr < 5; ++rr) a[rr] = (f32x4){0.f, 0.f, 0.f, 0.f};
#pragma unroll
        for (int i = 0; i < 32; ++i)
#pragma unroll
            for (int rr = 0; rr < 5; ++rr) a[rr] += scr[rr * 128 + 4 * i + q] * w[i];
#pragma unroll
        for (int rr = 0; rr < 5; ++rr)
#pragma unroll
            for (int e = 0; e < 4; ++e) { float t = a[rr][e]; t += __shfl_xor(t, 16); t += __shfl_xor(t, 32); a[rr][e] = t; }
        if (q == 0) {
#pragma unroll
            for (int rr = 0; rr < 5; ++rr) *(LAS f32x4*)(red + F.wave * 320 + rr * 64 + 4 * cl) = a[rr]; }
        __syncthreads();
        if (F.tid < 320) { float sacc = 0.f;
#pragma unroll
            for (int ww = 0; ww < 8; ++ww) sacc += red[ww * 320 + F.tid];
            const int rr = F.tid >> 6, nn = cg * 64 + (F.tid & 63);
            F.modp[((size_t)kh2 * 5 + rr) * NMOD + nn] = sacc + (kh2 == 0 ? F.b_mod[nn] : 0.f); }
        __syncthreads();
    }
    if (signal) { int mine = 0; for (int it = F.vcu; it < NGEMV; it += F.G) ++mine;
        if (mine) { asm volatile("s_waitcnt vmcnt(0)" ::: "memory"); __syncthreads();
            if (F.tid == 0) { __builtin_amdgcn_fence(__ATOMIC_RELEASE, "agent"); asm volatile("s_waitcnt vmcnt(0)" ::: "memory"); __hip_atomic_fetch_add((unsigned*)(F.ctl + CW_GEMV), (unsigned)mine, RLX_AGENT); } } }
    constexpr int NB_IN = NU / 64, I_IN = (DM / 64) * NB_IN;
    int base, cnt;
    if (F.G == 256) { static_assert(NGEMV * 17 + (256 - NGEMV) * 31 == I_IN, "P0 block split"); base = F.vcu < NGEMV ? 17 * F.vcu : 17 * NGEMV + 31 * (F.vcu - NGEMV); cnt = F.vcu < NGEMV ? 17 : 31; }
    else { const int per = (I_IN + F.G - 1) / F.G; base = F.vcu * per; cnt = I_IN - base < per ? I_IN - base : per; }
    for (int o = F.wave; o < cnt; o += NWAVES) { const int r = base + o;
        transpose_item<true>(F.w_in, NIN, NIN, DM, F.WinT, (LAS unsigned*)scr, r / NB_IN, r % NB_IN, F.lane); }
}
__device__ __forceinline__ void p2_wout_copy(Frame& F, const int nunits) {
    constexpr int NB_OUT = DM / 64, I_OUT = (DM / 64) * NB_OUT;
    LAS unsigned* scr = (LAS unsigned*)(F.lds + RING_OFF + F.wave * 16384);
    const int G = F.G, c = (int)blockIdx.x, rounds = (nunits + G - 1) / G, nsp = rounds * G - nunits;
    int w0, ws;
    if (nsp > 0) { if (c < G - nsp) return; w0 = (c - (G - nsp)) * NWAVES + F.wave; ws = nsp * NWAVES; }
    else { w0 = F.vcu * NWAVES + F.wave; ws = G * NWAVES; }
    for (int r = w0; r < I_OUT; r += ws) transpose_item<false>(F.w_out, DM, DM, DM, F.WoutT, scr, r / NB_OUT, r % NB_OUT, F.lane);
}

__device__ __forceinline__ void ln_mod_row2(Frame& F, const float* xa, const float* xb, bf16* oa, bf16* ob, const LAS float* shift, const LAS float* scale) {
    const GAS f32x4* ra = (const GAS f32x4*)xa + F.lane; const GAS f32x4* rb = (const GAS f32x4*)xb + F.lane;
    f32x4 va[8], vb[8]; float sa = 0.f, sb = 0.f;
#pragma unroll
    for (int j = 0; j < 8; ++j) { va[j] = NTL(ra + 64 * j); vb[j] = NTL(rb + 64 * j); }
#pragma unroll
    for (int j = 0; j < 8; ++j) { sa += (va[j].x + va[j].y) + (va[j].z + va[j].w); sb += (vb[j].x + vb[j].y) + (vb[j].z + vb[j].w); }
    const float ma = wave_sum(sa) * (1.f / DM), mb = wave_sum(sb) * (1.f / DM); float qa = 0.f, qb = 0.f;
#pragma unroll
    for (int j = 0; j < 8; ++j) { va[j] = va[j] - ma; vb[j] = vb[j] - mb; qa += (va[j].x * va[j].x + va[j].y * va[j].y) + (va[j].z * va[j].z + va[j].w * va[j].w); qb += (vb[j].x * vb[j].x + vb[j].y * vb[j].y) + (vb[j].z * vb[j].z + vb[j].w * vb[j].w); }
    const float rsa = 1.f / sqrtf(wave_sum(qa) * (1.f / DM) + LN_EPS), rsb = 1.f / sqrtf(wave_sum(qb) * (1.f / DM) + LN_EPS);
    GAS unsigned long long* o8a = (GAS unsigned long long*)oa + F.lane; GAS unsigned long long* o8b = (GAS unsigned long long*)ob + F.lane;
#pragma unroll
    for (int j = 0; j < 8; ++j) { const int k = 4 * F.lane + 256 * j; const f32x4 sc = *(const LAS f32x4*)(scale + k) + 1.f, sh = *(const LAS f32x4*)(shift + k);
        const f32x4 ha = va[j] * rsa * sc + sh, hb = vb[j] * rsb * sc + sh;
        o8a[64 * j] = (unsigned long long)pk2(ha.x, ha.y) | ((unsigned long long)pk2(ha.z, ha.w) << 32);
        o8b[64 * j] = (unsigned long long)pk2(hb.x, hb.y) | ((unsigned long long)pk2(hb.z, hb.w) << 32); }
}
__device__ __forceinline__ void ln_mod_row(Frame& F, const float* xrow, bf16* orow, const LAS float* shift, const LAS float* scale) {
    const GAS f32x4* xr = (const GAS f32x4*)xrow + F.lane;
    f32x4 v[8]; float s = 0.f;
#pragma unroll
    for (int j = 0; j < 8; ++j) { v[j] = NTL(xr + 64 * j); s += (v[j].x + v[j].y) + (v[j].z + v[j].w); }
    const float mean = wave_sum(s) * (1.f / DM); float s2 = 0.f;
#pragma unroll
    for (int j = 0; j < 8; ++j) { v[j] = v[j] - mean; s2 += (v[j].x * v[j].x + v[j].y * v[j].y) + (v[j].z * v[j].z + v[j].w * v[j].w); }
    const float rstd = 1.f / sqrtf(wave_sum(s2) * (1.f / DM) + LN_EPS);
    GAS unsigned long long* o8 = (GAS unsigned long long*)orow + F.lane;
#pragma unroll
    for (int j = 0; j < 8; ++j) { const int k = 4 * F.lane + 256 * j; const f32x4 sc = *(const LAS f32x4*)(scale + k), sh = *(const LAS f32x4*)(shift + k);
        const f32x4 h = v[j] * rstd * (sc + 1.f) + sh;
        o8[64 * j] = (unsigned long long)pk2(h.x, h.y) | ((unsigned long long)pk2(h.z, h.w) << 32); }
}
__device__ __forceinline__ void gemv_wait(Frame& F) {
    if (F.tid == 0) { unsigned sp = 0; while (__hip_atomic_load((unsigned*)(F.ctl + CW_GEMV), RLX_AGENT) < (unsigned)((NMOD / 64) * KS2)) { __builtin_amdgcn_s_sleep(2); if (++sp > (1u << 22)) break; }
        __builtin_amdgcn_fence(__ATOMIC_ACQUIRE, "agent"); asm volatile("s_waitcnt vmcnt(0)" ::: "memory"); }
    __syncthreads();
}
__device__ __forceinline__ void p1_lnmod(Frame& F) {
    LAS float* md = (LAS float*)(F.lds + RING_OFF);
    for (int e = F.vcu * NT + F.tid; e < BATCH * DM; e += F.G * NT) { const int b = e / DM, n = e % DM;
        F.gate[e] = F.modp[(size_t)b * NMOD + 2 * DM + n] + F.modp[((size_t)5 + b) * NMOD + 2 * DM + n]; }
    for (int blk = F.vcu; blk < 256; blk += F.G) {
        const int b = blk >> 6;
        __syncthreads();
        { float m0v[16], m1v[16];
#pragma unroll
          for (int i = 0; i < 16; ++i) { const int e = F.tid + NT * i; const int row = e < 2 * DM ? b : 4, col = e & (2 * DM - 1); m0v[i] = F.modp[(size_t)row * NMOD + col]; m1v[i] = F.modp[((size_t)5 + row) * NMOD + col]; }
#pragma unroll
          for (int i = 0; i < 16; ++i) md[F.tid + NT * i] = m0v[i] + m1v[i]; }
        __syncthreads();
#pragma unroll 1
        for (int r = 0; r < 8; r += 2) { const int m = blk * 64 + F.wave * 8 + r;
            ln_mod_row2(F, F.x + (size_t)m * DM, F.x + (size_t)(m + 1) * DM, F.XN + (size_t)m * DM, F.XN + (size_t)(m + 1) * DM, md, md + DM); }
        if (F.wave < 4) { const int m = blk * 4 + F.wave; ln_mod_row(F, F.ctx + (size_t)m * DM, F.XN + (size_t)(MX + m) * DM, md + 2 * DM, md + 3 * DM); }
    }
}

__device__ __forceinline__ float rcpf_(float v) { return __builtin_amdgcn_rcpf(v); }
__device__ __forceinline__ float silu_fast(float v) { return v * rcpf_(1.f + __expf(-v)); }
#ifndef P3_CA
#define P3_CA 8
#endif
#ifndef P3_CB
#define P3_CB 9
#endif
constexpr int NSC = 4;
__device__ __forceinline__ void p3_conv(Frame& F) {
    bf16* QKM = F.XN;
    if (F.G > 2 * NSC && F.vcu < NSC) return;
    const int wk = F.G > 2 * NSC ? F.vcu - NSC : F.vcu, NW = F.G > 2 * NSC ? F.G - NSC : F.G;
    const int gw = wk * NWAVES + F.wave, NGW = NW * NWAVES;
    const int cq = gw & 3, ch = cq * 512 + F.lane * 8;
    LAS float* WL = (LAS float*)F.lds;
    for (int i = F.tid; i < 9 * 2048 / 4; i += NT) ((LAS f32x4*)WL)[i] = ((const GAS f32x4*)F.conv_w)[i];
    __syncthreads();
    const f32x4 ba = *(const GAS f32x4*)(F.conv_b + ch), bb = *(const GAS f32x4*)(F.conv_b + ch + 4);
    const f32x2_t bias2[4] = {(f32x2_t){ba.x, ba.y}, (f32x2_t){ba.z, ba.w}, (f32x2_t){bb.x, bb.y}, (f32x2_t){bb.z, bb.w}};
    const float sc = ch >= 1024 ? 0.0625f : 1.f;
    constexpr int NLAT = BATCH * 32 * 16, NCTX = BATCH * (CTXL / 8);
    constexpr int CA = P3_CA, CB = P3_CB, NB1 = (NLAT + NCTX - 80 * CA) - 172 * (CB - 1);
    static_assert(NB1 >= 0 && NB1 <= 172 && 80 * CA + NB1 * CB + (172 - NB1) * (CB - 1) == NLAT + NCTX, "conv split");
    int it0 = gw >> 2, it1 = NLAT + NCTX, its = NGW >> 2;
    if (NW == 252) { const int j = wk - 80; const int lo = wk < 80 ? CA * wk : 80 * CA + (j < NB1 ? CB * j : NB1 * CB + (CB - 1) * (j - NB1)); const int len = wk < 80 ? CA : (j < NB1 ? CB : CB - 1);
        it0 = lo + (F.wave >> 2); it1 = lo + len; its = 2; }
    const v4u zero4 = {0u, 0u, 0u, 0u};
    for (int it = it0; it < it1; it += its) {
        const bool lat = it < NLAT; const int ic = it - NLAT;
        const int b = lat ? it >> 9 : ic >> 5, r0 = lat ? ((it >> 4) & 31) * 2 : 0, c0 = lat ? (it & 15) * 4 : (ic & 31) * 8, ncol = lat ? 64 : CTXL;
        const unsigned rowb = lat ? (unsigned)(b * SEQ) : (unsigned)(MX + b * CTXL);
        v4u in[4][6];
#pragma unroll
        for (int ir = 0; ir < 4; ++ir) { int rr = r0 + ir - 1; rr = rr < 0 ? 0 : (rr > 63 ? 63 : rr);
#pragma unroll
            for (int j = 0; j < 6; ++j) { int cc = (lat ? c0 : c0 + 4 * (ir - 1)) + j - 1; cc = cc < 0 ? 0 : (cc >= ncol ? ncol - 1 : cc);
                const unsigned off = ((rowb + (unsigned)(lat ? rr * 64 : 0) + (unsigned)cc) * (unsigned)NU + (unsigned)(C_BQK + ch)) * 2u;
                in[ir][j] = *(const GAS v4u*)((const GAS char*)F.U + off); } }
        f32x2_t acc[2][4][4];
#pragma unroll
        for (int orow = 0; orow < 2; ++orow)
#pragma unroll
            for (int o = 0; o < 4; ++o)
#pragma unroll
                for (int c = 0; c < 4; ++c) acc[orow][o][c] = bias2[c];
#pragma unroll
        for (int dr = 0; dr < 3; ++dr)
#pragma unroll
            for (int dc = 0; dc < 3; ++dc) {
                const f32x4 a = *(const LAS f32x4*)(WL + (dr * 3 + dc) * 2048 + ch), bq = *(const LAS f32x4*)(WL + (dr * 3 + dc) * 2048 + ch + 4);
                const f32x2_t w0 = {a.x, a.y}, w1 = {a.z, a.w}, w2_ = {bq.x, bq.y}, w3 = {bq.z, bq.w};
#pragma unroll
                for (int orow = 0; orow < 2; ++orow) { const int ir = orow + dr;
                    const bool rok = lat ? (r0 + ir - 1 >= 0 && r0 + ir - 1 < 64) : dr == 1;
#pragma unroll
                    for (int o = 0; o < 4; ++o) { const int j = o + dc, cc = (lat ? c0 : c0 + 4 * (ir - 1)) + j - 1; const bool ok = rok && cc >= 0 && cc < ncol; const v4u u = ok ? in[ir][j] : zero4;
                        acc[orow][o][0] += (f32x2_t){lo2f(u.x), hi2f(u.x)} * w0; acc[orow][o][1] += (f32x2_t){lo2f(u.y), hi2f(u.y)} * w1;
                        acc[orow][o][2] += (f32x2_t){lo2f(u.z), hi2f(u.z)} * w2_; acc[orow][o][3] += (f32x2_t){lo2f(u.w), hi2f(u.w)} * w3; } } }
#pragma unroll
        for (int orow = 0; orow < 2; ++orow)
#pragma unroll
            for (int o = 0; o < 4; ++o) { unsigned ov[4];
#pragma unroll
                for (int c = 0; c < 4; ++c) ov[c] = pk2(silu_fast(acc[orow][o][c].x) * sc, silu_fast(acc[orow][o][c].y) * sc);
                const unsigned tok = lat ? (unsigned)((r0 + orow) * 64 + c0 + o) : (unsigned)(c0 + 4 * orow + o);
                const unsigned ooff = ((rowb + tok) * (unsigned)DM + (unsigned)ch) * 2u;
                *(GAS v4u*)((GAS char*)QKM + ooff) = (v4u){ov[0], ov[1], ov[2], ov[3]}; }
    }
}

constexpr int NCHUNK = MALL / 64;
__device__ __forceinline__ void gate_fk(float z, float lb, float& f, float& kk) {
    const float e = __expf(-fabsf(z)); const float rb = 1.f / (1.f + e), rs = e * rb;
    const float sg = z >= 0.f ? rb : rs, sn = z >= 0.f ? rs : rb;
    f = lb + (1.f - lb) * sg; kk = (1.f - lb) * sn;
}
template <int DIR>
__device__ __forceinline__ float hg_walk(LAS unsigned char* L, int cl, float lb, float olb, unsigned (&qb)[32]) {
    constexpr int TQ = 0, TZF = 32768, TZB = 65536, TQF = 98304;
    LAS unsigned short* zt = (LAS unsigned short*)(L + (DIR ? TZB : TZF)) + cl;
    const LAS unsigned short* qtile = (const LAS unsigned short*)(L + TQ) + cl;
    LAS unsigned short* qf = (LAS unsigned short*)(L + TQF) + cl;
    float P = 1.f;
#pragma unroll
    for (int blk = 0; blk < 4; ++blk) {
        unsigned short zr[16], qr[16];
#pragma unroll
        for (int j = 0; j < 16; ++j) { const int pp = blk * 16 + j, p = DIR ? 63 - pp : pp; zr[j] = zt[p * 256]; qr[j] = qtile[p * 256]; }
#pragma unroll
        for (int j = 0; j < 16; ++j) { const int pp = blk * 16 + j, p = DIR ? 63 - pp : pp;
            const float z = bf2f(zr[j]), q = bf2f(qr[j]);
            const float e = __expf(-fabsf(z)); const float rbig = rcpf_(1.f + e), rsm = e * rbig;
            const float sg = z >= 0.f ? rbig : rsm, sn = z >= 0.f ? rsm : rbig;
            const float f = lb + olb * sg, kk = olb * sn; P *= f;
            const float qt = q * P, kt = kk * rcpf_(P);
            zt[p * 256] = (unsigned short)(pkbf(kt, 0.f) & 0xffffu);
            const unsigned qh = pkbf(qt, 0.f) & 0xffffu;
            if (DIR) { if (pp & 1) qb[pp >> 1] |= qh << 16; else qb[pp >> 1] = qh; } else qf[p * 256] = (unsigned short)qh; }
    }
    return P;
}
template <int DIR>
__device__ __forceinline__ f32x2_t hg_walk2(LAS unsigned char* L, int cp, f32x2_t lb, f32x2_t olb, unsigned (&qb)[64]) {
    constexpr int TQ = 0, TZF = 32768, TZB = 65536, TQF = 98304;
    LAS unsigned* zt = (LAS unsigned*)(L + (DIR ? TZB : TZF)) + cp;
    const LAS unsigned* qtile = (const LAS unsigned*)(L + TQ) + cp;
    LAS unsigned* qf = (LAS unsigned*)(L + TQF) + cp;
    f32x2_t P = {1.f, 1.f};
#pragma unroll
    for (int blk = 0; blk < 4; ++blk) {
        unsigned zr[16], qr[16];
#pragma unroll
        for (int j = 0; j < 16; ++j) { const int pp = blk * 16 + j, p = DIR ? 63 - pp : pp; zr[j] = zt[p * 128]; qr[j] = qtile[p * 128]; }
#pragma unroll
        for (int j = 0; j < 16; ++j) { const int pp = blk * 16 + j, p = DIR ? 63 - pp : pp;
            const f32x2_t z = {lo2f(zr[j]), hi2f(zr[j])}, q = {lo2f(qr[j]), hi2f(qr[j])};
            f32x2_t sg; sg.x = rcpf_(1.f + __expf(-z.x)); sg.y = rcpf_(1.f + __expf(-z.y));
            const f32x2_t sn = 1.f - sg, f = lb + olb * sg, kk = olb * sn; P = P * f;
            f32x2_t ip; ip.x = rcpf_(P.x); ip.y = rcpf_(P.y);
            const f32x2_t qt = q * P, kt = kk * ip;
            zt[p * 128] = pkbf(kt.x, kt.y);
            const unsigned qh = pkbf(qt.x, qt.y);
            if (DIR) qb[pp] = qh; else qf[p * 128] = qh; }
    }
    return P;
}
template <bool DUMMY>
__device__ __forceinline__ void p3_hg_prep(Frame& F) {
    bf16* dq = F.OAF; bf16* dkf = F.OAB; bf16* dkb = F.HBF;
    LAS unsigned char* L = F.lds;
    constexpr int TQ = 0, TZF = 32768, TZB = 65536, TQF = 98304;
    const int tid = F.tid, dirn = (F.wave >> 1) & 1, cp = tid & 127; const bool walker = F.wave < 4;
    if (F.G > 2 * NSC && F.vcu < NSC) return;
    const int wk = F.G > 2 * NSC ? F.vcu - NSC : F.vcu, NW = F.G > 2 * NSC ? F.G - NSC : F.G;
    v4u pre[3][4];
    auto issue = [&](int it) { const int cid = it >> 2, cb = (it & 3) * 256; const size_t row0 = (size_t)cid * 64;
#pragma unroll
        for (int i = 0; i < 4; ++i) { const int piece = tid + NT * i, row = piece >> 5, c16 = piece & 31; const bf16* ur = F.U + (row0 + row) * NU + cb + c16 * 8;
            pre[0][i] = NTL((const GAS v4u*)(ur + C_AQ)); pre[1][i] = NTL((const GAS v4u*)(ur + C_AFF)); pre[2][i] = NTL((const GAS v4u*)(ur + C_AFB)); } };
    int it = wk;
    if (it < NCHUNK * 4) issue(it);
    f32x2_t lbv[4];
#pragma unroll
    for (int g = 0; g < 4; ++g) { const int c = g * 256 + 2 * cp; const f32x2_t h0 = *(const GAS f32x2_t*)(F.hg_lb + (dirn * 2) * WA + c), h1 = *(const GAS f32x2_t*)(F.hg_lb + (dirn * 2 + 1) * WA + c);
        lbv[g].x = sigmf(h0.x - h1.x); lbv[g].y = sigmf(h0.y - h1.y); }
    for (; it < NCHUNK * 4; it += NW) {
        const int cid = it >> 2, cb = (it & 3) * 256; const size_t row0 = (size_t)cid * 64;
        __syncthreads();
#pragma unroll
        for (int i = 0; i < 4; ++i) { const int piece = tid + NT * i; *(LAS v4u*)(L + TQ + piece * 16) = pre[0][i]; *(LAS v4u*)(L + TZF + piece * 16) = pre[1][i]; *(LAS v4u*)(L + TZB + piece * 16) = pre[2][i]; }
        __syncthreads();
        if (it + NW < NCHUNK * 4) issue(it + NW);
        const int c = cb + 2 * cp;
        const int gsel = it & 3; const f32x2_t lb = gsel == 0 ? lbv[0] : (gsel == 1 ? lbv[1] : (gsel == 2 ? lbv[2] : lbv[3])), olb = 1.f - lb;
        unsigned qb[64];
        if (walker) { f32x2_t P;
            if (dirn) P = hg_walk2<1>(L, cp, lb, olb, qb); else P = hg_walk2<0>(L, cp, lb, olb, qb);
            *(GAS f32x2_t*)(F.PE + (size_t)(dirn * NCHUNK + cid) * WA + c) = P; }
        __syncthreads();
        if (walker && dirn) {
            LAS unsigned* qw = (LAS unsigned*)(L + TQ) + cp;
#pragma unroll
            for (int pp = 0; pp < 64; ++pp) qw[(63 - pp) * 128] = qb[pp];
        }
        __syncthreads();
#pragma unroll
        for (int i = 0; i < 4; ++i) { const int piece = tid + NT * i, row = piece >> 5, c16 = piece & 31; const size_t r = row0 + row; bf16* ur = F.U + r * NU + cb + c16 * 8;
            const v4u vq = *(const LAS v4u*)(L + TQ + piece * 16), vf = *(const LAS v4u*)(L + TZF + piece * 16), vb = *(const LAS v4u*)(L + TZB + piece * 16), vqf = *(const LAS v4u*)(L + TQF + piece * 16);
            *(GAS v4u*)(F.QTF + r * WA + cb + c16 * 8) = vqf;
            if (DUMMY) { if (r < MX) { *(GAS v4u*)(dq + r * WA + cb + c16 * 8) = vq; *(GAS v4u*)(dkf + r * WA + cb + c16 * 8) = vf; *(GAS v4u*)(dkb + r * WA + cb + c16 * 8) = vb; } }
            else { *(GAS v4u*)(ur + C_AQ) = vq; *(GAS v4u*)(ur + C_AFF) = vf; *(GAS v4u*)(ur + C_AFB) = vb; } }
    }
    __syncthreads();
}
template <int CTRL, int RM> __device__ __forceinline__ float dpp_f(float idv, float x) { return __builtin_bit_cast(float, __builtin_amdgcn_update_dpp(__builtin_bit_cast(int, idv), __builtin_bit_cast(int, x), CTRL, RM, 0xf, false)); }
__device__ __forceinline__ float wave_scan_add(float x) {
    x += dpp_f<0x111, 0xf>(0.f, x); x += dpp_f<0x112, 0xf>(0.f, x); x += dpp_f<0x114, 0xf>(0.f, x); x += dpp_f<0x118, 0xf>(0.f, x);
    x += dpp_f<0x142, 0xa>(0.f, x); x += dpp_f<0x143, 0xc>(0.f, x); return x; }
__device__ __forceinline__ float wave_scan_max(float x) { const float ni = -__builtin_inff();
    x = fmaxf(x, dpp_f<0x111, 0xf>(ni, x)); x = fmaxf(x, dpp_f<0x112, 0xf>(ni, x)); x = fmaxf(x, dpp_f<0x114, 0xf>(ni, x)); x = fmaxf(x, dpp_f<0x118, 0xf>(ni, x));
    x = fmaxf(x, dpp_f<0x142, 0xa>(ni, x)); x = fmaxf(x, dpp_f<0x143, 0xc>(ni, x)); return x; }
__device__ __forceinline__ void p3_ml_scalars(Frame& F) {
    const int gw = F.vcu * NWAVES + F.wave;
    if (gw >= 32) return;
    const int dirn = gw & 1, h = (gw >> 1) & 3, b = gw >> 3;
    const float gbi = F.ml_gate_b[dirn * 4 + h], gbf = F.ml_gate_b[(2 + dirn) * 4 + h];
    float m0 = 0.f;
    float* mls = F.MLS + (size_t)(dirn * 4 + h) * MALL * 8;
    auto row_of = [&](int n) -> int { int row0; if (n < 4) { const int cc = dirn ? 3 - n : n; row0 = MX + b * CTXL + cc * 64; } else { const int lc = dirn ? 67 - n : n - 4; row0 = b * SEQ + lc * 64; }
        return row0 + (dirn ? 63 - F.lane : F.lane); };
    LAS unsigned* G = (LAS unsigned*)(F.lds + F.wave * 17408);
#pragma unroll 1
    for (int nb = 0; nb < 68; nb += 17) {
        float gi_r[17], gf_r[17];
#pragma unroll
        for (int j = 0; j < 17; ++j) { const int row = row_of(nb + j); gi_r[j] = F.GG[(size_t)row * 16 + dirn * 4 + h]; gf_r[j] = F.GG[(size_t)row * 16 + 8 + dirn * 4 + h]; }
#pragma unroll
        for (int j = 0; j < 17; ++j) G[(nb + j) * 64 + F.lane] = pkbf(gi_r[j], gf_r[j]);
    }
    LDS_WAIT(); asm volatile("" ::: "memory");
#pragma unroll 1
    for (int nb = 0; nb < 68; nb += 4) {
        float gi[4], cs[4], a[4], cm[4], cs63[4], cm63[4];
#pragma unroll
        for (int j = 0; j < 4; ++j) { const unsigned g = G[(nb + j) * 64 + F.lane]; gi[j] = lo2f(g) + gbi; const float gf = hi2f(g) + gbf;
            cs[j] = fminf(gf, 0.f) - __logf(1.f + __expf(-fabsf(gf))); }
#pragma unroll
        for (int j = 0; j < 4; ++j) cs[j] = wave_scan_add(cs[j]);
#pragma unroll
        for (int j = 0; j < 4; ++j) { a[j] = gi[j] - cs[j]; cm[j] = a[j]; }
#pragma unroll
        for (int j = 0; j < 4; ++j) cm[j] = wave_scan_max(cm[j]);
#pragma unroll
        for (int j = 0; j < 4; ++j) { cs63[j] = __shfl(cs[j], 63); cm63[j] = __shfl(cm[j], 63); }
#pragma unroll
        for (int j = 0; j < 4; ++j) {
            const int row = row_of(nb + j);
            const float mx = fmaxf(m0, cm[j]), m63 = fmaxf(m0, cm63[j]);
            f32x4 o0; o0.x = a[j]; o0.y = mx; o0.z = __expf(m0 - mx); o0.w = __expf(a[j] - m63);
            f32x4 o1; o1.x = __expf(-(cs[j] + mx)); o1.y = 0.f; o1.z = __expf(m0 - m63); o1.w = 0.f;
            *(f32x4*)(mls + (size_t)row * 8) = o0; *(f32x4*)(mls + (size_t)row * 8 + 4) = o1;
            const int row0 = row - (dirn ? 63 - F.lane : F.lane);
            if (F.lane == 0) F.DEC[(dirn * 4 + h) * NCHUNK + (row0 >> 6)] = __expf(m0 - m63);
            m0 = cs63[j] + m63;
        }
    }
}

typedef short s16x4 __attribute__((ext_vector_type(4)));
typedef float f32x16 __attribute__((ext_vector_type(16)));
#define MFMA32(a, b, c) __builtin_amdgcn_mfma_f32_32x32x16_bf16((a), (b), (c), 0, 0, 0)
__device__ __forceinline__ bf16x8 pk8(float a0, float a1, float a2, float a3, float a4, float a5, float a6, float a7) {
    const v4u u = {pkbf(a0, a1), pkbf(a2, a3), pkbf(a4, a5), pkbf(a6, a7)}; return __builtin_bit_cast(bf16x8, u); }
__device__ __forceinline__ bf16x8 cat4(s16x4 lo, s16x4 hi) { return __builtin_shufflevector(lo, hi, 0, 1, 2, 3, 4, 5, 6, 7); }
__device__ __forceinline__ s16x4 lds_tr(LAS unsigned char* p) { return __builtin_amdgcn_ds_read_tr16_b64_v4i16((LAS s16x4*)p); }
__device__ __forceinline__ unsigned img_off_a(unsigned row, unsigned ch) { return 2048u * (row >> 3) + 512u * (ch >> 2) + 64u * (row & 7) + 16u * ((ch & 3) ^ ((row >> 2) & 3)); }
__device__ __forceinline__ unsigned img_addr(unsigned row, unsigned ch, unsigned ncb) { return ((row >> 5) * ncb + (ch >> 4)) * 8192u + img_off_a(row & 31, ch & 15); }
__device__ __forceinline__ unsigned v_addr(unsigned row, unsigned ch) { const unsigned r = row & 31; return (row >> 5) * 4096u + 1024u * (r >> 3) + 512u * (ch >> 2) + 64u * (r & 7) + 16u * ((ch & 3) ^ ((r >> 2) & 3)); }

constexpr int SL_QT = 0, SL_KT = 32768, SL_V = 65536, SL_VW = 73728, SL_SF = 81920, SL_XCH = 114688, SL_SC = 131072, SL_W = 144384;
constexpr int SC_PAR = 448, SC_DQW = 896, SC_N0 = 1024, SC_NP = 1280;


__device__ __forceinline__ void p3b_ml_scores(Frame& F) {
    LAS unsigned char* L = F.lds;
    constexpr int BQ = 0, BK = 32768, BX = 65536, BS = 98304;
    LAS float* SCA = (LAS float*)(L + BS);
    const int tid = F.tid, lane = F.lane, w = F.wave, ts = w & 1, tp = (w >> 1) & 1, kh = w >> 2;
    const unsigned hh = lane >> 5, x4 = (lane >> 2) & 3;
    const unsigned LB0 = 2048u * ((lane >> 3) & 3) + 64u * (lane & 7);
    unsigned LBx[2];
#pragma unroll
    for (int e = 0; e < 2; ++e) LBx[e] = LB0 + 16u * ((2u * e + hh) ^ x4) + kh * 8192u;
    v4u pq[4], pk[4]; f32x2_t psc;
    auto issue = [&](int it) { const int lc = it & 63, h = (it >> 6) & 3, b = it >> 8; const size_t row0 = (size_t)b * SEQ + lc * 64;
        int tv = F.tid; asm volatile("" : "+v"(tv));
#pragma unroll
        for (int i = 0; i < 4; ++i) { const int u = ((tv >> 6) + 8 * i) * 8 + ((tv & 63) >> 3), row = 2 * (u >> 3) + ((tv >> 2) & 1), ch = 4 * (u & 7) + (tv & 3);
            pq[i] = *(const GAS v4u*)(F.XN + (row0 + row) * DM + h * MLD + ch * 8); pk[i] = *(const GAS v4u*)(F.XN + (row0 + row) * DM + WB + h * MLD + ch * 8); }
        if (tv < 128) psc = *(const GAS f32x2_t*)(F.MLS + ((size_t)((tv >> 6) * 4 + h) * MALL + row0 + (tv & 63)) * 8); };
    int it = F.vcu;
    if (it < 1024) issue(it);
    for (; it < 1024; it += F.G) {
        const int lc = it & 63, h = (it >> 6) & 3, b = it >> 8; const size_t row0 = (size_t)b * SEQ + lc * 64;
        __syncthreads();
        { int tv = F.tid; asm volatile("" : "+v"(tv));
#pragma unroll
          for (int i = 0; i < 4; ++i) { const int u = ((tv >> 6) + 8 * i) * 8 + ((tv & 63) >> 3), row = 2 * (u >> 3) + ((tv >> 2) & 1), ch = 4 * (u & 7) + (tv & 3); const unsigned a = img_addr(row, ch, 2); *(LAS v4u*)(L + BQ + a) = pq[i]; *(LAS v4u*)(L + BK + a) = pk[i]; }
          if (tv < 128) { SCA[(tv >> 6) * 128 + (tv & 63)] = psc.x; SCA[(tv >> 6) * 128 + 64 + (tv & 63)] = psc.y; } }
        __syncthreads();
        if (it + F.G < 1024) issue(it + F.G);
        f32x16 c;
#pragma unroll
        for (int r = 0; r < 16; ++r) c[r] = 0.f;
#pragma unroll
        for (int s = 0; s < 8; ++s) {
            const bf16x8 a = *(const LAS bf16x8*)(L + BK + ts * 16384 + 512 * (s >> 1) + LBx[s & 1]);
            const bf16x8 bq = *(const LAS bf16x8*)(L + BQ + tp * 16384 + 512 * (s >> 1) + LBx[s & 1]);
            c = MFMA32(a, bq, c);
        }
#pragma unroll
        for (int r = 0; r < 16; ++r) *(LAS float*)(L + BX + (((kh * 4 + ts * 2 + tp) * 16 + r) * 64 + lane) * 4) = c[r];
        __syncthreads();
#pragma unroll
        for (int r = 0; r < 16; ++r) c[r] += *(const LAS float*)(L + BX + ((((1 - kh) * 4 + ts * 2 + tp) * 16 + r) * 64 + lane) * 4);
        const int dirn = kh;
        const bool need = dirn ? (ts >= tp) : (ts <= tp);
        const float mxp = SCA[dirn * 128 + 64 + 32 * tp + (lane & 31)];
        int dl = (lane & 31) - 4 * (int)hh; if (dirn) dl = -dl; asm volatile("" : "+v"(dl));
        const int sg1 = dirn ? -1 : 1; const bool diag = ts == tp;
        float rs = 0.f;
        bf16* wout = F.MLW + ((size_t)((dirn * 4 + h) * 256 + (int)(row0 >> 6)) * 4096) + (32 * tp + (lane & 31)) * 64 + 32 * ts + 4 * hh;
#pragma unroll
        for (int g = 0; g < 4; ++g) {
            const f32x4 av = *(const LAS f32x4*)(SCA + dirn * 128 + 32 * ts + 8 * g + 4 * hh);
            float wv[4];
#pragma unroll
            for (int j = 0; j < 4; ++j) { float v = need ? c[4 * g + j] * __expf(av[j] - mxp) : 0.f;
                if (diag) v = (dl - sg1 * (j + 8 * g) >= 0) ? v : 0.f;
                wv[j] = v; rs += v; }
            *(GAS unsigned long long*)(wout + 8 * g) = (unsigned long long)pkbf(wv[0], wv[1]) | ((unsigned long long)pkbf(wv[2], wv[3]) << 32);
        }
        rs += __shfl_xor(rs, 32);
        if (lane < 32) SCA[256 + (dirn * 2 + ts) * 64 + 32 * tp + lane] = rs;
        __syncthreads();
        if (tid < 128) { const int d = tid >> 6, p = tid & 63; F.MLS[((size_t)(d * 4 + h) * MALL + row0 + p) * 8 + 5] = SCA[256 + (d * 2) * 64 + p] + SCA[256 + (d * 2 + 1) * 64 + p]; }
    }
    __syncthreads();
}

template <bool ML, int SKIP = 0>
__device__ __forceinline__ void scan_task(Frame& F, int task) {
    constexpr int NKT = ML ? 8 : 4, NCB = NKT / 4, NKH = NKT / 2, NOWN = NKT / 4, NPQ = ML ? 4 : 2, DKK = 32 * NKT;
    int vs, dirn, h, b;
    if (ML) { vs = task & 3; dirn = (task >> 2) & 1; h = (task >> 3) & 3; b = task >> 5; } else { vs = task & 1; dirn = (task >> 1) & 1; h = (task >> 2) & 7; b = task >> 5; }
    const int lane = F.lane, w = F.wave, tid = F.tid; const int tp = (w >> 2) & 1, tj = (w >> 1) & 1, kh = w & 1;
    const unsigned hh = lane >> 5, q4 = (lane & 15) >> 2, p4 = lane & 3, blk = (lane >> 4) & 1, x4 = (lane >> 2) & 3;
    LAS unsigned char* L = F.lds;
    LAS float* SC = (LAS float*)(L + SL_SC);
    const unsigned LB0 = 2048u * ((lane >> 3) & 3) + 64u * (lane & 7);
    const unsigned khoff = ML ? kh * 8192u : kh * 1024u;
    unsigned LBx[2], LK[2][2], TRK[2], VK[2], VN[2], WL[2];
#pragma unroll
    for (int e = 0; e < 2; ++e) { LBx[e] = LB0 + 16u * ((2u * e + hh) ^ x4) + khoff; WL[e] = 1024u * ((lane >> 3) & 3) + 64u * (lane & 7) + 16u * ((2u * e + hh) ^ x4);
#pragma unroll
        for (int t = 0; t < 2; ++t) LK[e][t] = LB0 + 16u * ((2u * e + t) ^ x4) + 8u * hh + khoff; }
#pragma unroll
    for (int t = 0; t < 2; ++t) {
        TRK[t] = 2048u * hh + 64u * q4 + 8u * (p4 & 1) + 16u * ((2u * blk + (p4 >> 1)) ^ (2u * hh + t));
        VK[t] = 64u * (4u * hh + q4) + 8u * (p4 & 1) + 16u * ((2u * blk + (p4 >> 1)) ^ (2u * t + hh)) + 512u * tj;
        VN[t] = 1024u * hh + 64u * q4 + 8u * (p4 & 1) + 512u * tj + 16u * ((2u * blk + (p4 >> 1)) ^ (2u * hh + t)); }
    unsigned tkoff[NOWN];
#pragma unroll
    for (int i = 0; i < NOWN; ++i) { const unsigned tk = kh * NKH + tp * NOWN + i; tkoff[i] = (tk >> 2) * 8192u + 512u * (tk & 3); }
    const bf16 *gq, *gk, *gv; int sq, sk; bf16* go;
    if (ML) { gq = F.XN + h * MLD; gk = F.XN + WB + h * MLD; sq = DM; sk = DM; gv = F.U + C_BV + h * MLD + vs * 64; go = (dirn ? F.HBB : F.HBF) + h * MLD + vs * 64; }
    else { if (dirn) { gq = F.U + C_AQ + h * HGD; sq = NU; gk = F.U + C_AFB + h * HGD; } else { gq = F.QTF + h * HGD; sq = WA; gk = F.U + C_AFF + h * HGD; }
        sk = NU; gv = F.U + C_AI + h * HGD + vs * 64; go = (dirn ? F.OAB : F.OAF) + h * HGD + vs * 64; }
    const float* mls = F.MLS + (size_t)(dirn * 4 + h) * MALL * 8;
    const float* pev = F.PE + (size_t)dirn * NCHUNK * WA + h * HGD;
    f32x16 S[NOWN];
#pragma unroll
    for (int i = 0; i < NOWN; ++i)
#pragma unroll
        for (int r = 0; r < 16; ++r) S[i][r] = 0.f;
    v4u pq[NPQ], pk[NPQ], pv, pw; f32x4 ps0, ps1; float pws;
    const bf16* gw_ = F.MLW + (size_t)(dirn * 4 + h) * 256 * 4096;
    auto row0_of = [&](int n) -> int { if (n < 4) { const int cc = dirn ? 3 - n : n; return MX + b * CTXL + cc * 64; } const int lc = dirn ? 67 - n : n - 4; return b * SEQ + lc * 64; };
    int offq[NPQ], offk[NPQ]; unsigned aimg[NPQ];
#pragma unroll
    for (int i = 0; i < NPQ; ++i) { const int u = (w + 8 * i) * 8 + (lane >> 3), NB = NCB * 4, row = 2 * (u / NB) + ((lane >> 2) & 1), ch = 4 * (u % NB) + (lane & 3);
        offq[i] = row * sq + ch * 8; offk[i] = row * sk + ch * 8; aimg[i] = img_addr(row, ch, NCB); }
    const int vu = w * 8 + (lane >> 3), vrow = 2 * (vu >> 1) + ((lane >> 2) & 1), vch = 4 * (vu & 1) + (lane & 3);
    const int offv = vrow * NU + vch * 8, offw = vrow * 64 + vch * 8; const unsigned va = v_addr(vrow, vch);
    auto issue_loads = [&](int n) {
        const int row0 = row0_of(n);
        const bf16* bq_ = gq + (size_t)row0 * sq; const bf16* bk_ = gk + (size_t)row0 * sk;
#pragma unroll
        for (int i = 0; i < NPQ; ++i) { pq[i] = *(const GAS v4u*)(bq_ + offq[i]); pk[i] = *(const GAS v4u*)(bk_ + offk[i]); }
        pv = NTL((const GAS v4u*)(gv + (size_t)row0 * NU + offv));
        if (ML) { pws = mls[(size_t)(row0 + vrow) * 8 + 3];
            if (n >= 4) pw = *(const GAS v4u*)(gw_ + (size_t)(row0 >> 6) * 4096 + offw);
            if (tid < 64) { ps0 = *(const GAS f32x4*)(mls + (size_t)(row0 + tid) * 8); ps1 = *(const GAS f32x4*)(mls + (size_t)(row0 + tid) * 8 + 4); } }
        else { if (tid < 32) ps0 = *(const GAS f32x4*)(pev + (size_t)(row0 >> 6) * WA + tid * 4); }
    };
    unsigned tch0 = 0u, tch1 = 0u, tdummy = 0u;
    auto touch = [&](int n) {
        const int row0 = row0_of(n);
        if (ML) { const int ln = tid & 255; const bf16* bp = (tid < 256 ? gq + (size_t)row0 * sq : gk + (size_t)row0 * sk) + (size_t)(ln >> 2) * DM + (ln & 3) * 64;
            tch0 = *(const GAS unsigned*)bp;
            if (tid < 64) tch1 = *(const GAS unsigned*)(gv + (size_t)(row0 + tid) * NU);
            else if (tid < 128 && n >= 4) tch1 = *(const GAS unsigned*)(gw_ + (size_t)(row0 >> 6) * 4096 + (tid - 64) * 64); }
        else { if (tid < 256) { const int ln = tid & 127; tch0 = *(const GAS unsigned*)((tid < 128 ? gq + (size_t)(row0 + (ln >> 1)) * sq : gk + (size_t)(row0 + (ln >> 1)) * sk) + (ln & 1) * 64); }
            else if (tid < 320) tch0 = *(const GAS unsigned*)(gv + (size_t)(row0 + tid - 256) * NU); }
    };
    auto store_images = [&](int n) {
#pragma unroll
        for (int i = 0; i < NPQ; ++i) { *(LAS v4u*)(L + SL_QT + aimg[i]) = pq[i]; *(LAS v4u*)(L + SL_KT + aimg[i]) = pk[i]; }
        *(LAS v4u*)(L + SL_V + va) = pv;
        if (!ML && tid < 32) *(LAS f32x4*)(SC + (n & 1) * SC_PAR + tid * 4) = ps0;
        if (ML) { v4u o; o.x = pkbf(lo2f(pv.x) * pws, hi2f(pv.x) * pws); o.y = pkbf(lo2f(pv.y) * pws, hi2f(pv.y) * pws); o.z = pkbf(lo2f(pv.z) * pws, hi2f(pv.z) * pws); o.w = pkbf(lo2f(pv.w) * pws, hi2f(pv.w) * pws);
            *(LAS v4u*)(L + SL_VW + va) = o;
            if (n >= 4) *(LAS v4u*)(L + SL_W + va) = pw;
            if (tid < 64) { LAS float* sp = SC + (n & 1) * SC_PAR + tid; sp[0] = ps0.x; sp[64] = ps0.y; sp[128] = ps0.z; sp[192] = ps0.w; sp[256] = ps1.x; sp[320] = ps1.y; sp[384] = ps1.z; SC[896 + tid] = ps1.w; } }
    };
    __syncthreads();
    issue_loads(0);
    for (int e = tid; e < 32768 / 16; e += NT) *(LAS v4u*)(L + SL_SF + e * 16) = (v4u){0u, 0u, 0u, 0u};
    store_images(0);
    __syncthreads();
#pragma unroll 1
    for (int n = 0; n < 68; ++n) {
        const bool lat = n >= 4; const int row0 = row0_of(n); const int cid = row0 >> 6;
        if (n + 1 < 68 && !(SKIP & 16)) issue_loads(n + 1);
        LAS float* SP = SC + (n & 1) * SC_PAR;
        float dec = 1.f; f32x4 pe[NOWN][4];
        if (ML) dec = SP[384];
        else {
#pragma unroll
            for (int i = 0; i < NOWN; ++i)
#pragma unroll
                for (int g = 0; g < 4; ++g) pe[i][g] = *(const LAS f32x4*)(SP + 32 * (kh * NKH + tp * NOWN + i) + 8 * g + 4 * hh);
        }
        f32x16 o;
        if (lat && !(SKIP & 4)) {
            f32x16 acc_o, acc_i;
#pragma unroll
            for (int r = 0; r < 16; ++r) { acc_o[r] = 0.f; acc_i[r] = 0.f; }
            if (ML) {
                if (kh == 0) {
#pragma unroll
                    for (int ts = 0; ts < 2; ++ts) {
                        const bool need = dirn ? (ts >= tp) : (ts <= tp);
                        if (need) {
                            const bf16x8 a0 = *(const LAS bf16x8*)(L + SL_W + tp * 4096 + 512 * ts + WL[0]), a1 = *(const LAS bf16x8*)(L + SL_W + tp * 4096 + 512 * ts + WL[1]);
                            const s16x4 lo0 = lds_tr(L + SL_V + ts * 4096 + VN[0]), hi0 = lds_tr(L + SL_V + ts * 4096 + 256 + VN[1]);
                            const s16x4 lo1 = lds_tr(L + SL_V + ts * 4096 + 2048 + VN[0]), hi1 = lds_tr(L + SL_V + ts * 4096 + 2048 + 256 + VN[1]);
                            acc_o = MFMA32(a0, cat4(lo0, hi0), acc_o);
                            acc_o = MFMA32(a1, cat4(lo1, hi1), acc_o);
                        }
                    }
                }
            } else
#pragma unroll
            for (int ts = 0; ts < 2; ++ts) {
                const bool need = dirn ? (ts >= tp) : (ts <= tp);
                if (need) {
                    f32x16 c;
#pragma unroll
                    for (int r = 0; r < 16; ++r) c[r] = 0.f;
                    {
                        bf16x8 a_c = *(const LAS bf16x8*)(L + SL_KT + ts * NCB * 8192 + LBx[0]), b_c = *(const LAS bf16x8*)(L + SL_QT + tp * NCB * 8192 + LBx[0]), a_n = a_c, b_n = b_c;
#pragma unroll
                        for (int s = 0; s < NKT; ++s) {
                            if (s + 1 < NKT) { a_n = *(const LAS bf16x8*)(L + SL_KT + ts * NCB * 8192 + 512 * ((s + 1) >> 1) + LBx[(s + 1) & 1]); b_n = *(const LAS bf16x8*)(L + SL_QT + tp * NCB * 8192 + 512 * ((s + 1) >> 1) + LBx[(s + 1) & 1]); }
                            c = MFMA32(a_c, b_c, c);
                            a_c = a_n; b_c = b_n;
                        }
                    }
                    const s16x4 vlo0 = lds_tr(L + SL_V + ts * 4096 + VK[0]), vhi0 = lds_tr(L + SL_V + ts * 4096 + 1024 + VK[1]);
                    const s16x4 vlo1 = lds_tr(L + SL_V + ts * 4096 + 2048 + VK[0]), vhi1 = lds_tr(L + SL_V + ts * 4096 + 3072 + VK[1]);
                    int dl = (lane & 31) - 4 * (int)hh; if (dirn) dl = -dl; asm volatile("" : "+v"(dl));
                    const int sg1 = dirn ? -1 : 1; const bool diag = ts == tp;
#pragma unroll
                    for (int r = 0; r < 16; ++r) { const int ro = (r & 3) + 8 * (r >> 2);
                        float wv = c[r];
                        if (diag) wv = (dl - sg1 * ro >= 0) ? wv : 0.f;
                        c[r] = wv; }
                    acc_o = MFMA32(pk8(c[0], c[1], c[2], c[3], c[4], c[5], c[6], c[7]), cat4(vlo0, vhi0), acc_o);
                    acc_o = MFMA32(pk8(c[8], c[9], c[10], c[11], c[12], c[13], c[14], c[15]), cat4(vlo1, vhi1), acc_o);
                }
            }
            {
#define LD_INTER(i_, LO_, HI_, SF_) do { LO_ = *(const LAS s16x4*)(L + SL_QT + tp * NCB * 8192 + 512 * ((i_) >> 1) + LK[(i_) & 1][0]); HI_ = *(const LAS s16x4*)(L + SL_QT + tp * NCB * 8192 + 512 * ((i_) >> 1) + LK[(i_) & 1][1]); \
                SF_ = *(const LAS bf16x8*)(L + SL_SF + ((((kh * NKH + ((i_) >> 1)) * 2 + tj) * 2 + ((i_) & 1)) * 1024) + lane * 16); } while (0)
                s16x4 lo_c, hi_c, lo_n, hi_n; bf16x8 sf_c, sf_n;
                LD_INTER(0, lo_c, hi_c, sf_c); lo_n = lo_c; hi_n = hi_c; sf_n = sf_c;
#pragma unroll
                for (int i = 0; i < 2 * NKH; ++i) {
                    if (i + 1 < 2 * NKH) LD_INTER(i + 1, lo_n, hi_n, sf_n);
                    acc_i = MFMA32(cat4(lo_c, hi_c), sf_c, acc_i);
                    lo_c = lo_n; hi_c = hi_n; sf_c = sf_n;
                }
#undef LD_INTER
            }
            if (ML) {
                f32x4 wi[4];
#pragma unroll
                for (int g = 0; g < 4; ++g) wi[g] = *(const LAS f32x4*)(SP + 128 + 32 * tp + 8 * g + 4 * hh);
#pragma unroll
                for (int r = 0; r < 16; ++r) o[r] = acc_o[r] + wi[r >> 2][r & 3] * acc_i[r];
            } else {
#pragma unroll
                for (int r = 0; r < 16; ++r) o[r] = acc_o[r] + acc_i[r];
            }
            {
#pragma unroll
                for (int r = 0; r < 8; ++r) { const int rr = kh ? r : r + 8; *(LAS float*)(L + SL_XCH + (((tp * 2 + tj) * 16 + rr) * 64 + lane) * 4) = kh ? o[r] : o[r + 8]; }
            }
        }
        {
            if (ML) {
#pragma unroll
                for (int i = 0; i < NOWN; ++i)
#pragma unroll
                    for (int r = 0; r < 16; ++r) S[i][r] *= dec;
            }
#define LD_GA(ks_, i_, LO_, HI_) do { LO_ = lds_tr(L + SL_KT + ((ks_) >> 1) * NCB * 8192 + 4096 * ((ks_) & 1) + tkoff[i_] + TRK[0]); HI_ = lds_tr(L + SL_KT + ((ks_) >> 1) * NCB * 8192 + 4096 * ((ks_) & 1) + 256 + tkoff[i_] + TRK[1]); } while (0)
#define LD_GB(ks_, LO_, HI_) do { LO_ = lds_tr(L + (ML ? SL_VW : SL_V) + ((ks_) >> 1) * 4096 + 2048 * ((ks_) & 1) + VN[0]); HI_ = lds_tr(L + (ML ? SL_VW : SL_V) + ((ks_) >> 1) * 4096 + 2048 * ((ks_) & 1) + 256 + VN[1]); } while (0)
            s16x4 alo_c, ahi_c, blo_c, bhi_c, alo_n, ahi_n, blo_n, bhi_n;
            LD_GB(0, blo_c, bhi_c); LD_GA(0, 0, alo_c, ahi_c); alo_n = alo_c; ahi_n = ahi_c; blo_n = blo_c; bhi_n = bhi_c;
            constexpr int NG = (SKIP & 8) ? 0 : 4 * NOWN;
#pragma unroll
            for (int j = 0; j < NG; ++j) {
                const int ks = j / NOWN, i = j % NOWN, ks1 = (j + 1) / NOWN, i1 = (j + 1) % NOWN;
                if (j + 1 < NG) { LD_GA(ks1, i1, alo_n, ahi_n); if (i1 == 0) LD_GB(ks1, blo_n, bhi_n); }
                S[i] = MFMA32(cat4(alo_c, ahi_c), cat4(blo_c, bhi_c), S[i]);
                alo_c = alo_n; ahi_c = ahi_n; if (i1 == 0) { blo_c = blo_n; bhi_c = bhi_n; }
                (void)ks;
            }
#undef LD_GA
#undef LD_GB
            if (!ML) {
#pragma unroll
                for (int i = 0; i < NOWN; ++i)
#pragma unroll
                    for (int r = 0; r < 16; ++r) S[i][r] *= pe[i][r >> 2][r & 3];
            }
        }
        __syncthreads();
#pragma unroll
        for (int i = 0; i < NOWN; ++i)
#pragma unroll
            for (int st = 0; st < 2; ++st) {
                const bf16x8 f8 = pk8(S[i][8 * st], S[i][8 * st + 1], S[i][8 * st + 2], S[i][8 * st + 3], S[i][8 * st + 4], S[i][8 * st + 5], S[i][8 * st + 6], S[i][8 * st + 7]);
                *(LAS bf16x8*)(L + SL_SF + ((((kh * NKH + tp * NOWN + i) * 2 + tj) * 2 + st) * 1024) + lane * 16) = f8;
            }
        if (n + 1 < 68 && !(SKIP & 16)) store_images(n + 1);
        if (lat && !(SKIP & 2)) {
            float xv[8];
#pragma unroll
            for (int r8 = 0; r8 < 8; ++r8) { const int r = kh ? r8 + 8 : r8; xv[r8] = *(const LAS float*)(L + SL_XCH + (((tp * 2 + tj) * 16 + r) * 64 + lane) * 4); }
#pragma unroll
            for (int r8 = 0; r8 < 8; ++r8) { const int r = kh ? r8 + 8 : r8; const float ov = (kh ? o[r8 + 8] : o[r8]) + xv[r8];
                const int pr = 32 * tp + (r & 3) + 8 * (r >> 2) + 4 * (int)hh;
                go[(size_t)(row0 + pr) * WA + 32 * tj + (lane & 31)] = (bf16)(pkbf(ov, 0.f) & 0xffffu); }
        }
        LDS_BARRIER();
    }
}

__device__ __forceinline__ void nchain_task(Frame& F, int j) {
    const int kq = j & 3, id = j >> 2, dirn = id & 1, h = (id >> 1) & 3, b = id >> 3;
    const int tid = F.tid, lane = F.lane, w = F.wave;
    LAS unsigned char* L = F.lds;
    constexpr int NQ = 0, NK = 8192, NS = 16384;
    LAS float* SN = (LAS float*)(L + NS);
    const bf16* gq = F.XN + h * MLD + kq * 64; const bf16* gk = gq + WB;
    const float* mls = F.MLS + (size_t)(dirn * 4 + h) * MALL * 8;
    float* dqp = F.DQP + (size_t)((dirn * 4 + h) * 4 + kq) * MX;
    auto row0_of = [&](int n) -> int { if (n > 67) n = 67; if (n < 4) { const int cc = dirn ? 3 - n : n; return MX + b * CTXL + cc * 64; } const int lc = dirn ? 67 - n : n - 4; return b * SEQ + lc * 64; };
    struct Stg { v4u q, k; float ws, dec; };
    Stg A, B, C; A.ws = A.dec = B.ws = B.dec = C.ws = C.dec = 0.f;
    auto issue = [&](int n, Stg& t) { const int row0 = row0_of(n); const size_t off = (size_t)(row0 + (tid >> 3)) * DM + (tid & 7) * 8;
        t.q = *(const GAS v4u*)(gq + off); t.k = *(const GAS v4u*)(gk + off);
        if (tid < 64) { t.ws = mls[(size_t)(row0 + tid) * 8 + 3]; t.dec = mls[(size_t)(row0 + tid) * 8 + 6]; } };
    auto stash = [&](const Stg& t) { *(LAS v4u*)(L + NQ + tid * 16) = t.q; *(LAS v4u*)(L + NK + tid * 16) = t.k; if (tid < 64) { SN[tid] = t.ws; if (tid == 0) SN[640] = t.dec; } };
    auto step = [&](int n, Stg& ld, const Stg& st) {
        const int row0 = row0_of(n); const bool on = n < 68;
        issue(n + 2, ld);
        float dq_keep = 0.f;
        if (on && n >= 4) {
            const int kk = tid & 7; const v4u u = *(const LAS v4u*)(L + NQ + tid * 16);
            const f32x4 na = *(const LAS f32x4*)(SN + 64 + 8 * kk), nb = *(const LAS f32x4*)(SN + 64 + 8 * kk + 4);
            float d = lo2f(u.x) * na.x + hi2f(u.x) * na.y + lo2f(u.y) * na.z + hi2f(u.y) * na.w + lo2f(u.z) * nb.x + hi2f(u.z) * nb.y + lo2f(u.w) * nb.z + hi2f(u.w) * nb.w;
            d += __shfl_xor(d, 1); d += __shfl_xor(d, 2); d += __shfl_xor(d, 4);
            dq_keep = d;
        }
        { float a = 0.f;
#pragma unroll
          for (int i = 0; i < 8; ++i) { const int s_ = 8 * w + i; a += SN[s_] * bf2f(*(const LAS unsigned short*)(L + NK + s_ * 128 + lane * 2)); }
          SN[128 + w * 64 + lane] = a; }
        __syncthreads();
        if (on && tid < 64) { float nn = SN[640] * SN[64 + tid];
#pragma unroll
            for (int ww = 0; ww < 8; ++ww) nn += SN[128 + ww * 64 + tid];
            SN[64 + tid] = nn; }
        stash(st);
        if (on && n >= 4 && (tid & 7) == 0) dqp[row0 + (tid >> 3)] = dq_keep;
        LDS_BARRIER();
    };
    __syncthreads();
    issue(0, A); issue(1, B);
    if (tid < 64) SN[64 + tid] = 0.f;
    stash(A);
    __syncthreads();
#pragma unroll 1
    for (int n = 0; n < 69; n += 3) { step(n, C, B); step(n + 1, A, C); step(n + 2, B, A); }
}

__device__ __forceinline__ void p4_scan(Frame& F) {
    for (int t = F.vcu; t < 256; t += F.G) {
        if (t < 128) scan_task<true>(F, t);
        else { scan_task<false>(F, t - 128); nchain_task(F, t - 128); }
    }
}
__device__ __forceinline__ void p5_combine(Frame& F) {
    bf16* Y = F.XN;
    const int gw = F.vcu * NWAVES + F.wave, NGW = F.G * NWAVES;
    const int ch = F.lane * 16, hq = F.lane >> 4;
    float nwa[16], nwb[16];
#pragma unroll
    for (int j = 0; j < 4; ++j) { const f32x4 a = *(const GAS f32x4*)(F.hg_norm_w + ch + 4 * j), b = *(const GAS f32x4*)(F.ml_norm_w + ch + 4 * j);
        nwa[4 * j] = a.x; nwa[4 * j + 1] = a.y; nwa[4 * j + 2] = a.z; nwa[4 * j + 3] = a.w; nwb[4 * j] = b.x; nwb[4 * j + 1] = b.y; nwb[4 * j + 2] = b.z; nwb[4 * j + 3] = b.w; }
    for (int row0 = gw; row0 < MX; row0 += 2 * NGW) {
        v4u fa[2][2], fb[2][2], fz[2][2], ha[2][2], hb[2][2], hg[2][2]; float m2[2][2], m4[2][2], m5[2][2], dq[2][2][4];
#pragma unroll
        for (int rr = 0; rr < 2; ++rr) { const int row = (row0 + rr * NGW < MX) ? row0 + rr * NGW : row0;
#pragma unroll
            for (int e = 0; e < 2; ++e) {
                fa[rr][e] = *(const GAS v4u*)(F.OAF + (size_t)row * WA + ch + 8 * e); fb[rr][e] = *(const GAS v4u*)(F.OAB + (size_t)row * WA + ch + 8 * e);
                fz[rr][e] = NTL((const GAS v4u*)(F.U + (size_t)row * NU + C_AZ + ch + 8 * e));
                ha[rr][e] = *(const GAS v4u*)(F.HBF + (size_t)row * WB + ch + 8 * e); hb[rr][e] = *(const GAS v4u*)(F.HBB + (size_t)row * WB + ch + 8 * e);
                hg[rr][e] = NTL((const GAS v4u*)(F.U + (size_t)row * NU + C_BO + ch + 8 * e)); }
#pragma unroll
            for (int d = 0; d < 2; ++d) { const GAS float* mr = (const GAS float*)F.MLS + ((size_t)(d * 4 + hq) * MALL + row) * 8; const GAS float* dp = (const GAS float*)F.DQP + (size_t)((d * 4 + hq) * 4) * MX + row;
                m2[rr][d] = mr[2]; m4[rr][d] = mr[4]; m5[rr][d] = mr[5]; dq[rr][d][0] = dp[0]; dq[rr][d][1] = dp[MX]; dq[rr][d][2] = dp[2 * MX]; dq[rr][d][3] = dp[3 * MX]; } }
#pragma unroll
        for (int rr = 0; rr < 2; ++rr) { const int row = row0 + rr * NGW; if (row >= MX) break;
            { float o[16];
                const unsigned ua[8] = {fa[rr][0].x, fa[rr][0].y, fa[rr][0].z, fa[rr][0].w, fa[rr][1].x, fa[rr][1].y, fa[rr][1].z, fa[rr][1].w}, ub[8] = {fb[rr][0].x, fb[rr][0].y, fb[rr][0].z, fb[rr][0].w, fb[rr][1].x, fb[rr][1].y, fb[rr][1].z, fb[rr][1].w};
                const unsigned uz[8] = {fz[rr][0].x, fz[rr][0].y, fz[rr][0].z, fz[rr][0].w, fz[rr][1].x, fz[rr][1].y, fz[rr][1].z, fz[rr][1].w};
                float ss = 0.f;
#pragma unroll
                for (int j = 0; j < 8; ++j) { o[2 * j] = lo2f(ua[j]) + lo2f(ub[j]); o[2 * j + 1] = hi2f(ua[j]) + hi2f(ub[j]); ss += o[2 * j] * o[2 * j] + o[2 * j + 1] * o[2 * j + 1]; }
                ss += __shfl_xor(ss, 1); ss += __shfl_xor(ss, 2); ss += __shfl_xor(ss, 4);
                const float r = 1.f / sqrtf(ss * (1.f / HGD) + NORM_EPS);
                unsigned w[8];
#pragma unroll
                for (int j = 0; j < 8; ++j) { const float y0 = o[2 * j] * r * nwa[2 * j] * siluf(lo2f(uz[j])), y1 = o[2 * j + 1] * r * nwa[2 * j + 1] * siluf(hi2f(uz[j])); w[j] = pk2(y0, y1); }
                *(GAS v4u*)(Y + (size_t)row * DM + ch) = (v4u){w[0], w[1], w[2], w[3]}; *(GAS v4u*)(Y + (size_t)row * DM + ch + 8) = (v4u){w[4], w[5], w[6], w[7]}; }
            { float o[16];
                const unsigned ua[8] = {ha[rr][0].x, ha[rr][0].y, ha[rr][0].z, ha[rr][0].w, ha[rr][1].x, ha[rr][1].y, ha[rr][1].z, ha[rr][1].w}, ub[8] = {hb[rr][0].x, hb[rr][0].y, hb[rr][0].z, hb[rr][0].w, hb[rr][1].x, hb[rr][1].y, hb[rr][1].z, hb[rr][1].w};
                const unsigned ug[8] = {hg[rr][0].x, hg[rr][0].y, hg[rr][0].z, hg[rr][0].w, hg[rr][1].x, hg[rr][1].y, hg[rr][1].z, hg[rr][1].w};
                float invd[2];
#pragma unroll
                for (int d = 0; d < 2; ++d) { const float den = m2[rr][d] * ((dq[rr][d][0] + dq[rr][d][1]) + (dq[rr][d][2] + dq[rr][d][3])) + m5[rr][d]; invd[d] = rcpf_(fmaxf(fabsf(den), m4[rr][d])); }
                float s = 0.f;
#pragma unroll
                for (int j = 0; j < 8; ++j) { o[2 * j] = lo2f(ua[j]) * invd[0] + lo2f(ub[j]) * invd[1]; o[2 * j + 1] = hi2f(ua[j]) * invd[0] + hi2f(ub[j]) * invd[1]; s += o[2 * j] + o[2 * j + 1]; }
                s += __shfl_xor(s, 1); s += __shfl_xor(s, 2); s += __shfl_xor(s, 4); s += __shfl_xor(s, 8);
                const float mu = s * (1.f / MLD); float q = 0.f;
#pragma unroll
                for (int j = 0; j < 16; ++j) { o[j] -= mu; q += o[j] * o[j]; }
                q += __shfl_xor(q, 1); q += __shfl_xor(q, 2); q += __shfl_xor(q, 4); q += __shfl_xor(q, 8);
                const float r = 1.f / sqrtf(q * (1.f / MLD) + NORM_EPS);
                unsigned w[8];
#pragma unroll
                for (int j = 0; j < 8; ++j) { const float y0 = o[2 * j] * r * nwb[2 * j] * lo2f(ug[j]), y1 = o[2 * j + 1] * r * nwb[2 * j + 1] * hi2f(ug[j]); w[j] = pk2(y0, y1); }
                *(GAS v4u*)(Y + (size_t)row * DM + WA + ch) = (v4u){w[0], w[1], w[2], w[3]}; *(GAS v4u*)(Y + (size_t)row * DM + WA + ch + 8) = (v4u){w[4], w[5], w[6], w[7]}; }
        }
    }
}

struct EpiGate {
    static constexpr bool PERM = true, AFTER_DRAIN = false, SPLIT = true, ADJ = true; static constexpr int HALF_STORES = 8;
    bf16* O; int ldc; const LAS unsigned short* gl;
    __device__ __forceinline__ void operator()(const pg8::f32x4 (&acc)[2][2][4][2], const pg8::Unit& u, int wr, int wc, int fr, int fq) const {}
    __device__ __forceinline__ void half(const pg8::f32x4 (&acc)[2][2][4][2], const pg8::Unit& u, const int ai, int wr, int wc, int fr, int fq) const {
        using pg8::BM; using pg8::HALF; using pg8::f32x4; using pg8::u32x4;
        unsigned frv = (unsigned)fr; asm volatile("" : "+v"(frv));
        const bool odd = (frv & 1u) != 0u;
        const unsigned off0 = ((unsigned)(u.pm * BM + wr * 64 + ai * HALF) + (frv & ~1u)) * (unsigned)ldc * 2u + (unsigned)(u.pn * BM + wc * 64 + 8 * fq) * 2u + (frv & 1u) * 64u;
        char* const ob = (char*)O;
        const LAS unsigned short* gp = gl + ((u.pm * BM) / SEQ) * DM + u.pn * BM + wc * 64 + 8 * fq;
        const v4u g0 = *(const LAS v4u*)gp, g1 = *(const LAS v4u*)(gp + 32);
#pragma unroll
        for (int m = 0; m < 4; ++m) { u32x4 w[2];
#pragma unroll
            for (int bj = 0; bj < 2; ++bj) { const f32x4 v0 = acc[ai][bj][m][0], v1 = acc[ai][bj][m][1]; const v4u gq = bj ? g1 : g0;
                w[bj].x = pg8::cvt_pk_bf16(v0[0] * lo2f(gq.x), v0[1] * hi2f(gq.x)); w[bj].y = pg8::cvt_pk_bf16(v0[2] * lo2f(gq.y), v0[3] * hi2f(gq.y));
                w[bj].z = pg8::cvt_pk_bf16(v1[0] * lo2f(gq.z), v1[1] * hi2f(gq.z)); w[bj].w = pg8::cvt_pk_bf16(v1[2] * lo2f(gq.w), v1[3] * hi2f(gq.w)); }
            u32x4 sa, sb;
#pragma unroll
            for (int e = 0; e < 4; ++e) { const unsigned t = odd ? w[0][e] : w[1][e];
                const unsigned r = (unsigned)__builtin_amdgcn_update_dpp(0, (int)t, 0xB1, 0xf, 0xf, false);
                sa[e] = odd ? r : w[0][e]; sb[e] = odd ? w[1][e] : r; }
            *(u32x4*)(ob + (size_t)(off0 + (unsigned)(m * 16 * ldc) * 2u)) = sa;
            *(u32x4*)(ob + (size_t)(off0 + (unsigned)((m * 16 + 1) * ldc) * 2u)) = sb; }
    }
};

typedef unsigned u32x2_t __attribute__((ext_vector_type(2)));
__device__ __forceinline__ void p7_ln(Frame& F) {
    const int gw = F.vcu * NWAVES + F.wave, NGW = F.G * NWAVES;
    const bf16* Y2 = F.U;
    f32x4 gg[8], bbv[8];
#pragma unroll
    for (int j = 0; j < 8; ++j) { const int k = 4 * F.lane + 256 * j; gg[j] = *(const GAS f32x4*)(F.ln_g + k); bbv[j] = *(const GAS f32x4*)(F.ln_b + k); }
    for (int row = 2 * gw; row < MX; row += 2 * NGW) {
        const GAS f32x4* xa = (const GAS f32x4*)(F.x + (size_t)row * DM) + F.lane; const GAS f32x4* xb = xa + DM / 4;
        const GAS u32x2_t* ya = (const GAS u32x2_t*)(Y2 + (size_t)row * DM) + F.lane; const GAS u32x2_t* yb = ya + DM / 4;
        GAS f32x4* ra = (GAS f32x4*)(F.out + (size_t)row * DM) + F.lane; GAS f32x4* rb = ra + DM / 4;
        f32x4 va[8], vb[8]; u32x2_t pa[8], pb[8]; float sa = 0.f, sb = 0.f;
#pragma unroll
        for (int j = 0; j < 8; ++j) { va[j] = NTL(xa + 64 * j); vb[j] = NTL(xb + 64 * j); pa[j] = ya[64 * j]; pb[j] = yb[64 * j]; }
#pragma unroll
        for (int j = 0; j < 8; ++j) { va[j] = va[j] * ALPHA + (f32x4){lo2f(pa[j].x), hi2f(pa[j].x), lo2f(pa[j].y), hi2f(pa[j].y)}; vb[j] = vb[j] * ALPHA + (f32x4){lo2f(pb[j].x), hi2f(pb[j].x), lo2f(pb[j].y), hi2f(pb[j].y)};
            sa += (va[j].x + va[j].y) + (va[j].z + va[j].w); sb += (vb[j].x + vb[j].y) + (vb[j].z + vb[j].w); }
        const float ma = wave_sum(sa) * (1.f / DM), mb = wave_sum(sb) * (1.f / DM); float qa = 0.f, qb = 0.f;
#pragma unroll
        for (int j = 0; j < 8; ++j) { va[j] = va[j] - ma; vb[j] = vb[j] - mb; qa += (va[j].x * va[j].x + va[j].y * va[j].y) + (va[j].z * va[j].z + va[j].w * va[j].w); qb += (vb[j].x * vb[j].x + vb[j].y * vb[j].y) + (vb[j].z * vb[j].z + vb[j].w * vb[j].w); }
        const float rsa = 1.f / sqrtf(wave_sum(qa) * (1.f / DM) + LN_EPS), rsb = 1.f / sqrtf(wave_sum(qb) * (1.f / DM) + LN_EPS);
#pragma unroll
        for (int j = 0; j < 8; ++j) { ra[64 * j] = va[j] * rsa * gg[j] + bbv[j]; rb[64 * j] = vb[j] * rsb * gg[j] + bbv[j]; }
    }
}

struct Args { const float* in[16]; float* out; unsigned char* ws; int ph_lo, ph_hi, li, pad; };
__global__ void __launch_bounds__(NWAVES * 64, 2) mk_fwd(Args args) {
    extern __shared__ __attribute__((aligned(16))) unsigned char lds[];
    Frame F;
    F.lds = (LAS unsigned char*)lds;
    F.MISC = (volatile LAS unsigned*)(F.lds + MISC_OFF);
    F.tid = threadIdx.x; F.lane = F.tid & 63; F.wave = __builtin_amdgcn_readfirstlane(F.tid >> 6);
    F.G = gridDim.x; { const int bx = blockIdx.x; F.vcu = (F.G % 8 == 0) ? (bx % 8) * (F.G / 8) + bx / 8 : bx; }
    unsigned char* ws = args.ws;
    F.ctl = (gu32*)(ws + WS_CTL);
    F.x = args.in[0]; F.c = args.in[1]; F.ctx = args.in[2]; F.c_ctx = args.in[3]; F.w_mod = args.in[4]; F.b_mod = args.in[5]; F.w_in = args.in[6];
    F.conv_w = args.in[7]; F.conv_b = args.in[8]; F.hg_lb = args.in[9]; F.ml_gate_b = args.in[10]; F.hg_norm_w = args.in[11]; F.ml_norm_w = args.in[12];
    F.w_out = args.in[13]; F.ln_g = args.in[14]; F.ln_b = args.in[15]; F.out = args.out;
    F.modp = (float*)(ws + WS_MODP); F.gate = (float*)(ws + WS_GATE);
    F.QTF = (bf16*)(ws + WS_WINT); F.PE = (float*)(ws + WS_PE); F.MLS = (float*)(ws + WS_MLS); F.DEC = (float*)(ws + WS_DEC); F.MLW = (bf16*)(ws + WS_MLW); F.DQP = (float*)(ws + WS_DQP); F.GG = (float*)(ws + WS_GG);
    F.WinT = (bf16*)(ws + WS_WINT); F.WoutT = (bf16*)(ws + WS_WOUTT); F.XN = (bf16*)(ws + WS_XN); F.U = (bf16*)(ws + WS_U);
    F.OAF = (bf16*)args.out; F.OAB = F.OAF + (size_t)MX * WA; F.HBF = F.OAB + (size_t)MX * WA; F.HBB = F.HBF + (size_t)MX * WB;
    for (int u = F.tid; u < (LDS_BYTES - LDSCTL_OFF) / 4; u += NT) ((LAS unsigned*)(F.lds + LDSCTL_OFF))[u] = 0u;
    __syncthreads();
    XcdBarrier bar; bar.bar = (unsigned*)(F.ctl + CW_BAR); bar.x = 0; bar.st = nullptr;
    if (MK_N_LAUNCHES == 1) bar = xcd_barrier_post((unsigned*)(F.ctl + CW_BAR), F.MISC + 8);
    const int lo = args.ph_lo, hi = args.ph_hi;
#define IN(k) (lo <= (k) && (k) < hi)
#define SEAM(k) do { if (IN(k) && IN((k) + 1)) xcd_barrier(bar); } while (0)
    const bool merge01 = IN(0) && IN(1) && MK_N_LAUNCHES == 1;
    if (IN(0)) { p0_prep(F, merge01); } if (!merge01) SEAM(0);
    if (IN(1)) { if (merge01) gemv_wait(F); p1_lnmod(F); } SEAM(1);
    if (IN(2)) { pg8::Gemm g{F.XN, F.WinT, MALL, NU, DM}; pg8::StaticOrder S; S.init(MALL, NU, F.G, (int)blockIdx.x);
        pg8::EpiBf16<2> E{F.U, NU, nullptr, 0, 0, 1.f, 4, F.GG, C_BG / 256, C_BO / 256, C_BG / 256, (unsigned*)(F.GG + (size_t)MALL * 16 + 65536)};
        pg8::gemm_phase<pg8::EpiBf16<2>, pg8::StaticOrder, PG8_ALIGN, PG8_SP2>(F.lds + RING_OFF, g, S, E);
        p2_wout_copy(F, (MALL / 256) * (NU / 256)); } SEAM(2);
    if (IN(3)) { p3_conv(F); p3_hg_prep<false>(F); p3_ml_scalars(F); xcd_barrier(bar); p3b_ml_scores(F); } SEAM(3);
    if (IN(4)) { p4_scan(F); } SEAM(4);
    if (IN(5)) { p5_combine(F); } SEAM(5);
    if (IN(6)) { pg8::Gemm g{F.XN, F.WoutT, MX, DM, DM}; pg8::StaticOrder S; S.init(MX, DM, F.G, (int)blockIdx.x);
        LAS unsigned short* gl = (LAS unsigned short*)(F.lds + RING_OFF + RING_BYTES);
        for (int i = F.tid; i < BATCH * DM / 2; i += NT) { const f32x2_t gv = *(const GAS f32x2_t*)(F.gate + 2 * i); ((LAS unsigned*)gl)[i] = pkbf(gv.x, gv.y); }
        __syncthreads();
        EpiGate E{F.U, DM, gl};
        pg8::gemm_phase<EpiGate, pg8::StaticOrder, PG8_ALIGN, PG8_SP2>(F.lds + RING_OFF, g, S, E); } SEAM(6);
    if (IN(7)) { p7_ln(F); }
#undef IN
#undef SEAM
}

extern "C" void kernel_launch(void* const* d_in, const int* in_sizes, int n_in, void* d_out, int out_size, void* d_ws, size_t ws_size, hipStream_t stream) {
    static int grid = 0;
    if (grid == 0) {
        if (n_in != 16 || out_size != MX * DM || ws_size < WS_END) { fprintf(stderr, "kernel_launch: unexpected shapes (n_in %d out %d ws %zu)\n", n_in, out_size, ws_size); grid = -1; return; }
        int dev = 0, cus = 0, per_cu = 0;
        if (hipGetDevice(&dev) != hipSuccess || hipDeviceGetAttribute(&cus, hipDeviceAttributeMultiprocessorCount, dev) != hipSuccess) { grid = -1; return; }
        if (hipFuncSetAttribute((const void*)mk_fwd, hipFuncAttributeMaxDynamicSharedMemorySize, LDS_BYTES) != hipSuccess) { fprintf(stderr, "kernel_launch: hipFuncSetAttribute failed\n"); grid = -1; return; }
        if (hipOccupancyMaxActiveBlocksPerMultiprocessor(&per_cu, (const void*)mk_fwd, NT, LDS_BYTES) != hipSuccess || per_cu < 1) { fprintf(stderr, "kernel_launch: occupancy query says %d\n", per_cu); per_cu = 1; }
        (void)hipGetLastError();
        grid = cus;
    }
    if (grid < 0) return;
    if (hipMemsetAsync((char*)d_ws + WS_CTL, 0, CTL_ZERO_BYTES, stream) != hipSuccess) { fprintf(stderr, "kernel_launch: memset failed\n"); return; }
    Args a{};
    for (int i = 0; i < 16; ++i) a.in[i] = (const float*)d_in[i];
    a.out = (float*)d_out; a.ws = (unsigned char*)d_ws;
    for (int li = 0; li < MK_N_LAUNCHES; ++li) {
        a.ph_lo = (MK_N_LAUNCHES == 1) ? 0 : li; a.ph_hi = (MK_N_LAUNCHES == 1) ? N_PHASES : li + 1; a.li = li;
        hipLaunchKernelGGL(mk_fwd, dim3(grid), dim3(NT), LDS_BYTES, stream, a);
        const hipError_t le = hipPeekAtLastError();
        if (le != hipSuccess) { fprintf(stderr, "kernel_launch: launch %d failed: %s\n", li, hipGetErrorName(le)); break; }
    }
}
```
